# Optimizing an MI355X kernel written in HIP

```python
import jax
import jax.numpy as jnp
from jax import lax
import numpy as np

D_MODEL = 1024
BATCH = 2
SEQ = 8192
DEPTH = 2

GRID_W = 64
CTX_LEN = 256
ROPE_THETA = 10000.0
RMS_EPS = 1e-6

GLA_HEADS = 4
GLA_DK = 64
GLA_DV = 128
GLA_RANK = 16
GLA_TAU = 16.0
GLA_CHUNK = 64

SWA_HEADS = 8
SWA_KV_HEADS = 2
SWA_HD = 64
WINDOW = 128
SWA_BLOCK = WINDOW

MLA_HEADS = 8
MLA_Q_RANK = 512
MLA_KV_RANK = 256
MLA_NOPE = 128
MLA_ROPE = 64
MLA_V = 128
MLA_BLOCK = 128
MLA_SCALE = (MLA_NOPE + MLA_ROPE) ** -0.5

N_EXPERTS = 64
TOP_K = 8
N_GROUPS = 8
TOPK_GROUPS = 4
D_EXPERT = 256
D_SHARED = 256
ROUTED_SCALE = 2.5
MOE_BLOCK = 128

EVEN_SPLITS = (GLA_HEADS * GLA_DK, GLA_HEADS * GLA_DK, GLA_HEADS * GLA_DV, GLA_HEADS * GLA_DV, GLA_RANK, GLA_RANK, SWA_HEADS * SWA_HD, SWA_KV_HEADS * SWA_HD, SWA_KV_HEADS * SWA_HD)
EVEN_IN = sum(EVEN_SPLITS)
EVEN_OUT = GLA_HEADS * GLA_DV + SWA_HEADS * SWA_HD
ODD_SPLITS = (MLA_Q_RANK, MLA_KV_RANK, MLA_ROPE)
ODD_IN = sum(ODD_SPLITS)
ODD_OUT = MLA_HEADS * MLA_V
N_EVEN = (DEPTH + 1) // 2
N_ODD = DEPTH // 2

kernel_name = "hybrid_gla_swa_mla_moe_dit"


def rmsnorm(x, g):
    xf = x.astype(jnp.float32)
    y = xf * lax.rsqrt(jnp.mean(xf * xf, axis=-1, keepdims=True) + RMS_EPS)
    return y.astype(x.dtype) * g


def modulate(x, g, shift, scale):
    return rmsnorm(x, g) * (1 + scale) + shift


def split_cols(z, sizes):
    cuts = [int(s) for s in np.cumsum(sizes)[:-1]]
    return jnp.split(z, cuts, axis=-1)


def axial_rope_angles(seq_len, rot_dim):
    rows = seq_len // GRID_W
    row = jnp.repeat(jnp.arange(rows, dtype=jnp.float32), GRID_W)
    col = jnp.tile(jnp.arange(GRID_W, dtype=jnp.float32), rows)
    axis_dim = rot_dim // 2
    inv_freq = ROPE_THETA ** (-jnp.arange(0, axis_dim, 2, dtype=jnp.float32) / axis_dim)
    return jnp.concatenate([row[:, None] * inv_freq, col[:, None] * inv_freq], axis=-1)


def apply_rope(x, ang):
    seq_len, half = ang.shape
    a = ang.reshape((1, seq_len) + (1,) * (x.ndim - 3) + (half,))
    cos, sin = jnp.cos(a), jnp.sin(a)
    xf = x.astype(jnp.float32)
    x1, x2 = xf[..., :half], xf[..., half:]
    return jnp.concatenate([x1 * cos - x2 * sin, x2 * cos + x1 * sin], axis=-1).astype(x.dtype)


def gla_log_decay(a_low, wa2, ba):
    return jax.nn.log_sigmoid((a_low @ wa2 + ba).astype(jnp.float32)) / GLA_TAU


def gla_chunk_scan(q, k, v, log_a, s0):
    b_, length, h, _ = q.shape
    dv = v.shape[-1]
    n = length // GLA_CHUNK

    def to_chunks(t):
        return t.astype(jnp.float32).reshape(b_, n, GLA_CHUNK, h, t.shape[-1]).transpose(1, 0, 3, 2, 4)

    incl = jnp.tril(jnp.ones((GLA_CHUNK, GLA_CHUNK), dtype=bool))[None, None, :, :, None]

    def step(state, inp):
        qc, kc, vc, ac = inp
        cum = jnp.cumsum(ac, axis=2)
        o = jnp.einsum('bhcd,bhde->bhce', qc * jnp.exp(cum), state)
        rel = jnp.exp(jnp.where(incl, cum[:, :, :, None, :] - cum[:, :, None, :, :], -jnp.inf))
        scores = jnp.einsum('bhijd,bhjd->bhij', qc[:, :, :, None, :] * rel, kc)
        o = o + jnp.einsum('bhij,bhje->bhie', scores, vc)
        last = cum[:, :, -1:, :]
        state = jnp.exp(last[:, :, 0, :])[..., None] * state + jnp.einsum('bhjd,bhje->bhde', kc * jnp.exp(last - cum), vc)
        return state, o

    s_fin, o = lax.scan(step, s0, (to_chunks(q), to_chunks(k), to_chunks(v), to_chunks(log_a)))
    o = o.transpose(1, 0, 3, 2, 4).reshape(b_, length, h, dv)
    return o.astype(v.dtype), s_fin


def gla_bidir(q, k, v, la_f, la_b, s_f, s_b):
    o_f, s_f = gla_chunk_scan(q, k, v, la_f, s_f)
    flip = lambda t: jnp.flip(t, axis=1)
    o_b, s_b = gla_chunk_scan(flip(q), flip(k), flip(v), flip(la_b), s_b)
    return o_f + flip(o_b), s_f, s_b


def gla_output(o, g, norm_g):
    b_, length = g.shape[:2]
    return rmsnorm(o, norm_g).reshape(b_, length, -1) * jax.nn.silu(g)


def swa_context(q, k, v, sink):
    b_, length = q.shape[:2]
    g = SWA_HEADS // SWA_KV_HEADS
    qg = q.reshape(b_, length, SWA_KV_HEADS, g, SWA_HD)
    s = jnp.einsum('bqhgd,bkhd->bhgqk', qg, k).astype(jnp.float32) * (SWA_HD ** -0.5)
    sink_b = jnp.broadcast_to(sink.reshape(1, SWA_KV_HEADS, g, 1, 1).astype(jnp.float32), s.shape[:-1] + (1,))
    p = jax.nn.softmax(jnp.concatenate([sink_b, s], axis=-1), axis=-1)[..., 1:].astype(v.dtype)
    o = jnp.einsum('bhgqk,bkhd->bqhgd', p, v)
    return o.reshape(b_, length, SWA_HEADS * SWA_HD)


def swa_latent(q, k, v, k_ctx, v_ctx, sink):
    b_, length = q.shape[:2]
    g = SWA_HEADS // SWA_KV_HEADS
    blk = SWA_BLOCK
    nb = length // blk
    scale = SWA_HD ** -0.5
    qb = q.reshape(b_, nb, blk, SWA_KV_HEADS, g, SWA_HD)

    def band(t):
        tp = jnp.pad(t, ((0, 0), (blk, blk), (0, 0), (0, 0))).reshape(b_, nb + 2, blk, SWA_KV_HEADS, SWA_HD)
        return jnp.concatenate([tp[:, :-2], tp[:, 1:-1], tp[:, 2:]], axis=2)

    kw, vw = band(k), band(v)
    s_win = jnp.einsum('bnqhgd,bnshd->bnhgqs', qb, kw).astype(jnp.float32) * scale
    s_ctx = jnp.einsum('bnqhgd,bchd->bnhgqc', qb, k_ctx).astype(jnp.float32) * scale
    qi = jnp.arange(blk)[:, None]
    si = jnp.arange(3 * blk)[None, :]
    kpos = jnp.arange(nb)[:, None, None] * blk - blk + si[None]
    valid = (jnp.abs(si - blk - qi) <= WINDOW)[None] & (kpos >= 0) & (kpos < length)
    s_win = jnp.where(valid[None, :, None, None], s_win, -jnp.inf)
    sink_b = jnp.broadcast_to(sink.reshape(1, 1, SWA_KV_HEADS, g, 1, 1).astype(jnp.float32), s_win.shape[:-1] + (1,))
    p = jax.nn.softmax(jnp.concatenate([sink_b, s_ctx, s_win], axis=-1), axis=-1).astype(v.dtype)
    n_ctx = k_ctx.shape[1]
    o = (jnp.einsum('bnhgqc,bchd->bnqhgd', p[..., 1:1 + n_ctx], v_ctx)
         + jnp.einsum('bnhgqs,bnshd->bnqhgd', p[..., 1 + n_ctx:], vw))
    return o.reshape(b_, length, SWA_HEADS * SWA_HD)


def even_project(u, w_in, wa2, ba):
    b_, length = u.shape[:2]
    q, k, v, g, a_f, a_b, sq, sk, sv = split_cols(u @ w_in, EVEN_SPLITS)
    heads = lambda t, h: t.reshape(b_, length, h, -1)
    la_f = gla_log_decay(a_f, wa2[0], ba[0])
    la_b = gla_log_decay(a_b, wa2[1], ba[1])
    return (heads(q * GLA_DK ** -0.5, GLA_HEADS), heads(k, GLA_HEADS), heads(v, GLA_HEADS), g,
            heads(la_f, GLA_HEADS), heads(la_b, GLA_HEADS),
            heads(sq, SWA_HEADS), heads(sk, SWA_KV_HEADS), heads(sv, SWA_KV_HEADS))


def even_mixer(ul, uc, w_in, wa2, ba, norm_g, sink, w_out, ang, need_ctx):
    cq, ck, cv, cg, claf, clab, csq, csk, csv = even_project(uc, w_in, wa2, ba)
    lq, lk, lv, lg, llaf, llab, lsq, lsk, lsv = even_project(ul, w_in, wa2, ba)
    zero = jnp.zeros((uc.shape[0], GLA_HEADS, GLA_DK, GLA_DV), jnp.float32)
    o_c, s_f, s_b = gla_bidir(cq, ck, cv, claf, clab, zero, zero)
    o_l, _, _ = gla_bidir(lq, lk, lv, llaf, llab, s_f, s_b)
    a_l = swa_latent(apply_rope(lsq, ang), apply_rope(lsk, ang), lsv, csk, csv, sink)
    y_l = jnp.concatenate([gla_output(o_l, lg, norm_g), a_l], axis=-1) @ w_out
    y_c = None
    if need_ctx:
        a_c = swa_context(csq, csk, csv, sink)
        y_c = jnp.concatenate([gla_output(o_c, cg, norm_g), a_c], axis=-1) @ w_out
    return y_l, y_c


def mla_project(u, w_in, q_norm, kv_norm, w_uq, w_ukv):
    b_, length = u.shape[:2]
    cq, ckv, k_rope = split_cols(u @ w_in, ODD_SPLITS)
    q = (rmsnorm(cq, q_norm) @ w_uq).reshape(b_, length, MLA_HEADS, MLA_NOPE + MLA_ROPE)
    kv = (rmsnorm(ckv, kv_norm) @ w_ukv).reshape(b_, length, MLA_HEADS, MLA_NOPE + MLA_V)
    return q[..., :MLA_NOPE], q[..., MLA_NOPE:], kv[..., :MLA_NOPE], kv[..., MLA_NOPE:], k_rope


def mla_scores(qn, qr, kn, kr):
    s = jnp.einsum('bqhd,bkhd->bhqk', qn, kn) + jnp.einsum('bqhr,bkr->bhqk', qr, kr)
    return s.astype(jnp.float32) * MLA_SCALE


def mla_context(qn, qr, kn, kr, v):
    p = jax.nn.softmax(mla_scores(qn, qr, kn, kr), axis=-1).astype(v.dtype)
    return jnp.einsum('bhqk,bkhd->bqhd', p, v)


def mla_latent(qn, qr, kn, kr, v, kn_c, kr_c, v_c):
    b_, length = qn.shape[:2]
    nb = length // MLA_BLOCK
    n_ctx = kn_c.shape[1]

    def blocks(t):
        return t.reshape((b_, nb, MLA_BLOCK) + t.shape[2:]).swapaxes(0, 1)

    def attend(args):
        qn_i, qr_i = args
        s = jnp.concatenate([mla_scores(qn_i, qr_i, kn_c, kr_c), mla_scores(qn_i, qr_i, kn, kr)], axis=-1)
        p = jax.nn.softmax(s, axis=-1).astype(v.dtype)
        return (jnp.einsum('bhqc,bchd->bqhd', p[..., :n_ctx], v_c)
                + jnp.einsum('bhqk,bkhd->bqhd', p[..., n_ctx:], v))

    o = lax.map(attend, (blocks(qn), blocks(qr)))
    return o.swapaxes(0, 1).reshape(b_, length, MLA_HEADS * MLA_V)


def odd_mixer(ul, uc, w_in, q_norm, kv_norm, w_uq, w_ukv, w_out, ang, need_ctx):
    b_, length = ul.shape[:2]
    lqn, lqr, lkn, lv, lkr = mla_project(ul, w_in, q_norm, kv_norm, w_uq, w_ukv)
    cqn, cqr, ckn, cv, ckr = mla_project(uc, w_in, q_norm, kv_norm, w_uq, w_ukv)
    o_l = mla_latent(lqn, apply_rope(lqr, ang), lkn, apply_rope(lkr, ang), lv, ckn, ckr, cv)
    y_l = o_l @ w_out
    y_c = None
    if need_ctx:
        y_c = mla_context(cqn, cqr, ckn, ckr, cv).reshape(uc.shape[0], uc.shape[1], -1) @ w_out
    return y_l, y_c


def route(h, w_router, b_corr):
    t = h.shape[0]
    scores = jax.nn.sigmoid(h.astype(jnp.float32) @ w_router.astype(jnp.float32))
    sel = scores + b_corr.astype(jnp.float32)
    grp = lax.top_k(sel.reshape(t, N_GROUPS, N_EXPERTS // N_GROUPS), 2)[0].sum(-1)
    _, gidx = lax.top_k(grp, TOPK_GROUPS)
    gmask = jax.nn.one_hot(gidx, N_GROUPS, dtype=jnp.float32).sum(1)
    emask = jnp.repeat(gmask, N_EXPERTS // N_GROUPS, axis=1) > 0
    _, idx = lax.top_k(jnp.where(emask, sel, -jnp.inf), TOP_K)
    w = jnp.take_along_axis(scores, idx, axis=1)
    w = w / jnp.sum(w, axis=-1, keepdims=True) * ROUTED_SCALE
    return idx, w


def moe(h, w_router, b_corr, w_g, w_u, w_d, ws_g, ws_u, ws_d):
    t, d = h.shape
    idx, wts = route(h, w_router, b_corr)
    n_assign = t * TOP_K
    flat_e = idx.reshape(-1)
    flat_t = jnp.repeat(jnp.arange(t, dtype=jnp.int32), TOP_K)
    flat_w = wts.reshape(-1)
    order = jnp.argsort(flat_e)
    se, st, sw = flat_e[order], flat_t[order], flat_w[order]
    counts = jnp.bincount(flat_e, length=N_EXPERTS)
    starts = jnp.cumsum(counts) - counts
    padded = (counts + MOE_BLOCK - 1) // MOE_BLOCK * MOE_BLOCK
    pad_end = jnp.cumsum(padded)
    pad_start = pad_end - padded
    dest = pad_start[se] + (jnp.arange(n_assign) - starts[se])
    n_blk = -(-n_assign // MOE_BLOCK) + N_EXPERTS
    buf_tok = jnp.zeros((n_blk * MOE_BLOCK,), jnp.int32).at[dest].set(st)
    buf_w = jnp.zeros((n_blk * MOE_BLOCK,), jnp.float32).at[dest].set(sw)
    blk_start = jnp.arange(n_blk, dtype=pad_end.dtype) * MOE_BLOCK
    blk_e = jnp.minimum(jnp.searchsorted(pad_end, blk_start, side='right'), N_EXPERTS - 1)

    def expert_block(args):
        tok, wt, e = args
        xb = h[tok]
        hid = jax.nn.silu(xb @ w_g[e]) * (xb @ w_u[e])
        return (hid @ w_d[e]) * wt[:, None].astype(h.dtype)

    yb = lax.map(expert_block, (buf_tok.reshape(n_blk, MOE_BLOCK), buf_w.reshape(n_blk, MOE_BLOCK), blk_e))
    routed = jnp.zeros_like(h).at[buf_tok].add(yb.reshape(-1, d))
    shared = (jax.nn.silu(h @ ws_g) * (h @ ws_u)) @ ws_d
    return shared + routed


def setup_inputs(seed: int = 0) -> dict:
    key = jax.random.key(seed)
    ks = jax.random.split(key, 30)
    d = D_MODEL

    def nrm(i, shape, scale):
        return jax.random.normal(ks[i], shape, jnp.float32) * scale

    return {
        'x': nrm(0, (BATCH, SEQ, d), 1.0),
        'c': nrm(1, (BATCH, d), 1.0),
        'ctx': nrm(2, (BATCH, CTX_LEN, d), 1.0),
        'c_ctx': nrm(3, (d,), 1.0),
        'w_mod': nrm(4, (DEPTH, d, 6 * d), 0.5 * d ** -0.5),
        'b_mod': nrm(5, (DEPTH, 6 * d), 0.02),
        'g_mix_pre': 1.0 + nrm(6, (DEPTH, d), 0.05),
        'g_mix_post': 1.0 + nrm(7, (DEPTH, d), 0.05),
        'g_ffn_pre': 1.0 + nrm(8, (DEPTH, d), 0.05),
        'g_ffn_post': 1.0 + nrm(9, (DEPTH, d), 0.05),
        'w_in_e': nrm(10, (N_EVEN, d, EVEN_IN), d ** -0.5),
        'gla_wa2': nrm(11, (N_EVEN, 2, GLA_RANK, GLA_HEADS * GLA_DK), GLA_RANK ** -0.5),
        'gla_ba': nrm(12, (N_EVEN, 2, GLA_HEADS * GLA_DK), 0.5),
        'gla_norm': 1.0 + nrm(13, (N_EVEN, GLA_DV), 0.05),
        'swa_sink': nrm(14, (N_EVEN, SWA_HEADS), 0.5),
        'w_out_e': nrm(15, (N_EVEN, EVEN_OUT, d), EVEN_OUT ** -0.5),
        'w_in_o': nrm(16, (N_ODD, d, ODD_IN), d ** -0.5),
        'mla_q_norm': 1.0 + nrm(17, (N_ODD, MLA_Q_RANK), 0.05),
        'mla_kv_norm': 1.0 + nrm(18, (N_ODD, MLA_KV_RANK), 0.05),
        'w_uq': nrm(19, (N_ODD, MLA_Q_RANK, MLA_HEADS * (MLA_NOPE + MLA_ROPE)), MLA_Q_RANK ** -0.5),
        'w_ukv': nrm(20, (N_ODD, MLA_KV_RANK, MLA_HEADS * (MLA_NOPE + MLA_V)), MLA_KV_RANK ** -0.5),
        'w_out_o': nrm(21, (N_ODD, ODD_OUT, d), ODD_OUT ** -0.5),
        'w_router': nrm(22, (DEPTH, d, N_EXPERTS), d ** -0.5),
        'b_router': nrm(23, (DEPTH, N_EXPERTS), 0.01),
        'w_exp_gate': nrm(24, (DEPTH, N_EXPERTS, d, D_EXPERT), d ** -0.5),
        'w_exp_up': nrm(25, (DEPTH, N_EXPERTS, d, D_EXPERT), d ** -0.5),
        'w_exp_down': nrm(26, (DEPTH, N_EXPERTS, D_EXPERT, d), D_EXPERT ** -0.5),
        'w_sh_gate': nrm(27, (DEPTH, d, D_SHARED), d ** -0.5),
        'w_sh_up': nrm(28, (DEPTH, d, D_SHARED), d ** -0.5),
        'w_sh_down': nrm(29, (DEPTH, D_SHARED, d), D_SHARED ** -0.5),
    }


def reference(x, c, ctx, c_ctx, w_mod, b_mod, g_mix_pre, g_mix_post, g_ffn_pre, g_ffn_post,
              w_in_e, gla_wa2, gla_ba, gla_norm, swa_sink, w_out_e,
              w_in_o, mla_q_norm, mla_kv_norm, w_uq, w_ukv, w_out_o,
              w_router, b_router, w_exp_gate, w_exp_up, w_exp_down, w_sh_gate, w_sh_up, w_sh_down):
    b_, seq_len, d = x.shape
    ang_swa = axial_rope_angles(seq_len, SWA_HD)
    ang_mla = axial_rope_angles(seq_len, MLA_ROPE)
    hl, hc = x, ctx
    for l in range(DEPTH):
        last = l == DEPTH - 1
        mod_l = (jax.nn.silu(c) @ w_mod[l] + b_mod[l])[:, None, :]
        mod_c = (jax.nn.silu(c_ctx) @ w_mod[l] + b_mod[l])[None, None, :]
        sh_a, sc_a, gt_a, sh_f, sc_f, gt_f = jnp.split(mod_l, 6, axis=-1)
        csh_a, csc_a, cgt_a, csh_f, csc_f, cgt_f = jnp.split(mod_c, 6, axis=-1)
        ul = modulate(hl, g_mix_pre[l], sh_a, sc_a)
        uc = modulate(hc, g_mix_pre[l], csh_a, csc_a)
        i = l // 2
        if l % 2 == 0:
            yl, yc = even_mixer(ul, uc, w_in_e[i], gla_wa2[i], gla_ba[i], gla_norm[i], swa_sink[i], w_out_e[i], ang_swa, not last)
        else:
            yl, yc = odd_mixer(ul, uc, w_in_o[i], mla_q_norm[i], mla_kv_norm[i], w_uq[i], w_ukv[i], w_out_o[i], ang_mla, not last)
        hl = hl + gt_a * rmsnorm(yl, g_mix_post[l])
        vl = modulate(hl, g_ffn_pre[l], sh_f, sc_f)
        moe_w = (w_router[l], b_router[l], w_exp_gate[l], w_exp_up[l], w_exp_down[l], w_sh_gate[l], w_sh_up[l], w_sh_down[l])
        if last:
            fl = moe(vl.reshape(-1, d), *moe_w).reshape(b_, seq_len, d)
        else:
            hc = hc + cgt_a * rmsnorm(yc, g_mix_post[l])
            vc = modulate(hc, g_ffn_pre[l], csh_f, csc_f)
            n_c = vc.shape[0] * vc.shape[1]
            f = moe(jnp.concatenate([vc.reshape(-1, d), vl.reshape(-1, d)], axis=0), *moe_w)
            hc = hc + cgt_f * rmsnorm(f[:n_c].reshape(hc.shape), g_ffn_post[l])
            fl = f[n_c:].reshape(b_, seq_len, d)
        hl = hl + gt_f * rmsnorm(fl, g_ffn_post[l])
    return hl
```

```cpp
#include <hip/hip_runtime.h>
#include <hip/hip_cooperative_groups.h>
#include <cstdio>
#include <cstdint>
namespace cg = cooperative_groups;

#define LAS __attribute__((address_space(3)))
typedef unsigned short bf16;
typedef short bf16x8 __attribute__((ext_vector_type(8)));
typedef float f32x2 __attribute__((ext_vector_type(2)));
typedef float f32x4 __attribute__((ext_vector_type(4)));
typedef float f32x8 __attribute__((ext_vector_type(8)));
typedef float f32x16 __attribute__((ext_vector_type(16)));
typedef unsigned u32x2 __attribute__((ext_vector_type(2)));
typedef unsigned u32x4 __attribute__((ext_vector_type(4)));
typedef __bf16 bf16x2_t __attribute__((ext_vector_type(2)));

constexpr int DM = 1024, NB = 2, SEQ = 8192, CTX = 256;
constexpr int TC = NB * CTX, TL = NB * SEQ, TT = TC + TL, NKEY = CTX + SEQ;
constexpr int NEXP = 64;
constexpr float RMS_EPS = 1e-6f;
constexpr int E_IN_PAD = 2432, O_IN_PAD = 896;
constexpr float LOG2E = 1.4426950408889634f;
constexpr int NSTEP = 132;
constexpr int Z0P = 1056;
constexpr int Z1P = 768;
constexpr int LDS_BYTES = 65536;

constexpr size_t al(size_t x) { return (x + 255) & ~(size_t)255; }
constexpr size_t OFF_W_IN_E = 0;
constexpr size_t OFF_W_OUT_E = OFF_W_IN_E + al((size_t)E_IN_PAD * DM * 2);
constexpr size_t OFF_W_IN_O = OFF_W_OUT_E + al((size_t)DM * DM * 2);
constexpr size_t OFF_W_UQ = OFF_W_IN_O + al((size_t)O_IN_PAD * DM * 2);
constexpr size_t OFF_W_UKV = OFF_W_UQ + al((size_t)1536 * 512 * 2);
constexpr size_t OFF_W_OUT_O = OFF_W_UKV + al((size_t)2048 * 256 * 2);
constexpr size_t OFF_W_RT = OFF_W_OUT_O + al((size_t)DM * DM * 2);
constexpr size_t OFF_W_GU = OFF_W_RT + al((size_t)2 * 128 * DM * 2);
constexpr size_t OFF_W_D = OFF_W_GU + al((size_t)65 * 512 * DM * 2);
constexpr size_t OFF_U = OFF_W_D + al((size_t)65 * DM * 256 * 2);
constexpr size_t OFF_HC = OFF_U + al((size_t)TT * DM * 2);
constexpr size_t OFF_MOD = OFF_HC + al((size_t)TC * DM * 4);
constexpr size_t OFF_ROPE = OFF_MOD + al((size_t)2 * 3 * 6144 * 4);
constexpr size_t OFF_CNT = OFF_ROPE + al((size_t)SEQ * 32 * 8);
constexpr size_t OFF_TOKSLOT = OFF_CNT + al(2 * 64 * 4);
constexpr size_t OFF_W8 = OFF_TOKSLOT + al((size_t)TT * 8 * 4);
constexpr size_t OFF_LIST = OFF_W8 + al((size_t)TT * 8 * 4);
constexpr size_t OFF_ARENA = OFF_LIST + al((size_t)64 * TT * 4);
constexpr size_t A0_Z0 = OFF_ARENA;
constexpr size_t A0_VGT = A0_Z0 + al((size_t)TT * Z0P * 2);
constexpr size_t A0_QS = A0_VGT + al((size_t)4 * 128 * TT * 2);
constexpr size_t A0_KS = A0_QS + al((size_t)2 * 8 * NKEY * 64 * 2);
constexpr size_t A0_VST = A0_KS + al((size_t)2 * 2 * NKEY * 64 * 2);
constexpr size_t A0_GS = A0_VST + al((size_t)2 * 2 * 64 * NKEY * 2);
constexpr size_t A0_GD = A0_GS + al((size_t)16 * NSTEP * 8192 * 4);
constexpr size_t A0_MIX = A0_GD + al((size_t)16 * NSTEP * 64 * 4);
constexpr size_t A0_Y = A0_MIX + al((size_t)TT * DM * 2);
constexpr size_t A0_END = A0_Y + al((size_t)TT * DM * 4);
constexpr size_t A1_Z1 = OFF_ARENA;
constexpr size_t A1_QM = A1_Z1 + al((size_t)TT * Z1P * 2);
constexpr size_t A1_KM = A1_QM + al((size_t)2 * 8 * SEQ * 192 * 2);
constexpr size_t A1_VTM = A1_KM + al((size_t)2 * 8 * NKEY * 192 * 2);
constexpr size_t A1_MIX = A1_VTM + al((size_t)2 * 8 * 128 * NKEY * 2);
constexpr size_t A1_Y = A1_MIX + al((size_t)TT * DM * 2);
constexpr size_t A1_END = A1_Y + al((size_t)TT * DM * 4);
constexpr size_t AM_HM = OFF_ARENA;
constexpr size_t AM_YR = AM_HM + al((size_t)TT * 9 * 256 * 2);
constexpr size_t AM_END = AM_YR + al((size_t)TT * 9 * 1024 * 2);
constexpr size_t WS_NEED = AM_END > A0_END ? (AM_END > A1_END ? AM_END : A1_END) : (A0_END > A1_END ? A0_END : A1_END);
static_assert(WS_NEED <= 555747360ull, "workspace map exceeds the guaranteed d_ws size");

struct Params {
    const float *x, *c, *ctx, *c_ctx, *w_mod, *b_mod, *g_mix_pre, *g_mix_post, *g_ffn_pre, *g_ffn_post;
    const float *w_in_e, *gla_wa2, *gla_ba, *gla_norm, *swa_sink, *w_out_e;
    const float *w_in_o, *mla_q_norm, *mla_kv_norm, *w_uq, *w_ukv, *w_out_o;
    const float *w_router, *b_router, *w_exp_gate, *w_exp_up, *w_exp_down, *w_sh_gate, *w_sh_up, *w_sh_down;
    float* out; unsigned char* ws; int ph_lo, ph_hi;
};

__device__ __forceinline__ unsigned pk2(float lo, float hi) { f32x2 v = {lo, hi}; bf16x2_t b = __builtin_convertvector(v, bf16x2_t); return __builtin_bit_cast(unsigned, b); }
__device__ __forceinline__ float bflo(unsigned u) { return __uint_as_float(u << 16); }
__device__ __forceinline__ float bfhi(unsigned u) { return __uint_as_float(u & 0xffff0000u); }
__device__ __forceinline__ float bf2f(bf16 v) { return __uint_as_float((unsigned)v << 16); }
__device__ __forceinline__ bf16 f2bf(float f) { return (bf16)(pk2(f, 0.f) & 0xffffu); }
__device__ __forceinline__ float wave_sum(float v) {
#pragma unroll
    for (int o = 1; o < 64; o <<= 1) v += __shfl_xor(v, o);
    return v;
}
__device__ __forceinline__ void glds16(const void* g, LAS void* l) { __builtin_amdgcn_global_load_lds((const unsigned*)g, (LAS unsigned*)l, 16, 0, 0); }
__device__ __forceinline__ float siluf(float x) { return x / (1.f + __expf(-x)); }
__device__ __forceinline__ float ex2(float x) { return __builtin_amdgcn_exp2f(x); }
__device__ __forceinline__ int crow(int r, int hi) { return (r & 3) + 8 * (r >> 2) + 4 * hi; }
__device__ __forceinline__ bf16x8 mk8(u32x4 v) { return __builtin_bit_cast(bf16x8, v); }

struct RowInfo { int b, kq, pos; bool lat; };
__device__ __forceinline__ RowInfo rowinfo(int r) {
    RowInfo i;
    if (r < TC) { i.b = r >> 8; i.pos = r & 255; i.kq = i.pos; i.lat = false; }
    else { const int rl = r - TC; i.b = rl >> 13; i.pos = rl & (SEQ - 1); i.kq = CTX + i.pos; i.lat = true; }
    return i;
}
__device__ __forceinline__ int modvec(int r) { return r < TC ? 2 : ((r - TC) >> 13); }

__device__ __forceinline__ void gemm_core(LAS unsigned char* lds, const bf16* a0, const bf16* a1, const bf16* b0, const bf16* b1, int nk, f32x4 (&acc)[4][4]) {
    const int tid = threadIdx.x, lane = tid & 63, wid = tid >> 6, wr = wid >> 1, wc = wid & 1, fr = lane & 15, fq = lane >> 4;
#pragma unroll
    for (int m = 0; m < 4; ++m)
#pragma unroll
        for (int n = 0; n < 4; ++n) acc[m][n] = (f32x4){0.f, 0.f, 0.f, 0.f};
    {
        LAS unsigned char* d = lds + tid * 16;
        glds16(a0, d); glds16(a1, d + 4096); glds16(b0, d + 8192); glds16(b1, d + 12288);
    }
    const int aoff = (wr * 64 + fr) * 64 + fq * 16, boff = 8192 + (wc * 64 + fr) * 64 + fq * 16;
    for (int kt = 0; kt < nk; ++kt) {
        const int s = kt & 1;
        asm volatile("s_waitcnt vmcnt(0)" ::: "memory");
        __syncthreads();
        if (kt + 1 < nk) {
            LAS unsigned char* d = lds + (s ^ 1) * 16384 + tid * 16;
            const int ko = (kt + 1) * 32;
            glds16(a0 + ko, d); glds16(a1 + ko, d + 4096); glds16(b0 + ko, d + 8192); glds16(b1 + ko, d + 12288);
        }
        bf16x8 af[4], bfr[4];
        LAS unsigned char* base = lds + s * 16384;
#pragma unroll
        for (int m = 0; m < 4; ++m) af[m] = *(const LAS bf16x8*)(base + aoff + m * 1024);
#pragma unroll
        for (int n = 0; n < 4; ++n) bfr[n] = *(const LAS bf16x8*)(base + boff + n * 1024);
#pragma unroll
        for (int m = 0; m < 4; ++m)
#pragma unroll
            for (int n = 0; n < 4; ++n) acc[m][n] = __builtin_amdgcn_mfma_f32_16x16x32_bf16(bfr[n], af[m], acc[m][n], 0, 0, 0);
    }
    __syncthreads();
}

__device__ __forceinline__ int ein_map(int n) {
    if (n < 512) return n;
    if (n < 1024) return n + 512;
    if (n < 1536) return n - 512;
    if (n < 2048) return 1568 + (n - 1536);
    if (n < 2176) return 2080 + (n - 2048);
    if (n < 2304) return 2208 + (n - 2176);
    if (n < 2320) return 1536 + (n - 2304);
    if (n < 2336) return 1552 + (n - 2320);
    return -1;
}
__device__ __forceinline__ void transpose_item(LAS unsigned char* lds, int K, bf16* dst, int k0, int n0, int ld, int mode, const float* srcA, const float* srcB, int nvalid, const float* kscale) {
    LAS float* tile = (LAS float*)lds;
    const int tid = threadIdx.x;
    {
        const int nl = tid & 63, kq = tid >> 6, n = n0 + nl;
        const float* cp = nullptr; float sc = 1.f;
        if (mode == 0) { if (n < nvalid) cp = srcA + n; }
        else if (mode == 1) { const int c = ein_map(n); if (c >= 0) cp = srcA + c; if (n < 256) sc = 0.125f; }
        else { const int grp = n >> 6, w = n & 63; cp = (w < 32 ? srcA : srcB) + grp * 32 + (w & 31); }
#pragma unroll 4
        for (int kk = 0; kk < 16; ++kk) {
            const int k = kq * 16 + kk;
            float v = 0.f;
            if (cp) { v = cp[(size_t)(k0 + k) * ld] * sc; if (kscale) v *= kscale[k0 + k]; }
            tile[k * 65 + nl] = v;
        }
    }
    __syncthreads();
    {
        const int n = tid >> 2, kc = tid & 3;
#pragma unroll
        for (int h = 0; h < 2; ++h) {
            const int k8 = kc * 16 + h * 8;
            u32x4 o;
            o.x = pk2(tile[(k8 + 0) * 65 + n], tile[(k8 + 1) * 65 + n]);
            o.y = pk2(tile[(k8 + 2) * 65 + n], tile[(k8 + 3) * 65 + n]);
            o.z = pk2(tile[(k8 + 4) * 65 + n], tile[(k8 + 5) * 65 + n]);
            o.w = pk2(tile[(k8 + 6) * 65 + n], tile[(k8 + 7) * 65 + n]);
            *(u32x4*)(dst + (size_t)(n0 + n) * K + k0 + k8) = o;
        }
    }
    __syncthreads();
}

constexpr int EXP_GU_ITEMS = 65 * 16 * 8, EXP_D_ITEMS = 65 * 4 * 16, EXP_ITEMS = EXP_GU_ITEMS + EXP_D_ITEMS;
__device__ __forceinline__ void expert_convert_item(const Params& p, LAS unsigned char* lds, int l, int it) {
    unsigned char* ws = p.ws;
    if (it < EXP_GU_ITEMS) {
        const int e = it / 128, r = it % 128, kb = r / 8, nb = r % 8;
        const float* gate = e < 64 ? p.w_exp_gate + ((size_t)(l * 64 + e)) * DM * 256 : p.w_sh_gate + (size_t)l * DM * 256;
        const float* up = e < 64 ? p.w_exp_up + ((size_t)(l * 64 + e)) * DM * 256 : p.w_sh_up + (size_t)l * DM * 256;
        transpose_item(lds, DM, (bf16*)(ws + OFF_W_GU) + (size_t)e * 512 * DM, kb * 64, nb * 64, 256, 2, gate, up, 512, nullptr);
    } else {
        it -= EXP_GU_ITEMS;
        const int e = it / 64, r = it % 64, kb = r / 16, nb = r % 16;
        const float* dn = e < 64 ? p.w_exp_down + ((size_t)(l * 64 + e)) * 256 * DM : p.w_sh_down + (size_t)l * 256 * DM;
        transpose_item(lds, 256, (bf16*)(ws + OFF_W_D) + (size_t)e * DM * 256, kb * 64, nb * 64, DM, 0, dn, nullptr, DM, nullptr);
    }
}

__device__ __forceinline__ void ph_prep(const Params& p, LAS unsigned char* lds) {
    unsigned char* ws = p.ws;
    const int tid = threadIdx.x;
    if (blockIdx.x == 0 && tid < 128) ((int*)(ws + OFF_CNT))[tid] = 0;
    constexpr int I_MOD = 48, I_ROPE = 1024, I_INE = 16 * 38, I_OUTE = 256, I_INO = 16 * 14, I_UQ = 8 * 24, I_UKV = 4 * 32, I_OUTO = 256, I_RT = 64;
    constexpr int NITEMS = I_MOD + I_ROPE + I_INE + I_OUTE + I_INO + I_UQ + I_UKV + I_OUTO + I_RT + EXP_ITEMS;
    for (int item = blockIdx.x; item < NITEMS; item += gridDim.x) {
        int it = item;
        if (it < I_MOD) {
            const int l = it / 24, n = (it % 24) * 256 + tid;
            LAS float* s = (LAS float*)lds;
            for (int idx = tid; idx < 3072; idx += 256) { const int v = idx >> 10, k = idx & 1023; const float cv = v < 2 ? p.c[v * DM + k] : p.c_ctx[k]; s[idx] = cv / (1.f + expf(-cv)); }
            __syncthreads();
            float a0 = 0.f, a1 = 0.f, a2 = 0.f;
            const float* w = p.w_mod + (size_t)l * DM * 6144 + n;
#pragma unroll 8
            for (int k = 0; k < DM; ++k) { const float wv = w[(size_t)k * 6144]; a0 += s[k] * wv; a1 += s[1024 + k] * wv; a2 += s[2048 + k] * wv; }
            float* mod = (float*)(ws + OFF_MOD) + (size_t)l * 3 * 6144;
            const float bb = p.b_mod[l * 6144 + n];
            mod[n] = a0 + bb; mod[6144 + n] = a1 + bb; mod[2 * 6144 + n] = a2 + bb;
            __syncthreads();
            continue;
        }
        it -= I_MOD;
        if (it < I_ROPE) {
            const int idx = it * 256 + tid, pos = idx >> 5, i = idx & 31, row = pos >> 6, col = pos & 63, j = i & 15;
            const float invf = powf(10000.f, -(float)(2 * j) / 32.f);
            const float ang = (float)(i < 16 ? row : col) * invf;
            float sn, cs; sincosf(ang, &sn, &cs);
            ((f32x2*)(ws + OFF_ROPE))[idx] = (f32x2){cs, sn};
            continue;
        }
        it -= I_ROPE;
        if (it < I_INE) { const int kb = it / 38, nb = it % 38;
            transpose_item(lds, DM, (bf16*)(ws + OFF_W_IN_E), kb * 64, nb * 64, 2336, 1, p.w_in_e, nullptr, 2336, nullptr); continue; }
        it -= I_INE;
        if (it < I_OUTE) { const int kb = it / 16, nb = it % 16;
            transpose_item(lds, DM, (bf16*)(ws + OFF_W_OUT_E), kb * 64, nb * 64, DM, 0, p.w_out_e, nullptr, DM, nullptr); continue; }
        it -= I_OUTE;
        if (it < I_INO) { const int kb = it / 14, nb = it % 14;
            transpose_item(lds, DM, (bf16*)(ws + OFF_W_IN_O), kb * 64, nb * 64, 832, 0, p.w_in_o, nullptr, 832, nullptr); continue; }
        it -= I_INO;
        if (it < I_UQ) { const int kb = it / 24, nb = it % 24;
            transpose_item(lds, 512, (bf16*)(ws + OFF_W_UQ), kb * 64, nb * 64, 1536, 0, p.w_uq, nullptr, 1536, p.mla_q_norm); continue; }
        it -= I_UQ;
        if (it < I_UKV) { const int kb = it / 32, nb = it % 32;
            transpose_item(lds, 256, (bf16*)(ws + OFF_W_UKV), kb * 64, nb * 64, 2048, 0, p.w_ukv, nullptr, 2048, p.mla_kv_norm); continue; }
        it -= I_UKV;
        if (it < I_OUTO) { const int kb = it / 16, nb = it % 16;
            transpose_item(lds, DM, (bf16*)(ws + OFF_W_OUT_O), kb * 64, nb * 64, DM, 0, p.w_out_o, nullptr, DM, nullptr); continue; }
        it -= I_OUTO;
        if (it < I_RT) { const int l = it / 32, r = it % 32, kb = r / 2, nb = r % 2;
            transpose_item(lds, DM, (bf16*)(ws + OFF_W_RT) + (size_t)l * 128 * DM, kb * 64, nb * 64, 64, 0, p.w_router + (size_t)l * DM * 64, nullptr, 64, nullptr); continue; }
        it -= I_RT;
        expert_convert_item(p, lds, 0, it);
    }
}

__device__ __forceinline__ void load_row(const float* src, int lane, f32x4 (&v)[4]) {
#pragma unroll
    for (int j = 0; j < 4; ++j) v[j] = *(const f32x4*)(src + lane * 4 + 256 * j);
}
__device__ __forceinline__ float row_sumsq(const f32x4 (&v)[4]) {
    float s = 0.f;
#pragma unroll
    for (int j = 0; j < 4; ++j) s += v[j].x * v[j].x + v[j].y * v[j].y + v[j].z * v[j].z + v[j].w * v[j].w;
    return wave_sum(s);
}
__device__ __forceinline__ void modulate_store(const f32x4 (&v)[4], float rinv, const float* g, const float* sh, const float* sc, bf16* dst, int lane) {
#pragma unroll
    for (int j = 0; j < 4; ++j) {
        const int c = lane * 4 + 256 * j;
        const f32x4 gg = *(const f32x4*)(g + c), s1 = *(const f32x4*)(sc + c), s0 = *(const f32x4*)(sh + c);
        const f32x4 o = v[j] * rinv * gg * (s1 + 1.f) + s0;
        u32x2 w; w.x = pk2(o.x, o.y); w.y = pk2(o.z, o.w);
        *(u32x2*)(dst + c) = w;
    }
}
__device__ __forceinline__ const float* hl_src0(const Params& p, int r) { return r < TC ? p.ctx + (size_t)r * DM : p.x + (size_t)(r - TC) * DM; }
__device__ __forceinline__ float* hl_buf(const Params& p, int r) { return r < TC ? (float*)(p.ws + OFF_HC) + (size_t)r * DM : p.out + (size_t)(r - TC) * DM; }

__device__ __forceinline__ void ph_modulate0(const Params& p) {
    const int lane = threadIdx.x & 63, gw = blockIdx.x * 4 + (threadIdx.x >> 6), ngw = gridDim.x * 4;
    const float* mod = (const float*)(p.ws + OFF_MOD);
    bf16* U = (bf16*)(p.ws + OFF_U);
    for (int r = gw; r < TT; r += ngw) {
        f32x4 v[4]; load_row(hl_src0(p, r), lane, v);
        const float rinv = rsqrtf(row_sumsq(v) * (1.f / DM) + RMS_EPS);
        const float* mv = mod + (size_t)modvec(r) * 6144;
        modulate_store(v, rinv, p.g_mix_pre, mv, mv + 1024, U + (size_t)r * DM, lane);
    }
}

__device__ __forceinline__ void ph_rowpassA(const Params& p, int l, int row_lo, const float* Y) {
    const int lane = threadIdx.x & 63, gw = blockIdx.x * 4 + (threadIdx.x >> 6), ngw = gridDim.x * 4;
    const float* mod = (const float*)(p.ws + OFF_MOD) + (size_t)l * 3 * 6144;
    bf16* U = (bf16*)(p.ws + OFF_U);
    for (int r = row_lo + gw; r < TT; r += ngw) {
        f32x4 y[4], h[4];
        load_row(Y + (size_t)r * DM, lane, y);
        load_row(l == 0 ? hl_src0(p, r) : (const float*)hl_buf(p, r), lane, h);
        const float rinv = rsqrtf(row_sumsq(y) * (1.f / DM) + RMS_EPS);
        const float* mv = mod + (size_t)modvec(r) * 6144;
        float* hb = hl_buf(p, r);
#pragma unroll
        for (int j = 0; j < 4; ++j) {
            const int c = lane * 4 + 256 * j;
            const f32x4 gg = *(const f32x4*)(p.g_mix_post + l * DM + c), gt = *(const f32x4*)(mv + 2048 + c);
            h[j] = h[j] + gt * (y[j] * rinv * gg);
            *(f32x4*)(hb + c) = h[j];
        }
        const float rinv2 = rsqrtf(row_sumsq(h) * (1.f / DM) + RMS_EPS);
        modulate_store(h, rinv2, p.g_ffn_pre + l * DM, mv + 3072, mv + 4096, U + (size_t)r * DM, lane);
    }
}

constexpr int MOE_LDS_OFF = 40960;
__device__ __forceinline__ void moe_tables(const Params& p, LAS unsigned char* lds, int l, int row_lo) {
    LAS int* cnt = (LAS int*)(lds + MOE_LDS_OFF); LAS int* tp = cnt + 80; LAS int* sp = tp + 80;
    const int tid = threadIdx.x;
    if (tid < 64) cnt[tid] = ((const int*)(p.ws + OFF_CNT))[l * 64 + tid];
    if (tid == 64) cnt[64] = TT - row_lo;
    __syncthreads();
    if (tid == 0) {
        int a = 0, s = 0;
        for (int e = 0; e < 65; ++e) { tp[e] = a; sp[e] = s; a += (cnt[e] + 127) >> 7; s += cnt[e]; }
        tp[65] = a;
    }
    __syncthreads();
}

__device__ __forceinline__ void ph_rowpassB(const Params& p, LAS unsigned char* lds, int l, int row_lo) {
    moe_tables(p, lds, l, row_lo);
    LAS int* sp = (LAS int*)(lds + MOE_LDS_OFF) + 160;
    const int lane = threadIdx.x & 63, gw = blockIdx.x * 4 + (threadIdx.x >> 6), ngw = gridDim.x * 4;
    const float* mod = (const float*)(p.ws + OFF_MOD) + (size_t)l * 3 * 6144;
    const bf16* YR = (const bf16*)(p.ws + AM_YR);
    const int* tokslot = (const int*)(p.ws + OFF_TOKSLOT);
    bf16* U = (bf16*)(p.ws + OFF_U);
    for (int r = row_lo + gw; r < TT; r += ngw) {
        f32x4 f[4];
#pragma unroll
        for (int j = 0; j < 4; ++j) f[j] = (f32x4){0.f, 0.f, 0.f, 0.f};
#pragma unroll
        for (int k = 0; k < 9; ++k) {
            size_t slot;
            if (k < 8) { const int ts = tokslot[(size_t)r * 8 + k]; slot = (size_t)(sp[ts >> 20] + (ts & 0xfffff)); }
            else slot = (size_t)TT * 8 + r;
            const bf16* yr = YR + slot * DM;
#pragma unroll
            for (int j = 0; j < 4; ++j) {
                const u32x2 w = *(const u32x2*)(yr + lane * 4 + 256 * j);
                f[j].x += bflo(w.x); f[j].y += bfhi(w.x); f[j].z += bflo(w.y); f[j].w += bfhi(w.y);
            }
        }
        const float rinv = rsqrtf(row_sumsq(f) * (1.f / DM) + RMS_EPS);
        const float* mv = mod + (size_t)modvec(r) * 6144;
        float* hb = hl_buf(p, r);
        f32x4 h[4]; load_row(hb, lane, h);
#pragma unroll
        for (int j = 0; j < 4; ++j) {
            const int c = lane * 4 + 256 * j;
            const f32x4 gg = *(const f32x4*)(p.g_ffn_post + l * DM + c), gt = *(const f32x4*)(mv + 5120 + c);
            h[j] = h[j] + gt * (f[j] * rinv * gg);
            *(f32x4*)(hb + c) = h[j];
        }
        if (l == 0) {
            const float rinv2 = rsqrtf(row_sumsq(h) * (1.f / DM) + RMS_EPS);
            const float* mv1 = mv + 3 * 6144;
            modulate_store(h, rinv2, p.g_mix_pre + DM, mv1, mv1 + 1024, U + (size_t)r * DM, lane);
        }
    }
}

__device__ __forceinline__ void plain_ptrs(const bf16* base, int row0, int ld, const bf16*& p0, const bf16*& p1) {
    const int tid = threadIdx.x;
    p0 = base + (size_t)(row0 + (tid >> 2)) * ld + (tid & 3) * 8;
    p1 = p0 + (size_t)64 * ld;
}

__device__ __forceinline__ void ph_inproj0(const Params& p, LAS unsigned char* lds) {
    unsigned char* ws = p.ws;
    const bf16* U = (const bf16*)(ws + OFF_U); const bf16* W = (const bf16*)(ws + OFF_W_IN_E);
    bf16* Z0 = (bf16*)(ws + A0_Z0); bf16* VGT = (bf16*)(ws + A0_VGT); bf16* QS = (bf16*)(ws + A0_QS); bf16* KS = (bf16*)(ws + A0_KS); bf16* VST = (bf16*)(ws + A0_VST);
    const f32x2* rope = (const f32x2*)(ws + OFF_ROPE);
    const int tid = threadIdx.x, lane = tid & 63, wid = tid >> 6, wr = wid >> 1, wc = wid & 1, fr = lane & 15, fq = lane >> 4;
    constexpr int NTN = 19, NTM = TT / 128;
    for (int t = blockIdx.x; t < NTM * NTN; t += gridDim.x) {
        const int tm = t / NTN, tn = t % NTN, brow = tm * 128, bcol = tn * 128;
        const bf16 *a0, *a1, *b0, *b1; plain_ptrs(U, brow, DM, a0, a1); plain_ptrs(W, bcol, DM, b0, b1);
        f32x4 acc[4][4];
        gemm_core(lds, a0, a1, b0, b1, DM / 32, acc);
        const int cb = bcol + wc * 64;
#pragma unroll
        for (int m = 0; m < 4; ++m) {
            const int r = brow + wr * 64 + m * 16 + fr;
            const RowInfo ri = rowinfo(r);
            if (cb < 1024) {
#pragma unroll
                for (int n = 0; n < 4; ++n) { u32x2 w; w.x = pk2(acc[m][n][0], acc[m][n][1]); w.y = pk2(acc[m][n][2], acc[m][n][3]); *(u32x2*)(Z0 + (size_t)r * Z0P + cb + n * 16 + fq * 4) = w; }
            } else if (cb < 1536) {
                const int c0 = cb - 1024;
#pragma unroll
                for (int n = 0; n < 4; ++n)
#pragma unroll
                    for (int j = 0; j < 4; ++j) VGT[(size_t)(c0 + n * 16 + fq * 4 + j) * TT + r] = f2bf(acc[m][n][j]);
            } else if (cb < 2176) {
                f32x4 o[4];
#pragma unroll
                for (int n = 0; n < 2; ++n) {
#pragma unroll
                    for (int j = 0; j < 4; ++j) {
                        const float x1 = acc[m][n][j], x2 = acc[m][n + 2][j];
                        if (ri.lat) { const f32x2 cs = rope[(size_t)ri.pos * 32 + n * 16 + fq * 4 + j]; o[n][j] = x1 * cs.x - x2 * cs.y; o[n + 2][j] = x2 * cs.x + x1 * cs.y; }
                        else { o[n][j] = x1; o[n + 2][j] = x2; }
                    }
                }
                bf16* dst; float sc;
                if (cb < 2048) { const int h = (cb - 1536) >> 6; dst = QS + ((size_t)(ri.b * 8 + h) * NKEY + ri.kq) * 64; sc = 0.125f * LOG2E; }
                else { const int h = (cb - 2048) >> 6; dst = KS + ((size_t)(ri.b * 2 + h) * NKEY + ri.kq) * 64; sc = 1.f; }
#pragma unroll
                for (int n = 0; n < 4; ++n) { u32x2 w; w.x = pk2(o[n][0] * sc, o[n][1] * sc); w.y = pk2(o[n][2] * sc, o[n][3] * sc); *(u32x2*)(dst + n * 16 + fq * 4) = w; }
            } else if (cb < 2304) {
                const int h = (cb - 2176) >> 6;
                bf16* dst = VST + (size_t)(ri.b * 2 + h) * 64 * NKEY + ri.kq;
#pragma unroll
                for (int n = 0; n < 4; ++n)
#pragma unroll
                    for (int j = 0; j < 4; ++j) dst[(size_t)(n * 16 + fq * 4 + j) * NKEY] = f2bf(acc[m][n][j]);
            } else if (cb == 2304) {
#pragma unroll
                for (int n = 0; n < 2; ++n) { u32x2 w; w.x = pk2(acc[m][n][0], acc[m][n][1]); w.y = pk2(acc[m][n][2], acc[m][n][3]); *(u32x2*)(Z0 + (size_t)r * Z0P + 1024 + n * 16 + fq * 4) = w; }
            }
        }
    }
}

__device__ __forceinline__ void ph_outproj(const Params& p, LAS unsigned char* lds, const bf16* MIX, const bf16* W, float* Y, int row_lo) {
    const int tid = threadIdx.x, lane = tid & 63, wid = tid >> 6, wr = wid >> 1, wc = wid & 1, fr = lane & 15, fq = lane >> 4;
    const int tm0 = row_lo / 128, ntm = TT / 128 - tm0;
    for (int t = blockIdx.x; t < ntm * 8; t += gridDim.x) {
        const int tm = tm0 + t / 8, tn = t % 8, brow = tm * 128, bcol = tn * 128;
        const bf16 *a0, *a1, *b0, *b1; plain_ptrs(MIX, brow, DM, a0, a1); plain_ptrs(W, bcol, DM, b0, b1);
        f32x4 acc[4][4];
        gemm_core(lds, a0, a1, b0, b1, DM / 32, acc);
#pragma unroll
        for (int m = 0; m < 4; ++m) {
            const int r = brow + wr * 64 + m * 16 + fr;
#pragma unroll
            for (int n = 0; n < 4; ++n) *(f32x4*)(Y + (size_t)r * DM + bcol + wc * 64 + n * 16 + fq * 4) = acc[m][n];
        }
    }
}

template <int DQK, int DV>
__device__ __forceinline__ void attn_item(LAS unsigned char* lds, const bf16* Qg, const bf16* Kg, const bf16* VTg, int a1, int b0, int b1, int qpos0,
                                          float m_init, float l_init, bf16* Og, int o_pitch) {
    constexpr int KP = (DQK + 8) * 2, VP = 136, NS = DQK / 16, NDV = DV / 32, KCH = DQK / 8;
    const int tid = threadIdx.x, lane = tid & 63, wid = tid >> 6, ql = lane & 31, hi = lane >> 5;
    bf16x8 qf[NS];
    {
        const bf16* qrow = Qg + (size_t)(wid * 32 + ql) * DQK + hi * 8;
#pragma unroll
        for (int s = 0; s < NS; ++s) qf[s] = *(const bf16x8*)(qrow + s * 16);
    }
    f32x16 o[NDV];
#pragma unroll
    for (int d = 0; d < NDV; ++d)
#pragma unroll
        for (int r = 0; r < 16; ++r) o[d][r] = 0.f;
    float mrun = m_init, lrun = l_init;
    const int ntot = a1 + (b1 - b0);
    LAS unsigned char* Ks = lds; LAS unsigned char* Vs = lds + 64 * KP;
    for (int it = 0; it < ntot; ++it) {
        const int kt = it < a1 ? it : b0 + (it - a1);
        const bool masked = it >= a1;
        __syncthreads();
        for (int c = tid; c < 64 * KCH; c += 256) {
            const int key = c / KCH, ch = c % KCH;
            const u32x4 v = *(const u32x4*)(Kg + (size_t)(kt * 64 + key) * DQK + ch * 8);
            *(LAS u32x4*)(Ks + key * KP + ch * 16) = v;
        }
        for (int c = tid; c < DV * 8; c += 256) {
            const int dv = c >> 3, ch = c & 7;
            const u32x4 v = *(const u32x4*)(VTg + (size_t)dv * NKEY + kt * 64 + ch * 8);
            LAS u32x2* d = (LAS u32x2*)(Vs + dv * VP + ch * 16);
            d[0] = (u32x2){v.x, v.y}; d[1] = (u32x2){v.z, v.w};
        }
        __syncthreads();
        f32x16 p0, p1;
#pragma unroll
        for (int r = 0; r < 16; ++r) { p0[r] = 0.f; p1[r] = 0.f; }
#pragma unroll
        for (int s = 0; s < NS; ++s) {
            const bf16x8 k0 = *(const LAS bf16x8*)(Ks + ql * KP + (s * 16 + hi * 8) * 2);
            const bf16x8 k1 = *(const LAS bf16x8*)(Ks + (32 + ql) * KP + (s * 16 + hi * 8) * 2);
            p0 = __builtin_amdgcn_mfma_f32_32x32x16_bf16(k0, qf[s], p0, 0, 0, 0);
            p1 = __builtin_amdgcn_mfma_f32_32x32x16_bf16(k1, qf[s], p1, 0, 0, 0);
        }
        if (masked) {
            const int kbase = kt * 64 - CTX, qpos = qpos0 + wid * 32 + ql;
#pragma unroll
            for (int r = 0; r < 16; ++r) {
                const int d0 = qpos - (kbase + crow(r, hi)), d1 = d0 - 32;
                if (d0 > 128 || d0 < -128) p0[r] = -1e30f;
                if (d1 > 128 || d1 < -128) p1[r] = -1e30f;
            }
        }
        float mx = p0[0];
#pragma unroll
        for (int r = 1; r < 16; ++r) mx = fmaxf(mx, p0[r]);
#pragma unroll
        for (int r = 0; r < 16; ++r) mx = fmaxf(mx, p1[r]);
        mx = fmaxf(mx, __shfl_xor(mx, 32));
        const float mn = fmaxf(mrun, mx), alpha = ex2(mrun - mn);
        mrun = mn;
        float rs = 0.f;
#pragma unroll
        for (int r = 0; r < 16; ++r) { p0[r] = ex2(p0[r] - mn); rs += p0[r]; }
#pragma unroll
        for (int r = 0; r < 16; ++r) { p1[r] = ex2(p1[r] - mn); rs += p1[r]; }
        rs += __shfl_xor(rs, 32);
        lrun = lrun * alpha + rs;
#pragma unroll
        for (int d = 0; d < NDV; ++d)
#pragma unroll
            for (int r = 0; r < 16; ++r) o[d][r] *= alpha;
        bf16x8 pf[4];
        { u32x4 w;
          w.x = pk2(p0[0], p0[1]); w.y = pk2(p0[2], p0[3]); w.z = pk2(p0[4], p0[5]); w.w = pk2(p0[6], p0[7]); pf[0] = mk8(w);
          w.x = pk2(p0[8], p0[9]); w.y = pk2(p0[10], p0[11]); w.z = pk2(p0[12], p0[13]); w.w = pk2(p0[14], p0[15]); pf[1] = mk8(w);
          w.x = pk2(p1[0], p1[1]); w.y = pk2(p1[2], p1[3]); w.z = pk2(p1[4], p1[5]); w.w = pk2(p1[6], p1[7]); pf[2] = mk8(w);
          w.x = pk2(p1[8], p1[9]); w.y = pk2(p1[10], p1[11]); w.z = pk2(p1[12], p1[13]); w.w = pk2(p1[14], p1[15]); pf[3] = mk8(w); }
#pragma unroll
        for (int d = 0; d < NDV; ++d) {
#pragma unroll
            for (int kk = 0; kk < 4; ++kk) {
                const int keybase = kk * 16 + 4 * hi;
                const LAS unsigned char* vp = Vs + (d * 32 + ql) * VP + keybase * 2;
                const u32x2 lo = *(const LAS u32x2*)vp, hh = *(const LAS u32x2*)(vp + 16);
                const bf16x8 vf = mk8((u32x4){lo.x, lo.y, hh.x, hh.y});
                o[d] = __builtin_amdgcn_mfma_f32_32x32x16_bf16(vf, pf[kk], o[d], 0, 0, 0);
            }
        }
    }
    const float inv = 1.f / lrun;
    bf16* orow = Og + (size_t)(wid * 32 + ql) * o_pitch;
#pragma unroll
    for (int d = 0; d < NDV; ++d)
#pragma unroll
        for (int g = 0; g < 4; ++g) {
            u32x2 w; w.x = pk2(o[d][g * 4 + 0] * inv, o[d][g * 4 + 1] * inv); w.y = pk2(o[d][g * 4 + 2] * inv, o[d][g * 4 + 3] * inv);
            *(u32x2*)(orow + d * 32 + 8 * g + 4 * hi) = w;
        }
}

constexpr int GA_CUM = 0, GA_ALOW = 16384, GA_WA = 20480, GA_BA = 24576, GA_QT = 24832, GA_TOT = 25856, GA_END = 26112;
__device__ __forceinline__ void gla_cum(const Params& p, LAS unsigned char* lds, const bf16* Z0, int r0, int h, int dir) {
    const int tid = threadIdx.x;
    LAS float* cum = (LAS float*)(lds + GA_CUM); LAS float* alow = (LAS float*)(lds + GA_ALOW); LAS float* wa = (LAS float*)(lds + GA_WA);
    LAS float* ba = (LAS float*)(lds + GA_BA); LAS float* qt = (LAS float*)(lds + GA_QT); LAS float* tot = (LAS float*)(lds + GA_TOT);
    {
        const int t = tid >> 2, i4 = (tid & 3) * 4;
        const u32x2 w = *(const u32x2*)(Z0 + (size_t)(r0 + t) * Z0P + 1024 + dir * 16 + i4);
        alow[t * 16 + i4 + 0] = bflo(w.x); alow[t * 16 + i4 + 1] = bfhi(w.x); alow[t * 16 + i4 + 2] = bflo(w.y); alow[t * 16 + i4 + 3] = bfhi(w.y);
#pragma unroll
        for (int q = 0; q < 4; ++q) { const int idx = tid * 4 + q, i = idx >> 6, j = idx & 63; wa[idx] = p.gla_wa2[(size_t)(dir * 16 + i) * 256 + h * 64 + j]; }
        if (tid < 64) ba[tid] = p.gla_ba[dir * 256 + h * 64 + tid];
    }
    __syncthreads();
    const int j = tid & 63, tq = tid >> 6;
    float la[16];
#pragma unroll
    for (int tt = 0; tt < 16; ++tt) {
        const int t = tq * 16 + tt;
        float x = ba[j];
#pragma unroll
        for (int i = 0; i < 16; ++i) x += alow[t * 16 + i] * wa[i * 64 + j];
        la[tt] = (fminf(x, 0.f) - log1pf(expf(-fabsf(x)))) * (1.f / 16.f);
    }
    float run = 0.f;
    if (dir == 0) {
#pragma unroll
        for (int tt = 0; tt < 16; ++tt) { run += la[tt]; cum[(tq * 16 + tt) * 64 + j] = run; }
    } else {
#pragma unroll
        for (int tt = 15; tt >= 0; --tt) { run += la[tt]; cum[(tq * 16 + tt) * 64 + j] = run; }
    }
    qt[tq * 64 + j] = run;
    __syncthreads();
    float off = 0.f, total = 0.f;
#pragma unroll
    for (int q = 0; q < 4; ++q) { const float v = qt[q * 64 + j]; total += v; if (dir == 0 ? (q < tq) : (q > tq)) off += v; }
#pragma unroll
    for (int tt = 0; tt < 16; ++tt) cum[(tq * 16 + tt) * 64 + j] += off;
    if (tq == 0) tot[j] = total;
    __syncthreads();
}

__device__ __forceinline__ int gla_row0(int b, int cc) { return cc < 4 ? b * CTX + cc * 64 : TC + b * SEQ + (cc - 4) * 64; }
__device__ __forceinline__ int gla_step(int cc, int dir) { return dir == 0 ? cc : (cc < 4 ? 3 - cc : 4 + (131 - cc)); }

__device__ __forceinline__ void gla_g1_item(const Params& p, LAS unsigned char* lds, int item) {
    unsigned char* ws = p.ws;
    const bf16* Z0 = (const bf16*)(ws + A0_Z0); const bf16* VGT = (const bf16*)(ws + A0_VGT);
    float* GS = (float*)(ws + A0_GS); float* GD = (float*)(ws + A0_GD);
    const int cc = item % NSTEP, rest = item / NSTEP, dir = rest & 1, h = (rest >> 1) & 3, b = rest >> 3;
    const int r0 = gla_row0(b, cc), step = gla_step(cc, dir), chain = (b * 4 + h) * 2 + dir;
    const int tid = threadIdx.x, lane = tid & 63, wid = tid >> 6, fr = lane & 15, fq = lane >> 4;
    __syncthreads();
    gla_cum(p, lds, Z0, r0, h, dir);
    LAS float* cum = (LAS float*)(lds + GA_CUM); LAS float* tot = (LAS float*)(lds + GA_TOT);
    LAS bf16* KT = (LAS bf16*)(lds + GA_END);
    {
        const int t = tid >> 2, d0 = (tid & 3) * 16;
        const u32x4 w0 = *(const u32x4*)(Z0 + (size_t)(r0 + t) * Z0P + 256 + h * 64 + d0), w1 = *(const u32x4*)(Z0 + (size_t)(r0 + t) * Z0P + 256 + h * 64 + d0 + 8);
        const unsigned ww[8] = {w0.x, w0.y, w0.z, w0.w, w1.x, w1.y, w1.z, w1.w};
#pragma unroll
        for (int i = 0; i < 8; ++i) {
            const int d = d0 + 2 * i;
            KT[d * 72 + t] = f2bf(bflo(ww[i]) * __expf(tot[d] - cum[t * 64 + d]));
            KT[(d + 1) * 72 + t] = f2bf(bfhi(ww[i]) * __expf(tot[d + 1] - cum[t * 64 + d + 1]));
        }
    }
    if (tid < 64) GD[((size_t)chain * NSTEP + step) * 64 + tid] = __expf(tot[tid]);
    __syncthreads();
    f32x4 acc[2][4];
#pragma unroll
    for (int m = 0; m < 2; ++m)
#pragma unroll
        for (int n = 0; n < 4; ++n) acc[m][n] = (f32x4){0.f, 0.f, 0.f, 0.f};
#pragma unroll
    for (int ks = 0; ks < 2; ++ks) {
        bf16x8 af[2], bfr[4];
#pragma unroll
        for (int m = 0; m < 2; ++m) af[m] = *(const bf16x8*)(VGT + (size_t)(h * 128 + wid * 32 + m * 16 + fr) * TT + r0 + ks * 32 + fq * 8);
#pragma unroll
        for (int n = 0; n < 4; ++n) bfr[n] = *(const LAS bf16x8*)(KT + (n * 16 + fr) * 72 + ks * 32 + fq * 8);
#pragma unroll
        for (int m = 0; m < 2; ++m)
#pragma unroll
            for (int n = 0; n < 4; ++n) acc[m][n] = __builtin_amdgcn_mfma_f32_16x16x32_bf16(bfr[n], af[m], acc[m][n], 0, 0, 0);
    }
    float* dst = GS + ((size_t)chain * NSTEP + step) * 8192;
#pragma unroll
    for (int m = 0; m < 2; ++m)
#pragma unroll
        for (int n = 0; n < 4; ++n) *(f32x4*)(dst + (size_t)(wid * 32 + m * 16 + fr) * 64 + n * 16 + fq * 4) = acc[m][n];
}

__device__ __forceinline__ void ph_gla_scan(const Params& p) {
    float* GS = (float*)(p.ws + A0_GS); const float* GD = (const float*)(p.ws + A0_GD);
    for (int idx = blockIdx.x * 256 + threadIdx.x; idx < 16 * 8192; idx += gridDim.x * 256) {
        const int chain = idx >> 13, e = idx & 8191, dk = e & 63;
        float* g = GS + (size_t)chain * NSTEP * 8192 + e;
        const float* d = GD + (size_t)chain * NSTEP * 64 + dk;
        float st = 0.f;
#pragma unroll 6
        for (int s = 0; s < NSTEP; ++s) { const float t = g[(size_t)s * 8192]; const float dec = d[s * 64]; g[(size_t)s * 8192] = st; st = dec * st + t; }
    }
}

__device__ __forceinline__ void gla_g3_item(const Params& p, LAS unsigned char* lds, int item) {
    unsigned char* ws = p.ws;
    const bf16* Z0 = (const bf16*)(ws + A0_Z0); const bf16* VGT = (const bf16*)(ws + A0_VGT);
    const float* GS = (const float*)(ws + A0_GS); bf16* MIX = (bf16*)(ws + A0_MIX);
    const int cc = item % NSTEP, rest = item / NSTEP, h = rest & 3, b = rest >> 2;
    const int r0 = gla_row0(b, cc);
    const int tid = threadIdx.x, lane = tid & 63, wid = tid >> 6, fr = lane & 15, fq = lane >> 4;
    LAS bf16* QT = (LAS bf16*)(lds + GA_END);
    LAS bf16* QI = (LAS bf16*)(lds + GA_END + 9216);
    LAS bf16* KT = (LAS bf16*)(lds + GA_END + 18432);
    LAS bf16* PP = (LAS bf16*)(lds);
    f32x4 o[4][2];
#pragma unroll
    for (int m = 0; m < 4; ++m)
#pragma unroll
        for (int n = 0; n < 2; ++n) o[m][n] = (f32x4){0.f, 0.f, 0.f, 0.f};
    for (int dir = 0; dir < 2; ++dir) {
        const int step = gla_step(cc, dir), chain = (b * 4 + h) * 2 + dir;
        __syncthreads();
        gla_cum(p, lds, Z0, r0, h, dir);
        LAS float* cum = (LAS float*)(lds + GA_CUM); LAS float* tot = (LAS float*)(lds + GA_TOT);
        {
            const int t = tid >> 2, d0 = (tid & 3) * 16;
            const bf16* zr = Z0 + (size_t)(r0 + t) * Z0P + h * 64 + d0;
            const u32x4 q0 = *(const u32x4*)(zr), q1 = *(const u32x4*)(zr + 8), k0 = *(const u32x4*)(zr + 256), k1 = *(const u32x4*)(zr + 264);
            const unsigned qq[8] = {q0.x, q0.y, q0.z, q0.w, q1.x, q1.y, q1.z, q1.w}, kk[8] = {k0.x, k0.y, k0.z, k0.w, k1.x, k1.y, k1.z, k1.w};
            unsigned oqt[8], oqi[8], okt[8];
#pragma unroll
            for (int i = 0; i < 8; ++i) {
                const int d = d0 + 2 * i;
                const float c0 = cum[t * 64 + d], c1 = cum[t * 64 + d + 1], t0 = tot[d], t1 = tot[d + 1];
                const float qa = bflo(qq[i]), qb = bfhi(qq[i]), ka = bflo(kk[i]), kb = bfhi(kk[i]);
                oqt[i] = pk2(qa * __expf(c0 - t0), qb * __expf(c1 - t1));
                oqi[i] = pk2(qa * __expf(c0), qb * __expf(c1));
                okt[i] = pk2(ka * __expf(t0 - c0), kb * __expf(t1 - c1));
            }
            *(LAS u32x4*)(QT + t * 72 + d0) = (u32x4){oqt[0], oqt[1], oqt[2], oqt[3]}; *(LAS u32x4*)(QT + t * 72 + d0 + 8) = (u32x4){oqt[4], oqt[5], oqt[6], oqt[7]};
            *(LAS u32x4*)(QI + t * 72 + d0) = (u32x4){oqi[0], oqi[1], oqi[2], oqi[3]}; *(LAS u32x4*)(QI + t * 72 + d0 + 8) = (u32x4){oqi[4], oqi[5], oqi[6], oqi[7]};
            *(LAS u32x4*)(KT + t * 72 + d0) = (u32x4){okt[0], okt[1], okt[2], okt[3]}; *(LAS u32x4*)(KT + t * 72 + d0 + 8) = (u32x4){okt[4], okt[5], okt[6], okt[7]};
        }
        __syncthreads();
        {
            f32x4 sa[4];
#pragma unroll
            for (int m = 0; m < 4; ++m) sa[m] = (f32x4){0.f, 0.f, 0.f, 0.f};
#pragma unroll
            for (int ks = 0; ks < 2; ++ks) {
                const bf16x8 kf = *(const LAS bf16x8*)(KT + (wid * 16 + fr) * 72 + ks * 32 + fq * 8);
#pragma unroll
                for (int m = 0; m < 4; ++m) {
                    const bf16x8 qfm = *(const LAS bf16x8*)(QT + (m * 16 + fr) * 72 + ks * 32 + fq * 8);
                    sa[m] = __builtin_amdgcn_mfma_f32_16x16x32_bf16(kf, qfm, sa[m], 0, 0, 0);
                }
            }
#pragma unroll
            for (int m = 0; m < 4; ++m) {
                const int t = m * 16 + fr;
                float v[4];
#pragma unroll
                for (int jj = 0; jj < 4; ++jj) { const int j = wid * 16 + fq * 4 + jj; const bool keep = dir == 0 ? (j <= t) : (j >= t); v[jj] = keep ? sa[m][jj] : 0.f; }
                *(LAS u32x2*)(PP + t * 72 + wid * 16 + fq * 4) = (u32x2){pk2(v[0], v[1]), pk2(v[2], v[3])};
            }
        }
        __syncthreads();
        const float* Sg = GS + ((size_t)chain * NSTEP + step) * 8192;
#pragma unroll
        for (int ks = 0; ks < 2; ++ks) {
            bf16x8 vfr[2], sfr[2];
#pragma unroll
            for (int n = 0; n < 2; ++n) {
                const int dv = wid * 32 + n * 16 + fr;
                vfr[n] = *(const bf16x8*)(VGT + (size_t)(h * 128 + dv) * TT + r0 + ks * 32 + fq * 8);
                const f32x4 s0 = *(const f32x4*)(Sg + (size_t)dv * 64 + ks * 32 + fq * 8), s1 = *(const f32x4*)(Sg + (size_t)dv * 64 + ks * 32 + fq * 8 + 4);
                sfr[n] = mk8((u32x4){pk2(s0.x, s0.y), pk2(s0.z, s0.w), pk2(s1.x, s1.y), pk2(s1.z, s1.w)});
            }
#pragma unroll
            for (int m = 0; m < 4; ++m) {
                const bf16x8 pfm = *(const LAS bf16x8*)(PP + (m * 16 + fr) * 72 + ks * 32 + fq * 8);
                const bf16x8 qim = *(const LAS bf16x8*)(QI + (m * 16 + fr) * 72 + ks * 32 + fq * 8);
#pragma unroll
                for (int n = 0; n < 2; ++n) {
                    o[m][n] = __builtin_amdgcn_mfma_f32_16x16x32_bf16(vfr[n], pfm, o[m][n], 0, 0, 0);
                    o[m][n] = __builtin_amdgcn_mfma_f32_16x16x32_bf16(sfr[n], qim, o[m][n], 0, 0, 0);
                }
            }
        }
    }
    __syncthreads();
    LAS float* red = (LAS float*)(lds + GA_END + 27648);
#pragma unroll
    for (int m = 0; m < 4; ++m) {
        float s = 0.f;
#pragma unroll
        for (int n = 0; n < 2; ++n)
#pragma unroll
            for (int j = 0; j < 4; ++j) s += o[m][n][j] * o[m][n][j];
        s += __shfl_xor(s, 16); s += __shfl_xor(s, 32);
        if (fq == 0) red[wid * 64 + m * 16 + fr] = s;
    }
    __syncthreads();
#pragma unroll
    for (int m = 0; m < 4; ++m) {
        const int t = m * 16 + fr;
        const float ss = red[t] + red[64 + t] + red[128 + t] + red[192 + t];
        const float rinv = rsqrtf(ss * (1.f / 128.f) + RMS_EPS);
        const int r = r0 + t;
#pragma unroll
        for (int n = 0; n < 2; ++n) {
            const int dv = wid * 32 + n * 16 + fq * 4;
            const u32x2 gw = *(const u32x2*)(Z0 + (size_t)r * Z0P + 512 + h * 128 + dv);
            const f32x4 ng = *(const f32x4*)(p.gla_norm + dv);
            const float g0 = bflo(gw.x), g1 = bfhi(gw.x), g2 = bflo(gw.y), g3 = bfhi(gw.y);
            const float y0 = o[m][n][0] * rinv * ng.x * siluf(g0), y1 = o[m][n][1] * rinv * ng.y * siluf(g1);
            const float y2 = o[m][n][2] * rinv * ng.z * siluf(g2), y3 = o[m][n][3] * rinv * ng.w * siluf(g3);
            *(u32x2*)(MIX + (size_t)r * DM + h * 128 + dv) = (u32x2){pk2(y0, y1), pk2(y2, y3)};
        }
    }
}

__device__ __forceinline__ void ph_swa_g1(const Params& p, LAS unsigned char* lds) {
    unsigned char* ws = p.ws;
    const bf16* QS = (const bf16*)(ws + A0_QS); const bf16* KS = (const bf16*)(ws + A0_KS); const bf16* VST = (const bf16*)(ws + A0_VST); bf16* MIX = (bf16*)(ws + A0_MIX);
    constexpr int N_SWA = 2 * 8 * 66, N_G1 = 2 * 4 * 2 * NSTEP;
    for (int item = blockIdx.x; item < N_SWA + N_G1; item += gridDim.x) {
        if (item < N_SWA) {
            const int qt = item % 66, rest = item / 66, h = rest & 7, b = rest >> 3, kvh = h >> 2;
            const bf16* Qg = QS + ((size_t)(b * 8 + h) * NKEY + qt * 128) * 64;
            const bf16* Kg = KS + (size_t)(b * 2 + kvh) * NKEY * 64;
            const bf16* Vg = VST + (size_t)(b * 2 + kvh) * 64 * NKEY;
            int b0 = 0, b1 = 0, qpos0 = 0, row0;
            if (qt >= 2) { qpos0 = (qt - 2) * 128; const int lo = qpos0 - 128 < 0 ? 0 : qpos0 - 128, hi2 = qpos0 + 256 > SEQ ? SEQ : qpos0 + 256; b0 = 4 + lo / 64; b1 = 4 + hi2 / 64; row0 = TC + b * SEQ + qpos0; }
            else row0 = b * CTX + qt * 128;
            const float sink = p.swa_sink[h] * LOG2E;
            attn_item<64, 64>(lds, Qg, Kg, Vg, 4, b0, b1, qpos0, sink, 1.f, MIX + (size_t)row0 * DM + 512 + h * 64, DM);
        } else gla_g1_item(p, lds, item - N_SWA);
    }
}
__device__ __forceinline__ void ph_gla_g3(const Params& p, LAS unsigned char* lds) {
    for (int item = blockIdx.x; item < 2 * 4 * NSTEP; item += gridDim.x) gla_g3_item(p, lds, item);
}

__device__ __forceinline__ void ph_router(const Params& p, LAS unsigned char* lds, int l, int row_lo) {
    unsigned char* ws = p.ws;
    const bf16* U = (const bf16*)(ws + OFF_U); const bf16* W = (const bf16*)(ws + OFF_W_RT) + (size_t)l * 128 * DM;
    int* cntg = (int*)(ws + OFF_CNT) + l * 64; int* tokslot = (int*)(ws + OFF_TOKSLOT); float* W8 = (float*)(ws + OFF_W8); int* LIST = (int*)(ws + OFF_LIST);
    const int tid = threadIdx.x, lane = tid & 63, wid = tid >> 6, wr = wid >> 1, wc = wid & 1, fr = lane & 15, fq = lane >> 4;
    LAS float* lg = (LAS float*)lds;
    LAS int* ebuf = (LAS int*)(lds + 34816) + wid * 256;
    LAS float* wbuf = (LAS float*)(lds + 34816 + 4096) + wid * 256;
    const float bias = p.b_router[l * 64 + lane];
    const int tm0 = row_lo / 128;
    for (int tm = tm0 + blockIdx.x; tm < TT / 128; tm += gridDim.x) {
        const int brow = tm * 128;
        const bf16 *a0, *a1, *b0, *b1; plain_ptrs(U, brow, DM, a0, a1); plain_ptrs(W, 0, DM, b0, b1);
        f32x4 acc[4][4];
        __syncthreads();
        gemm_core(lds, a0, a1, b0, b1, DM / 32, acc);
        if (wc == 0) {
#pragma unroll
            for (int m = 0; m < 4; ++m)
#pragma unroll
                for (int n = 0; n < 4; ++n)
#pragma unroll
                    for (int j = 0; j < 4; ++j) lg[(wr * 64 + m * 16 + fr) * 65 + n * 16 + fq * 4 + j] = acc[m][n][j];
        }
        __syncthreads();
        unsigned mask = 0u;
        for (int rr = 0; rr < 32; ++rr) {
            const float logit = lg[(wid * 32 + rr) * 65 + lane];
            const float score = 1.f / (1.f + expf(-logit));
            const float sel = score + bias;
            int rin = 0;
#pragma unroll
            for (int i = 0; i < 8; ++i) { const float ov = __shfl(sel, (lane & ~7) | i); rin += (ov > sel || (ov == sel && i < (lane & 7))) ? 1 : 0; }
            float gs = rin < 2 ? sel : 0.f;
            gs += __shfl_xor(gs, 1); gs += __shfl_xor(gs, 2); gs += __shfl_xor(gs, 4);
            int grk = 0;
#pragma unroll
            for (int g = 0; g < 8; ++g) { const float og = __shfl(gs, g * 8); grk += (og > gs || (og == gs && g < (lane >> 3))) ? 1 : 0; }
            const bool allowed = grk < 4;
            const float sm = allowed ? sel : -INFINITY;
            int rk = 0;
#pragma unroll 16
            for (int i = 0; i < 64; ++i) { const float ov = __shfl(sm, i); rk += (ov > sm || (ov == sm && i < lane)) ? 1 : 0; }
            const bool selected = allowed && rk < 8;
            const float wsum = wave_sum(selected ? score : 0.f);
            if (selected) { mask |= 1u << rr; ebuf[rr * 8 + rk] = lane; wbuf[rr * 8 + rk] = score / wsum * 2.5f; }
        }
        const int nsel = __popc(mask);
        int base = 0;
        if (nsel > 0) base = atomicAdd(cntg + lane, nsel);
        asm volatile("s_waitcnt lgkmcnt(0)" ::: "memory");
#pragma unroll
        for (int q = 0; q < 4; ++q) {
            const int ent = q * 64 + lane, rr = ent >> 3, rk = ent & 7;
            const int e = ebuf[ent]; const float w = wbuf[ent];
            const int be = __shfl(base, e); const unsigned me = (unsigned)__shfl((int)mask, e);
            const int pos = be + __popc(me & ((1u << rr) - 1u));
            const int t = brow + wid * 32 + rr;
            tokslot[(size_t)t * 8 + rk] = (e << 20) | pos;
            W8[(size_t)t * 8 + rk] = w;
            LIST[(size_t)e * TT + pos] = t * 8 + rk;
        }
    }
}

__device__ __forceinline__ int moe_find_expert(const LAS int* tp, int mtg) {
    int lo = 0, hi = 64;
    while (lo < hi) { const int mid = (lo + hi + 1) >> 1; if (tp[mid] <= mtg) lo = mid; else hi = mid - 1; }
    return lo;
}
__device__ __forceinline__ void ph_moe1(const Params& p, LAS unsigned char* lds, int l, int row_lo) {
    unsigned char* ws = p.ws;
    moe_tables(p, lds, l, row_lo);
    LAS int* cnt = (LAS int*)(lds + MOE_LDS_OFF); LAS int* tp = cnt + 80; LAS int* sp = tp + 80;
    const bf16* U = (const bf16*)(ws + OFF_U); const bf16* WGU = (const bf16*)(ws + OFF_W_GU); bf16* HM = (bf16*)(ws + AM_HM);
    const int* LIST = (const int*)(ws + OFF_LIST);
    const int tid = threadIdx.x, lane = tid & 63, wid = tid >> 6, wr = wid >> 1, wc = wid & 1, fr = lane & 15, fq = lane >> 4;
    const int ntiles = tp[65] * 4;
    for (int t = blockIdx.x; t < ntiles; t += gridDim.x) {
        const int mtg = t >> 2, nt = t & 3, e = moe_find_expert(tp, mtg), mt = mtg - tp[e], ce = cnt[e];
        const bf16 *a0, *a1, *b0, *b1;
        {
            const int i0 = mt * 128 + (tid >> 2), i1 = i0 + 64;
            int tk0 = row_lo, tk1 = row_lo;
            if (e < 64) { if (i0 < ce) tk0 = LIST[(size_t)e * TT + i0] >> 3; if (i1 < ce) tk1 = LIST[(size_t)e * TT + i1] >> 3; }
            else { if (i0 < ce) tk0 = row_lo + i0; if (i1 < ce) tk1 = row_lo + i1; }
            a0 = U + (size_t)tk0 * DM + (tid & 3) * 8; a1 = U + (size_t)tk1 * DM + (tid & 3) * 8;
        }
        plain_ptrs(WGU + (size_t)e * 512 * DM, nt * 128, DM, b0, b1);
        f32x4 acc[4][4];
        gemm_core(lds, a0, a1, b0, b1, DM / 32, acc);
        const size_t slot0 = e < 64 ? (size_t)(sp[e] + mt * 128) : (size_t)TT * 8 + row_lo + mt * 128;
        const int hc0 = nt * 64 + wc * 32;
#pragma unroll
        for (int m = 0; m < 4; ++m) {
            const int i = wr * 64 + m * 16 + fr;
            if (mt * 128 + i < ce) {
#pragma unroll
                for (int n = 0; n < 2; ++n) {
                    const f32x4 g = acc[m][n], u = acc[m][n + 2];
                    const u32x2 w = {pk2(siluf(g[0]) * u[0], siluf(g[1]) * u[1]), pk2(siluf(g[2]) * u[2], siluf(g[3]) * u[3])};
                    *(u32x2*)(HM + (slot0 + i) * 256 + hc0 + n * 16 + fq * 4) = w;
                }
            }
        }
    }
}
__device__ __forceinline__ void ph_moe2(const Params& p, LAS unsigned char* lds, int l, int row_lo) {
    unsigned char* ws = p.ws;
    moe_tables(p, lds, l, row_lo);
    LAS int* cnt = (LAS int*)(lds + MOE_LDS_OFF); LAS int* tp = cnt + 80; LAS int* sp = tp + 80;
    const bf16* HM = (const bf16*)(ws + AM_HM); const bf16* WD = (const bf16*)(ws + OFF_W_D); bf16* YR = (bf16*)(ws + AM_YR);
    const int* LIST = (const int*)(ws + OFF_LIST); const float* W8 = (const float*)(ws + OFF_W8);
    const int tid = threadIdx.x, lane = tid & 63, wid = tid >> 6, wr = wid >> 1, wc = wid & 1, fr = lane & 15, fq = lane >> 4;
    const int ntiles = tp[65] * 8;
    for (int t = blockIdx.x; t < ntiles; t += gridDim.x) {
        const int mtg = t >> 3, nt = t & 7, e = moe_find_expert(tp, mtg), mt = mtg - tp[e], ce = cnt[e];
        const size_t slot0 = e < 64 ? (size_t)(sp[e] + mt * 128) : (size_t)TT * 8 + row_lo + mt * 128;
        const bf16 *a0, *a1, *b0, *b1;
        a0 = HM + (slot0 + (tid >> 2)) * 256 + (tid & 3) * 8; a1 = a0 + 64 * 256;
        plain_ptrs(WD + (size_t)e * DM * 256, nt * 128, 256, b0, b1);
        f32x4 acc[4][4];
        gemm_core(lds, a0, a1, b0, b1, 256 / 32, acc);
#pragma unroll
        for (int m = 0; m < 4; ++m) {
            const int i = wr * 64 + m * 16 + fr, li = mt * 128 + i;
            if (li < ce) {
                const float w = e < 64 ? W8[LIST[(size_t)e * TT + li]] : 1.f;
#pragma unroll
                for (int n = 0; n < 4; ++n) {
                    const f32x4 a = acc[m][n] * w;
                    *(u32x2*)(YR + (slot0 + i) * DM + nt * 128 + wc * 64 + n * 16 + fq * 4) = (u32x2){pk2(a[0], a[1]), pk2(a[2], a[3])};
                }
            }
        }
    }
}

__device__ __forceinline__ void ph_inproj1(const Params& p, LAS unsigned char* lds) {
    unsigned char* ws = p.ws;
    const bf16* U = (const bf16*)(ws + OFF_U); const bf16* W = (const bf16*)(ws + OFF_W_IN_O);
    bf16* Z1 = (bf16*)(ws + A1_Z1); bf16* KM = (bf16*)(ws + A1_KM);
    const f32x2* rope = (const f32x2*)(ws + OFF_ROPE);
    const int tid = threadIdx.x, lane = tid & 63, wid = tid >> 6, wr = wid >> 1, wc = wid & 1, fr = lane & 15, fq = lane >> 4;
    constexpr int NTN = 7, NTM = TT / 128;
    for (int t = blockIdx.x; t < NTM * NTN; t += gridDim.x) {
        const int tm = t / NTN, tn = t % NTN, brow = tm * 128, bcol = tn * 128;
        const bf16 *a0, *a1, *b0, *b1; plain_ptrs(U, brow, DM, a0, a1); plain_ptrs(W, bcol, DM, b0, b1);
        f32x4 acc[4][4];
        gemm_core(lds, a0, a1, b0, b1, DM / 32, acc);
        const int cb = bcol + wc * 64;
#pragma unroll
        for (int m = 0; m < 4; ++m) {
            const int r = brow + wr * 64 + m * 16 + fr;
            if (cb < 768) {
#pragma unroll
                for (int n = 0; n < 4; ++n) *(u32x2*)(Z1 + (size_t)r * Z1P + cb + n * 16 + fq * 4) = (u32x2){pk2(acc[m][n][0], acc[m][n][1]), pk2(acc[m][n][2], acc[m][n][3])};
            } else if (cb == 768) {
                const RowInfo ri = rowinfo(r);
                f32x4 o[4];
#pragma unroll
                for (int n = 0; n < 2; ++n)
#pragma unroll
                    for (int j = 0; j < 4; ++j) {
                        const float x1 = acc[m][n][j], x2 = acc[m][n + 2][j];
                        if (ri.lat) { const f32x2 cs = rope[(size_t)ri.pos * 32 + n * 16 + fq * 4 + j]; o[n][j] = x1 * cs.x - x2 * cs.y; o[n + 2][j] = x2 * cs.x + x1 * cs.y; }
                        else { o[n][j] = x1; o[n + 2][j] = x2; }
                    }
#pragma unroll
                for (int h = 0; h < 8; ++h) {
                    bf16* dst = KM + ((size_t)(ri.b * 8 + h) * NKEY + ri.kq) * 192 + 128;
#pragma unroll
                    for (int n = 0; n < 4; ++n) *(u32x2*)(dst + n * 16 + fq * 4) = (u32x2){pk2(o[n][0], o[n][1]), pk2(o[n][2], o[n][3])};
                }
            }
        }
    }
}

__device__ __forceinline__ void ph_mla_up(const Params& p, LAS unsigned char* lds) {
    unsigned char* ws = p.ws;
    const bf16* Z1 = (const bf16*)(ws + A1_Z1); const bf16* WQ = (const bf16*)(ws + OFF_W_UQ); const bf16* WKV = (const bf16*)(ws + OFF_W_UKV);
    bf16* QM = (bf16*)(ws + A1_QM); bf16* KM = (bf16*)(ws + A1_KM); bf16* VTM = (bf16*)(ws + A1_VTM);
    const f32x2* rope = (const f32x2*)(ws + OFF_ROPE);
    const int tid = threadIdx.x, lane = tid & 63, wid = tid >> 6, wr = wid >> 1, wc = wid & 1, fr = lane & 15, fq = lane >> 4;
    LAS float* rsb = (LAS float*)(lds + 32768);
    constexpr int NQ = (TL / 128) * 12, NKV = (TT / 128) * 16;
    constexpr float QSCALE = 0.07216878364870322f * LOG2E;
    for (int t = blockIdx.x; t < NQ + NKV; t += gridDim.x) {
        const bool isq = t < NQ;
        int tm, tn;
        if (isq) { tm = 4 + t / 12; tn = t % 12; } else { const int u = t - NQ; tm = u / 16; tn = u % 16; }
        const int brow = tm * 128, bcol = tn * 128, K = isq ? 512 : 256, acol = isq ? 0 : 512;
        __syncthreads();
        {
            const int row = tid >> 1, half = tid & 1;
            const bf16* ap = Z1 + (size_t)(brow + row) * Z1P + acol + half * (K / 2);
            float ss = 0.f;
            for (int c = 0; c < K / 2; c += 8) { const u32x4 w = *(const u32x4*)(ap + c);
                const float v0 = bflo(w.x), v1 = bfhi(w.x), v2 = bflo(w.y), v3 = bfhi(w.y), v4 = bflo(w.z), v5 = bfhi(w.z), v6 = bflo(w.w), v7 = bfhi(w.w);
                ss += v0 * v0 + v1 * v1 + v2 * v2 + v3 * v3 + v4 * v4 + v5 * v5 + v6 * v6 + v7 * v7; }
            ss += __shfl_xor(ss, 1);
            if (half == 0) rsb[row] = rsqrtf(ss / (float)K + RMS_EPS);
        }
        const bf16 *a0, *a1, *b0, *b1; plain_ptrs(Z1 + acol, brow, Z1P, a0, a1); plain_ptrs(isq ? WQ : WKV, bcol, K, b0, b1);
        f32x4 acc[4][4];
        gemm_core(lds, a0, a1, b0, b1, K / 32, acc);
        const int cb = bcol + wc * 64;
#pragma unroll
        for (int m = 0; m < 4; ++m) {
            const int i = wr * 64 + m * 16 + fr, r = brow + i;
            const RowInfo ri = rowinfo(r);
            const float rs = rsb[i];
            if (isq) {
                const int h = cb / 192, part = (cb % 192) >> 6;
                bf16* dst = QM + ((size_t)(ri.b * 8 + h) * SEQ + ri.pos) * 192 + part * 64;
                const float sc = rs * QSCALE;
                if (part < 2) {
#pragma unroll
                    for (int n = 0; n < 4; ++n) *(u32x2*)(dst + n * 16 + fq * 4) = (u32x2){pk2(acc[m][n][0] * sc, acc[m][n][1] * sc), pk2(acc[m][n][2] * sc, acc[m][n][3] * sc)};
                } else {
                    f32x4 o[4];
#pragma unroll
                    for (int n = 0; n < 2; ++n)
#pragma unroll
                        for (int j = 0; j < 4; ++j) {
                            const float x1 = acc[m][n][j] * sc, x2 = acc[m][n + 2][j] * sc;
                            const f32x2 cs = rope[(size_t)ri.pos * 32 + n * 16 + fq * 4 + j];
                            o[n][j] = x1 * cs.x - x2 * cs.y; o[n + 2][j] = x2 * cs.x + x1 * cs.y;
                        }
#pragma unroll
                    for (int n = 0; n < 4; ++n) *(u32x2*)(dst + n * 16 + fq * 4) = (u32x2){pk2(o[n][0], o[n][1]), pk2(o[n][2], o[n][3])};
                }
            } else {
                const int h = cb >> 8, part = (cb & 255) >> 6;
                if (part < 2) {
                    bf16* dst = KM + ((size_t)(ri.b * 8 + h) * NKEY + ri.kq) * 192 + part * 64;
#pragma unroll
                    for (int n = 0; n < 4; ++n) *(u32x2*)(dst + n * 16 + fq * 4) = (u32x2){pk2(acc[m][n][0] * rs, acc[m][n][1] * rs), pk2(acc[m][n][2] * rs, acc[m][n][3] * rs)};
                } else {
                    bf16* dst = VTM + ((size_t)(ri.b * 8 + h) * 128 + (part - 2) * 64) * NKEY + ri.kq;
#pragma unroll
                    for (int n = 0; n < 4; ++n)
#pragma unroll
                        for (int j = 0; j < 4; ++j) dst[(size_t)(n * 16 + fq * 4 + j) * NKEY] = f2bf(acc[m][n][j] * rs);
                }
            }
        }
    }
}

__device__ __forceinline__ void ph_mla_attn(const Params& p, LAS unsigned char* lds) {
    unsigned char* ws = p.ws;
    const bf16* QM = (const bf16*)(ws + A1_QM); const bf16* KM = (const bf16*)(ws + A1_KM); const bf16* VTM = (const bf16*)(ws + A1_VTM); bf16* MIX = (bf16*)(ws + A1_MIX);
    for (int item = blockIdx.x; item < 2 * 8 * 64; item += gridDim.x) {
        const int qt = item & 63, h = (item >> 6) & 7, b = item >> 9;
        const bf16* Qg = QM + ((size_t)(b * 8 + h) * SEQ + qt * 128) * 192;
        const bf16* Kg = KM + (size_t)(b * 8 + h) * NKEY * 192;
        const bf16* Vg = VTM + (size_t)(b * 8 + h) * 128 * NKEY;
        attn_item<192, 128>(lds, Qg, Kg, Vg, NKEY / 64, 0, 0, 0, -1e30f, 0.f, MIX + (size_t)(TC + b * SEQ + qt * 128) * DM + h * 128, DM);
    }
}

constexpr int NPHASE = 19;
__global__ void __launch_bounds__(256, 2) mega(Params p) {
    extern __shared__ __attribute__((aligned(16))) unsigned char lds_[];
    LAS unsigned char* lds = (LAS unsigned char*)lds_;
    cg::grid_group grid = cg::this_grid();
    unsigned char* ws = p.ws;
#define PHASE(k, body) do { if (p.ph_lo <= (k) && (k) < p.ph_hi) { body; if ((k) + 1 < p.ph_hi) grid.sync(); } } while (0)
    PHASE(0, ph_prep(p, lds));
    PHASE(1, ph_modulate0(p));
    PHASE(2, ph_inproj0(p, lds));
    PHASE(3, ph_swa_g1(p, lds));
    PHASE(4, ph_gla_scan(p));
    PHASE(5, ph_gla_g3(p, lds));
    PHASE(6, ph_outproj(p, lds, (const bf16*)(ws + A0_MIX), (const bf16*)(ws + OFF_W_OUT_E), (float*)(ws + A0_Y), 0));
    PHASE(7, ph_rowpassA(p, 0, 0, (const float*)(ws + A0_Y)));
    PHASE(8, ph_router(p, lds, 0, 0));
    PHASE(9, ph_moe1(p, lds, 0, 0));
    PHASE(10, ph_moe2(p, lds, 0, 0));
    PHASE(11, { ph_rowpassB(p, lds, 0, 0); __syncthreads(); for (int it = blockIdx.x; it < EXP_ITEMS; it += gridDim.x) expert_convert_item(p, lds, 1, it); });
    PHASE(12, ph_inproj1(p, lds));
    PHASE(13, ph_mla_up(p, lds));
    PHASE(14, ph_mla_attn(p, lds));
    PHASE(15, ph_outproj(p, lds, (const bf16*)(ws + A1_MIX), (const bf16*)(ws + OFF_W_OUT_O), (float*)(ws + A1_Y), TC));
    PHASE(16, ph_rowpassA(p, 1, TC, (const float*)(ws + A1_Y)));
    PHASE(17, ph_router(p, lds, 1, TC));
    PHASE(18, ph_moe1(p, lds, 1, TC));
    PHASE(19, ph_moe2(p, lds, 1, TC));
    PHASE(20, ph_rowpassB(p, lds, 1, TC));
}

extern "C" void kernel_launch(void* const* d_in, const int* in_sizes, int n_in, void* d_out, int out_size, void* d_ws, size_t ws_size, hipStream_t stream) {
    static int grid_blocks = 0;
    if (!grid_blocks) {
        int dev = 0, cus = 0, per_cu = 0;
        (void)hipGetDevice(&dev);
        (void)hipDeviceGetAttribute(&cus, hipDeviceAttributeMultiprocessorCount, dev);
        (void)hipFuncSetAttribute((const void*)mega, hipFuncAttributeMaxDynamicSharedMemorySize, LDS_BYTES);
        (void)hipOccupancyMaxActiveBlocksPerMultiprocessor(&per_cu, (const void*)mega, 256, LDS_BYTES);
        if (per_cu > 2) per_cu = 2;
        if (per_cu < 1) per_cu = 1;
        grid_blocks = cus * per_cu;
        if (ws_size < WS_NEED) fprintf(stderr, "kernel_launch: workspace too small: %zu < %zu\n", ws_size, (size_t)WS_NEED);
    }
    Params p{};
    const float** f = (const float**)&p;
    for (int i = 0; i < 30; ++i) f[i] = (const float*)d_in[i];
    p.out = (float*)d_out; p.ws = (unsigned char*)d_ws; p.ph_lo = 0; p.ph_hi = 21;
    void* args[] = {&p};
    hipError_t e = hipLaunchCooperativeKernel((const void*)mega, dim3(grid_blocks), dim3(256), args, LDS_BYTES, stream);
    if (e != hipSuccess) fprintf(stderr, "cooperative launch failed: %s (grid %d)\n", hipGetErrorString(e), grid_blocks);
}
```

```cpp
#include <hip/hip_runtime.h>
#include <hip/hip_cooperative_groups.h>
#include <cstdio>
#include <cstdint>
namespace cg = cooperative_groups;

#define LAS __attribute__((address_space(3)))
typedef unsigned short bf16;
typedef short bf16x8 __attribute__((ext_vector_type(8)));
typedef float f32x2 __attribute__((ext_vector_type(2)));
typedef float f32x4 __attribute__((ext_vector_type(4)));
typedef float f32x8 __attribute__((ext_vector_type(8)));
typedef float f32x16 __attribute__((ext_vector_type(16)));
typedef unsigned u32x2 __attribute__((ext_vector_type(2)));
typedef unsigned u32x4 __attribute__((ext_vector_type(4)));
typedef __bf16 bf16x2_t __attribute__((ext_vector_type(2)));

constexpr int DM = 1024, NB = 2, SEQ = 8192, CTX = 256;
constexpr int TC = NB * CTX, TL = NB * SEQ, TT = TC + TL, NKEY = CTX + SEQ;
constexpr int NEXP = 64;
constexpr float RMS_EPS = 1e-6f;
constexpr int E_IN_PAD = 2432, O_IN_PAD = 896;
constexpr float LOG2E = 1.4426950408889634f;
constexpr int NSTEP = 132;
constexpr int Z0P = 1056;
constexpr int Z1P = 768;
constexpr int LDS_BYTES = 65536;

constexpr size_t al(size_t x) { return (x + 255) & ~(size_t)255; }
constexpr size_t OFF_W_IN_E = 0;
constexpr size_t OFF_W_OUT_E = OFF_W_IN_E + al((size_t)E_IN_PAD * DM * 2);
constexpr size_t OFF_W_IN_O = OFF_W_OUT_E + al((size_t)DM * DM * 2);
constexpr size_t OFF_W_UQ = OFF_W_IN_O + al((size_t)O_IN_PAD * DM * 2);
constexpr size_t OFF_W_UKV = OFF_W_UQ + al((size_t)1536 * 512 * 2);
constexpr size_t OFF_W_OUT_O = OFF_W_UKV + al((size_t)2048 * 256 * 2);
constexpr size_t OFF_W_RT = OFF_W_OUT_O + al((size_t)DM * DM * 2);
constexpr size_t OFF_W_GU = OFF_W_RT + al((size_t)2 * 128 * DM * 2);
constexpr size_t OFF_W_D = OFF_W_GU + al((size_t)65 * 512 * DM * 2);
constexpr size_t OFF_U = OFF_W_D + al((size_t)65 * DM * 256 * 2);
constexpr size_t OFF_HC = OFF_U + al((size_t)TT * DM * 2);
constexpr size_t OFF_MOD = OFF_HC + al((size_t)TC * DM * 4);
constexpr size_t OFF_ROPE = OFF_MOD + al((size_t)2 * 3 * 6144 * 4);
constexpr size_t OFF_CNT = OFF_ROPE + al((size_t)SEQ * 32 * 8);
constexpr size_t OFF_TOKSLOT = OFF_CNT + al(2 * 64 * 4);
constexpr size_t OFF_W8 = OFF_TOKSLOT + al((size_t)TT * 8 * 4);
constexpr size_t OFF_LIST = OFF_W8 + al((size_t)TT * 8 * 4);
constexpr size_t OFF_BAR = OFF_LIST + al((size_t)64 * TT * 4);
constexpr size_t BAR_BYTES = 16384;
constexpr size_t OFF_ARENA = OFF_BAR + BAR_BYTES;
constexpr size_t A0_Z0 = OFF_ARENA;
constexpr size_t A0_VGT = A0_Z0 + al((size_t)TT * Z0P * 2);
constexpr size_t A0_QS = A0_VGT + al((size_t)4 * 128 * TT * 2);
constexpr size_t A0_KS = A0_QS + al((size_t)2 * 8 * NKEY * 64 * 2);
constexpr size_t A0_VST = A0_KS + al((size_t)2 * 2 * NKEY * 64 * 2);
constexpr size_t A0_GS = A0_VST + al((size_t)2 * 2 * 64 * NKEY * 2);
constexpr size_t A0_GD = A0_GS + al((size_t)16 * NSTEP * 8192 * 4);
constexpr size_t A0_MIX = A0_GD + al((size_t)16 * NSTEP * 64 * 4);
constexpr size_t A0_Y = A0_MIX + al((size_t)TT * DM * 2);
constexpr size_t A0_END = A0_Y + al((size_t)TT * DM * 4);
constexpr size_t A1_Z1 = OFF_ARENA;
constexpr size_t A1_QM = A1_Z1 + al((size_t)TT * Z1P * 2);
constexpr size_t A1_KM = A1_QM + al((size_t)2 * 8 * SEQ * 192 * 2);
constexpr size_t A1_VTM = A1_KM + al((size_t)2 * 8 * NKEY * 192 * 2);
constexpr size_t A1_MIX = A1_VTM + al((size_t)2 * 8 * 128 * NKEY * 2);
constexpr size_t A1_Y = A1_MIX + al((size_t)TT * DM * 2);
constexpr size_t A1_END = A1_Y + al((size_t)TT * DM * 4);
constexpr size_t AM_HM = OFF_ARENA;
constexpr size_t AM_YR = AM_HM + al((size_t)TT * 9 * 256 * 2);
constexpr size_t AM_END = AM_YR + al((size_t)TT * 9 * 1024 * 2);
constexpr size_t WS_NEED = AM_END > A0_END ? (AM_END > A1_END ? AM_END : A1_END) : (A0_END > A1_END ? A0_END : A1_END);
static_assert(WS_NEED <= 555747360ull, "workspace map exceeds the guaranteed d_ws size");

struct Params {
    const float *x, *c, *ctx, *c_ctx, *w_mod, *b_mod, *g_mix_pre, *g_mix_post, *g_ffn_pre, *g_ffn_post;
    const float *w_in_e, *gla_wa2, *gla_ba, *gla_norm, *swa_sink, *w_out_e;
    const float *w_in_o, *mla_q_norm, *mla_kv_norm, *w_uq, *w_ukv, *w_out_o;
    const float *w_router, *b_router, *w_exp_gate, *w_exp_up, *w_exp_down, *w_sh_gate, *w_sh_up, *w_sh_down;
    float* out; unsigned char* ws; int ph_lo, ph_hi;
};

__device__ __forceinline__ unsigned pk2(float lo, float hi) { f32x2 v = {lo, hi}; bf16x2_t b = __builtin_convertvector(v, bf16x2_t); return __builtin_bit_cast(unsigned, b); }
__device__ __forceinline__ float bflo(unsigned u) { return __uint_as_float(u << 16); }
__device__ __forceinline__ float bfhi(unsigned u) { return __uint_as_float(u & 0xffff0000u); }
__device__ __forceinline__ float bf2f(bf16 v) { return __uint_as_float((unsigned)v << 16); }
__device__ __forceinline__ bf16 f2bf(float f) { return (bf16)(pk2(f, 0.f) & 0xffffu); }
__device__ __forceinline__ float wave_sum(float v) {
#pragma unroll
    for (int o = 1; o < 64; o <<= 1) v += __shfl_xor(v, o);
    return v;
}
__device__ __forceinline__ void glds16(const void* g, LAS void* l) { __builtin_amdgcn_global_load_lds((const unsigned*)g, (LAS unsigned*)l, 16, 0, 0); }
__device__ __forceinline__ float siluf(float x) { return x / (1.f + __expf(-x)); }
__device__ __forceinline__ float ex2(float x) { return __builtin_amdgcn_exp2f(x); }
__device__ __forceinline__ int crow(int r, int hi) { return (r & 3) + 8 * (r >> 2) + 4 * hi; }
__device__ __forceinline__ bf16x8 mk8(u32x4 v) { return __builtin_bit_cast(bf16x8, v); }

struct RowInfo { int b, kq, pos; bool lat; };
__device__ __forceinline__ RowInfo rowinfo(int r) {
    RowInfo i;
    if (r < TC) { i.b = r >> 8; i.pos = r & 255; i.kq = i.pos; i.lat = false; }
    else { const int rl = r - TC; i.b = rl >> 13; i.pos = rl & (SEQ - 1); i.kq = CTX + i.pos; i.lat = true; }
    return i;
}
__device__ __forceinline__ int modvec(int r) { return r < TC ? 2 : ((r - TC) >> 13); }

__device__ __forceinline__ void gemm_core(LAS unsigned char* lds, const bf16* a0, const bf16* a1, const bf16* b0, const bf16* b1, int nk, f32x4 (&acc)[4][4]) {
    const int tid = threadIdx.x, lane = tid & 63, wid = tid >> 6, wr = wid >> 1, wc = wid & 1, fr = lane & 15, fq = lane >> 4;
#pragma unroll
    for (int m = 0; m < 4; ++m)
#pragma unroll
        for (int n = 0; n < 4; ++n) acc[m][n] = (f32x4){0.f, 0.f, 0.f, 0.f};
    {
        LAS unsigned char* d = lds + tid * 16;
        glds16(a0, d); glds16(a1, d + 4096); glds16(b0, d + 8192); glds16(b1, d + 12288);
    }
    const int aoff = (wr * 64 + fr) * 64 + fq * 16, boff = 8192 + (wc * 64 + fr) * 64 + fq * 16;
    for (int kt = 0; kt < nk; ++kt) {
        const int s = kt & 1;
        asm volatile("s_waitcnt vmcnt(0)" ::: "memory");
        __syncthreads();
        if (kt + 1 < nk) {
            LAS unsigned char* d = lds + (s ^ 1) * 16384 + tid * 16;
            const int ko = (kt + 1) * 32;
            glds16(a0 + ko, d); glds16(a1 + ko, d + 4096); glds16(b0 + ko, d + 8192); glds16(b1 + ko, d + 12288);
        }
        bf16x8 af[4], bfr[4];
        LAS unsigned char* base = lds + s * 16384;
#pragma unroll
        for (int m = 0; m < 4; ++m) af[m] = *(const LAS bf16x8*)(base + aoff + m * 1024);
#pragma unroll
        for (int n = 0; n < 4; ++n) bfr[n] = *(const LAS bf16x8*)(base + boff + n * 1024);
#pragma unroll
        for (int m = 0; m < 4; ++m)
#pragma unroll
            for (int n = 0; n < 4; ++n) acc[m][n] = __builtin_amdgcn_mfma_f32_16x16x32_bf16(bfr[n], af[m], acc[m][n], 0, 0, 0);
    }
    __syncthreads();
}

__device__ __forceinline__ int ein_map(int n) {
    if (n < 512) return n;
    if (n < 1024) return n + 512;
    if (n < 1536) return n - 512;
    if (n < 2048) return 1568 + (n - 1536);
    if (n < 2176) return 2080 + (n - 2048);
    if (n < 2304) return 2208 + (n - 2176);
    if (n < 2320) return 1536 + (n - 2304);
    if (n < 2336) return 1552 + (n - 2320);
    return -1;
}
__device__ __forceinline__ void transpose_item(LAS unsigned char* lds, int K, bf16* dst, int k0, int n0, int ld, int mode, const float* srcA, const float* srcB, int nvalid, const float* kscale) {
    LAS float* tile = (LAS float*)lds;
    const int tid = threadIdx.x;
    {
        const int nl = tid & 63, kq = tid >> 6, n = n0 + nl;
        const float* cp = nullptr; float sc = 1.f;
        if (mode == 0) { if (n < nvalid) cp = srcA + n; }
        else if (mode == 1) { const int c = ein_map(n); if (c >= 0) cp = srcA + c; if (n < 256) sc = 0.125f; }
        else { const int grp = n >> 6, w = n & 63; cp = (w < 32 ? srcA : srcB) + grp * 32 + (w & 31); }
#pragma unroll 4
        for (int kk = 0; kk < 16; ++kk) {
            const int k = kq * 16 + kk;
            float v = 0.f;
            if (cp) { v = cp[(size_t)(k0 + k) * ld] * sc; if (kscale) v *= kscale[k0 + k]; }
            tile[k * 65 + nl] = v;
        }
    }
    __syncthreads();
    {
        const int n = tid >> 2, kc = tid & 3;
#pragma unroll
        for (int h = 0; h < 2; ++h) {
            const int k8 = kc * 16 + h * 8;
            u32x4 o;
            o.x = pk2(tile[(k8 + 0) * 65 + n], tile[(k8 + 1) * 65 + n]);
            o.y = pk2(tile[(k8 + 2) * 65 + n], tile[(k8 + 3) * 65 + n]);
            o.z = pk2(tile[(k8 + 4) * 65 + n], tile[(k8 + 5) * 65 + n]);
            o.w = pk2(tile[(k8 + 6) * 65 + n], tile[(k8 + 7) * 65 + n]);
            *(u32x4*)(dst + (size_t)(n0 + n) * K + k0 + k8) = o;
        }
    }
    __syncthreads();
}

constexpr int EXP_GU_ITEMS = 65 * 16 * 8, EXP_D_ITEMS = 65 * 4 * 16, EXP_ITEMS = EXP_GU_ITEMS + EXP_D_ITEMS;
__device__ __forceinline__ void expert_convert_item(const Params& p, LAS unsigned char* lds, int l, int it) {
    unsigned char* ws = p.ws;
    if (it < EXP_GU_ITEMS) {
        const int e = it / 128, r = it % 128, kb = r / 8, nb = r % 8;
        const float* gate = e < 64 ? p.w_exp_gate + ((size_t)(l * 64 + e)) * DM * 256 : p.w_sh_gate + (size_t)l * DM * 256;
        const float* up = e < 64 ? p.w_exp_up + ((size_t)(l * 64 + e)) * DM * 256 : p.w_sh_up + (size_t)l * DM * 256;
        transpose_item(lds, DM, (bf16*)(ws + OFF_W_GU) + (size_t)e * 512 * DM, kb * 64, nb * 64, 256, 2, gate, up, 512, nullptr);
    } else {
        it -= EXP_GU_ITEMS;
        const int e = it / 64, r = it % 64, kb = r / 16, nb = r % 16;
        const float* dn = e < 64 ? p.w_exp_down + ((size_t)(l * 64 + e)) * 256 * DM : p.w_sh_down + (size_t)l * 256 * DM;
        transpose_item(lds, 256, (bf16*)(ws + OFF_W_D) + (size_t)e * DM * 256, kb * 64, nb * 64, DM, 0, dn, nullptr, DM, nullptr);
    }
}

__device__ __forceinline__ void ph_prep(const Params& p, LAS unsigned char* lds) {
    unsigned char* ws = p.ws;
    const int tid = threadIdx.x;
    if (blockIdx.x == 0 && tid < 128) ((int*)(ws + OFF_CNT))[tid] = 0;
    constexpr int I_MOD = 48, I_ROPE = 1024, I_INE = 16 * 38, I_OUTE = 256, I_INO = 16 * 14, I_UQ = 8 * 24, I_UKV = 4 * 32, I_OUTO = 256, I_RT = 64;
    constexpr int NITEMS = I_MOD + I_ROPE + I_INE + I_OUTE + I_INO + I_UQ + I_UKV + I_OUTO + I_RT + EXP_ITEMS;
    for (int item = blockIdx.x; item < NITEMS; item += gridDim.x) {
        int it = item;
        if (it < I_MOD) {
            const int l = it / 24, n = (it % 24) * 256 + tid;
            LAS float* s = (LAS float*)lds;
            for (int idx = tid; idx < 3072; idx += 256) { const int v = idx >> 10, k = idx & 1023; const float cv = v < 2 ? p.c[v * DM + k] : p.c_ctx[k]; s[idx] = cv / (1.f + expf(-cv)); }
            __syncthreads();
            float a0 = 0.f, a1 = 0.f, a2 = 0.f;
            const float* w = p.w_mod + (size_t)l * DM * 6144 + n;
#pragma unroll 8
            for (int k = 0; k < DM; ++k) { const float wv = w[(size_t)k * 6144]; a0 += s[k] * wv; a1 += s[1024 + k] * wv; a2 += s[2048 + k] * wv; }
            float* mod = (float*)(ws + OFF_MOD) + (size_t)l * 3 * 6144;
            const float bb = p.b_mod[l * 6144 + n];
            mod[n] = a0 + bb; mod[6144 + n] = a1 + bb; mod[2 * 6144 + n] = a2 + bb;
            __syncthreads();
            continue;
        }
        it -= I_MOD;
        if (it < I_ROPE) {
            const int idx = it * 256 + tid, pos = idx >> 5, i = idx & 31, row = pos >> 6, col = pos & 63, j = i & 15;
            const float invf = powf(10000.f, -(float)(2 * j) / 32.f);
            const float ang = (float)(i < 16 ? row : col) * invf;
            float sn, cs; sincosf(ang, &sn, &cs);
            ((f32x2*)(ws + OFF_ROPE))[idx] = (f32x2){cs, sn};
            continue;
        }
        it -= I_ROPE;
        if (it < I_INE) { const int kb = it / 38, nb = it % 38;
            transpose_item(lds, DM, (bf16*)(ws + OFF_W_IN_E), kb * 64, nb * 64, 2336, 1, p.w_in_e, nullptr, 2336, nullptr); continue; }
        it -= I_INE;
        if (it < I_OUTE) { const int kb = it / 16, nb = it % 16;
            transpose_item(lds, DM, (bf16*)(ws + OFF_W_OUT_E), kb * 64, nb * 64, DM, 0, p.w_out_e, nullptr, DM, nullptr); continue; }
        it -= I_OUTE;
        if (it < I_INO) { const int kb = it / 14, nb = it % 14;
            transpose_item(lds, DM, (bf16*)(ws + OFF_W_IN_O), kb * 64, nb * 64, 832, 0, p.w_in_o, nullptr, 832, nullptr); continue; }
        it -= I_INO;
        if (it < I_UQ) { const int kb = it / 24, nb = it % 24;
            transpose_item(lds, 512, (bf16*)(ws + OFF_W_UQ), kb * 64, nb * 64, 1536, 0, p.w_uq, nullptr, 1536, p.mla_q_norm); continue; }
        it -= I_UQ;
        if (it < I_UKV) { const int kb = it / 32, nb = it % 32;
            transpose_item(lds, 256, (bf16*)(ws + OFF_W_UKV), kb * 64, nb * 64, 2048, 0, p.w_ukv, nullptr, 2048, p.mla_kv_norm); continue; }
        it -= I_UKV;
        if (it < I_OUTO) { const int kb = it / 16, nb = it % 16;
            transpose_item(lds, DM, (bf16*)(ws + OFF_W_OUT_O), kb * 64, nb * 64, DM, 0, p.w_out_o, nullptr, DM, nullptr); continue; }
        it -= I_OUTO;
        if (it < I_RT) { const int l = it / 32, r = it % 32, kb = r / 2, nb = r % 2;
            transpose_item(lds, DM, (bf16*)(ws + OFF_W_RT) + (size_t)l * 128 * DM, kb * 64, nb * 64, 64, 0, p.w_router + (size_t)l * DM * 64, nullptr, 64, nullptr); continue; }
        it -= I_RT;
        expert_convert_item(p, lds, 0, it);
    }
}

__device__ __forceinline__ void load_row(const float* src, int lane, f32x4 (&v)[4]) {
#pragma unroll
    for (int j = 0; j < 4; ++j) v[j] = *(const f32x4*)(src + lane * 4 + 256 * j);
}
__device__ __forceinline__ float row_sumsq(const f32x4 (&v)[4]) {
    float s = 0.f;
#pragma unroll
    for (int j = 0; j < 4; ++j) s += v[j].x * v[j].x + v[j].y * v[j].y + v[j].z * v[j].z + v[j].w * v[j].w;
    return wave_sum(s);
}
__device__ __forceinline__ void modulate_store(const f32x4 (&v)[4], float rinv, const float* g, const float* sh, const float* sc, bf16* dst, int lane) {
#pragma unroll
    for (int j = 0; j < 4; ++j) {
        const int c = lane * 4 + 256 * j;
        const f32x4 gg = *(const f32x4*)(g + c), s1 = *(const f32x4*)(sc + c), s0 = *(const f32x4*)(sh + c);
        const f32x4 o = v[j] * rinv * gg * (s1 + 1.f) + s0;
        u32x2 w; w.x = pk2(o.x, o.y); w.y = pk2(o.z, o.w);
        *(u32x2*)(dst + c) = w;
    }
}
__device__ __forceinline__ const float* hl_src0(const Params& p, int r) { return r < TC ? p.ctx + (size_t)r * DM : p.x + (size_t)(r - TC) * DM; }
__device__ __forceinline__ float* hl_buf(const Params& p, int r) { return r < TC ? (float*)(p.ws + OFF_HC) + (size_t)r * DM : p.out + (size_t)(r - TC) * DM; }

__device__ __forceinline__ void ph_modulate0(const Params& p) {
    const int lane = threadIdx.x & 63, gw = blockIdx.x * 4 + (threadIdx.x >> 6), ngw = gridDim.x * 4;
    const float* mod = (const float*)(p.ws + OFF_MOD);
    bf16* U = (bf16*)(p.ws + OFF_U);
    for (int r = gw; r < TT; r += ngw) {
        f32x4 v[4]; load_row(hl_src0(p, r), lane, v);
        const float rinv = rsqrtf(row_sumsq(v) * (1.f / DM) + RMS_EPS);
        const float* mv = mod + (size_t)modvec(r) * 6144;
        modulate_store(v, rinv, p.g_mix_pre, mv, mv + 1024, U + (size_t)r * DM, lane);
    }
}

__device__ __forceinline__ void ph_rowpassA(const Params& p, int l, int row_lo, const float* Y) {
    const int lane = threadIdx.x & 63, gw = blockIdx.x * 4 + (threadIdx.x >> 6), ngw = gridDim.x * 4;
    const float* mod = (const float*)(p.ws + OFF_MOD) + (size_t)l * 3 * 6144;
    bf16* U = (bf16*)(p.ws + OFF_U);
    for (int r = row_lo + gw; r < TT; r += ngw) {
        f32x4 y[4], h[4];
        load_row(Y + (size_t)r * DM, lane, y);
        load_row(l == 0 ? hl_src0(p, r) : (const float*)hl_buf(p, r), lane, h);
        const float rinv = rsqrtf(row_sumsq(y) * (1.f / DM) + RMS_EPS);
        const float* mv = mod + (size_t)modvec(r) * 6144;
        float* hb = hl_buf(p, r);
#pragma unroll
        for (int j = 0; j < 4; ++j) {
            const int c = lane * 4 + 256 * j;
            const f32x4 gg = *(const f32x4*)(p.g_mix_post + l * DM + c), gt = *(const f32x4*)(mv + 2048 + c);
            h[j] = h[j] + gt * (y[j] * rinv * gg);
            *(f32x4*)(hb + c) = h[j];
        }
        const float rinv2 = rsqrtf(row_sumsq(h) * (1.f / DM) + RMS_EPS);
        modulate_store(h, rinv2, p.g_ffn_pre + l * DM, mv + 3072, mv + 4096, U + (size_t)r * DM, lane);
    }
}

constexpr int MOE_LDS_OFF = 40960;
__device__ __forceinline__ void moe_tables(const Params& p, LAS unsigned char* lds, int l, int row_lo) {
    LAS int* cnt = (LAS int*)(lds + MOE_LDS_OFF); LAS int* tp = cnt + 80; LAS int* sp = tp + 80;
    const int tid = threadIdx.x;
    if (tid < 64) cnt[tid] = ((const int*)(p.ws + OFF_CNT))[l * 64 + tid];
    if (tid == 64) cnt[64] = TT - row_lo;
    __syncthreads();
    if (tid == 0) {
        int a = 0, s = 0;
        for (int e = 0; e < 65; ++e) { tp[e] = a; sp[e] = s; a += (cnt[e] + 127) >> 7; s += cnt[e]; }
        tp[65] = a;
    }
    __syncthreads();
}

__device__ __forceinline__ void ph_rowpassB(const Params& p, LAS unsigned char* lds, int l, int row_lo) {
    moe_tables(p, lds, l, row_lo);
    LAS int* sp = (LAS int*)(lds + MOE_LDS_OFF) + 160;
    const int lane = threadIdx.x & 63, gw = blockIdx.x * 4 + (threadIdx.x >> 6), ngw = gridDim.x * 4;
    const float* mod = (const float*)(p.ws + OFF_MOD) + (size_t)l * 3 * 6144;
    const bf16* YR = (const bf16*)(p.ws + AM_YR);
    const int* tokslot = (const int*)(p.ws + OFF_TOKSLOT);
    bf16* U = (bf16*)(p.ws + OFF_U);
    for (int r = row_lo + gw; r < TT; r += ngw) {
        f32x4 f[4];
#pragma unroll
        for (int j = 0; j < 4; ++j) f[j] = (f32x4){0.f, 0.f, 0.f, 0.f};
#pragma unroll
        for (int k = 0; k < 9; ++k) {
            size_t slot;
            if (k < 8) { const int ts = tokslot[(size_t)r * 8 + k]; slot = (size_t)(sp[ts >> 20] + (ts & 0xfffff)); }
            else slot = (size_t)TT * 8 + r;
            const bf16* yr = YR + slot * DM;
#pragma unroll
            for (int j = 0; j < 4; ++j) {
                const u32x2 w = *(const u32x2*)(yr + lane * 4 + 256 * j);
                f[j].x += bflo(w.x); f[j].y += bfhi(w.x); f[j].z += bflo(w.y); f[j].w += bfhi(w.y);
            }
        }
        const float rinv = rsqrtf(row_sumsq(f) * (1.f / DM) + RMS_EPS);
        const float* mv = mod + (size_t)modvec(r) * 6144;
        float* hb = hl_buf(p, r);
        f32x4 h[4]; load_row(hb, lane, h);
#pragma unroll
        for (int j = 0; j < 4; ++j) {
            const int c = lane * 4 + 256 * j;
            const f32x4 gg = *(const f32x4*)(p.g_ffn_post + l * DM + c), gt = *(const f32x4*)(mv + 5120 + c);
            h[j] = h[j] + gt * (f[j] * rinv * gg);
            *(f32x4*)(hb + c) = h[j];
        }
        if (l == 0) {
            const float rinv2 = rsqrtf(row_sumsq(h) * (1.f / DM) + RMS_EPS);
            const float* mv1 = mv + 3 * 6144;
            modulate_store(h, rinv2, p.g_mix_pre + DM, mv1, mv1 + 1024, U + (size_t)r * DM, lane);
        }
    }
}

__device__ __forceinline__ void plain_ptrs(const bf16* base, int row0, int ld, const bf16*& p0, const bf16*& p1) {
    const int tid = threadIdx.x;
    p0 = base + (size_t)(row0 + (tid >> 2)) * ld + (tid & 3) * 8;
    p1 = p0 + (size_t)64 * ld;
}

__device__ __forceinline__ void ph_inproj0(const Params& p, LAS unsigned char* lds) {
    unsigned char* ws = p.ws;
    const bf16* U = (const bf16*)(ws + OFF_U); const bf16* W = (const bf16*)(ws + OFF_W_IN_E);
    bf16* Z0 = (bf16*)(ws + A0_Z0); bf16* VGT = (bf16*)(ws + A0_VGT); bf16* QS = (bf16*)(ws + A0_QS); bf16* KS = (bf16*)(ws + A0_KS); bf16* VST = (bf16*)(ws + A0_VST);
    const f32x2* rope = (const f32x2*)(ws + OFF_ROPE);
    const int tid = threadIdx.x, lane = tid & 63, wid = tid >> 6, wr = wid >> 1, wc = wid & 1, fr = lane & 15, fq = lane >> 4;
    constexpr int NTN = 19, NTM = TT / 128;
    for (int t = blockIdx.x; t < NTM * NTN; t += gridDim.x) {
        const int tm = t / NTN, tn = t % NTN, brow = tm * 128, bcol = tn * 128;
        const bf16 *a0, *a1, *b0, *b1; plain_ptrs(U, brow, DM, a0, a1); plain_ptrs(W, bcol, DM, b0, b1);
        f32x4 acc[4][4];
        gemm_core(lds, a0, a1, b0, b1, DM / 32, acc);
        const int cb = bcol + wc * 64;
#pragma unroll
        for (int m = 0; m < 4; ++m) {
            const int r = brow + wr * 64 + m * 16 + fr;
            const RowInfo ri = rowinfo(r);
            if (cb < 1024) {
#pragma unroll
                for (int n = 0; n < 4; ++n) { u32x2 w; w.x = pk2(acc[m][n][0], acc[m][n][1]); w.y = pk2(acc[m][n][2], acc[m][n][3]); *(u32x2*)(Z0 + (size_t)r * Z0P + cb + n * 16 + fq * 4) = w; }
            } else if (cb < 1536) {
                const int c0 = cb - 1024;
#pragma unroll
                for (int n = 0; n < 4; ++n)
#pragma unroll
                    for (int j = 0; j < 4; ++j) VGT[(size_t)(c0 + n * 16 + fq * 4 + j) * TT + r] = f2bf(acc[m][n][j]);
            } else if (cb < 2176) {
                f32x4 o[4];
#pragma unroll
                for (int n = 0; n < 2; ++n) {
#pragma unroll
                    for (int j = 0; j < 4; ++j) {
                        const float x1 = acc[m][n][j], x2 = acc[m][n + 2][j];
                        if (ri.lat) { const f32x2 cs = rope[(size_t)ri.pos * 32 + n * 16 + fq * 4 + j]; o[n][j] = x1 * cs.x - x2 * cs.y; o[n + 2][j] = x2 * cs.x + x1 * cs.y; }
                        else { o[n][j] = x1; o[n + 2][j] = x2; }
                    }
                }
                bf16* dst; float sc;
                if (cb < 2048) { const int h = (cb - 1536) >> 6; dst = QS + ((size_t)(ri.b * 8 + h) * NKEY + ri.kq) * 64; sc = 0.125f * LOG2E; }
                else { const int h = (cb - 2048) >> 6; dst = KS + ((size_t)(ri.b * 2 + h) * NKEY + ri.kq) * 64; sc = 1.f; }
#pragma unroll
                for (int n = 0; n < 4; ++n) { u32x2 w; w.x = pk2(o[n][0] * sc, o[n][1] * sc); w.y = pk2(o[n][2] * sc, o[n][3] * sc); *(u32x2*)(dst + n * 16 + fq * 4) = w; }
            } else if (cb < 2304) {
                const int h = (cb - 2176) >> 6;
                bf16* dst = VST + (size_t)(ri.b * 2 + h) * 64 * NKEY + ri.kq;
#pragma unroll
                for (int n = 0; n < 4; ++n)
#pragma unroll
                    for (int j = 0; j < 4; ++j) dst[(size_t)(n * 16 + fq * 4 + j) * NKEY] = f2bf(acc[m][n][j]);
            } else if (cb == 2304) {
#pragma unroll
                for (int n = 0; n < 2; ++n) { u32x2 w; w.x = pk2(acc[m][n][0], acc[m][n][1]); w.y = pk2(acc[m][n][2], acc[m][n][3]); *(u32x2*)(Z0 + (size_t)r * Z0P + 1024 + n * 16 + fq * 4) = w; }
            }
        }
    }
}

__device__ __forceinline__ void ph_outproj(const Params& p, LAS unsigned char* lds, const bf16* MIX, const bf16* W, float* Y, int row_lo) {
    const int tid = threadIdx.x, lane = tid & 63, wid = tid >> 6, wr = wid >> 1, wc = wid & 1, fr = lane & 15, fq = lane >> 4;
    const int tm0 = row_lo / 128, ntm = TT / 128 - tm0;
    for (int t = blockIdx.x; t < ntm * 8; t += gridDim.x) {
        const int tm = tm0 + t / 8, tn = t % 8, brow = tm * 128, bcol = tn * 128;
        const bf16 *a0, *a1, *b0, *b1; plain_ptrs(MIX, brow, DM, a0, a1); plain_ptrs(W, bcol, DM, b0, b1);
        f32x4 acc[4][4];
        gemm_core(lds, a0, a1, b0, b1, DM / 32, acc);
#pragma unroll
        for (int m = 0; m < 4; ++m) {
            const int r = brow + wr * 64 + m * 16 + fr;
#pragma unroll
            for (int n = 0; n < 4; ++n) *(f32x4*)(Y + (size_t)r * DM + bcol + wc * 64 + n * 16 + fq * 4) = acc[m][n];
        }
    }
}

template <int DQK, int DV>
__device__ __forceinline__ void attn_item(LAS unsigned char* lds, const bf16* Qg, const bf16* Kg, const bf16* VTg, int a1, int b0, int b1, int qpos0,
                                          float m_init, float l_init, bf16* Og, int o_pitch) {
    constexpr int KP = (DQK + 8) * 2, VP = 136, NS = DQK / 16, NDV = DV / 32, KCH = DQK / 8;
    const int tid = threadIdx.x, lane = tid & 63, wid = tid >> 6, ql = lane & 31, hi = lane >> 5;
    bf16x8 qf[NS];
    {
        const bf16* qrow = Qg + (size_t)(wid * 32 + ql) * DQK + hi * 8;
#pragma unroll
        for (int s = 0; s < NS; ++s) qf[s] = *(const bf16x8*)(qrow + s * 16);
    }
    f32x16 o[NDV];
#pragma unroll
    for (int d = 0; d < NDV; ++d)
#pragma unroll
        for (int r = 0; r < 16; ++r) o[d][r] = 0.f;
    float mrun = m_init, lrun = l_init;
    const int ntot = a1 + (b1 - b0);
    LAS unsigned char* Ks = lds; LAS unsigned char* Vs = lds + 64 * KP;
    for (int it = 0; it < ntot; ++it) {
        const int kt = it < a1 ? it : b0 + (it - a1);
        const bool masked = it >= a1;
        __syncthreads();
        for (int c = tid; c < 64 * KCH; c += 256) {
            const int key = c / KCH, ch = c % KCH;
            const u32x4 v = *(const u32x4*)(Kg + (size_t)(kt * 64 + key) * DQK + ch * 8);
            *(LAS u32x4*)(Ks + key * KP + ch * 16) = v;
        }
        for (int c = tid; c < DV * 8; c += 256) {
            const int dv = c >> 3, ch = c & 7;
            const u32x4 v = *(const u32x4*)(VTg + (size_t)dv * NKEY + kt * 64 + ch * 8);
            LAS u32x2* d = (LAS u32x2*)(Vs + dv * VP + ch * 16);
            d[0] = (u32x2){v.x, v.y}; d[1] = (u32x2){v.z, v.w};
        }
        __syncthreads();
        f32x16 p0, p1;
#pragma unroll
        for (int r = 0; r < 16; ++r) { p0[r] = 0.f; p1[r] = 0.f; }
#pragma unroll
        for (int s = 0; s < NS; ++s) {
            const bf16x8 k0 = *(const LAS bf16x8*)(Ks + ql * KP + (s * 16 + hi * 8) * 2);
            const bf16x8 k1 = *(const LAS bf16x8*)(Ks + (32 + ql) * KP + (s * 16 + hi * 8) * 2);
            p0 = __builtin_amdgcn_mfma_f32_32x32x16_bf16(k0, qf[s], p0, 0, 0, 0);
            p1 = __builtin_amdgcn_mfma_f32_32x32x16_bf16(k1, qf[s], p1, 0, 0, 0);
        }
        if (masked) {
            const int kbase = kt * 64 - CTX, qpos = qpos0 + wid * 32 + ql;
#pragma unroll
            for (int r = 0; r < 16; ++r) {
                const int d0 = qpos - (kbase + crow(r, hi)), d1 = d0 - 32;
                if (d0 > 128 || d0 < -128) p0[r] = -1e30f;
                if (d1 > 128 || d1 < -128) p1[r] = -1e30f;
            }
        }
        float mx = p0[0];
#pragma unroll
        for (int r = 1; r < 16; ++r) mx = fmaxf(mx, p0[r]);
#pragma unroll
        for (int r = 0; r < 16; ++r) mx = fmaxf(mx, p1[r]);
        mx = fmaxf(mx, __shfl_xor(mx, 32));
        const float mn = fmaxf(mrun, mx), alpha = ex2(mrun - mn);
        mrun = mn;
        float rs = 0.f;
#pragma unroll
        for (int r = 0; r < 16; ++r) { p0[r] = ex2(p0[r] - mn); rs += p0[r]; }
#pragma unroll
        for (int r = 0; r < 16; ++r) { p1[r] = ex2(p1[r] - mn); rs += p1[r]; }
        rs += __shfl_xor(rs, 32);
        lrun = lrun * alpha + rs;
#pragma unroll
        for (int d = 0; d < NDV; ++d)
#pragma unroll
            for (int r = 0; r < 16; ++r) o[d][r] *= alpha;
        bf16x8 pf[4];
        { u32x4 w;
          w.x = pk2(p0[0], p0[1]); w.y = pk2(p0[2], p0[3]); w.z = pk2(p0[4], p0[5]); w.w = pk2(p0[6], p0[7]); pf[0] = mk8(w);
          w.x = pk2(p0[8], p0[9]); w.y = pk2(p0[10], p0[11]); w.z = pk2(p0[12], p0[13]); w.w = pk2(p0[14], p0[15]); pf[1] = mk8(w);
          w.x = pk2(p1[0], p1[1]); w.y = pk2(p1[2], p1[3]); w.z = pk2(p1[4], p1[5]); w.w = pk2(p1[6], p1[7]); pf[2] = mk8(w);
          w.x = pk2(p1[8], p1[9]); w.y = pk2(p1[10], p1[11]); w.z = pk2(p1[12], p1[13]); w.w = pk2(p1[14], p1[15]); pf[3] = mk8(w); }
#pragma unroll
        for (int d = 0; d < NDV; ++d) {
#pragma unroll
            for (int kk = 0; kk < 4; ++kk) {
                const int keybase = kk * 16 + 4 * hi;
                const LAS unsigned char* vp = Vs + (d * 32 + ql) * VP + keybase * 2;
                const u32x2 lo = *(const LAS u32x2*)vp, hh = *(const LAS u32x2*)(vp + 16);
                const bf16x8 vf = mk8((u32x4){lo.x, lo.y, hh.x, hh.y});
                o[d] = __builtin_amdgcn_mfma_f32_32x32x16_bf16(vf, pf[kk], o[d], 0, 0, 0);
            }
        }
    }
    const float inv = 1.f / lrun;
    bf16* orow = Og + (size_t)(wid * 32 + ql) * o_pitch;
#pragma unroll
    for (int d = 0; d < NDV; ++d)
#pragma unroll
        for (int g = 0; g < 4; ++g) {
            u32x2 w; w.x = pk2(o[d][g * 4 + 0] * inv, o[d][g * 4 + 1] * inv); w.y = pk2(o[d][g * 4 + 2] * inv, o[d][g * 4 + 3] * inv);
            *(u32x2*)(orow + d * 32 + 8 * g + 4 * hi) = w;
        }
}

constexpr int GA_CUM = 0, GA_ALOW = 16384, GA_WA = 20480, GA_BA = 24576, GA_QT = 24832, GA_TOT = 25856, GA_END = 26112;
__device__ __forceinline__ void gla_cum(const Params& p, LAS unsigned char* lds, const bf16* Z0, int r0, int h, int dir) {
    const int tid = threadIdx.x;
    LAS float* cum = (LAS float*)(lds + GA_CUM); LAS float* alow = (LAS float*)(lds + GA_ALOW); LAS float* wa = (LAS float*)(lds + GA_WA);
    LAS float* ba = (LAS float*)(lds + GA_BA); LAS float* qt = (LAS float*)(lds + GA_QT); LAS float* tot = (LAS float*)(lds + GA_TOT);
    {
        const int t = tid >> 2, i4 = (tid & 3) * 4;
        const u32x2 w = *(const u32x2*)(Z0 + (size_t)(r0 + t) * Z0P + 1024 + dir * 16 + i4);
        alow[t * 16 + i4 + 0] = bflo(w.x); alow[t * 16 + i4 + 1] = bfhi(w.x); alow[t * 16 + i4 + 2] = bflo(w.y); alow[t * 16 + i4 + 3] = bfhi(w.y);
#pragma unroll
        for (int q = 0; q < 4; ++q) { const int idx = tid * 4 + q, i = idx >> 6, j = idx & 63; wa[idx] = p.gla_wa2[(size_t)(dir * 16 + i) * 256 + h * 64 + j]; }
        if (tid < 64) ba[tid] = p.gla_ba[dir * 256 + h * 64 + tid];
    }
    __syncthreads();
    const int j = tid & 63, tq = tid >> 6;
    float la[16];
#pragma unroll
    for (int tt = 0; tt < 16; ++tt) {
        const int t = tq * 16 + tt;
        float x = ba[j];
#pragma unroll
        for (int i = 0; i < 16; ++i) x += alow[t * 16 + i] * wa[i * 64 + j];
        la[tt] = (fminf(x, 0.f) - log1pf(expf(-fabsf(x)))) * (1.f / 16.f);
    }
    float run = 0.f;
    if (dir == 0) {
#pragma unroll
        for (int tt = 0; tt < 16; ++tt) { run += la[tt]; cum[(tq * 16 + tt) * 64 + j] = run; }
    } else {
#pragma unroll
        for (int tt = 15; tt >= 0; --tt) { run += la[tt]; cum[(tq * 16 + tt) * 64 + j] = run; }
    }
    qt[tq * 64 + j] = run;
    __syncthreads();
    float off = 0.f, total = 0.f;
#pragma unroll
    for (int q = 0; q < 4; ++q) { const float v = qt[q * 64 + j]; total += v; if (dir == 0 ? (q < tq) : (q > tq)) off += v; }
#pragma unroll
    for (int tt = 0; tt < 16; ++tt) cum[(tq * 16 + tt) * 64 + j] += off;
    if (tq == 0) tot[j] = total;
    __syncthreads();
}

__device__ __forceinline__ int gla_row0(int b, int cc) { return cc < 4 ? b * CTX + cc * 64 : TC + b * SEQ + (cc - 4) * 64; }
__device__ __forceinline__ int gla_step(int cc, int dir) { return dir == 0 ? cc : (cc < 4 ? 3 - cc : 4 + (131 - cc)); }

__device__ __forceinline__ void gla_g1_item(const Params& p, LAS unsigned char* lds, int item) {
    unsigned char* ws = p.ws;
    const bf16* Z0 = (const bf16*)(ws + A0_Z0); const bf16* VGT = (const bf16*)(ws + A0_VGT);
    float* GS = (float*)(ws + A0_GS); float* GD = (float*)(ws + A0_GD);
    const int cc = item % NSTEP, rest = item / NSTEP, dir = rest & 1, h = (rest >> 1) & 3, b = rest >> 3;
    const int r0 = gla_row0(b, cc), step = gla_step(cc, dir), chain = (b * 4 + h) * 2 + dir;
    const int tid = threadIdx.x, lane = tid & 63, wid = tid >> 6, fr = lane & 15, fq = lane >> 4;
    __syncthreads();
    gla_cum(p, lds, Z0, r0, h, dir);
    LAS float* cum = (LAS float*)(lds + GA_CUM); LAS float* tot = (LAS float*)(lds + GA_TOT);
    LAS bf16* KT = (LAS bf16*)(lds + GA_END);
    {
        const int t = tid >> 2, d0 = (tid & 3) * 16;
        const u32x4 w0 = *(const u32x4*)(Z0 + (size_t)(r0 + t) * Z0P + 256 + h * 64 + d0), w1 = *(const u32x4*)(Z0 + (size_t)(r0 + t) * Z0P + 256 + h * 64 + d0 + 8);
        const unsigned ww[8] = {w0.x, w0.y, w0.z, w0.w, w1.x, w1.y, w1.z, w1.w};
#pragma unroll
        for (int i = 0; i < 8; ++i) {
            const int d = d0 + 2 * i;
            KT[d * 72 + t] = f2bf(bflo(ww[i]) * __expf(tot[d] - cum[t * 64 + d]));
            KT[(d + 1) * 72 + t] = f2bf(bfhi(ww[i]) * __expf(tot[d + 1] - cum[t * 64 + d + 1]));
        }
    }
    if (tid < 64) GD[((size_t)chain * NSTEP + step) * 64 + tid] = __expf(tot[tid]);
    __syncthreads();
    f32x4 acc[2][4];
#pragma unroll
    for (int m = 0; m < 2; ++m)
#pragma unroll
        for (int n = 0; n < 4; ++n) acc[m][n] = (f32x4){0.f, 0.f, 0.f, 0.f};
#pragma unroll
    for (int ks = 0; ks < 2; ++ks) {
        bf16x8 af[2], bfr[4];
#pragma unroll
        for (int m = 0; m < 2; ++m) af[m] = *(const bf16x8*)(VGT + (size_t)(h * 128 + wid * 32 + m * 16 + fr) * TT + r0 + ks * 32 + fq * 8);
#pragma unroll
        for (int n = 0; n < 4; ++n) bfr[n] = *(const LAS bf16x8*)(KT + (n * 16 + fr) * 72 + ks * 32 + fq * 8);
#pragma unroll
        for (int m = 0; m < 2; ++m)
#pragma unroll
            for (int n = 0; n < 4; ++n) acc[m][n] = __builtin_amdgcn_mfma_f32_16x16x32_bf16(bfr[n], af[m], acc[m][n], 0, 0, 0);
    }
    float* dst = GS + ((size_t)chain * NSTEP + step) * 8192;
#pragma unroll
    for (int m = 0; m < 2; ++m)
#pragma unroll
        for (int n = 0; n < 4; ++n) *(f32x4*)(dst + (size_t)(wid * 32 + m * 16 + fr) * 64 + n * 16 + fq * 4) = acc[m][n];
}

__device__ __forceinline__ void ph_gla_scan(const Params& p) {
    float* GS = (float*)(p.ws + A0_GS); const float* GD = (const float*)(p.ws + A0_GD);
    for (int idx = blockIdx.x * 256 + threadIdx.x; idx < 16 * 8192; idx += gridDim.x * 256) {
        const int chain = idx >> 13, e = idx & 8191, dk = e & 63;
        float* g = GS + (size_t)chain * NSTEP * 8192 + e;
        const float* d = GD + (size_t)chain * NSTEP * 64 + dk;
        float st = 0.f;
#pragma unroll 6
        for (int s = 0; s < NSTEP; ++s) { const float t = g[(size_t)s * 8192]; const float dec = d[s * 64]; g[(size_t)s * 8192] = st; st = dec * st + t; }
    }
}

__device__ __forceinline__ void gla_g3_item(const Params& p, LAS unsigned char* lds, int item) {
    unsigned char* ws = p.ws;
    const bf16* Z0 = (const bf16*)(ws + A0_Z0); const bf16* VGT = (const bf16*)(ws + A0_VGT);
    const float* GS = (const float*)(ws + A0_GS); bf16* MIX = (bf16*)(ws + A0_MIX);
    const int cc = item % NSTEP, rest = item / NSTEP, h = rest & 3, b = rest >> 2;
    const int r0 = gla_row0(b, cc);
    const int tid = threadIdx.x, lane = tid & 63, wid = tid >> 6, fr = lane & 15, fq = lane >> 4;
    LAS bf16* QT = (LAS bf16*)(lds + GA_END);
    LAS bf16* QI = (LAS bf16*)(lds + GA_END + 9216);
    LAS bf16* KT = (LAS bf16*)(lds + GA_END + 18432);
    LAS bf16* PP = (LAS bf16*)(lds);
    f32x4 o[4][2];
#pragma unroll
    for (int m = 0; m < 4; ++m)
#pragma unroll
        for (int n = 0; n < 2; ++n) o[m][n] = (f32x4){0.f, 0.f, 0.f, 0.f};
    for (int dir = 0; dir < 2; ++dir) {
        const int step = gla_step(cc, dir), chain = (b * 4 + h) * 2 + dir;
        __syncthreads();
        gla_cum(p, lds, Z0, r0, h, dir);
        LAS float* cum = (LAS float*)(lds + GA_CUM); LAS float* tot = (LAS float*)(lds + GA_TOT);
        {
            const int t = tid >> 2, d0 = (tid & 3) * 16;
            const bf16* zr = Z0 + (size_t)(r0 + t) * Z0P + h * 64 + d0;
            const u32x4 q0 = *(const u32x4*)(zr), q1 = *(const u32x4*)(zr + 8), k0 = *(const u32x4*)(zr + 256), k1 = *(const u32x4*)(zr + 264);
            const unsigned qq[8] = {q0.x, q0.y, q0.z, q0.w, q1.x, q1.y, q1.z, q1.w}, kk[8] = {k0.x, k0.y, k0.z, k0.w, k1.x, k1.y, k1.z, k1.w};
            unsigned oqt[8], oqi[8], okt[8];
#pragma unroll
            for (int i = 0; i < 8; ++i) {
                const int d = d0 + 2 * i;
                const float c0 = cum[t * 64 + d], c1 = cum[t * 64 + d + 1], t0 = tot[d], t1 = tot[d + 1];
                const float qa = bflo(qq[i]), qb = bfhi(qq[i]), ka = bflo(kk[i]), kb = bfhi(kk[i]);
                oqt[i] = pk2(qa * __expf(c0 - t0), qb * __expf(c1 - t1));
                oqi[i] = pk2(qa * __expf(c0), qb * __expf(c1));
                okt[i] = pk2(ka * __expf(t0 - c0), kb * __expf(t1 - c1));
            }
            *(LAS u32x4*)(QT + t * 72 + d0) = (u32x4){oqt[0], oqt[1], oqt[2], oqt[3]}; *(LAS u32x4*)(QT + t * 72 + d0 + 8) = (u32x4){oqt[4], oqt[5], oqt[6], oqt[7]};
            *(LAS u32x4*)(QI + t * 72 + d0) = (u32x4){oqi[0], oqi[1], oqi[2], oqi[3]}; *(LAS u32x4*)(QI + t * 72 + d0 + 8) = (u32x4){oqi[4], oqi[5], oqi[6], oqi[7]};
            *(LAS u32x4*)(KT + t * 72 + d0) = (u32x4){okt[0], okt[1], okt[2], okt[3]}; *(LAS u32x4*)(KT + t * 72 + d0 + 8) = (u32x4){okt[4], okt[5], okt[6], okt[7]};
        }
        __syncthreads();
        {
            f32x4 sa[4];
#pragma unroll
            for (int m = 0; m < 4; ++m) sa[m] = (f32x4){0.f, 0.f, 0.f, 0.f};
#pragma unroll
            for (int ks = 0; ks < 2; ++ks) {
                const bf16x8 kf = *(const LAS bf16x8*)(KT + (wid * 16 + fr) * 72 + ks * 32 + fq * 8);
#pragma unroll
                for (int m = 0; m < 4; ++m) {
                    const bf16x8 qfm = *(const LAS bf16x8*)(QT + (m * 16 + fr) * 72 + ks * 32 + fq * 8);
                    sa[m] = __builtin_amdgcn_mfma_f32_16x16x32_bf16(kf, qfm, sa[m], 0, 0, 0);
                }
            }
#pragma unroll
            for (int m = 0; m < 4; ++m) {
                const int t = m * 16 + fr;
                float v[4];
#pragma unroll
                for (int jj = 0; jj < 4; ++jj) { const int j = wid * 16 + fq * 4 + jj; const bool keep = dir == 0 ? (j <= t) : (j >= t); v[jj] = keep ? sa[m][jj] : 0.f; }
                *(LAS u32x2*)(PP + t * 72 + wid * 16 + fq * 4) = (u32x2){pk2(v[0], v[1]), pk2(v[2], v[3])};
            }
        }
        __syncthreads();
        const float* Sg = GS + ((size_t)chain * NSTEP + step) * 8192;
#pragma unroll
        for (int ks = 0; ks < 2; ++ks) {
            bf16x8 vfr[2], sfr[2];
#pragma unroll
            for (int n = 0; n < 2; ++n) {
                const int dv = wid * 32 + n * 16 + fr;
                vfr[n] = *(const bf16x8*)(VGT + (size_t)(h * 128 + dv) * TT + r0 + ks * 32 + fq * 8);
                const f32x4 s0 = *(const f32x4*)(Sg + (size_t)dv * 64 + ks * 32 + fq * 8), s1 = *(const f32x4*)(Sg + (size_t)dv * 64 + ks * 32 + fq * 8 + 4);
                sfr[n] = mk8((u32x4){pk2(s0.x, s0.y), pk2(s0.z, s0.w), pk2(s1.x, s1.y), pk2(s1.z, s1.w)});
            }
#pragma unroll
            for (int m = 0; m < 4; ++m) {
                const bf16x8 pfm = *(const LAS bf16x8*)(PP + (m * 16 + fr) * 72 + ks * 32 + fq * 8);
                const bf16x8 qim = *(const LAS bf16x8*)(QI + (m * 16 + fr) * 72 + ks * 32 + fq * 8);
#pragma unroll
                for (int n = 0; n < 2; ++n) {
                    o[m][n] = __builtin_amdgcn_mfma_f32_16x16x32_bf16(vfr[n], pfm, o[m][n], 0, 0, 0);
                    o[m][n] = __builtin_amdgcn_mfma_f32_16x16x32_bf16(sfr[n], qim, o[m][n], 0, 0, 0);
                }
            }
        }
    }
    __syncthreads();
    LAS float* red = (LAS float*)(lds + GA_END + 27648);
#pragma unroll
    for (int m = 0; m < 4; ++m) {
        float s = 0.f;
#pragma unroll
        for (int n = 0; n < 2; ++n)
#pragma unroll
            for (int j = 0; j < 4; ++j) s += o[m][n][j] * o[m][n][j];
        s += __shfl_xor(s, 16); s += __shfl_xor(s, 32);
        if (fq == 0) red[wid * 64 + m * 16 + fr] = s;
    }
    __syncthreads();
#pragma unroll
    for (int m = 0; m < 4; ++m) {
        const int t = m * 16 + fr;
        const float ss = red[t] + red[64 + t] + red[128 + t] + red[192 + t];
        const float rinv = rsqrtf(ss * (1.f / 128.f) + RMS_EPS);
        const int r = r0 + t;
#pragma unroll
        for (int n = 0; n < 2; ++n) {
            const int dv = wid * 32 + n * 16 + fq * 4;
            const u32x2 gw = *(const u32x2*)(Z0 + (size_t)r * Z0P + 512 + h * 128 + dv);
            const f32x4 ng = *(const f32x4*)(p.gla_norm + dv);
            const float g0 = bflo(gw.x), g1 = bfhi(gw.x), g2 = bflo(gw.y), g3 = bfhi(gw.y);
            const float y0 = o[m][n][0] * rinv * ng.x * siluf(g0), y1 = o[m][n][1] * rinv * ng.y * siluf(g1);
            const float y2 = o[m][n][2] * rinv * ng.z * siluf(g2), y3 = o[m][n][3] * rinv * ng.w * siluf(g3);
            *(u32x2*)(MIX + (size_t)r * DM + h * 128 + dv) = (u32x2){pk2(y0, y1), pk2(y2, y3)};
        }
    }
}

__device__ __forceinline__ void ph_swa_g1(const Params& p, LAS unsigned char* lds) {
    unsigned char* ws = p.ws;
    const bf16* QS = (const bf16*)(ws + A0_QS); const bf16* KS = (const bf16*)(ws + A0_KS); const bf16* VST = (const bf16*)(ws + A0_VST); bf16* MIX = (bf16*)(ws + A0_MIX);
    constexpr int N_SWA = 2 * 8 * 66, N_G1 = 2 * 4 * 2 * NSTEP;
    for (int item = blockIdx.x; item < N_SWA + N_G1; item += gridDim.x) {
        if (item < N_SWA) {
            const int qt = item % 66, rest = item / 66, h = rest & 7, b = rest >> 3, kvh = h >> 2;
            const bf16* Qg = QS + ((size_t)(b * 8 + h) * NKEY + qt * 128) * 64;
            const bf16* Kg = KS + (size_t)(b * 2 + kvh) * NKEY * 64;
            const bf16* Vg = VST + (size_t)(b * 2 + kvh) * 64 * NKEY;
            int b0 = 0, b1 = 0, qpos0 = 0, row0;
            if (qt >= 2) { qpos0 = (qt - 2) * 128; const int lo = qpos0 - 128 < 0 ? 0 : qpos0 - 128, hi2 = qpos0 + 256 > SEQ ? SEQ : qpos0 + 256; b0 = 4 + lo / 64; b1 = 4 + hi2 / 64; row0 = TC + b * SEQ + qpos0; }
            else row0 = b * CTX + qt * 128;
            const float sink = p.swa_sink[h] * LOG2E;
            attn_item<64, 64>(lds, Qg, Kg, Vg, 4, b0, b1, qpos0, sink, 1.f, MIX + (size_t)row0 * DM + 512 + h * 64, DM);
        } else gla_g1_item(p, lds, item - N_SWA);
    }
}
__device__ __forceinline__ void ph_gla_g3(const Params& p, LAS unsigned char* lds) {
    for (int item = blockIdx.x; item < 2 * 4 * NSTEP; item += gridDim.x) gla_g3_item(p, lds, item);
}

__device__ __forceinline__ void ph_router(const Params& p, LAS unsigned char* lds, int l, int row_lo) {
    unsigned char* ws = p.ws;
    const bf16* U = (const bf16*)(ws + OFF_U); const bf16* W = (const bf16*)(ws + OFF_W_RT) + (size_t)l * 128 * DM;
    int* cntg = (int*)(ws + OFF_CNT) + l * 64; int* tokslot = (int*)(ws + OFF_TOKSLOT); float* W8 = (float*)(ws + OFF_W8); int* LIST = (int*)(ws + OFF_LIST);
    const int tid = threadIdx.x, lane = tid & 63, wid = tid >> 6, wr = wid >> 1, wc = wid & 1, fr = lane & 15, fq = lane >> 4;
    LAS float* lg = (LAS float*)lds;
    LAS int* ebuf = (LAS int*)(lds + 34816) + wid * 256;
    LAS float* wbuf = (LAS float*)(lds + 34816 + 4096) + wid * 256;
    const float bias = p.b_router[l * 64 + lane];
    const int tm0 = row_lo / 128;
    for (int tm = tm0 + blockIdx.x; tm < TT / 128; tm += gridDim.x) {
        const int brow = tm * 128;
        const bf16 *a0, *a1, *b0, *b1; plain_ptrs(U, brow, DM, a0, a1); plain_ptrs(W, 0, DM, b0, b1);
        f32x4 acc[4][4];
        __syncthreads();
        gemm_core(lds, a0, a1, b0, b1, DM / 32, acc);
        if (wc == 0) {
#pragma unroll
            for (int m = 0; m < 4; ++m)
#pragma unroll
                for (int n = 0; n < 4; ++n)
#pragma unroll
                    for (int j = 0; j < 4; ++j) lg[(wr * 64 + m * 16 + fr) * 65 + n * 16 + fq * 4 + j] = acc[m][n][j];
        }
        __syncthreads();
        unsigned mask = 0u;
        for (int rr = 0; rr < 32; ++rr) {
            const float logit = lg[(wid * 32 + rr) * 65 + lane];
            const float score = 1.f / (1.f + expf(-logit));
            const float sel = score + bias;
            int rin = 0;
#pragma unroll
            for (int i = 0; i < 8; ++i) { const float ov = __shfl(sel, (lane & ~7) | i); rin += (ov > sel || (ov == sel && i < (lane & 7))) ? 1 : 0; }
            float gs = rin < 2 ? sel : 0.f;
            gs += __shfl_xor(gs, 1); gs += __shfl_xor(gs, 2); gs += __shfl_xor(gs, 4);
            int grk = 0;
#pragma unroll
            for (int g = 0; g < 8; ++g) { const float og = __shfl(gs, g * 8); grk += (og > gs || (og == gs && g < (lane >> 3))) ? 1 : 0; }
            const bool allowed = grk < 4;
            const float sm = allowed ? sel : -INFINITY;
            int rk = 0;
#pragma unroll 16
            for (int i = 0; i < 64; ++i) { const float ov = __shfl(sm, i); rk += (ov > sm || (ov == sm && i < lane)) ? 1 : 0; }
            const bool selected = allowed && rk < 8;
            const float wsum = wave_sum(selected ? score : 0.f);
            if (selected) { mask |= 1u << rr; ebuf[rr * 8 + rk] = lane; wbuf[rr * 8 + rk] = score / wsum * 2.5f; }
        }
        const int nsel = __popc(mask);
        int base = 0;
        if (nsel > 0) base = atomicAdd(cntg + lane, nsel);
        asm volatile("s_waitcnt lgkmcnt(0)" ::: "memory");
#pragma unroll
        for (int q = 0; q < 4; ++q) {
            const int ent = q * 64 + lane, rr = ent >> 3, rk = ent & 7;
            const int e = ebuf[ent]; const float w = wbuf[ent];
            const int be = __shfl(base, e); const unsigned me = (unsigned)__shfl((int)mask, e);
            const int pos = be + __popc(me & ((1u << rr) - 1u));
            const int t = brow + wid * 32 + rr;
            tokslot[(size_t)t * 8 + rk] = (e << 20) | pos;
            W8[(size_t)t * 8 + rk] = w;
            LIST[(size_t)e * TT + pos] = t * 8 + rk;
        }
    }
}

__device__ __forceinline__ int moe_find_expert(const LAS int* tp, int mtg) {
    int lo = 0, hi = 64;
    while (lo < hi) { const int mid = (lo + hi + 1) >> 1; if (tp[mid] <= mtg) lo = mid; else hi = mid - 1; }
    return lo;
}
__device__ __forceinline__ void ph_moe1(const Params& p, LAS unsigned char* lds, int l, int row_lo) {
    unsigned char* ws = p.ws;
    moe_tables(p, lds, l, row_lo);
    LAS int* cnt = (LAS int*)(lds + MOE_LDS_OFF); LAS int* tp = cnt + 80; LAS int* sp = tp + 80;
    const bf16* U = (const bf16*)(ws + OFF_U); const bf16* WGU = (const bf16*)(ws + OFF_W_GU); bf16* HM = (bf16*)(ws + AM_HM);
    const int* LIST = (const int*)(ws + OFF_LIST);
    const int tid = threadIdx.x, lane = tid & 63, wid = tid >> 6, wr = wid >> 1, wc = wid & 1, fr = lane & 15, fq = lane >> 4;
    const int ntiles = tp[65] * 4;
    for (int t = blockIdx.x; t < ntiles; t += gridDim.x) {
        const int mtg = t >> 2, nt = t & 3, e = moe_find_expert(tp, mtg), mt = mtg - tp[e], ce = cnt[e];
        const bf16 *a0, *a1, *b0, *b1;
        {
            const int i0 = mt * 128 + (tid >> 2), i1 = i0 + 64;
            int tk0 = row_lo, tk1 = row_lo;
            if (e < 64) { if (i0 < ce) tk0 = LIST[(size_t)e * TT + i0] >> 3; if (i1 < ce) tk1 = LIST[(size_t)e * TT + i1] >> 3; }
            else { if (i0 < ce) tk0 = row_lo + i0; if (i1 < ce) tk1 = row_lo + i1; }
            a0 = U + (size_t)tk0 * DM + (tid & 3) * 8; a1 = U + (size_t)tk1 * DM + (tid & 3) * 8;
        }
        plain_ptrs(WGU + (size_t)e * 512 * DM, nt * 128, DM, b0, b1);
        f32x4 acc[4][4];
        gemm_core(lds, a0, a1, b0, b1, DM / 32, acc);
        const size_t slot0 = e < 64 ? (size_t)(sp[e] + mt * 128) : (size_t)TT * 8 + row_lo + mt * 128;
        const int hc0 = nt * 64 + wc * 32;
#pragma unroll
        for (int m = 0; m < 4; ++m) {
            const int i = wr * 64 + m * 16 + fr;
            if (mt * 128 + i < ce) {
#pragma unroll
                for (int n = 0; n < 2; ++n) {
                    const f32x4 g = acc[m][n], u = acc[m][n + 2];
                    const u32x2 w = {pk2(siluf(g[0]) * u[0], siluf(g[1]) * u[1]), pk2(siluf(g[2]) * u[2], siluf(g[3]) * u[3])};
                    *(u32x2*)(HM + (slot0 + i) * 256 + hc0 + n * 16 + fq * 4) = w;
                }
            }
        }
    }
}
__device__ __forceinline__ void ph_moe2(const Params& p, LAS unsigned char* lds, int l, int row_lo) {
    unsigned char* ws = p.ws;
    moe_tables(p, lds, l, row_lo);
    LAS int* cnt = (LAS int*)(lds + MOE_LDS_OFF); LAS int* tp = cnt + 80; LAS int* sp = tp + 80;
    const bf16* HM = (const bf16*)(ws + AM_HM); const bf16* WD = (const bf16*)(ws + OFF_W_D); bf16* YR = (bf16*)(ws + AM_YR);
    const int* LIST = (const int*)(ws + OFF_LIST); const float* W8 = (const float*)(ws + OFF_W8);
    const int tid = threadIdx.x, lane = tid & 63, wid = tid >> 6, wr = wid >> 1, wc = wid & 1, fr = lane & 15, fq = lane >> 4;
    const int ntiles = tp[65] * 8;
    for (int t = blockIdx.x; t < ntiles; t += gridDim.x) {
        const int mtg = t >> 3, nt = t & 7, e = moe_find_expert(tp, mtg), mt = mtg - tp[e], ce = cnt[e];
        const size_t slot0 = e < 64 ? (size_t)(sp[e] + mt * 128) : (size_t)TT * 8 + row_lo + mt * 128;
        const bf16 *a0, *a1, *b0, *b1;
        a0 = HM + (slot0 + (tid >> 2)) * 256 + (tid & 3) * 8; a1 = a0 + 64 * 256;
        plain_ptrs(WD + (size_t)e * DM * 256, nt * 128, 256, b0, b1);
        f32x4 acc[4][4];
        gemm_core(lds, a0, a1, b0, b1, 256 / 32, acc);
#pragma unroll
        for (int m = 0; m < 4; ++m) {
            const int i = wr * 64 + m * 16 + fr, li = mt * 128 + i;
            if (li < ce) {
                const float w = e < 64 ? W8[LIST[(size_t)e * TT + li]] : 1.f;
#pragma unroll
                for (int n = 0; n < 4; ++n) {
                    const f32x4 a = acc[m][n] * w;
                    *(u32x2*)(YR + (slot0 + i) * DM + nt * 128 + wc * 64 + n * 16 + fq * 4) = (u32x2){pk2(a[0], a[1]), pk2(a[2], a[3])};
                }
            }
        }
    }
}

__device__ __forceinline__ void ph_inproj1(const Params& p, LAS unsigned char* lds) {
    unsigned char* ws = p.ws;
    const bf16* U = (const bf16*)(ws + OFF_U); const bf16* W = (const bf16*)(ws + OFF_W_IN_O);
    bf16* Z1 = (bf16*)(ws + A1_Z1); bf16* KM = (bf16*)(ws + A1_KM);
    const f32x2* rope = (const f32x2*)(ws + OFF_ROPE);
    const int tid = threadIdx.x, lane = tid & 63, wid = tid >> 6, wr = wid >> 1, wc = wid & 1, fr = lane & 15, fq = lane >> 4;
    constexpr int NTN = 7, NTM = TT / 128;
    for (int t = blockIdx.x; t < NTM * NTN; t += gridDim.x) {
        const int tm = t / NTN, tn = t % NTN, brow = tm * 128, bcol = tn * 128;
        const bf16 *a0, *a1, *b0, *b1; plain_ptrs(U, brow, DM, a0, a1); plain_ptrs(W, bcol, DM, b0, b1);
        f32x4 acc[4][4];
        gemm_core(lds, a0, a1, b0, b1, DM / 32, acc);
        const int cb = bcol + wc * 64;
#pragma unroll
        for (int m = 0; m < 4; ++m) {
            const int r = brow + wr * 64 + m * 16 + fr;
            if (cb < 768) {
#pragma unroll
                for (int n = 0; n < 4; ++n) *(u32x2*)(Z1 + (size_t)r * Z1P + cb + n * 16 + fq * 4) = (u32x2){pk2(acc[m][n][0], acc[m][n][1]), pk2(acc[m][n][2], acc[m][n][3])};
            } else if (cb == 768) {
                const RowInfo ri = rowinfo(r);
                f32x4 o[4];
#pragma unroll
                for (int n = 0; n < 2; ++n)
#pragma unroll
                    for (int j = 0; j < 4; ++j) {
                        const float x1 = acc[m][n][j], x2 = acc[m][n + 2][j];
                        if (ri.lat) { const f32x2 cs = rope[(size_t)ri.pos * 32 + n * 16 + fq * 4 + j]; o[n][j] = x1 * cs.x - x2 * cs.y; o[n + 2][j] = x2 * cs.x + x1 * cs.y; }
                        else { o[n][j] = x1; o[n + 2][j] = x2; }
                    }
#pragma unroll
                for (int h = 0; h < 8; ++h) {
                    bf16* dst = KM + ((size_t)(ri.b * 8 + h) * NKEY + ri.kq) * 192 + 128;
#pragma unroll
                    for (int n = 0; n < 4; ++n) *(u32x2*)(dst + n * 16 + fq * 4) = (u32x2){pk2(o[n][0], o[n][1]), pk2(o[n][2], o[n][3])};
                }
            }
        }
    }
}

__device__ __forceinline__ void ph_mla_up(const Params& p, LAS unsigned char* lds) {
    unsigned char* ws = p.ws;
    const bf16* Z1 = (const bf16*)(ws + A1_Z1); const bf16* WQ = (const bf16*)(ws + OFF_W_UQ); const bf16* WKV = (const bf16*)(ws + OFF_W_UKV);
    bf16* QM = (bf16*)(ws + A1_QM); bf16* KM = (bf16*)(ws + A1_KM); bf16* VTM = (bf16*)(ws + A1_VTM);
    const f32x2* rope = (const f32x2*)(ws + OFF_ROPE);
    const int tid = threadIdx.x, lane = tid & 63, wid = tid >> 6, wr = wid >> 1, wc = wid & 1, fr = lane & 15, fq = lane >> 4;
    LAS float* rsb = (LAS float*)(lds + 32768);
    constexpr int NQ = (TL / 128) * 12, NKV = (TT / 128) * 16;
    constexpr float QSCALE = 0.07216878364870322f * LOG2E;
    for (int t = blockIdx.x; t < NQ + NKV; t += gridDim.x) {
        const bool isq = t < NQ;
        int tm, tn;
        if (isq) { tm = 4 + t / 12; tn = t % 12; } else { const int u = t - NQ; tm = u / 16; tn = u % 16; }
        const int brow = tm * 128, bcol = tn * 128, K = isq ? 512 : 256, acol = isq ? 0 : 512;
        __syncthreads();
        {
            const int row = tid >> 1, half = tid & 1;
            const bf16* ap = Z1 + (size_t)(brow + row) * Z1P + acol + half * (K / 2);
            float ss = 0.f;
            for (int c = 0; c < K / 2; c += 8) { const u32x4 w = *(const u32x4*)(ap + c);
                const float v0 = bflo(w.x), v1 = bfhi(w.x), v2 = bflo(w.y), v3 = bfhi(w.y), v4 = bflo(w.z), v5 = bfhi(w.z), v6 = bflo(w.w), v7 = bfhi(w.w);
                ss += v0 * v0 + v1 * v1 + v2 * v2 + v3 * v3 + v4 * v4 + v5 * v5 + v6 * v6 + v7 * v7; }
            ss += __shfl_xor(ss, 1);
            if (half == 0) rsb[row] = rsqrtf(ss / (float)K + RMS_EPS);
        }
        const bf16 *a0, *a1, *b0, *b1; plain_ptrs(Z1 + acol, brow, Z1P, a0, a1); plain_ptrs(isq ? WQ : WKV, bcol, K, b0, b1);
        f32x4 acc[4][4];
        gemm_core(lds, a0, a1, b0, b1, K / 32, acc);
        const int cb = bcol + wc * 64;
#pragma unroll
        for (int m = 0; m < 4; ++m) {
            const int i = wr * 64 + m * 16 + fr, r = brow + i;
            const RowInfo ri = rowinfo(r);
            const float rs = rsb[i];
            if (isq) {
                const int h = cb / 192, part = (cb % 192) >> 6;
                bf16* dst = QM + ((size_t)(ri.b * 8 + h) * SEQ + ri.pos) * 192 + part * 64;
                const float sc = rs * QSCALE;
                if (part < 2) {
#pragma unroll
                    for (int n = 0; n < 4; ++n) *(u32x2*)(dst + n * 16 + fq * 4) = (u32x2){pk2(acc[m][n][0] * sc, acc[m][n][1] * sc), pk2(acc[m][n][2] * sc, acc[m][n][3] * sc)};
                } else {
                    f32x4 o[4];
#pragma unroll
                    for (int n = 0; n < 2; ++n)
#pragma unroll
                        for (int j = 0; j < 4; ++j) {
                            const float x1 = acc[m][n][j] * sc, x2 = acc[m][n + 2][j] * sc;
                            const f32x2 cs = rope[(size_t)ri.pos * 32 + n * 16 + fq * 4 + j];
                            o[n][j] = x1 * cs.x - x2 * cs.y; o[n + 2][j] = x2 * cs.x + x1 * cs.y;
                        }
#pragma unroll
                    for (int n = 0; n < 4; ++n) *(u32x2*)(dst + n * 16 + fq * 4) = (u32x2){pk2(o[n][0], o[n][1]), pk2(o[n][2], o[n][3])};
                }
            } else {
                const int h = cb >> 8, part = (cb & 255) >> 6;
                if (part < 2) {
                    bf16* dst = KM + ((size_t)(ri.b * 8 + h) * NKEY + ri.kq) * 192 + part * 64;
#pragma unroll
                    for (int n = 0; n < 4; ++n) *(u32x2*)(dst + n * 16 + fq * 4) = (u32x2){pk2(acc[m][n][0] * rs, acc[m][n][1] * rs), pk2(acc[m][n][2] * rs, acc[m][n][3] * rs)};
                } else {
                    bf16* dst = VTM + ((size_t)(ri.b * 8 + h) * 128 + (part - 2) * 64) * NKEY + ri.kq;
#pragma unroll
                    for (int n = 0; n < 4; ++n)
#pragma unroll
                        for (int j = 0; j < 4; ++j) dst[(size_t)(n * 16 + fq * 4 + j) * NKEY] = f2bf(acc[m][n][j] * rs);
                }
            }
        }
    }
}

__device__ __forceinline__ void ph_mla_attn(const Params& p, LAS unsigned char* lds) {
    unsigned char* ws = p.ws;
    const bf16* QM = (const bf16*)(ws + A1_QM); const bf16* KM = (const bf16*)(ws + A1_KM); const bf16* VTM = (const bf16*)(ws + A1_VTM); bf16* MIX = (bf16*)(ws + A1_MIX);
    for (int item = blockIdx.x; item < 2 * 8 * 64; item += gridDim.x) {
        const int qt = item & 63, h = (item >> 6) & 7, b = item >> 9;
        const bf16* Qg = QM + ((size_t)(b * 8 + h) * SEQ + qt * 128) * 192;
        const bf16* Kg = KM + (size_t)(b * 8 + h) * NKEY * 192;
        const bf16* Vg = VTM + (size_t)(b * 8 + h) * 128 * NKEY;
        attn_item<192, 128>(lds, Qg, Kg, Vg, NKEY / 64, 0, 0, 0, -1e30f, 0.f, MIX + (size_t)(TC + b * SEQ + qt * 128) * DM + h * 128, DM);
    }
}


#define XB_TMO      128
#define XB_XCNT(j)  (256  + 64 * (j))
#define XB_XSUB(j)  (1280 + 64 * (j))
#define XB_XGEN(j)  (2304 + 64 * (j))
#define XB_TOP      3328
#define XB_TOPGEN   3392
#define XCD_BAR_WORDS 3456
#define XB_SPIN_CAP (1u << 18)
__device__ __forceinline__ unsigned xb_ld(unsigned* p)              { return __hip_atomic_load(p, __ATOMIC_RELAXED, __HIP_MEMORY_SCOPE_AGENT); }
__device__ __forceinline__ unsigned xb_add(unsigned* p, unsigned v) { return __hip_atomic_fetch_add(p, v, __ATOMIC_RELAXED, __HIP_MEMORY_SCOPE_AGENT); }
__device__ __forceinline__ unsigned xb_xcc_id() { return (unsigned)__builtin_amdgcn_s_getreg((3 << 11) | 20) & 0xFu; }
#define XB_SPIN(cond, bar) do { unsigned _sp = 0; while (cond) { __builtin_amdgcn_s_sleep(1); \
    if ((++_sp & 255u) == 0u) { if (xb_ld(&(bar)[XB_TMO])) break; if (_sp > XB_SPIN_CAP) { atomicAdd(&(bar)[XB_TMO], 1u); break; } } } } while (0)
struct XcdBarrier { unsigned* bar; unsigned x; volatile LAS unsigned* st; };
__device__ __forceinline__ XcdBarrier xcd_barrier_post(unsigned* bar, volatile LAS unsigned* st) {
    XcdBarrier b; b.bar = bar; b.x = xb_xcc_id(); b.st = st;
    if (threadIdx.x == 0) (void)xb_add(&bar[XB_XCNT(b.x)], 1u);
    return b;
}
__device__ __forceinline__ void xcd_barrier_complete(unsigned* bar, unsigned x, unsigned& nloc, unsigned& nx) {
    const unsigned G = gridDim.x * gridDim.y * gridDim.z;
    unsigned sum, cnt, mine, sp = 0u;
    for (;;) {
        sum = 0u; cnt = 0u; mine = 0u;
#pragma unroll
        for (unsigned j = 0; j < 16; ++j) { const unsigned c = xb_ld(&bar[XB_XCNT(j)]); sum += c; cnt += (c > 0u) ? 1u : 0u; mine = (j == x) ? c : mine; }
        if (sum == G) break;
        __builtin_amdgcn_s_sleep(1);
        if ((++sp & 255u) == 0u) { if (xb_ld(&bar[XB_TMO])) break; if (sp > XB_SPIN_CAP) { atomicAdd(&bar[XB_TMO], 1u); break; } }
    }
    nloc = mine > 0u ? mine : 1u; nx = cnt > 0u ? cnt : 1u;
}
__device__ __forceinline__ void xcd_barrier(const XcdBarrier& b) {
    asm volatile("s_waitcnt vmcnt(0)" ::: "memory");
    __syncthreads();
    if (threadIdx.x == 0) {
        unsigned* bar = b.bar;
        __builtin_amdgcn_s_waitcnt(0);
        unsigned nloc = b.st[0], nx = b.st[1];
        if (nloc == 0u) { xcd_barrier_complete(bar, b.x, nloc, nx); b.st[0] = nloc; b.st[1] = nx; }
        const unsigned old = xb_add(&bar[XB_XSUB(b.x)], 1u);
        const unsigned gen = old / nloc;
        if (old + 1u == (gen + 1u) * nloc) {
            __builtin_amdgcn_fence(__ATOMIC_RELEASE, "agent");
            asm volatile("s_waitcnt vmcnt(0)" ::: "memory");
            const unsigned og = xb_add(&bar[XB_TOP], 1u);
            const unsigned tg = og / nx;
            if (og + 1u == (tg + 1u) * nx) xb_add(&bar[XB_TOPGEN], 1u);
            else XB_SPIN(xb_ld(&bar[XB_TOPGEN]) == tg, bar);
            __builtin_amdgcn_fence(__ATOMIC_ACQUIRE, "agent");
            xb_add(&bar[XB_XGEN(b.x)], 1u);
            asm volatile("s_waitcnt vmcnt(0)" ::: "memory");
        } else {
            XB_SPIN(xb_ld(&bar[XB_XGEN(b.x)]) == gen, bar);
            __builtin_amdgcn_fence(__ATOMIC_ACQUIRE, "agent");
            asm volatile("s_waitcnt vmcnt(0)" ::: "memory");
        }
    }
    __syncthreads();
}
static_assert(XCD_BAR_WORDS * 4 <= BAR_BYTES, "barrier words");

constexpr int NPHASE = 19;
__global__ void __launch_bounds__(256, 2) mega(Params p) {
    extern __shared__ __attribute__((aligned(16))) unsigned char lds_[];
    LAS unsigned char* lds = (LAS unsigned char*)lds_;
    cg::grid_group grid = cg::this_grid();
    unsigned char* ws = p.ws;
    volatile LAS unsigned* bst = (volatile LAS unsigned*)(lds + LDS_BYTES - 16);
    if (threadIdx.x < 4) bst[threadIdx.x] = 0u;
    __syncthreads();
    const XcdBarrier xbar = xcd_barrier_post((unsigned*)(ws + OFF_BAR), bst);
#define GRID_BAR(k) do { if ((k) == 0) grid.sync(); else xcd_barrier(xbar); } while (0)
#ifndef PROBE_REP_MASK
#define PROBE_REP_MASK 0u
#endif
#ifndef PROBE_EXTRA_SYNCS
#define PROBE_EXTRA_SYNCS 0
#endif
#define PHASE(k, body) do { if (p.ph_lo <= (k) && (k) < p.ph_hi) { body; if ((PROBE_REP_MASK >> (k)) & 1u) { xcd_barrier(xbar); body; } if ((k) + 1 < p.ph_hi) GRID_BAR(k); } } while (0)
    for (int i = 0; i < PROBE_EXTRA_SYNCS; ++i) xcd_barrier(xbar);
    PHASE(0, ph_prep(p, lds));
    PHASE(1, ph_modulate0(p));
    PHASE(2, ph_inproj0(p, lds));
    PHASE(3, ph_swa_g1(p, lds));
    PHASE(4, ph_gla_scan(p));
    PHASE(5, ph_gla_g3(p, lds));
    PHASE(6, ph_outproj(p, lds, (const bf16*)(ws + A0_MIX), (const bf16*)(ws + OFF_W_OUT_E), (float*)(ws + A0_Y), 0));
    PHASE(7, ph_rowpassA(p, 0, 0, (const float*)(ws + A0_Y)));
    PHASE(8, ph_router(p, lds, 0, 0));
    PHASE(9, ph_moe1(p, lds, 0, 0));
    PHASE(10, ph_moe2(p, lds, 0, 0));
    PHASE(11, { ph_rowpassB(p, lds, 0, 0); __syncthreads(); for (int it = blockIdx.x; it < EXP_ITEMS; it += gridDim.x) expert_convert_item(p, lds, 1, it); });
    PHASE(12, ph_inproj1(p, lds));
    PHASE(13, ph_mla_up(p, lds));
    PHASE(14, ph_mla_attn(p, lds));
    PHASE(15, ph_outproj(p, lds, (const bf16*)(ws + A1_MIX), (const bf16*)(ws + OFF_W_OUT_O), (float*)(ws + A1_Y), TC));
    PHASE(16, ph_rowpassA(p, 1, TC, (const float*)(ws + A1_Y)));
    PHASE(17, ph_router(p, lds, 1, TC));
    PHASE(18, ph_moe1(p, lds, 1, TC));
    PHASE(19, ph_moe2(p, lds, 1, TC));
    PHASE(20, ph_rowpassB(p, lds, 1, TC));
}

extern "C" void kernel_launch(void* const* d_in, const int* in_sizes, int n_in, void* d_out, int out_size, void* d_ws, size_t ws_size, hipStream_t stream) {
    static int grid_blocks = 0;
    if (!grid_blocks) {
        int dev = 0, cus = 0, per_cu = 0;
        (void)hipGetDevice(&dev);
        (void)hipDeviceGetAttribute(&cus, hipDeviceAttributeMultiprocessorCount, dev);
        (void)hipFuncSetAttribute((const void*)mega, hipFuncAttributeMaxDynamicSharedMemorySize, LDS_BYTES);
        (void)hipOccupancyMaxActiveBlocksPerMultiprocessor(&per_cu, (const void*)mega, 256, LDS_BYTES);
        if (per_cu > 2) per_cu = 2;
        if (per_cu < 1) per_cu = 1;
        grid_blocks = cus * per_cu;
        if (ws_size < WS_NEED) fprintf(stderr, "kernel_launch: workspace too small: %zu < %zu\n", ws_size, (size_t)WS_NEED);
    }
    Params p{};
    const float** f = (const float**)&p;
    for (int i = 0; i < 30; ++i) f[i] = (const float*)d_in[i];
    p.out = (float*)d_out; p.ws = (unsigned char*)d_ws; p.ph_lo = 0; p.ph_hi = 21;
    (void)hipMemsetAsync((unsigned char*)d_ws + OFF_BAR, 0, BAR_BYTES, stream);
    void* args[] = {&p};
    hipError_t e = hipLaunchCooperativeKernel((const void*)mega, dim3(grid_blocks), dim3(256), args, LDS_BYTES, stream);
    if (e != hipSuccess) fprintf(stderr, "cooperative launch failed: %s (grid %d)\n", hipGetErrorString(e), grid_blocks);
}
```

```cpp
#include <hip/hip_runtime.h>
#include <hip/hip_cooperative_groups.h>
#include <cstdio>
#include <cstdint>
namespace cg = cooperative_groups;

#define LAS __attribute__((address_space(3)))
typedef unsigned short bf16;
typedef short bf16x8 __attribute__((ext_vector_type(8)));
typedef float f32x2 __attribute__((ext_vector_type(2)));
typedef float f32x4 __attribute__((ext_vector_type(4)));
typedef float f32x8 __attribute__((ext_vector_type(8)));
typedef float f32x16 __attribute__((ext_vector_type(16)));
typedef unsigned u32x2 __attribute__((ext_vector_type(2)));
typedef unsigned u32x4 __attribute__((ext_vector_type(4)));
typedef __bf16 bf16x2_t __attribute__((ext_vector_type(2)));

constexpr int DM = 1024, NB = 2, SEQ = 8192, CTX = 256;
constexpr int TC = NB * CTX, TL = NB * SEQ, TT = TC + TL, NKEY = CTX + SEQ;
constexpr int NEXP = 64;
constexpr float RMS_EPS = 1e-6f;
constexpr int E_IN_PAD = 2432, O_IN_PAD = 896;
constexpr float LOG2E = 1.4426950408889634f;
constexpr int NSTEP = 132;
constexpr int Z0P = 1056;
constexpr int Z1P = 768;
constexpr int LDS_BYTES = 65536;

constexpr size_t al(size_t x) { return (x + 255) & ~(size_t)255; }
constexpr size_t OFF_W_IN_E = 0;
constexpr size_t OFF_W_OUT_E = OFF_W_IN_E + al((size_t)E_IN_PAD * DM * 2);
constexpr size_t OFF_W_IN_O = OFF_W_OUT_E + al((size_t)DM * DM * 2);
constexpr size_t OFF_W_UQ = OFF_W_IN_O + al((size_t)O_IN_PAD * DM * 2);
constexpr size_t OFF_W_UKV = OFF_W_UQ + al((size_t)1536 * 512 * 2);
constexpr size_t OFF_W_OUT_O = OFF_W_UKV + al((size_t)2048 * 256 * 2);
constexpr size_t OFF_W_RT = OFF_W_OUT_O + al((size_t)DM * DM * 2);
constexpr size_t OFF_W_GU = OFF_W_RT + al((size_t)2 * 128 * DM * 2);
constexpr size_t OFF_W_D = OFF_W_GU + al((size_t)65 * 512 * DM * 2);
constexpr size_t OFF_U = OFF_W_D + al((size_t)65 * DM * 256 * 2);
constexpr size_t OFF_HC = OFF_U + al((size_t)TT * DM * 2);
constexpr size_t OFF_MOD = OFF_HC + al((size_t)TC * DM * 4);
constexpr size_t OFF_ROPE = OFF_MOD + al((size_t)2 * 3 * 6144 * 4);
constexpr size_t OFF_CNT = OFF_ROPE + al((size_t)SEQ * 32 * 8);
constexpr size_t OFF_TOKSLOT = OFF_CNT + al(2 * 64 * 4);
constexpr size_t OFF_W8 = OFF_TOKSLOT + al((size_t)TT * 8 * 4);
constexpr size_t OFF_LIST = OFF_W8 + al((size_t)TT * 8 * 4);
constexpr size_t OFF_BAR = OFF_LIST + al((size_t)64 * TT * 4);
constexpr size_t BAR_BYTES = 16384;
constexpr size_t OFF_ARENA = OFF_BAR + BAR_BYTES;
constexpr size_t A0_Z0 = OFF_ARENA;
constexpr size_t A0_VGT = A0_Z0 + al((size_t)TT * Z0P * 2);
constexpr size_t A0_QS = A0_VGT + al((size_t)4 * 128 * TT * 2);
constexpr size_t A0_KS = A0_QS + al((size_t)2 * 8 * NKEY * 64 * 2);
constexpr size_t A0_VST = A0_KS + al((size_t)2 * 2 * NKEY * 64 * 2);
constexpr size_t A0_GS = A0_VST + al((size_t)2 * 2 * 64 * NKEY * 2);
constexpr size_t A0_GD = A0_GS + al((size_t)16 * NSTEP * 8192 * 4);
constexpr size_t A0_MIX = A0_GD + al((size_t)16 * NSTEP * 64 * 4);
constexpr size_t A0_Y = A0_MIX + al((size_t)TT * DM * 2);
constexpr size_t A0_END = A0_Y + al((size_t)TT * DM * 4);
constexpr size_t A1_Z1 = OFF_ARENA;
constexpr size_t A1_QM = A1_Z1 + al((size_t)TT * Z1P * 2);
constexpr size_t A1_KM = A1_QM + al((size_t)2 * 8 * SEQ * 192 * 2);
constexpr size_t A1_VTM = A1_KM + al((size_t)2 * 8 * NKEY * 192 * 2);
constexpr size_t A1_MIX = A1_VTM + al((size_t)2 * 8 * 128 * NKEY * 2);
constexpr size_t A1_Y = A1_MIX + al((size_t)TT * DM * 2);
constexpr size_t A1_END = A1_Y + al((size_t)TT * DM * 4);
constexpr size_t AM_HM = OFF_ARENA;
constexpr size_t AM_YR = AM_HM + al((size_t)TT * 9 * 256 * 2);
constexpr size_t AM_END = AM_YR + al((size_t)TT * 9 * 1024 * 2);
constexpr size_t WS_NEED = AM_END > A0_END ? (AM_END > A1_END ? AM_END : A1_END) : (A0_END > A1_END ? A0_END : A1_END);
static_assert(WS_NEED <= 555747360ull, "workspace map exceeds the guaranteed d_ws size");

struct Params {
    const float *x, *c, *ctx, *c_ctx, *w_mod, *b_mod, *g_mix_pre, *g_mix_post, *g_ffn_pre, *g_ffn_post;
    const float *w_in_e, *gla_wa2, *gla_ba, *gla_norm, *swa_sink, *w_out_e;
    const float *w_in_o, *mla_q_norm, *mla_kv_norm, *w_uq, *w_ukv, *w_out_o;
    const float *w_router, *b_router, *w_exp_gate, *w_exp_up, *w_exp_down, *w_sh_gate, *w_sh_up, *w_sh_down;
    float* out; unsigned char* ws; int ph_lo, ph_hi;
};

__device__ __forceinline__ unsigned pk2(float lo, float hi) { f32x2 v = {lo, hi}; bf16x2_t b = __builtin_convertvector(v, bf16x2_t); return __builtin_bit_cast(unsigned, b); }
__device__ __forceinline__ float bflo(unsigned u) { return __uint_as_float(u << 16); }
__device__ __forceinline__ float bfhi(unsigned u) { return __uint_as_float(u & 0xffff0000u); }
__device__ __forceinline__ float bf2f(bf16 v) { return __uint_as_float((unsigned)v << 16); }
__device__ __forceinline__ bf16 f2bf(float f) { return (bf16)(pk2(f, 0.f) & 0xffffu); }
__device__ __forceinline__ float wave_sum(float v) {
#pragma unroll
    for (int o = 1; o < 64; o <<= 1) v += __shfl_xor(v, o);
    return v;
}
__device__ __forceinline__ void glds16(const void* g, LAS void* l) { __builtin_amdgcn_global_load_lds((const unsigned*)g, (LAS unsigned*)l, 16, 0, 0); }
__device__ __forceinline__ float siluf(float x) { return x / (1.f + __expf(-x)); }
__device__ __forceinline__ float ex2(float x) { return __builtin_amdgcn_exp2f(x); }
__device__ __forceinline__ int crow(int r, int hi) { return (r & 3) + 8 * (r >> 2) + 4 * hi; }
__device__ __forceinline__ bf16x8 mk8(u32x4 v) { return __builtin_bit_cast(bf16x8, v); }

struct RowInfo { int b, kq, pos; bool lat; };
__device__ __forceinline__ RowInfo rowinfo(int r) {
    RowInfo i;
    if (r < TC) { i.b = r >> 8; i.pos = r & 255; i.kq = i.pos; i.lat = false; }
    else { const int rl = r - TC; i.b = rl >> 13; i.pos = rl & (SEQ - 1); i.kq = CTX + i.pos; i.lat = true; }
    return i;
}
__device__ __forceinline__ int modvec(int r) { return r < TC ? 2 : ((r - TC) >> 13); }

__device__ __forceinline__ void gemm_core(LAS unsigned char* lds, const bf16* a0, const bf16* a1, const bf16* b0, const bf16* b1, int nk, f32x4 (&acc)[4][4]) {
    const int tid = threadIdx.x, lane = tid & 63, wid = tid >> 6, wr = wid >> 1, wc = wid & 1, fr = lane & 15, fq = lane >> 4;
#pragma unroll
    for (int m = 0; m < 4; ++m)
#pragma unroll
        for (int n = 0; n < 4; ++n) acc[m][n] = (f32x4){0.f, 0.f, 0.f, 0.f};
    {
        LAS unsigned char* d = lds + tid * 16;
        glds16(a0, d); glds16(a1, d + 4096); glds16(b0, d + 8192); glds16(b1, d + 12288);
    }
    const int swz = (fq ^ (((fr >> 3) & 1) << 1)) * 16;
    const int aoff = (wr * 64 + fr) * 64 + swz, boff = 8192 + (wc * 64 + fr) * 64 + swz;
    for (int kt = 0; kt < nk; ++kt) {
        const int s = kt & 1;
        asm volatile("s_waitcnt vmcnt(0)" ::: "memory");
        __syncthreads();
        if (kt + 1 < nk) {
            LAS unsigned char* d = lds + (s ^ 1) * 16384 + tid * 16;
            const int ko = (kt + 1) * 32;
            glds16(a0 + ko, d); glds16(a1 + ko, d + 4096); glds16(b0 + ko, d + 8192); glds16(b1 + ko, d + 12288);
        }
        bf16x8 af[4], bfr[4];
        LAS unsigned char* base = lds + s * 16384;
#pragma unroll
        for (int m = 0; m < 4; ++m) af[m] = *(const LAS bf16x8*)(base + aoff + m * 1024);
#pragma unroll
        for (int n = 0; n < 4; ++n) bfr[n] = *(const LAS bf16x8*)(base + boff + n * 1024);
#pragma unroll
        for (int m = 0; m < 4; ++m)
#pragma unroll
            for (int n = 0; n < 4; ++n) acc[m][n] = __builtin_amdgcn_mfma_f32_16x16x32_bf16(bfr[n], af[m], acc[m][n], 0, 0, 0);
    }
    __syncthreads();
}

__device__ __forceinline__ int ein_map(int n) {
    if (n < 512) return n;
    if (n < 1024) return n + 512;
    if (n < 1536) return n - 512;
    if (n < 2048) return 1568 + (n - 1536);
    if (n < 2176) return 2080 + (n - 2048);
    if (n < 2304) return 2208 + (n - 2176);
    if (n < 2320) return 1536 + (n - 2304);
    if (n < 2336) return 1552 + (n - 2320);
    return -1;
}
__device__ __forceinline__ void transpose_item(LAS unsigned char* lds, int K, bf16* dst, int k0, int n0, int ld, int mode, const float* srcA, const float* srcB, int nvalid, const float* kscale) {
    LAS float* tile = (LAS float*)lds;
    const int tid = threadIdx.x;
    {
        const int nl = tid & 63, kq = tid >> 6, n = n0 + nl;
        const float* cp = nullptr; float sc = 1.f;
        if (mode == 0) { if (n < nvalid) cp = srcA + n; }
        else if (mode == 1) { const int c = ein_map(n); if (c >= 0) cp = srcA + c; if (n < 256) sc = 0.125f; }
        else { const int grp = n >> 6, w = n & 63; cp = (w < 32 ? srcA : srcB) + grp * 32 + (w & 31); }
#pragma unroll 4
        for (int kk = 0; kk < 16; ++kk) {
            const int k = kq * 16 + kk;
            float v = 0.f;
            if (cp) { v = cp[(size_t)(k0 + k) * ld] * sc; if (kscale) v *= kscale[k0 + k]; }
            tile[k * 65 + nl] = v;
        }
    }
    __syncthreads();
    {
        const int n = tid >> 2, kc = tid & 3;
#pragma unroll
        for (int h = 0; h < 2; ++h) {
            const int k8 = kc * 16 + h * 8;
            u32x4 o;
            o.x = pk2(tile[(k8 + 0) * 65 + n], tile[(k8 + 1) * 65 + n]);
            o.y = pk2(tile[(k8 + 2) * 65 + n], tile[(k8 + 3) * 65 + n]);
            o.z = pk2(tile[(k8 + 4) * 65 + n], tile[(k8 + 5) * 65 + n]);
            o.w = pk2(tile[(k8 + 6) * 65 + n], tile[(k8 + 7) * 65 + n]);
            *(u32x4*)(dst + (size_t)(n0 + n) * K + k0 + k8) = o;
        }
    }
    __syncthreads();
}

constexpr int EXP_GU_ITEMS = 65 * 16 * 8, EXP_D_ITEMS = 65 * 4 * 16, EXP_ITEMS = EXP_GU_ITEMS + EXP_D_ITEMS;
__device__ __forceinline__ void expert_convert_item(const Params& p, LAS unsigned char* lds, int l, int it) {
    unsigned char* ws = p.ws;
    if (it < EXP_GU_ITEMS) {
        const int e = it / 128, r = it % 128, kb = r / 8, nb = r % 8;
        const float* gate = e < 64 ? p.w_exp_gate + ((size_t)(l * 64 + e)) * DM * 256 : p.w_sh_gate + (size_t)l * DM * 256;
        const float* up = e < 64 ? p.w_exp_up + ((size_t)(l * 64 + e)) * DM * 256 : p.w_sh_up + (size_t)l * DM * 256;
        transpose_item(lds, DM, (bf16*)(ws + OFF_W_GU) + (size_t)e * 512 * DM, kb * 64, nb * 64, 256, 2, gate, up, 512, nullptr);
    } else {
        it -= EXP_GU_ITEMS;
        const int e = it / 64, r = it % 64, kb = r / 16, nb = r % 16;
        const float* dn = e < 64 ? p.w_exp_down + ((size_t)(l * 64 + e)) * 256 * DM : p.w_sh_down + (size_t)l * 256 * DM;
        transpose_item(lds, 256, (bf16*)(ws + OFF_W_D) + (size_t)e * DM * 256, kb * 64, nb * 64, DM, 0, dn, nullptr, DM, nullptr);
    }
}

__device__ __forceinline__ void ph_prep(const Params& p, LAS unsigned char* lds) {
    unsigned char* ws = p.ws;
    const int tid = threadIdx.x;
    if (blockIdx.x == 0 && tid < 128) ((int*)(ws + OFF_CNT))[tid] = 0;
    constexpr int I_MOD = 96, I_ROPE = 1024, I_INE = 16 * 38, I_OUTE = 256, I_INO = 16 * 14, I_UQ = 8 * 24, I_UKV = 4 * 32, I_OUTO = 256, I_RT = 64;
    constexpr int NITEMS = I_MOD + I_ROPE + I_INE + I_OUTE + I_INO + I_UQ + I_UKV + I_OUTO + I_RT + EXP_ITEMS;
    for (int item = blockIdx.x; item < NITEMS; item += gridDim.x) {
        int it = item;
        if (it < I_MOD) {
            const int l = it / 48, n0 = (it % 48) * 128, kg = tid >> 5, cl = tid & 31;
            LAS float* s = (LAS float*)lds;
            LAS float* red = (LAS float*)(lds + 12288);
            for (int idx = tid; idx < 3072; idx += 256) { const int v = idx >> 10, k = idx & 1023; const float cv = v < 2 ? p.c[v * DM + k] : p.c_ctx[k]; s[idx] = cv / (1.f + expf(-cv)); }
            __syncthreads();
            f32x4 a0 = {0.f, 0.f, 0.f, 0.f}, a1 = a0, a2 = a0;
            const float* w = p.w_mod + (size_t)l * DM * 6144 + (size_t)(kg * 128) * 6144 + n0 + cl * 4;
#pragma unroll 8
            for (int k = 0; k < 128; ++k) { const f32x4 wv = *(const f32x4*)(w + (size_t)k * 6144); const int kk = kg * 128 + k; a0 += wv * s[kk]; a1 += wv * s[1024 + kk]; a2 += wv * s[2048 + kk]; }
            *(LAS f32x4*)(red + (kg * 3 + 0) * 128 + cl * 4) = a0; *(LAS f32x4*)(red + (kg * 3 + 1) * 128 + cl * 4) = a1; *(LAS f32x4*)(red + (kg * 3 + 2) * 128 + cl * 4) = a2;
            __syncthreads();
            for (int idx = tid; idx < 384; idx += 256) { const int v = idx >> 7, n = idx & 127; float acc = 0.f;
#pragma unroll
                for (int g = 0; g < 8; ++g) acc += red[(g * 3 + v) * 128 + n];
                ((float*)(ws + OFF_MOD))[((size_t)l * 3 + v) * 6144 + n0 + n] = acc + p.b_mod[l * 6144 + n0 + n]; }
            __syncthreads();
            continue;
        }
        it -= I_MOD;
        if (it < I_ROPE) {
            const int idx = it * 256 + tid, pos = idx >> 5, i = idx & 31, row = pos >> 6, col = pos & 63, j = i & 15;
            const float invf = powf(10000.f, -(float)(2 * j) / 32.f);
            const float ang = (float)(i < 16 ? row : col) * invf;
            float sn, cs; sincosf(ang, &sn, &cs);
            ((f32x2*)(ws + OFF_ROPE))[idx] = (f32x2){cs, sn};
            continue;
        }
        it -= I_ROPE;
        if (it < I_INE) { const int kb = it / 38, nb = it % 38;
            transpose_item(lds, DM, (bf16*)(ws + OFF_W_IN_E), kb * 64, nb * 64, 2336, 1, p.w_in_e, nullptr, 2336, nullptr); continue; }
        it -= I_INE;
        if (it < I_OUTE) { const int kb = it / 16, nb = it % 16;
            transpose_item(lds, DM, (bf16*)(ws + OFF_W_OUT_E), kb * 64, nb * 64, DM, 0, p.w_out_e, nullptr, DM, nullptr); continue; }
        it -= I_OUTE;
        if (it < I_INO) { const int kb = it / 14, nb = it % 14;
            transpose_item(lds, DM, (bf16*)(ws + OFF_W_IN_O), kb * 64, nb * 64, 832, 0, p.w_in_o, nullptr, 832, nullptr); continue; }
        it -= I_INO;
        if (it < I_UQ) { const int kb = it / 24, nb = it % 24;
            transpose_item(lds, 512, (bf16*)(ws + OFF_W_UQ), kb * 64, nb * 64, 1536, 0, p.w_uq, nullptr, 1536, p.mla_q_norm); continue; }
        it -= I_UQ;
        if (it < I_UKV) { const int kb = it / 32, nb = it % 32;
            transpose_item(lds, 256, (bf16*)(ws + OFF_W_UKV), kb * 64, nb * 64, 2048, 0, p.w_ukv, nullptr, 2048, p.mla_kv_norm); continue; }
        it -= I_UKV;
        if (it < I_OUTO) { const int kb = it / 16, nb = it % 16;
            transpose_item(lds, DM, (bf16*)(ws + OFF_W_OUT_O), kb * 64, nb * 64, DM, 0, p.w_out_o, nullptr, DM, nullptr); continue; }
        it -= I_OUTO;
        if (it < I_RT) { const int l = it / 32, r = it % 32, kb = r / 2, nb = r % 2;
            transpose_item(lds, DM, (bf16*)(ws + OFF_W_RT) + (size_t)l * 128 * DM, kb * 64, nb * 64, 64, 0, p.w_router + (size_t)l * DM * 64, nullptr, 64, nullptr); continue; }
        it -= I_RT;
        expert_convert_item(p, lds, 0, it);
    }
}

__device__ __forceinline__ void load_row(const float* src, int lane, f32x4 (&v)[4]) {
#pragma unroll
    for (int j = 0; j < 4; ++j) v[j] = *(const f32x4*)(src + lane * 4 + 256 * j);
}
__device__ __forceinline__ float row_sumsq(const f32x4 (&v)[4]) {
    float s = 0.f;
#pragma unroll
    for (int j = 0; j < 4; ++j) s += v[j].x * v[j].x + v[j].y * v[j].y + v[j].z * v[j].z + v[j].w * v[j].w;
    return wave_sum(s);
}
__device__ __forceinline__ void modulate_store(const f32x4 (&v)[4], float rinv, const float* g, const float* sh, const float* sc, bf16* dst, int lane) {
#pragma unroll
    for (int j = 0; j < 4; ++j) {
        const int c = lane * 4 + 256 * j;
        const f32x4 gg = *(const f32x4*)(g + c), s1 = *(const f32x4*)(sc + c), s0 = *(const f32x4*)(sh + c);
        const f32x4 o = v[j] * rinv * gg * (s1 + 1.f) + s0;
        u32x2 w; w.x = pk2(o.x, o.y); w.y = pk2(o.z, o.w);
        *(u32x2*)(dst + c) = w;
    }
}
__device__ __forceinline__ const float* hl_src0(const Params& p, int r) { return r < TC ? p.ctx + (size_t)r * DM : p.x + (size_t)(r - TC) * DM; }
__device__ __forceinline__ float* hl_buf(const Params& p, int r) { return r < TC ? (float*)(p.ws + OFF_HC) + (size_t)r * DM : p.out + (size_t)(r - TC) * DM; }

__device__ __forceinline__ void ph_modulate0(const Params& p) {
    const int lane = threadIdx.x & 63, gw = blockIdx.x * 4 + (threadIdx.x >> 6), ngw = gridDim.x * 4;
    const float* mod = (const float*)(p.ws + OFF_MOD);
    bf16* U = (bf16*)(p.ws + OFF_U);
    for (int r = gw; r < TT; r += ngw) {
        f32x4 v[4]; load_row(hl_src0(p, r), lane, v);
        const float rinv = rsqrtf(row_sumsq(v) * (1.f / DM) + RMS_EPS);
        const float* mv = mod + (size_t)modvec(r) * 6144;
        modulate_store(v, rinv, p.g_mix_pre, mv, mv + 1024, U + (size_t)r * DM, lane);
    }
}

__device__ __forceinline__ void ph_rowpassA(const Params& p, int l, int row_lo, const float* Y) {
    const int lane = threadIdx.x & 63, gw = blockIdx.x * 4 + (threadIdx.x >> 6), ngw = gridDim.x * 4;
    const float* mod = (const float*)(p.ws + OFF_MOD) + (size_t)l * 3 * 6144;
    bf16* U = (bf16*)(p.ws + OFF_U);
    for (int r = row_lo + gw; r < TT; r += ngw) {
        f32x4 y[4], h[4];
        load_row(Y + (size_t)r * DM, lane, y);
        load_row(l == 0 ? hl_src0(p, r) : (const float*)hl_buf(p, r), lane, h);
        const float rinv = rsqrtf(row_sumsq(y) * (1.f / DM) + RMS_EPS);
        const float* mv = mod + (size_t)modvec(r) * 6144;
        float* hb = hl_buf(p, r);
#pragma unroll
        for (int j = 0; j < 4; ++j) {
            const int c = lane * 4 + 256 * j;
            const f32x4 gg = *(const f32x4*)(p.g_mix_post + l * DM + c), gt = *(const f32x4*)(mv + 2048 + c);
            h[j] = h[j] + gt * (y[j] * rinv * gg);
            *(f32x4*)(hb + c) = h[j];
        }
        const float rinv2 = rsqrtf(row_sumsq(h) * (1.f / DM) + RMS_EPS);
        modulate_store(h, rinv2, p.g_ffn_pre + l * DM, mv + 3072, mv + 4096, U + (size_t)r * DM, lane);
    }
}

constexpr int MOE_LDS_OFF = 40960;
__device__ __forceinline__ void moe_tables(const Params& p, LAS unsigned char* lds, int l, int row_lo) {
    LAS int* cnt = (LAS int*)(lds + MOE_LDS_OFF); LAS int* tp = cnt + 80; LAS int* sp = tp + 80;
    const int tid = threadIdx.x;
    if (tid < 64) cnt[tid] = ((const int*)(p.ws + OFF_CNT))[l * 64 + tid];
    if (tid == 64) cnt[64] = TT - row_lo;
    __syncthreads();
    if (tid == 0) {
        int a = 0, s = 0;
        for (int e = 0; e < 65; ++e) { tp[e] = a; sp[e] = s; a += (cnt[e] + 127) >> 7; s += cnt[e]; }
        tp[65] = a;
    }
    __syncthreads();
}

__device__ __forceinline__ void ph_rowpassB(const Params& p, LAS unsigned char* lds, int l, int row_lo) {
    moe_tables(p, lds, l, row_lo);
    LAS int* sp = (LAS int*)(lds + MOE_LDS_OFF) + 160;
    const int lane = threadIdx.x & 63, gw = blockIdx.x * 4 + (threadIdx.x >> 6), ngw = gridDim.x * 4;
    const float* mod = (const float*)(p.ws + OFF_MOD) + (size_t)l * 3 * 6144;
    const bf16* YR = (const bf16*)(p.ws + AM_YR);
    const int* tokslot = (const int*)(p.ws + OFF_TOKSLOT);
    bf16* U = (bf16*)(p.ws + OFF_U);
    for (int r = row_lo + gw; r < TT; r += ngw) {
        f32x4 f[4];
#pragma unroll
        for (int j = 0; j < 4; ++j) f[j] = (f32x4){0.f, 0.f, 0.f, 0.f};
#pragma unroll
        for (int k = 0; k < 9; ++k) {
            size_t slot;
            if (k < 8) { const int ts = tokslot[(size_t)r * 8 + k]; slot = (size_t)(sp[ts >> 20] + (ts & 0xfffff)); }
            else slot = (size_t)TT * 8 + r;
            const bf16* yr = YR + slot * DM;
#pragma unroll
            for (int j = 0; j < 4; ++j) {
                const u32x2 w = *(const u32x2*)(yr + lane * 4 + 256 * j);
                f[j].x += bflo(w.x); f[j].y += bfhi(w.x); f[j].z += bflo(w.y); f[j].w += bfhi(w.y);
            }
        }
        const float rinv = rsqrtf(row_sumsq(f) * (1.f / DM) + RMS_EPS);
        const float* mv = mod + (size_t)modvec(r) * 6144;
        float* hb = hl_buf(p, r);
        f32x4 h[4]; load_row(hb, lane, h);
#pragma unroll
        for (int j = 0; j < 4; ++j) {
            const int c = lane * 4 + 256 * j;
            const f32x4 gg = *(const f32x4*)(p.g_ffn_post + l * DM + c), gt = *(const f32x4*)(mv + 5120 + c);
            h[j] = h[j] + gt * (f[j] * rinv * gg);
            *(f32x4*)(hb + c) = h[j];
        }
        if (l == 0) {
            const float rinv2 = rsqrtf(row_sumsq(h) * (1.f / DM) + RMS_EPS);
            const float* mv1 = mv + 3 * 6144;
            modulate_store(h, rinv2, p.g_mix_pre + DM, mv1, mv1 + 1024, U + (size_t)r * DM, lane);
        }
    }
}

__device__ __forceinline__ int stg_col() { const int tid = threadIdx.x; return (((tid & 3) ^ (((tid >> 5) & 1) << 1))) * 8; }
__device__ __forceinline__ void plain_ptrs(const bf16* base, int row0, int ld, const bf16*& p0, const bf16*& p1) {
    const int tid = threadIdx.x;
    p0 = base + (size_t)(row0 + (tid >> 2)) * ld + stg_col();
    p1 = p0 + (size_t)64 * ld;
}

__device__ __forceinline__ void ph_inproj0(const Params& p, LAS unsigned char* lds) {
    unsigned char* ws = p.ws;
    const bf16* U = (const bf16*)(ws + OFF_U); const bf16* W = (const bf16*)(ws + OFF_W_IN_E);
    bf16* Z0 = (bf16*)(ws + A0_Z0); bf16* VGT = (bf16*)(ws + A0_VGT); bf16* QS = (bf16*)(ws + A0_QS); bf16* KS = (bf16*)(ws + A0_KS); bf16* VST = (bf16*)(ws + A0_VST);
    const f32x2* rope = (const f32x2*)(ws + OFF_ROPE);
    const int tid = threadIdx.x, lane = tid & 63, wid = tid >> 6, wr = wid >> 1, wc = wid & 1, fr = lane & 15, fq = lane >> 4;
    constexpr int NTN = 19, NTM = TT / 128;
    for (int t = blockIdx.x; t < NTM * NTN; t += gridDim.x) {
        const int tm = t / NTN, tn = t % NTN, brow = tm * 128, bcol = tn * 128;
        const bf16 *a0, *a1, *b0, *b1; plain_ptrs(U, brow, DM, a0, a1); plain_ptrs(W, bcol, DM, b0, b1);
        f32x4 acc[4][4];
        gemm_core(lds, a0, a1, b0, b1, DM / 32, acc);
        const int cb = bcol + wc * 64;
#pragma unroll
        for (int m = 0; m < 4; ++m) {
            const int r = brow + wr * 64 + m * 16 + fr;
            const RowInfo ri = rowinfo(r);
            if (cb < 1024) {
#pragma unroll
                for (int n = 0; n < 4; ++n) { u32x2 w; w.x = pk2(acc[m][n][0], acc[m][n][1]); w.y = pk2(acc[m][n][2], acc[m][n][3]); *(u32x2*)(Z0 + (size_t)r * Z0P + cb + n * 16 + fq * 4) = w; }
            } else if (cb < 1536) {
                const int c0 = cb - 1024;
#pragma unroll
                for (int n = 0; n < 4; ++n)
#pragma unroll
                    for (int j = 0; j < 4; ++j) VGT[(size_t)(c0 + n * 16 + fq * 4 + j) * TT + r] = f2bf(acc[m][n][j]);
            } else if (cb < 2176) {
                f32x4 o[4];
#pragma unroll
                for (int n = 0; n < 2; ++n) {
#pragma unroll
                    for (int j = 0; j < 4; ++j) {
                        const float x1 = acc[m][n][j], x2 = acc[m][n + 2][j];
                        if (ri.lat) { const f32x2 cs = rope[(size_t)ri.pos * 32 + n * 16 + fq * 4 + j]; o[n][j] = x1 * cs.x - x2 * cs.y; o[n + 2][j] = x2 * cs.x + x1 * cs.y; }
                        else { o[n][j] = x1; o[n + 2][j] = x2; }
                    }
                }
                bf16* dst; float sc;
                if (cb < 2048) { const int h = (cb - 1536) >> 6; dst = QS + ((size_t)(ri.b * 8 + h) * NKEY + ri.kq) * 64; sc = 0.125f * LOG2E; }
                else { const int h = (cb - 2048) >> 6; dst = KS + ((size_t)(ri.b * 2 + h) * NKEY + ri.kq) * 64; sc = 1.f; }
#pragma unroll
                for (int n = 0; n < 4; ++n) { u32x2 w; w.x = pk2(o[n][0] * sc, o[n][1] * sc); w.y = pk2(o[n][2] * sc, o[n][3] * sc); *(u32x2*)(dst + n * 16 + fq * 4) = w; }
            } else if (cb < 2304) {
                const int h = (cb - 2176) >> 6;
                bf16* dst = VST + (size_t)(ri.b * 2 + h) * 64 * NKEY + ri.kq;
#pragma unroll
                for (int n = 0; n < 4; ++n)
#pragma unroll
                    for (int j = 0; j < 4; ++j) dst[(size_t)(n * 16 + fq * 4 + j) * NKEY] = f2bf(acc[m][n][j]);
            } else if (cb == 2304) {
#pragma unroll
                for (int n = 0; n < 2; ++n) { u32x2 w; w.x = pk2(acc[m][n][0], acc[m][n][1]); w.y = pk2(acc[m][n][2], acc[m][n][3]); *(u32x2*)(Z0 + (size_t)r * Z0P + 1024 + n * 16 + fq * 4) = w; }
            }
        }
    }
}

__device__ __forceinline__ void ph_outproj(const Params& p, LAS unsigned char* lds, const bf16* MIX, const bf16* W, float* Y, int row_lo) {
    const int tid = threadIdx.x, lane = tid & 63, wid = tid >> 6, wr = wid >> 1, wc = wid & 1, fr = lane & 15, fq = lane >> 4;
    const int tm0 = row_lo / 128, ntm = TT / 128 - tm0;
    for (int t = blockIdx.x; t < ntm * 8; t += gridDim.x) {
        const int tm = tm0 + t / 8, tn = t % 8, brow = tm * 128, bcol = tn * 128;
        const bf16 *a0, *a1, *b0, *b1; plain_ptrs(MIX, brow, DM, a0, a1); plain_ptrs(W, bcol, DM, b0, b1);
        f32x4 acc[4][4];
        gemm_core(lds, a0, a1, b0, b1, DM / 32, acc);
#pragma unroll
        for (int m = 0; m < 4; ++m) {
            const int r = brow + wr * 64 + m * 16 + fr;
#pragma unroll
            for (int n = 0; n < 4; ++n) *(f32x4*)(Y + (size_t)r * DM + bcol + wc * 64 + n * 16 + fq * 4) = acc[m][n];
        }
    }
}

template <int DQK, int DV>
__device__ __forceinline__ void attn_item(LAS unsigned char* lds, const bf16* Qg, const bf16* Kg, const bf16* VTg, int a1, int b0, int b1, int qpos0,
                                          float m_init, float l_init, bf16* Og, int o_pitch) {
    constexpr int KP = (DQK + 8) * 2, VP = 136, NS = DQK / 16, NDV = DV / 32, KCH = DQK / 8;
    const int tid = threadIdx.x, lane = tid & 63, wid = tid >> 6, ql = lane & 31, hi = lane >> 5;
    bf16x8 qf[NS];
    {
        const bf16* qrow = Qg + (size_t)(wid * 32 + ql) * DQK + hi * 8;
#pragma unroll
        for (int s = 0; s < NS; ++s) qf[s] = *(const bf16x8*)(qrow + s * 16);
    }
    f32x16 o[NDV];
#pragma unroll
    for (int d = 0; d < NDV; ++d)
#pragma unroll
        for (int r = 0; r < 16; ++r) o[d][r] = 0.f;
    float mrun = m_init, lrun = l_init;
    const int ntot = a1 + (b1 - b0);
    LAS unsigned char* Ks = lds; LAS unsigned char* Vs = lds + 64 * KP;
    constexpr int KN = KCH / 4, VN = DV / 32;
    u32x4 kreg[KN], vreg[VN];
    const bf16* kgp = Kg + (size_t)(tid >> 2) * DQK + (tid & 3) * 8;
    const bf16* vgp = VTg + (size_t)(tid >> 3) * NKEY + (tid & 7) * 8;
    LAS unsigned char* ksp = Ks + (tid >> 2) * KP + (tid & 3) * 16;
    LAS unsigned char* vsp = Vs + (tid >> 3) * VP + (tid & 7) * 16;
#define ATTN_LOAD(kt_) do { \
        _Pragma("unroll") for (int i_ = 0; i_ < KN; ++i_) kreg[i_] = *(const u32x4*)(kgp + (size_t)(kt_) * 64 * DQK + i_ * 32); \
        _Pragma("unroll") for (int i_ = 0; i_ < VN; ++i_) vreg[i_] = *(const u32x4*)(vgp + (size_t)(i_ * 32) * NKEY + (kt_) * 64); } while (0)
    ATTN_LOAD(a1 > 0 ? 0 : b0);
    for (int it = 0; it < ntot; ++it) {
        const int kt = it < a1 ? it : b0 + (it - a1);
        const bool masked = it >= a1;
        __syncthreads();
#pragma unroll
        for (int i = 0; i < KN; ++i) *(LAS u32x4*)(ksp + i * 64) = kreg[i];
#pragma unroll
        for (int i = 0; i < VN; ++i) { LAS u32x2* d = (LAS u32x2*)(vsp + i * 32 * VP); d[0] = (u32x2){vreg[i].x, vreg[i].y}; d[1] = (u32x2){vreg[i].z, vreg[i].w}; }
        __syncthreads();
        if (it + 1 < ntot) { const int ktn = (it + 1) < a1 ? (it + 1) : b0 + (it + 1 - a1); ATTN_LOAD(ktn); }
        f32x16 p0, p1;
#pragma unroll
        for (int r = 0; r < 16; ++r) { p0[r] = 0.f; p1[r] = 0.f; }
#pragma unroll
        for (int s = 0; s < NS; ++s) {
            const bf16x8 k0 = *(const LAS bf16x8*)(Ks + ql * KP + (s * 16 + hi * 8) * 2);
            const bf16x8 k1 = *(const LAS bf16x8*)(Ks + (32 + ql) * KP + (s * 16 + hi * 8) * 2);
            p0 = __builtin_amdgcn_mfma_f32_32x32x16_bf16(k0, qf[s], p0, 0, 0, 0);
            p1 = __builtin_amdgcn_mfma_f32_32x32x16_bf16(k1, qf[s], p1, 0, 0, 0);
        }
        if (masked) {
            const int kbase = kt * 64 - CTX, qpos = qpos0 + wid * 32 + ql;
#pragma unroll
            for (int r = 0; r < 16; ++r) {
                const int d0 = qpos - (kbase + crow(r, hi)), d1 = d0 - 32;
                if (d0 > 128 || d0 < -128) p0[r] = -1e30f;
                if (d1 > 128 || d1 < -128) p1[r] = -1e30f;
            }
        }
        float mx = p0[0];
#pragma unroll
        for (int r = 1; r < 16; ++r) mx = fmaxf(mx, p0[r]);
#pragma unroll
        for (int r = 0; r < 16; ++r) mx = fmaxf(mx, p1[r]);
        mx = fmaxf(mx, __shfl_xor(mx, 32));
        if (__any(mx > mrun + 8.f)) {
            const float mn = fmaxf(mrun, mx), alpha = ex2(mrun - mn);
            mrun = mn; lrun *= alpha;
#pragma unroll
            for (int d = 0; d < NDV; ++d)
#pragma unroll
                for (int r = 0; r < 16; ++r) o[d][r] *= alpha;
        }
        float rs = 0.f;
#pragma unroll
        for (int r = 0; r < 16; ++r) { p0[r] = ex2(p0[r] - mrun); rs += p0[r]; }
#pragma unroll
        for (int r = 0; r < 16; ++r) { p1[r] = ex2(p1[r] - mrun); rs += p1[r]; }
        rs += __shfl_xor(rs, 32);
        lrun += rs;
        bf16x8 pf[4];
        { u32x4 w;
          w.x = pk2(p0[0], p0[1]); w.y = pk2(p0[2], p0[3]); w.z = pk2(p0[4], p0[5]); w.w = pk2(p0[6], p0[7]); pf[0] = mk8(w);
          w.x = pk2(p0[8], p0[9]); w.y = pk2(p0[10], p0[11]); w.z = pk2(p0[12], p0[13]); w.w = pk2(p0[14], p0[15]); pf[1] = mk8(w);
          w.x = pk2(p1[0], p1[1]); w.y = pk2(p1[2], p1[3]); w.z = pk2(p1[4], p1[5]); w.w = pk2(p1[6], p1[7]); pf[2] = mk8(w);
          w.x = pk2(p1[8], p1[9]); w.y = pk2(p1[10], p1[11]); w.z = pk2(p1[12], p1[13]); w.w = pk2(p1[14], p1[15]); pf[3] = mk8(w); }
#pragma unroll
        for (int d = 0; d < NDV; ++d) {
#pragma unroll
            for (int kk = 0; kk < 4; ++kk) {
                const int keybase = kk * 16 + 4 * hi;
                const LAS unsigned char* vp = Vs + (d * 32 + ql) * VP + keybase * 2;
                const u32x2 lo = *(const LAS u32x2*)vp, hh = *(const LAS u32x2*)(vp + 16);
                const bf16x8 vf = mk8((u32x4){lo.x, lo.y, hh.x, hh.y});
                o[d] = __builtin_amdgcn_mfma_f32_32x32x16_bf16(vf, pf[kk], o[d], 0, 0, 0);
            }
        }
    }
#undef ATTN_LOAD
    const float inv = 1.f / lrun;
    bf16* orow = Og + (size_t)(wid * 32 + ql) * o_pitch;
#pragma unroll
    for (int d = 0; d < NDV; ++d)
#pragma unroll
        for (int g = 0; g < 4; ++g) {
            u32x2 w; w.x = pk2(o[d][g * 4 + 0] * inv, o[d][g * 4 + 1] * inv); w.y = pk2(o[d][g * 4 + 2] * inv, o[d][g * 4 + 3] * inv);
            *(u32x2*)(orow + d * 32 + 8 * g + 4 * hi) = w;
        }
}

constexpr int GA_CUM = 0, GA_ALOW = 16384, GA_WA = 20480, GA_BA = 24576, GA_QT = 24832, GA_TOT = 25856, GA_END = 26112;
__device__ __forceinline__ void gla_cum(const Params& p, LAS unsigned char* lds, const bf16* Z0, int r0, int h, int dir) {
    const int tid = threadIdx.x;
    LAS float* cum = (LAS float*)(lds + GA_CUM); LAS float* alow = (LAS float*)(lds + GA_ALOW); LAS float* wa = (LAS float*)(lds + GA_WA);
    LAS float* ba = (LAS float*)(lds + GA_BA); LAS float* qt = (LAS float*)(lds + GA_QT); LAS float* tot = (LAS float*)(lds + GA_TOT);
    {
        const int t = tid >> 2, i4 = (tid & 3) * 4;
        const u32x2 w = *(const u32x2*)(Z0 + (size_t)(r0 + t) * Z0P + 1024 + dir * 16 + i4);
        alow[t * 16 + i4 + 0] = bflo(w.x); alow[t * 16 + i4 + 1] = bfhi(w.x); alow[t * 16 + i4 + 2] = bflo(w.y); alow[t * 16 + i4 + 3] = bfhi(w.y);
#pragma unroll
        for (int q = 0; q < 4; ++q) { const int idx = tid * 4 + q, i = idx >> 6, j = idx & 63; wa[idx] = p.gla_wa2[(size_t)(dir * 16 + i) * 256 + h * 64 + j]; }
        if (tid < 64) ba[tid] = p.gla_ba[dir * 256 + h * 64 + tid];
    }
    __syncthreads();
    const int j = tid & 63, tq = tid >> 6;
    float la[16];
#pragma unroll
    for (int tt = 0; tt < 16; ++tt) {
        const int t = tq * 16 + tt;
        float x = ba[j];
#pragma unroll
        for (int i = 0; i < 16; ++i) x += alow[t * 16 + i] * wa[i * 64 + j];
        la[tt] = (fminf(x, 0.f) - log1pf(expf(-fabsf(x)))) * (1.f / 16.f);
    }
    float run = 0.f;
    if (dir == 0) {
#pragma unroll
        for (int tt = 0; tt < 16; ++tt) { run += la[tt]; cum[(tq * 16 + tt) * 64 + j] = run; }
    } else {
#pragma unroll
        for (int tt = 15; tt >= 0; --tt) { run += la[tt]; cum[(tq * 16 + tt) * 64 + j] = run; }
    }
    qt[tq * 64 + j] = run;
    __syncthreads();
    float off = 0.f, total = 0.f;
#pragma unroll
    for (int q = 0; q < 4; ++q) { const float v = qt[q * 64 + j]; total += v; if (dir == 0 ? (q < tq) : (q > tq)) off += v; }
#pragma unroll
    for (int tt = 0; tt < 16; ++tt) cum[(tq * 16 + tt) * 64 + j] += off;
    if (tq == 0) tot[j] = total;
    __syncthreads();
}

__device__ __forceinline__ int gla_row0(int b, int cc) { return cc < 4 ? b * CTX + cc * 64 : TC + b * SEQ + (cc - 4) * 64; }
__device__ __forceinline__ int gla_step(int cc, int dir) { return dir == 0 ? cc : (cc < 4 ? 3 - cc : 4 + (131 - cc)); }

__device__ __forceinline__ void gla_g1_item(const Params& p, LAS unsigned char* lds, int item) {
    unsigned char* ws = p.ws;
    const bf16* Z0 = (const bf16*)(ws + A0_Z0); const bf16* VGT = (const bf16*)(ws + A0_VGT);
    float* GS = (float*)(ws + A0_GS); float* GD = (float*)(ws + A0_GD);
    const int cc = item % NSTEP, rest = item / NSTEP, dir = rest & 1, h = (rest >> 1) & 3, b = rest >> 3;
    const int r0 = gla_row0(b, cc), step = gla_step(cc, dir), chain = (b * 4 + h) * 2 + dir;
    const int tid = threadIdx.x, lane = tid & 63, wid = tid >> 6, fr = lane & 15, fq = lane >> 4;
    __syncthreads();
    gla_cum(p, lds, Z0, r0, h, dir);
    LAS float* cum = (LAS float*)(lds + GA_CUM); LAS float* tot = (LAS float*)(lds + GA_TOT);
    LAS bf16* KT = (LAS bf16*)(lds + GA_END);
    {
        const int t = tid >> 2, d0 = (tid & 3) * 16;
        const u32x4 w0 = *(const u32x4*)(Z0 + (size_t)(r0 + t) * Z0P + 256 + h * 64 + d0), w1 = *(const u32x4*)(Z0 + (size_t)(r0 + t) * Z0P + 256 + h * 64 + d0 + 8);
        const unsigned ww[8] = {w0.x, w0.y, w0.z, w0.w, w1.x, w1.y, w1.z, w1.w};
#pragma unroll
        for (int i = 0; i < 8; ++i) {
            const int d = d0 + 2 * i;
            KT[d * 72 + t] = f2bf(bflo(ww[i]) * __expf(tot[d] - cum[t * 64 + d]));
            KT[(d + 1) * 72 + t] = f2bf(bfhi(ww[i]) * __expf(tot[d + 1] - cum[t * 64 + d + 1]));
        }
    }
    if (tid < 64) GD[((size_t)chain * NSTEP + step) * 64 + tid] = __expf(tot[tid]);
    __syncthreads();
    f32x4 acc[2][4];
#pragma unroll
    for (int m = 0; m < 2; ++m)
#pragma unroll
        for (int n = 0; n < 4; ++n) acc[m][n] = (f32x4){0.f, 0.f, 0.f, 0.f};
#pragma unroll
    for (int ks = 0; ks < 2; ++ks) {
        bf16x8 af[2], bfr[4];
#pragma unroll
        for (int m = 0; m < 2; ++m) af[m] = *(const bf16x8*)(VGT + (size_t)(h * 128 + wid * 32 + m * 16 + fr) * TT + r0 + ks * 32 + fq * 8);
#pragma unroll
        for (int n = 0; n < 4; ++n) bfr[n] = *(const LAS bf16x8*)(KT + (n * 16 + fr) * 72 + ks * 32 + fq * 8);
#pragma unroll
        for (int m = 0; m < 2; ++m)
#pragma unroll
            for (int n = 0; n < 4; ++n) acc[m][n] = __builtin_amdgcn_mfma_f32_16x16x32_bf16(bfr[n], af[m], acc[m][n], 0, 0, 0);
    }
    float* dst = GS + ((size_t)chain * NSTEP + step) * 8192;
#pragma unroll
    for (int m = 0; m < 2; ++m)
#pragma unroll
        for (int n = 0; n < 4; ++n) *(f32x4*)(dst + (size_t)(wid * 32 + m * 16 + fr) * 64 + n * 16 + fq * 4) = acc[m][n];
}

__device__ __forceinline__ void ph_gla_scan(const Params& p) {
    float* GS = (float*)(p.ws + A0_GS); const float* GD = (const float*)(p.ws + A0_GD);
    for (int idx = blockIdx.x * 256 + threadIdx.x; idx < 16 * 8192; idx += gridDim.x * 256) {
        const int chain = idx >> 13, e = idx & 8191, dk = e & 63;
        float* g = GS + (size_t)chain * NSTEP * 8192 + e;
        const float* d = GD + (size_t)chain * NSTEP * 64 + dk;
        float st = 0.f;
#pragma unroll 6
        for (int s = 0; s < NSTEP; ++s) { const float t = g[(size_t)s * 8192]; const float dec = d[s * 64]; g[(size_t)s * 8192] = st; st = dec * st + t; }
    }
}

__device__ __forceinline__ void gla_g3_item(const Params& p, LAS unsigned char* lds, int item) {
    unsigned char* ws = p.ws;
    const bf16* Z0 = (const bf16*)(ws + A0_Z0); const bf16* VGT = (const bf16*)(ws + A0_VGT);
    const float* GS = (const float*)(ws + A0_GS); bf16* MIX = (bf16*)(ws + A0_MIX);
    const int cc = item % NSTEP, rest = item / NSTEP, h = rest & 3, b = rest >> 2;
    const int r0 = gla_row0(b, cc);
    const int tid = threadIdx.x, lane = tid & 63, wid = tid >> 6, fr = lane & 15, fq = lane >> 4;
    LAS bf16* QT = (LAS bf16*)(lds + GA_END);
    LAS bf16* QI = (LAS bf16*)(lds + GA_END + 9216);
    LAS bf16* KT = (LAS bf16*)(lds + GA_END + 18432);
    LAS bf16* PP = (LAS bf16*)(lds);
    f32x4 o[4][2];
#pragma unroll
    for (int m = 0; m < 4; ++m)
#pragma unroll
        for (int n = 0; n < 2; ++n) o[m][n] = (f32x4){0.f, 0.f, 0.f, 0.f};
    for (int dir = 0; dir < 2; ++dir) {
        const int step = gla_step(cc, dir), chain = (b * 4 + h) * 2 + dir;
        __syncthreads();
        gla_cum(p, lds, Z0, r0, h, dir);
        LAS float* cum = (LAS float*)(lds + GA_CUM); LAS float* tot = (LAS float*)(lds + GA_TOT);
        {
            const int t = tid >> 2, d0 = (tid & 3) * 16;
            const bf16* zr = Z0 + (size_t)(r0 + t) * Z0P + h * 64 + d0;
            const u32x4 q0 = *(const u32x4*)(zr), q1 = *(const u32x4*)(zr + 8), k0 = *(const u32x4*)(zr + 256), k1 = *(const u32x4*)(zr + 264);
            const unsigned qq[8] = {q0.x, q0.y, q0.z, q0.w, q1.x, q1.y, q1.z, q1.w}, kk[8] = {k0.x, k0.y, k0.z, k0.w, k1.x, k1.y, k1.z, k1.w};
            unsigned oqt[8], oqi[8], okt[8];
#pragma unroll
            for (int i = 0; i < 8; ++i) {
                const int d = d0 + 2 * i;
                const float c0 = cum[t * 64 + d], c1 = cum[t * 64 + d + 1], t0 = tot[d], t1 = tot[d + 1];
                const float qa = bflo(qq[i]), qb = bfhi(qq[i]), ka = bflo(kk[i]), kb = bfhi(kk[i]);
                oqt[i] = pk2(qa * __expf(c0 - t0), qb * __expf(c1 - t1));
                oqi[i] = pk2(qa * __expf(c0), qb * __expf(c1));
                okt[i] = pk2(ka * __expf(t0 - c0), kb * __expf(t1 - c1));
            }
            *(LAS u32x4*)(QT + t * 72 + d0) = (u32x4){oqt[0], oqt[1], oqt[2], oqt[3]}; *(LAS u32x4*)(QT + t * 72 + d0 + 8) = (u32x4){oqt[4], oqt[5], oqt[6], oqt[7]};
            *(LAS u32x4*)(QI + t * 72 + d0) = (u32x4){oqi[0], oqi[1], oqi[2], oqi[3]}; *(LAS u32x4*)(QI + t * 72 + d0 + 8) = (u32x4){oqi[4], oqi[5], oqi[6], oqi[7]};
            *(LAS u32x4*)(KT + t * 72 + d0) = (u32x4){okt[0], okt[1], okt[2], okt[3]}; *(LAS u32x4*)(KT + t * 72 + d0 + 8) = (u32x4){okt[4], okt[5], okt[6], okt[7]};
        }
        __syncthreads();
        {
            f32x4 sa[4];
#pragma unroll
            for (int m = 0; m < 4; ++m) sa[m] = (f32x4){0.f, 0.f, 0.f, 0.f};
#pragma unroll
            for (int ks = 0; ks < 2; ++ks) {
                const bf16x8 kf = *(const LAS bf16x8*)(KT + (wid * 16 + fr) * 72 + ks * 32 + fq * 8);
#pragma unroll
                for (int m = 0; m < 4; ++m) {
                    const bf16x8 qfm = *(const LAS bf16x8*)(QT + (m * 16 + fr) * 72 + ks * 32 + fq * 8);
                    sa[m] = __builtin_amdgcn_mfma_f32_16x16x32_bf16(kf, qfm, sa[m], 0, 0, 0);
                }
            }
#pragma unroll
            for (int m = 0; m < 4; ++m) {
                const int t = m * 16 + fr;
                float v[4];
#pragma unroll
                for (int jj = 0; jj < 4; ++jj) { const int j = wid * 16 + fq * 4 + jj; const bool keep = dir == 0 ? (j <= t) : (j >= t); v[jj] = keep ? sa[m][jj] : 0.f; }
                *(LAS u32x2*)(PP + t * 72 + wid * 16 + fq * 4) = (u32x2){pk2(v[0], v[1]), pk2(v[2], v[3])};
            }
        }
        __syncthreads();
        const float* Sg = GS + ((size_t)chain * NSTEP + step) * 8192;
#pragma unroll
        for (int ks = 0; ks < 2; ++ks) {
            bf16x8 vfr[2], sfr[2];
#pragma unroll
            for (int n = 0; n < 2; ++n) {
                const int dv = wid * 32 + n * 16 + fr;
                vfr[n] = *(const bf16x8*)(VGT + (size_t)(h * 128 + dv) * TT + r0 + ks * 32 + fq * 8);
                const f32x4 s0 = *(const f32x4*)(Sg + (size_t)dv * 64 + ks * 32 + fq * 8), s1 = *(const f32x4*)(Sg + (size_t)dv * 64 + ks * 32 + fq * 8 + 4);
                sfr[n] = mk8((u32x4){pk2(s0.x, s0.y), pk2(s0.z, s0.w), pk2(s1.x, s1.y), pk2(s1.z, s1.w)});
            }
#pragma unroll
            for (int m = 0; m < 4; ++m) {
                const bf16x8 pfm = *(const LAS bf16x8*)(PP + (m * 16 + fr) * 72 + ks * 32 + fq * 8);
                const bf16x8 qim = *(const LAS bf16x8*)(QI + (m * 16 + fr) * 72 + ks * 32 + fq * 8);
#pragma unroll
                for (int n = 0; n < 2; ++n) {
                    o[m][n] = __builtin_amdgcn_mfma_f32_16x16x32_bf16(vfr[n], pfm, o[m][n], 0, 0, 0);
                    o[m][n] = __builtin_amdgcn_mfma_f32_16x16x32_bf16(sfr[n], qim, o[m][n], 0, 0, 0);
                }
            }
        }
    }
    __syncthreads();
    LAS float* red = (LAS float*)(lds + GA_END + 27648);
#pragma unroll
    for (int m = 0; m < 4; ++m) {
        float s = 0.f;
#pragma unroll
        for (int n = 0; n < 2; ++n)
#pragma unroll
            for (int j = 0; j < 4; ++j) s += o[m][n][j] * o[m][n][j];
        s += __shfl_xor(s, 16); s += __shfl_xor(s, 32);
        if (fq == 0) red[wid * 64 + m * 16 + fr] = s;
    }
    __syncthreads();
#pragma unroll
    for (int m = 0; m < 4; ++m) {
        const int t = m * 16 + fr;
        const float ss = red[t] + red[64 + t] + red[128 + t] + red[192 + t];
        const float rinv = rsqrtf(ss * (1.f / 128.f) + RMS_EPS);
        const int r = r0 + t;
#pragma unroll
        for (int n = 0; n < 2; ++n) {
            const int dv = wid * 32 + n * 16 + fq * 4;
            const u32x2 gw = *(const u32x2*)(Z0 + (size_t)r * Z0P + 512 + h * 128 + dv);
            const f32x4 ng = *(const f32x4*)(p.gla_norm + dv);
            const float g0 = bflo(gw.x), g1 = bfhi(gw.x), g2 = bflo(gw.y), g3 = bfhi(gw.y);
            const float y0 = o[m][n][0] * rinv * ng.x * siluf(g0), y1 = o[m][n][1] * rinv * ng.y * siluf(g1);
            const float y2 = o[m][n][2] * rinv * ng.z * siluf(g2), y3 = o[m][n][3] * rinv * ng.w * siluf(g3);
            *(u32x2*)(MIX + (size_t)r * DM + h * 128 + dv) = (u32x2){pk2(y0, y1), pk2(y2, y3)};
        }
    }
}

__device__ __forceinline__ void ph_swa_g1(const Params& p, LAS unsigned char* lds) {
    unsigned char* ws = p.ws;
    const bf16* QS = (const bf16*)(ws + A0_QS); const bf16* KS = (const bf16*)(ws + A0_KS); const bf16* VST = (const bf16*)(ws + A0_VST); bf16* MIX = (bf16*)(ws + A0_MIX);
    constexpr int N_SWA = 2 * 8 * 66, N_G1 = 2 * 4 * 2 * NSTEP;
    for (int item = blockIdx.x; item < N_SWA + N_G1; item += gridDim.x) {
        if (item < N_SWA) {
            const int qt = item % 66, rest = item / 66, h = rest & 7, b = rest >> 3, kvh = h >> 2;
            const bf16* Qg = QS + ((size_t)(b * 8 + h) * NKEY + qt * 128) * 64;
            const bf16* Kg = KS + (size_t)(b * 2 + kvh) * NKEY * 64;
            const bf16* Vg = VST + (size_t)(b * 2 + kvh) * 64 * NKEY;
            int b0 = 0, b1 = 0, qpos0 = 0, row0;
            if (qt >= 2) { qpos0 = (qt - 2) * 128; const int lo = qpos0 - 128 < 0 ? 0 : qpos0 - 128, hi2 = qpos0 + 256 > SEQ ? SEQ : qpos0 + 256; b0 = 4 + lo / 64; b1 = 4 + hi2 / 64; row0 = TC + b * SEQ + qpos0; }
            else row0 = b * CTX + qt * 128;
            const float sink = p.swa_sink[h] * LOG2E;
            attn_item<64, 64>(lds, Qg, Kg, Vg, 4, b0, b1, qpos0, sink, 1.f, MIX + (size_t)row0 * DM + 512 + h * 64, DM);
        } else gla_g1_item(p, lds, item - N_SWA);
    }
}
__device__ __forceinline__ void ph_gla_g3(const Params& p, LAS unsigned char* lds) {
    for (int item = blockIdx.x; item < 2 * 4 * NSTEP; item += gridDim.x) gla_g3_item(p, lds, item);
}

__device__ __forceinline__ void ph_router(const Params& p, LAS unsigned char* lds, int l, int row_lo) {
    unsigned char* ws = p.ws;
    const bf16* U = (const bf16*)(ws + OFF_U); const bf16* W = (const bf16*)(ws + OFF_W_RT) + (size_t)l * 128 * DM;
    int* cntg = (int*)(ws + OFF_CNT) + l * 64; int* tokslot = (int*)(ws + OFF_TOKSLOT); float* W8 = (float*)(ws + OFF_W8); int* LIST = (int*)(ws + OFF_LIST);
    const int tid = threadIdx.x, lane = tid & 63, wid = tid >> 6, wr = wid >> 1, wc = wid & 1, fr = lane & 15, fq = lane >> 4;
    LAS float* lg = (LAS float*)lds;
    LAS int* ebuf = (LAS int*)(lds + 34816) + wid * 256;
    LAS float* wbuf = (LAS float*)(lds + 34816 + 4096) + wid * 256;
    const float bias = p.b_router[l * 64 + lane];
    const int tm0 = row_lo / 128;
    for (int tm = tm0 + blockIdx.x; tm < TT / 128; tm += gridDim.x) {
        const int brow = tm * 128;
        const bf16 *a0, *a1, *b0, *b1; plain_ptrs(U, brow, DM, a0, a1); plain_ptrs(W, 0, DM, b0, b1);
        f32x4 acc[4][4];
        __syncthreads();
        gemm_core(lds, a0, a1, b0, b1, DM / 32, acc);
        if (wc == 0) {
#pragma unroll
            for (int m = 0; m < 4; ++m)
#pragma unroll
                for (int n = 0; n < 4; ++n)
#pragma unroll
                    for (int j = 0; j < 4; ++j) lg[(wr * 64 + m * 16 + fr) * 65 + n * 16 + fq * 4 + j] = acc[m][n][j];
        }
        __syncthreads();
        unsigned mask = 0u;
        for (int rr = 0; rr < 32; ++rr) {
            const float logit = lg[(wid * 32 + rr) * 65 + lane];
            const float score = 1.f / (1.f + expf(-logit));
            const float sel = score + bias;
            int rin = 0;
#pragma unroll
            for (int i = 0; i < 8; ++i) { const float ov = __shfl(sel, (lane & ~7) | i); rin += (ov > sel || (ov == sel && i < (lane & 7))) ? 1 : 0; }
            float gs = rin < 2 ? sel : 0.f;
            gs += __shfl_xor(gs, 1); gs += __shfl_xor(gs, 2); gs += __shfl_xor(gs, 4);
            int grk = 0;
#pragma unroll
            for (int g = 0; g < 8; ++g) { const float og = __shfl(gs, g * 8); grk += (og > gs || (og == gs && g < (lane >> 3))) ? 1 : 0; }
            const bool allowed = grk < 4;
            const float sm = allowed ? sel : -INFINITY;
            int rk = 0;
#pragma unroll 16
            for (int i = 0; i < 64; ++i) { const float ov = __shfl(sm, i); rk += (ov > sm || (ov == sm && i < lane)) ? 1 : 0; }
            const bool selected = allowed && rk < 8;
            const float wsum = wave_sum(selected ? score : 0.f);
            if (selected) { mask |= 1u << rr; ebuf[rr * 8 + rk] = lane; wbuf[rr * 8 + rk] = score / wsum * 2.5f; }
        }
        const int nsel = __popc(mask);
        int base = 0;
        if (nsel > 0) base = atomicAdd(cntg + lane, nsel);
        asm volatile("s_waitcnt lgkmcnt(0)" ::: "memory");
#pragma unroll
        for (int q = 0; q < 4; ++q) {
            const int ent = q * 64 + lane, rr = ent >> 3, rk = ent & 7;
            const int e = ebuf[ent]; const float w = wbuf[ent];
            const int be = __shfl(base, e); const unsigned me = (unsigned)__shfl((int)mask, e);
            const int pos = be + __popc(me & ((1u << rr) - 1u));
            const int t = brow + wid * 32 + rr;
            tokslot[(size_t)t * 8 + rk] = (e << 20) | pos;
            W8[(size_t)t * 8 + rk] = w;
            LIST[(size_t)e * TT + pos] = t * 8 + rk;
        }
    }
}

__device__ __forceinline__ int moe_find_expert(const LAS int* tp, int mtg) {
    int lo = 0, hi = 64;
    while (lo < hi) { const int mid = (lo + hi + 1) >> 1; if (tp[mid] <= mtg) lo = mid; else hi = mid - 1; }
    return lo;
}
__device__ __forceinline__ void ph_moe1(const Params& p, LAS unsigned char* lds, int l, int row_lo) {
    unsigned char* ws = p.ws;
    moe_tables(p, lds, l, row_lo);
    LAS int* cnt = (LAS int*)(lds + MOE_LDS_OFF); LAS int* tp = cnt + 80; LAS int* sp = tp + 80;
    const bf16* U = (const bf16*)(ws + OFF_U); const bf16* WGU = (const bf16*)(ws + OFF_W_GU); bf16* HM = (bf16*)(ws + AM_HM);
    const int* LIST = (const int*)(ws + OFF_LIST);
    const int tid = threadIdx.x, lane = tid & 63, wid = tid >> 6, wr = wid >> 1, wc = wid & 1, fr = lane & 15, fq = lane >> 4;
    const int ntiles = tp[65] * 4;
    for (int t = blockIdx.x; t < ntiles; t += gridDim.x) {
        const int mtg = t >> 2, nt = t & 3, e = moe_find_expert(tp, mtg), mt = mtg - tp[e], ce = cnt[e];
        const bf16 *a0, *a1, *b0, *b1;
        {
            const int i0 = mt * 128 + (tid >> 2), i1 = i0 + 64;
            int tk0 = row_lo, tk1 = row_lo;
            if (e < 64) { if (i0 < ce) tk0 = LIST[(size_t)e * TT + i0] >> 3; if (i1 < ce) tk1 = LIST[(size_t)e * TT + i1] >> 3; }
            else { if (i0 < ce) tk0 = row_lo + i0; if (i1 < ce) tk1 = row_lo + i1; }
            a0 = U + (size_t)tk0 * DM + stg_col(); a1 = U + (size_t)tk1 * DM + stg_col();
        }
        plain_ptrs(WGU + (size_t)e * 512 * DM, nt * 128, DM, b0, b1);
        f32x4 acc[4][4];
        gemm_core(lds, a0, a1, b0, b1, DM / 32, acc);
        const size_t slot0 = e < 64 ? (size_t)(sp[e] + mt * 128) : (size_t)TT * 8 + row_lo + mt * 128;
        const int hc0 = nt * 64 + wc * 32;
#pragma unroll
        for (int m = 0; m < 4; ++m) {
            const int i = wr * 64 + m * 16 + fr;
            if (mt * 128 + i < ce) {
#pragma unroll
                for (int n = 0; n < 2; ++n) {
                    const f32x4 g = acc[m][n], u = acc[m][n + 2];
                    const u32x2 w = {pk2(siluf(g[0]) * u[0], siluf(g[1]) * u[1]), pk2(siluf(g[2]) * u[2], siluf(g[3]) * u[3])};
                    *(u32x2*)(HM + (slot0 + i) * 256 + hc0 + n * 16 + fq * 4) = w;
                }
            }
        }
    }
}
__device__ __forceinline__ void ph_moe2(const Params& p, LAS unsigned char* lds, int l, int row_lo) {
    unsigned char* ws = p.ws;
    moe_tables(p, lds, l, row_lo);
    LAS int* cnt = (LAS int*)(lds + MOE_LDS_OFF); LAS int* tp = cnt + 80; LAS int* sp = tp + 80;
    const bf16* HM = (const bf16*)(ws + AM_HM); const bf16* WD = (const bf16*)(ws + OFF_W_D); bf16* YR = (bf16*)(ws + AM_YR);
    const int* LIST = (const int*)(ws + OFF_LIST); const float* W8 = (const float*)(ws + OFF_W8);
    const int tid = threadIdx.x, lane = tid & 63, wid = tid >> 6, wr = wid >> 1, wc = wid & 1, fr = lane & 15, fq = lane >> 4;
    const int ntiles = tp[65] * 8;
    for (int t = blockIdx.x; t < ntiles; t += gridDim.x) {
        const int mtg = t >> 3, nt = t & 7, e = moe_find_expert(tp, mtg), mt = mtg - tp[e], ce = cnt[e];
        const size_t slot0 = e < 64 ? (size_t)(sp[e] + mt * 128) : (size_t)TT * 8 + row_lo + mt * 128;
        const bf16 *a0, *a1, *b0, *b1;
        a0 = HM + (slot0 + (tid >> 2)) * 256 + stg_col(); a1 = a0 + 64 * 256;
        plain_ptrs(WD + (size_t)e * DM * 256, nt * 128, 256, b0, b1);
        f32x4 acc[4][4];
        gemm_core(lds, a0, a1, b0, b1, 256 / 32, acc);
#pragma unroll
        for (int m = 0; m < 4; ++m) {
            const int i = wr * 64 + m * 16 + fr, li = mt * 128 + i;
            if (li < ce) {
                const float w = e < 64 ? W8[LIST[(size_t)e * TT + li]] : 1.f;
#pragma unroll
                for (int n = 0; n < 4; ++n) {
                    const f32x4 a = acc[m][n] * w;
                    *(u32x2*)(YR + (slot0 + i) * DM + nt * 128 + wc * 64 + n * 16 + fq * 4) = (u32x2){pk2(a[0], a[1]), pk2(a[2], a[3])};
                }
            }
        }
    }
}

__device__ __forceinline__ void ph_inproj1(const Params& p, LAS unsigned char* lds) {
    unsigned char* ws = p.ws;
    const bf16* U = (const bf16*)(ws + OFF_U); const bf16* W = (const bf16*)(ws + OFF_W_IN_O);
    bf16* Z1 = (bf16*)(ws + A1_Z1); bf16* KM = (bf16*)(ws + A1_KM);
    const f32x2* rope = (const f32x2*)(ws + OFF_ROPE);
    const int tid = threadIdx.x, lane = tid & 63, wid = tid >> 6, wr = wid >> 1, wc = wid & 1, fr = lane & 15, fq = lane >> 4;
    constexpr int NTN = 7, NTM = TT / 128;
    for (int t = blockIdx.x; t < NTM * NTN; t += gridDim.x) {
        const int tm = t / NTN, tn = t % NTN, brow = tm * 128, bcol = tn * 128;
        const bf16 *a0, *a1, *b0, *b1; plain_ptrs(U, brow, DM, a0, a1); plain_ptrs(W, bcol, DM, b0, b1);
        f32x4 acc[4][4];
        gemm_core(lds, a0, a1, b0, b1, DM / 32, acc);
        const int cb = bcol + wc * 64;
#pragma unroll
        for (int m = 0; m < 4; ++m) {
            const int r = brow + wr * 64 + m * 16 + fr;
            if (cb < 768) {
#pragma unroll
                for (int n = 0; n < 4; ++n) *(u32x2*)(Z1 + (size_t)r * Z1P + cb + n * 16 + fq * 4) = (u32x2){pk2(acc[m][n][0], acc[m][n][1]), pk2(acc[m][n][2], acc[m][n][3])};
            } else if (cb == 768) {
                const RowInfo ri = rowinfo(r);
                f32x4 o[4];
#pragma unroll
                for (int n = 0; n < 2; ++n)
#pragma unroll
                    for (int j = 0; j < 4; ++j) {
                        const float x1 = acc[m][n][j], x2 = acc[m][n + 2][j];
                        if (ri.lat) { const f32x2 cs = rope[(size_t)ri.pos * 32 + n * 16 + fq * 4 + j]; o[n][j] = x1 * cs.x - x2 * cs.y; o[n + 2][j] = x2 * cs.x + x1 * cs.y; }
                        else { o[n][j] = x1; o[n + 2][j] = x2; }
                    }
#pragma unroll
                for (int h = 0; h < 8; ++h) {
                    bf16* dst = KM + ((size_t)(ri.b * 8 + h) * NKEY + ri.kq) * 192 + 128;
#pragma unroll
                    for (int n = 0; n < 4; ++n) *(u32x2*)(dst + n * 16 + fq * 4) = (u32x2){pk2(o[n][0], o[n][1]), pk2(o[n][2], o[n][3])};
                }
            }
        }
    }
}

__device__ __forceinline__ void ph_mla_up(const Params& p, LAS unsigned char* lds) {
    unsigned char* ws = p.ws;
    const bf16* Z1 = (const bf16*)(ws + A1_Z1); const bf16* WQ = (const bf16*)(ws + OFF_W_UQ); const bf16* WKV = (const bf16*)(ws + OFF_W_UKV);
    bf16* QM = (bf16*)(ws + A1_QM); bf16* KM = (bf16*)(ws + A1_KM); bf16* VTM = (bf16*)(ws + A1_VTM);
    const f32x2* rope = (const f32x2*)(ws + OFF_ROPE);
    const int tid = threadIdx.x, lane = tid & 63, wid = tid >> 6, wr = wid >> 1, wc = wid & 1, fr = lane & 15, fq = lane >> 4;
    LAS float* rsb = (LAS float*)(lds + 32768);
    constexpr int NQ = (TL / 128) * 12, NKV = (TT / 128) * 16;
    constexpr float QSCALE = 0.07216878364870322f * LOG2E;
    for (int t = blockIdx.x; t < NQ + NKV; t += gridDim.x) {
        const bool isq = t < NQ;
        int tm, tn;
        if (isq) { tm = 4 + t / 12; tn = t % 12; } else { const int u = t - NQ; tm = u / 16; tn = u % 16; }
        const int brow = tm * 128, bcol = tn * 128, K = isq ? 512 : 256, acol = isq ? 0 : 512;
        __syncthreads();
        {
            const int row = tid >> 1, half = tid & 1;
            const bf16* ap = Z1 + (size_t)(brow + row) * Z1P + acol + half * (K / 2);
            float ss = 0.f;
            for (int c = 0; c < K / 2; c += 8) { const u32x4 w = *(const u32x4*)(ap + c);
                const float v0 = bflo(w.x), v1 = bfhi(w.x), v2 = bflo(w.y), v3 = bfhi(w.y), v4 = bflo(w.z), v5 = bfhi(w.z), v6 = bflo(w.w), v7 = bfhi(w.w);
                ss += v0 * v0 + v1 * v1 + v2 * v2 + v3 * v3 + v4 * v4 + v5 * v5 + v6 * v6 + v7 * v7; }
            ss += __shfl_xor(ss, 1);
            if (half == 0) rsb[row] = rsqrtf(ss / (float)K + RMS_EPS);
        }
        const bf16 *a0, *a1, *b0, *b1; plain_ptrs(Z1 + acol, brow, Z1P, a0, a1); plain_ptrs(isq ? WQ : WKV, bcol, K, b0, b1);
        f32x4 acc[4][4];
        gemm_core(lds, a0, a1, b0, b1, K / 32, acc);
        const int cb = bcol + wc * 64;
#pragma unroll
        for (int m = 0; m < 4; ++m) {
            const int i = wr * 64 + m * 16 + fr, r = brow + i;
            const RowInfo ri = rowinfo(r);
            const float rs = rsb[i];
            if (isq) {
                const int h = cb / 192, part = (cb % 192) >> 6;
                bf16* dst = QM + ((size_t)(ri.b * 8 + h) * SEQ + ri.pos) * 192 + part * 64;
                const float sc = rs * QSCALE;
                if (part < 2) {
#pragma unroll
                    for (int n = 0; n < 4; ++n) *(u32x2*)(dst + n * 16 + fq * 4) = (u32x2){pk2(acc[m][n][0] * sc, acc[m][n][1] * sc), pk2(acc[m][n][2] * sc, acc[m][n][3] * sc)};
                } else {
                    f32x4 o[4];
#pragma unroll
                    for (int n = 0; n < 2; ++n)
#pragma unroll
                        for (int j = 0; j < 4; ++j) {
                            const float x1 = acc[m][n][j] * sc, x2 = acc[m][n + 2][j] * sc;
                            const f32x2 cs = rope[(size_t)ri.pos * 32 + n * 16 + fq * 4 + j];
                            o[n][j] = x1 * cs.x - x2 * cs.y; o[n + 2][j] = x2 * cs.x + x1 * cs.y;
                        }
#pragma unroll
                    for (int n = 0; n < 4; ++n) *(u32x2*)(dst + n * 16 + fq * 4) = (u32x2){pk2(o[n][0], o[n][1]), pk2(o[n][2], o[n][3])};
                }
            } else {
                const int h = cb >> 8, part = (cb & 255) >> 6;
                if (part < 2) {
                    bf16* dst = KM + ((size_t)(ri.b * 8 + h) * NKEY + ri.kq) * 192 + part * 64;
#pragma unroll
                    for (int n = 0; n < 4; ++n) *(u32x2*)(dst + n * 16 + fq * 4) = (u32x2){pk2(acc[m][n][0] * rs, acc[m][n][1] * rs), pk2(acc[m][n][2] * rs, acc[m][n][3] * rs)};
                } else {
                    bf16* dst = VTM + ((size_t)(ri.b * 8 + h) * 128 + (part - 2) * 64) * NKEY + ri.kq;
#pragma unroll
                    for (int n = 0; n < 4; ++n)
#pragma unroll
                        for (int j = 0; j < 4; ++j) dst[(size_t)(n * 16 + fq * 4 + j) * NKEY] = f2bf(acc[m][n][j] * rs);
                }
            }
        }
    }
}

__device__ __forceinline__ void ph_mla_attn(const Params& p, LAS unsigned char* lds) {
    unsigned char* ws = p.ws;
    const bf16* QM = (const bf16*)(ws + A1_QM); const bf16* KM = (const bf16*)(ws + A1_KM); const bf16* VTM = (const bf16*)(ws + A1_VTM); bf16* MIX = (bf16*)(ws + A1_MIX);
    for (int item = blockIdx.x; item < 2 * 8 * 64; item += gridDim.x) {
        const int qt = item & 63, h = (item >> 6) & 7, b = item >> 9;
        const bf16* Qg = QM + ((size_t)(b * 8 + h) * SEQ + qt * 128) * 192;
        const bf16* Kg = KM + (size_t)(b * 8 + h) * NKEY * 192;
        const bf16* Vg = VTM + (size_t)(b * 8 + h) * 128 * NKEY;
        attn_item<192, 128>(lds, Qg, Kg, Vg, NKEY / 64, 0, 0, 0, -1e30f, 0.f, MIX + (size_t)(TC + b * SEQ + qt * 128) * DM + h * 128, DM);
    }
}


#define XB_TMO      128
#define XB_XCNT(j)  (256  + 64 * (j))
#define XB_XSUB(j)  (1280 + 64 * (j))
#define XB_XGEN(j)  (2304 + 64 * (j))
#define XB_TOP      3328
#define XB_TOPGEN   3392
#define XCD_BAR_WORDS 3456
#define XB_SPIN_CAP (1u << 18)
__device__ __forceinline__ unsigned xb_ld(unsigned* p)              { return __hip_atomic_load(p, __ATOMIC_RELAXED, __HIP_MEMORY_SCOPE_AGENT); }
__device__ __forceinline__ unsigned xb_add(unsigned* p, unsigned v) { return __hip_atomic_fetch_add(p, v, __ATOMIC_RELAXED, __HIP_MEMORY_SCOPE_AGENT); }
__device__ __forceinline__ unsigned xb_xcc_id() { return (unsigned)__builtin_amdgcn_s_getreg((3 << 11) | 20) & 0xFu; }
#define XB_SPIN(cond, bar) do { unsigned _sp = 0; while (cond) { __builtin_amdgcn_s_sleep(1); \
    if ((++_sp & 255u) == 0u) { if (xb_ld(&(bar)[XB_TMO])) break; if (_sp > XB_SPIN_CAP) { atomicAdd(&(bar)[XB_TMO], 1u); break; } } } } while (0)
struct XcdBarrier { unsigned* bar; unsigned x; volatile LAS unsigned* st; };
__device__ __forceinline__ XcdBarrier xcd_barrier_post(unsigned* bar, volatile LAS unsigned* st) {
    XcdBarrier b; b.bar = bar; b.x = xb_xcc_id(); b.st = st;
    if (threadIdx.x == 0) (void)xb_add(&bar[XB_XCNT(b.x)], 1u);
    return b;
}
__device__ __forceinline__ void xcd_barrier_complete(unsigned* bar, unsigned x, unsigned& nloc, unsigned& nx) {
    const unsigned G = gridDim.x * gridDim.y * gridDim.z;
    unsigned sum, cnt, mine, sp = 0u;
    for (;;) {
        sum = 0u; cnt = 0u; mine = 0u;
#pragma unroll
        for (unsigned j = 0; j < 16; ++j) { const unsigned c = xb_ld(&bar[XB_XCNT(j)]); sum += c; cnt += (c > 0u) ? 1u : 0u; mine = (j == x) ? c : mine; }
        if (sum == G) break;
        __builtin_amdgcn_s_sleep(1);
        if ((++sp & 255u) == 0u) { if (xb_ld(&bar[XB_TMO])) break; if (sp > XB_SPIN_CAP) { atomicAdd(&bar[XB_TMO], 1u); break; } }
    }
    nloc = mine > 0u ? mine : 1u; nx = cnt > 0u ? cnt : 1u;
}
__device__ __forceinline__ void xcd_barrier(const XcdBarrier& b) {
    asm volatile("s_waitcnt vmcnt(0)" ::: "memory");
    __syncthreads();
    if (threadIdx.x == 0) {
        unsigned* bar = b.bar;
        __builtin_amdgcn_s_waitcnt(0);
        unsigned nloc = b.st[0], nx = b.st[1];
        if (nloc == 0u) { xcd_barrier_complete(bar, b.x, nloc, nx); b.st[0] = nloc; b.st[1] = nx; }
        const unsigned old = xb_add(&bar[XB_XSUB(b.x)], 1u);
        const unsigned gen = old / nloc;
        if (old + 1u == (gen + 1u) * nloc) {
            __builtin_amdgcn_fence(__ATOMIC_RELEASE, "agent");
            asm volatile("s_waitcnt vmcnt(0)" ::: "memory");
            const unsigned og = xb_add(&bar[XB_TOP], 1u);
            const unsigned tg = og / nx;
            if (og + 1u == (tg + 1u) * nx) xb_add(&bar[XB_TOPGEN], 1u);
            else XB_SPIN(xb_ld(&bar[XB_TOPGEN]) == tg, bar);
            __builtin_amdgcn_fence(__ATOMIC_ACQUIRE, "agent");
            xb_add(&bar[XB_XGEN(b.x)], 1u);
            asm volatile("s_waitcnt vmcnt(0)" ::: "memory");
        } else {
            XB_SPIN(xb_ld(&bar[XB_XGEN(b.x)]) == gen, bar);
            __builtin_amdgcn_fence(__ATOMIC_ACQUIRE, "agent");
            asm volatile("s_waitcnt vmcnt(0)" ::: "memory");
        }
    }
    __syncthreads();
}
static_assert(XCD_BAR_WORDS * 4 <= BAR_BYTES, "barrier words");

constexpr int NPHASE = 19;
__global__ void __launch_bounds__(256, 2) mega(Params p) {
    extern __shared__ __attribute__((aligned(16))) unsigned char lds_[];
    LAS unsigned char* lds = (LAS unsigned char*)lds_;
    cg::grid_group grid = cg::this_grid();
    unsigned char* ws = p.ws;
    volatile LAS unsigned* bst = (volatile LAS unsigned*)(lds + LDS_BYTES - 16);
    if (threadIdx.x < 4) bst[threadIdx.x] = 0u;
    __syncthreads();
    const XcdBarrier xbar = xcd_barrier_post((unsigned*)(ws + OFF_BAR), bst);
#define GRID_BAR(k) do { if ((k) == 0) grid.sync(); else xcd_barrier(xbar); } while (0)
#ifndef PROBE_REP_MASK
#define PROBE_REP_MASK 0u
#endif
#ifndef PROBE_EXTRA_SYNCS
#define PROBE_EXTRA_SYNCS 0
#endif
#define PHASE(k, body) do { if (p.ph_lo <= (k) && (k) < p.ph_hi) { body; if ((PROBE_REP_MASK >> (k)) & 1u) { xcd_barrier(xbar); body; } if ((k) + 1 < p.ph_hi) GRID_BAR(k); } } while (0)
    for (int i = 0; i < PROBE_EXTRA_SYNCS; ++i) xcd_barrier(xbar);
    PHASE(0, ph_prep(p, lds));
    PHASE(1, ph_modulate0(p));
    PHASE(2, ph_inproj0(p, lds));
    PHASE(3, ph_swa_g1(p, lds));
    PHASE(4, ph_gla_scan(p));
    PHASE(5, ph_gla_g3(p, lds));
    PHASE(6, ph_outproj(p, lds, (const bf16*)(ws + A0_MIX), (const bf16*)(ws + OFF_W_OUT_E), (float*)(ws + A0_Y), 0));
    PHASE(7, ph_rowpassA(p, 0, 0, (const float*)(ws + A0_Y)));
    PHASE(8, ph_router(p, lds, 0, 0));
    PHASE(9, ph_moe1(p, lds, 0, 0));
    PHASE(10, ph_moe2(p, lds, 0, 0));
    PHASE(11, { ph_rowpassB(p, lds, 0, 0); __syncthreads(); for (int it = blockIdx.x; it < EXP_ITEMS; it += gridDim.x) expert_convert_item(p, lds, 1, it); });
    PHASE(12, ph_inproj1(p, lds));
    PHASE(13, ph_mla_up(p, lds));
    PHASE(14, ph_mla_attn(p, lds));
    PHASE(15, ph_outproj(p, lds, (const bf16*)(ws + A1_MIX), (const bf16*)(ws + OFF_W_OUT_O), (float*)(ws + A1_Y), TC));
    PHASE(16, ph_rowpassA(p, 1, TC, (const float*)(ws + A1_Y)));
    PHASE(17, ph_router(p, lds, 1, TC));
    PHASE(18, ph_moe1(p, lds, 1, TC));
    PHASE(19, ph_moe2(p, lds, 1, TC));
    PHASE(20, ph_rowpassB(p, lds, 1, TC));
}

extern "C" void kernel_launch(void* const* d_in, const int* in_sizes, int n_in, void* d_out, int out_size, void* d_ws, size_t ws_size, hipStream_t stream) {
    static int grid_blocks = 0;
    if (!grid_blocks) {
        int dev = 0, cus = 0, per_cu = 0;
        (void)hipGetDevice(&dev);
        (void)hipDeviceGetAttribute(&cus, hipDeviceAttributeMultiprocessorCount, dev);
        (void)hipFuncSetAttribute((const void*)mega, hipFuncAttributeMaxDynamicSharedMemorySize, LDS_BYTES);
        (void)hipOccupancyMaxActiveBlocksPerMultiprocessor(&per_cu, (const void*)mega, 256, LDS_BYTES);
        if (per_cu > 2) per_cu = 2;
        if (per_cu < 1) per_cu = 1;
        grid_blocks = cus * per_cu;
        if (ws_size < WS_NEED) fprintf(stderr, "kernel_launch: workspace too small: %zu < %zu\n", ws_size, (size_t)WS_NEED);
    }
    Params p{};
    const float** f = (const float**)&p;
    for (int i = 0; i < 30; ++i) f[i] = (const float*)d_in[i];
    p.out = (float*)d_out; p.ws = (unsigned char*)d_ws; p.ph_lo = 0; p.ph_hi = 21;
    (void)hipMemsetAsync((unsigned char*)d_ws + OFF_BAR, 0, BAR_BYTES, stream);
    void* args[] = {&p};
    hipError_t e = hipLaunchCooperativeKernel((const void*)mega, dim3(grid_blocks), dim3(256), args, LDS_BYTES, stream);
    if (e != hipSuccess) fprintf(stderr, "cooperative launch failed: %s (grid %d)\n", hipGetErrorString(e), grid_blocks);
}
```

```cpp
#include <hip/hip_runtime.h>
#include <hip/hip_cooperative_groups.h>
#include <cstdio>
#include <cstdint>
namespace cg = cooperative_groups;

#define LAS __attribute__((address_space(3)))
typedef unsigned short bf16;
typedef short bf16x8 __attribute__((ext_vector_type(8)));
typedef float f32x2 __attribute__((ext_vector_type(2)));
typedef float f32x4 __attribute__((ext_vector_type(4)));
typedef float f32x8 __attribute__((ext_vector_type(8)));
typedef float f32x16 __attribute__((ext_vector_type(16)));
typedef unsigned u32x2 __attribute__((ext_vector_type(2)));
typedef unsigned u32x4 __attribute__((ext_vector_type(4)));
typedef __bf16 bf16x2_t __attribute__((ext_vector_type(2)));

constexpr int DM = 1024, NB = 2, SEQ = 8192, CTX = 256;
constexpr int TC = NB * CTX, TL = NB * SEQ, TT = TC + TL, NKEY = CTX + SEQ;
constexpr int NEXP = 64;
constexpr float RMS_EPS = 1e-6f;
constexpr int E_IN_PAD = 2432, O_IN_PAD = 896;
constexpr float LOG2E = 1.4426950408889634f;
constexpr int NSTEP = 132;
constexpr int Z0P = 1056;
constexpr int Z1P = 768;
constexpr int LDS_BYTES = 73728;

constexpr size_t al(size_t x) { return (x + 255) & ~(size_t)255; }
constexpr size_t OFF_W_IN_E = 0;
constexpr size_t OFF_W_OUT_E = OFF_W_IN_E + al((size_t)E_IN_PAD * DM * 2);
constexpr size_t OFF_W_IN_O = OFF_W_OUT_E + al((size_t)DM * DM * 2);
constexpr size_t OFF_W_UQ = OFF_W_IN_O + al((size_t)O_IN_PAD * DM * 2);
constexpr size_t OFF_W_UKV = OFF_W_UQ + al((size_t)1536 * 512 * 2);
constexpr size_t OFF_W_OUT_O = OFF_W_UKV + al((size_t)2048 * 256 * 2);
constexpr size_t OFF_W_RT = OFF_W_OUT_O + al((size_t)DM * DM * 2);
constexpr size_t OFF_W_GU = OFF_W_RT + al((size_t)2 * 128 * DM * 2);
constexpr size_t OFF_W_D = OFF_W_GU + al((size_t)65 * 512 * DM * 2);
constexpr size_t OFF_U = OFF_W_D + al((size_t)65 * DM * 256 * 2);
constexpr size_t OFF_HC = OFF_U + al((size_t)TT * DM * 2);
constexpr size_t OFF_MOD = OFF_HC + al((size_t)TC * DM * 4);
constexpr size_t OFF_ROPE = OFF_MOD + al((size_t)2 * 3 * 6144 * 4);
constexpr size_t OFF_CNT = OFF_ROPE + al((size_t)SEQ * 32 * 8);
constexpr size_t OFF_TOKSLOT = OFF_CNT + al(2 * 64 * 4);
constexpr size_t OFF_W8 = OFF_TOKSLOT + al((size_t)TT * 8 * 4);
constexpr size_t OFF_LIST = OFF_W8 + al((size_t)TT * 8 * 4);
constexpr size_t OFF_BAR = OFF_LIST + al((size_t)64 * TT * 4);
constexpr size_t BAR_BYTES = 16384;
constexpr size_t OFF_ARENA = OFF_BAR + BAR_BYTES;
constexpr size_t A0_Z0 = OFF_ARENA;
constexpr size_t A0_VGT = A0_Z0 + al((size_t)TT * Z0P * 2);
constexpr size_t A0_QS = A0_VGT + al((size_t)4 * 128 * TT * 2);
constexpr size_t A0_KS = A0_QS + al((size_t)2 * 8 * NKEY * 64 * 2);
constexpr size_t A0_VST = A0_KS + al((size_t)2 * 2 * NKEY * 64 * 2);
constexpr size_t A0_GS = A0_VST + al((size_t)2 * 2 * 64 * NKEY * 2);
constexpr size_t A0_GD = A0_GS + al((size_t)16 * NSTEP * 8192 * 4);
constexpr size_t A0_MIX = A0_GD + al((size_t)16 * NSTEP * 64 * 4);
constexpr size_t A0_Y = A0_MIX + al((size_t)TT * DM * 2);
constexpr size_t A0_END = A0_Y + al((size_t)TT * DM * 4);
constexpr size_t A1_Z1 = OFF_ARENA;
constexpr size_t A1_QM = A1_Z1 + al((size_t)TT * Z1P * 2);
constexpr size_t A1_KM = A1_QM + al((size_t)2 * 8 * SEQ * 192 * 2);
constexpr size_t A1_VTM = A1_KM + al((size_t)2 * 8 * NKEY * 192 * 2);
constexpr size_t A1_MIX = A1_VTM + al((size_t)2 * 8 * 128 * NKEY * 2);
constexpr size_t A1_Y = A1_MIX + al((size_t)TT * DM * 2);
constexpr size_t A1_END = A1_Y + al((size_t)TT * DM * 4);
constexpr size_t AM_HM = OFF_ARENA;
constexpr size_t AM_YR = AM_HM + al((size_t)TT * 9 * 256 * 2);
constexpr size_t AM_END = AM_YR + al((size_t)TT * 9 * 1024 * 2);
constexpr size_t WS_NEED = AM_END > A0_END ? (AM_END > A1_END ? AM_END : A1_END) : (A0_END > A1_END ? A0_END : A1_END);
static_assert(WS_NEED <= 555747360ull, "workspace map exceeds the guaranteed d_ws size");

struct Params {
    const float *x, *c, *ctx, *c_ctx, *w_mod, *b_mod, *g_mix_pre, *g_mix_post, *g_ffn_pre, *g_ffn_post;
    const float *w_in_e, *gla_wa2, *gla_ba, *gla_norm, *swa_sink, *w_out_e;
    const float *w_in_o, *mla_q_norm, *mla_kv_norm, *w_uq, *w_ukv, *w_out_o;
    const float *w_router, *b_router, *w_exp_gate, *w_exp_up, *w_exp_down, *w_sh_gate, *w_sh_up, *w_sh_down;
    float* out; unsigned char* ws; int ph_lo, ph_hi;
};

__device__ __forceinline__ unsigned pk2(float lo, float hi) { f32x2 v = {lo, hi}; bf16x2_t b = __builtin_convertvector(v, bf16x2_t); return __builtin_bit_cast(unsigned, b); }
__device__ __forceinline__ float bflo(unsigned u) { return __uint_as_float(u << 16); }
__device__ __forceinline__ float bfhi(unsigned u) { return __uint_as_float(u & 0xffff0000u); }
__device__ __forceinline__ float bf2f(bf16 v) { return __uint_as_float((unsigned)v << 16); }
__device__ __forceinline__ bf16 f2bf(float f) { return (bf16)(pk2(f, 0.f) & 0xffffu); }
__device__ __forceinline__ float wave_sum(float v) {
#pragma unroll
    for (int o = 1; o < 64; o <<= 1) v += __shfl_xor(v, o);
    return v;
}
__device__ __forceinline__ void glds16(const void* g, LAS void* l) { __builtin_amdgcn_global_load_lds((const unsigned*)g, (LAS unsigned*)l, 16, 0, 0); }
__device__ __forceinline__ float siluf(float x) { return x / (1.f + __expf(-x)); }
__device__ __forceinline__ float ex2(float x) { return __builtin_amdgcn_exp2f(x); }
__device__ __forceinline__ int crow(int r, int hi) { return (r & 3) + 8 * (r >> 2) + 4 * hi; }
__device__ __forceinline__ bf16x8 mk8(u32x4 v) { return __builtin_bit_cast(bf16x8, v); }

struct RowInfo { int b, kq, pos; bool lat; };
__device__ __forceinline__ RowInfo rowinfo(int r) {
    RowInfo i;
    if (r < TC) { i.b = r >> 8; i.pos = r & 255; i.kq = i.pos; i.lat = false; }
    else { const int rl = r - TC; i.b = rl >> 13; i.pos = rl & (SEQ - 1); i.kq = CTX + i.pos; i.lat = true; }
    return i;
}
__device__ __forceinline__ int modvec(int r) { return r < TC ? 2 : ((r - TC) >> 13); }

struct GPtrs { const bf16* a[4]; const bf16* b[4]; };
constexpr int G_STAGE = 32768;
#define G_FENCE() asm volatile("" ::: "memory")
__device__ __forceinline__ void gemm_issue(LAS unsigned char* lds, const GPtrs& g, int kt) {
    LAS unsigned char* d = lds + (kt & 1) * G_STAGE + threadIdx.x * 16; const int ko = kt * 64;
#pragma unroll
    for (int i = 0; i < 4; ++i) { glds16(g.a[i] + ko, d + i * 4096); glds16(g.b[i] + ko, d + 16384 + i * 4096); }
}
__device__ __forceinline__ void gemm_prologue(LAS unsigned char* lds, const GPtrs& g, int nk) { gemm_issue(lds, g, 0); }
__device__ __forceinline__ void gemm_main(LAS unsigned char* lds, const GPtrs& g, int nk, f32x4 (&acc)[4][4], bool) {
    const int tid = threadIdx.x, lane = tid & 63, wid = tid >> 6, wr = wid >> 1, wc = wid & 1, fr = lane & 15, fq = lane >> 4;
#pragma unroll
    for (int m = 0; m < 4; ++m)
#pragma unroll
        for (int n = 0; n < 4; ++n) acc[m][n] = (f32x4){0.f, 0.f, 0.f, 0.f};
    const int c0 = ((fq) ^ (fr & 7)) * 16, c1 = ((4 + fq) ^ (fr & 7)) * 16;
    const int aoff = (wr * 64 + fr) * 128, boff = 16384 + (wc * 64 + fr) * 128;
    for (int kt = 0; kt < nk; ++kt) {
        asm volatile("s_waitcnt vmcnt(0) lgkmcnt(0)" ::: "memory");
        __builtin_amdgcn_s_barrier();
        G_FENCE();
        if (kt + 1 < nk) gemm_issue(lds, g, kt + 1);
        LAS unsigned char* base = lds + (kt & 1) * G_STAGE;
#pragma unroll
        for (int ks = 0; ks < 2; ++ks) {
            const int co = ks ? c1 : c0;
            bf16x8 af[4], bfr[4];
#pragma unroll
            for (int m = 0; m < 4; ++m) af[m] = *(const LAS bf16x8*)(base + aoff + m * 2048 + co);
#pragma unroll
            for (int n = 0; n < 4; ++n) bfr[n] = *(const LAS bf16x8*)(base + boff + n * 2048 + co);
#pragma unroll
            for (int m = 0; m < 4; ++m)
#pragma unroll
                for (int n = 0; n < 4; ++n) acc[m][n] = __builtin_amdgcn_mfma_f32_16x16x32_bf16(bfr[n], af[m], acc[m][n], 0, 0, 0);
        }
    }
    asm volatile("s_waitcnt lgkmcnt(0)" ::: "memory");
    __builtin_amdgcn_s_barrier();
    G_FENCE();
}
__device__ __forceinline__ int vcu_id() { const int b = blockIdx.x, G = gridDim.x; return (G % 8 == 0) ? (b % 8) * (G / 8) + b / 8 : b; }
__device__ __forceinline__ void tile_mn(int w, int ntm, int ntn, int& tm, int& tn) {
    const int nig = 8 * ntn, gid = w / nig, fm = gid * 8, gsz = (ntm - fm) < 8 ? (ntm - fm) : 8, within = w - gid * nig;
    tm = fm + within % gsz; tn = within / gsz;
}
template <bool PREFETCH_NEXT, class Make, class Epi>
__device__ __forceinline__ void gemm_tiles(LAS unsigned char* lds, int t0, int nt, int stride, Make make, Epi epi) {
    if (t0 >= nt) return;
    GPtrs g; int nk;
    make(t0, g, nk);
    G_FENCE();
    gemm_prologue(lds, g, nk);
    bool first = true;
    for (int t = t0; t < nt;) {
        const int tn = t + stride;
        f32x4 acc[4][4];
        gemm_main(lds, g, nk, acc, !first);
        first = false;
        if (PREFETCH_NEXT) { if (tn < nt) { make(tn, g, nk); G_FENCE(); gemm_prologue(lds, g, nk); } epi(t, acc); }
        else { epi(t, acc); __syncthreads(); if (tn < nt) { make(tn, g, nk); G_FENCE(); gemm_prologue(lds, g, nk); } }
        t = tn;
    }
}

__device__ __forceinline__ int ein_map(int n) {
    if (n < 512) return n;
    if (n < 1024) return n + 512;
    if (n < 1536) return n - 512;
    if (n < 2048) return 1568 + (n - 1536);
    if (n < 2176) return 2080 + (n - 2048);
    if (n < 2304) return 2208 + (n - 2176);
    if (n < 2320) return 1536 + (n - 2304);
    if (n < 2336) return 1552 + (n - 2320);
    return -1;
}
__device__ __forceinline__ void transpose_item(LAS unsigned char* lds, int K, bf16* dst, int k0, int n0, int ld, int mode, const float* srcA, const float* srcB, int nvalid, const float* kscale) {
    LAS float* tile = (LAS float*)lds;
    const int tid = threadIdx.x;
    {
        const int nq = tid & 31, kr = tid >> 5, n = n0 + nq * 4;
        const float* cp = nullptr; float sc = 1.f;
        if (mode == 0) { if (n < nvalid) cp = srcA + n; }
        else if (mode == 1) { const int c = ein_map(n); if (c >= 0) cp = srcA + c; if (n < 256) sc = 0.125f; }
        else { const int grp = n >> 6, w = n & 63; cp = (w < 32 ? srcA : srcB) + grp * 32 + (w & 31); }
        f32x4 v[8];
#pragma unroll
        for (int i = 0; i < 8; ++i) { const int k = kr + 8 * i; v[i] = cp ? *(const f32x4*)(cp + (size_t)(k0 + k) * ld) : (f32x4){0.f, 0.f, 0.f, 0.f}; }
#pragma unroll
        for (int i = 0; i < 8; ++i) { const int k = kr + 8 * i; float m = sc; if (kscale) m *= kscale[k0 + k]; *(LAS f32x4*)(tile + k * 132 + nq * 4) = v[i] * m; }
    }
    __syncthreads();
    {
        const int n = tid >> 1, hf = tid & 1;
#pragma unroll
        for (int c = 0; c < 4; ++c) {
            const int k8 = hf * 32 + c * 8;
            u32x4 o;
            o.x = pk2(tile[(k8 + 0) * 132 + n], tile[(k8 + 1) * 132 + n]);
            o.y = pk2(tile[(k8 + 2) * 132 + n], tile[(k8 + 3) * 132 + n]);
            o.z = pk2(tile[(k8 + 4) * 132 + n], tile[(k8 + 5) * 132 + n]);
            o.w = pk2(tile[(k8 + 6) * 132 + n], tile[(k8 + 7) * 132 + n]);
            *(u32x4*)(dst + (size_t)(n0 + n) * K + k0 + k8) = o;
        }
    }
    __syncthreads();
}

constexpr int EXP_GU_ITEMS = 65 * 16 * 4, EXP_D_ITEMS = 65 * 4 * 8, EXP_ITEMS = EXP_GU_ITEMS + EXP_D_ITEMS;
__device__ __forceinline__ void expert_convert_item(const Params& p, LAS unsigned char* lds, int l, int it) {
    unsigned char* ws = p.ws;
    if (it < EXP_GU_ITEMS) {
        const int e = it / 64, r = it % 64, kb = r / 4, nb = r % 4;
        const float* gate = e < 64 ? p.w_exp_gate + ((size_t)(l * 64 + e)) * DM * 256 : p.w_sh_gate + (size_t)l * DM * 256;
        const float* up = e < 64 ? p.w_exp_up + ((size_t)(l * 64 + e)) * DM * 256 : p.w_sh_up + (size_t)l * DM * 256;
        transpose_item(lds, DM, (bf16*)(ws + OFF_W_GU) + (size_t)e * 512 * DM, kb * 64, nb * 128, 256, 2, gate, up, 512, nullptr);
    } else {
        it -= EXP_GU_ITEMS;
        const int e = it / 32, r = it % 32, kb = r / 8, nb = r % 8;
        const float* dn = e < 64 ? p.w_exp_down + ((size_t)(l * 64 + e)) * 256 * DM : p.w_sh_down + (size_t)l * 256 * DM;
        transpose_item(lds, 256, (bf16*)(ws + OFF_W_D) + (size_t)e * DM * 256, kb * 64, nb * 128, DM, 0, dn, nullptr, DM, nullptr);
    }
}

__device__ __forceinline__ void ph_prep(const Params& p, LAS unsigned char* lds) {
    unsigned char* ws = p.ws;
    const int tid = threadIdx.x;
    if (blockIdx.x == 0 && tid < 128) ((int*)(ws + OFF_CNT))[tid] = 0;
    constexpr int I_MOD = 96, I_ROPE = 1024, I_INE = 16 * 19, I_OUTE = 128, I_INO = 16 * 7, I_UQ = 8 * 12, I_UKV = 4 * 16, I_OUTO = 128, I_RT = 32;
    constexpr int NITEMS = I_MOD + I_ROPE + I_INE + I_OUTE + I_INO + I_UQ + I_UKV + I_OUTO + I_RT;
    for (int item = blockIdx.x; item < NITEMS; item += gridDim.x) {
        int it = item;
        if (it < I_MOD) {
            const int l = it / 48, n0 = (it % 48) * 128, kg = tid >> 5, cl = tid & 31;
            LAS float* s = (LAS float*)lds;
            LAS float* red = (LAS float*)(lds + 12288);
            for (int idx = tid; idx < 3072; idx += 256) { const int v = idx >> 10, k = idx & 1023; const float cv = v < 2 ? p.c[v * DM + k] : p.c_ctx[k]; s[idx] = cv / (1.f + expf(-cv)); }
            __syncthreads();
            f32x4 a0 = {0.f, 0.f, 0.f, 0.f}, a1 = a0, a2 = a0;
            const float* w = p.w_mod + (size_t)l * DM * 6144 + (size_t)(kg * 128) * 6144 + n0 + cl * 4;
#pragma unroll 8
            for (int k = 0; k < 128; ++k) { const f32x4 wv = *(const f32x4*)(w + (size_t)k * 6144); const int kk = kg * 128 + k; a0 += wv * s[kk]; a1 += wv * s[1024 + kk]; a2 += wv * s[2048 + kk]; }
            *(LAS f32x4*)(red + (kg * 3 + 0) * 128 + cl * 4) = a0; *(LAS f32x4*)(red + (kg * 3 + 1) * 128 + cl * 4) = a1; *(LAS f32x4*)(red + (kg * 3 + 2) * 128 + cl * 4) = a2;
            __syncthreads();
            for (int idx = tid; idx < 384; idx += 256) { const int v = idx >> 7, n = idx & 127; float acc = 0.f;
#pragma unroll
                for (int g = 0; g < 8; ++g) acc += red[(g * 3 + v) * 128 + n];
                ((float*)(ws + OFF_MOD))[((size_t)l * 3 + v) * 6144 + n0 + n] = acc + p.b_mod[l * 6144 + n0 + n]; }
            __syncthreads();
            continue;
        }
        it -= I_MOD;
        if (it < I_ROPE) {
            const int idx = it * 256 + tid, pos = idx >> 5, i = idx & 31, row = pos >> 6, col = pos & 63, j = i & 15;
            const float invf = powf(10000.f, -(float)(2 * j) / 32.f);
            const float ang = (float)(i < 16 ? row : col) * invf;
            float sn, cs; sincosf(ang, &sn, &cs);
            ((f32x2*)(ws + OFF_ROPE))[idx] = (f32x2){cs, sn};
            continue;
        }
        it -= I_ROPE;
        if (it < I_INE) { const int kb = it / 19, nb = it % 19;
            transpose_item(lds, DM, (bf16*)(ws + OFF_W_IN_E), kb * 64, nb * 128, 2336, 1, p.w_in_e, nullptr, 2336, nullptr); continue; }
        it -= I_INE;
        if (it < I_OUTE) { const int kb = it / 8, nb = it % 8;
            transpose_item(lds, DM, (bf16*)(ws + OFF_W_OUT_E), kb * 64, nb * 128, DM, 0, p.w_out_e, nullptr, DM, nullptr); continue; }
        it -= I_OUTE;
        if (it < I_INO) { const int kb = it / 7, nb = it % 7;
            transpose_item(lds, DM, (bf16*)(ws + OFF_W_IN_O), kb * 64, nb * 128, 832, 0, p.w_in_o, nullptr, 832, nullptr); continue; }
        it -= I_INO;
        if (it < I_UQ) { const int kb = it / 12, nb = it % 12;
            transpose_item(lds, 512, (bf16*)(ws + OFF_W_UQ), kb * 64, nb * 128, 1536, 0, p.w_uq, nullptr, 1536, p.mla_q_norm); continue; }
        it -= I_UQ;
        if (it < I_UKV) { const int kb = it / 16, nb = it % 16;
            transpose_item(lds, 256, (bf16*)(ws + OFF_W_UKV), kb * 64, nb * 128, 2048, 0, p.w_ukv, nullptr, 2048, p.mla_kv_norm); continue; }
        it -= I_UKV;
        if (it < I_OUTO) { const int kb = it / 8, nb = it % 8;
            transpose_item(lds, DM, (bf16*)(ws + OFF_W_OUT_O), kb * 64, nb * 128, DM, 0, p.w_out_o, nullptr, DM, nullptr); continue; }
        it -= I_OUTO;
        { const int l = it / 16, kb = it % 16;
            transpose_item(lds, DM, (bf16*)(ws + OFF_W_RT) + (size_t)l * 128 * DM, kb * 64, 0, 64, 0, p.w_router + (size_t)l * DM * 64, nullptr, 64, nullptr); }
    }
}

__device__ __forceinline__ void load_row(const float* src, int lane, f32x4 (&v)[4]) {
#pragma unroll
    for (int j = 0; j < 4; ++j) v[j] = *(const f32x4*)(src + lane * 4 + 256 * j);
}
__device__ __forceinline__ float row_sumsq(const f32x4 (&v)[4]) {
    float s = 0.f;
#pragma unroll
    for (int j = 0; j < 4; ++j) s += v[j].x * v[j].x + v[j].y * v[j].y + v[j].z * v[j].z + v[j].w * v[j].w;
    return wave_sum(s);
}
__device__ __forceinline__ void modulate_store(const f32x4 (&v)[4], float rinv, const float* g, const float* sh, const float* sc, bf16* dst, int lane) {
#pragma unroll
    for (int j = 0; j < 4; ++j) {
        const int c = lane * 4 + 256 * j;
        const f32x4 gg = *(const f32x4*)(g + c), s1 = *(const f32x4*)(sc + c), s0 = *(const f32x4*)(sh + c);
        const f32x4 o = v[j] * rinv * gg * (s1 + 1.f) + s0;
        u32x2 w; w.x = pk2(o.x, o.y); w.y = pk2(o.z, o.w);
        *(u32x2*)(dst + c) = w;
    }
}
__device__ __forceinline__ const float* hl_src0(const Params& p, int r) { return r < TC ? p.ctx + (size_t)r * DM : p.x + (size_t)(r - TC) * DM; }
__device__ __forceinline__ float* hl_buf(const Params& p, int r) { return r < TC ? (float*)(p.ws + OFF_HC) + (size_t)r * DM : p.out + (size_t)(r - TC) * DM; }

__device__ __forceinline__ void ph_modulate0(const Params& p) {
    const int lane = threadIdx.x & 63, gw = blockIdx.x * 4 + (threadIdx.x >> 6), ngw = gridDim.x * 4;
    const float* mod = (const float*)(p.ws + OFF_MOD);
    bf16* U = (bf16*)(p.ws + OFF_U);
    for (int r = gw; r < TT; r += ngw) {
        f32x4 v[4]; load_row(hl_src0(p, r), lane, v);
        const float rinv = rsqrtf(row_sumsq(v) * (1.f / DM) + RMS_EPS);
        const float* mv = mod + (size_t)modvec(r) * 6144;
        modulate_store(v, rinv, p.g_mix_pre, mv, mv + 1024, U + (size_t)r * DM, lane);
    }
}

__device__ __forceinline__ void ph_rowpassA(const Params& p, int l, int row_lo, const float* Y) {
    const int lane = threadIdx.x & 63, gw = blockIdx.x * 4 + (threadIdx.x >> 6), ngw = gridDim.x * 4;
    const float* mod = (const float*)(p.ws + OFF_MOD) + (size_t)l * 3 * 6144;
    bf16* U = (bf16*)(p.ws + OFF_U);
    for (int r = row_lo + gw; r < TT; r += ngw) {
        f32x4 y[4], h[4];
        load_row(Y + (size_t)r * DM, lane, y);
        load_row(l == 0 ? hl_src0(p, r) : (const float*)hl_buf(p, r), lane, h);
        const float rinv = rsqrtf(row_sumsq(y) * (1.f / DM) + RMS_EPS);
        const float* mv = mod + (size_t)modvec(r) * 6144;
        float* hb = hl_buf(p, r);
#pragma unroll
        for (int j = 0; j < 4; ++j) {
            const int c = lane * 4 + 256 * j;
            const f32x4 gg = *(const f32x4*)(p.g_mix_post + l * DM + c), gt = *(const f32x4*)(mv + 2048 + c);
            h[j] = h[j] + gt * (y[j] * rinv * gg);
            *(f32x4*)(hb + c) = h[j];
        }
        const float rinv2 = rsqrtf(row_sumsq(h) * (1.f / DM) + RMS_EPS);
        modulate_store(h, rinv2, p.g_ffn_pre + l * DM, mv + 3072, mv + 4096, U + (size_t)r * DM, lane);
    }
}

constexpr int MOE_LDS_OFF = 65536;
__device__ __forceinline__ void moe_tables(const Params& p, LAS unsigned char* lds, int l, int row_lo) {
    LAS int* cnt = (LAS int*)(lds + MOE_LDS_OFF); LAS int* tp = cnt + 80; LAS int* sp = tp + 80;
    const int tid = threadIdx.x;
    if (tid < 64) cnt[tid] = ((const int*)(p.ws + OFF_CNT))[l * 64 + tid];
    if (tid == 64) cnt[64] = TT - row_lo;
    __syncthreads();
    if (tid == 0) {
        int a = 0, s = 0;
        for (int e = 0; e < 65; ++e) { tp[e] = a; sp[e] = s; a += (cnt[e] + 127) >> 7; s += cnt[e]; }
        tp[65] = a;
    }
    __syncthreads();
}

__device__ __forceinline__ void ph_rowpassB(const Params& p, LAS unsigned char* lds, int l, int row_lo) {
    moe_tables(p, lds, l, row_lo);
    LAS int* sp = (LAS int*)(lds + MOE_LDS_OFF) + 160;
    const int lane = threadIdx.x & 63, gw = blockIdx.x * 4 + (threadIdx.x >> 6), ngw = gridDim.x * 4;
    const float* mod = (const float*)(p.ws + OFF_MOD) + (size_t)l * 3 * 6144;
    const bf16* YR = (const bf16*)(p.ws + AM_YR);
    const int* tokslot = (const int*)(p.ws + OFF_TOKSLOT);
    bf16* U = (bf16*)(p.ws + OFF_U);
    for (int r = row_lo + gw; r < TT; r += ngw) {
        f32x4 f[4];
#pragma unroll
        for (int j = 0; j < 4; ++j) f[j] = (f32x4){0.f, 0.f, 0.f, 0.f};
#pragma unroll
        for (int k = 0; k < 9; ++k) {
            size_t slot;
            if (k < 8) { const int ts = tokslot[(size_t)r * 8 + k]; slot = (size_t)(sp[ts >> 20] + (ts & 0xfffff)); }
            else slot = (size_t)TT * 8 + r;
            const bf16* yr = YR + slot * DM;
#pragma unroll
            for (int j = 0; j < 4; ++j) {
                const u32x2 w = *(const u32x2*)(yr + lane * 4 + 256 * j);
                f[j].x += bflo(w.x); f[j].y += bfhi(w.x); f[j].z += bflo(w.y); f[j].w += bfhi(w.y);
            }
        }
        const float rinv = rsqrtf(row_sumsq(f) * (1.f / DM) + RMS_EPS);
        const float* mv = mod + (size_t)modvec(r) * 6144;
        float* hb = hl_buf(p, r);
        f32x4 h[4]; load_row(hb, lane, h);
#pragma unroll
        for (int j = 0; j < 4; ++j) {
            const int c = lane * 4 + 256 * j;
            const f32x4 gg = *(const f32x4*)(p.g_ffn_post + l * DM + c), gt = *(const f32x4*)(mv + 5120 + c);
            h[j] = h[j] + gt * (f[j] * rinv * gg);
            *(f32x4*)(hb + c) = h[j];
        }
        if (l == 0) {
            const float rinv2 = rsqrtf(row_sumsq(h) * (1.f / DM) + RMS_EPS);
            const float* mv1 = mv + 3 * 6144;
            modulate_store(h, rinv2, p.g_mix_pre + DM, mv1, mv1 + 1024, U + (size_t)r * DM, lane);
        }
    }
}

__device__ __forceinline__ int stg_col() { const int tid = threadIdx.x; return ((tid & 7) ^ ((tid >> 3) & 7)) * 8; }
__device__ __forceinline__ void plain_ptrs(const bf16* base, int row0, int ld, const bf16* (&pp)[4]) {
    const int tid = threadIdx.x;
    pp[0] = base + (size_t)(row0 + (tid >> 3)) * ld + stg_col();
#pragma unroll
    for (int i = 1; i < 4; ++i) pp[i] = pp[0] + (size_t)(32 * i) * ld;
}

__device__ __forceinline__ void ph_inproj0(const Params& p, LAS unsigned char* lds) {
    unsigned char* ws = p.ws;
    const bf16* U = (const bf16*)(ws + OFF_U); const bf16* W = (const bf16*)(ws + OFF_W_IN_E);
    bf16* Z0 = (bf16*)(ws + A0_Z0); bf16* VGT = (bf16*)(ws + A0_VGT); bf16* QS = (bf16*)(ws + A0_QS); bf16* KS = (bf16*)(ws + A0_KS); bf16* VST = (bf16*)(ws + A0_VST);
    const f32x2* rope = (const f32x2*)(ws + OFF_ROPE);
    const int tid = threadIdx.x, lane = tid & 63, wid = tid >> 6, wr = wid >> 1, wc = wid & 1, fr = lane & 15, fq = lane >> 4;
    constexpr int NTN = 19, NTM = TT / 128;
    auto make = [&](int t, GPtrs& g, int& nk) { int tm, tn; tile_mn(t, NTM, NTN, tm, tn); plain_ptrs(U, tm * 128, DM, g.a); plain_ptrs(W, tn * 128, DM, g.b); nk = DM / 64; };
    auto epi = [&](int t, f32x4 (&acc)[4][4]) {
        int tm, tn; tile_mn(t, NTM, NTN, tm, tn); const int brow = tm * 128, bcol = tn * 128;
        const int cb = bcol + wc * 64;
#pragma unroll
        for (int m = 0; m < 4; ++m) {
            const int r = brow + wr * 64 + m * 16 + fr;
            const RowInfo ri = rowinfo(r);
            if (cb < 1024) {
#pragma unroll
                for (int n = 0; n < 4; ++n) { u32x2 w; w.x = pk2(acc[m][n][0], acc[m][n][1]); w.y = pk2(acc[m][n][2], acc[m][n][3]); *(u32x2*)(Z0 + (size_t)r * Z0P + cb + n * 16 + fq * 4) = w; }
            } else if (cb < 1536) {
                const int c0 = cb - 1024;
#pragma unroll
                for (int n = 0; n < 4; ++n)
#pragma unroll
                    for (int j = 0; j < 4; ++j) VGT[(size_t)(c0 + n * 16 + fq * 4 + j) * TT + r] = f2bf(acc[m][n][j]);
            } else if (cb < 2176) {
                f32x4 o[4];
#pragma unroll
                for (int n = 0; n < 2; ++n) {
#pragma unroll
                    for (int j = 0; j < 4; ++j) {
                        const float x1 = acc[m][n][j], x2 = acc[m][n + 2][j];
                        if (ri.lat) { const f32x2 cs = rope[(size_t)ri.pos * 32 + n * 16 + fq * 4 + j]; o[n][j] = x1 * cs.x - x2 * cs.y; o[n + 2][j] = x2 * cs.x + x1 * cs.y; }
                        else { o[n][j] = x1; o[n + 2][j] = x2; }
                    }
                }
                bf16* dst; float sc;
                if (cb < 2048) { const int h = (cb - 1536) >> 6; dst = QS + ((size_t)(ri.b * 8 + h) * NKEY + ri.kq) * 64; sc = 0.125f * LOG2E; }
                else { const int h = (cb - 2048) >> 6; dst = KS + ((size_t)(ri.b * 2 + h) * NKEY + ri.kq) * 64; sc = 1.f; }
#pragma unroll
                for (int n = 0; n < 4; ++n) { u32x2 w; w.x = pk2(o[n][0] * sc, o[n][1] * sc); w.y = pk2(o[n][2] * sc, o[n][3] * sc); *(u32x2*)(dst + n * 16 + fq * 4) = w; }
            } else if (cb < 2304) {
                const int h = (cb - 2176) >> 6;
                bf16* dst = VST + (size_t)(ri.b * 2 + h) * 64 * NKEY + ri.kq;
#pragma unroll
                for (int n = 0; n < 4; ++n)
#pragma unroll
                    for (int j = 0; j < 4; ++j) dst[(size_t)(n * 16 + fq * 4 + j) * NKEY] = f2bf(acc[m][n][j]);
            } else if (cb == 2304) {
#pragma unroll
                for (int n = 0; n < 2; ++n) { u32x2 w; w.x = pk2(acc[m][n][0], acc[m][n][1]); w.y = pk2(acc[m][n][2], acc[m][n][3]); *(u32x2*)(Z0 + (size_t)r * Z0P + 1024 + n * 16 + fq * 4) = w; }
            }
        }
    };
    gemm_tiles<true>(lds, vcu_id(), NTM * NTN, gridDim.x, make, epi);
}

__device__ __forceinline__ void ph_outproj(const Params& p, LAS unsigned char* lds, const bf16* MIX, const bf16* W, float* Y, int row_lo) {
    const int tid = threadIdx.x, lane = tid & 63, wid = tid >> 6, wr = wid >> 1, wc = wid & 1, fr = lane & 15, fq = lane >> 4;
    const int tm0 = row_lo / 128, ntm = TT / 128 - tm0;
    auto make = [&](int t, GPtrs& g, int& nk) { int tm, tn; tile_mn(t, ntm, 8, tm, tn); plain_ptrs(MIX, (tm0 + tm) * 128, DM, g.a); plain_ptrs(W, tn * 128, DM, g.b); nk = DM / 64; };
    auto epi = [&](int t, f32x4 (&acc)[4][4]) {
        int tm, tn; tile_mn(t, ntm, 8, tm, tn); tm += tm0; const int brow = tm * 128, bcol = tn * 128;
#pragma unroll
        for (int m = 0; m < 4; ++m) {
            const int r = brow + wr * 64 + m * 16 + fr;
#pragma unroll
            for (int n = 0; n < 4; ++n) *(f32x4*)(Y + (size_t)r * DM + bcol + wc * 64 + n * 16 + fq * 4) = acc[m][n];
        }
    };
    gemm_tiles<true>(lds, vcu_id(), ntm * 8, gridDim.x, make, epi);
}

template <int DQK, int DV>
__device__ __forceinline__ void attn_item(LAS unsigned char* lds, const bf16* Qg, const bf16* Kg, const bf16* VTg, int a1, int b0, int b1, int qpos0,
                                          float m_init, float l_init, bf16* Og, int o_pitch) {
    constexpr int KP = (DQK + 8) * 2, VP = 136, NS = DQK / 16, NDV = DV / 32, KCH = DQK / 8;
    const int tid = threadIdx.x, lane = tid & 63, wid = tid >> 6, ql = lane & 31, hi = lane >> 5;
    bf16x8 qf[NS];
    {
        const bf16* qrow = Qg + (size_t)(wid * 32 + ql) * DQK + hi * 8;
#pragma unroll
        for (int s = 0; s < NS; ++s) qf[s] = *(const bf16x8*)(qrow + s * 16);
    }
    f32x16 o[NDV];
#pragma unroll
    for (int d = 0; d < NDV; ++d)
#pragma unroll
        for (int r = 0; r < 16; ++r) o[d][r] = 0.f;
    float mrun = m_init, lrun = l_init;
    const int ntot = a1 + (b1 - b0);
    LAS unsigned char* Ks = lds; LAS unsigned char* Vs = lds + 64 * KP;
    constexpr int KN = KCH / 4, VN = DV / 32;
    u32x4 kreg[KN], vreg[VN];
    const bf16* kgp = Kg + (size_t)(tid >> 2) * DQK + (tid & 3) * 8;
    const bf16* vgp = VTg + (size_t)(tid >> 3) * NKEY + (tid & 7) * 8;
    LAS unsigned char* ksp = Ks + (tid >> 2) * KP + (tid & 3) * 16;
    LAS unsigned char* vsp = Vs + (tid >> 3) * VP + (tid & 7) * 16;
#define ATTN_LOAD(kt_) do { \
        _Pragma("unroll") for (int i_ = 0; i_ < KN; ++i_) kreg[i_] = *(const u32x4*)(kgp + (size_t)(kt_) * 64 * DQK + i_ * 32); \
        _Pragma("unroll") for (int i_ = 0; i_ < VN; ++i_) vreg[i_] = *(const u32x4*)(vgp + (size_t)(i_ * 32) * NKEY + (kt_) * 64); } while (0)
    ATTN_LOAD(a1 > 0 ? 0 : b0);
    for (int it = 0; it < ntot; ++it) {
        const int kt = it < a1 ? it : b0 + (it - a1);
        const bool masked = it >= a1;
        __syncthreads();
#pragma unroll
        for (int i = 0; i < KN; ++i) *(LAS u32x4*)(ksp + i * 64) = kreg[i];
#pragma unroll
        for (int i = 0; i < VN; ++i) { LAS u32x2* d = (LAS u32x2*)(vsp + i * 32 * VP); d[0] = (u32x2){vreg[i].x, vreg[i].y}; d[1] = (u32x2){vreg[i].z, vreg[i].w}; }
        __syncthreads();
        if (it + 1 < ntot) { const int ktn = (it + 1) < a1 ? (it + 1) : b0 + (it + 1 - a1); ATTN_LOAD(ktn); }
        f32x16 p0, p1;
#pragma unroll
        for (int r = 0; r < 16; ++r) { p0[r] = 0.f; p1[r] = 0.f; }
#pragma unroll
        for (int s = 0; s < NS; ++s) {
            const bf16x8 k0 = *(const LAS bf16x8*)(Ks + ql * KP + (s * 16 + hi * 8) * 2);
            const bf16x8 k1 = *(const LAS bf16x8*)(Ks + (32 + ql) * KP + (s * 16 + hi * 8) * 2);
            p0 = __builtin_amdgcn_mfma_f32_32x32x16_bf16(k0, qf[s], p0, 0, 0, 0);
            p1 = __builtin_amdgcn_mfma_f32_32x32x16_bf16(k1, qf[s], p1, 0, 0, 0);
        }
        if (masked) {
            const int kbase = kt * 64 - CTX, qpos = qpos0 + wid * 32 + ql;
#pragma unroll
            for (int r = 0; r < 16; ++r) {
                const int d0 = qpos - (kbase + crow(r, hi)), d1 = d0 - 32;
                if (d0 > 128 || d0 < -128) p0[r] = -1e30f;
                if (d1 > 128 || d1 < -128) p1[r] = -1e30f;
            }
        }
        float mx = p0[0];
#pragma unroll
        for (int r = 1; r < 16; ++r) mx = fmaxf(mx, p0[r]);
#pragma unroll
        for (int r = 0; r < 16; ++r) mx = fmaxf(mx, p1[r]);
        mx = fmaxf(mx, __shfl_xor(mx, 32));
        if (__any(mx > mrun + 8.f)) {
            const float mn = fmaxf(mrun, mx), alpha = ex2(mrun - mn);
            mrun = mn; lrun *= alpha;
#pragma unroll
            for (int d = 0; d < NDV; ++d)
#pragma unroll
                for (int r = 0; r < 16; ++r) o[d][r] *= alpha;
        }
        float rs = 0.f;
#pragma unroll
        for (int r = 0; r < 16; ++r) { p0[r] = ex2(p0[r] - mrun); rs += p0[r]; }
#pragma unroll
        for (int r = 0; r < 16; ++r) { p1[r] = ex2(p1[r] - mrun); rs += p1[r]; }
        rs += __shfl_xor(rs, 32);
        lrun += rs;
        bf16x8 pf[4];
        { u32x4 w;
          w.x = pk2(p0[0], p0[1]); w.y = pk2(p0[2], p0[3]); w.z = pk2(p0[4], p0[5]); w.w = pk2(p0[6], p0[7]); pf[0] = mk8(w);
          w.x = pk2(p0[8], p0[9]); w.y = pk2(p0[10], p0[11]); w.z = pk2(p0[12], p0[13]); w.w = pk2(p0[14], p0[15]); pf[1] = mk8(w);
          w.x = pk2(p1[0], p1[1]); w.y = pk2(p1[2], p1[3]); w.z = pk2(p1[4], p1[5]); w.w = pk2(p1[6], p1[7]); pf[2] = mk8(w);
          w.x = pk2(p1[8], p1[9]); w.y = pk2(p1[10], p1[11]); w.z = pk2(p1[12], p1[13]); w.w = pk2(p1[14], p1[15]); pf[3] = mk8(w); }
#pragma unroll
        for (int d = 0; d < NDV; ++d) {
#pragma unroll
            for (int kk = 0; kk < 4; ++kk) {
                const int keybase = kk * 16 + 4 * hi;
                const LAS unsigned char* vp = Vs + (d * 32 + ql) * VP + keybase * 2;
                const u32x2 lo = *(const LAS u32x2*)vp, hh = *(const LAS u32x2*)(vp + 16);
                const bf16x8 vf = mk8((u32x4){lo.x, lo.y, hh.x, hh.y});
                o[d] = __builtin_amdgcn_mfma_f32_32x32x16_bf16(vf, pf[kk], o[d], 0, 0, 0);
            }
        }
    }
#undef ATTN_LOAD
    const float inv = 1.f / lrun;
    bf16* orow = Og + (size_t)(wid * 32 + ql) * o_pitch;
#pragma unroll
    for (int d = 0; d < NDV; ++d)
#pragma unroll
        for (int g = 0; g < 4; ++g) {
            u32x2 w; w.x = pk2(o[d][g * 4 + 0] * inv, o[d][g * 4 + 1] * inv); w.y = pk2(o[d][g * 4 + 2] * inv, o[d][g * 4 + 3] * inv);
            *(u32x2*)(orow + d * 32 + 8 * g + 4 * hi) = w;
        }
}

constexpr int GA_CUM = 0, GA_ALOW = 16384, GA_WA = 20480, GA_BA = 24576, GA_QT = 24832, GA_TOT = 25856, GA_END = 26112;
__device__ __forceinline__ void gla_cum(const Params& p, LAS unsigned char* lds, const bf16* Z0, int r0, int h, int dir) {
    const int tid = threadIdx.x;
    LAS float* cum = (LAS float*)(lds + GA_CUM); LAS float* alow = (LAS float*)(lds + GA_ALOW); LAS float* wa = (LAS float*)(lds + GA_WA);
    LAS float* ba = (LAS float*)(lds + GA_BA); LAS float* qt = (LAS float*)(lds + GA_QT); LAS float* tot = (LAS float*)(lds + GA_TOT);
    {
        const int t = tid >> 2, i4 = (tid & 3) * 4;
        const u32x2 w = *(const u32x2*)(Z0 + (size_t)(r0 + t) * Z0P + 1024 + dir * 16 + i4);
        alow[t * 16 + i4 + 0] = bflo(w.x); alow[t * 16 + i4 + 1] = bfhi(w.x); alow[t * 16 + i4 + 2] = bflo(w.y); alow[t * 16 + i4 + 3] = bfhi(w.y);
#pragma unroll
        for (int q = 0; q < 4; ++q) { const int idx = tid * 4 + q, i = idx >> 6, j = idx & 63; wa[idx] = p.gla_wa2[(size_t)(dir * 16 + i) * 256 + h * 64 + j]; }
        if (tid < 64) ba[tid] = p.gla_ba[dir * 256 + h * 64 + tid];
    }
    __syncthreads();
    const int j = tid & 63, tq = tid >> 6;
    float la[16];
#pragma unroll
    for (int tt = 0; tt < 16; ++tt) {
        const int t = tq * 16 + tt;
        float x = ba[j];
#pragma unroll
        for (int i = 0; i < 16; ++i) x += alow[t * 16 + i] * wa[i * 64 + j];
        la[tt] = (fminf(x, 0.f) - log1pf(expf(-fabsf(x)))) * (1.f / 16.f);
    }
    float run = 0.f;
    if (dir == 0) {
#pragma unroll
        for (int tt = 0; tt < 16; ++tt) { run += la[tt]; cum[(tq * 16 + tt) * 64 + j] = run; }
    } else {
#pragma unroll
        for (int tt = 15; tt >= 0; --tt) { run += la[tt]; cum[(tq * 16 + tt) * 64 + j] = run; }
    }
    qt[tq * 64 + j] = run;
    __syncthreads();
    float off = 0.f, total = 0.f;
#pragma unroll
    for (int q = 0; q < 4; ++q) { const float v = qt[q * 64 + j]; total += v; if (dir == 0 ? (q < tq) : (q > tq)) off += v; }
#pragma unroll
    for (int tt = 0; tt < 16; ++tt) cum[(tq * 16 + tt) * 64 + j] += off;
    if (tq == 0) tot[j] = total;
    __syncthreads();
}

__device__ __forceinline__ int gla_row0(int b, int cc) { return cc < 4 ? b * CTX + cc * 64 : TC + b * SEQ + (cc - 4) * 64; }
__device__ __forceinline__ int gla_step(int cc, int dir) { return dir == 0 ? cc : (cc < 4 ? 3 - cc : 4 + (131 - cc)); }

__device__ __forceinline__ void gla_g1_item(const Params& p, LAS unsigned char* lds, int item) {
    unsigned char* ws = p.ws;
    const bf16* Z0 = (const bf16*)(ws + A0_Z0); const bf16* VGT = (const bf16*)(ws + A0_VGT);
    float* GS = (float*)(ws + A0_GS); float* GD = (float*)(ws + A0_GD);
    const int cc = item % NSTEP, rest = item / NSTEP, dir = rest & 1, h = (rest >> 1) & 3, b = rest >> 3;
    const int r0 = gla_row0(b, cc), step = gla_step(cc, dir), chain = (b * 4 + h) * 2 + dir;
    const int tid = threadIdx.x, lane = tid & 63, wid = tid >> 6, fr = lane & 15, fq = lane >> 4;
    __syncthreads();
    gla_cum(p, lds, Z0, r0, h, dir);
    LAS float* cum = (LAS float*)(lds + GA_CUM); LAS float* tot = (LAS float*)(lds + GA_TOT);
    LAS bf16* KT = (LAS bf16*)(lds + GA_END);
    {
        const int t = tid >> 2, d0 = (tid & 3) * 16;
        const u32x4 w0 = *(const u32x4*)(Z0 + (size_t)(r0 + t) * Z0P + 256 + h * 64 + d0), w1 = *(const u32x4*)(Z0 + (size_t)(r0 + t) * Z0P + 256 + h * 64 + d0 + 8);
        const unsigned ww[8] = {w0.x, w0.y, w0.z, w0.w, w1.x, w1.y, w1.z, w1.w};
#pragma unroll
        for (int i = 0; i < 8; ++i) {
            const int d = d0 + 2 * i;
            KT[d * 72 + t] = f2bf(bflo(ww[i]) * __expf(tot[d] - cum[t * 64 + d]));
            KT[(d + 1) * 72 + t] = f2bf(bfhi(ww[i]) * __expf(tot[d + 1] - cum[t * 64 + d + 1]));
        }
    }
    if (tid < 64) GD[((size_t)chain * NSTEP + step) * 64 + tid] = __expf(tot[tid]);
    __syncthreads();
    f32x4 acc[2][4];
#pragma unroll
    for (int m = 0; m < 2; ++m)
#pragma unroll
        for (int n = 0; n < 4; ++n) acc[m][n] = (f32x4){0.f, 0.f, 0.f, 0.f};
#pragma unroll
    for (int ks = 0; ks < 2; ++ks) {
        bf16x8 af[2], bfr[4];
#pragma unroll
        for (int m = 0; m < 2; ++m) af[m] = *(const bf16x8*)(VGT + (size_t)(h * 128 + wid * 32 + m * 16 + fr) * TT + r0 + ks * 32 + fq * 8);
#pragma unroll
        for (int n = 0; n < 4; ++n) bfr[n] = *(const LAS bf16x8*)(KT + (n * 16 + fr) * 72 + ks * 32 + fq * 8);
#pragma unroll
        for (int m = 0; m < 2; ++m)
#pragma unroll
            for (int n = 0; n < 4; ++n) acc[m][n] = __builtin_amdgcn_mfma_f32_16x16x32_bf16(bfr[n], af[m], acc[m][n], 0, 0, 0);
    }
    float* dst = GS + ((size_t)chain * NSTEP + step) * 8192;
#pragma unroll
    for (int m = 0; m < 2; ++m)
#pragma unroll
        for (int n = 0; n < 4; ++n) *(f32x4*)(dst + (size_t)(wid * 32 + m * 16 + fr) * 64 + n * 16 + fq * 4) = acc[m][n];
}

__device__ __forceinline__ void ph_gla_scan(const Params& p) {
    float* GS = (float*)(p.ws + A0_GS); const float* GD = (const float*)(p.ws + A0_GD);
    for (int idx = blockIdx.x * 256 + threadIdx.x; idx < 16 * 8192; idx += gridDim.x * 256) {
        const int chain = idx >> 13, e = idx & 8191, dk = e & 63;
        float* g = GS + (size_t)chain * NSTEP * 8192 + e;
        const float* d = GD + (size_t)chain * NSTEP * 64 + dk;
        float st = 0.f;
#pragma unroll 6
        for (int s = 0; s < NSTEP; ++s) { const float t = g[(size_t)s * 8192]; const float dec = d[s * 64]; g[(size_t)s * 8192] = st; st = dec * st + t; }
    }
}

__device__ __forceinline__ void gla_g3_item(const Params& p, LAS unsigned char* lds, int item) {
    unsigned char* ws = p.ws;
    const bf16* Z0 = (const bf16*)(ws + A0_Z0); const bf16* VGT = (const bf16*)(ws + A0_VGT);
    const float* GS = (const float*)(ws + A0_GS); bf16* MIX = (bf16*)(ws + A0_MIX);
    const int cc = item % NSTEP, rest = item / NSTEP, h = rest & 3, b = rest >> 2;
    const int r0 = gla_row0(b, cc);
    const int tid = threadIdx.x, lane = tid & 63, wid = tid >> 6, fr = lane & 15, fq = lane >> 4;
    LAS bf16* QT = (LAS bf16*)(lds + GA_END);
    LAS bf16* QI = (LAS bf16*)(lds + GA_END + 9216);
    LAS bf16* KT = (LAS bf16*)(lds + GA_END + 18432);
    LAS bf16* PP = (LAS bf16*)(lds);
    f32x4 o[4][2];
#pragma unroll
    for (int m = 0; m < 4; ++m)
#pragma unroll
        for (int n = 0; n < 2; ++n) o[m][n] = (f32x4){0.f, 0.f, 0.f, 0.f};
    for (int dir = 0; dir < 2; ++dir) {
        const int step = gla_step(cc, dir), chain = (b * 4 + h) * 2 + dir;
        __syncthreads();
        gla_cum(p, lds, Z0, r0, h, dir);
        LAS float* cum = (LAS float*)(lds + GA_CUM); LAS float* tot = (LAS float*)(lds + GA_TOT);
        {
            const int t = tid >> 2, d0 = (tid & 3) * 16;
            const bf16* zr = Z0 + (size_t)(r0 + t) * Z0P + h * 64 + d0;
            const u32x4 q0 = *(const u32x4*)(zr), q1 = *(const u32x4*)(zr + 8), k0 = *(const u32x4*)(zr + 256), k1 = *(const u32x4*)(zr + 264);
            const unsigned qq[8] = {q0.x, q0.y, q0.z, q0.w, q1.x, q1.y, q1.z, q1.w}, kk[8] = {k0.x, k0.y, k0.z, k0.w, k1.x, k1.y, k1.z, k1.w};
            unsigned oqt[8], oqi[8], okt[8];
#pragma unroll
            for (int i = 0; i < 8; ++i) {
                const int d = d0 + 2 * i;
                const float c0 = cum[t * 64 + d], c1 = cum[t * 64 + d + 1], t0 = tot[d], t1 = tot[d + 1];
                const float qa = bflo(qq[i]), qb = bfhi(qq[i]), ka = bflo(kk[i]), kb = bfhi(kk[i]);
                oqt[i] = pk2(qa * __expf(c0 - t0), qb * __expf(c1 - t1));
                oqi[i] = pk2(qa * __expf(c0), qb * __expf(c1));
                okt[i] = pk2(ka * __expf(t0 - c0), kb * __expf(t1 - c1));
            }
            *(LAS u32x4*)(QT + t * 72 + d0) = (u32x4){oqt[0], oqt[1], oqt[2], oqt[3]}; *(LAS u32x4*)(QT + t * 72 + d0 + 8) = (u32x4){oqt[4], oqt[5], oqt[6], oqt[7]};
            *(LAS u32x4*)(QI + t * 72 + d0) = (u32x4){oqi[0], oqi[1], oqi[2], oqi[3]}; *(LAS u32x4*)(QI + t * 72 + d0 + 8) = (u32x4){oqi[4], oqi[5], oqi[6], oqi[7]};
            *(LAS u32x4*)(KT + t * 72 + d0) = (u32x4){okt[0], okt[1], okt[2], okt[3]}; *(LAS u32x4*)(KT + t * 72 + d0 + 8) = (u32x4){okt[4], okt[5], okt[6], okt[7]};
        }
        __syncthreads();
        {
            f32x4 sa[4];
#pragma unroll
            for (int m = 0; m < 4; ++m) sa[m] = (f32x4){0.f, 0.f, 0.f, 0.f};
#pragma unroll
            for (int ks = 0; ks < 2; ++ks) {
                const bf16x8 kf = *(const LAS bf16x8*)(KT + (wid * 16 + fr) * 72 + ks * 32 + fq * 8);
#pragma unroll
                for (int m = 0; m < 4; ++m) {
                    const bf16x8 qfm = *(const LAS bf16x8*)(QT + (m * 16 + fr) * 72 + ks * 32 + fq * 8);
                    sa[m] = __builtin_amdgcn_mfma_f32_16x16x32_bf16(kf, qfm, sa[m], 0, 0, 0);
                }
            }
#pragma unroll
            for (int m = 0; m < 4; ++m) {
                const int t = m * 16 + fr;
                float v[4];
#pragma unroll
                for (int jj = 0; jj < 4; ++jj) { const int j = wid * 16 + fq * 4 + jj; const bool keep = dir == 0 ? (j <= t) : (j >= t); v[jj] = keep ? sa[m][jj] : 0.f; }
                *(LAS u32x2*)(PP + t * 72 + wid * 16 + fq * 4) = (u32x2){pk2(v[0], v[1]), pk2(v[2], v[3])};
            }
        }
        __syncthreads();
        const float* Sg = GS + ((size_t)chain * NSTEP + step) * 8192;
#pragma unroll
        for (int ks = 0; ks < 2; ++ks) {
            bf16x8 vfr[2], sfr[2];
#pragma unroll
            for (int n = 0; n < 2; ++n) {
                const int dv = wid * 32 + n * 16 + fr;
                vfr[n] = *(const bf16x8*)(VGT + (size_t)(h * 128 + dv) * TT + r0 + ks * 32 + fq * 8);
                const f32x4 s0 = *(const f32x4*)(Sg + (size_t)dv * 64 + ks * 32 + fq * 8), s1 = *(const f32x4*)(Sg + (size_t)dv * 64 + ks * 32 + fq * 8 + 4);
                sfr[n] = mk8((u32x4){pk2(s0.x, s0.y), pk2(s0.z, s0.w), pk2(s1.x, s1.y), pk2(s1.z, s1.w)});
            }
#pragma unroll
            for (int m = 0; m < 4; ++m) {
                const bf16x8 pfm = *(const LAS bf16x8*)(PP + (m * 16 + fr) * 72 + ks * 32 + fq * 8);
                const bf16x8 qim = *(const LAS bf16x8*)(QI + (m * 16 + fr) * 72 + ks * 32 + fq * 8);
#pragma unroll
                for (int n = 0; n < 2; ++n) {
                    o[m][n] = __builtin_amdgcn_mfma_f32_16x16x32_bf16(vfr[n], pfm, o[m][n], 0, 0, 0);
                    o[m][n] = __builtin_amdgcn_mfma_f32_16x16x32_bf16(sfr[n], qim, o[m][n], 0, 0, 0);
                }
            }
        }
    }
    __syncthreads();
    LAS float* red = (LAS float*)(lds + GA_END + 27648);
#pragma unroll
    for (int m = 0; m < 4; ++m) {
        float s = 0.f;
#pragma unroll
        for (int n = 0; n < 2; ++n)
#pragma unroll
            for (int j = 0; j < 4; ++j) s += o[m][n][j] * o[m][n][j];
        s += __shfl_xor(s, 16); s += __shfl_xor(s, 32);
        if (fq == 0) red[wid * 64 + m * 16 + fr] = s;
    }
    __syncthreads();
#pragma unroll
    for (int m = 0; m < 4; ++m) {
        const int t = m * 16 + fr;
        const float ss = red[t] + red[64 + t] + red[128 + t] + red[192 + t];
        const float rinv = rsqrtf(ss * (1.f / 128.f) + RMS_EPS);
        const int r = r0 + t;
#pragma unroll
        for (int n = 0; n < 2; ++n) {
            const int dv = wid * 32 + n * 16 + fq * 4;
            const u32x2 gw = *(const u32x2*)(Z0 + (size_t)r * Z0P + 512 + h * 128 + dv);
            const f32x4 ng = *(const f32x4*)(p.gla_norm + dv);
            const float g0 = bflo(gw.x), g1 = bfhi(gw.x), g2 = bflo(gw.y), g3 = bfhi(gw.y);
            const float y0 = o[m][n][0] * rinv * ng.x * siluf(g0), y1 = o[m][n][1] * rinv * ng.y * siluf(g1);
            const float y2 = o[m][n][2] * rinv * ng.z * siluf(g2), y3 = o[m][n][3] * rinv * ng.w * siluf(g3);
            *(u32x2*)(MIX + (size_t)r * DM + h * 128 + dv) = (u32x2){pk2(y0, y1), pk2(y2, y3)};
        }
    }
}

__device__ __forceinline__ void ph_swa_g1(const Params& p, LAS unsigned char* lds) {
    unsigned char* ws = p.ws;
    const bf16* QS = (const bf16*)(ws + A0_QS); const bf16* KS = (const bf16*)(ws + A0_KS); const bf16* VST = (const bf16*)(ws + A0_VST); bf16* MIX = (bf16*)(ws + A0_MIX);
    constexpr int N_SWA = 2 * 8 * 66, N_G1 = 2 * 4 * 2 * NSTEP;
    for (int item = blockIdx.x; item < N_SWA + N_G1; item += gridDim.x) {
        if (item < N_SWA) {
            const int qt = item % 66, rest = item / 66, h = rest & 7, b = rest >> 3, kvh = h >> 2;
            const bf16* Qg = QS + ((size_t)(b * 8 + h) * NKEY + qt * 128) * 64;
            const bf16* Kg = KS + (size_t)(b * 2 + kvh) * NKEY * 64;
            const bf16* Vg = VST + (size_t)(b * 2 + kvh) * 64 * NKEY;
            int b0 = 0, b1 = 0, qpos0 = 0, row0;
            if (qt >= 2) { qpos0 = (qt - 2) * 128; const int lo = qpos0 - 128 < 0 ? 0 : qpos0 - 128, hi2 = qpos0 + 256 > SEQ ? SEQ : qpos0 + 256; b0 = 4 + lo / 64; b1 = 4 + hi2 / 64; row0 = TC + b * SEQ + qpos0; }
            else row0 = b * CTX + qt * 128;
            const float sink = p.swa_sink[h] * LOG2E;
            attn_item<64, 64>(lds, Qg, Kg, Vg, 4, b0, b1, qpos0, sink, 1.f, MIX + (size_t)row0 * DM + 512 + h * 64, DM);
        } else gla_g1_item(p, lds, item - N_SWA);
    }
}
__device__ __forceinline__ void ph_gla_g3(const Params& p, LAS unsigned char* lds) {
    for (int item = blockIdx.x; item < 2 * 4 * NSTEP; item += gridDim.x) gla_g3_item(p, lds, item);
}

__device__ __forceinline__ void ph_router(const Params& p, LAS unsigned char* lds, int l, int row_lo) {
    unsigned char* ws = p.ws;
    const bf16* U = (const bf16*)(ws + OFF_U); const bf16* W = (const bf16*)(ws + OFF_W_RT) + (size_t)l * 128 * DM;
    int* cntg = (int*)(ws + OFF_CNT) + l * 64; int* tokslot = (int*)(ws + OFF_TOKSLOT); float* W8 = (float*)(ws + OFF_W8); int* LIST = (int*)(ws + OFF_LIST);
    const int tid = threadIdx.x, lane = tid & 63, wid = tid >> 6, wr = wid >> 1, wc = wid & 1, fr = lane & 15, fq = lane >> 4;
    LAS float* lg = (LAS float*)lds;
    const int tm0 = row_lo / 128;
    auto make = [&](int tm, GPtrs& g, int& nk) { plain_ptrs(U, tm * 128, DM, g.a); plain_ptrs(W, 0, DM, g.b); nk = DM / 64; };
    auto epi = [&](int tm, f32x4 (&acc)[4][4]) {
        const int brow = tm * 128;
        if (wc == 0) {
#pragma unroll
            for (int m = 0; m < 4; ++m)
#pragma unroll
                for (int n = 0; n < 4; ++n)
#pragma unroll
                    for (int j = 0; j < 4; ++j) lg[(wr * 64 + m * 16 + fr) * 65 + n * 16 + fq * 4 + j] = acc[m][n][j];
        }
        __syncthreads();
        LAS float* biasl = (LAS float*)(lds + 34816); LAS int* hist = (LAS int*)(lds + 34816 + 256); LAS int* basel = (LAS int*)(lds + 34816 + 512);
        if (tid < 64) { biasl[tid] = p.b_router[l * 64 + tid]; hist[tid] = 0; }
        __syncthreads();
        int esel[8], lrank[8]; float ssel[8]; float wsum = 0.f;
        if (tid < 128) {
            LAS float* L = lg + tid * 65;
            float gs[8];
#pragma unroll
            for (int g = 0; g < 8; ++g) {
                float m1 = -INFINITY, m2 = -INFINITY;
#pragma unroll
                for (int j = 0; j < 8; ++j) {
                    const int e = g * 8 + j;
                    const float sel = 1.f / (1.f + expf(-L[e])) + biasl[e];
                    L[e] = sel;
                    if (sel > m1) { m2 = m1; m1 = sel; } else if (sel > m2) m2 = sel;
                }
                gs[g] = m1 + m2;
            }
            unsigned allowed = 0u;
#pragma unroll
            for (int g = 0; g < 8; ++g) {
                int rk = 0;
#pragma unroll
                for (int h = 0; h < 8; ++h) rk += (gs[h] > gs[g] || (gs[h] == gs[g] && h < g)) ? 1 : 0;
                if (rk < 4) allowed |= 1u << g;
            }
#pragma unroll
            for (int k = 0; k < 8; ++k) {
                float best = -INFINITY; int bi = 0;
#pragma unroll
                for (int g = 0; g < 8; ++g) {
                    if ((allowed >> g) & 1u) {
#pragma unroll
                        for (int j = 0; j < 8; ++j) { const float v = L[g * 8 + j]; if (v > best) { best = v; bi = g * 8 + j; } }
                    }
                }
                esel[k] = bi; ssel[k] = best - biasl[bi]; wsum += ssel[k]; L[bi] = -INFINITY;
            }
#pragma unroll
            for (int k = 0; k < 8; ++k) lrank[k] = __hip_atomic_fetch_add(hist + esel[k], 1, __ATOMIC_RELAXED, __HIP_MEMORY_SCOPE_WORKGROUP);
        }
        __syncthreads();
        if (tid < 64) { const int c = hist[tid]; basel[tid] = c > 0 ? atomicAdd(cntg + tid, c) : 0; }
        __syncthreads();
        if (tid < 128) {
            const int t = brow + tid; const float wn = 2.5f / wsum;
#pragma unroll
            for (int k = 0; k < 8; ++k) {
                const int e = esel[k], pos = basel[e] + lrank[k];
                tokslot[(size_t)t * 8 + k] = (e << 20) | pos;
                W8[(size_t)t * 8 + k] = ssel[k] * wn;
                LIST[(size_t)e * TT + pos] = t * 8 + k;
            }
        }
    };
    gemm_tiles<false>(lds, tm0 + vcu_id(), TT / 128, gridDim.x, make, epi);
}

__device__ __forceinline__ int moe_find_expert(const LAS int* tp, int mtg) {
    int lo = 0, hi = 64;
    while (lo < hi) { const int mid = (lo + hi + 1) >> 1; if (tp[mid] <= mtg) lo = mid; else hi = mid - 1; }
    return lo;
}
__device__ __forceinline__ void ph_moe1(const Params& p, LAS unsigned char* lds, int l, int row_lo) {
    unsigned char* ws = p.ws;
    moe_tables(p, lds, l, row_lo);
    LAS int* cnt = (LAS int*)(lds + MOE_LDS_OFF); LAS int* tp = cnt + 80; LAS int* sp = tp + 80;
    const bf16* U = (const bf16*)(ws + OFF_U); const bf16* WGU = (const bf16*)(ws + OFF_W_GU); bf16* HM = (bf16*)(ws + AM_HM);
    const int* LIST = (const int*)(ws + OFF_LIST);
    const int tid = threadIdx.x, lane = tid & 63, wid = tid >> 6, wr = wid >> 1, wc = wid & 1, fr = lane & 15, fq = lane >> 4;
    const int ntiles = tp[65] * 4;
    auto make = [&](int t, GPtrs& g, int& nk) {
        const int mtg = t >> 2, nt = t & 3, e = moe_find_expert(tp, mtg), mt = mtg - tp[e], ce = cnt[e];
#pragma unroll
        for (int i = 0; i < 4; ++i) {
            const int li = mt * 128 + (tid >> 3) + 32 * i;
            int tk = row_lo;
            if (li < ce) tk = e < 64 ? (LIST[(size_t)e * TT + li] >> 3) : row_lo + li;
            g.a[i] = U + (size_t)tk * DM + stg_col();
        }
        plain_ptrs(WGU + (size_t)e * 512 * DM, nt * 128, DM, g.b); nk = DM / 64;
    };
    auto epi = [&](int t, f32x4 (&acc)[4][4]) {
        const int mtg = t >> 2, nt = t & 3, e = moe_find_expert(tp, mtg), mt = mtg - tp[e], ce = cnt[e];
        const size_t slot0 = e < 64 ? (size_t)(sp[e] + mt * 128) : (size_t)TT * 8 + row_lo + mt * 128;
        const int hc0 = nt * 64 + wc * 32;
#pragma unroll
        for (int m = 0; m < 4; ++m) {
            const int i = wr * 64 + m * 16 + fr;
            if (mt * 128 + i < ce) {
#pragma unroll
                for (int n = 0; n < 2; ++n) {
                    const f32x4 g = acc[m][n], u = acc[m][n + 2];
                    const u32x2 w = {pk2(siluf(g[0]) * u[0], siluf(g[1]) * u[1]), pk2(siluf(g[2]) * u[2], siluf(g[3]) * u[3])};
                    *(u32x2*)(HM + (slot0 + i) * 256 + hc0 + n * 16 + fq * 4) = w;
                }
            }
        }
    };
    gemm_tiles<true>(lds, vcu_id(), ntiles, gridDim.x, make, epi);
}
__device__ __forceinline__ void ph_moe2(const Params& p, LAS unsigned char* lds, int l, int row_lo) {
    unsigned char* ws = p.ws;
    moe_tables(p, lds, l, row_lo);
    LAS int* cnt = (LAS int*)(lds + MOE_LDS_OFF); LAS int* tp = cnt + 80; LAS int* sp = tp + 80;
    const bf16* HM = (const bf16*)(ws + AM_HM); const bf16* WD = (const bf16*)(ws + OFF_W_D); bf16* YR = (bf16*)(ws + AM_YR);
    const int* LIST = (const int*)(ws + OFF_LIST); const float* W8 = (const float*)(ws + OFF_W8);
    const int tid = threadIdx.x, lane = tid & 63, wid = tid >> 6, wr = wid >> 1, wc = wid & 1, fr = lane & 15, fq = lane >> 4;
    const int ntiles = tp[65] * 8;
    auto make = [&](int t, GPtrs& g, int& nk) {
        const int mtg = t >> 3, nt = t & 7, e = moe_find_expert(tp, mtg), mt = mtg - tp[e];
        const size_t slot0 = e < 64 ? (size_t)(sp[e] + mt * 128) : (size_t)TT * 8 + row_lo + mt * 128;
        plain_ptrs(HM, 0, 256, g.a);
#pragma unroll
        for (int i = 0; i < 4; ++i) g.a[i] += slot0 * 256;
        plain_ptrs(WD + (size_t)e * DM * 256, nt * 128, 256, g.b); nk = 256 / 64;
    };
    auto epi = [&](int t, f32x4 (&acc)[4][4]) {
        const int mtg = t >> 3, nt = t & 7, e = moe_find_expert(tp, mtg), mt = mtg - tp[e], ce = cnt[e];
        const size_t slot0 = e < 64 ? (size_t)(sp[e] + mt * 128) : (size_t)TT * 8 + row_lo + mt * 128;
#pragma unroll
        for (int m = 0; m < 4; ++m) {
            const int i = wr * 64 + m * 16 + fr, li = mt * 128 + i;
            if (li < ce) {
                const float w = e < 64 ? W8[LIST[(size_t)e * TT + li]] : 1.f;
#pragma unroll
                for (int n = 0; n < 4; ++n) {
                    const f32x4 a = acc[m][n] * w;
                    *(u32x2*)(YR + (slot0 + i) * DM + nt * 128 + wc * 64 + n * 16 + fq * 4) = (u32x2){pk2(a[0], a[1]), pk2(a[2], a[3])};
                }
            }
        }
    };
    gemm_tiles<true>(lds, vcu_id(), ntiles, gridDim.x, make, epi);
}

__device__ __forceinline__ void ph_inproj1(const Params& p, LAS unsigned char* lds) {
    unsigned char* ws = p.ws;
    const bf16* U = (const bf16*)(ws + OFF_U); const bf16* W = (const bf16*)(ws + OFF_W_IN_O);
    bf16* Z1 = (bf16*)(ws + A1_Z1); bf16* KM = (bf16*)(ws + A1_KM);
    const f32x2* rope = (const f32x2*)(ws + OFF_ROPE);
    const int tid = threadIdx.x, lane = tid & 63, wid = tid >> 6, wr = wid >> 1, wc = wid & 1, fr = lane & 15, fq = lane >> 4;
    constexpr int NTN = 7, NTM = TT / 128;
    auto make = [&](int t, GPtrs& g, int& nk) { int tm, tn; tile_mn(t, NTM, NTN, tm, tn); plain_ptrs(U, tm * 128, DM, g.a); plain_ptrs(W, tn * 128, DM, g.b); nk = DM / 64; };
    auto epi = [&](int t, f32x4 (&acc)[4][4]) {
        int tm, tn; tile_mn(t, NTM, NTN, tm, tn); const int brow = tm * 128, bcol = tn * 128;
        const int cb = bcol + wc * 64;
#pragma unroll
        for (int m = 0; m < 4; ++m) {
            const int r = brow + wr * 64 + m * 16 + fr;
            if (cb < 768) {
#pragma unroll
                for (int n = 0; n < 4; ++n) *(u32x2*)(Z1 + (size_t)r * Z1P + cb + n * 16 + fq * 4) = (u32x2){pk2(acc[m][n][0], acc[m][n][1]), pk2(acc[m][n][2], acc[m][n][3])};
            } else if (cb == 768) {
                const RowInfo ri = rowinfo(r);
                f32x4 o[4];
#pragma unroll
                for (int n = 0; n < 2; ++n)
#pragma unroll
                    for (int j = 0; j < 4; ++j) {
                        const float x1 = acc[m][n][j], x2 = acc[m][n + 2][j];
                        if (ri.lat) { const f32x2 cs = rope[(size_t)ri.pos * 32 + n * 16 + fq * 4 + j]; o[n][j] = x1 * cs.x - x2 * cs.y; o[n + 2][j] = x2 * cs.x + x1 * cs.y; }
                        else { o[n][j] = x1; o[n + 2][j] = x2; }
                    }
#pragma unroll
                for (int h = 0; h < 8; ++h) {
                    bf16* dst = KM + ((size_t)(ri.b * 8 + h) * NKEY + ri.kq) * 192 + 128;
#pragma unroll
                    for (int n = 0; n < 4; ++n) *(u32x2*)(dst + n * 16 + fq * 4) = (u32x2){pk2(o[n][0], o[n][1]), pk2(o[n][2], o[n][3])};
                }
            }
        }
    };
    gemm_tiles<true>(lds, vcu_id(), NTM * NTN, gridDim.x, make, epi);
}

__device__ __forceinline__ void ph_mla_up(const Params& p, LAS unsigned char* lds) {
    unsigned char* ws = p.ws;
    const bf16* Z1 = (const bf16*)(ws + A1_Z1); const bf16* WQ = (const bf16*)(ws + OFF_W_UQ); const bf16* WKV = (const bf16*)(ws + OFF_W_UKV);
    bf16* QM = (bf16*)(ws + A1_QM); bf16* KM = (bf16*)(ws + A1_KM); bf16* VTM = (bf16*)(ws + A1_VTM);
    const f32x2* rope = (const f32x2*)(ws + OFF_ROPE);
    const int tid = threadIdx.x, lane = tid & 63, wid = tid >> 6, wr = wid >> 1, wc = wid & 1, fr = lane & 15, fq = lane >> 4;
    LAS float* rsb = (LAS float*)(lds + 66560);
    constexpr int NQ = (TL / 128) * 12, NKV = (TT / 128) * 16;
    constexpr float QSCALE = 0.07216878364870322f * LOG2E;
    auto decode = [&](int t, bool& isq, int& tm, int& tn) { isq = t < NQ; if (isq) { tile_mn(t, TL / 128, 12, tm, tn); tm += 4; } else tile_mn(t - NQ, TT / 128, 16, tm, tn); };
    auto make = [&](int t, GPtrs& g, int& nk) {
        bool isq; int tm, tn; decode(t, isq, tm, tn);
        const int brow = tm * 128, bcol = tn * 128, K = isq ? 512 : 256, acol = isq ? 0 : 512;
        const int par = ((t - vcu_id()) / (int)gridDim.x) & 1;
        {
            const int row = tid >> 1, half = tid & 1;
            const bf16* ap = Z1 + (size_t)(brow + row) * Z1P + acol + half * (K / 2);
            float ss = 0.f;
            for (int c = 0; c < K / 2; c += 8) { const u32x4 w = *(const u32x4*)(ap + c);
                const float v0 = bflo(w.x), v1 = bfhi(w.x), v2 = bflo(w.y), v3 = bfhi(w.y), v4 = bflo(w.z), v5 = bfhi(w.z), v6 = bflo(w.w), v7 = bfhi(w.w);
                ss += v0 * v0 + v1 * v1 + v2 * v2 + v3 * v3 + v4 * v4 + v5 * v5 + v6 * v6 + v7 * v7; }
            ss += __shfl_xor(ss, 1);
            if (half == 0) rsb[par * 128 + row] = rsqrtf(ss / (float)K + RMS_EPS);
        }
        plain_ptrs(Z1 + acol, brow, Z1P, g.a); plain_ptrs(isq ? WQ : WKV, bcol, K, g.b); nk = K / 64;
    };
    auto epi = [&](int t, f32x4 (&acc)[4][4]) {
        bool isq; int tm, tn; decode(t, isq, tm, tn);
        const int brow = tm * 128, bcol = tn * 128;
        const int par = ((t - vcu_id()) / (int)gridDim.x) & 1;
        const int cb = bcol + wc * 64;
#pragma unroll
        for (int m = 0; m < 4; ++m) {
            const int i = wr * 64 + m * 16 + fr, r = brow + i;
            const RowInfo ri = rowinfo(r);
            const float rs = rsb[par * 128 + i];
            if (isq) {
                const int h = cb / 192, part = (cb % 192) >> 6;
                bf16* dst = QM + ((size_t)(ri.b * 8 + h) * SEQ + ri.pos) * 192 + part * 64;
                const float sc = rs * QSCALE;
                if (part < 2) {
#pragma unroll
                    for (int n = 0; n < 4; ++n) *(u32x2*)(dst + n * 16 + fq * 4) = (u32x2){pk2(acc[m][n][0] * sc, acc[m][n][1] * sc), pk2(acc[m][n][2] * sc, acc[m][n][3] * sc)};
                } else {
                    f32x4 o[4];
#pragma unroll
                    for (int n = 0; n < 2; ++n)
#pragma unroll
                        for (int j = 0; j < 4; ++j) {
                            const float x1 = acc[m][n][j] * sc, x2 = acc[m][n + 2][j] * sc;
                            const f32x2 cs = rope[(size_t)ri.pos * 32 + n * 16 + fq * 4 + j];
                            o[n][j] = x1 * cs.x - x2 * cs.y; o[n + 2][j] = x2 * cs.x + x1 * cs.y;
                        }
#pragma unroll
                    for (int n = 0; n < 4; ++n) *(u32x2*)(dst + n * 16 + fq * 4) = (u32x2){pk2(o[n][0], o[n][1]), pk2(o[n][2], o[n][3])};
                }
            } else {
                const int h = cb >> 8, part = (cb & 255) >> 6;
                if (part < 2) {
                    bf16* dst = KM + ((size_t)(ri.b * 8 + h) * NKEY + ri.kq) * 192 + part * 64;
#pragma unroll
                    for (int n = 0; n < 4; ++n) *(u32x2*)(dst + n * 16 + fq * 4) = (u32x2){pk2(acc[m][n][0] * rs, acc[m][n][1] * rs), pk2(acc[m][n][2] * rs, acc[m][n][3] * rs)};
                } else {
                    bf16* dst = VTM + ((size_t)(ri.b * 8 + h) * 128 + (part - 2) * 64) * NKEY + ri.kq;
#pragma unroll
                    for (int n = 0; n < 4; ++n)
#pragma unroll
                        for (int j = 0; j < 4; ++j) dst[(size_t)(n * 16 + fq * 4 + j) * NKEY] = f2bf(acc[m][n][j] * rs);
                }
            }
        }
    };
    gemm_tiles<true>(lds, vcu_id(), NQ + NKV, gridDim.x, make, epi);
}

__device__ __forceinline__ void ph_mla_attn(const Params& p, LAS unsigned char* lds) {
    unsigned char* ws = p.ws;
    const bf16* QM = (const bf16*)(ws + A1_QM); const bf16* KM = (const bf16*)(ws + A1_KM); const bf16* VTM = (const bf16*)(ws + A1_VTM); bf16* MIX = (bf16*)(ws + A1_MIX);
    for (int item = blockIdx.x; item < 2 * 8 * 64; item += gridDim.x) {
        const int qt = item & 63, h = (item >> 6) & 7, b = item >> 9;
        const bf16* Qg = QM + ((size_t)(b * 8 + h) * SEQ + qt * 128) * 192;
        const bf16* Kg = KM + (size_t)(b * 8 + h) * NKEY * 192;
        const bf16* Vg = VTM + (size_t)(b * 8 + h) * 128 * NKEY;
        attn_item<192, 128>(lds, Qg, Kg, Vg, NKEY / 64, 0, 0, 0, -1e30f, 0.f, MIX + (size_t)(TC + b * SEQ + qt * 128) * DM + h * 128, DM);
    }
}


#define XB_TMO      128
#define XB_XCNT(j)  (256  + 64 * (j))
#define XB_XSUB(j)  (1280 + 64 * (j))
#define XB_XGEN(j)  (2304 + 64 * (j))
#define XB_TOP      3328
#define XB_TOPGEN   3392
#define XCD_BAR_WORDS 3456
#define XB_SPIN_CAP (1u << 18)
__device__ __forceinline__ unsigned xb_ld(unsigned* p)              { return __hip_atomic_load(p, __ATOMIC_RELAXED, __HIP_MEMORY_SCOPE_AGENT); }
__device__ __forceinline__ unsigned xb_add(unsigned* p, unsigned v) { return __hip_atomic_fetch_add(p, v, __ATOMIC_RELAXED, __HIP_MEMORY_SCOPE_AGENT); }
__device__ __forceinline__ unsigned xb_xcc_id() { return (unsigned)__builtin_amdgcn_s_getreg((3 << 11) | 20) & 0xFu; }
#define XB_SPIN(cond, bar) do { unsigned _sp = 0; while (cond) { __builtin_amdgcn_s_sleep(1); \
    if ((++_sp & 255u) == 0u) { if (xb_ld(&(bar)[XB_TMO])) break; if (_sp > XB_SPIN_CAP) { atomicAdd(&(bar)[XB_TMO], 1u); break; } } } } while (0)
struct XcdBarrier { unsigned* bar; unsigned x; volatile LAS unsigned* st; };
__device__ __forceinline__ XcdBarrier xcd_barrier_post(unsigned* bar, volatile LAS unsigned* st) {
    XcdBarrier b; b.bar = bar; b.x = xb_xcc_id(); b.st = st;
    if (threadIdx.x == 0) (void)xb_add(&bar[XB_XCNT(b.x)], 1u);
    return b;
}
__device__ __forceinline__ void xcd_barrier_complete(unsigned* bar, unsigned x, unsigned& nloc, unsigned& nx) {
    const unsigned G = gridDim.x * gridDim.y * gridDim.z;
    unsigned sum, cnt, mine, sp = 0u;
    for (;;) {
        sum = 0u; cnt = 0u; mine = 0u;
#pragma unroll
        for (unsigned j = 0; j < 16; ++j) { const unsigned c = xb_ld(&bar[XB_XCNT(j)]); sum += c; cnt += (c > 0u) ? 1u : 0u; mine = (j == x) ? c : mine; }
        if (sum == G) break;
        __builtin_amdgcn_s_sleep(1);
        if ((++sp & 255u) == 0u) { if (xb_ld(&bar[XB_TMO])) break; if (sp > XB_SPIN_CAP) { atomicAdd(&bar[XB_TMO], 1u); break; } }
    }
    nloc = mine > 0u ? mine : 1u; nx = cnt > 0u ? cnt : 1u;
}
__device__ __forceinline__ void xcd_barrier(const XcdBarrier& b) {
    asm volatile("s_waitcnt vmcnt(0)" ::: "memory");
    __syncthreads();
    if (threadIdx.x == 0) {
        unsigned* bar = b.bar;
        __builtin_amdgcn_s_waitcnt(0);
        unsigned nloc = b.st[0], nx = b.st[1];
        if (nloc == 0u) { xcd_barrier_complete(bar, b.x, nloc, nx); b.st[0] = nloc; b.st[1] = nx; }
        const unsigned old = xb_add(&bar[XB_XSUB(b.x)], 1u);
        const unsigned gen = old / nloc;
        if (old + 1u == (gen + 1u) * nloc) {
            __builtin_amdgcn_fence(__ATOMIC_RELEASE, "agent");
            asm volatile("s_waitcnt vmcnt(0)" ::: "memory");
            const unsigned og = xb_add(&bar[XB_TOP], 1u);
            const unsigned tg = og / nx;
            if (og + 1u == (tg + 1u) * nx) xb_add(&bar[XB_TOPGEN], 1u);
            else XB_SPIN(xb_ld(&bar[XB_TOPGEN]) == tg, bar);
            __builtin_amdgcn_fence(__ATOMIC_ACQUIRE, "agent");
            xb_add(&bar[XB_XGEN(b.x)], 1u);
            asm volatile("s_waitcnt vmcnt(0)" ::: "memory");
        } else {
            XB_SPIN(xb_ld(&bar[XB_XGEN(b.x)]) == gen, bar);
            __builtin_amdgcn_fence(__ATOMIC_ACQUIRE, "agent");
            asm volatile("s_waitcnt vmcnt(0)" ::: "memory");
        }
    }
    __syncthreads();
}
static_assert(XCD_BAR_WORDS * 4 <= BAR_BYTES, "barrier words");

constexpr int NPHASE = 19;
__global__ void __launch_bounds__(256, 2) mega(Params p) {
    extern __shared__ __attribute__((aligned(16))) unsigned char lds_[];
    LAS unsigned char* lds = (LAS unsigned char*)lds_;
    cg::grid_group grid = cg::this_grid();
    unsigned char* ws = p.ws;
    volatile LAS unsigned* bst = (volatile LAS unsigned*)(lds + LDS_BYTES - 16);
    if (threadIdx.x < 4) bst[threadIdx.x] = 0u;
    __syncthreads();
    const XcdBarrier xbar = xcd_barrier_post((unsigned*)(ws + OFF_BAR), bst);
#define GRID_BAR(k) do { if ((k) == 0) grid.sync(); else xcd_barrier(xbar); } while (0)
#ifndef PROBE_REP_MASK
#define PROBE_REP_MASK 0u
#endif
#ifndef PROBE_EXTRA_SYNCS
#define PROBE_EXTRA_SYNCS 0
#endif
#define PHASE(k, body) do { if (p.ph_lo <= (k) && (k) < p.ph_hi) { body; if ((PROBE_REP_MASK >> (k)) & 1u) { xcd_barrier(xbar); body; } if ((k) + 1 < p.ph_hi) GRID_BAR(k); } } while (0)
    for (int i = 0; i < PROBE_EXTRA_SYNCS; ++i) xcd_barrier(xbar);
    PHASE(0, ph_prep(p, lds));
    PHASE(1, ph_modulate0(p));
    PHASE(2, ph_inproj0(p, lds));
    PHASE(3, ph_swa_g1(p, lds));
    PHASE(4, ph_gla_scan(p));
    PHASE(5, ph_gla_g3(p, lds));
    PHASE(6, ph_outproj(p, lds, (const bf16*)(ws + A0_MIX), (const bf16*)(ws + OFF_W_OUT_E), (float*)(ws + A0_Y), 0));
    PHASE(7, ph_rowpassA(p, 0, 0, (const float*)(ws + A0_Y)));
    PHASE(8, { ph_router(p, lds, 0, 0); __syncthreads(); for (int it = blockIdx.x; it < EXP_ITEMS; it += gridDim.x) expert_convert_item(p, lds, 0, it); });
    PHASE(9, ph_moe1(p, lds, 0, 0));
    PHASE(10, ph_moe2(p, lds, 0, 0));
    PHASE(11, ph_rowpassB(p, lds, 0, 0));
    PHASE(12, ph_inproj1(p, lds));
    PHASE(13, ph_mla_up(p, lds));
    PHASE(14, ph_mla_attn(p, lds));
    PHASE(15, ph_outproj(p, lds, (const bf16*)(ws + A1_MIX), (const bf16*)(ws + OFF_W_OUT_O), (float*)(ws + A1_Y), TC));
    PHASE(16, ph_rowpassA(p, 1, TC, (const float*)(ws + A1_Y)));
    PHASE(17, { ph_router(p, lds, 1, TC); __syncthreads(); for (int it = blockIdx.x; it < EXP_ITEMS; it += gridDim.x) expert_convert_item(p, lds, 1, it); });
    PHASE(18, ph_moe1(p, lds, 1, TC));
    PHASE(19, ph_moe2(p, lds, 1, TC));
    PHASE(20, ph_rowpassB(p, lds, 1, TC));
}

extern "C" void kernel_launch(void* const* d_in, const int* in_sizes, int n_in, void* d_out, int out_size, void* d_ws, size_t ws_size, hipStream_t stream) {
    static int grid_blocks = 0;
    if (!grid_blocks) {
        int dev = 0, cus = 0, per_cu = 0;
        (void)hipGetDevice(&dev);
        (void)hipDeviceGetAttribute(&cus, hipDeviceAttributeMultiprocessorCount, dev);
        (void)hipFuncSetAttribute((const void*)mega, hipFuncAttributeMaxDynamicSharedMemorySize, LDS_BYTES);
        (void)hipOccupancyMaxActiveBlocksPerMultiprocessor(&per_cu, (const void*)mega, 256, LDS_BYTES);
        if (per_cu > 2) per_cu = 2;
        if (per_cu < 1) per_cu = 1;
        grid_blocks = cus * per_cu;
        if (ws_size < WS_NEED) fprintf(stderr, "kernel_launch: workspace too small: %zu < %zu\n", ws_size, (size_t)WS_NEED);
    }
    Params p{};
    const float** f = (const float**)&p;
    for (int i = 0; i < 30; ++i) f[i] = (const float*)d_in[i];
    p.out = (float*)d_out; p.ws = (unsigned char*)d_ws; p.ph_lo = 0; p.ph_hi = 21;
    (void)hipMemsetAsync((unsigned char*)d_ws + OFF_BAR, 0, BAR_BYTES, stream);
    void* args[] = {&p};
    hipError_t e = hipLaunchCooperativeKernel((const void*)mega, dim3(grid_blocks), dim3(256), args, LDS_BYTES, stream);
    if (e != hipSuccess) fprintf(stderr, "cooperative launch failed: %s (grid %d)\n", hipGetErrorString(e), grid_blocks);
}
```

```cpp
#include <hip/hip_runtime.h>
#include <hip/hip_cooperative_groups.h>
#include <cstdio>
#include <cstdint>
namespace cg = cooperative_groups;

#define LAS __attribute__((address_space(3)))
typedef unsigned short bf16;
typedef short bf16x8 __attribute__((ext_vector_type(8)));
typedef float f32x2 __attribute__((ext_vector_type(2)));
typedef float f32x4 __attribute__((ext_vector_type(4)));
typedef float f32x8 __attribute__((ext_vector_type(8)));
typedef float f32x16 __attribute__((ext_vector_type(16)));
typedef unsigned u32x2 __attribute__((ext_vector_type(2)));
typedef unsigned u32x4 __attribute__((ext_vector_type(4)));
typedef __bf16 bf16x2_t __attribute__((ext_vector_type(2)));

constexpr int DM = 1024, NB = 2, SEQ = 8192, CTX = 256;
constexpr int TC = NB * CTX, TL = NB * SEQ, TT = TC + TL, NKEY = CTX + SEQ;
constexpr int NEXP = 64;
constexpr float RMS_EPS = 1e-6f;
constexpr int E_IN_PAD = 2432, O_IN_PAD = 896;
constexpr float LOG2E = 1.4426950408889634f;
constexpr int NSTEP = 132;
constexpr int Z0P = 1056;
constexpr int Z1P = 768;
constexpr int LDS_BYTES = 73728;

constexpr size_t al(size_t x) { return (x + 255) & ~(size_t)255; }
constexpr size_t OFF_W_IN_E = 0;
constexpr size_t OFF_W_OUT_E = OFF_W_IN_E + al((size_t)E_IN_PAD * DM * 2);
constexpr size_t OFF_W_IN_O = OFF_W_OUT_E + al((size_t)DM * DM * 2);
constexpr size_t OFF_W_UQ = OFF_W_IN_O + al((size_t)O_IN_PAD * DM * 2);
constexpr size_t OFF_W_UKV = OFF_W_UQ + al((size_t)1536 * 512 * 2);
constexpr size_t OFF_W_OUT_O = OFF_W_UKV + al((size_t)2048 * 256 * 2);
constexpr size_t OFF_W_RT = OFF_W_OUT_O + al((size_t)DM * DM * 2);
constexpr size_t OFF_W_GU = OFF_W_RT + al((size_t)2 * 128 * DM * 2);
constexpr size_t OFF_W_D = OFF_W_GU + al((size_t)65 * 512 * DM * 2);
constexpr size_t OFF_U = OFF_W_D + al((size_t)65 * DM * 256 * 2);
constexpr size_t OFF_HC = OFF_U + al((size_t)TT * DM * 2);
constexpr size_t OFF_MOD = OFF_HC + al((size_t)TC * DM * 4);
constexpr size_t OFF_ROPE = OFF_MOD + al((size_t)2 * 3 * 6144 * 4);
constexpr size_t OFF_CNT = OFF_ROPE + al((size_t)SEQ * 32 * 8);
constexpr size_t OFF_TOKSLOT = OFF_CNT + al(2 * 64 * 4);
constexpr size_t OFF_W8 = OFF_TOKSLOT + al((size_t)TT * 8 * 4);
constexpr size_t OFF_LIST = OFF_W8 + al((size_t)TT * 8 * 4);
constexpr size_t OFF_BAR = OFF_LIST + al((size_t)64 * TT * 4);
constexpr size_t BAR_BYTES = 16384;
constexpr size_t OFF_ARENA = OFF_BAR + BAR_BYTES;
constexpr size_t A0_Z0 = OFF_ARENA;
constexpr size_t A0_VGT = A0_Z0 + al((size_t)TT * Z0P * 2);
constexpr size_t A0_QS = A0_VGT + al((size_t)4 * 128 * TT * 2);
constexpr size_t A0_KS = A0_QS + al((size_t)2 * 8 * NKEY * 64 * 2);
constexpr size_t A0_VST = A0_KS + al((size_t)2 * 2 * NKEY * 64 * 2);
constexpr size_t A0_GS = A0_VST + al((size_t)2 * 2 * 64 * NKEY * 2);
constexpr size_t A0_GD = A0_GS + al((size_t)16 * NSTEP * 8192 * 4);
constexpr size_t A0_MIX = A0_GD + al((size_t)16 * NSTEP * 64 * 4);
constexpr size_t A0_Y = A0_MIX + al((size_t)TT * DM * 2);
constexpr size_t A0_END = A0_Y + al((size_t)TT * DM * 4);
constexpr size_t A1_Z1 = OFF_ARENA;
constexpr size_t A1_QM = A1_Z1 + al((size_t)TT * Z1P * 2);
constexpr size_t A1_KM = A1_QM + al((size_t)2 * 8 * SEQ * 192 * 2);
constexpr size_t A1_VTM = A1_KM + al((size_t)2 * 8 * NKEY * 192 * 2);
constexpr size_t A1_MIX = A1_VTM + al((size_t)2 * 8 * 128 * NKEY * 2);
constexpr size_t A1_Y = A1_MIX + al((size_t)TT * DM * 2);
constexpr size_t A1_END = A1_Y + al((size_t)TT * DM * 4);
constexpr size_t AM_HM = OFF_ARENA;
constexpr size_t AM_YR = AM_HM + al((size_t)TT * 9 * 256 * 2);
constexpr size_t AM_END = AM_YR + al((size_t)TT * 9 * 1024 * 2);
constexpr size_t WS_NEED = AM_END > A0_END ? (AM_END > A1_END ? AM_END : A1_END) : (A0_END > A1_END ? A0_END : A1_END);
static_assert(WS_NEED <= 555747360ull, "workspace map exceeds the guaranteed d_ws size");

struct Params {
    const float *x, *c, *ctx, *c_ctx, *w_mod, *b_mod, *g_mix_pre, *g_mix_post, *g_ffn_pre, *g_ffn_post;
    const float *w_in_e, *gla_wa2, *gla_ba, *gla_norm, *swa_sink, *w_out_e;
    const float *w_in_o, *mla_q_norm, *mla_kv_norm, *w_uq, *w_ukv, *w_out_o;
    const float *w_router, *b_router, *w_exp_gate, *w_exp_up, *w_exp_down, *w_sh_gate, *w_sh_up, *w_sh_down;
    float* out; unsigned char* ws; int ph_lo, ph_hi;
};

__device__ __forceinline__ unsigned pk2(float lo, float hi) { f32x2 v = {lo, hi}; bf16x2_t b = __builtin_convertvector(v, bf16x2_t); return __builtin_bit_cast(unsigned, b); }
__device__ __forceinline__ float bflo(unsigned u) { return __uint_as_float(u << 16); }
__device__ __forceinline__ float bfhi(unsigned u) { return __uint_as_float(u & 0xffff0000u); }
__device__ __forceinline__ float bf2f(bf16 v) { return __uint_as_float((unsigned)v << 16); }
__device__ __forceinline__ bf16 f2bf(float f) { return (bf16)(pk2(f, 0.f) & 0xffffu); }
__device__ __forceinline__ float wave_sum(float v) {
#pragma unroll
    for (int o = 1; o < 64; o <<= 1) v += __shfl_xor(v, o);
    return v;
}
__device__ __forceinline__ void glds16(const void* g, LAS void* l) { __builtin_amdgcn_global_load_lds((const unsigned*)g, (LAS unsigned*)l, 16, 0, 0); }
__device__ __forceinline__ float siluf(float x) { return x / (1.f + __expf(-x)); }
__device__ __forceinline__ float ex2(float x) { return __builtin_amdgcn_exp2f(x); }
__device__ __forceinline__ int crow(int r, int hi) { return (r & 3) + 8 * (r >> 2) + 4 * hi; }
__device__ __forceinline__ bf16x8 mk8(u32x4 v) { return __builtin_bit_cast(bf16x8, v); }

struct RowInfo { int b, kq, pos; bool lat; };
__device__ __forceinline__ RowInfo rowinfo(int r) {
    RowInfo i;
    if (r < TC) { i.b = r >> 8; i.pos = r & 255; i.kq = i.pos; i.lat = false; }
    else { const int rl = r - TC; i.b = rl >> 13; i.pos = rl & (SEQ - 1); i.kq = CTX + i.pos; i.lat = true; }
    return i;
}
__device__ __forceinline__ int modvec(int r) { return r < TC ? 2 : ((r - TC) >> 13); }

struct GPtrs { const bf16* a[4]; const bf16* b[4]; };
constexpr int G_STAGE = 32768;
#define G_FENCE() asm volatile("" ::: "memory")
__device__ __forceinline__ void gemm_issue(LAS unsigned char* lds, const GPtrs& g, int kt) {
    LAS unsigned char* d = lds + (kt & 1) * G_STAGE + threadIdx.x * 16; const int ko = kt * 64;
#pragma unroll
    for (int i = 0; i < 4; ++i) { glds16(g.a[i] + ko, d + i * 4096); glds16(g.b[i] + ko, d + 16384 + i * 4096); }
}
__device__ __forceinline__ void gemm_prologue(LAS unsigned char* lds, const GPtrs& g, int nk) { gemm_issue(lds, g, 0); }
__device__ __forceinline__ void gemm_main(LAS unsigned char* lds, const GPtrs& g, int nk, f32x4 (&acc)[4][4], bool) {
    const int tid = threadIdx.x, lane = tid & 63, wid = tid >> 6, wr = wid >> 1, wc = wid & 1, fr = lane & 15, fq = lane >> 4;
#pragma unroll
    for (int m = 0; m < 4; ++m)
#pragma unroll
        for (int n = 0; n < 4; ++n) acc[m][n] = (f32x4){0.f, 0.f, 0.f, 0.f};
    const int c0 = ((fq) ^ (fr & 7)) * 16, c1 = ((4 + fq) ^ (fr & 7)) * 16;
    const int aoff = (wr * 64 + fr) * 128, boff = 16384 + (wc * 64 + fr) * 128;
    for (int kt = 0; kt < nk; ++kt) {
        asm volatile("s_waitcnt vmcnt(0) lgkmcnt(0)" ::: "memory");
        __builtin_amdgcn_s_barrier();
        G_FENCE();
        if (kt + 1 < nk) gemm_issue(lds, g, kt + 1);
        LAS unsigned char* base = lds + (kt & 1) * G_STAGE;
#pragma unroll
        for (int ks = 0; ks < 2; ++ks) {
            const int co = ks ? c1 : c0;
            bf16x8 af[4], bfr[4];
#pragma unroll
            for (int m = 0; m < 4; ++m) af[m] = *(const LAS bf16x8*)(base + aoff + m * 2048 + co);
#pragma unroll
            for (int n = 0; n < 4; ++n) bfr[n] = *(const LAS bf16x8*)(base + boff + n * 2048 + co);
#pragma unroll
            for (int m = 0; m < 4; ++m)
#pragma unroll
                for (int n = 0; n < 4; ++n) acc[m][n] = __builtin_amdgcn_mfma_f32_16x16x32_bf16(bfr[n], af[m], acc[m][n], 0, 0, 0);
        }
    }
    asm volatile("s_waitcnt lgkmcnt(0)" ::: "memory");
    __builtin_amdgcn_s_barrier();
    G_FENCE();
}
__device__ __forceinline__ int vcu_id() { const int b = blockIdx.x, G = gridDim.x; return (G % 8 == 0) ? (b % 8) * (G / 8) + b / 8 : b; }
__device__ __forceinline__ void tile_mn(int w, int ntm, int ntn, int& tm, int& tn) {
    const int nig = 8 * ntn, gid = w / nig, fm = gid * 8, gsz = (ntm - fm) < 8 ? (ntm - fm) : 8, within = w - gid * nig;
    tm = fm + within % gsz; tn = within / gsz;
}
template <bool PREFETCH_NEXT, class Make, class Epi>
__device__ __forceinline__ void gemm_tiles(LAS unsigned char* lds, int t0, int nt, int stride, Make make, Epi epi) {
    if (t0 >= nt) return;
    GPtrs g; int nk;
    make(t0, g, nk);
    G_FENCE();
    gemm_prologue(lds, g, nk);
    bool first = true;
    for (int t = t0; t < nt;) {
        const int tn = t + stride;
        f32x4 acc[4][4];
        gemm_main(lds, g, nk, acc, !first);
        first = false;
        if (PREFETCH_NEXT) { if (tn < nt) { make(tn, g, nk); G_FENCE(); gemm_prologue(lds, g, nk); } epi(t, acc); }
        else { epi(t, acc); __syncthreads(); if (tn < nt) { make(tn, g, nk); G_FENCE(); gemm_prologue(lds, g, nk); } }
        t = tn;
    }
}

template <class RowPtr>
__device__ __forceinline__ void epi_store_rows(LAS unsigned char* wl, const f32x4 (&v)[4][4], int fr, int fq, int lane, RowPtr rowptr, int nrep = 1, size_t rep_stride = 0) {
#pragma unroll
    for (int m = 0; m < 4; ++m)
#pragma unroll
        for (int n = 0; n < 4; ++n)
            *(LAS u32x2*)(wl + (m * 16 + fr) * 128 + (((n * 2 + (fq >> 1)) ^ (fr & 7)) * 16) + (fq & 1) * 8) = (u32x2){pk2(v[m][n][0], v[m][n][1]), pk2(v[m][n][2], v[m][n][3])};
#pragma unroll
    for (int i = 0; i < 8; ++i) {
        const int row = (lane >> 3) + 8 * i, pos = lane & 7;
        const u32x4 w = *(const LAS u32x4*)(wl + row * 128 + pos * 16);
        bf16* d = rowptr(row);
        if (d) { d += (pos ^ (row & 7)) * 8; for (int r = 0; r < nrep; ++r) *(u32x4*)(d + (size_t)r * rep_stride) = w; }
    }
}
template <class ColPtr>
__device__ __forceinline__ void epi_store_cols(LAS unsigned char* wl, const f32x4 (&v)[4][4], int fr, int fq, int lane, ColPtr colptr) {
    LAS unsigned char* wb = wl + fq * 512 + fr * 2;
#pragma unroll
    for (int m = 0; m < 4; ++m)
#pragma unroll
        for (int n = 0; n < 4; ++n)
#pragma unroll
            for (int j = 0; j < 4; ++j) *(LAS bf16*)(wb + n * 2048 + j * 128 + m * 32) = f2bf(v[m][n][j]);
#pragma unroll
    for (int i = 0; i < 8; ++i) {
        const int col = (lane >> 3) + 8 * i, pos = lane & 7;
        const u32x4 w = *(const LAS u32x4*)(wl + col * 128 + pos * 16);
        bf16* d = colptr(col);
        *(u32x4*)(d + pos * 8) = w;
    }
}

__device__ __forceinline__ int ein_map(int n) {
    if (n < 512) return n;
    if (n < 1024) return n + 512;
    if (n < 1536) return n - 512;
    if (n < 2048) return 1568 + (n - 1536);
    if (n < 2176) return 2080 + (n - 2048);
    if (n < 2304) return 2208 + (n - 2176);
    if (n < 2320) return 1536 + (n - 2304);
    if (n < 2336) return 1552 + (n - 2320);
    return -1;
}
__device__ __forceinline__ void transpose_item(LAS unsigned char* lds, int K, bf16* dst, int k0, int n0, int ld, int mode, const float* srcA, const float* srcB, int nvalid, const float* kscale) {
    LAS float* tile = (LAS float*)lds;
    const int tid = threadIdx.x;
    {
        const int nq = tid & 31, kr = tid >> 5, n = n0 + nq * 4;
        const float* cp = nullptr; float sc = 1.f;
        if (mode == 0) { if (n < nvalid) cp = srcA + n; }
        else if (mode == 1) { const int c = ein_map(n); if (c >= 0) cp = srcA + c; if (n < 256) sc = 0.125f; }
        else { const int grp = n >> 6, w = n & 63; cp = (w < 32 ? srcA : srcB) + grp * 32 + (w & 31); }
        f32x4 v[8];
#pragma unroll
        for (int i = 0; i < 8; ++i) { const int k = kr + 8 * i; v[i] = cp ? *(const f32x4*)(cp + (size_t)(k0 + k) * ld) : (f32x4){0.f, 0.f, 0.f, 0.f}; }
#pragma unroll
        for (int i = 0; i < 8; ++i) { const int k = kr + 8 * i; float m = sc; if (kscale) m *= kscale[k0 + k]; *(LAS f32x4*)(tile + k * 132 + nq * 4) = v[i] * m; }
    }
    __syncthreads();
    {
        const int n = tid >> 1, hf = tid & 1;
#pragma unroll
        for (int c = 0; c < 4; ++c) {
            const int k8 = hf * 32 + c * 8;
            u32x4 o;
            o.x = pk2(tile[(k8 + 0) * 132 + n], tile[(k8 + 1) * 132 + n]);
            o.y = pk2(tile[(k8 + 2) * 132 + n], tile[(k8 + 3) * 132 + n]);
            o.z = pk2(tile[(k8 + 4) * 132 + n], tile[(k8 + 5) * 132 + n]);
            o.w = pk2(tile[(k8 + 6) * 132 + n], tile[(k8 + 7) * 132 + n]);
            *(u32x4*)(dst + (size_t)(n0 + n) * K + k0 + k8) = o;
        }
    }
    __syncthreads();
}

constexpr int EXP_GU_ITEMS = 65 * 16 * 4, EXP_D_ITEMS = 65 * 4 * 8, EXP_ITEMS = EXP_GU_ITEMS + EXP_D_ITEMS;
__device__ __forceinline__ void expert_convert_item(const Params& p, LAS unsigned char* lds, int l, int it) {
    unsigned char* ws = p.ws;
    if (it < EXP_GU_ITEMS) {
        const int e = it / 64, r = it % 64, kb = r / 4, nb = r % 4;
        const float* gate = e < 64 ? p.w_exp_gate + ((size_t)(l * 64 + e)) * DM * 256 : p.w_sh_gate + (size_t)l * DM * 256;
        const float* up = e < 64 ? p.w_exp_up + ((size_t)(l * 64 + e)) * DM * 256 : p.w_sh_up + (size_t)l * DM * 256;
        transpose_item(lds, DM, (bf16*)(ws + OFF_W_GU) + (size_t)e * 512 * DM, kb * 64, nb * 128, 256, 2, gate, up, 512, nullptr);
    } else {
        it -= EXP_GU_ITEMS;
        const int e = it / 32, r = it % 32, kb = r / 8, nb = r % 8;
        const float* dn = e < 64 ? p.w_exp_down + ((size_t)(l * 64 + e)) * 256 * DM : p.w_sh_down + (size_t)l * 256 * DM;
        transpose_item(lds, 256, (bf16*)(ws + OFF_W_D) + (size_t)e * DM * 256, kb * 64, nb * 128, DM, 0, dn, nullptr, DM, nullptr);
    }
}

__device__ __forceinline__ void ph_prep(const Params& p, LAS unsigned char* lds) {
    unsigned char* ws = p.ws;
    const int tid = threadIdx.x;
    if (blockIdx.x == 0 && tid < 128) ((int*)(ws + OFF_CNT))[tid] = 0;
    constexpr int I_MOD = 96, I_ROPE = 1024, I_INE = 16 * 19, I_OUTE = 128, I_INO = 16 * 7, I_UQ = 8 * 12, I_UKV = 4 * 16, I_OUTO = 128, I_RT = 32;
    constexpr int NITEMS = I_MOD + I_ROPE + I_INE + I_OUTE + I_INO + I_UQ + I_UKV + I_OUTO + I_RT;
    for (int item = blockIdx.x; item < NITEMS; item += gridDim.x) {
        int it = item;
        if (it < I_MOD) {
            const int l = it / 48, n0 = (it % 48) * 128, kg = tid >> 5, cl = tid & 31;
            LAS float* s = (LAS float*)lds;
            LAS float* red = (LAS float*)(lds + 12288);
            for (int idx = tid; idx < 3072; idx += 256) { const int v = idx >> 10, k = idx & 1023; const float cv = v < 2 ? p.c[v * DM + k] : p.c_ctx[k]; s[idx] = cv / (1.f + expf(-cv)); }
            __syncthreads();
            f32x4 a0 = {0.f, 0.f, 0.f, 0.f}, a1 = a0, a2 = a0;
            const float* w = p.w_mod + (size_t)l * DM * 6144 + (size_t)(kg * 128) * 6144 + n0 + cl * 4;
#pragma unroll 8
            for (int k = 0; k < 128; ++k) { const f32x4 wv = *(const f32x4*)(w + (size_t)k * 6144); const int kk = kg * 128 + k; a0 += wv * s[kk]; a1 += wv * s[1024 + kk]; a2 += wv * s[2048 + kk]; }
            *(LAS f32x4*)(red + (kg * 3 + 0) * 128 + cl * 4) = a0; *(LAS f32x4*)(red + (kg * 3 + 1) * 128 + cl * 4) = a1; *(LAS f32x4*)(red + (kg * 3 + 2) * 128 + cl * 4) = a2;
            __syncthreads();
            for (int idx = tid; idx < 384; idx += 256) { const int v = idx >> 7, n = idx & 127; float acc = 0.f;
#pragma unroll
                for (int g = 0; g < 8; ++g) acc += red[(g * 3 + v) * 128 + n];
                ((float*)(ws + OFF_MOD))[((size_t)l * 3 + v) * 6144 + n0 + n] = acc + p.b_mod[l * 6144 + n0 + n]; }
            __syncthreads();
            continue;
        }
        it -= I_MOD;
        if (it < I_ROPE) {
            const int idx = it * 256 + tid, pos = idx >> 5, i = idx & 31, row = pos >> 6, col = pos & 63, j = i & 15;
            const float invf = powf(10000.f, -(float)(2 * j) / 32.f);
            const float ang = (float)(i < 16 ? row : col) * invf;
            float sn, cs; sincosf(ang, &sn, &cs);
            ((f32x2*)(ws + OFF_ROPE))[idx] = (f32x2){cs, sn};
            continue;
        }
        it -= I_ROPE;
        if (it < I_INE) { const int kb = it / 19, nb = it % 19;
            transpose_item(lds, DM, (bf16*)(ws + OFF_W_IN_E), kb * 64, nb * 128, 2336, 1, p.w_in_e, nullptr, 2336, nullptr); continue; }
        it -= I_INE;
        if (it < I_OUTE) { const int kb = it / 8, nb = it % 8;
            transpose_item(lds, DM, (bf16*)(ws + OFF_W_OUT_E), kb * 64, nb * 128, DM, 0, p.w_out_e, nullptr, DM, nullptr); continue; }
        it -= I_OUTE;
        if (it < I_INO) { const int kb = it / 7, nb = it % 7;
            transpose_item(lds, DM, (bf16*)(ws + OFF_W_IN_O), kb * 64, nb * 128, 832, 0, p.w_in_o, nullptr, 832, nullptr); continue; }
        it -= I_INO;
        if (it < I_UQ) { const int kb = it / 12, nb = it % 12;
            transpose_item(lds, 512, (bf16*)(ws + OFF_W_UQ), kb * 64, nb * 128, 1536, 0, p.w_uq, nullptr, 1536, p.mla_q_norm); continue; }
        it -= I_UQ;
        if (it < I_UKV) { const int kb = it / 16, nb = it % 16;
            transpose_item(lds, 256, (bf16*)(ws + OFF_W_UKV), kb * 64, nb * 128, 2048, 0, p.w_ukv, nullptr, 2048, p.mla_kv_norm); continue; }
        it -= I_UKV;
        if (it < I_OUTO) { const int kb = it / 8, nb = it % 8;
            transpose_item(lds, DM, (bf16*)(ws + OFF_W_OUT_O), kb * 64, nb * 128, DM, 0, p.w_out_o, nullptr, DM, nullptr); continue; }
        it -= I_OUTO;
        { const int l = it / 16, kb = it % 16;
            transpose_item(lds, DM, (bf16*)(ws + OFF_W_RT) + (size_t)l * 128 * DM, kb * 64, 0, 64, 0, p.w_router + (size_t)l * DM * 64, nullptr, 64, nullptr); }
    }
}

__device__ __forceinline__ void load_row(const float* src, int lane, f32x4 (&v)[4]) {
#pragma unroll
    for (int j = 0; j < 4; ++j) v[j] = *(const f32x4*)(src + lane * 4 + 256 * j);
}
__device__ __forceinline__ float row_sumsq(const f32x4 (&v)[4]) {
    float s = 0.f;
#pragma unroll
    for (int j = 0; j < 4; ++j) s += v[j].x * v[j].x + v[j].y * v[j].y + v[j].z * v[j].z + v[j].w * v[j].w;
    return wave_sum(s);
}
__device__ __forceinline__ void modulate_store(const f32x4 (&v)[4], float rinv, const float* g, const float* sh, const float* sc, bf16* dst, int lane) {
#pragma unroll
    for (int j = 0; j < 4; ++j) {
        const int c = lane * 4 + 256 * j;
        const f32x4 gg = *(const f32x4*)(g + c), s1 = *(const f32x4*)(sc + c), s0 = *(const f32x4*)(sh + c);
        const f32x4 o = v[j] * rinv * gg * (s1 + 1.f) + s0;
        u32x2 w; w.x = pk2(o.x, o.y); w.y = pk2(o.z, o.w);
        *(u32x2*)(dst + c) = w;
    }
}
__device__ __forceinline__ const float* hl_src0(const Params& p, int r) { return r < TC ? p.ctx + (size_t)r * DM : p.x + (size_t)(r - TC) * DM; }
__device__ __forceinline__ float* hl_buf(const Params& p, int r) { return r < TC ? (float*)(p.ws + OFF_HC) + (size_t)r * DM : p.out + (size_t)(r - TC) * DM; }

__device__ __forceinline__ void ph_modulate0(const Params& p) {
    const int lane = threadIdx.x & 63, gw = blockIdx.x * 4 + (threadIdx.x >> 6), ngw = gridDim.x * 4;
    const float* mod = (const float*)(p.ws + OFF_MOD);
    bf16* U = (bf16*)(p.ws + OFF_U);
    for (int r = gw; r < TT; r += ngw) {
        f32x4 v[4]; load_row(hl_src0(p, r), lane, v);
        const float rinv = rsqrtf(row_sumsq(v) * (1.f / DM) + RMS_EPS);
        const float* mv = mod + (size_t)modvec(r) * 6144;
        modulate_store(v, rinv, p.g_mix_pre, mv, mv + 1024, U + (size_t)r * DM, lane);
    }
}

__device__ __forceinline__ void ph_rowpassA(const Params& p, int l, int row_lo, const float* Y) {
    const int lane = threadIdx.x & 63, gw = blockIdx.x * 4 + (threadIdx.x >> 6), ngw = gridDim.x * 4;
    const float* mod = (const float*)(p.ws + OFF_MOD) + (size_t)l * 3 * 6144;
    bf16* U = (bf16*)(p.ws + OFF_U);
    for (int r = row_lo + gw; r < TT; r += ngw) {
        f32x4 y[4], h[4];
        load_row(Y + (size_t)r * DM, lane, y);
        load_row(l == 0 ? hl_src0(p, r) : (const float*)hl_buf(p, r), lane, h);
        const float rinv = rsqrtf(row_sumsq(y) * (1.f / DM) + RMS_EPS);
        const float* mv = mod + (size_t)modvec(r) * 6144;
        float* hb = hl_buf(p, r);
#pragma unroll
        for (int j = 0; j < 4; ++j) {
            const int c = lane * 4 + 256 * j;
            const f32x4 gg = *(const f32x4*)(p.g_mix_post + l * DM + c), gt = *(const f32x4*)(mv + 2048 + c);
            h[j] = h[j] + gt * (y[j] * rinv * gg);
            *(f32x4*)(hb + c) = h[j];
        }
        const float rinv2 = rsqrtf(row_sumsq(h) * (1.f / DM) + RMS_EPS);
        modulate_store(h, rinv2, p.g_ffn_pre + l * DM, mv + 3072, mv + 4096, U + (size_t)r * DM, lane);
    }
}

constexpr int MOE_LDS_OFF = 65536;
__device__ __forceinline__ void moe_tables(const Params& p, LAS unsigned char* lds, int l, int row_lo) {
    LAS int* cnt = (LAS int*)(lds + MOE_LDS_OFF); LAS int* tp = cnt + 80; LAS int* sp = tp + 80;
    const int tid = threadIdx.x;
    if (tid < 64) cnt[tid] = ((const int*)(p.ws + OFF_CNT))[l * 64 + tid];
    if (tid == 64) cnt[64] = TT - row_lo;
    __syncthreads();
    if (tid == 0) {
        int a = 0, s = 0;
        for (int e = 0; e < 65; ++e) { tp[e] = a; sp[e] = s; a += (cnt[e] + 127) >> 7; s += cnt[e]; }
        tp[65] = a;
    }
    __syncthreads();
}

__device__ __forceinline__ void ph_rowpassB(const Params& p, LAS unsigned char* lds, int l, int row_lo) {
    moe_tables(p, lds, l, row_lo);
    LAS int* sp = (LAS int*)(lds + MOE_LDS_OFF) + 160;
    const int lane = threadIdx.x & 63, gw = blockIdx.x * 4 + (threadIdx.x >> 6), ngw = gridDim.x * 4;
    const float* mod = (const float*)(p.ws + OFF_MOD) + (size_t)l * 3 * 6144;
    const bf16* YR = (const bf16*)(p.ws + AM_YR);
    const int* tokslot = (const int*)(p.ws + OFF_TOKSLOT); const float* W8 = (const float*)(p.ws + OFF_W8);
    bf16* U = (bf16*)(p.ws + OFF_U);
    for (int r = row_lo + gw; r < TT; r += ngw) {
        f32x4 f[4];
#pragma unroll
        for (int j = 0; j < 4; ++j) f[j] = (f32x4){0.f, 0.f, 0.f, 0.f};
#pragma unroll
        for (int k = 0; k < 9; ++k) {
            size_t slot; float wk = 1.f;
            if (k < 8) { const int ts = tokslot[(size_t)r * 8 + k]; slot = (size_t)(sp[ts >> 20] + (ts & 0xfffff)); wk = W8[(size_t)r * 8 + k]; }
            else slot = (size_t)TT * 8 + r;
            const bf16* yr = YR + slot * DM;
#pragma unroll
            for (int j = 0; j < 4; ++j) {
                const u32x2 w = *(const u32x2*)(yr + lane * 4 + 256 * j);
                f[j].x += wk * bflo(w.x); f[j].y += wk * bfhi(w.x); f[j].z += wk * bflo(w.y); f[j].w += wk * bfhi(w.y);
            }
        }
        const float rinv = rsqrtf(row_sumsq(f) * (1.f / DM) + RMS_EPS);
        const float* mv = mod + (size_t)modvec(r) * 6144;
        float* hb = hl_buf(p, r);
        f32x4 h[4]; load_row(hb, lane, h);
#pragma unroll
        for (int j = 0; j < 4; ++j) {
            const int c = lane * 4 + 256 * j;
            const f32x4 gg = *(const f32x4*)(p.g_ffn_post + l * DM + c), gt = *(const f32x4*)(mv + 5120 + c);
            h[j] = h[j] + gt * (f[j] * rinv * gg);
            *(f32x4*)(hb + c) = h[j];
        }
        if (l == 0) {
            const float rinv2 = rsqrtf(row_sumsq(h) * (1.f / DM) + RMS_EPS);
            const float* mv1 = mv + 3 * 6144;
            modulate_store(h, rinv2, p.g_mix_pre + DM, mv1, mv1 + 1024, U + (size_t)r * DM, lane);
        }
    }
}

__device__ __forceinline__ int stg_col() { const int tid = threadIdx.x; return ((tid & 7) ^ ((tid >> 3) & 7)) * 8; }
__device__ __forceinline__ void plain_ptrs(const bf16* base, int row0, int ld, const bf16* (&pp)[4]) {
    const int tid = threadIdx.x;
    pp[0] = base + (size_t)(row0 + (tid >> 3)) * ld + stg_col();
#pragma unroll
    for (int i = 1; i < 4; ++i) pp[i] = pp[0] + (size_t)(32 * i) * ld;
}

__device__ __forceinline__ void ph_inproj0(const Params& p, LAS unsigned char* lds) {
    unsigned char* ws = p.ws;
    const bf16* U = (const bf16*)(ws + OFF_U); const bf16* W = (const bf16*)(ws + OFF_W_IN_E);
    bf16* Z0 = (bf16*)(ws + A0_Z0); bf16* VGT = (bf16*)(ws + A0_VGT); bf16* QS = (bf16*)(ws + A0_QS); bf16* KS = (bf16*)(ws + A0_KS); bf16* VST = (bf16*)(ws + A0_VST);
    const f32x2* rope = (const f32x2*)(ws + OFF_ROPE);
    const int tid = threadIdx.x, lane = tid & 63, wid = tid >> 6, wr = wid >> 1, wc = wid & 1, fr = lane & 15, fq = lane >> 4;
    constexpr int NTN = 19, NTM = TT / 128;
    auto make = [&](int t, GPtrs& g, int& nk) { int tm, tn; tile_mn(t, NTM, NTN, tm, tn); plain_ptrs(U, tm * 128, DM, g.a); plain_ptrs(W, tn * 128, DM, g.b); nk = DM / 64; };
    auto epi = [&](int t, f32x4 (&acc)[4][4]) {
        int tm, tn; tile_mn(t, NTM, NTN, tm, tn); const int brow = tm * 128, bcol = tn * 128;
        const int cb = bcol + wc * 64;
        LAS unsigned char* wl = lds + 32768 + wid * 8192;
        const int r0 = brow + wr * 64;
        const RowInfo ri0 = rowinfo(r0);
        if (cb < 1024) {
            epi_store_rows(wl, acc, fr, fq, lane, [&](int row) { return Z0 + (size_t)(r0 + row) * Z0P + cb; });
        } else if (cb < 1536) {
            const int c0 = cb - 1024;
            epi_store_cols(wl, acc, fr, fq, lane, [&](int col) { return VGT + (size_t)(c0 + col) * TT + r0; });
        } else if (cb < 2176) {
            const float sc = cb < 2048 ? 0.125f * LOG2E : 1.f;
#pragma unroll
            for (int m = 0; m < 4; ++m) {
                const int pos = ri0.pos + m * 16 + fr;
#pragma unroll
                for (int n = 0; n < 2; ++n)
#pragma unroll
                    for (int j = 0; j < 4; ++j) {
                        const float x1 = acc[m][n][j] * sc, x2 = acc[m][n + 2][j] * sc;
                        if (ri0.lat) { const f32x2 cs = rope[(size_t)pos * 32 + n * 16 + fq * 4 + j]; acc[m][n][j] = x1 * cs.x - x2 * cs.y; acc[m][n + 2][j] = x2 * cs.x + x1 * cs.y; }
                        else { acc[m][n][j] = x1; acc[m][n + 2][j] = x2; }
                    }
                asm volatile("" ::: "memory");
            }
            bf16* dst;
            if (cb < 2048) { const int h = (cb - 1536) >> 6; dst = QS + ((size_t)(ri0.b * 8 + h) * NKEY + ri0.kq) * 64; }
            else { const int h = (cb - 2048) >> 6; dst = KS + ((size_t)(ri0.b * 2 + h) * NKEY + ri0.kq) * 64; }
            epi_store_rows(wl, acc, fr, fq, lane, [&](int row) { return dst + (size_t)row * 64; });
        } else if (cb < 2304) {
            const int h = (cb - 2176) >> 6;
            bf16* dst = VST + (size_t)(ri0.b * 2 + h) * 64 * NKEY + ri0.kq;
            epi_store_cols(wl, acc, fr, fq, lane, [&](int col) { return dst + (size_t)col * NKEY; });
        } else if (cb == 2304) {
#pragma unroll
            for (int m = 0; m < 4; ++m) {
                const int r = r0 + m * 16 + fr;
#pragma unroll
                for (int n = 0; n < 2; ++n) { u32x2 w; w.x = pk2(acc[m][n][0], acc[m][n][1]); w.y = pk2(acc[m][n][2], acc[m][n][3]); *(u32x2*)(Z0 + (size_t)r * Z0P + 1024 + n * 16 + fq * 4) = w; }
            }
        }
    };
    gemm_tiles<true>(lds, vcu_id(), NTM * NTN, gridDim.x, make, epi);
}

__device__ __forceinline__ void ph_outproj(const Params& p, LAS unsigned char* lds, const bf16* MIX, const bf16* W, float* Y, int row_lo) {
    const int tid = threadIdx.x, lane = tid & 63, wid = tid >> 6, wr = wid >> 1, wc = wid & 1, fr = lane & 15, fq = lane >> 4;
    const int tm0 = row_lo / 128, ntm = TT / 128 - tm0;
    auto make = [&](int t, GPtrs& g, int& nk) { int tm, tn; tile_mn(t, ntm, 8, tm, tn); plain_ptrs(MIX, (tm0 + tm) * 128, DM, g.a); plain_ptrs(W, tn * 128, DM, g.b); nk = DM / 64; };
    auto epi = [&](int t, f32x4 (&acc)[4][4]) {
        int tm, tn; tile_mn(t, ntm, 8, tm, tn); tm += tm0; const int brow = tm * 128, bcol = tn * 128;
#pragma unroll
        for (int m = 0; m < 4; ++m) {
            const int r = brow + wr * 64 + m * 16 + fr;
#pragma unroll
            for (int n = 0; n < 4; ++n) *(f32x4*)(Y + (size_t)r * DM + bcol + wc * 64 + n * 16 + fq * 4) = acc[m][n];
        }
    };
    gemm_tiles<true>(lds, vcu_id(), ntm * 8, gridDim.x, make, epi);
}

template <int DQK, int DV>
__device__ __forceinline__ void attn_item(LAS unsigned char* lds, const bf16* Qg, const bf16* Kg, const bf16* VTg, int a1, int b0, int b1, int qpos0,
                                          float m_init, float l_init, bf16* Og, int o_pitch) {
    constexpr int KP = (DQK + 8) * 2, VP = 136, NS = DQK / 16, NDV = DV / 32, KCH = DQK / 8;
    const int tid = threadIdx.x, lane = tid & 63, wid = tid >> 6, ql = lane & 31, hi = lane >> 5;
    bf16x8 qf[NS];
    {
        const bf16* qrow = Qg + (size_t)(wid * 32 + ql) * DQK + hi * 8;
#pragma unroll
        for (int s = 0; s < NS; ++s) qf[s] = *(const bf16x8*)(qrow + s * 16);
    }
    f32x16 o[NDV];
#pragma unroll
    for (int d = 0; d < NDV; ++d)
#pragma unroll
        for (int r = 0; r < 16; ++r) o[d][r] = 0.f;
    float mrun = m_init, lrun = l_init;
    const int ntot = a1 + (b1 - b0);
    LAS unsigned char* Ks = lds; LAS unsigned char* Vs = lds + 64 * KP;
    constexpr int KN = KCH / 4, VN = DV / 32;
    u32x4 kreg[KN], vreg[VN];
    const bf16* kgp = Kg + (size_t)(tid >> 2) * DQK + (tid & 3) * 8;
    const bf16* vgp = VTg + (size_t)(tid >> 3) * NKEY + (tid & 7) * 8;
    LAS unsigned char* ksp = Ks + (tid >> 2) * KP + (tid & 3) * 16;
    LAS unsigned char* vsp = Vs + (tid >> 3) * VP + (tid & 7) * 16;
#define ATTN_LOAD(kt_) do { \
        _Pragma("unroll") for (int i_ = 0; i_ < KN; ++i_) kreg[i_] = *(const u32x4*)(kgp + (size_t)(kt_) * 64 * DQK + i_ * 32); \
        _Pragma("unroll") for (int i_ = 0; i_ < VN; ++i_) vreg[i_] = *(const u32x4*)(vgp + (size_t)(i_ * 32) * NKEY + (kt_) * 64); } while (0)
    ATTN_LOAD(a1 > 0 ? 0 : b0);
    for (int it = 0; it < ntot; ++it) {
        const int kt = it < a1 ? it : b0 + (it - a1);
        const bool masked = it >= a1;
        __syncthreads();
#pragma unroll
        for (int i = 0; i < KN; ++i) *(LAS u32x4*)(ksp + i * 64) = kreg[i];
#pragma unroll
        for (int i = 0; i < VN; ++i) { LAS u32x2* d = (LAS u32x2*)(vsp + i * 32 * VP); d[0] = (u32x2){vreg[i].x, vreg[i].y}; d[1] = (u32x2){vreg[i].z, vreg[i].w}; }
        __syncthreads();
        if (it + 1 < ntot) { const int ktn = (it + 1) < a1 ? (it + 1) : b0 + (it + 1 - a1); ATTN_LOAD(ktn); }
        f32x16 p0, p1;
#pragma unroll
        for (int r = 0; r < 16; ++r) { p0[r] = 0.f; p1[r] = 0.f; }
#pragma unroll
        for (int s = 0; s < NS; ++s) {
            const bf16x8 k0 = *(const LAS bf16x8*)(Ks + ql * KP + (s * 16 + hi * 8) * 2);
            const bf16x8 k1 = *(const LAS bf16x8*)(Ks + (32 + ql) * KP + (s * 16 + hi * 8) * 2);
            p0 = __builtin_amdgcn_mfma_f32_32x32x16_bf16(k0, qf[s], p0, 0, 0, 0);
            p1 = __builtin_amdgcn_mfma_f32_32x32x16_bf16(k1, qf[s], p1, 0, 0, 0);
        }
        if (masked) {
            const int kbase = kt * 64 - CTX, qpos = qpos0 + wid * 32 + ql;
#pragma unroll
            for (int r = 0; r < 16; ++r) {
                const int d0 = qpos - (kbase + crow(r, hi)), d1 = d0 - 32;
                if (d0 > 128 || d0 < -128) p0[r] = -1e30f;
                if (d1 > 128 || d1 < -128) p1[r] = -1e30f;
            }
        }
        float mx = p0[0];
#pragma unroll
        for (int r = 1; r < 16; ++r) mx = fmaxf(mx, p0[r]);
#pragma unroll
        for (int r = 0; r < 16; ++r) mx = fmaxf(mx, p1[r]);
        mx = fmaxf(mx, __shfl_xor(mx, 32));
        if (__any(mx > mrun + 8.f)) {
            const float mn = fmaxf(mrun, mx), alpha = ex2(mrun - mn);
            mrun = mn; lrun *= alpha;
#pragma unroll
            for (int d = 0; d < NDV; ++d)
#pragma unroll
                for (int r = 0; r < 16; ++r) o[d][r] *= alpha;
        }
        float rs = 0.f;
#pragma unroll
        for (int r = 0; r < 16; ++r) { p0[r] = ex2(p0[r] - mrun); rs += p0[r]; }
#pragma unroll
        for (int r = 0; r < 16; ++r) { p1[r] = ex2(p1[r] - mrun); rs += p1[r]; }
        rs += __shfl_xor(rs, 32);
        lrun += rs;
        bf16x8 pf[4];
        { u32x4 w;
          w.x = pk2(p0[0], p0[1]); w.y = pk2(p0[2], p0[3]); w.z = pk2(p0[4], p0[5]); w.w = pk2(p0[6], p0[7]); pf[0] = mk8(w);
          w.x = pk2(p0[8], p0[9]); w.y = pk2(p0[10], p0[11]); w.z = pk2(p0[12], p0[13]); w.w = pk2(p0[14], p0[15]); pf[1] = mk8(w);
          w.x = pk2(p1[0], p1[1]); w.y = pk2(p1[2], p1[3]); w.z = pk2(p1[4], p1[5]); w.w = pk2(p1[6], p1[7]); pf[2] = mk8(w);
          w.x = pk2(p1[8], p1[9]); w.y = pk2(p1[10], p1[11]); w.z = pk2(p1[12], p1[13]); w.w = pk2(p1[14], p1[15]); pf[3] = mk8(w); }
#pragma unroll
        for (int d = 0; d < NDV; ++d) {
#pragma unroll
            for (int kk = 0; kk < 4; ++kk) {
                const int keybase = kk * 16 + 4 * hi;
                const LAS unsigned char* vp = Vs + (d * 32 + ql) * VP + keybase * 2;
                const u32x2 lo = *(const LAS u32x2*)vp, hh = *(const LAS u32x2*)(vp + 16);
                const bf16x8 vf = mk8((u32x4){lo.x, lo.y, hh.x, hh.y});
                o[d] = __builtin_amdgcn_mfma_f32_32x32x16_bf16(vf, pf[kk], o[d], 0, 0, 0);
            }
        }
    }
#undef ATTN_LOAD
    const float inv = 1.f / lrun;
    bf16* orow = Og + (size_t)(wid * 32 + ql) * o_pitch;
#pragma unroll
    for (int d = 0; d < NDV; ++d)
#pragma unroll
        for (int g = 0; g < 4; ++g) {
            u32x2 w; w.x = pk2(o[d][g * 4 + 0] * inv, o[d][g * 4 + 1] * inv); w.y = pk2(o[d][g * 4 + 2] * inv, o[d][g * 4 + 3] * inv);
            *(u32x2*)(orow + d * 32 + 8 * g + 4 * hi) = w;
        }
}

constexpr int GA_CUM = 0, GA_ALOW = 16384, GA_WA = 20480, GA_BA = 24576, GA_QT = 24832, GA_TOT = 25856, GA_END = 26112;
__device__ __forceinline__ void gla_cum(const Params& p, LAS unsigned char* lds, const bf16* Z0, int r0, int h, int dir) {
    const int tid = threadIdx.x;
    LAS float* cum = (LAS float*)(lds + GA_CUM); LAS float* alow = (LAS float*)(lds + GA_ALOW); LAS float* wa = (LAS float*)(lds + GA_WA);
    LAS float* ba = (LAS float*)(lds + GA_BA); LAS float* qt = (LAS float*)(lds + GA_QT); LAS float* tot = (LAS float*)(lds + GA_TOT);
    {
        const int t = tid >> 2, i4 = (tid & 3) * 4;
        const u32x2 w = *(const u32x2*)(Z0 + (size_t)(r0 + t) * Z0P + 1024 + dir * 16 + i4);
        alow[t * 16 + i4 + 0] = bflo(w.x); alow[t * 16 + i4 + 1] = bfhi(w.x); alow[t * 16 + i4 + 2] = bflo(w.y); alow[t * 16 + i4 + 3] = bfhi(w.y);
#pragma unroll
        for (int q = 0; q < 4; ++q) { const int idx = tid * 4 + q, i = idx >> 6, j = idx & 63; wa[idx] = p.gla_wa2[(size_t)(dir * 16 + i) * 256 + h * 64 + j]; }
        if (tid < 64) ba[tid] = p.gla_ba[dir * 256 + h * 64 + tid];
    }
    __syncthreads();
    const int j = tid & 63, tq = tid >> 6;
    float la[16];
#pragma unroll
    for (int tt = 0; tt < 16; ++tt) {
        const int t = tq * 16 + tt;
        float x = ba[j];
#pragma unroll
        for (int i = 0; i < 16; ++i) x += alow[t * 16 + i] * wa[i * 64 + j];
        la[tt] = (fminf(x, 0.f) - log1pf(expf(-fabsf(x)))) * (1.f / 16.f);
    }
    float run = 0.f;
    if (dir == 0) {
#pragma unroll
        for (int tt = 0; tt < 16; ++tt) { run += la[tt]; cum[(tq * 16 + tt) * 64 + j] = run; }
    } else {
#pragma unroll
        for (int tt = 15; tt >= 0; --tt) { run += la[tt]; cum[(tq * 16 + tt) * 64 + j] = run; }
    }
    qt[tq * 64 + j] = run;
    __syncthreads();
    float off = 0.f, total = 0.f;
#pragma unroll
    for (int q = 0; q < 4; ++q) { const float v = qt[q * 64 + j]; total += v; if (dir == 0 ? (q < tq) : (q > tq)) off += v; }
#pragma unroll
    for (int tt = 0; tt < 16; ++tt) cum[(tq * 16 + tt) * 64 + j] += off;
    if (tq == 0) tot[j] = total;
    __syncthreads();
}

__device__ __forceinline__ int gla_row0(int b, int cc) { return cc < 4 ? b * CTX + cc * 64 : TC + b * SEQ + (cc - 4) * 64; }
__device__ __forceinline__ int gla_step(int cc, int dir) { return dir == 0 ? cc : (cc < 4 ? 3 - cc : 4 + (131 - cc)); }

__device__ __forceinline__ void gla_g1_item(const Params& p, LAS unsigned char* lds, int item) {
    unsigned char* ws = p.ws;
    const bf16* Z0 = (const bf16*)(ws + A0_Z0); const bf16* VGT = (const bf16*)(ws + A0_VGT);
    float* GS = (float*)(ws + A0_GS); float* GD = (float*)(ws + A0_GD);
    const int cc = item % NSTEP, rest = item / NSTEP, dir = rest & 1, h = (rest >> 1) & 3, b = rest >> 3;
    const int r0 = gla_row0(b, cc), step = gla_step(cc, dir), chain = (b * 4 + h) * 2 + dir;
    const int tid = threadIdx.x, lane = tid & 63, wid = tid >> 6, fr = lane & 15, fq = lane >> 4;
    __syncthreads();
    gla_cum(p, lds, Z0, r0, h, dir);
    LAS float* cum = (LAS float*)(lds + GA_CUM); LAS float* tot = (LAS float*)(lds + GA_TOT);
    LAS bf16* KT = (LAS bf16*)(lds + GA_END);
    {
        const int t = tid >> 2, d0 = (tid & 3) * 16;
        const u32x4 w0 = *(const u32x4*)(Z0 + (size_t)(r0 + t) * Z0P + 256 + h * 64 + d0), w1 = *(const u32x4*)(Z0 + (size_t)(r0 + t) * Z0P + 256 + h * 64 + d0 + 8);
        const unsigned ww[8] = {w0.x, w0.y, w0.z, w0.w, w1.x, w1.y, w1.z, w1.w};
#pragma unroll
        for (int i = 0; i < 8; ++i) {
            const int d = d0 + 2 * i;
            KT[d * 72 + t] = f2bf(bflo(ww[i]) * __expf(tot[d] - cum[t * 64 + d]));
            KT[(d + 1) * 72 + t] = f2bf(bfhi(ww[i]) * __expf(tot[d + 1] - cum[t * 64 + d + 1]));
        }
    }
    if (tid < 64) GD[((size_t)chain * NSTEP + step) * 64 + tid] = __expf(tot[tid]);
    __syncthreads();
    f32x4 acc[2][4];
#pragma unroll
    for (int m = 0; m < 2; ++m)
#pragma unroll
        for (int n = 0; n < 4; ++n) acc[m][n] = (f32x4){0.f, 0.f, 0.f, 0.f};
#pragma unroll
    for (int ks = 0; ks < 2; ++ks) {
        bf16x8 af[2], bfr[4];
#pragma unroll
        for (int m = 0; m < 2; ++m) af[m] = *(const bf16x8*)(VGT + (size_t)(h * 128 + wid * 32 + m * 16 + fr) * TT + r0 + ks * 32 + fq * 8);
#pragma unroll
        for (int n = 0; n < 4; ++n) bfr[n] = *(const LAS bf16x8*)(KT + (n * 16 + fr) * 72 + ks * 32 + fq * 8);
#pragma unroll
        for (int m = 0; m < 2; ++m)
#pragma unroll
            for (int n = 0; n < 4; ++n) acc[m][n] = __builtin_amdgcn_mfma_f32_16x16x32_bf16(bfr[n], af[m], acc[m][n], 0, 0, 0);
    }
    float* dst = GS + ((size_t)chain * NSTEP + step) * 8192;
#pragma unroll
    for (int m = 0; m < 2; ++m)
#pragma unroll
        for (int n = 0; n < 4; ++n) *(f32x4*)(dst + (size_t)(wid * 32 + m * 16 + fr) * 64 + n * 16 + fq * 4) = acc[m][n];
}

__device__ __forceinline__ void ph_gla_scan(const Params& p) {
    float* GS = (float*)(p.ws + A0_GS); const float* GD = (const float*)(p.ws + A0_GD);
    for (int idx = blockIdx.x * 256 + threadIdx.x; idx < 16 * 8192; idx += gridDim.x * 256) {
        const int chain = idx >> 13, e = idx & 8191, dk = e & 63;
        float* g = GS + (size_t)chain * NSTEP * 8192 + e;
        const float* d = GD + (size_t)chain * NSTEP * 64 + dk;
        float st = 0.f;
#pragma unroll 6
        for (int s = 0; s < NSTEP; ++s) { const float t = g[(size_t)s * 8192]; const float dec = d[s * 64]; g[(size_t)s * 8192] = st; st = dec * st + t; }
    }
}

__device__ __forceinline__ void gla_g3_item(const Params& p, LAS unsigned char* lds, int item) {
    unsigned char* ws = p.ws;
    const bf16* Z0 = (const bf16*)(ws + A0_Z0); const bf16* VGT = (const bf16*)(ws + A0_VGT);
    const float* GS = (const float*)(ws + A0_GS); bf16* MIX = (bf16*)(ws + A0_MIX);
    const int cc = item % NSTEP, rest = item / NSTEP, h = rest & 3, b = rest >> 2;
    const int r0 = gla_row0(b, cc);
    const int tid = threadIdx.x, lane = tid & 63, wid = tid >> 6, fr = lane & 15, fq = lane >> 4;
    LAS bf16* QT = (LAS bf16*)(lds + GA_END);
    LAS bf16* QI = (LAS bf16*)(lds + GA_END + 9216);
    LAS bf16* KT = (LAS bf16*)(lds + GA_END + 18432);
    LAS bf16* PP = (LAS bf16*)(lds);
    f32x4 o[4][2];
#pragma unroll
    for (int m = 0; m < 4; ++m)
#pragma unroll
        for (int n = 0; n < 2; ++n) o[m][n] = (f32x4){0.f, 0.f, 0.f, 0.f};
    for (int dir = 0; dir < 2; ++dir) {
        const int step = gla_step(cc, dir), chain = (b * 4 + h) * 2 + dir;
        __syncthreads();
        gla_cum(p, lds, Z0, r0, h, dir);
        LAS float* cum = (LAS float*)(lds + GA_CUM); LAS float* tot = (LAS float*)(lds + GA_TOT);
        {
            const int t = tid >> 2, d0 = (tid & 3) * 16;
            const bf16* zr = Z0 + (size_t)(r0 + t) * Z0P + h * 64 + d0;
            const u32x4 q0 = *(const u32x4*)(zr), q1 = *(const u32x4*)(zr + 8), k0 = *(const u32x4*)(zr + 256), k1 = *(const u32x4*)(zr + 264);
            const unsigned qq[8] = {q0.x, q0.y, q0.z, q0.w, q1.x, q1.y, q1.z, q1.w}, kk[8] = {k0.x, k0.y, k0.z, k0.w, k1.x, k1.y, k1.z, k1.w};
            unsigned oqt[8], oqi[8], okt[8];
#pragma unroll
            for (int i = 0; i < 8; ++i) {
                const int d = d0 + 2 * i;
                const float c0 = cum[t * 64 + d], c1 = cum[t * 64 + d + 1], t0 = tot[d], t1 = tot[d + 1];
                const float qa = bflo(qq[i]), qb = bfhi(qq[i]), ka = bflo(kk[i]), kb = bfhi(kk[i]);
                oqt[i] = pk2(qa * __expf(c0 - t0), qb * __expf(c1 - t1));
                oqi[i] = pk2(qa * __expf(c0), qb * __expf(c1));
                okt[i] = pk2(ka * __expf(t0 - c0), kb * __expf(t1 - c1));
            }
            *(LAS u32x4*)(QT + t * 72 + d0) = (u32x4){oqt[0], oqt[1], oqt[2], oqt[3]}; *(LAS u32x4*)(QT + t * 72 + d0 + 8) = (u32x4){oqt[4], oqt[5], oqt[6], oqt[7]};
            *(LAS u32x4*)(QI + t * 72 + d0) = (u32x4){oqi[0], oqi[1], oqi[2], oqi[3]}; *(LAS u32x4*)(QI + t * 72 + d0 + 8) = (u32x4){oqi[4], oqi[5], oqi[6], oqi[7]};
            *(LAS u32x4*)(KT + t * 72 + d0) = (u32x4){okt[0], okt[1], okt[2], okt[3]}; *(LAS u32x4*)(KT + t * 72 + d0 + 8) = (u32x4){okt[4], okt[5], okt[6], okt[7]};
        }
        __syncthreads();
        {
            f32x4 sa[4];
#pragma unroll
            for (int m = 0; m < 4; ++m) sa[m] = (f32x4){0.f, 0.f, 0.f, 0.f};
#pragma unroll
            for (int ks = 0; ks < 2; ++ks) {
                const bf16x8 kf = *(const LAS bf16x8*)(KT + (wid * 16 + fr) * 72 + ks * 32 + fq * 8);
#pragma unroll
                for (int m = 0; m < 4; ++m) {
                    const bf16x8 qfm = *(const LAS bf16x8*)(QT + (m * 16 + fr) * 72 + ks * 32 + fq * 8);
                    sa[m] = __builtin_amdgcn_mfma_f32_16x16x32_bf16(kf, qfm, sa[m], 0, 0, 0);
                }
            }
#pragma unroll
            for (int m = 0; m < 4; ++m) {
                const int t = m * 16 + fr;
                float v[4];
#pragma unroll
                for (int jj = 0; jj < 4; ++jj) { const int j = wid * 16 + fq * 4 + jj; const bool keep = dir == 0 ? (j <= t) : (j >= t); v[jj] = keep ? sa[m][jj] : 0.f; }
                *(LAS u32x2*)(PP + t * 72 + wid * 16 + fq * 4) = (u32x2){pk2(v[0], v[1]), pk2(v[2], v[3])};
            }
        }
        __syncthreads();
        const float* Sg = GS + ((size_t)chain * NSTEP + step) * 8192;
#pragma unroll
        for (int ks = 0; ks < 2; ++ks) {
            bf16x8 vfr[2], sfr[2];
#pragma unroll
            for (int n = 0; n < 2; ++n) {
                const int dv = wid * 32 + n * 16 + fr;
                vfr[n] = *(const bf16x8*)(VGT + (size_t)(h * 128 + dv) * TT + r0 + ks * 32 + fq * 8);
                const f32x4 s0 = *(const f32x4*)(Sg + (size_t)dv * 64 + ks * 32 + fq * 8), s1 = *(const f32x4*)(Sg + (size_t)dv * 64 + ks * 32 + fq * 8 + 4);
                sfr[n] = mk8((u32x4){pk2(s0.x, s0.y), pk2(s0.z, s0.w), pk2(s1.x, s1.y), pk2(s1.z, s1.w)});
            }
#pragma unroll
            for (int m = 0; m < 4; ++m) {
                const bf16x8 pfm = *(const LAS bf16x8*)(PP + (m * 16 + fr) * 72 + ks * 32 + fq * 8);
                const bf16x8 qim = *(const LAS bf16x8*)(QI + (m * 16 + fr) * 72 + ks * 32 + fq * 8);
#pragma unroll
                for (int n = 0; n < 2; ++n) {
                    o[m][n] = __builtin_amdgcn_mfma_f32_16x16x32_bf16(vfr[n], pfm, o[m][n], 0, 0, 0);
                    o[m][n] = __builtin_amdgcn_mfma_f32_16x16x32_bf16(sfr[n], qim, o[m][n], 0, 0, 0);
                }
            }
        }
    }
    __syncthreads();
    LAS float* red = (LAS float*)(lds + GA_END + 27648);
#pragma unroll
    for (int m = 0; m < 4; ++m) {
        float s = 0.f;
#pragma unroll
        for (int n = 0; n < 2; ++n)
#pragma unroll
            for (int j = 0; j < 4; ++j) s += o[m][n][j] * o[m][n][j];
        s += __shfl_xor(s, 16); s += __shfl_xor(s, 32);
        if (fq == 0) red[wid * 64 + m * 16 + fr] = s;
    }
    __syncthreads();
#pragma unroll
    for (int m = 0; m < 4; ++m) {
        const int t = m * 16 + fr;
        const float ss = red[t] + red[64 + t] + red[128 + t] + red[192 + t];
        const float rinv = rsqrtf(ss * (1.f / 128.f) + RMS_EPS);
        const int r = r0 + t;
#pragma unroll
        for (int n = 0; n < 2; ++n) {
            const int dv = wid * 32 + n * 16 + fq * 4;
            const u32x2 gw = *(const u32x2*)(Z0 + (size_t)r * Z0P + 512 + h * 128 + dv);
            const f32x4 ng = *(const f32x4*)(p.gla_norm + dv);
            const float g0 = bflo(gw.x), g1 = bfhi(gw.x), g2 = bflo(gw.y), g3 = bfhi(gw.y);
            const float y0 = o[m][n][0] * rinv * ng.x * siluf(g0), y1 = o[m][n][1] * rinv * ng.y * siluf(g1);
            const float y2 = o[m][n][2] * rinv * ng.z * siluf(g2), y3 = o[m][n][3] * rinv * ng.w * siluf(g3);
            *(u32x2*)(MIX + (size_t)r * DM + h * 128 + dv) = (u32x2){pk2(y0, y1), pk2(y2, y3)};
        }
    }
}

__device__ __forceinline__ void ph_swa_g1(const Params& p, LAS unsigned char* lds) {
    unsigned char* ws = p.ws;
    const bf16* QS = (const bf16*)(ws + A0_QS); const bf16* KS = (const bf16*)(ws + A0_KS); const bf16* VST = (const bf16*)(ws + A0_VST); bf16* MIX = (bf16*)(ws + A0_MIX);
    constexpr int N_SWA = 2 * 8 * 66, N_G1 = 2 * 4 * 2 * NSTEP;
    for (int item = blockIdx.x; item < N_SWA + N_G1; item += gridDim.x) {
        if (item < N_SWA) {
            const int qt = item % 66, rest = item / 66, h = rest & 7, b = rest >> 3, kvh = h >> 2;
            const bf16* Qg = QS + ((size_t)(b * 8 + h) * NKEY + qt * 128) * 64;
            const bf16* Kg = KS + (size_t)(b * 2 + kvh) * NKEY * 64;
            const bf16* Vg = VST + (size_t)(b * 2 + kvh) * 64 * NKEY;
            int b0 = 0, b1 = 0, qpos0 = 0, row0;
            if (qt >= 2) { qpos0 = (qt - 2) * 128; const int lo = qpos0 - 128 < 0 ? 0 : qpos0 - 128, hi2 = qpos0 + 256 > SEQ ? SEQ : qpos0 + 256; b0 = 4 + lo / 64; b1 = 4 + hi2 / 64; row0 = TC + b * SEQ + qpos0; }
            else row0 = b * CTX + qt * 128;
            const float sink = p.swa_sink[h] * LOG2E;
            attn_item<64, 64>(lds, Qg, Kg, Vg, 4, b0, b1, qpos0, sink, 1.f, MIX + (size_t)row0 * DM + 512 + h * 64, DM);
        } else gla_g1_item(p, lds, item - N_SWA);
    }
}
__device__ __forceinline__ void ph_gla_g3(const Params& p, LAS unsigned char* lds) {
    for (int item = blockIdx.x; item < 2 * 4 * NSTEP; item += gridDim.x) gla_g3_item(p, lds, item);
}

__device__ __forceinline__ void ph_router(const Params& p, LAS unsigned char* lds, int l, int row_lo) {
    unsigned char* ws = p.ws;
    const bf16* U = (const bf16*)(ws + OFF_U); const bf16* W = (const bf16*)(ws + OFF_W_RT) + (size_t)l * 128 * DM;
    int* cntg = (int*)(ws + OFF_CNT) + l * 64; int* tokslot = (int*)(ws + OFF_TOKSLOT); float* W8 = (float*)(ws + OFF_W8); int* LIST = (int*)(ws + OFF_LIST);
    const int tid = threadIdx.x, lane = tid & 63, wid = tid >> 6, wr = wid >> 1, wc = wid & 1, fr = lane & 15, fq = lane >> 4;
    LAS float* lg = (LAS float*)lds;
    const int tm0 = row_lo / 128;
    auto make = [&](int tm, GPtrs& g, int& nk) { plain_ptrs(U, tm * 128, DM, g.a); plain_ptrs(W, 0, DM, g.b); nk = DM / 64; };
    auto epi = [&](int tm, f32x4 (&acc)[4][4]) {
        const int brow = tm * 128;
        if (wc == 0) {
#pragma unroll
            for (int m = 0; m < 4; ++m)
#pragma unroll
                for (int n = 0; n < 4; ++n)
#pragma unroll
                    for (int j = 0; j < 4; ++j) lg[(wr * 64 + m * 16 + fr) * 65 + n * 16 + fq * 4 + j] = acc[m][n][j];
        }
        __syncthreads();
        LAS float* biasl = (LAS float*)(lds + 34816); LAS int* hist = (LAS int*)(lds + 34816 + 256); LAS int* basel = (LAS int*)(lds + 34816 + 512);
        if (tid < 64) { biasl[tid] = p.b_router[l * 64 + tid]; hist[tid] = 0; }
        __syncthreads();
        int esel[8], lrank[8]; float ssel[8]; float wsum = 0.f;
        if (tid < 128) {
            LAS float* L = lg + tid * 65;
            float gs[8];
#pragma unroll
            for (int g = 0; g < 8; ++g) {
                float m1 = -INFINITY, m2 = -INFINITY;
#pragma unroll
                for (int j = 0; j < 8; ++j) {
                    const int e = g * 8 + j;
                    const float sel = 1.f / (1.f + expf(-L[e])) + biasl[e];
                    L[e] = sel;
                    if (sel > m1) { m2 = m1; m1 = sel; } else if (sel > m2) m2 = sel;
                }
                gs[g] = m1 + m2;
            }
            unsigned allowed = 0u;
#pragma unroll
            for (int g = 0; g < 8; ++g) {
                int rk = 0;
#pragma unroll
                for (int h = 0; h < 8; ++h) rk += (gs[h] > gs[g] || (gs[h] == gs[g] && h < g)) ? 1 : 0;
                if (rk < 4) allowed |= 1u << g;
            }
#pragma unroll
            for (int k = 0; k < 8; ++k) {
                float best = -INFINITY; int bi = 0;
#pragma unroll
                for (int g = 0; g < 8; ++g) {
                    if ((allowed >> g) & 1u) {
#pragma unroll
                        for (int j = 0; j < 8; ++j) { const float v = L[g * 8 + j]; if (v > best) { best = v; bi = g * 8 + j; } }
                    }
                }
                esel[k] = bi; ssel[k] = best - biasl[bi]; wsum += ssel[k]; L[bi] = -INFINITY;
            }
#pragma unroll
            for (int k = 0; k < 8; ++k) lrank[k] = __hip_atomic_fetch_add(hist + esel[k], 1, __ATOMIC_RELAXED, __HIP_MEMORY_SCOPE_WORKGROUP);
        }
        __syncthreads();
        if (tid < 64) { const int c = hist[tid]; basel[tid] = c > 0 ? atomicAdd(cntg + tid, c) : 0; }
        __syncthreads();
        if (tid < 128) {
            const int t = brow + tid; const float wn = 2.5f / wsum;
#pragma unroll
            for (int k = 0; k < 8; ++k) {
                const int e = esel[k], pos = basel[e] + lrank[k];
                tokslot[(size_t)t * 8 + k] = (e << 20) | pos;
                W8[(size_t)t * 8 + k] = ssel[k] * wn;
                LIST[(size_t)e * TT + pos] = t * 8 + k;
            }
        }
    };
    gemm_tiles<false>(lds, tm0 + vcu_id(), TT / 128, gridDim.x, make, epi);
}

__device__ __forceinline__ int moe_find_expert(const LAS int* tp, int mtg) {
    int lo = 0, hi = 64;
    while (lo < hi) { const int mid = (lo + hi + 1) >> 1; if (tp[mid] <= mtg) lo = mid; else hi = mid - 1; }
    return lo;
}
__device__ __forceinline__ void ph_moe1(const Params& p, LAS unsigned char* lds, int l, int row_lo) {
    unsigned char* ws = p.ws;
    moe_tables(p, lds, l, row_lo);
    LAS int* cnt = (LAS int*)(lds + MOE_LDS_OFF); LAS int* tp = cnt + 80; LAS int* sp = tp + 80;
    const bf16* U = (const bf16*)(ws + OFF_U); const bf16* WGU = (const bf16*)(ws + OFF_W_GU); bf16* HM = (bf16*)(ws + AM_HM);
    const int* LIST = (const int*)(ws + OFF_LIST);
    const int tid = threadIdx.x, lane = tid & 63, wid = tid >> 6, wr = wid >> 1, wc = wid & 1, fr = lane & 15, fq = lane >> 4;
    const int ntiles = tp[65] * 4;
    auto make = [&](int t, GPtrs& g, int& nk) {
        const int mtg = t >> 2, nt = t & 3, e = moe_find_expert(tp, mtg), mt = mtg - tp[e], ce = cnt[e];
#pragma unroll
        for (int i = 0; i < 4; ++i) {
            const int li = mt * 128 + (tid >> 3) + 32 * i;
            int tk = row_lo;
            if (li < ce) tk = e < 64 ? (LIST[(size_t)e * TT + li] >> 3) : row_lo + li;
            g.a[i] = U + (size_t)tk * DM + stg_col();
        }
        plain_ptrs(WGU + (size_t)e * 512 * DM, nt * 128, DM, g.b); nk = DM / 64;
    };
    auto epi = [&](int t, f32x4 (&acc)[4][4]) {
        const int mtg = t >> 2, nt = t & 3, e = moe_find_expert(tp, mtg), mt = mtg - tp[e], ce = cnt[e];
        const size_t slot0 = e < 64 ? (size_t)(sp[e] + mt * 128) : (size_t)TT * 8 + row_lo + mt * 128;
        const int hc0 = nt * 64 + wc * 32;
#pragma unroll
        for (int m = 0; m < 4; ++m) {
            const int i = wr * 64 + m * 16 + fr;
            if (mt * 128 + i < ce) {
#pragma unroll
                for (int n = 0; n < 2; ++n) {
                    const f32x4 g = acc[m][n], u = acc[m][n + 2];
                    const u32x2 w = {pk2(siluf(g[0]) * u[0], siluf(g[1]) * u[1]), pk2(siluf(g[2]) * u[2], siluf(g[3]) * u[3])};
                    *(u32x2*)(HM + (slot0 + i) * 256 + hc0 + n * 16 + fq * 4) = w;
                }
            }
        }
    };
    gemm_tiles<true>(lds, vcu_id(), ntiles, gridDim.x, make, epi);
}
__device__ __forceinline__ void ph_moe2(const Params& p, LAS unsigned char* lds, int l, int row_lo) {
    unsigned char* ws = p.ws;
    moe_tables(p, lds, l, row_lo);
    LAS int* cnt = (LAS int*)(lds + MOE_LDS_OFF); LAS int* tp = cnt + 80; LAS int* sp = tp + 80;
    const bf16* HM = (const bf16*)(ws + AM_HM); const bf16* WD = (const bf16*)(ws + OFF_W_D); bf16* YR = (bf16*)(ws + AM_YR);
    const int tid = threadIdx.x, lane = tid & 63, wid = tid >> 6, wr = wid >> 1, wc = wid & 1, fr = lane & 15, fq = lane >> 4;
    const int ntiles = tp[65] * 8;
    auto make = [&](int t, GPtrs& g, int& nk) {
        const int mtg = t >> 3, nt = t & 7, e = moe_find_expert(tp, mtg), mt = mtg - tp[e];
        const size_t slot0 = e < 64 ? (size_t)(sp[e] + mt * 128) : (size_t)TT * 8 + row_lo + mt * 128;
        plain_ptrs(HM, 0, 256, g.a);
#pragma unroll
        for (int i = 0; i < 4; ++i) g.a[i] += slot0 * 256;
        plain_ptrs(WD + (size_t)e * DM * 256, nt * 128, 256, g.b); nk = 256 / 64;
    };
    auto epi = [&](int t, f32x4 (&acc)[4][4]) {
        const int mtg = t >> 3, nt = t & 7, e = moe_find_expert(tp, mtg), mt = mtg - tp[e], ce = cnt[e];
        const size_t slot0 = e < 64 ? (size_t)(sp[e] + mt * 128) : (size_t)TT * 8 + row_lo + mt * 128;
        LAS unsigned char* wl = lds + 32768 + wid * 8192;
        const int i0 = wr * 64;
        epi_store_rows(wl, acc, fr, fq, lane, [&](int row) -> bf16* { return (mt * 128 + i0 + row < ce) ? YR + (slot0 + i0 + row) * DM + nt * 128 + wc * 64 : nullptr; });
    };
    gemm_tiles<true>(lds, vcu_id(), ntiles, gridDim.x, make, epi);
}

__device__ __forceinline__ void ph_inproj1(const Params& p, LAS unsigned char* lds) {
    unsigned char* ws = p.ws;
    const bf16* U = (const bf16*)(ws + OFF_U); const bf16* W = (const bf16*)(ws + OFF_W_IN_O);
    bf16* Z1 = (bf16*)(ws + A1_Z1); bf16* KM = (bf16*)(ws + A1_KM);
    const f32x2* rope = (const f32x2*)(ws + OFF_ROPE);
    const int tid = threadIdx.x, lane = tid & 63, wid = tid >> 6, wr = wid >> 1, wc = wid & 1, fr = lane & 15, fq = lane >> 4;
    constexpr int NTN = 7, NTM = TT / 128;
    auto make = [&](int t, GPtrs& g, int& nk) { int tm, tn; tile_mn(t, NTM, NTN, tm, tn); plain_ptrs(U, tm * 128, DM, g.a); plain_ptrs(W, tn * 128, DM, g.b); nk = DM / 64; };
    auto epi = [&](int t, f32x4 (&acc)[4][4]) {
        int tm, tn; tile_mn(t, NTM, NTN, tm, tn); const int brow = tm * 128, bcol = tn * 128;
        const int cb = bcol + wc * 64;
        LAS unsigned char* wl = lds + 32768 + wid * 8192;
        const int r0 = brow + wr * 64;
        const RowInfo ri0 = rowinfo(r0);
        if (cb < 768) {
            epi_store_rows(wl, acc, fr, fq, lane, [&](int row) { return Z1 + (size_t)(r0 + row) * Z1P + cb; });
        } else if (cb == 768) {
#pragma unroll
            for (int m = 0; m < 4; ++m) {
                const int pos = ri0.pos + m * 16 + fr;
#pragma unroll
                for (int n = 0; n < 2; ++n)
#pragma unroll
                    for (int j = 0; j < 4; ++j) {
                        const float x1 = acc[m][n][j], x2 = acc[m][n + 2][j];
                        if (ri0.lat) { const f32x2 cs = rope[(size_t)pos * 32 + n * 16 + fq * 4 + j]; acc[m][n][j] = x1 * cs.x - x2 * cs.y; acc[m][n + 2][j] = x2 * cs.x + x1 * cs.y; }
                    }
                asm volatile("" ::: "memory");
            }
            bf16* dst = KM + ((size_t)(ri0.b * 8) * NKEY + ri0.kq) * 192 + 128;
            epi_store_rows(wl, acc, fr, fq, lane, [&](int row) { return dst + (size_t)row * 192; }, 8, (size_t)NKEY * 192);
        }
    };
    gemm_tiles<true>(lds, vcu_id(), NTM * NTN, gridDim.x, make, epi);
}

__device__ __forceinline__ void ph_mla_up(const Params& p, LAS unsigned char* lds) {
    unsigned char* ws = p.ws;
    const bf16* Z1 = (const bf16*)(ws + A1_Z1); const bf16* WQ = (const bf16*)(ws + OFF_W_UQ); const bf16* WKV = (const bf16*)(ws + OFF_W_UKV);
    bf16* QM = (bf16*)(ws + A1_QM); bf16* KM = (bf16*)(ws + A1_KM); bf16* VTM = (bf16*)(ws + A1_VTM);
    const f32x2* rope = (const f32x2*)(ws + OFF_ROPE);
    const int tid = threadIdx.x, lane = tid & 63, wid = tid >> 6, wr = wid >> 1, wc = wid & 1, fr = lane & 15, fq = lane >> 4;
    LAS float* rsb = (LAS float*)(lds + 66560);
    constexpr int NQ = (TL / 128) * 12, NKV = (TT / 128) * 16;
    constexpr float QSCALE = 0.07216878364870322f * LOG2E;
    auto decode = [&](int t, bool& isq, int& tm, int& tn) { isq = t < NQ; if (isq) { tile_mn(t, TL / 128, 12, tm, tn); tm += 4; } else tile_mn(t - NQ, TT / 128, 16, tm, tn); };
    auto make = [&](int t, GPtrs& g, int& nk) {
        bool isq; int tm, tn; decode(t, isq, tm, tn);
        const int brow = tm * 128, bcol = tn * 128, K = isq ? 512 : 256, acol = isq ? 0 : 512;
        const int par = ((t - vcu_id()) / (int)gridDim.x) & 1;
        {
            const int row = tid >> 1, half = tid & 1;
            const bf16* ap = Z1 + (size_t)(brow + row) * Z1P + acol + half * (K / 2);
            float ss = 0.f;
            for (int c = 0; c < K / 2; c += 8) { const u32x4 w = *(const u32x4*)(ap + c);
                const float v0 = bflo(w.x), v1 = bfhi(w.x), v2 = bflo(w.y), v3 = bfhi(w.y), v4 = bflo(w.z), v5 = bfhi(w.z), v6 = bflo(w.w), v7 = bfhi(w.w);
                ss += v0 * v0 + v1 * v1 + v2 * v2 + v3 * v3 + v4 * v4 + v5 * v5 + v6 * v6 + v7 * v7; }
            ss += __shfl_xor(ss, 1);
            if (half == 0) rsb[par * 128 + row] = rsqrtf(ss / (float)K + RMS_EPS);
        }
        plain_ptrs(Z1 + acol, brow, Z1P, g.a); plain_ptrs(isq ? WQ : WKV, bcol, K, g.b); nk = K / 64;
    };
    auto epi = [&](int t, f32x4 (&acc)[4][4]) {
        bool isq; int tm, tn; decode(t, isq, tm, tn);
        const int brow = tm * 128, bcol = tn * 128;
        const int par = ((t - vcu_id()) / (int)gridDim.x) & 1;
        const int cb = bcol + wc * 64;
        LAS unsigned char* wl = lds + 32768 + wid * 8192;
        const int r0 = brow + wr * 64;
        const RowInfo ri0 = rowinfo(r0);
        if (isq) {
            const int h = cb / 192, part = (cb % 192) >> 6;
#pragma unroll
            for (int m = 0; m < 4; ++m) {
                const float sc = rsb[par * 128 + wr * 64 + m * 16 + fr] * QSCALE;
                const int pos = ri0.pos + m * 16 + fr;
                if (part < 2) {
#pragma unroll
                    for (int n = 0; n < 4; ++n) acc[m][n] = acc[m][n] * sc;
                } else {
#pragma unroll
                    for (int n = 0; n < 2; ++n)
#pragma unroll
                        for (int j = 0; j < 4; ++j) {
                            const float x1 = acc[m][n][j] * sc, x2 = acc[m][n + 2][j] * sc;
                            const f32x2 cs = rope[(size_t)pos * 32 + n * 16 + fq * 4 + j];
                            acc[m][n][j] = x1 * cs.x - x2 * cs.y; acc[m][n + 2][j] = x2 * cs.x + x1 * cs.y;
                        }
                }
                asm volatile("" ::: "memory");
            }
            bf16* dst = QM + ((size_t)(ri0.b * 8 + h) * SEQ + ri0.pos) * 192 + part * 64;
            epi_store_rows(wl, acc, fr, fq, lane, [&](int row) { return dst + (size_t)row * 192; });
        } else {
            const int h = cb >> 8, part = (cb & 255) >> 6;
#pragma unroll
            for (int m = 0; m < 4; ++m) {
                const float rs = rsb[par * 128 + wr * 64 + m * 16 + fr];
#pragma unroll
                for (int n = 0; n < 4; ++n) acc[m][n] = acc[m][n] * rs;
            }
            if (part < 2) {
                bf16* dst = KM + ((size_t)(ri0.b * 8 + h) * NKEY + ri0.kq) * 192 + part * 64;
                epi_store_rows(wl, acc, fr, fq, lane, [&](int row) { return dst + (size_t)row * 192; });
            } else {
                bf16* dst = VTM + ((size_t)(ri0.b * 8 + h) * 128 + (part - 2) * 64) * NKEY + ri0.kq;
                epi_store_cols(wl, acc, fr, fq, lane, [&](int col) { return dst + (size_t)col * NKEY; });
            }
        }
    };
    gemm_tiles<true>(lds, vcu_id(), NQ + NKV, gridDim.x, make, epi);
}

__device__ __forceinline__ void ph_mla_attn(const Params& p, LAS unsigned char* lds) {
    unsigned char* ws = p.ws;
    const bf16* QM = (const bf16*)(ws + A1_QM); const bf16* KM = (const bf16*)(ws + A1_KM); const bf16* VTM = (const bf16*)(ws + A1_VTM); bf16* MIX = (bf16*)(ws + A1_MIX);
    for (int item = blockIdx.x; item < 2 * 8 * 64; item += gridDim.x) {
        const int qt = item & 63, h = (item >> 6) & 7, b = item >> 9;
        const bf16* Qg = QM + ((size_t)(b * 8 + h) * SEQ + qt * 128) * 192;
        const bf16* Kg = KM + (size_t)(b * 8 + h) * NKEY * 192;
        const bf16* Vg = VTM + (size_t)(b * 8 + h) * 128 * NKEY;
        attn_item<192, 128>(lds, Qg, Kg, Vg, NKEY / 64, 0, 0, 0, -1e30f, 0.f, MIX + (size_t)(TC + b * SEQ + qt * 128) * DM + h * 128, DM);
    }
}


#define XB_TMO      128
#define XB_XCNT(j)  (256  + 64 * (j))
#define XB_XSUB(j)  (1280 + 64 * (j))
#define XB_XGEN(j)  (2304 + 64 * (j))
#define XB_TOP      3328
#define XB_TOPGEN   3392
#define XCD_BAR_WORDS 3456
#define XB_SPIN_CAP (1u << 18)
__device__ __forceinline__ unsigned xb_ld(unsigned* p)              { return __hip_atomic_load(p, __ATOMIC_RELAXED, __HIP_MEMORY_SCOPE_AGENT); }
__device__ __forceinline__ unsigned xb_add(unsigned* p, unsigned v) { return __hip_atomic_fetch_add(p, v, __ATOMIC_RELAXED, __HIP_MEMORY_SCOPE_AGENT); }
__device__ __forceinline__ unsigned xb_xcc_id() { return (unsigned)__builtin_amdgcn_s_getreg((3 << 11) | 20) & 0xFu; }
#define XB_SPIN(cond, bar) do { unsigned _sp = 0; while (cond) { __builtin_amdgcn_s_sleep(1); \
    if ((++_sp & 255u) == 0u) { if (xb_ld(&(bar)[XB_TMO])) break; if (_sp > XB_SPIN_CAP) { atomicAdd(&(bar)[XB_TMO], 1u); break; } } } } while (0)
struct XcdBarrier { unsigned* bar; unsigned x; volatile LAS unsigned* st; };
__device__ __forceinline__ XcdBarrier xcd_barrier_post(unsigned* bar, volatile LAS unsigned* st) {
    XcdBarrier b; b.bar = bar; b.x = xb_xcc_id(); b.st = st;
    if (threadIdx.x == 0) (void)xb_add(&bar[XB_XCNT(b.x)], 1u);
    return b;
}
__device__ __forceinline__ void xcd_barrier_complete(unsigned* bar, unsigned x, unsigned& nloc, unsigned& nx) {
    const unsigned G = gridDim.x * gridDim.y * gridDim.z;
    unsigned sum, cnt, mine, sp = 0u;
    for (;;) {
        sum = 0u; cnt = 0u; mine = 0u;
#pragma unroll
        for (unsigned j = 0; j < 16; ++j) { const unsigned c = xb_ld(&bar[XB_XCNT(j)]); sum += c; cnt += (c > 0u) ? 1u : 0u; mine = (j == x) ? c : mine; }
        if (sum == G) break;
        __builtin_amdgcn_s_sleep(1);
        if ((++sp & 255u) == 0u) { if (xb_ld(&bar[XB_TMO])) break; if (sp > XB_SPIN_CAP) { atomicAdd(&bar[XB_TMO], 1u); break; } }
    }
    nloc = mine > 0u ? mine : 1u; nx = cnt > 0u ? cnt : 1u;
}
__device__ __forceinline__ void xcd_barrier(const XcdBarrier& b) {
    asm volatile("s_waitcnt vmcnt(0)" ::: "memory");
    __syncthreads();
    if (threadIdx.x == 0) {
        unsigned* bar = b.bar;
        __builtin_amdgcn_s_waitcnt(0);
        unsigned nloc = b.st[0], nx = b.st[1];
        if (nloc == 0u) { xcd_barrier_complete(bar, b.x, nloc, nx); b.st[0] = nloc; b.st[1] = nx; }
        const unsigned old = xb_add(&bar[XB_XSUB(b.x)], 1u);
        const unsigned gen = old / nloc;
        if (old + 1u == (gen + 1u) * nloc) {
            __builtin_amdgcn_fence(__ATOMIC_RELEASE, "agent");
            asm volatile("s_waitcnt vmcnt(0)" ::: "memory");
            const unsigned og = xb_add(&bar[XB_TOP], 1u);
            const unsigned tg = og / nx;
            if (og + 1u == (tg + 1u) * nx) xb_add(&bar[XB_TOPGEN], 1u);
            else XB_SPIN(xb_ld(&bar[XB_TOPGEN]) == tg, bar);
            __builtin_amdgcn_fence(__ATOMIC_ACQUIRE, "agent");
            xb_add(&bar[XB_XGEN(b.x)], 1u);
            asm volatile("s_waitcnt vmcnt(0)" ::: "memory");
        } else {
            XB_SPIN(xb_ld(&bar[XB_XGEN(b.x)]) == gen, bar);
            __builtin_amdgcn_fence(__ATOMIC_ACQUIRE, "agent");
            asm volatile("s_waitcnt vmcnt(0)" ::: "memory");
        }
    }
    __syncthreads();
}
static_assert(XCD_BAR_WORDS * 4 <= BAR_BYTES, "barrier words");

constexpr int NPHASE = 19;
__global__ void __launch_bounds__(256, 2) mega(Params p) {
    extern __shared__ __attribute__((aligned(16))) unsigned char lds_[];
    LAS unsigned char* lds = (LAS unsigned char*)lds_;
    cg::grid_group grid = cg::this_grid();
    unsigned char* ws = p.ws;
    volatile LAS unsigned* bst = (volatile LAS unsigned*)(lds + LDS_BYTES - 16);
    if (threadIdx.x < 4) bst[threadIdx.x] = 0u;
    __syncthreads();
    const XcdBarrier xbar = xcd_barrier_post((unsigned*)(ws + OFF_BAR), bst);
#define GRID_BAR(k) do { if ((k) == 0) grid.sync(); else xcd_barrier(xbar); } while (0)
#ifndef PROBE_REP_MASK
#define PROBE_REP_MASK 0u
#endif
#ifndef PROBE_EXTRA_SYNCS
#define PROBE_EXTRA_SYNCS 0
#endif
#define PHASE(k, body) do { if (p.ph_lo <= (k) && (k) < p.ph_hi) { body; if ((PROBE_REP_MASK >> (k)) & 1u) { xcd_barrier(xbar); body; } if ((k) + 1 < p.ph_hi) GRID_BAR(k); } } while (0)
    for (int i = 0; i < PROBE_EXTRA_SYNCS; ++i) xcd_barrier(xbar);
    PHASE(0, ph_prep(p, lds));
    PHASE(1, ph_modulate0(p));
    PHASE(2, ph_inproj0(p, lds));
    PHASE(3, ph_swa_g1(p, lds));
    PHASE(4, ph_gla_scan(p));
    PHASE(5, ph_gla_g3(p, lds));
    PHASE(6, ph_outproj(p, lds, (const bf16*)(ws + A0_MIX), (const bf16*)(ws + OFF_W_OUT_E), (float*)(ws + A0_Y), 0));
    PHASE(7, ph_rowpassA(p, 0, 0, (const float*)(ws + A0_Y)));
    PHASE(8, { ph_router(p, lds, 0, 0); __syncthreads(); for (int it = blockIdx.x; it < EXP_ITEMS; it += gridDim.x) expert_convert_item(p, lds, 0, it); });
    PHASE(9, ph_moe1(p, lds, 0, 0));
    PHASE(10, ph_moe2(p, lds, 0, 0));
    PHASE(11, ph_rowpassB(p, lds, 0, 0));
    PHASE(12, ph_inproj1(p, lds));
    PHASE(13, ph_mla_up(p, lds));
    PHASE(14, ph_mla_attn(p, lds));
    PHASE(15, ph_outproj(p, lds, (const bf16*)(ws + A1_MIX), (const bf16*)(ws + OFF_W_OUT_O), (float*)(ws + A1_Y), TC));
    PHASE(16, ph_rowpassA(p, 1, TC, (const float*)(ws + A1_Y)));
    PHASE(17, { ph_router(p, lds, 1, TC); __syncthreads(); for (int it = blockIdx.x; it < EXP_ITEMS; it += gridDim.x) expert_convert_item(p, lds, 1, it); });
    PHASE(18, ph_moe1(p, lds, 1, TC));
    PHASE(19, ph_moe2(p, lds, 1, TC));
    PHASE(20, ph_rowpassB(p, lds, 1, TC));
}

extern "C" void kernel_launch(void* const* d_in, const int* in_sizes, int n_in, void* d_out, int out_size, void* d_ws, size_t ws_size, hipStream_t stream) {
    static int grid_blocks = 0;
    if (!grid_blocks) {
        int dev = 0, cus = 0, per_cu = 0;
        (void)hipGetDevice(&dev);
        (void)hipDeviceGetAttribute(&cus, hipDeviceAttributeMultiprocessorCount, dev);
        (void)hipFuncSetAttribute((const void*)mega, hipFuncAttributeMaxDynamicSharedMemorySize, LDS_BYTES);
        (void)hipOccupancyMaxActiveBlocksPerMultiprocessor(&per_cu, (const void*)mega, 256, LDS_BYTES);
        if (per_cu > 2) per_cu = 2;
        if (per_cu < 1) per_cu = 1;
        grid_blocks = cus * per_cu;
        if (ws_size < WS_NEED) fprintf(stderr, "kernel_launch: workspace too small: %zu < %zu\n", ws_size, (size_t)WS_NEED);
    }
    Params p{};
    const float** f = (const float**)&p;
    for (int i = 0; i < 30; ++i) f[i] = (const float*)d_in[i];
    p.out = (float*)d_out; p.ws = (unsigned char*)d_ws; p.ph_lo = 0; p.ph_hi = 21;
    (void)hipMemsetAsync((unsigned char*)d_ws + OFF_BAR, 0, BAR_BYTES, stream);
    void* args[] = {&p};
    hipError_t e = hipLaunchCooperativeKernel((const void*)mega, dim3(grid_blocks), dim3(256), args, LDS_BYTES, stream);
    if (e != hipSuccess) fprintf(stderr, "cooperative launch failed: %s (grid %d)\n", hipGetErrorString(e), grid_blocks);
}
```

```cpp
#include <hip/hip_runtime.h>
#include <hip/hip_cooperative_groups.h>
#include <cstdio>
#include <cstdint>
namespace cg = cooperative_groups;

#define LAS __attribute__((address_space(3)))
typedef unsigned short bf16;
typedef short bf16x8 __attribute__((ext_vector_type(8)));
typedef float f32x2 __attribute__((ext_vector_type(2)));
typedef float f32x4 __attribute__((ext_vector_type(4)));
typedef float f32x8 __attribute__((ext_vector_type(8)));
typedef float f32x16 __attribute__((ext_vector_type(16)));
typedef unsigned u32x2 __attribute__((ext_vector_type(2)));
typedef unsigned u32x4 __attribute__((ext_vector_type(4)));
typedef __bf16 bf16x2_t __attribute__((ext_vector_type(2)));

constexpr int DM = 1024, NB = 2, SEQ = 8192, CTX = 256;
constexpr int TC = NB * CTX, TL = NB * SEQ, TT = TC + TL, NKEY = CTX + SEQ;
constexpr int NEXP = 64;
constexpr float RMS_EPS = 1e-6f;
constexpr int E_IN_PAD = 2432, O_IN_PAD = 896;
constexpr float LOG2E = 1.4426950408889634f;
constexpr int NSTEP = 132;
constexpr int Z0P = 1056;
constexpr int Z1P = 768;
constexpr int LDS_BYTES = 73728;

constexpr size_t al(size_t x) { return (x + 255) & ~(size_t)255; }
constexpr size_t OFF_W_IN_E = 0;
constexpr size_t OFF_W_OUT_E = OFF_W_IN_E + al((size_t)E_IN_PAD * DM * 2);
constexpr size_t OFF_W_IN_O = OFF_W_OUT_E + al((size_t)DM * DM * 2);
constexpr size_t OFF_W_UQ = OFF_W_IN_O + al((size_t)O_IN_PAD * DM * 2);
constexpr size_t OFF_W_UKV = OFF_W_UQ + al((size_t)1536 * 512 * 2);
constexpr size_t OFF_W_OUT_O = OFF_W_UKV + al((size_t)2048 * 256 * 2);
constexpr size_t OFF_W_RT = OFF_W_OUT_O + al((size_t)DM * DM * 2);
constexpr size_t OFF_W_GU = OFF_W_RT + al((size_t)2 * 128 * DM * 2);
constexpr size_t OFF_W_D = OFF_W_GU + al((size_t)65 * 512 * DM * 2);
constexpr size_t OFF_U = OFF_W_D + al((size_t)65 * DM * 256 * 2);
constexpr size_t OFF_HC = OFF_U + al((size_t)TT * DM * 2);
constexpr size_t OFF_MOD = OFF_HC + al((size_t)TC * DM * 4);
constexpr size_t OFF_ROPE = OFF_MOD + al((size_t)2 * 3 * 6144 * 4);
constexpr size_t OFF_CNT = OFF_ROPE + al((size_t)SEQ * 32 * 8);
constexpr size_t OFF_TOKSLOT = OFF_CNT + al(2 * 64 * 4);
constexpr size_t OFF_W8 = OFF_TOKSLOT + al((size_t)TT * 8 * 4);
constexpr size_t OFF_LIST = OFF_W8 + al((size_t)TT * 8 * 4);
constexpr size_t OFF_SSQ = OFF_LIST + al((size_t)64 * TT * 4);
constexpr size_t OFF_BAR = OFF_SSQ + al((size_t)TT * 12 * 4);
constexpr size_t BAR_BYTES = 16384;
constexpr size_t OFF_ARENA = OFF_BAR + BAR_BYTES;
constexpr size_t A0_Z0 = OFF_ARENA;
constexpr size_t A0_VGT = A0_Z0 + al((size_t)TT * Z0P * 2);
constexpr size_t A0_QS = A0_VGT + al((size_t)4 * 128 * TT * 2);
constexpr size_t A0_KS = A0_QS + al((size_t)2 * 8 * NKEY * 64 * 2);
constexpr size_t A0_VST = A0_KS + al((size_t)2 * 2 * NKEY * 64 * 2);
constexpr size_t A0_GS = A0_VST + al((size_t)2 * 2 * 64 * NKEY * 2);
constexpr size_t A0_GD = A0_GS + al((size_t)16 * NSTEP * 8192 * 4);
constexpr size_t A0_MIX = A0_GD + al((size_t)16 * NSTEP * 64 * 4);
constexpr size_t A0_Y = A0_MIX + al((size_t)TT * DM * 2);
constexpr size_t A0_END = A0_Y + al((size_t)TT * DM * 4);
constexpr size_t A1_Z1 = OFF_ARENA;
constexpr size_t A1_QM = A1_Z1 + al((size_t)TT * Z1P * 2);
constexpr size_t A1_KM = A1_QM + al((size_t)2 * 8 * SEQ * 192 * 2);
constexpr size_t A1_VTM = A1_KM + al((size_t)2 * 8 * NKEY * 192 * 2);
constexpr size_t A1_MIX = A1_VTM + al((size_t)2 * 8 * 128 * NKEY * 2);
constexpr size_t A1_Y = A1_MIX + al((size_t)TT * DM * 2);
constexpr size_t A1_END = A1_Y + al((size_t)TT * DM * 4);
constexpr size_t AM_HM = OFF_ARENA;
constexpr size_t AM_YR = AM_HM + al((size_t)TT * 9 * 256 * 2);
constexpr size_t AM_END = AM_YR + al((size_t)TT * 9 * 1024 * 2);
constexpr size_t WS_NEED = AM_END > A0_END ? (AM_END > A1_END ? AM_END : A1_END) : (A0_END > A1_END ? A0_END : A1_END);
static_assert(WS_NEED <= 555747360ull, "workspace map exceeds the guaranteed d_ws size");

struct Params {
    const float *x, *c, *ctx, *c_ctx, *w_mod, *b_mod, *g_mix_pre, *g_mix_post, *g_ffn_pre, *g_ffn_post;
    const float *w_in_e, *gla_wa2, *gla_ba, *gla_norm, *swa_sink, *w_out_e;
    const float *w_in_o, *mla_q_norm, *mla_kv_norm, *w_uq, *w_ukv, *w_out_o;
    const float *w_router, *b_router, *w_exp_gate, *w_exp_up, *w_exp_down, *w_sh_gate, *w_sh_up, *w_sh_down;
    float* out; unsigned char* ws; int ph_lo, ph_hi;
};

__device__ __forceinline__ unsigned pk2(float lo, float hi) { f32x2 v = {lo, hi}; bf16x2_t b = __builtin_convertvector(v, bf16x2_t); return __builtin_bit_cast(unsigned, b); }
__device__ __forceinline__ float bflo(unsigned u) { return __uint_as_float(u << 16); }
__device__ __forceinline__ float bfhi(unsigned u) { return __uint_as_float(u & 0xffff0000u); }
__device__ __forceinline__ float bf2f(bf16 v) { return __uint_as_float((unsigned)v << 16); }
__device__ __forceinline__ bf16 f2bf(float f) { return (bf16)(pk2(f, 0.f) & 0xffffu); }
__device__ __forceinline__ float wave_sum(float v) {
#pragma unroll
    for (int o = 1; o < 64; o <<= 1) v += __shfl_xor(v, o);
    return v;
}
__device__ __forceinline__ void glds16(const void* g, LAS void* l) { __builtin_amdgcn_global_load_lds((const unsigned*)g, (LAS unsigned*)l, 16, 0, 0); }
__device__ __forceinline__ float siluf(float x) { return x / (1.f + __expf(-x)); }
__device__ __forceinline__ float ex2(float x) { return __builtin_amdgcn_exp2f(x); }
__device__ __forceinline__ int crow(int r, int hi) { return (r & 3) + 8 * (r >> 2) + 4 * hi; }
__device__ __forceinline__ bf16x8 mk8(u32x4 v) { return __builtin_bit_cast(bf16x8, v); }

struct RowInfo { int b, kq, pos; bool lat; };
__device__ __forceinline__ RowInfo rowinfo(int r) {
    RowInfo i;
    if (r < TC) { i.b = r >> 8; i.pos = r & 255; i.kq = i.pos; i.lat = false; }
    else { const int rl = r - TC; i.b = rl >> 13; i.pos = rl & (SEQ - 1); i.kq = CTX + i.pos; i.lat = true; }
    return i;
}
__device__ __forceinline__ int modvec(int r) { return r < TC ? 2 : ((r - TC) >> 13); }

struct GPtrs { const bf16* a[4]; const bf16* b[4]; };
constexpr int G_STAGE = 32768;
#define G_FENCE() asm volatile("" ::: "memory")
__device__ __forceinline__ void gemm_issue(LAS unsigned char* lds, const GPtrs& g, int kt) {
    LAS unsigned char* d = lds + (kt & 1) * G_STAGE + threadIdx.x * 16; const int ko = kt * 64;
#pragma unroll
    for (int i = 0; i < 4; ++i) { glds16(g.a[i] + ko, d + i * 4096); glds16(g.b[i] + ko, d + 16384 + i * 4096); }
}
__device__ __forceinline__ void gemm_prologue(LAS unsigned char* lds, const GPtrs& g, int nk) { gemm_issue(lds, g, 0); }
__device__ __forceinline__ void gemm_main(LAS unsigned char* lds, const GPtrs& g, int nk, f32x4 (&acc)[4][4], bool) {
    const int tid = threadIdx.x, lane = tid & 63, wid = tid >> 6, wr = wid >> 1, wc = wid & 1, fr = lane & 15, fq = lane >> 4;
#pragma unroll
    for (int m = 0; m < 4; ++m)
#pragma unroll
        for (int n = 0; n < 4; ++n) acc[m][n] = (f32x4){0.f, 0.f, 0.f, 0.f};
    const int c0 = ((fq) ^ (fr & 7)) * 16, c1 = ((4 + fq) ^ (fr & 7)) * 16;
    const int aoff = (wr * 64 + fr) * 128, boff = 16384 + (wc * 64 + fr) * 128;
    for (int kt = 0; kt < nk; ++kt) {
        asm volatile("s_waitcnt vmcnt(0) lgkmcnt(0)" ::: "memory");
        __builtin_amdgcn_s_barrier();
        G_FENCE();
        if (kt + 1 < nk) gemm_issue(lds, g, kt + 1);
        LAS unsigned char* base = lds + (kt & 1) * G_STAGE;
        bf16x8 af0[4], bf0[4], af1[4], bf1[4];
#pragma unroll
        for (int m = 0; m < 4; ++m) af0[m] = *(const LAS bf16x8*)(base + aoff + m * 2048 + c0);
#pragma unroll
        for (int n = 0; n < 4; ++n) bf0[n] = *(const LAS bf16x8*)(base + boff + n * 2048 + c0);
#pragma unroll
        for (int m = 0; m < 4; ++m) af1[m] = *(const LAS bf16x8*)(base + aoff + m * 2048 + c1);
#pragma unroll
        for (int n = 0; n < 4; ++n) bf1[n] = *(const LAS bf16x8*)(base + boff + n * 2048 + c1);
        __builtin_amdgcn_s_setprio(1);
#pragma unroll
        for (int m = 0; m < 4; ++m)
#pragma unroll
            for (int n = 0; n < 4; ++n) acc[m][n] = __builtin_amdgcn_mfma_f32_16x16x32_bf16(bf0[n], af0[m], acc[m][n], 0, 0, 0);
#pragma unroll
        for (int m = 0; m < 4; ++m)
#pragma unroll
            for (int n = 0; n < 4; ++n) acc[m][n] = __builtin_amdgcn_mfma_f32_16x16x32_bf16(bf1[n], af1[m], acc[m][n], 0, 0, 0);
        __builtin_amdgcn_s_setprio(0);
    }
    asm volatile("s_waitcnt lgkmcnt(0)" ::: "memory");
    __builtin_amdgcn_s_barrier();
    G_FENCE();
}
__device__ __forceinline__ int vcu_id() { const int b = blockIdx.x, G = gridDim.x; return (G % 8 == 0) ? (b % 8) * (G / 8) + b / 8 : b; }
__device__ __forceinline__ void tile_mn(int w, int ntm, int ntn, int& tm, int& tn) {
    const int nig = 8 * ntn, gid = w / nig, fm = gid * 8, gsz = (ntm - fm) < 8 ? (ntm - fm) : 8, within = w - gid * nig;
    tm = fm + within % gsz; tn = within / gsz;
}
template <bool PREFETCH_NEXT, class Make, class Epi>
__device__ __forceinline__ void gemm_tiles(LAS unsigned char* lds, int t0, int nt, int stride, Make make, Epi epi) {
    if (t0 >= nt) return;
    GPtrs g; int nk;
    make(t0, g, nk);
    G_FENCE();
    gemm_prologue(lds, g, nk);
    bool first = true;
    for (int t = t0; t < nt;) {
        const int tn = t + stride;
        f32x4 acc[4][4];
        gemm_main(lds, g, nk, acc, !first);
        first = false;
        if (PREFETCH_NEXT) { if (tn < nt) { make(tn, g, nk); G_FENCE(); gemm_prologue(lds, g, nk); } epi(t, acc); }
        else { epi(t, acc); __syncthreads(); if (tn < nt) { make(tn, g, nk); G_FENCE(); gemm_prologue(lds, g, nk); } }
        t = tn;
    }
}

template <class RowPtr>
__device__ __forceinline__ void epi_store_rows(LAS unsigned char* wl, const f32x4 (&v)[4][4], int fr, int fq, int lane, RowPtr rowptr, int nrep = 1, size_t rep_stride = 0) {
#pragma unroll
    for (int m = 0; m < 4; ++m)
#pragma unroll
        for (int n = 0; n < 4; ++n)
            *(LAS u32x2*)(wl + (m * 16 + fr) * 128 + (((n * 2 + (fq >> 1)) ^ (fr & 7)) * 16) + (fq & 1) * 8) = (u32x2){pk2(v[m][n][0], v[m][n][1]), pk2(v[m][n][2], v[m][n][3])};
#pragma unroll
    for (int i = 0; i < 8; ++i) {
        const int row = (lane >> 3) + 8 * i, pos = lane & 7;
        const u32x4 w = *(const LAS u32x4*)(wl + row * 128 + pos * 16);
        bf16* d = rowptr(row);
        if (d) { d += (pos ^ (row & 7)) * 8; for (int r = 0; r < nrep; ++r) *(u32x4*)(d + (size_t)r * rep_stride) = w; }
    }
}
template <class ColPtr>
__device__ __forceinline__ void epi_store_cols(LAS unsigned char* wl, const f32x4 (&v)[4][4], int fr, int fq, int lane, ColPtr colptr) {
    LAS unsigned char* wb = wl + fq * 512 + fr * 2;
#pragma unroll
    for (int m = 0; m < 4; ++m)
#pragma unroll
        for (int n = 0; n < 4; ++n)
#pragma unroll
            for (int j = 0; j < 4; ++j) *(LAS bf16*)(wb + n * 2048 + j * 128 + m * 32) = f2bf(v[m][n][j]);
#pragma unroll
    for (int i = 0; i < 8; ++i) {
        const int col = (lane >> 3) + 8 * i, pos = lane & 7;
        const u32x4 w = *(const LAS u32x4*)(wl + col * 128 + pos * 16);
        bf16* d = colptr(col);
        *(u32x4*)(d + pos * 8) = w;
    }
}

__device__ __forceinline__ int ein_map(int n) {
    if (n < 512) return n;
    if (n < 1024) return n + 512;
    if (n < 1536) return n - 512;
    if (n < 2048) return 1568 + (n - 1536);
    if (n < 2176) return 2080 + (n - 2048);
    if (n < 2304) return 2208 + (n - 2176);
    if (n < 2320) return 1536 + (n - 2304);
    if (n < 2336) return 1552 + (n - 2320);
    return -1;
}
__device__ __forceinline__ void transpose_item(LAS unsigned char* lds, int K, bf16* dst, int k0, int n0, int ld, int mode, const float* srcA, const float* srcB, int nvalid, const float* kscale) {
    LAS float* tile = (LAS float*)lds;
    const int tid = threadIdx.x;
    {
        const int nq = tid & 31, kr = tid >> 5, n = n0 + nq * 4;
        const float* cp = nullptr; float sc = 1.f;
        if (mode == 0) { if (n < nvalid) cp = srcA + n; }
        else if (mode == 1) { const int c = ein_map(n); if (c >= 0) cp = srcA + c; if (n < 256) sc = 0.125f; }
        else { const int grp = n >> 6, w = n & 63; cp = (w < 32 ? srcA : srcB) + grp * 32 + (w & 31); }
        f32x4 v[8];
#pragma unroll
        for (int i = 0; i < 8; ++i) { const int k = kr + 8 * i; v[i] = cp ? *(const f32x4*)(cp + (size_t)(k0 + k) * ld) : (f32x4){0.f, 0.f, 0.f, 0.f}; }
#pragma unroll
        for (int i = 0; i < 8; ++i) { const int k = kr + 8 * i; float m = sc; if (kscale) m *= kscale[k0 + k]; *(LAS f32x4*)(tile + k * 132 + nq * 4) = v[i] * m; }
    }
    __syncthreads();
    {
        const int n = tid >> 1, hf = tid & 1;
#pragma unroll
        for (int c = 0; c < 4; ++c) {
            const int k8 = hf * 32 + c * 8;
            u32x4 o;
            o.x = pk2(tile[(k8 + 0) * 132 + n], tile[(k8 + 1) * 132 + n]);
            o.y = pk2(tile[(k8 + 2) * 132 + n], tile[(k8 + 3) * 132 + n]);
            o.z = pk2(tile[(k8 + 4) * 132 + n], tile[(k8 + 5) * 132 + n]);
            o.w = pk2(tile[(k8 + 6) * 132 + n], tile[(k8 + 7) * 132 + n]);
            *(u32x4*)(dst + (size_t)(n0 + n) * K + k0 + k8) = o;
        }
    }
    __syncthreads();
}

constexpr int EXP_GU_ITEMS = 65 * 16 * 4, EXP_D_ITEMS = 65 * 4 * 8, EXP_ITEMS = EXP_GU_ITEMS + EXP_D_ITEMS;
__device__ __forceinline__ void expert_convert_item(const Params& p, LAS unsigned char* lds, int l, int it) {
    unsigned char* ws = p.ws;
    if (it < EXP_GU_ITEMS) {
        const int e = it / 64, r = it % 64, kb = r / 4, nb = r % 4;
        const float* gate = e < 64 ? p.w_exp_gate + ((size_t)(l * 64 + e)) * DM * 256 : p.w_sh_gate + (size_t)l * DM * 256;
        const float* up = e < 64 ? p.w_exp_up + ((size_t)(l * 64 + e)) * DM * 256 : p.w_sh_up + (size_t)l * DM * 256;
        transpose_item(lds, DM, (bf16*)(ws + OFF_W_GU) + (size_t)e * 512 * DM, kb * 64, nb * 128, 256, 2, gate, up, 512, nullptr);
    } else {
        it -= EXP_GU_ITEMS;
        const int e = it / 32, r = it % 32, kb = r / 8, nb = r % 8;
        const float* dn = e < 64 ? p.w_exp_down + ((size_t)(l * 64 + e)) * 256 * DM : p.w_sh_down + (size_t)l * 256 * DM;
        transpose_item(lds, 256, (bf16*)(ws + OFF_W_D) + (size_t)e * DM * 256, kb * 64, nb * 128, DM, 0, dn, nullptr, DM, nullptr);
    }
}

__device__ __forceinline__ void ph_prep(const Params& p, LAS unsigned char* lds) {
    unsigned char* ws = p.ws;
    const int tid = threadIdx.x;
    if (blockIdx.x == 0 && tid < 128) ((int*)(ws + OFF_CNT))[tid] = 0;
    constexpr int I_MOD = 96, I_ROPE = 1024, I_INE = 16 * 19, I_OUTE = 128, I_INO = 16 * 7, I_UQ = 8 * 12, I_UKV = 4 * 16, I_OUTO = 128, I_RT = 32;
    constexpr int NITEMS = I_MOD + I_ROPE + I_INE + I_OUTE + I_INO + I_UQ + I_UKV + I_OUTO + I_RT;
    for (int item = blockIdx.x; item < NITEMS; item += gridDim.x) {
        int it = item;
        if (it < I_MOD) {
            const int l = it / 48, n0 = (it % 48) * 128, kg = tid >> 5, cl = tid & 31;
            LAS float* s = (LAS float*)lds;
            LAS float* red = (LAS float*)(lds + 12288);
            for (int idx = tid; idx < 3072; idx += 256) { const int v = idx >> 10, k = idx & 1023; const float cv = v < 2 ? p.c[v * DM + k] : p.c_ctx[k]; s[idx] = cv / (1.f + expf(-cv)); }
            __syncthreads();
            f32x4 a0 = {0.f, 0.f, 0.f, 0.f}, a1 = a0, a2 = a0;
            const float* w = p.w_mod + (size_t)l * DM * 6144 + (size_t)(kg * 128) * 6144 + n0 + cl * 4;
#pragma unroll 8
            for (int k = 0; k < 128; ++k) { const f32x4 wv = *(const f32x4*)(w + (size_t)k * 6144); const int kk = kg * 128 + k; a0 += wv * s[kk]; a1 += wv * s[1024 + kk]; a2 += wv * s[2048 + kk]; }
            *(LAS f32x4*)(red + (kg * 3 + 0) * 128 + cl * 4) = a0; *(LAS f32x4*)(red + (kg * 3 + 1) * 128 + cl * 4) = a1; *(LAS f32x4*)(red + (kg * 3 + 2) * 128 + cl * 4) = a2;
            __syncthreads();
            for (int idx = tid; idx < 384; idx += 256) { const int v = idx >> 7, n = idx & 127; float acc = 0.f;
#pragma unroll
                for (int g = 0; g < 8; ++g) acc += red[(g * 3 + v) * 128 + n];
                ((float*)(ws + OFF_MOD))[((size_t)l * 3 + v) * 6144 + n0 + n] = acc + p.b_mod[l * 6144 + n0 + n]; }
            __syncthreads();
            continue;
        }
        it -= I_MOD;
        if (it < I_ROPE) {
            const int idx = it * 256 + tid, pos = idx >> 5, i = idx & 31, row = pos >> 6, col = pos & 63, j = i & 15;
            const float invf = powf(10000.f, -(float)(2 * j) / 32.f);
            const float ang = (float)(i < 16 ? row : col) * invf;
            float sn, cs; sincosf(ang, &sn, &cs);
            ((f32x2*)(ws + OFF_ROPE))[idx] = (f32x2){cs, sn};
            continue;
        }
        it -= I_ROPE;
        if (it < I_INE) { const int kb = it / 19, nb = it % 19;
            transpose_item(lds, DM, (bf16*)(ws + OFF_W_IN_E), kb * 64, nb * 128, 2336, 1, p.w_in_e, nullptr, 2336, nullptr); continue; }
        it -= I_INE;
        if (it < I_OUTE) { const int kb = it / 8, nb = it % 8;
            transpose_item(lds, DM, (bf16*)(ws + OFF_W_OUT_E), kb * 64, nb * 128, DM, 0, p.w_out_e, nullptr, DM, nullptr); continue; }
        it -= I_OUTE;
        if (it < I_INO) { const int kb = it / 7, nb = it % 7;
            transpose_item(lds, DM, (bf16*)(ws + OFF_W_IN_O), kb * 64, nb * 128, 832, 0, p.w_in_o, nullptr, 832, nullptr); continue; }
        it -= I_INO;
        if (it < I_UQ) { const int kb = it / 12, nb = it % 12;
            transpose_item(lds, 512, (bf16*)(ws + OFF_W_UQ), kb * 64, nb * 128, 1536, 0, p.w_uq, nullptr, 1536, p.mla_q_norm); continue; }
        it -= I_UQ;
        if (it < I_UKV) { const int kb = it / 16, nb = it % 16;
            transpose_item(lds, 256, (bf16*)(ws + OFF_W_UKV), kb * 64, nb * 128, 2048, 0, p.w_ukv, nullptr, 2048, p.mla_kv_norm); continue; }
        it -= I_UKV;
        if (it < I_OUTO) { const int kb = it / 8, nb = it % 8;
            transpose_item(lds, DM, (bf16*)(ws + OFF_W_OUT_O), kb * 64, nb * 128, DM, 0, p.w_out_o, nullptr, DM, nullptr); continue; }
        it -= I_OUTO;
        { const int l = it / 16, kb = it % 16;
            transpose_item(lds, DM, (bf16*)(ws + OFF_W_RT) + (size_t)l * 128 * DM, kb * 64, 0, 64, 0, p.w_router + (size_t)l * DM * 64, nullptr, 64, nullptr); }
    }
}

__device__ __forceinline__ void load_row(const float* src, int lane, f32x4 (&v)[4]) {
#pragma unroll
    for (int j = 0; j < 4; ++j) v[j] = *(const f32x4*)(src + lane * 4 + 256 * j);
}
__device__ __forceinline__ float row_sumsq(const f32x4 (&v)[4]) {
    float s = 0.f;
#pragma unroll
    for (int j = 0; j < 4; ++j) s += v[j].x * v[j].x + v[j].y * v[j].y + v[j].z * v[j].z + v[j].w * v[j].w;
    return wave_sum(s);
}
__device__ __forceinline__ void modulate_store(const f32x4 (&v)[4], float rinv, const float* g, const float* sh, const float* sc, bf16* dst, int lane) {
#pragma unroll
    for (int j = 0; j < 4; ++j) {
        const int c = lane * 4 + 256 * j;
        const f32x4 gg = *(const f32x4*)(g + c), s1 = *(const f32x4*)(sc + c), s0 = *(const f32x4*)(sh + c);
        const f32x4 o = v[j] * rinv * gg * (s1 + 1.f) + s0;
        u32x2 w; w.x = pk2(o.x, o.y); w.y = pk2(o.z, o.w);
        *(u32x2*)(dst + c) = w;
    }
}
__device__ __forceinline__ const float* hl_src0(const Params& p, int r) { return r < TC ? p.ctx + (size_t)r * DM : p.x + (size_t)(r - TC) * DM; }
__device__ __forceinline__ float* hl_buf(const Params& p, int r) { return r < TC ? (float*)(p.ws + OFF_HC) + (size_t)r * DM : p.out + (size_t)(r - TC) * DM; }

__device__ __forceinline__ void ph_modulate0(const Params& p) {
    const int lane = threadIdx.x & 63, gw = blockIdx.x * 4 + (threadIdx.x >> 6), ngw = gridDim.x * 4;
    const float* mod = (const float*)(p.ws + OFF_MOD);
    bf16* U = (bf16*)(p.ws + OFF_U);
    for (int r = gw; r < TT; r += ngw) {
        f32x4 v[4]; load_row(hl_src0(p, r), lane, v);
        const float rinv = rsqrtf(row_sumsq(v) * (1.f / DM) + RMS_EPS);
        const float* mv = mod + (size_t)modvec(r) * 6144;
        modulate_store(v, rinv, p.g_mix_pre, mv, mv + 1024, U + (size_t)r * DM, lane);
    }
}

__device__ __forceinline__ void ph_rowpassA(const Params& p, int l, int row_lo, const float* Y) {
    const int lane = threadIdx.x & 63, gw = blockIdx.x * 4 + (threadIdx.x >> 6), ngw = gridDim.x * 4;
    const float* mod = (const float*)(p.ws + OFF_MOD) + (size_t)l * 3 * 6144;
    bf16* U = (bf16*)(p.ws + OFF_U);
    for (int r = row_lo + gw; r < TT; r += ngw) {
        f32x4 y[4], h[4];
        load_row(Y + (size_t)r * DM, lane, y);
        load_row(l == 0 ? hl_src0(p, r) : (const float*)hl_buf(p, r), lane, h);
        const float rinv = rsqrtf(row_sumsq(y) * (1.f / DM) + RMS_EPS);
        const float* mv = mod + (size_t)modvec(r) * 6144;
        float* hb = hl_buf(p, r);
#pragma unroll
        for (int j = 0; j < 4; ++j) {
            const int c = lane * 4 + 256 * j;
            const f32x4 gg = *(const f32x4*)(p.g_mix_post + l * DM + c), gt = *(const f32x4*)(mv + 2048 + c);
            h[j] = h[j] + gt * (y[j] * rinv * gg);
            *(f32x4*)(hb + c) = h[j];
        }
        const float rinv2 = rsqrtf(row_sumsq(h) * (1.f / DM) + RMS_EPS);
        modulate_store(h, rinv2, p.g_ffn_pre + l * DM, mv + 3072, mv + 4096, U + (size_t)r * DM, lane);
    }
}

constexpr int MOE_LDS_OFF = 65536;
__device__ __forceinline__ void moe_tables(const Params& p, LAS unsigned char* lds, int l, int row_lo) {
    LAS int* cnt = (LAS int*)(lds + MOE_LDS_OFF); LAS int* tp = cnt + 80; LAS int* sp = tp + 80;
    const int tid = threadIdx.x;
    if (tid < 64) cnt[tid] = ((const int*)(p.ws + OFF_CNT))[l * 64 + tid];
    if (tid == 64) cnt[64] = TT - row_lo;
    __syncthreads();
    if (tid == 0) {
        int a = 0, s = 0;
        for (int e = 0; e < 65; ++e) { tp[e] = a; sp[e] = s; a += (cnt[e] + 127) >> 7; s += cnt[e]; }
        tp[65] = a;
    }
    __syncthreads();
}

__device__ __forceinline__ void ph_rowpassB(const Params& p, LAS unsigned char* lds, int l, int row_lo) {
    moe_tables(p, lds, l, row_lo);
    LAS int* sp = (LAS int*)(lds + MOE_LDS_OFF) + 160;
    const int lane = threadIdx.x & 63, gw = blockIdx.x * 4 + (threadIdx.x >> 6), ngw = gridDim.x * 4;
    const float* mod = (const float*)(p.ws + OFF_MOD) + (size_t)l * 3 * 6144;
    const bf16* YR = (const bf16*)(p.ws + AM_YR);
    const int* tokslot = (const int*)(p.ws + OFF_TOKSLOT); const float* W8 = (const float*)(p.ws + OFF_W8);
    bf16* U = (bf16*)(p.ws + OFF_U);
    for (int r = row_lo + gw; r < TT; r += ngw) {
        f32x4 f[4];
#pragma unroll
        for (int j = 0; j < 4; ++j) f[j] = (f32x4){0.f, 0.f, 0.f, 0.f};
#pragma unroll
        for (int k = 0; k < 9; ++k) {
            size_t slot; float wk = 1.f;
            if (k < 8) { const int ts = tokslot[(size_t)r * 8 + k]; slot = (size_t)(sp[ts >> 20] + (ts & 0xfffff)); wk = W8[(size_t)r * 8 + k]; }
            else slot = (size_t)TT * 8 + r;
            const bf16* yr = YR + slot * DM;
#pragma unroll
            for (int j = 0; j < 4; ++j) {
                const u32x2 w = *(const u32x2*)(yr + lane * 4 + 256 * j);
                f[j].x += wk * bflo(w.x); f[j].y += wk * bfhi(w.x); f[j].z += wk * bflo(w.y); f[j].w += wk * bfhi(w.y);
            }
        }
        const float rinv = rsqrtf(row_sumsq(f) * (1.f / DM) + RMS_EPS);
        const float* mv = mod + (size_t)modvec(r) * 6144;
        float* hb = hl_buf(p, r);
        f32x4 h[4]; load_row(hb, lane, h);
#pragma unroll
        for (int j = 0; j < 4; ++j) {
            const int c = lane * 4 + 256 * j;
            const f32x4 gg = *(const f32x4*)(p.g_ffn_post + l * DM + c), gt = *(const f32x4*)(mv + 5120 + c);
            h[j] = h[j] + gt * (f[j] * rinv * gg);
            *(f32x4*)(hb + c) = h[j];
        }
        if (l == 0) {
            const float rinv2 = rsqrtf(row_sumsq(h) * (1.f / DM) + RMS_EPS);
            const float* mv1 = mv + 3 * 6144;
            modulate_store(h, rinv2, p.g_mix_pre + DM, mv1, mv1 + 1024, U + (size_t)r * DM, lane);
        }
    }
}

__device__ __forceinline__ int stg_col() { const int tid = threadIdx.x; return ((tid & 7) ^ ((tid >> 3) & 7)) * 8; }
__device__ __forceinline__ void plain_ptrs(const bf16* base, int row0, int ld, const bf16* (&pp)[4]) {
    const int tid = threadIdx.x;
    pp[0] = base + (size_t)(row0 + (tid >> 3)) * ld + stg_col();
#pragma unroll
    for (int i = 1; i < 4; ++i) pp[i] = pp[0] + (size_t)(32 * i) * ld;
}

__device__ __forceinline__ void ph_inproj0(const Params& p, LAS unsigned char* lds) {
    unsigned char* ws = p.ws;
    const bf16* U = (const bf16*)(ws + OFF_U); const bf16* W = (const bf16*)(ws + OFF_W_IN_E);
    bf16* Z0 = (bf16*)(ws + A0_Z0); bf16* VGT = (bf16*)(ws + A0_VGT); bf16* QS = (bf16*)(ws + A0_QS); bf16* KS = (bf16*)(ws + A0_KS); bf16* VST = (bf16*)(ws + A0_VST);
    const f32x2* rope = (const f32x2*)(ws + OFF_ROPE);
    const int tid = threadIdx.x, lane = tid & 63, wid = tid >> 6, wr = wid >> 1, wc = wid & 1, fr = lane & 15, fq = lane >> 4;
    constexpr int NTN = 19, NTM = TT / 128;
    auto make = [&](int t, GPtrs& g, int& nk) { int tm, tn; tile_mn(t, NTM, NTN, tm, tn); plain_ptrs(U, tm * 128, DM, g.a); plain_ptrs(W, tn * 128, DM, g.b); nk = DM / 64; };
    auto epi = [&](int t, f32x4 (&acc)[4][4]) {
        int tm, tn; tile_mn(t, NTM, NTN, tm, tn); const int brow = tm * 128, bcol = tn * 128;
        const int cb = bcol + wc * 64;
        LAS unsigned char* wl = lds + 32768 + wid * 8192;
        const int r0 = brow + wr * 64;
        const RowInfo ri0 = rowinfo(r0);
        if (cb < 1024) {
            epi_store_rows(wl, acc, fr, fq, lane, [&](int row) { return Z0 + (size_t)(r0 + row) * Z0P + cb; });
        } else if (cb < 1536) {
            const int c0 = cb - 1024;
            epi_store_cols(wl, acc, fr, fq, lane, [&](int col) { return VGT + (size_t)(c0 + col) * TT + r0; });
        } else if (cb < 2176) {
            const float sc = cb < 2048 ? 0.125f * LOG2E : 1.f;
#pragma unroll
            for (int m = 0; m < 4; ++m) {
                const int pos = ri0.pos + m * 16 + fr;
#pragma unroll
                for (int n = 0; n < 2; ++n)
#pragma unroll
                    for (int j = 0; j < 4; ++j) {
                        const float x1 = acc[m][n][j] * sc, x2 = acc[m][n + 2][j] * sc;
                        if (ri0.lat) { const f32x2 cs = rope[(size_t)pos * 32 + n * 16 + fq * 4 + j]; acc[m][n][j] = x1 * cs.x - x2 * cs.y; acc[m][n + 2][j] = x2 * cs.x + x1 * cs.y; }
                        else { acc[m][n][j] = x1; acc[m][n + 2][j] = x2; }
                    }
                asm volatile("" ::: "memory");
            }
            bf16* dst;
            if (cb < 2048) { const int h = (cb - 1536) >> 6; dst = QS + ((size_t)(ri0.b * 8 + h) * NKEY + ri0.kq) * 64; }
            else { const int h = (cb - 2048) >> 6; dst = KS + ((size_t)(ri0.b * 2 + h) * NKEY + ri0.kq) * 64; }
            epi_store_rows(wl, acc, fr, fq, lane, [&](int row) { return dst + (size_t)row * 64; });
        } else if (cb < 2304) {
            const int h = (cb - 2176) >> 6;
            bf16* dst = VST + (size_t)(ri0.b * 2 + h) * 64 * NKEY + ri0.kq;
            epi_store_cols(wl, acc, fr, fq, lane, [&](int col) { return dst + (size_t)col * NKEY; });
        } else if (cb == 2304) {
#pragma unroll
            for (int m = 0; m < 4; ++m) {
                const int r = r0 + m * 16 + fr;
#pragma unroll
                for (int n = 0; n < 2; ++n) { u32x2 w; w.x = pk2(acc[m][n][0], acc[m][n][1]); w.y = pk2(acc[m][n][2], acc[m][n][3]); *(u32x2*)(Z0 + (size_t)r * Z0P + 1024 + n * 16 + fq * 4) = w; }
            }
        }
    };
    gemm_tiles<true>(lds, vcu_id(), NTM * NTN, gridDim.x, make, epi);
}

__device__ __forceinline__ void ph_outproj(const Params& p, LAS unsigned char* lds, const bf16* MIX, const bf16* W, float* Y, int row_lo) {
    const int tid = threadIdx.x, lane = tid & 63, wid = tid >> 6, wr = wid >> 1, wc = wid & 1, fr = lane & 15, fq = lane >> 4;
    const int tm0 = row_lo / 128, ntm = TT / 128 - tm0;
    auto make = [&](int t, GPtrs& g, int& nk) { int tm, tn; tile_mn(t, ntm, 8, tm, tn); plain_ptrs(MIX, (tm0 + tm) * 128, DM, g.a); plain_ptrs(W, tn * 128, DM, g.b); nk = DM / 64; };
    auto epi = [&](int t, f32x4 (&acc)[4][4]) {
        int tm, tn; tile_mn(t, ntm, 8, tm, tn); tm += tm0; const int brow = tm * 128, bcol = tn * 128;
#pragma unroll
        for (int m = 0; m < 4; ++m) {
            const int r = brow + wr * 64 + m * 16 + fr;
#pragma unroll
            for (int n = 0; n < 4; ++n) *(f32x4*)(Y + (size_t)r * DM + bcol + wc * 64 + n * 16 + fq * 4) = acc[m][n];
        }
    };
    gemm_tiles<true>(lds, vcu_id(), ntm * 8, gridDim.x, make, epi);
}

template <int DQK, int DV>
__device__ __forceinline__ void attn_item(LAS unsigned char* lds, const bf16* Qg, const bf16* Kg, const bf16* VTg, int a1, int b0, int b1, int qpos0,
                                          float m_init, float l_init, bf16* Og, int o_pitch) {
    constexpr int KP = (DQK + 8) * 2, VP = 144, NS = DQK / 16, NDV = DV / 32, KCH = DQK / 8;
    const int tid = threadIdx.x, lane = tid & 63, wid = tid >> 6, ql = lane & 31, hi = lane >> 5;
    bf16x8 qf[NS];
    {
        const bf16* qrow = Qg + (size_t)(wid * 32 + ql) * DQK + hi * 8;
#pragma unroll
        for (int s = 0; s < NS; ++s) qf[s] = *(const bf16x8*)(qrow + s * 16);
    }
    f32x16 o[NDV];
#pragma unroll
    for (int d = 0; d < NDV; ++d)
#pragma unroll
        for (int r = 0; r < 16; ++r) o[d][r] = 0.f;
    float mrun = m_init, lrun = l_init;
    const int ntot = a1 + (b1 - b0);
    LAS unsigned char* Ks = lds; LAS unsigned char* Vs = lds + 64 * KP;
    constexpr int KN = KCH / 4, VN = DV / 32;
    u32x4 kreg[KN], vreg[VN];
    const bf16* kgp = Kg + (size_t)(tid >> 2) * DQK + (tid & 3) * 8;
    const bf16* vgp = VTg + (size_t)(tid >> 3) * NKEY + (tid & 7) * 8;
    LAS unsigned char* ksp = Ks + (tid >> 2) * KP + (tid & 3) * 16;
    LAS unsigned char* vsp = Vs + (tid >> 3) * VP + ((tid & 7) >> 1) * 32 + (tid & 1) * 8;
#define ATTN_LOAD(kt_) do { \
        _Pragma("unroll") for (int i_ = 0; i_ < KN; ++i_) kreg[i_] = *(const u32x4*)(kgp + (size_t)(kt_) * 64 * DQK + i_ * 32); \
        _Pragma("unroll") for (int i_ = 0; i_ < VN; ++i_) vreg[i_] = *(const u32x4*)(vgp + (size_t)(i_ * 32) * NKEY + (kt_) * 64); } while (0)
    ATTN_LOAD(a1 > 0 ? 0 : b0);
    for (int it = 0; it < ntot; ++it) {
        const int kt = it < a1 ? it : b0 + (it - a1);
        const bool masked = it >= a1;
        __syncthreads();
#pragma unroll
        for (int i = 0; i < KN; ++i) *(LAS u32x4*)(ksp + i * 64) = kreg[i];
#pragma unroll
        for (int i = 0; i < VN; ++i) { LAS u32x2* d = (LAS u32x2*)(vsp + i * 32 * VP); d[0] = (u32x2){vreg[i].x, vreg[i].y}; d[2] = (u32x2){vreg[i].z, vreg[i].w}; }
        __syncthreads();
        if (it + 1 < ntot) { const int ktn = (it + 1) < a1 ? (it + 1) : b0 + (it + 1 - a1); ATTN_LOAD(ktn); }
        f32x16 p0, p1;
#pragma unroll
        for (int r = 0; r < 16; ++r) { p0[r] = 0.f; p1[r] = 0.f; }
#pragma unroll
        for (int s = 0; s < NS; ++s) {
            const bf16x8 k0 = *(const LAS bf16x8*)(Ks + ql * KP + (s * 16 + hi * 8) * 2);
            const bf16x8 k1 = *(const LAS bf16x8*)(Ks + (32 + ql) * KP + (s * 16 + hi * 8) * 2);
            p0 = __builtin_amdgcn_mfma_f32_32x32x16_bf16(k0, qf[s], p0, 0, 0, 0);
            p1 = __builtin_amdgcn_mfma_f32_32x32x16_bf16(k1, qf[s], p1, 0, 0, 0);
        }
        if (masked) {
            const int kbase = kt * 64 - CTX, qpos = qpos0 + wid * 32 + ql;
#pragma unroll
            for (int r = 0; r < 16; ++r) {
                const int d0 = qpos - (kbase + crow(r, hi)), d1 = d0 - 32;
                if (d0 > 128 || d0 < -128) p0[r] = -1e30f;
                if (d1 > 128 || d1 < -128) p1[r] = -1e30f;
            }
        }
        float mx = p0[0];
#pragma unroll
        for (int r = 1; r < 16; ++r) mx = fmaxf(mx, p0[r]);
#pragma unroll
        for (int r = 0; r < 16; ++r) mx = fmaxf(mx, p1[r]);
        mx = fmaxf(mx, __shfl_xor(mx, 32));
        if (__any(mx > mrun + 8.f)) {
            const float mn = fmaxf(mrun, mx), alpha = ex2(mrun - mn);
            mrun = mn; lrun *= alpha;
#pragma unroll
            for (int d = 0; d < NDV; ++d)
#pragma unroll
                for (int r = 0; r < 16; ++r) o[d][r] *= alpha;
        }
        float rs = 0.f;
#pragma unroll
        for (int r = 0; r < 16; ++r) { p0[r] = ex2(p0[r] - mrun); rs += p0[r]; }
#pragma unroll
        for (int r = 0; r < 16; ++r) { p1[r] = ex2(p1[r] - mrun); rs += p1[r]; }
        rs += __shfl_xor(rs, 32);
        lrun += rs;
        bf16x8 pf[4];
        { u32x4 w;
          w.x = pk2(p0[0], p0[1]); w.y = pk2(p0[2], p0[3]); w.z = pk2(p0[4], p0[5]); w.w = pk2(p0[6], p0[7]); pf[0] = mk8(w);
          w.x = pk2(p0[8], p0[9]); w.y = pk2(p0[10], p0[11]); w.z = pk2(p0[12], p0[13]); w.w = pk2(p0[14], p0[15]); pf[1] = mk8(w);
          w.x = pk2(p1[0], p1[1]); w.y = pk2(p1[2], p1[3]); w.z = pk2(p1[4], p1[5]); w.w = pk2(p1[6], p1[7]); pf[2] = mk8(w);
          w.x = pk2(p1[8], p1[9]); w.y = pk2(p1[10], p1[11]); w.z = pk2(p1[12], p1[13]); w.w = pk2(p1[14], p1[15]); pf[3] = mk8(w); }
#pragma unroll
        for (int d = 0; d < NDV; ++d) {
#pragma unroll
            for (int kk = 0; kk < 4; ++kk) {
                const bf16x8 vf = *(const LAS bf16x8*)(Vs + (d * 32 + ql) * VP + kk * 32 + hi * 16);
                o[d] = __builtin_amdgcn_mfma_f32_32x32x16_bf16(vf, pf[kk], o[d], 0, 0, 0);
            }
        }
    }
#undef ATTN_LOAD
    const float inv = 1.f / lrun;
    bf16* orow = Og + (size_t)(wid * 32 + ql) * o_pitch;
#pragma unroll
    for (int d = 0; d < NDV; ++d)
#pragma unroll
        for (int g = 0; g < 4; ++g) {
            u32x2 w; w.x = pk2(o[d][g * 4 + 0] * inv, o[d][g * 4 + 1] * inv); w.y = pk2(o[d][g * 4 + 2] * inv, o[d][g * 4 + 3] * inv);
            *(u32x2*)(orow + d * 32 + 8 * g + 4 * hi) = w;
        }
}

constexpr int GA_CUM = 0, GA_ALOW = 16384, GA_WA = 20480, GA_BA = 24576, GA_QT = 24832, GA_TOT = 25856, GA_END = 26112;
__device__ __forceinline__ void gla_cum(const Params& p, LAS unsigned char* lds, const bf16* Z0, int r0, int h, int dir) {
    const int tid = threadIdx.x;
    LAS float* cum = (LAS float*)(lds + GA_CUM); LAS float* alow = (LAS float*)(lds + GA_ALOW); LAS float* wa = (LAS float*)(lds + GA_WA);
    LAS float* ba = (LAS float*)(lds + GA_BA); LAS float* qt = (LAS float*)(lds + GA_QT); LAS float* tot = (LAS float*)(lds + GA_TOT);
    {
        const int t = tid >> 2, i4 = (tid & 3) * 4;
        const u32x2 w = *(const u32x2*)(Z0 + (size_t)(r0 + t) * Z0P + 1024 + dir * 16 + i4);
        alow[t * 16 + i4 + 0] = bflo(w.x); alow[t * 16 + i4 + 1] = bfhi(w.x); alow[t * 16 + i4 + 2] = bflo(w.y); alow[t * 16 + i4 + 3] = bfhi(w.y);
#pragma unroll
        for (int q = 0; q < 4; ++q) { const int idx = tid * 4 + q, i = idx >> 6, j = idx & 63; wa[idx] = p.gla_wa2[(size_t)(dir * 16 + i) * 256 + h * 64 + j]; }
        if (tid < 64) ba[tid] = p.gla_ba[dir * 256 + h * 64 + tid];
    }
    __syncthreads();
    const int j = tid & 63, tq = tid >> 6;
    float la[16];
#pragma unroll
    for (int tt = 0; tt < 16; ++tt) {
        const int t = tq * 16 + tt;
        float x = ba[j];
#pragma unroll
        for (int i = 0; i < 16; ++i) x += alow[t * 16 + i] * wa[i * 64 + j];
        la[tt] = (fminf(x, 0.f) - log1pf(expf(-fabsf(x)))) * (1.f / 16.f);
    }
    float run = 0.f;
    if (dir == 0) {
#pragma unroll
        for (int tt = 0; tt < 16; ++tt) { run += la[tt]; cum[(tq * 16 + tt) * 64 + j] = run; }
    } else {
#pragma unroll
        for (int tt = 15; tt >= 0; --tt) { run += la[tt]; cum[(tq * 16 + tt) * 64 + j] = run; }
    }
    qt[tq * 64 + j] = run;
    __syncthreads();
    float off = 0.f, total = 0.f;
#pragma unroll
    for (int q = 0; q < 4; ++q) { const float v = qt[q * 64 + j]; total += v; if (dir == 0 ? (q < tq) : (q > tq)) off += v; }
#pragma unroll
    for (int tt = 0; tt < 16; ++tt) cum[(tq * 16 + tt) * 64 + j] += off;
    if (tq == 0) tot[j] = total;
    __syncthreads();
}

__device__ __forceinline__ int gla_row0(int b, int cc) { return cc < 4 ? b * CTX + cc * 64 : TC + b * SEQ + (cc - 4) * 64; }
__device__ __forceinline__ int gla_step(int cc, int dir) { return dir == 0 ? cc : (cc < 4 ? 3 - cc : 4 + (131 - cc)); }

__device__ __forceinline__ void gla_g1_item(const Params& p, LAS unsigned char* lds, int item) {
    unsigned char* ws = p.ws;
    const bf16* Z0 = (const bf16*)(ws + A0_Z0); const bf16* VGT = (const bf16*)(ws + A0_VGT);
    bf16* GS = (bf16*)(ws + A0_GS); float* GD = (float*)(ws + A0_GD);
    const int cc = item % NSTEP, rest = item / NSTEP, dir = rest & 1, h = (rest >> 1) & 3, b = rest >> 3;
    const int r0 = gla_row0(b, cc), step = gla_step(cc, dir), chain = (b * 4 + h) * 2 + dir;
    const int tid = threadIdx.x, lane = tid & 63, wid = tid >> 6, fr = lane & 15, fq = lane >> 4;
    __syncthreads();
    gla_cum(p, lds, Z0, r0, h, dir);
    LAS float* cum = (LAS float*)(lds + GA_CUM); LAS float* tot = (LAS float*)(lds + GA_TOT);
    LAS bf16* KT = (LAS bf16*)(lds + GA_END);
    {
        const int t = tid >> 2, d0 = (tid & 3) * 16;
        const u32x4 w0 = *(const u32x4*)(Z0 + (size_t)(r0 + t) * Z0P + 256 + h * 64 + d0), w1 = *(const u32x4*)(Z0 + (size_t)(r0 + t) * Z0P + 256 + h * 64 + d0 + 8);
        const unsigned ww[8] = {w0.x, w0.y, w0.z, w0.w, w1.x, w1.y, w1.z, w1.w};
#pragma unroll
        for (int i = 0; i < 8; ++i) {
            const int d = d0 + 2 * i;
            KT[d * 72 + t] = f2bf(bflo(ww[i]) * __expf(tot[d] - cum[t * 64 + d]));
            KT[(d + 1) * 72 + t] = f2bf(bfhi(ww[i]) * __expf(tot[d + 1] - cum[t * 64 + d + 1]));
        }
    }
    if (tid < 64) GD[((size_t)chain * NSTEP + step) * 64 + tid] = __expf(tot[tid]);
    __syncthreads();
    f32x4 acc[2][4];
#pragma unroll
    for (int m = 0; m < 2; ++m)
#pragma unroll
        for (int n = 0; n < 4; ++n) acc[m][n] = (f32x4){0.f, 0.f, 0.f, 0.f};
#pragma unroll
    for (int ks = 0; ks < 2; ++ks) {
        bf16x8 af[2], bfr[4];
#pragma unroll
        for (int m = 0; m < 2; ++m) af[m] = *(const bf16x8*)(VGT + (size_t)(h * 128 + wid * 32 + m * 16 + fr) * TT + r0 + ks * 32 + fq * 8);
#pragma unroll
        for (int n = 0; n < 4; ++n) bfr[n] = *(const LAS bf16x8*)(KT + (n * 16 + fr) * 72 + ks * 32 + fq * 8);
#pragma unroll
        for (int m = 0; m < 2; ++m)
#pragma unroll
            for (int n = 0; n < 4; ++n) acc[m][n] = __builtin_amdgcn_mfma_f32_16x16x32_bf16(bfr[n], af[m], acc[m][n], 0, 0, 0);
    }
    bf16* dst = GS + ((size_t)chain * NSTEP + step) * 8192;
#pragma unroll
    for (int m = 0; m < 2; ++m)
#pragma unroll
        for (int n = 0; n < 4; ++n) *(u32x2*)(dst + (size_t)(wid * 32 + m * 16 + fr) * 64 + n * 16 + fq * 4) = (u32x2){pk2(acc[m][n][0], acc[m][n][1]), pk2(acc[m][n][2], acc[m][n][3])};
}

__device__ __forceinline__ void ph_gla_scan(const Params& p) {
    unsigned* GS = (unsigned*)(p.ws + A0_GS); const float* GD = (const float*)(p.ws + A0_GD);
    for (int idx = blockIdx.x * 256 + threadIdx.x; idx < 16 * 4096; idx += gridDim.x * 256) {
        const int chain = idx >> 12, e2 = idx & 4095, dk = (e2 & 31) * 2;
        unsigned* g = GS + (size_t)chain * NSTEP * 4096 + e2;
        const f32x2* d = (const f32x2*)(GD + (size_t)chain * NSTEP * 64 + dk);
        float s0 = 0.f, s1 = 0.f;
#pragma unroll 12
        for (int s = 0; s < NSTEP; ++s) {
            const unsigned t = g[(size_t)s * 4096]; const f32x2 dec = d[s * 32];
            g[(size_t)s * 4096] = pk2(s0, s1);
            s0 = dec.x * s0 + bflo(t); s1 = dec.y * s1 + bfhi(t);
        }
    }
}

__device__ __forceinline__ void gla_g3_item(const Params& p, LAS unsigned char* lds, int item) {
    unsigned char* ws = p.ws;
    const bf16* Z0 = (const bf16*)(ws + A0_Z0); const bf16* VGT = (const bf16*)(ws + A0_VGT);
    const bf16* GS = (const bf16*)(ws + A0_GS); bf16* MIX = (bf16*)(ws + A0_MIX);
    const int cc = item % NSTEP, rest = item / NSTEP, h = rest & 3, b = rest >> 2;
    const int r0 = gla_row0(b, cc);
    const int tid = threadIdx.x, lane = tid & 63, wid = tid >> 6, fr = lane & 15, fq = lane >> 4;
    LAS bf16* QT = (LAS bf16*)(lds + GA_END);
    LAS bf16* QI = (LAS bf16*)(lds + GA_END + 9216);
    LAS bf16* KT = (LAS bf16*)(lds + GA_END + 18432);
    LAS bf16* PP = (LAS bf16*)(lds);
    f32x4 o[4][2];
#pragma unroll
    for (int m = 0; m < 4; ++m)
#pragma unroll
        for (int n = 0; n < 2; ++n) o[m][n] = (f32x4){0.f, 0.f, 0.f, 0.f};
    for (int dir = 0; dir < 2; ++dir) {
        const int step = gla_step(cc, dir), chain = (b * 4 + h) * 2 + dir;
        __syncthreads();
        gla_cum(p, lds, Z0, r0, h, dir);
        LAS float* cum = (LAS float*)(lds + GA_CUM); LAS float* tot = (LAS float*)(lds + GA_TOT);
        {
            const int t = tid >> 2, d0 = (tid & 3) * 16;
            const bf16* zr = Z0 + (size_t)(r0 + t) * Z0P + h * 64 + d0;
            const u32x4 q0 = *(const u32x4*)(zr), q1 = *(const u32x4*)(zr + 8), k0 = *(const u32x4*)(zr + 256), k1 = *(const u32x4*)(zr + 264);
            const unsigned qq[8] = {q0.x, q0.y, q0.z, q0.w, q1.x, q1.y, q1.z, q1.w}, kk[8] = {k0.x, k0.y, k0.z, k0.w, k1.x, k1.y, k1.z, k1.w};
            unsigned oqt[8], oqi[8], okt[8];
#pragma unroll
            for (int i = 0; i < 8; ++i) {
                const int d = d0 + 2 * i;
                const float c0 = cum[t * 64 + d], c1 = cum[t * 64 + d + 1], t0 = tot[d], t1 = tot[d + 1];
                const float qa = bflo(qq[i]), qb = bfhi(qq[i]), ka = bflo(kk[i]), kb = bfhi(kk[i]);
                oqt[i] = pk2(qa * __expf(c0 - t0), qb * __expf(c1 - t1));
                oqi[i] = pk2(qa * __expf(c0), qb * __expf(c1));
                okt[i] = pk2(ka * __expf(t0 - c0), kb * __expf(t1 - c1));
            }
            *(LAS u32x4*)(QT + t * 72 + d0) = (u32x4){oqt[0], oqt[1], oqt[2], oqt[3]}; *(LAS u32x4*)(QT + t * 72 + d0 + 8) = (u32x4){oqt[4], oqt[5], oqt[6], oqt[7]};
            *(LAS u32x4*)(QI + t * 72 + d0) = (u32x4){oqi[0], oqi[1], oqi[2], oqi[3]}; *(LAS u32x4*)(QI + t * 72 + d0 + 8) = (u32x4){oqi[4], oqi[5], oqi[6], oqi[7]};
            *(LAS u32x4*)(KT + t * 72 + d0) = (u32x4){okt[0], okt[1], okt[2], okt[3]}; *(LAS u32x4*)(KT + t * 72 + d0 + 8) = (u32x4){okt[4], okt[5], okt[6], okt[7]};
        }
        __syncthreads();
        {
            f32x4 sa[4];
#pragma unroll
            for (int m = 0; m < 4; ++m) sa[m] = (f32x4){0.f, 0.f, 0.f, 0.f};
#pragma unroll
            for (int ks = 0; ks < 2; ++ks) {
                const bf16x8 kf = *(const LAS bf16x8*)(KT + (wid * 16 + fr) * 72 + ks * 32 + fq * 8);
#pragma unroll
                for (int m = 0; m < 4; ++m) {
                    const bf16x8 qfm = *(const LAS bf16x8*)(QT + (m * 16 + fr) * 72 + ks * 32 + fq * 8);
                    sa[m] = __builtin_amdgcn_mfma_f32_16x16x32_bf16(kf, qfm, sa[m], 0, 0, 0);
                }
            }
#pragma unroll
            for (int m = 0; m < 4; ++m) {
                const int t = m * 16 + fr;
                float v[4];
#pragma unroll
                for (int jj = 0; jj < 4; ++jj) { const int j = wid * 16 + fq * 4 + jj; const bool keep = dir == 0 ? (j <= t) : (j >= t); v[jj] = keep ? sa[m][jj] : 0.f; }
                *(LAS u32x2*)(PP + t * 72 + wid * 16 + fq * 4) = (u32x2){pk2(v[0], v[1]), pk2(v[2], v[3])};
            }
        }
        __syncthreads();
        const bf16* Sg = GS + ((size_t)chain * NSTEP + step) * 8192;
#pragma unroll
        for (int ks = 0; ks < 2; ++ks) {
            bf16x8 vfr[2], sfr[2];
#pragma unroll
            for (int n = 0; n < 2; ++n) {
                const int dv = wid * 32 + n * 16 + fr;
                vfr[n] = *(const bf16x8*)(VGT + (size_t)(h * 128 + dv) * TT + r0 + ks * 32 + fq * 8);
                sfr[n] = *(const bf16x8*)(Sg + (size_t)dv * 64 + ks * 32 + fq * 8);
            }
#pragma unroll
            for (int m = 0; m < 4; ++m) {
                const bf16x8 pfm = *(const LAS bf16x8*)(PP + (m * 16 + fr) * 72 + ks * 32 + fq * 8);
                const bf16x8 qim = *(const LAS bf16x8*)(QI + (m * 16 + fr) * 72 + ks * 32 + fq * 8);
#pragma unroll
                for (int n = 0; n < 2; ++n) {
                    o[m][n] = __builtin_amdgcn_mfma_f32_16x16x32_bf16(vfr[n], pfm, o[m][n], 0, 0, 0);
                    o[m][n] = __builtin_amdgcn_mfma_f32_16x16x32_bf16(sfr[n], qim, o[m][n], 0, 0, 0);
                }
            }
        }
    }
    __syncthreads();
    LAS float* red = (LAS float*)(lds + GA_END + 27648);
#pragma unroll
    for (int m = 0; m < 4; ++m) {
        float s = 0.f;
#pragma unroll
        for (int n = 0; n < 2; ++n)
#pragma unroll
            for (int j = 0; j < 4; ++j) s += o[m][n][j] * o[m][n][j];
        s += __shfl_xor(s, 16); s += __shfl_xor(s, 32);
        if (fq == 0) red[wid * 64 + m * 16 + fr] = s;
    }
    __syncthreads();
#pragma unroll
    for (int m = 0; m < 4; ++m) {
        const int t = m * 16 + fr;
        const float ss = red[t] + red[64 + t] + red[128 + t] + red[192 + t];
        const float rinv = rsqrtf(ss * (1.f / 128.f) + RMS_EPS);
        const int r = r0 + t;
#pragma unroll
        for (int n = 0; n < 2; ++n) {
            const int dv = wid * 32 + n * 16 + fq * 4;
            const u32x2 gw = *(const u32x2*)(Z0 + (size_t)r * Z0P + 512 + h * 128 + dv);
            const f32x4 ng = *(const f32x4*)(p.gla_norm + dv);
            const float g0 = bflo(gw.x), g1 = bfhi(gw.x), g2 = bflo(gw.y), g3 = bfhi(gw.y);
            const float y0 = o[m][n][0] * rinv * ng.x * siluf(g0), y1 = o[m][n][1] * rinv * ng.y * siluf(g1);
            const float y2 = o[m][n][2] * rinv * ng.z * siluf(g2), y3 = o[m][n][3] * rinv * ng.w * siluf(g3);
            *(u32x2*)(MIX + (size_t)r * DM + h * 128 + dv) = (u32x2){pk2(y0, y1), pk2(y2, y3)};
        }
    }
}

__device__ __forceinline__ void ph_swa_g1(const Params& p, LAS unsigned char* lds) {
    unsigned char* ws = p.ws;
    const bf16* QS = (const bf16*)(ws + A0_QS); const bf16* KS = (const bf16*)(ws + A0_KS); const bf16* VST = (const bf16*)(ws + A0_VST); bf16* MIX = (bf16*)(ws + A0_MIX);
    constexpr int N_SWA = 2 * 8 * 66, N_G1 = 2 * 4 * 2 * NSTEP;
    for (int item = blockIdx.x; item < N_SWA + N_G1; item += gridDim.x) {
        if (item < N_SWA) {
            const int qt = item % 66, rest = item / 66, h = rest & 7, b = rest >> 3, kvh = h >> 2;
            const bf16* Qg = QS + ((size_t)(b * 8 + h) * NKEY + qt * 128) * 64;
            const bf16* Kg = KS + (size_t)(b * 2 + kvh) * NKEY * 64;
            const bf16* Vg = VST + (size_t)(b * 2 + kvh) * 64 * NKEY;
            int b0 = 0, b1 = 0, qpos0 = 0, row0;
            if (qt >= 2) { qpos0 = (qt - 2) * 128; const int lo = qpos0 - 128 < 0 ? 0 : qpos0 - 128, hi2 = qpos0 + 256 > SEQ ? SEQ : qpos0 + 256; b0 = 4 + lo / 64; b1 = 4 + hi2 / 64; row0 = TC + b * SEQ + qpos0; }
            else row0 = b * CTX + qt * 128;
            const float sink = p.swa_sink[h] * LOG2E;
            attn_item<64, 64>(lds, Qg, Kg, Vg, 4, b0, b1, qpos0, sink, 1.f, MIX + (size_t)row0 * DM + 512 + h * 64, DM);
        } else gla_g1_item(p, lds, item - N_SWA);
    }
}
__device__ __forceinline__ void ph_gla_g3(const Params& p, LAS unsigned char* lds) {
    for (int item = blockIdx.x; item < 2 * 4 * NSTEP; item += gridDim.x) gla_g3_item(p, lds, item);
}

__device__ __forceinline__ void ph_router(const Params& p, LAS unsigned char* lds, int l, int row_lo) {
    unsigned char* ws = p.ws;
    const bf16* U = (const bf16*)(ws + OFF_U); const bf16* W = (const bf16*)(ws + OFF_W_RT) + (size_t)l * 128 * DM;
    int* cntg = (int*)(ws + OFF_CNT) + l * 64; int* tokslot = (int*)(ws + OFF_TOKSLOT); float* W8 = (float*)(ws + OFF_W8); int* LIST = (int*)(ws + OFF_LIST);
    const int tid = threadIdx.x, lane = tid & 63, wid = tid >> 6, wr = wid >> 1, wc = wid & 1, fr = lane & 15, fq = lane >> 4;
    LAS float* lg = (LAS float*)lds;
    const int tm0 = row_lo / 128;
    auto make = [&](int tm, GPtrs& g, int& nk) { plain_ptrs(U, tm * 128, DM, g.a); plain_ptrs(W, 0, DM, g.b); nk = DM / 64; };
    auto epi = [&](int tm, f32x4 (&acc)[4][4]) {
        const int brow = tm * 128;
        if (wc == 0) {
#pragma unroll
            for (int m = 0; m < 4; ++m)
#pragma unroll
                for (int n = 0; n < 4; ++n)
#pragma unroll
                    for (int j = 0; j < 4; ++j) lg[(wr * 64 + m * 16 + fr) * 65 + n * 16 + fq * 4 + j] = acc[m][n][j];
        }
        __syncthreads();
        LAS float* biasl = (LAS float*)(lds + 34816); LAS int* hist = (LAS int*)(lds + 34816 + 256); LAS int* basel = (LAS int*)(lds + 34816 + 512);
        if (tid < 64) { biasl[tid] = p.b_router[l * 64 + tid]; hist[tid] = 0; }
        __syncthreads();
        int esel[8], lrank[8]; float ssel[8]; float wsum = 0.f;
        if (tid < 128) {
            LAS float* L = lg + tid * 65;
            float gs[8];
#pragma unroll
            for (int g = 0; g < 8; ++g) {
                float m1 = -INFINITY, m2 = -INFINITY;
#pragma unroll
                for (int j = 0; j < 8; ++j) {
                    const int e = g * 8 + j;
                    const float sel = 1.f / (1.f + expf(-L[e])) + biasl[e];
                    L[e] = sel;
                    if (sel > m1) { m2 = m1; m1 = sel; } else if (sel > m2) m2 = sel;
                }
                gs[g] = m1 + m2;
            }
            unsigned allowed = 0u;
#pragma unroll
            for (int g = 0; g < 8; ++g) {
                int rk = 0;
#pragma unroll
                for (int h = 0; h < 8; ++h) rk += (gs[h] > gs[g] || (gs[h] == gs[g] && h < g)) ? 1 : 0;
                if (rk < 4) allowed |= 1u << g;
            }
#pragma unroll
            for (int k = 0; k < 8; ++k) {
                float best = -INFINITY; int bi = 0;
#pragma unroll
                for (int g = 0; g < 8; ++g) {
                    if ((allowed >> g) & 1u) {
#pragma unroll
                        for (int j = 0; j < 8; ++j) { const float v = L[g * 8 + j]; if (v > best) { best = v; bi = g * 8 + j; } }
                    }
                }
                esel[k] = bi; ssel[k] = best - biasl[bi]; wsum += ssel[k]; L[bi] = -INFINITY;
            }
#pragma unroll
            for (int k = 0; k < 8; ++k) lrank[k] = __hip_atomic_fetch_add(hist + esel[k], 1, __ATOMIC_RELAXED, __HIP_MEMORY_SCOPE_WORKGROUP);
        }
        __syncthreads();
        if (tid < 64) { const int c = hist[tid]; basel[tid] = c > 0 ? atomicAdd(cntg + tid, c) : 0; }
        __syncthreads();
        if (tid < 128) {
            const int t = brow + tid; const float wn = 2.5f / wsum;
#pragma unroll
            for (int k = 0; k < 8; ++k) {
                const int e = esel[k], pos = basel[e] + lrank[k];
                tokslot[(size_t)t * 8 + k] = (e << 20) | pos;
                W8[(size_t)t * 8 + k] = ssel[k] * wn;
                LIST[(size_t)e * TT + pos] = t * 8 + k;
            }
        }
    };
    gemm_tiles<false>(lds, tm0 + vcu_id(), TT / 128, gridDim.x, make, epi);
}

__device__ __forceinline__ int moe_find_expert(const LAS int* tp, int mtg) {
    int lo = 0, hi = 64;
    while (lo < hi) { const int mid = (lo + hi + 1) >> 1; if (tp[mid] <= mtg) lo = mid; else hi = mid - 1; }
    return lo;
}
__device__ __forceinline__ void ph_moe1(const Params& p, LAS unsigned char* lds, int l, int row_lo) {
    unsigned char* ws = p.ws;
    moe_tables(p, lds, l, row_lo);
    LAS int* cnt = (LAS int*)(lds + MOE_LDS_OFF); LAS int* tp = cnt + 80; LAS int* sp = tp + 80;
    const bf16* U = (const bf16*)(ws + OFF_U); const bf16* WGU = (const bf16*)(ws + OFF_W_GU); bf16* HM = (bf16*)(ws + AM_HM);
    const int* LIST = (const int*)(ws + OFF_LIST);
    const int tid = threadIdx.x, lane = tid & 63, wid = tid >> 6, wr = wid >> 1, wc = wid & 1, fr = lane & 15, fq = lane >> 4;
    const int ntiles = tp[65] * 4;
    auto make = [&](int t, GPtrs& g, int& nk) {
        const int mtg = t >> 2, nt = t & 3, e = moe_find_expert(tp, mtg), mt = mtg - tp[e], ce = cnt[e];
#pragma unroll
        for (int i = 0; i < 4; ++i) {
            const int li = mt * 128 + (tid >> 3) + 32 * i;
            int tk = row_lo;
            if (li < ce) tk = e < 64 ? (LIST[(size_t)e * TT + li] >> 3) : row_lo + li;
            g.a[i] = U + (size_t)tk * DM + stg_col();
        }
        plain_ptrs(WGU + (size_t)e * 512 * DM, nt * 128, DM, g.b); nk = DM / 64;
    };
    auto epi = [&](int t, f32x4 (&acc)[4][4]) {
        const int mtg = t >> 2, nt = t & 3, e = moe_find_expert(tp, mtg), mt = mtg - tp[e], ce = cnt[e];
        const size_t slot0 = e < 64 ? (size_t)(sp[e] + mt * 128) : (size_t)TT * 8 + row_lo + mt * 128;
        const int hc0 = nt * 64 + wc * 32;
#pragma unroll
        for (int m = 0; m < 4; ++m) {
            const int i = wr * 64 + m * 16 + fr;
            if (mt * 128 + i < ce) {
#pragma unroll
                for (int n = 0; n < 2; ++n) {
                    const f32x4 g = acc[m][n], u = acc[m][n + 2];
                    const u32x2 w = {pk2(siluf(g[0]) * u[0], siluf(g[1]) * u[1]), pk2(siluf(g[2]) * u[2], siluf(g[3]) * u[3])};
                    *(u32x2*)(HM + (slot0 + i) * 256 + hc0 + n * 16 + fq * 4) = w;
                }
            }
        }
    };
    gemm_tiles<true>(lds, vcu_id(), ntiles, gridDim.x, make, epi);
}
__device__ __forceinline__ void ph_moe2(const Params& p, LAS unsigned char* lds, int l, int row_lo) {
    unsigned char* ws = p.ws;
    moe_tables(p, lds, l, row_lo);
    LAS int* cnt = (LAS int*)(lds + MOE_LDS_OFF); LAS int* tp = cnt + 80; LAS int* sp = tp + 80;
    const bf16* HM = (const bf16*)(ws + AM_HM); const bf16* WD = (const bf16*)(ws + OFF_W_D); bf16* YR = (bf16*)(ws + AM_YR);
    const int tid = threadIdx.x, lane = tid & 63, wid = tid >> 6, wr = wid >> 1, wc = wid & 1, fr = lane & 15, fq = lane >> 4;
    const int ntiles = tp[65] * 8;
    auto make = [&](int t, GPtrs& g, int& nk) {
        const int mtg = t >> 3, nt = t & 7, e = moe_find_expert(tp, mtg), mt = mtg - tp[e];
        const size_t slot0 = e < 64 ? (size_t)(sp[e] + mt * 128) : (size_t)TT * 8 + row_lo + mt * 128;
        plain_ptrs(HM, 0, 256, g.a);
#pragma unroll
        for (int i = 0; i < 4; ++i) g.a[i] += slot0 * 256;
        plain_ptrs(WD + (size_t)e * DM * 256, nt * 128, 256, g.b); nk = 256 / 64;
    };
    auto epi = [&](int t, f32x4 (&acc)[4][4]) {
        const int mtg = t >> 3, nt = t & 7, e = moe_find_expert(tp, mtg), mt = mtg - tp[e], ce = cnt[e];
        const size_t slot0 = e < 64 ? (size_t)(sp[e] + mt * 128) : (size_t)TT * 8 + row_lo + mt * 128;
        LAS unsigned char* wl = lds + 32768 + wid * 8192;
        const int i0 = wr * 64;
        epi_store_rows(wl, acc, fr, fq, lane, [&](int row) -> bf16* { return (mt * 128 + i0 + row < ce) ? YR + (slot0 + i0 + row) * DM + nt * 128 + wc * 64 : nullptr; });
    };
    gemm_tiles<true>(lds, vcu_id(), ntiles, gridDim.x, make, epi);
}

__device__ __forceinline__ void ph_inproj1(const Params& p, LAS unsigned char* lds) {
    unsigned char* ws = p.ws;
    const bf16* U = (const bf16*)(ws + OFF_U); const bf16* W = (const bf16*)(ws + OFF_W_IN_O);
    bf16* Z1 = (bf16*)(ws + A1_Z1); bf16* KM = (bf16*)(ws + A1_KM);
    const f32x2* rope = (const f32x2*)(ws + OFF_ROPE);
    const int tid = threadIdx.x, lane = tid & 63, wid = tid >> 6, wr = wid >> 1, wc = wid & 1, fr = lane & 15, fq = lane >> 4;
    constexpr int NTN = 7, NTM = TT / 128;
    auto make = [&](int t, GPtrs& g, int& nk) { int tm, tn; tile_mn(t, NTM, NTN, tm, tn); plain_ptrs(U, tm * 128, DM, g.a); plain_ptrs(W, tn * 128, DM, g.b); nk = DM / 64; };
    auto epi = [&](int t, f32x4 (&acc)[4][4]) {
        int tm, tn; tile_mn(t, NTM, NTN, tm, tn); const int brow = tm * 128, bcol = tn * 128;
        const int cb = bcol + wc * 64;
        LAS unsigned char* wl = lds + 32768 + wid * 8192;
        const int r0 = brow + wr * 64;
        const RowInfo ri0 = rowinfo(r0);
        if (cb < 768) {
            float* ssq = (float*)(ws + OFF_SSQ);
#pragma unroll
            for (int m = 0; m < 4; ++m) {
                float q = 0.f;
#pragma unroll
                for (int n = 0; n < 4; ++n) q += (acc[m][n][0] * acc[m][n][0] + acc[m][n][1] * acc[m][n][1]) + (acc[m][n][2] * acc[m][n][2] + acc[m][n][3] * acc[m][n][3]);
                q += __shfl_xor(q, 16); q += __shfl_xor(q, 32);
                if (fq == 0) ssq[(size_t)(r0 + m * 16 + fr) * 12 + (cb >> 6)] = q;
            }
            epi_store_rows(wl, acc, fr, fq, lane, [&](int row) { return Z1 + (size_t)(r0 + row) * Z1P + cb; });
        } else if (cb == 768) {
#pragma unroll
            for (int m = 0; m < 4; ++m) {
                const int pos = ri0.pos + m * 16 + fr;
#pragma unroll
                for (int n = 0; n < 2; ++n)
#pragma unroll
                    for (int j = 0; j < 4; ++j) {
                        const float x1 = acc[m][n][j], x2 = acc[m][n + 2][j];
                        if (ri0.lat) { const f32x2 cs = rope[(size_t)pos * 32 + n * 16 + fq * 4 + j]; acc[m][n][j] = x1 * cs.x - x2 * cs.y; acc[m][n + 2][j] = x2 * cs.x + x1 * cs.y; }
                    }
                asm volatile("" ::: "memory");
            }
            bf16* dst = KM + ((size_t)(ri0.b * 8) * NKEY + ri0.kq) * 192 + 128;
            epi_store_rows(wl, acc, fr, fq, lane, [&](int row) { return dst + (size_t)row * 192; }, 8, (size_t)NKEY * 192);
        }
    };
    gemm_tiles<true>(lds, vcu_id(), NTM * NTN, gridDim.x, make, epi);
}

__device__ __forceinline__ void ph_mla_up(const Params& p, LAS unsigned char* lds) {
    unsigned char* ws = p.ws;
    const bf16* Z1 = (const bf16*)(ws + A1_Z1); const bf16* WQ = (const bf16*)(ws + OFF_W_UQ); const bf16* WKV = (const bf16*)(ws + OFF_W_UKV);
    bf16* QM = (bf16*)(ws + A1_QM); bf16* KM = (bf16*)(ws + A1_KM); bf16* VTM = (bf16*)(ws + A1_VTM);
    const f32x2* rope = (const f32x2*)(ws + OFF_ROPE);
    const int tid = threadIdx.x, lane = tid & 63, wid = tid >> 6, wr = wid >> 1, wc = wid & 1, fr = lane & 15, fq = lane >> 4;
    LAS float* rsb = (LAS float*)(lds + 66560);
    constexpr int NQ = (TL / 128) * 12, NKV = (TT / 128) * 16;
    constexpr float QSCALE = 0.07216878364870322f * LOG2E;
    auto decode = [&](int t, bool& isq, int& tm, int& tn) { isq = t < NQ; if (isq) { tile_mn(t, TL / 128, 12, tm, tn); tm += 4; } else tile_mn(t - NQ, TT / 128, 16, tm, tn); };
    auto make = [&](int t, GPtrs& g, int& nk) {
        bool isq; int tm, tn; decode(t, isq, tm, tn);
        const int brow = tm * 128, bcol = tn * 128, K = isq ? 512 : 256, acol = isq ? 0 : 512;
        const int par = ((t - vcu_id()) / (int)gridDim.x) & 1;
        if (tid < 128) {
            const float* q = (const float*)(ws + OFF_SSQ) + (size_t)(brow + tid) * 12;
            float ss;
            if (isq) { const f32x4 a = *(const f32x4*)q, b2 = *(const f32x4*)(q + 4); ss = ((a.x + a.y) + (a.z + a.w)) + ((b2.x + b2.y) + (b2.z + b2.w)); }
            else { const f32x4 a = *(const f32x4*)(q + 8); ss = (a.x + a.y) + (a.z + a.w); }
            rsb[par * 128 + tid] = rsqrtf(ss / (float)K + RMS_EPS);
        }
        plain_ptrs(Z1 + acol, brow, Z1P, g.a); plain_ptrs(isq ? WQ : WKV, bcol, K, g.b); nk = K / 64;
    };
    auto epi = [&](int t, f32x4 (&acc)[4][4]) {
        bool isq; int tm, tn; decode(t, isq, tm, tn);
        const int brow = tm * 128, bcol = tn * 128;
        const int par = ((t - vcu_id()) / (int)gridDim.x) & 1;
        const int cb = bcol + wc * 64;
        LAS unsigned char* wl = lds + 32768 + wid * 8192;
        const int r0 = brow + wr * 64;
        const RowInfo ri0 = rowinfo(r0);
        if (isq) {
            const int h = cb / 192, part = (cb % 192) >> 6;
#pragma unroll
            for (int m = 0; m < 4; ++m) {
                const float sc = rsb[par * 128 + wr * 64 + m * 16 + fr] * QSCALE;
                const int pos = ri0.pos + m * 16 + fr;
                if (part < 2) {
#pragma unroll
                    for (int n = 0; n < 4; ++n) acc[m][n] = acc[m][n] * sc;
                } else {
#pragma unroll
                    for (int n = 0; n < 2; ++n)
#pragma unroll
                        for (int j = 0; j < 4; ++j) {
                            const float x1 = acc[m][n][j] * sc, x2 = acc[m][n + 2][j] * sc;
                            const f32x2 cs = rope[(size_t)pos * 32 + n * 16 + fq * 4 + j];
                            acc[m][n][j] = x1 * cs.x - x2 * cs.y; acc[m][n + 2][j] = x2 * cs.x + x1 * cs.y;
                        }
                }
                asm volatile("" ::: "memory");
            }
            bf16* dst = QM + ((size_t)(ri0.b * 8 + h) * SEQ + ri0.pos) * 192 + part * 64;
            epi_store_rows(wl, acc, fr, fq, lane, [&](int row) { return dst + (size_t)row * 192; });
        } else {
            const int h = cb >> 8, part = (cb & 255) >> 6;
#pragma unroll
            for (int m = 0; m < 4; ++m) {
                const float rs = rsb[par * 128 + wr * 64 + m * 16 + fr];
#pragma unroll
                for (int n = 0; n < 4; ++n) acc[m][n] = acc[m][n] * rs;
            }
            if (part < 2) {
                bf16* dst = KM + ((size_t)(ri0.b * 8 + h) * NKEY + ri0.kq) * 192 + part * 64;
                epi_store_rows(wl, acc, fr, fq, lane, [&](int row) { return dst + (size_t)row * 192; });
            } else {
                bf16* dst = VTM + ((size_t)(ri0.b * 8 + h) * 128 + (part - 2) * 64) * NKEY + ri0.kq;
                epi_store_cols(wl, acc, fr, fq, lane, [&](int col) { return dst + (size_t)col * NKEY; });
            }
        }
    };
    gemm_tiles<true>(lds, vcu_id(), NQ + NKV, gridDim.x, make, epi);
}

__device__ __forceinline__ void ph_mla_attn(const Params& p, LAS unsigned char* lds) {
    unsigned char* ws = p.ws;
    const bf16* QM = (const bf16*)(ws + A1_QM); const bf16* KM = (const bf16*)(ws + A1_KM); const bf16* VTM = (const bf16*)(ws + A1_VTM); bf16* MIX = (bf16*)(ws + A1_MIX);
    for (int item = vcu_id(); item < 2 * 8 * 64; item += gridDim.x) {
        const int qt = item & 63, h = (item >> 6) & 7, b = item >> 9;
        const bf16* Qg = QM + ((size_t)(b * 8 + h) * SEQ + qt * 128) * 192;
        const bf16* Kg = KM + (size_t)(b * 8 + h) * NKEY * 192;
        const bf16* Vg = VTM + (size_t)(b * 8 + h) * 128 * NKEY;
        attn_item<192, 128>(lds, Qg, Kg, Vg, NKEY / 64, 0, 0, 0, -1e30f, 0.f, MIX + (size_t)(TC + b * SEQ + qt * 128) * DM + h * 128, DM);
    }
}


#define XB_TMO      128
#define XB_XCNT(j)  (256  + 64 * (j))
#define XB_XSUB(j)  (1280 + 64 * (j))
#define XB_XGEN(j)  (2304 + 64 * (j))
#define XB_TOP      3328
#define XB_TOPGEN   3392
#define XCD_BAR_WORDS 3456
#define XB_SPIN_CAP (1u << 18)
__device__ __forceinline__ unsigned xb_ld(unsigned* p)              { return __hip_atomic_load(p, __ATOMIC_RELAXED, __HIP_MEMORY_SCOPE_AGENT); }
__device__ __forceinline__ unsigned xb_add(unsigned* p, unsigned v) { return __hip_atomic_fetch_add(p, v, __ATOMIC_RELAXED, __HIP_MEMORY_SCOPE_AGENT); }
__device__ __forceinline__ unsigned xb_xcc_id() { return (unsigned)__builtin_amdgcn_s_getreg((3 << 11) | 20) & 0xFu; }
#define XB_SPIN(cond, bar) do { unsigned _sp = 0; while (cond) { __builtin_amdgcn_s_sleep(1); \
    if ((++_sp & 255u) == 0u) { if (xb_ld(&(bar)[XB_TMO])) break; if (_sp > XB_SPIN_CAP) { atomicAdd(&(bar)[XB_TMO], 1u); break; } } } } while (0)
struct XcdBarrier { unsigned* bar; unsigned x; volatile LAS unsigned* st; };
__device__ __forceinline__ XcdBarrier xcd_barrier_post(unsigned* bar, volatile LAS unsigned* st) {
    XcdBarrier b; b.bar = bar; b.x = xb_xcc_id(); b.st = st;
    if (threadIdx.x == 0) (void)xb_add(&bar[XB_XCNT(b.x)], 1u);
    return b;
}
__device__ __forceinline__ void xcd_barrier_complete(unsigned* bar, unsigned x, unsigned& nloc, unsigned& nx) {
    const unsigned G = gridDim.x * gridDim.y * gridDim.z;
    unsigned sum, cnt, mine, sp = 0u;
    for (;;) {
        sum = 0u; cnt = 0u; mine = 0u;
#pragma unroll
        for (unsigned j = 0; j < 16; ++j) { const unsigned c = xb_ld(&bar[XB_XCNT(j)]); sum += c; cnt += (c > 0u) ? 1u : 0u; mine = (j == x) ? c : mine; }
        if (sum == G) break;
        __builtin_amdgcn_s_sleep(1);
        if ((++sp & 255u) == 0u) { if (xb_ld(&bar[XB_TMO])) break; if (sp > XB_SPIN_CAP) { atomicAdd(&bar[XB_TMO], 1u); break; } }
    }
    nloc = mine > 0u ? mine : 1u; nx = cnt > 0u ? cnt : 1u;
}
__device__ __forceinline__ void xcd_barrier(const XcdBarrier& b) {
    asm volatile("s_waitcnt vmcnt(0)" ::: "memory");
    __syncthreads();
    if (threadIdx.x == 0) {
        unsigned* bar = b.bar;
        __builtin_amdgcn_s_waitcnt(0);
        unsigned nloc = b.st[0], nx = b.st[1];
        if (nloc == 0u) { xcd_barrier_complete(bar, b.x, nloc, nx); b.st[0] = nloc; b.st[1] = nx; }
        const unsigned old = xb_add(&bar[XB_XSUB(b.x)], 1u);
        const unsigned gen = old / nloc;
        if (old + 1u == (gen + 1u) * nloc) {
            __builtin_amdgcn_fence(__ATOMIC_RELEASE, "agent");
            asm volatile("s_waitcnt vmcnt(0)" ::: "memory");
            const unsigned og = xb_add(&bar[XB_TOP], 1u);
            const unsigned tg = og / nx;
            if (og + 1u == (tg + 1u) * nx) xb_add(&bar[XB_TOPGEN], 1u);
            else XB_SPIN(xb_ld(&bar[XB_TOPGEN]) == tg, bar);
            __builtin_amdgcn_fence(__ATOMIC_ACQUIRE, "agent");
            xb_add(&bar[XB_XGEN(b.x)], 1u);
            asm volatile("s_waitcnt vmcnt(0)" ::: "memory");
        } else {
            XB_SPIN(xb_ld(&bar[XB_XGEN(b.x)]) == gen, bar);
            __builtin_amdgcn_fence(__ATOMIC_ACQUIRE, "agent");
            asm volatile("s_waitcnt vmcnt(0)" ::: "memory");
        }
    }
    __syncthreads();
}
static_assert(XCD_BAR_WORDS * 4 <= BAR_BYTES, "barrier words");

constexpr int NPHASE = 19;
__global__ void __launch_bounds__(256, 2) mega(Params p) {
    extern __shared__ __attribute__((aligned(16))) unsigned char lds_[];
    LAS unsigned char* lds = (LAS unsigned char*)lds_;
    cg::grid_group grid = cg::this_grid();
    unsigned char* ws = p.ws;
    volatile LAS unsigned* bst = (volatile LAS unsigned*)(lds + LDS_BYTES - 16);
    if (threadIdx.x < 4) bst[threadIdx.x] = 0u;
    __syncthreads();
    const XcdBarrier xbar = xcd_barrier_post((unsigned*)(ws + OFF_BAR), bst);
#define GRID_BAR(k) do { if ((k) == 0) grid.sync(); else xcd_barrier(xbar); } while (0)
#ifndef PROBE_REP_MASK
#define PROBE_REP_MASK 0u
#endif
#ifndef PROBE_EXTRA_SYNCS
#define PROBE_EXTRA_SYNCS 0
#endif
#define PHASE(k, body) do { if (p.ph_lo <= (k) && (k) < p.ph_hi) { body; if ((PROBE_REP_MASK >> (k)) & 1u) { xcd_barrier(xbar); body; } if ((k) + 1 < p.ph_hi) GRID_BAR(k); } } while (0)
    for (int i = 0; i < PROBE_EXTRA_SYNCS; ++i) xcd_barrier(xbar);
    PHASE(0, ph_prep(p, lds));
    PHASE(1, ph_modulate0(p));
    PHASE(2, ph_inproj0(p, lds));
    PHASE(3, ph_swa_g1(p, lds));
    PHASE(4, ph_gla_scan(p));
    PHASE(5, ph_gla_g3(p, lds));
    PHASE(6, ph_outproj(p, lds, (const bf16*)(ws + A0_MIX), (const bf16*)(ws + OFF_W_OUT_E), (float*)(ws + A0_Y), 0));
    PHASE(7, ph_rowpassA(p, 0, 0, (const float*)(ws + A0_Y)));
    PHASE(8, { ph_router(p, lds, 0, 0); __syncthreads(); for (int it = blockIdx.x; it < EXP_ITEMS; it += gridDim.x) expert_convert_item(p, lds, 0, it); });
    PHASE(9, ph_moe1(p, lds, 0, 0));
    PHASE(10, ph_moe2(p, lds, 0, 0));
    PHASE(11, ph_rowpassB(p, lds, 0, 0));
    PHASE(12, ph_inproj1(p, lds));
    PHASE(13, ph_mla_up(p, lds));
    PHASE(14, ph_mla_attn(p, lds));
    PHASE(15, ph_outproj(p, lds, (const bf16*)(ws + A1_MIX), (const bf16*)(ws + OFF_W_OUT_O), (float*)(ws + A1_Y), TC));
    PHASE(16, ph_rowpassA(p, 1, TC, (const float*)(ws + A1_Y)));
    PHASE(17, { ph_router(p, lds, 1, TC); __syncthreads(); for (int it = blockIdx.x; it < EXP_ITEMS; it += gridDim.x) expert_convert_item(p, lds, 1, it); });
    PHASE(18, ph_moe1(p, lds, 1, TC));
    PHASE(19, ph_moe2(p, lds, 1, TC));
    PHASE(20, ph_rowpassB(p, lds, 1, TC));
}

extern "C" void kernel_launch(void* const* d_in, const int* in_sizes, int n_in, void* d_out, int out_size, void* d_ws, size_t ws_size, hipStream_t stream) {
    static int grid_blocks = 0;
    if (!grid_blocks) {
        int dev = 0, cus = 0, per_cu = 0;
        (void)hipGetDevice(&dev);
        (void)hipDeviceGetAttribute(&cus, hipDeviceAttributeMultiprocessorCount, dev);
        (void)hipFuncSetAttribute((const void*)mega, hipFuncAttributeMaxDynamicSharedMemorySize, LDS_BYTES);
        (void)hipOccupancyMaxActiveBlocksPerMultiprocessor(&per_cu, (const void*)mega, 256, LDS_BYTES);
        if (per_cu > 2) per_cu = 2;
        if (per_cu < 1) per_cu = 1;
        grid_blocks = cus * per_cu;
        if (ws_size < WS_NEED) fprintf(stderr, "kernel_launch: workspace too small: %zu < %zu\n", ws_size, (size_t)WS_NEED);
    }
    Params p{};
    const float** f = (const float**)&p;
    for (int i = 0; i < 30; ++i) f[i] = (const float*)d_in[i];
    p.out = (float*)d_out; p.ws = (unsigned char*)d_ws; p.ph_lo = 0; p.ph_hi = 21;
    (void)hipMemsetAsync((unsigned char*)d_ws + OFF_BAR, 0, BAR_BYTES, stream);
    void* args[] = {&p};
    hipError_t e = hipLaunchCooperativeKernel((const void*)mega, dim3(grid_blocks), dim3(256), args, LDS_BYTES, stream);
    if (e != hipSuccess) fprintf(stderr, "cooperative launch failed: %s (grid %d)\n", hipGetErrorString(e), grid_blocks);
}
```

```cpp
#include <hip/hip_runtime.h>
#include <hip/hip_cooperative_groups.h>
#include <cstdio>
#include <cstdint>
namespace cg = cooperative_groups;

#define LAS __attribute__((address_space(3)))
typedef unsigned short bf16;
typedef short bf16x8 __attribute__((ext_vector_type(8)));
typedef float f32x2 __attribute__((ext_vector_type(2)));
typedef float f32x4 __attribute__((ext_vector_type(4)));
typedef float f32x8 __attribute__((ext_vector_type(8)));
typedef float f32x16 __attribute__((ext_vector_type(16)));
typedef unsigned u32x2 __attribute__((ext_vector_type(2)));
typedef unsigned u32x4 __attribute__((ext_vector_type(4)));
typedef __bf16 bf16x2_t __attribute__((ext_vector_type(2)));

constexpr int DM = 1024, NB = 2, SEQ = 8192, CTX = 256;
constexpr int TC = NB * CTX, TL = NB * SEQ, TT = TC + TL, NKEY = CTX + SEQ;
constexpr int NEXP = 64;
constexpr float RMS_EPS = 1e-6f;
constexpr int E_IN_PAD = 2432, O_IN_PAD = 896;
constexpr float LOG2E = 1.4426950408889634f;
constexpr int NSTEP = 132;
constexpr int Z0P = 1056;
constexpr int Z1P = 768;
constexpr int LDS_BYTES = 73728;

constexpr size_t al(size_t x) { return (x + 255) & ~(size_t)255; }
constexpr size_t OFF_W_IN_E = 0;
constexpr size_t OFF_W_OUT_E = OFF_W_IN_E + al((size_t)E_IN_PAD * DM * 2);
constexpr size_t OFF_W_IN_O = OFF_W_OUT_E + al((size_t)DM * DM * 2);
constexpr size_t OFF_W_UQ = OFF_W_IN_O + al((size_t)O_IN_PAD * DM * 2);
constexpr size_t OFF_W_UKV = OFF_W_UQ + al((size_t)1536 * 512 * 2);
constexpr size_t OFF_W_OUT_O = OFF_W_UKV + al((size_t)2048 * 256 * 2);
constexpr size_t OFF_W_RT = OFF_W_OUT_O + al((size_t)DM * DM * 2);
constexpr size_t OFF_W_GU = OFF_W_RT + al((size_t)2 * 128 * DM * 2);
constexpr size_t OFF_W_D = OFF_W_GU + al((size_t)65 * 512 * DM * 2);
constexpr size_t OFF_U = OFF_W_D + al((size_t)65 * DM * 256 * 2);
constexpr size_t OFF_HC = OFF_U + al((size_t)TT * DM * 2);
constexpr size_t OFF_MOD = OFF_HC + al((size_t)TC * DM * 4);
constexpr size_t OFF_ROPE = OFF_MOD + al((size_t)2 * 3 * 6144 * 4);
constexpr size_t OFF_CNT = OFF_ROPE + al((size_t)SEQ * 32 * 8);
constexpr size_t OFF_TOKSLOT = OFF_CNT + al(2 * 64 * 4);
constexpr size_t OFF_W8 = OFF_TOKSLOT + al((size_t)TT * 8 * 4);
constexpr size_t OFF_LIST = OFF_W8 + al((size_t)TT * 8 * 4);
constexpr size_t OFF_SSQ = OFF_LIST + al((size_t)64 * TT * 4);
constexpr size_t OFF_BAR = OFF_SSQ + al((size_t)TT * 12 * 4);
constexpr size_t BAR_BYTES = 16384;
constexpr size_t OFF_ARENA = OFF_BAR + BAR_BYTES;
constexpr size_t A0_Z0 = OFF_ARENA;
constexpr size_t A0_VGT = A0_Z0 + al((size_t)TT * Z0P * 2);
constexpr size_t A0_QS = A0_VGT + al((size_t)4 * 128 * TT * 2);
constexpr size_t A0_KS = A0_QS + al((size_t)2 * 8 * NKEY * 64 * 2);
constexpr size_t A0_VST = A0_KS + al((size_t)2 * 2 * NKEY * 64 * 2);
constexpr size_t A0_GS = A0_VST + al((size_t)2 * 2 * 64 * NKEY * 2);
constexpr size_t A0_GD = A0_GS + al((size_t)16 * NSTEP * 8192 * 4);
constexpr size_t A0_MIX = A0_GD + al((size_t)16 * NSTEP * 64 * 4);
constexpr size_t A0_Y = A0_MIX + al((size_t)TT * DM * 2);
constexpr size_t A0_END = A0_Y + al((size_t)TT * DM * 4);
constexpr size_t A1_Z1 = OFF_ARENA;
constexpr size_t A1_QM = A1_Z1 + al((size_t)TT * Z1P * 2);
constexpr size_t A1_KM = A1_QM + al((size_t)2 * 8 * SEQ * 192 * 2);
constexpr size_t A1_VTM = A1_KM + al((size_t)2 * 8 * NKEY * 192 * 2);
constexpr size_t A1_MIX = A1_VTM + al((size_t)2 * 8 * 128 * NKEY * 2);
constexpr size_t A1_Y = A1_MIX + al((size_t)TT * DM * 2);
constexpr size_t A1_END = A1_Y + al((size_t)TT * DM * 4);
constexpr size_t AM_HM = OFF_ARENA;
constexpr size_t AM_YR = AM_HM + al((size_t)TT * 9 * 256 * 2);
constexpr size_t AM_END = AM_YR + al((size_t)TT * 9 * 1024 * 2);
constexpr size_t WS_NEED = AM_END > A0_END ? (AM_END > A1_END ? AM_END : A1_END) : (A0_END > A1_END ? A0_END : A1_END);
static_assert(WS_NEED <= 555747360ull, "workspace map exceeds the guaranteed d_ws size");

struct Params {
    const float *x, *c, *ctx, *c_ctx, *w_mod, *b_mod, *g_mix_pre, *g_mix_post, *g_ffn_pre, *g_ffn_post;
    const float *w_in_e, *gla_wa2, *gla_ba, *gla_norm, *swa_sink, *w_out_e;
    const float *w_in_o, *mla_q_norm, *mla_kv_norm, *w_uq, *w_ukv, *w_out_o;
    const float *w_router, *b_router, *w_exp_gate, *w_exp_up, *w_exp_down, *w_sh_gate, *w_sh_up, *w_sh_down;
    float* out; unsigned char* ws; int ph_lo, ph_hi;
};

__device__ __forceinline__ unsigned pk2(float lo, float hi) { f32x2 v = {lo, hi}; bf16x2_t b = __builtin_convertvector(v, bf16x2_t); return __builtin_bit_cast(unsigned, b); }
__device__ __forceinline__ float bflo(unsigned u) { return __uint_as_float(u << 16); }
__device__ __forceinline__ float bfhi(unsigned u) { return __uint_as_float(u & 0xffff0000u); }
__device__ __forceinline__ float bf2f(bf16 v) { return __uint_as_float((unsigned)v << 16); }
__device__ __forceinline__ bf16 f2bf(float f) { return (bf16)(pk2(f, 0.f) & 0xffffu); }
__device__ __forceinline__ float wave_sum(float v) {
#pragma unroll
    for (int o = 1; o < 64; o <<= 1) v += __shfl_xor(v, o);
    return v;
}
__device__ __forceinline__ void glds16(const void* g, LAS void* l) { __builtin_amdgcn_global_load_lds((const unsigned*)g, (LAS unsigned*)l, 16, 0, 0); }
__device__ __forceinline__ float siluf(float x) { return x / (1.f + __expf(-x)); }
__device__ __forceinline__ float ex2(float x) { return __builtin_amdgcn_exp2f(x); }
__device__ __forceinline__ int crow(int r, int hi) { return (r & 3) + 8 * (r >> 2) + 4 * hi; }
__device__ __forceinline__ bf16x8 mk8(u32x4 v) { return __builtin_bit_cast(bf16x8, v); }

struct RowInfo { int b, kq, pos; bool lat; };
__device__ __forceinline__ RowInfo rowinfo(int r) {
    RowInfo i;
    if (r < TC) { i.b = r >> 8; i.pos = r & 255; i.kq = i.pos; i.lat = false; }
    else { const int rl = r - TC; i.b = rl >> 13; i.pos = rl & (SEQ - 1); i.kq = CTX + i.pos; i.lat = true; }
    return i;
}
__device__ __forceinline__ int modvec(int r) { return r < TC ? 2 : ((r - TC) >> 13); }

struct GPtrs { const bf16* a[4]; const bf16* b[4]; };
constexpr int G_STAGE = 32768;
#define G_FENCE() asm volatile("" ::: "memory")
__device__ __forceinline__ void gemm_issue(LAS unsigned char* lds, const GPtrs& g, int kt) {
    LAS unsigned char* d = lds + (kt & 1) * G_STAGE + threadIdx.x * 16; const int ko = kt * 64;
#pragma unroll
    for (int i = 0; i < 4; ++i) { glds16(g.a[i] + ko, d + i * 4096); glds16(g.b[i] + ko, d + 16384 + i * 4096); }
}
__device__ __forceinline__ void gemm_prologue(LAS unsigned char* lds, const GPtrs& g, int nk) { gemm_issue(lds, g, 0); }
__device__ __forceinline__ void gemm_main(LAS unsigned char* lds, const GPtrs& g, int nk, f32x4 (&acc)[4][4], bool) {
    const int tid = threadIdx.x, lane = tid & 63, wid = tid >> 6, wr = wid >> 1, wc = wid & 1, fr = lane & 15, fq = lane >> 4;
#pragma unroll
    for (int m = 0; m < 4; ++m)
#pragma unroll
        for (int n = 0; n < 4; ++n) acc[m][n] = (f32x4){0.f, 0.f, 0.f, 0.f};
    const int c0 = ((fq) ^ (fr & 7)) * 16, c1 = ((4 + fq) ^ (fr & 7)) * 16;
    const int aoff = (wr * 64 + fr) * 128, boff = 16384 + (wc * 64 + fr) * 128;
    for (int kt = 0; kt < nk; ++kt) {
        asm volatile("s_waitcnt vmcnt(0) lgkmcnt(0)" ::: "memory");
        __builtin_amdgcn_s_barrier();
        G_FENCE();
        if (kt + 1 < nk) gemm_issue(lds, g, kt + 1);
        LAS unsigned char* base = lds + (kt & 1) * G_STAGE;
        bf16x8 af0[4], bf0[4], af1[4], bf1[4];
#pragma unroll
        for (int m = 0; m < 4; ++m) af0[m] = *(const LAS bf16x8*)(base + aoff + m * 2048 + c0);
#pragma unroll
        for (int n = 0; n < 4; ++n) bf0[n] = *(const LAS bf16x8*)(base + boff + n * 2048 + c0);
#pragma unroll
        for (int m = 0; m < 4; ++m) af1[m] = *(const LAS bf16x8*)(base + aoff + m * 2048 + c1);
#pragma unroll
        for (int n = 0; n < 4; ++n) bf1[n] = *(const LAS bf16x8*)(base + boff + n * 2048 + c1);
        __builtin_amdgcn_s_setprio(1);
#pragma unroll
        for (int m = 0; m < 4; ++m)
#pragma unroll
            for (int n = 0; n < 4; ++n) acc[m][n] = __builtin_amdgcn_mfma_f32_16x16x32_bf16(bf0[n], af0[m], acc[m][n], 0, 0, 0);
#pragma unroll
        for (int m = 0; m < 4; ++m)
#pragma unroll
            for (int n = 0; n < 4; ++n) acc[m][n] = __builtin_amdgcn_mfma_f32_16x16x32_bf16(bf1[n], af1[m], acc[m][n], 0, 0, 0);
        __builtin_amdgcn_s_setprio(0);
    }
    asm volatile("s_waitcnt lgkmcnt(0)" ::: "memory");
    __builtin_amdgcn_s_barrier();
    G_FENCE();
}
__device__ __forceinline__ int vcu_id() { const int b = blockIdx.x, G = gridDim.x; return (G % 8 == 0) ? (b % 8) * (G / 8) + b / 8 : b; }
__device__ __forceinline__ void tile_mn(int w, int ntm, int ntn, int& tm, int& tn) {
    const int nig = 8 * ntn, gid = w / nig, fm = gid * 8, gsz = (ntm - fm) < 8 ? (ntm - fm) : 8, within = w - gid * nig;
    tm = fm + within % gsz; tn = within / gsz;
}
template <bool PREFETCH_NEXT, class Make, class Epi>
__device__ __forceinline__ void gemm_tiles(LAS unsigned char* lds, int t0, int nt, int stride, Make make, Epi epi) {
    if (t0 >= nt) return;
    GPtrs g; int nk;
    make(t0, g, nk);
    G_FENCE();
    gemm_prologue(lds, g, nk);
    bool first = true;
    for (int t = t0; t < nt;) {
        const int tn = t + stride;
        f32x4 acc[4][4];
        gemm_main(lds, g, nk, acc, !first);
        first = false;
        if (PREFETCH_NEXT) { if (tn < nt) { make(tn, g, nk); G_FENCE(); gemm_prologue(lds, g, nk); } epi(t, acc); }
        else { epi(t, acc); __syncthreads(); if (tn < nt) { make(tn, g, nk); G_FENCE(); gemm_prologue(lds, g, nk); } }
        t = tn;
    }
}

template <class RowPtr>
__device__ __forceinline__ void epi_store_rows(LAS unsigned char* wl, const f32x4 (&v)[4][4], int fr, int fq, int lane, RowPtr rowptr, int nrep = 1, size_t rep_stride = 0) {
#pragma unroll
    for (int m = 0; m < 4; ++m)
#pragma unroll
        for (int n = 0; n < 4; ++n)
            *(LAS u32x2*)(wl + (m * 16 + fr) * 128 + (((n * 2 + (fq >> 1)) ^ (fr & 7)) * 16) + (fq & 1) * 8) = (u32x2){pk2(v[m][n][0], v[m][n][1]), pk2(v[m][n][2], v[m][n][3])};
#pragma unroll
    for (int i = 0; i < 8; ++i) {
        const int row = (lane >> 3) + 8 * i, pos = lane & 7;
        const u32x4 w = *(const LAS u32x4*)(wl + row * 128 + pos * 16);
        bf16* d = rowptr(row);
        if (d) { d += (pos ^ (row & 7)) * 8; for (int r = 0; r < nrep; ++r) *(u32x4*)(d + (size_t)r * rep_stride) = w; }
    }
}
template <class ColPtr>
__device__ __forceinline__ void epi_store_cols(LAS unsigned char* wl, const f32x4 (&v)[4][4], int fr, int fq, int lane, ColPtr colptr) {
    LAS unsigned char* wb = wl + fq * 512 + fr * 2;
#pragma unroll
    for (int m = 0; m < 4; ++m)
#pragma unroll
        for (int n = 0; n < 4; ++n)
#pragma unroll
            for (int j = 0; j < 4; ++j) *(LAS bf16*)(wb + n * 2048 + j * 128 + m * 32) = f2bf(v[m][n][j]);
#pragma unroll
    for (int i = 0; i < 8; ++i) {
        const int col = (lane >> 3) + 8 * i, pos = lane & 7;
        const u32x4 w = *(const LAS u32x4*)(wl + col * 128 + pos * 16);
        bf16* d = colptr(col);
        *(u32x4*)(d + pos * 8) = w;
    }
}

__device__ __forceinline__ int ein_map(int n) {
    if (n < 512) return n;
    if (n < 1024) return n + 512;
    if (n < 1536) return n - 512;
    if (n < 2048) return 1568 + (n - 1536);
    if (n < 2176) return 2080 + (n - 2048);
    if (n < 2304) return 2208 + (n - 2176);
    if (n < 2320) return 1536 + (n - 2304);
    if (n < 2336) return 1552 + (n - 2320);
    return -1;
}
__device__ __forceinline__ void transpose_item(LAS unsigned char* lds, int K, bf16* dst, int k0, int n0, int ld, int mode, const float* srcA, const float* srcB, int nvalid, const float* kscale) {
    LAS float* tile = (LAS float*)lds;
    const int tid = threadIdx.x;
    {
        const int nq = tid & 31, kr = tid >> 5, n = n0 + nq * 4;
        const float* cp = nullptr; float sc = 1.f;
        if (mode == 0) { if (n < nvalid) cp = srcA + n; }
        else if (mode == 1) { const int c = ein_map(n); if (c >= 0) cp = srcA + c; if (n < 256) sc = 0.125f; }
        else { const int grp = n >> 6, w = n & 63; cp = (w < 32 ? srcA : srcB) + grp * 32 + (w & 31); }
        f32x4 v[8];
#pragma unroll
        for (int i = 0; i < 8; ++i) { const int k = kr + 8 * i; v[i] = cp ? *(const f32x4*)(cp + (size_t)(k0 + k) * ld) : (f32x4){0.f, 0.f, 0.f, 0.f}; }
#pragma unroll
        for (int i = 0; i < 8; ++i) { const int k = kr + 8 * i; float m = sc; if (kscale) m *= kscale[k0 + k]; *(LAS f32x4*)(tile + k * 132 + nq * 4) = v[i] * m; }
    }
    __syncthreads();
    {
        const int n = tid >> 1, hf = tid & 1;
#pragma unroll
        for (int c = 0; c < 4; ++c) {
            const int k8 = hf * 32 + c * 8;
            u32x4 o;
            o.x = pk2(tile[(k8 + 0) * 132 + n], tile[(k8 + 1) * 132 + n]);
            o.y = pk2(tile[(k8 + 2) * 132 + n], tile[(k8 + 3) * 132 + n]);
            o.z = pk2(tile[(k8 + 4) * 132 + n], tile[(k8 + 5) * 132 + n]);
            o.w = pk2(tile[(k8 + 6) * 132 + n], tile[(k8 + 7) * 132 + n]);
            *(u32x4*)(dst + (size_t)(n0 + n) * K + k0 + k8) = o;
        }
    }
    __syncthreads();
}

constexpr int EXP_GU_ITEMS = 65 * 16 * 4, EXP_D_ITEMS = 65 * 4 * 8, EXP_ITEMS = EXP_GU_ITEMS + EXP_D_ITEMS;
__device__ __forceinline__ void expert_convert_item(const Params& p, LAS unsigned char* lds, int l, int it) {
    unsigned char* ws = p.ws;
    if (it < EXP_GU_ITEMS) {
        const int e = it / 64, r = it % 64, kb = r / 4, nb = r % 4;
        const float* gate = e < 64 ? p.w_exp_gate + ((size_t)(l * 64 + e)) * DM * 256 : p.w_sh_gate + (size_t)l * DM * 256;
        const float* up = e < 64 ? p.w_exp_up + ((size_t)(l * 64 + e)) * DM * 256 : p.w_sh_up + (size_t)l * DM * 256;
        transpose_item(lds, DM, (bf16*)(ws + OFF_W_GU) + (size_t)e * 512 * DM, kb * 64, nb * 128, 256, 2, gate, up, 512, nullptr);
    } else {
        it -= EXP_GU_ITEMS;
        const int e = it / 32, r = it % 32, kb = r / 8, nb = r % 8;
        const float* dn = e < 64 ? p.w_exp_down + ((size_t)(l * 64 + e)) * 256 * DM : p.w_sh_down + (size_t)l * 256 * DM;
        transpose_item(lds, 256, (bf16*)(ws + OFF_W_D) + (size_t)e * DM * 256, kb * 64, nb * 128, DM, 0, dn, nullptr, DM, nullptr);
    }
}

__device__ __forceinline__ void ph_prep(const Params& p, LAS unsigned char* lds) {
    unsigned char* ws = p.ws;
    const int tid = threadIdx.x;
    if (blockIdx.x == 0 && tid < 128) ((int*)(ws + OFF_CNT))[tid] = 0;
    constexpr int I_MOD = 96, I_ROPE = 1024, I_INE = 16 * 19, I_OUTE = 128, I_INO = 16 * 7, I_UQ = 8 * 12, I_UKV = 4 * 16, I_OUTO = 128, I_RT = 32;
    constexpr int NITEMS = I_MOD + I_ROPE + I_INE + I_OUTE + I_INO + I_UQ + I_UKV + I_OUTO + I_RT;
    for (int item = blockIdx.x; item < NITEMS; item += gridDim.x) {
        int it = item;
        if (it < I_MOD) {
            const int l = it / 48, n0 = (it % 48) * 128, kg = tid >> 5, cl = tid & 31;
            LAS float* s = (LAS float*)lds;
            LAS float* red = (LAS float*)(lds + 12288);
            for (int idx = tid; idx < 3072; idx += 256) { const int v = idx >> 10, k = idx & 1023; const float cv = v < 2 ? p.c[v * DM + k] : p.c_ctx[k]; s[idx] = cv / (1.f + expf(-cv)); }
            __syncthreads();
            f32x4 a0 = {0.f, 0.f, 0.f, 0.f}, a1 = a0, a2 = a0;
            const float* w = p.w_mod + (size_t)l * DM * 6144 + (size_t)(kg * 128) * 6144 + n0 + cl * 4;
#pragma unroll 8
            for (int k = 0; k < 128; ++k) { const f32x4 wv = *(const f32x4*)(w + (size_t)k * 6144); const int kk = kg * 128 + k; a0 += wv * s[kk]; a1 += wv * s[1024 + kk]; a2 += wv * s[2048 + kk]; }
            *(LAS f32x4*)(red + (kg * 3 + 0) * 128 + cl * 4) = a0; *(LAS f32x4*)(red + (kg * 3 + 1) * 128 + cl * 4) = a1; *(LAS f32x4*)(red + (kg * 3 + 2) * 128 + cl * 4) = a2;
            __syncthreads();
            for (int idx = tid; idx < 384; idx += 256) { const int v = idx >> 7, n = idx & 127; float acc = 0.f;
#pragma unroll
                for (int g = 0; g < 8; ++g) acc += red[(g * 3 + v) * 128 + n];
                ((float*)(ws + OFF_MOD))[((size_t)l * 3 + v) * 6144 + n0 + n] = acc + p.b_mod[l * 6144 + n0 + n]; }
            __syncthreads();
            continue;
        }
        it -= I_MOD;
        if (it < I_ROPE) {
            const int idx = it * 256 + tid, pos = idx >> 5, i = idx & 31, row = pos >> 6, col = pos & 63, j = i & 15;
            const float invf = powf(10000.f, -(float)(2 * j) / 32.f);
            const float ang = (float)(i < 16 ? row : col) * invf;
            float sn, cs; sincosf(ang, &sn, &cs);
            ((f32x2*)(ws + OFF_ROPE))[idx] = (f32x2){cs, sn};
            continue;
        }
        it -= I_ROPE;
        if (it < I_INE) { const int kb = it / 19, nb = it % 19;
            transpose_item(lds, DM, (bf16*)(ws + OFF_W_IN_E), kb * 64, nb * 128, 2336, 1, p.w_in_e, nullptr, 2336, nullptr); continue; }
        it -= I_INE;
        if (it < I_OUTE) { const int kb = it / 8, nb = it % 8;
            transpose_item(lds, DM, (bf16*)(ws + OFF_W_OUT_E), kb * 64, nb * 128, DM, 0, p.w_out_e, nullptr, DM, nullptr); continue; }
        it -= I_OUTE;
        if (it < I_INO) { const int kb = it / 7, nb = it % 7;
            transpose_item(lds, DM, (bf16*)(ws + OFF_W_IN_O), kb * 64, nb * 128, 832, 0, p.w_in_o, nullptr, 832, nullptr); continue; }
        it -= I_INO;
        if (it < I_UQ) { const int kb = it / 12, nb = it % 12;
            transpose_item(lds, 512, (bf16*)(ws + OFF_W_UQ), kb * 64, nb * 128, 1536, 0, p.w_uq, nullptr, 1536, p.mla_q_norm); continue; }
        it -= I_UQ;
        if (it < I_UKV) { const int kb = it / 16, nb = it % 16;
            transpose_item(lds, 256, (bf16*)(ws + OFF_W_UKV), kb * 64, nb * 128, 2048, 0, p.w_ukv, nullptr, 2048, p.mla_kv_norm); continue; }
        it -= I_UKV;
        if (it < I_OUTO) { const int kb = it / 8, nb = it % 8;
            transpose_item(lds, DM, (bf16*)(ws + OFF_W_OUT_O), kb * 64, nb * 128, DM, 0, p.w_out_o, nullptr, DM, nullptr); continue; }
        it -= I_OUTO;
        { const int l = it / 16, kb = it % 16;
            transpose_item(lds, DM, (bf16*)(ws + OFF_W_RT) + (size_t)l * 128 * DM, kb * 64, 0, 64, 0, p.w_router + (size_t)l * DM * 64, nullptr, 64, nullptr); }
    }
}

__device__ __forceinline__ void load_row(const float* src, int lane, f32x4 (&v)[4]) {
#pragma unroll
    for (int j = 0; j < 4; ++j) v[j] = *(const f32x4*)(src + lane * 4 + 256 * j);
}
__device__ __forceinline__ float row_sumsq(const f32x4 (&v)[4]) {
    float s = 0.f;
#pragma unroll
    for (int j = 0; j < 4; ++j) s += v[j].x * v[j].x + v[j].y * v[j].y + v[j].z * v[j].z + v[j].w * v[j].w;
    return wave_sum(s);
}
__device__ __forceinline__ void modulate_store(const f32x4 (&v)[4], float rinv, const float* g, const float* sh, const float* sc, bf16* dst, int lane) {
#pragma unroll
    for (int j = 0; j < 4; ++j) {
        const int c = lane * 4 + 256 * j;
        const f32x4 gg = *(const f32x4*)(g + c), s1 = *(const f32x4*)(sc + c), s0 = *(const f32x4*)(sh + c);
        const f32x4 o = v[j] * rinv * gg * (s1 + 1.f) + s0;
        u32x2 w; w.x = pk2(o.x, o.y); w.y = pk2(o.z, o.w);
        *(u32x2*)(dst + c) = w;
    }
}
__device__ __forceinline__ const float* hl_src0(const Params& p, int r) { return r < TC ? p.ctx + (size_t)r * DM : p.x + (size_t)(r - TC) * DM; }
__device__ __forceinline__ float* hl_buf(const Params& p, int r) { return r < TC ? (float*)(p.ws + OFF_HC) + (size_t)r * DM : p.out + (size_t)(r - TC) * DM; }

__device__ __forceinline__ void ph_modulate0(const Params& p) {
    const int lane = threadIdx.x & 63, gw = blockIdx.x * 4 + (threadIdx.x >> 6), ngw = gridDim.x * 4;
    const float* mod = (const float*)(p.ws + OFF_MOD);
    bf16* U = (bf16*)(p.ws + OFF_U);
    for (int r = gw; r < TT; r += ngw) {
        f32x4 v[4]; load_row(hl_src0(p, r), lane, v);
        const float rinv = rsqrtf(row_sumsq(v) * (1.f / DM) + RMS_EPS);
        const float* mv = mod + (size_t)modvec(r) * 6144;
        modulate_store(v, rinv, p.g_mix_pre, mv, mv + 1024, U + (size_t)r * DM, lane);
    }
}

__device__ __forceinline__ void ph_rowpassA(const Params& p, int l, int row_lo, const float* Y) {
    const int lane = threadIdx.x & 63, gw = blockIdx.x * 4 + (threadIdx.x >> 6), ngw = gridDim.x * 4;
    const float* mod = (const float*)(p.ws + OFF_MOD) + (size_t)l * 3 * 6144;
    bf16* U = (bf16*)(p.ws + OFF_U);
    for (int r = row_lo + gw; r < TT; r += ngw) {
        f32x4 y[4], h[4];
        load_row(Y + (size_t)r * DM, lane, y);
        load_row(l == 0 ? hl_src0(p, r) : (const float*)hl_buf(p, r), lane, h);
        const float rinv = rsqrtf(row_sumsq(y) * (1.f / DM) + RMS_EPS);
        const float* mv = mod + (size_t)modvec(r) * 6144;
        float* hb = hl_buf(p, r);
#pragma unroll
        for (int j = 0; j < 4; ++j) {
            const int c = lane * 4 + 256 * j;
            const f32x4 gg = *(const f32x4*)(p.g_mix_post + l * DM + c), gt = *(const f32x4*)(mv + 2048 + c);
            h[j] = h[j] + gt * (y[j] * rinv * gg);
            *(f32x4*)(hb + c) = h[j];
        }
        const float rinv2 = rsqrtf(row_sumsq(h) * (1.f / DM) + RMS_EPS);
        modulate_store(h, rinv2, p.g_ffn_pre + l * DM, mv + 3072, mv + 4096, U + (size_t)r * DM, lane);
    }
}

constexpr int MOE_LDS_OFF = 65536;
__device__ __forceinline__ void moe_tables(const Params& p, LAS unsigned char* lds, int l, int row_lo) {
    LAS int* cnt = (LAS int*)(lds + MOE_LDS_OFF); LAS int* tp = cnt + 80; LAS int* sp = tp + 80;
    const int tid = threadIdx.x;
    if (tid < 64) cnt[tid] = ((const int*)(p.ws + OFF_CNT))[l * 64 + tid];
    if (tid == 64) cnt[64] = TT - row_lo;
    __syncthreads();
    if (tid == 0) {
        int a = 0, s = 0;
        for (int e = 0; e < 65; ++e) { tp[e] = a; sp[e] = s; a += (cnt[e] + 127) >> 7; s += cnt[e]; }
        tp[65] = a;
    }
    __syncthreads();
}

__device__ __forceinline__ void ph_rowpassB(const Params& p, LAS unsigned char* lds, int l, int row_lo) {
    moe_tables(p, lds, l, row_lo);
    LAS int* sp = (LAS int*)(lds + MOE_LDS_OFF) + 160;
    const int lane = threadIdx.x & 63, gw = blockIdx.x * 4 + (threadIdx.x >> 6), ngw = gridDim.x * 4;
    const float* mod = (const float*)(p.ws + OFF_MOD) + (size_t)l * 3 * 6144;
    const bf16* YR = (const bf16*)(p.ws + AM_YR);
    const int* tokslot = (const int*)(p.ws + OFF_TOKSLOT); const float* W8 = (const float*)(p.ws + OFF_W8);
    bf16* U = (bf16*)(p.ws + OFF_U);
    const int c0 = lane * 8;
    for (int r = row_lo + gw; r < TT; r += ngw) {
        int ts = 0; float wv = 0.f;
        if (lane < 8) { ts = tokslot[(size_t)r * 8 + lane]; wv = W8[(size_t)r * 8 + lane]; }
        const int myslot = sp[ts >> 20] + (ts & 0xfffff);
        float f[16];
#pragma unroll
        for (int i = 0; i < 16; ++i) f[i] = 0.f;
#pragma unroll
        for (int k = 0; k < 9; ++k) {
            size_t slot; float wk = 1.f;
            if (k < 8) { slot = (size_t)__shfl(myslot, k); wk = __shfl(wv, k); } else slot = (size_t)TT * 8 + r;
            const bf16* yr = YR + slot * DM + c0;
            const u32x4 a = *(const u32x4*)yr, b2 = *(const u32x4*)(yr + 512);
            f[0] += wk * bflo(a.x); f[1] += wk * bfhi(a.x); f[2] += wk * bflo(a.y); f[3] += wk * bfhi(a.y);
            f[4] += wk * bflo(a.z); f[5] += wk * bfhi(a.z); f[6] += wk * bflo(a.w); f[7] += wk * bfhi(a.w);
            f[8] += wk * bflo(b2.x); f[9] += wk * bfhi(b2.x); f[10] += wk * bflo(b2.y); f[11] += wk * bfhi(b2.y);
            f[12] += wk * bflo(b2.z); f[13] += wk * bfhi(b2.z); f[14] += wk * bflo(b2.w); f[15] += wk * bfhi(b2.w);
        }
        float ss = 0.f;
#pragma unroll
        for (int i = 0; i < 16; ++i) ss += f[i] * f[i];
        const float rinv = rsqrtf(wave_sum(ss) * (1.f / DM) + RMS_EPS);
        const float* mv = mod + (size_t)modvec(r) * 6144;
        float* hb = hl_buf(p, r);
        float h[16];
#pragma unroll
        for (int q = 0; q < 4; ++q) {
            const int c = c0 + (q & 1) * 4 + (q >> 1) * 512;
            const f32x4 hv = *(const f32x4*)(hb + c), gg = *(const f32x4*)(p.g_ffn_post + l * DM + c), gt = *(const f32x4*)(mv + 5120 + c);
            const f32x4 fv = {f[q * 4 + 0], f[q * 4 + 1], f[q * 4 + 2], f[q * 4 + 3]};
            const f32x4 o = hv + gt * (fv * rinv * gg);
            *(f32x4*)(hb + c) = o;
            h[q * 4 + 0] = o.x; h[q * 4 + 1] = o.y; h[q * 4 + 2] = o.z; h[q * 4 + 3] = o.w;
        }
        if (l == 0) {
            float s2 = 0.f;
#pragma unroll
            for (int i = 0; i < 16; ++i) s2 += h[i] * h[i];
            const float rinv2 = rsqrtf(wave_sum(s2) * (1.f / DM) + RMS_EPS);
            const float* mv1 = mv + 3 * 6144;
#pragma unroll
            for (int hf = 0; hf < 2; ++hf) {
                const int c = c0 + hf * 512;
                const f32x4 g0 = *(const f32x4*)(p.g_mix_pre + DM + c), g1 = *(const f32x4*)(p.g_mix_pre + DM + c + 4);
                const f32x4 sh0 = *(const f32x4*)(mv1 + c), sh1 = *(const f32x4*)(mv1 + c + 4), sc0 = *(const f32x4*)(mv1 + 1024 + c), sc1 = *(const f32x4*)(mv1 + 1024 + c + 4);
                const f32x4 h0 = {h[hf * 8 + 0], h[hf * 8 + 1], h[hf * 8 + 2], h[hf * 8 + 3]}, h1 = {h[hf * 8 + 4], h[hf * 8 + 5], h[hf * 8 + 6], h[hf * 8 + 7]};
                const f32x4 o0 = h0 * rinv2 * g0 * (sc0 + 1.f) + sh0, o1 = h1 * rinv2 * g1 * (sc1 + 1.f) + sh1;
                *(u32x4*)(U + (size_t)r * DM + c) = (u32x4){pk2(o0.x, o0.y), pk2(o0.z, o0.w), pk2(o1.x, o1.y), pk2(o1.z, o1.w)};
            }
        }
    }
}

__device__ __forceinline__ int stg_col() { const int tid = threadIdx.x; return ((tid & 7) ^ ((tid >> 3) & 7)) * 8; }
__device__ __forceinline__ void plain_ptrs(const bf16* base, int row0, int ld, const bf16* (&pp)[4]) {
    const int tid = threadIdx.x;
    pp[0] = base + (size_t)(row0 + (tid >> 3)) * ld + stg_col();
#pragma unroll
    for (int i = 1; i < 4; ++i) pp[i] = pp[0] + (size_t)(32 * i) * ld;
}

__device__ __forceinline__ void ph_inproj0(const Params& p, LAS unsigned char* lds) {
    unsigned char* ws = p.ws;
    const bf16* U = (const bf16*)(ws + OFF_U); const bf16* W = (const bf16*)(ws + OFF_W_IN_E);
    bf16* Z0 = (bf16*)(ws + A0_Z0); bf16* VGT = (bf16*)(ws + A0_VGT); bf16* QS = (bf16*)(ws + A0_QS); bf16* KS = (bf16*)(ws + A0_KS); bf16* VST = (bf16*)(ws + A0_VST);
    const f32x2* rope = (const f32x2*)(ws + OFF_ROPE);
    const int tid = threadIdx.x, lane = tid & 63, wid = tid >> 6, wr = wid >> 1, wc = wid & 1, fr = lane & 15, fq = lane >> 4;
    constexpr int NTN = 19, NTM = TT / 128;
    auto make = [&](int t, GPtrs& g, int& nk) { int tm, tn; tile_mn(t, NTM, NTN, tm, tn); plain_ptrs(U, tm * 128, DM, g.a); plain_ptrs(W, tn * 128, DM, g.b); nk = DM / 64; };
    auto epi = [&](int t, f32x4 (&acc)[4][4]) {
        int tm, tn; tile_mn(t, NTM, NTN, tm, tn); const int brow = tm * 128, bcol = tn * 128;
        const int cb = bcol + wc * 64;
        LAS unsigned char* wl = lds + 32768 + wid * 8192;
        const int r0 = brow + wr * 64;
        const RowInfo ri0 = rowinfo(r0);
        if (cb < 1024) {
            epi_store_rows(wl, acc, fr, fq, lane, [&](int row) { return Z0 + (size_t)(r0 + row) * Z0P + cb; });
        } else if (cb < 1536) {
            const int c0 = cb - 1024;
            epi_store_cols(wl, acc, fr, fq, lane, [&](int col) { return VGT + (size_t)(c0 + col) * TT + r0; });
        } else if (cb < 2176) {
            const float sc = cb < 2048 ? 0.125f * LOG2E : 1.f;
#pragma unroll
            for (int m = 0; m < 4; ++m) {
                const int pos = ri0.pos + m * 16 + fr;
#pragma unroll
                for (int n = 0; n < 2; ++n)
#pragma unroll
                    for (int j = 0; j < 4; ++j) {
                        const float x1 = acc[m][n][j] * sc, x2 = acc[m][n + 2][j] * sc;
                        if (ri0.lat) { const f32x2 cs = rope[(size_t)pos * 32 + n * 16 + fq * 4 + j]; acc[m][n][j] = x1 * cs.x - x2 * cs.y; acc[m][n + 2][j] = x2 * cs.x + x1 * cs.y; }
                        else { acc[m][n][j] = x1; acc[m][n + 2][j] = x2; }
                    }
                asm volatile("" ::: "memory");
            }
            bf16* dst;
            if (cb < 2048) { const int h = (cb - 1536) >> 6; dst = QS + ((size_t)(ri0.b * 8 + h) * NKEY + ri0.kq) * 64; }
            else { const int h = (cb - 2048) >> 6; dst = KS + ((size_t)(ri0.b * 2 + h) * NKEY + ri0.kq) * 64; }
            epi_store_rows(wl, acc, fr, fq, lane, [&](int row) { return dst + (size_t)row * 64; });
        } else if (cb < 2304) {
            const int h = (cb - 2176) >> 6;
            bf16* dst = VST + (size_t)(ri0.b * 2 + h) * 64 * NKEY + ri0.kq;
            epi_store_cols(wl, acc, fr, fq, lane, [&](int col) { return dst + (size_t)col * NKEY; });
        } else if (cb == 2304) {
#pragma unroll
            for (int m = 0; m < 4; ++m) {
                const int r = r0 + m * 16 + fr;
#pragma unroll
                for (int n = 0; n < 2; ++n) { u32x2 w; w.x = pk2(acc[m][n][0], acc[m][n][1]); w.y = pk2(acc[m][n][2], acc[m][n][3]); *(u32x2*)(Z0 + (size_t)r * Z0P + 1024 + n * 16 + fq * 4) = w; }
            }
        }
    };
    gemm_tiles<true>(lds, vcu_id(), NTM * NTN, gridDim.x, make, epi);
}

__device__ __forceinline__ void ph_outproj(const Params& p, LAS unsigned char* lds, const bf16* MIX, const bf16* W, float* Y, int row_lo) {
    const int tid = threadIdx.x, lane = tid & 63, wid = tid >> 6, wr = wid >> 1, wc = wid & 1, fr = lane & 15, fq = lane >> 4;
    const int tm0 = row_lo / 128, ntm = TT / 128 - tm0;
    auto make = [&](int t, GPtrs& g, int& nk) { int tm, tn; tile_mn(t, ntm, 8, tm, tn); plain_ptrs(MIX, (tm0 + tm) * 128, DM, g.a); plain_ptrs(W, tn * 128, DM, g.b); nk = DM / 64; };
    auto epi = [&](int t, f32x4 (&acc)[4][4]) {
        int tm, tn; tile_mn(t, ntm, 8, tm, tn); tm += tm0; const int brow = tm * 128, bcol = tn * 128;
#pragma unroll
        for (int m = 0; m < 4; ++m) {
            const int r = brow + wr * 64 + m * 16 + fr;
#pragma unroll
            for (int n = 0; n < 4; ++n) *(f32x4*)(Y + (size_t)r * DM + bcol + wc * 64 + n * 16 + fq * 4) = acc[m][n];
        }
    };
    gemm_tiles<true>(lds, vcu_id(), ntm * 8, gridDim.x, make, epi);
}

template <int DQK, int DV>
__device__ __forceinline__ void attn_item(LAS unsigned char* lds, const bf16* Qg, const bf16* Kg, const bf16* VTg, int a1, int b0, int b1, int qpos0,
                                          float m_init, float l_init, bf16* Og, int o_pitch) {
    constexpr int KP = (DQK + 8) * 2, VP = 144, NS = DQK / 16, NDV = DV / 32, KCH = DQK / 8;
    const int tid = threadIdx.x, lane = tid & 63, wid = tid >> 6, ql = lane & 31, hi = lane >> 5;
    bf16x8 qf[NS];
    {
        const bf16* qrow = Qg + (size_t)(wid * 32 + ql) * DQK + hi * 8;
#pragma unroll
        for (int s = 0; s < NS; ++s) qf[s] = *(const bf16x8*)(qrow + s * 16);
    }
    f32x16 o[NDV];
#pragma unroll
    for (int d = 0; d < NDV; ++d)
#pragma unroll
        for (int r = 0; r < 16; ++r) o[d][r] = 0.f;
    float mrun = m_init, lrun = l_init;
    const int ntot = a1 + (b1 - b0);
    LAS unsigned char* Ks = lds; LAS unsigned char* Vs = lds + 64 * KP;
    constexpr int KN = KCH / 4, VN = DV / 32;
    u32x4 kreg[KN], vreg[VN];
    const bf16* kgp = Kg + (size_t)(tid >> 2) * DQK + (tid & 3) * 8;
    const bf16* vgp = VTg + (size_t)(tid >> 3) * NKEY + (tid & 7) * 8;
    LAS unsigned char* ksp = Ks + (tid >> 2) * KP + (tid & 3) * 16;
    LAS unsigned char* vsp = Vs + (tid >> 3) * VP + ((tid & 7) >> 1) * 32 + (tid & 1) * 8;
#define ATTN_LOAD(kt_) do { \
        _Pragma("unroll") for (int i_ = 0; i_ < KN; ++i_) kreg[i_] = *(const u32x4*)(kgp + (size_t)(kt_) * 64 * DQK + i_ * 32); \
        _Pragma("unroll") for (int i_ = 0; i_ < VN; ++i_) vreg[i_] = *(const u32x4*)(vgp + (size_t)(i_ * 32) * NKEY + (kt_) * 64); } while (0)
    ATTN_LOAD(a1 > 0 ? 0 : b0);
    for (int it = 0; it < ntot; ++it) {
        const int kt = it < a1 ? it : b0 + (it - a1);
        const bool masked = it >= a1;
        __syncthreads();
#pragma unroll
        for (int i = 0; i < KN; ++i) *(LAS u32x4*)(ksp + i * 64) = kreg[i];
#pragma unroll
        for (int i = 0; i < VN; ++i) { LAS u32x2* d = (LAS u32x2*)(vsp + i * 32 * VP); d[0] = (u32x2){vreg[i].x, vreg[i].y}; d[2] = (u32x2){vreg[i].z, vreg[i].w}; }
        __syncthreads();
        __builtin_amdgcn_iglp_opt(0);
        if (it + 1 < ntot) { const int ktn = (it + 1) < a1 ? (it + 1) : b0 + (it + 1 - a1); ATTN_LOAD(ktn); }
        f32x16 p0, p1;
#pragma unroll
        for (int r = 0; r < 16; ++r) { p0[r] = 0.f; p1[r] = 0.f; }
#pragma unroll
        for (int s = 0; s < NS; ++s) {
            const bf16x8 k0 = *(const LAS bf16x8*)(Ks + ql * KP + (s * 16 + hi * 8) * 2);
            const bf16x8 k1 = *(const LAS bf16x8*)(Ks + (32 + ql) * KP + (s * 16 + hi * 8) * 2);
            p0 = __builtin_amdgcn_mfma_f32_32x32x16_bf16(k0, qf[s], p0, 0, 0, 0);
            p1 = __builtin_amdgcn_mfma_f32_32x32x16_bf16(k1, qf[s], p1, 0, 0, 0);
        }
        if (masked) {
            const int kbase = kt * 64 - CTX, qpos = qpos0 + wid * 32 + ql;
#pragma unroll
            for (int r = 0; r < 16; ++r) {
                const int d0 = qpos - (kbase + crow(r, hi)), d1 = d0 - 32;
                if (d0 > 128 || d0 < -128) p0[r] = -1e30f;
                if (d1 > 128 || d1 < -128) p1[r] = -1e30f;
            }
        }
        float mx = p0[0];
#pragma unroll
        for (int r = 1; r < 16; ++r) mx = fmaxf(mx, p0[r]);
#pragma unroll
        for (int r = 0; r < 16; ++r) mx = fmaxf(mx, p1[r]);
        mx = fmaxf(mx, __shfl_xor(mx, 32));
        if (__any(mx > mrun + 8.f)) {
            const float mn = fmaxf(mrun, mx), alpha = ex2(mrun - mn);
            mrun = mn; lrun *= alpha;
#pragma unroll
            for (int d = 0; d < NDV; ++d)
#pragma unroll
                for (int r = 0; r < 16; ++r) o[d][r] *= alpha;
        }
        float rs = 0.f;
#pragma unroll
        for (int r = 0; r < 16; ++r) { p0[r] = ex2(p0[r] - mrun); rs += p0[r]; }
#pragma unroll
        for (int r = 0; r < 16; ++r) { p1[r] = ex2(p1[r] - mrun); rs += p1[r]; }
        rs += __shfl_xor(rs, 32);
        lrun += rs;
        bf16x8 pf[4];
        { u32x4 w;
          w.x = pk2(p0[0], p0[1]); w.y = pk2(p0[2], p0[3]); w.z = pk2(p0[4], p0[5]); w.w = pk2(p0[6], p0[7]); pf[0] = mk8(w);
          w.x = pk2(p0[8], p0[9]); w.y = pk2(p0[10], p0[11]); w.z = pk2(p0[12], p0[13]); w.w = pk2(p0[14], p0[15]); pf[1] = mk8(w);
          w.x = pk2(p1[0], p1[1]); w.y = pk2(p1[2], p1[3]); w.z = pk2(p1[4], p1[5]); w.w = pk2(p1[6], p1[7]); pf[2] = mk8(w);
          w.x = pk2(p1[8], p1[9]); w.y = pk2(p1[10], p1[11]); w.z = pk2(p1[12], p1[13]); w.w = pk2(p1[14], p1[15]); pf[3] = mk8(w); }
#pragma unroll
        for (int d = 0; d < NDV; ++d) {
#pragma unroll
            for (int kk = 0; kk < 4; ++kk) {
                const bf16x8 vf = *(const LAS bf16x8*)(Vs + (d * 32 + ql) * VP + kk * 32 + hi * 16);
                o[d] = __builtin_amdgcn_mfma_f32_32x32x16_bf16(vf, pf[kk], o[d], 0, 0, 0);
            }
        }
    }
#undef ATTN_LOAD
    const float inv = 1.f / lrun;
    bf16* orow = Og + (size_t)(wid * 32 + ql) * o_pitch;
#pragma unroll
    for (int d = 0; d < NDV; ++d)
#pragma unroll
        for (int g = 0; g < 4; ++g) {
            u32x2 w; w.x = pk2(o[d][g * 4 + 0] * inv, o[d][g * 4 + 1] * inv); w.y = pk2(o[d][g * 4 + 2] * inv, o[d][g * 4 + 3] * inv);
            *(u32x2*)(orow + d * 32 + 8 * g + 4 * hi) = w;
        }
}

constexpr int GA_CUM = 0, GA_ALOW = 16384, GA_WA = 20480, GA_BA = 24576, GA_QT = 24832, GA_TOT = 25856, GA_END = 26112;
__device__ __forceinline__ void gla_cum(const Params& p, LAS unsigned char* lds, const bf16* Z0, int r0, int h, int dir) {
    const int tid = threadIdx.x;
    LAS float* cum = (LAS float*)(lds + GA_CUM); LAS float* alow = (LAS float*)(lds + GA_ALOW); LAS float* wa = (LAS float*)(lds + GA_WA);
    LAS float* ba = (LAS float*)(lds + GA_BA); LAS float* qt = (LAS float*)(lds + GA_QT); LAS float* tot = (LAS float*)(lds + GA_TOT);
    {
        const int t = tid >> 2, i4 = (tid & 3) * 4;
        const u32x2 w = *(const u32x2*)(Z0 + (size_t)(r0 + t) * Z0P + 1024 + dir * 16 + i4);
        alow[t * 16 + i4 + 0] = bflo(w.x); alow[t * 16 + i4 + 1] = bfhi(w.x); alow[t * 16 + i4 + 2] = bflo(w.y); alow[t * 16 + i4 + 3] = bfhi(w.y);
#pragma unroll
        for (int q = 0; q < 4; ++q) { const int idx = tid * 4 + q, i = idx >> 6, j = idx & 63; wa[idx] = p.gla_wa2[(size_t)(dir * 16 + i) * 256 + h * 64 + j]; }
        if (tid < 64) ba[tid] = p.gla_ba[dir * 256 + h * 64 + tid];
    }
    __syncthreads();
    const int j = tid & 63, tq = tid >> 6;
    float la[16], wj[16];
#pragma unroll
    for (int i = 0; i < 16; ++i) wj[i] = wa[i * 64 + j];
    const float bj = ba[j];
#pragma unroll
    for (int tt = 0; tt < 16; ++tt) {
        const int t = tq * 16 + tt;
        float x = bj;
#pragma unroll
        for (int q = 0; q < 4; ++q) { const f32x4 a = *(const LAS f32x4*)(alow + t * 16 + q * 4);
            x += a.x * wj[q * 4] + a.y * wj[q * 4 + 1] + a.z * wj[q * 4 + 2] + a.w * wj[q * 4 + 3]; }
        la[tt] = (fminf(x, 0.f) - __logf(1.f + __expf(-fabsf(x)))) * (1.f / 16.f);
    }
    float run = 0.f;
    if (dir == 0) {
#pragma unroll
        for (int tt = 0; tt < 16; ++tt) { run += la[tt]; cum[(tq * 16 + tt) * 64 + j] = run; }
    } else {
#pragma unroll
        for (int tt = 15; tt >= 0; --tt) { run += la[tt]; cum[(tq * 16 + tt) * 64 + j] = run; }
    }
    qt[tq * 64 + j] = run;
    __syncthreads();
    float off = 0.f, total = 0.f;
#pragma unroll
    for (int q = 0; q < 4; ++q) { const float v = qt[q * 64 + j]; total += v; if (dir == 0 ? (q < tq) : (q > tq)) off += v; }
#pragma unroll
    for (int tt = 0; tt < 16; ++tt) cum[(tq * 16 + tt) * 64 + j] += off;
    if (tq == 0) tot[j] = total;
    __syncthreads();
}

__device__ __forceinline__ int gla_row0(int b, int cc) { return cc < 4 ? b * CTX + cc * 64 : TC + b * SEQ + (cc - 4) * 64; }
__device__ __forceinline__ int gla_step(int cc, int dir) { return dir == 0 ? cc : (cc < 4 ? 3 - cc : 4 + (131 - cc)); }

__device__ __forceinline__ void gla_g1_item(const Params& p, LAS unsigned char* lds, int item) {
    unsigned char* ws = p.ws;
    const bf16* Z0 = (const bf16*)(ws + A0_Z0); const bf16* VGT = (const bf16*)(ws + A0_VGT);
    bf16* GS = (bf16*)(ws + A0_GS); float* GD = (float*)(ws + A0_GD);
    const int cc = item % NSTEP, rest = item / NSTEP, dir = rest & 1, h = (rest >> 1) & 3, b = rest >> 3;
    const int r0 = gla_row0(b, cc), step = gla_step(cc, dir), chain = (b * 4 + h) * 2 + dir;
    const int tid = threadIdx.x, lane = tid & 63, wid = tid >> 6, fr = lane & 15, fq = lane >> 4;
    __syncthreads();
    gla_cum(p, lds, Z0, r0, h, dir);
    LAS float* cum = (LAS float*)(lds + GA_CUM); LAS float* tot = (LAS float*)(lds + GA_TOT);
    LAS bf16* KT = (LAS bf16*)(lds + GA_END);
    {
        const int t = tid >> 2, d0 = (tid & 3) * 16;
        const u32x4 w0 = *(const u32x4*)(Z0 + (size_t)(r0 + t) * Z0P + 256 + h * 64 + d0), w1 = *(const u32x4*)(Z0 + (size_t)(r0 + t) * Z0P + 256 + h * 64 + d0 + 8);
        const unsigned ww[8] = {w0.x, w0.y, w0.z, w0.w, w1.x, w1.y, w1.z, w1.w};
#pragma unroll
        for (int i = 0; i < 8; ++i) {
            const int d = d0 + 2 * i;
            KT[d * 72 + t] = f2bf(bflo(ww[i]) * __expf(tot[d] - cum[t * 64 + d]));
            KT[(d + 1) * 72 + t] = f2bf(bfhi(ww[i]) * __expf(tot[d + 1] - cum[t * 64 + d + 1]));
        }
    }
    if (tid < 64) GD[((size_t)chain * NSTEP + step) * 64 + tid] = __expf(tot[tid]);
    __syncthreads();
    f32x4 acc[2][4];
#pragma unroll
    for (int m = 0; m < 2; ++m)
#pragma unroll
        for (int n = 0; n < 4; ++n) acc[m][n] = (f32x4){0.f, 0.f, 0.f, 0.f};
#pragma unroll
    for (int ks = 0; ks < 2; ++ks) {
        bf16x8 af[2], bfr[4];
#pragma unroll
        for (int m = 0; m < 2; ++m) af[m] = *(const bf16x8*)(VGT + (size_t)(h * 128 + wid * 32 + m * 16 + fr) * TT + r0 + ks * 32 + fq * 8);
#pragma unroll
        for (int n = 0; n < 4; ++n) bfr[n] = *(const LAS bf16x8*)(KT + (n * 16 + fr) * 72 + ks * 32 + fq * 8);
#pragma unroll
        for (int m = 0; m < 2; ++m)
#pragma unroll
            for (int n = 0; n < 4; ++n) acc[m][n] = __builtin_amdgcn_mfma_f32_16x16x32_bf16(bfr[n], af[m], acc[m][n], 0, 0, 0);
    }
    bf16* dst = GS + ((size_t)chain * NSTEP + step) * 8192;
#pragma unroll
    for (int m = 0; m < 2; ++m)
#pragma unroll
        for (int n = 0; n < 4; ++n) *(u32x2*)(dst + (size_t)(wid * 32 + m * 16 + fr) * 64 + n * 16 + fq * 4) = (u32x2){pk2(acc[m][n][0], acc[m][n][1]), pk2(acc[m][n][2], acc[m][n][3])};
}

__device__ __forceinline__ void ph_gla_scan(const Params& p) {
    unsigned* GS = (unsigned*)(p.ws + A0_GS); const float* GD = (const float*)(p.ws + A0_GD);
    for (int idx = blockIdx.x * 256 + threadIdx.x; idx < 16 * 4096; idx += gridDim.x * 256) {
        const int chain = idx >> 12, e2 = idx & 4095, dk = (e2 & 31) * 2;
        unsigned* g = GS + (size_t)chain * NSTEP * 4096 + e2;
        const f32x2* d = (const f32x2*)(GD + (size_t)chain * NSTEP * 64 + dk);
        float s0 = 0.f, s1 = 0.f;
#pragma unroll 12
        for (int s = 0; s < NSTEP; ++s) {
            const unsigned t = g[(size_t)s * 4096]; const f32x2 dec = d[s * 32];
            g[(size_t)s * 4096] = pk2(s0, s1);
            s0 = dec.x * s0 + bflo(t); s1 = dec.y * s1 + bfhi(t);
        }
    }
}

__device__ __forceinline__ void gla_g3_item(const Params& p, LAS unsigned char* lds, int item) {
    unsigned char* ws = p.ws;
    const bf16* Z0 = (const bf16*)(ws + A0_Z0); const bf16* VGT = (const bf16*)(ws + A0_VGT);
    const bf16* GS = (const bf16*)(ws + A0_GS); bf16* MIX = (bf16*)(ws + A0_MIX);
    const int cc = item % NSTEP, rest = item / NSTEP, h = rest & 3, b = rest >> 2;
    const int r0 = gla_row0(b, cc);
    const int tid = threadIdx.x, lane = tid & 63, wid = tid >> 6, fr = lane & 15, fq = lane >> 4;
    LAS bf16* QT = (LAS bf16*)(lds + GA_END);
    LAS bf16* QI = (LAS bf16*)(lds + GA_END + 9216);
    LAS bf16* KT = (LAS bf16*)(lds + GA_END + 18432);
    LAS bf16* PP = (LAS bf16*)(lds);
    f32x4 o[4][2];
#pragma unroll
    for (int m = 0; m < 4; ++m)
#pragma unroll
        for (int n = 0; n < 2; ++n) o[m][n] = (f32x4){0.f, 0.f, 0.f, 0.f};
    for (int dir = 0; dir < 2; ++dir) {
        const int step = gla_step(cc, dir), chain = (b * 4 + h) * 2 + dir;
        __syncthreads();
        gla_cum(p, lds, Z0, r0, h, dir);
        LAS float* cum = (LAS float*)(lds + GA_CUM); LAS float* tot = (LAS float*)(lds + GA_TOT);
        {
            const int t = tid >> 2, d0 = (tid & 3) * 16;
            const bf16* zr = Z0 + (size_t)(r0 + t) * Z0P + h * 64 + d0;
            const u32x4 q0 = *(const u32x4*)(zr), q1 = *(const u32x4*)(zr + 8), k0 = *(const u32x4*)(zr + 256), k1 = *(const u32x4*)(zr + 264);
            const unsigned qq[8] = {q0.x, q0.y, q0.z, q0.w, q1.x, q1.y, q1.z, q1.w}, kk[8] = {k0.x, k0.y, k0.z, k0.w, k1.x, k1.y, k1.z, k1.w};
            unsigned oqt[8], oqi[8], okt[8];
#pragma unroll
            for (int i = 0; i < 8; ++i) {
                const int d = d0 + 2 * i;
                const float c0 = cum[t * 64 + d], c1 = cum[t * 64 + d + 1], t0 = tot[d], t1 = tot[d + 1];
                const float qa = bflo(qq[i]), qb = bfhi(qq[i]), ka = bflo(kk[i]), kb = bfhi(kk[i]);
                oqt[i] = pk2(qa * __expf(c0 - t0), qb * __expf(c1 - t1));
                oqi[i] = pk2(qa * __expf(c0), qb * __expf(c1));
                okt[i] = pk2(ka * __expf(t0 - c0), kb * __expf(t1 - c1));
            }
            *(LAS u32x4*)(QT + t * 72 + d0) = (u32x4){oqt[0], oqt[1], oqt[2], oqt[3]}; *(LAS u32x4*)(QT + t * 72 + d0 + 8) = (u32x4){oqt[4], oqt[5], oqt[6], oqt[7]};
            *(LAS u32x4*)(QI + t * 72 + d0) = (u32x4){oqi[0], oqi[1], oqi[2], oqi[3]}; *(LAS u32x4*)(QI + t * 72 + d0 + 8) = (u32x4){oqi[4], oqi[5], oqi[6], oqi[7]};
            *(LAS u32x4*)(KT + t * 72 + d0) = (u32x4){okt[0], okt[1], okt[2], okt[3]}; *(LAS u32x4*)(KT + t * 72 + d0 + 8) = (u32x4){okt[4], okt[5], okt[6], okt[7]};
        }
        __syncthreads();
        {
            f32x4 sa[4];
#pragma unroll
            for (int m = 0; m < 4; ++m) sa[m] = (f32x4){0.f, 0.f, 0.f, 0.f};
#pragma unroll
            for (int ks = 0; ks < 2; ++ks) {
                const bf16x8 kf = *(const LAS bf16x8*)(KT + (wid * 16 + fr) * 72 + ks * 32 + fq * 8);
#pragma unroll
                for (int m = 0; m < 4; ++m) {
                    const bf16x8 qfm = *(const LAS bf16x8*)(QT + (m * 16 + fr) * 72 + ks * 32 + fq * 8);
                    sa[m] = __builtin_amdgcn_mfma_f32_16x16x32_bf16(kf, qfm, sa[m], 0, 0, 0);
                }
            }
#pragma unroll
            for (int m = 0; m < 4; ++m) {
                const int t = m * 16 + fr;
                float v[4];
#pragma unroll
                for (int jj = 0; jj < 4; ++jj) { const int j = wid * 16 + fq * 4 + jj; const bool keep = dir == 0 ? (j <= t) : (j >= t); v[jj] = keep ? sa[m][jj] : 0.f; }
                *(LAS u32x2*)(PP + t * 72 + wid * 16 + fq * 4) = (u32x2){pk2(v[0], v[1]), pk2(v[2], v[3])};
            }
        }
        __syncthreads();
        const bf16* Sg = GS + ((size_t)chain * NSTEP + step) * 8192;
#pragma unroll
        for (int ks = 0; ks < 2; ++ks) {
            bf16x8 vfr[2], sfr[2];
#pragma unroll
            for (int n = 0; n < 2; ++n) {
                const int dv = wid * 32 + n * 16 + fr;
                vfr[n] = *(const bf16x8*)(VGT + (size_t)(h * 128 + dv) * TT + r0 + ks * 32 + fq * 8);
                sfr[n] = *(const bf16x8*)(Sg + (size_t)dv * 64 + ks * 32 + fq * 8);
            }
#pragma unroll
            for (int m = 0; m < 4; ++m) {
                const bf16x8 pfm = *(const LAS bf16x8*)(PP + (m * 16 + fr) * 72 + ks * 32 + fq * 8);
                const bf16x8 qim = *(const LAS bf16x8*)(QI + (m * 16 + fr) * 72 + ks * 32 + fq * 8);
#pragma unroll
                for (int n = 0; n < 2; ++n) {
                    o[m][n] = __builtin_amdgcn_mfma_f32_16x16x32_bf16(vfr[n], pfm, o[m][n], 0, 0, 0);
                    o[m][n] = __builtin_amdgcn_mfma_f32_16x16x32_bf16(sfr[n], qim, o[m][n], 0, 0, 0);
                }
            }
        }
    }
    __syncthreads();
    LAS float* red = (LAS float*)(lds + GA_END + 27648);
#pragma unroll
    for (int m = 0; m < 4; ++m) {
        float s = 0.f;
#pragma unroll
        for (int n = 0; n < 2; ++n)
#pragma unroll
            for (int j = 0; j < 4; ++j) s += o[m][n][j] * o[m][n][j];
        s += __shfl_xor(s, 16); s += __shfl_xor(s, 32);
        if (fq == 0) red[wid * 64 + m * 16 + fr] = s;
    }
    __syncthreads();
#pragma unroll
    for (int m = 0; m < 4; ++m) {
        const int t = m * 16 + fr;
        const float ss = red[t] + red[64 + t] + red[128 + t] + red[192 + t];
        const float rinv = rsqrtf(ss * (1.f / 128.f) + RMS_EPS);
        const int r = r0 + t;
#pragma unroll
        for (int n = 0; n < 2; ++n) {
            const int dv = wid * 32 + n * 16 + fq * 4;
            const u32x2 gw = *(const u32x2*)(Z0 + (size_t)r * Z0P + 512 + h * 128 + dv);
            const f32x4 ng = *(const f32x4*)(p.gla_norm + dv);
            const float g0 = bflo(gw.x), g1 = bfhi(gw.x), g2 = bflo(gw.y), g3 = bfhi(gw.y);
            const float y0 = o[m][n][0] * rinv * ng.x * siluf(g0), y1 = o[m][n][1] * rinv * ng.y * siluf(g1);
            const float y2 = o[m][n][2] * rinv * ng.z * siluf(g2), y3 = o[m][n][3] * rinv * ng.w * siluf(g3);
            *(u32x2*)(MIX + (size_t)r * DM + h * 128 + dv) = (u32x2){pk2(y0, y1), pk2(y2, y3)};
        }
    }
}

__device__ __forceinline__ void ph_swa_g1(const Params& p, LAS unsigned char* lds) {
    unsigned char* ws = p.ws;
    const bf16* QS = (const bf16*)(ws + A0_QS); const bf16* KS = (const bf16*)(ws + A0_KS); const bf16* VST = (const bf16*)(ws + A0_VST); bf16* MIX = (bf16*)(ws + A0_MIX);
    constexpr int N_SWA = 2 * 8 * 66, N_G1 = 2 * 4 * 2 * NSTEP;
    for (int item = blockIdx.x; item < N_SWA + N_G1; item += gridDim.x) {
        if (item < N_SWA) {
            const int qt = item % 66, rest = item / 66, h = rest & 7, b = rest >> 3, kvh = h >> 2;
            const bf16* Qg = QS + ((size_t)(b * 8 + h) * NKEY + qt * 128) * 64;
            const bf16* Kg = KS + (size_t)(b * 2 + kvh) * NKEY * 64;
            const bf16* Vg = VST + (size_t)(b * 2 + kvh) * 64 * NKEY;
            int b0 = 0, b1 = 0, qpos0 = 0, row0;
            if (qt >= 2) { qpos0 = (qt - 2) * 128; const int lo = qpos0 - 128 < 0 ? 0 : qpos0 - 128, hi2 = qpos0 + 256 > SEQ ? SEQ : qpos0 + 256; b0 = 4 + lo / 64; b1 = 4 + hi2 / 64; row0 = TC + b * SEQ + qpos0; }
            else row0 = b * CTX + qt * 128;
            const float sink = p.swa_sink[h] * LOG2E;
            attn_item<64, 64>(lds, Qg, Kg, Vg, 4, b0, b1, qpos0, sink, 1.f, MIX + (size_t)row0 * DM + 512 + h * 64, DM);
        } else gla_g1_item(p, lds, item - N_SWA);
    }
}
__device__ __forceinline__ void ph_gla_g3(const Params& p, LAS unsigned char* lds) {
    for (int item = blockIdx.x; item < 2 * 4 * NSTEP; item += gridDim.x) gla_g3_item(p, lds, item);
}

__device__ __forceinline__ void ph_router(const Params& p, LAS unsigned char* lds, int l, int row_lo) {
    unsigned char* ws = p.ws;
    const bf16* U = (const bf16*)(ws + OFF_U); const bf16* W = (const bf16*)(ws + OFF_W_RT) + (size_t)l * 128 * DM;
    int* cntg = (int*)(ws + OFF_CNT) + l * 64; int* tokslot = (int*)(ws + OFF_TOKSLOT); float* W8 = (float*)(ws + OFF_W8); int* LIST = (int*)(ws + OFF_LIST);
    const int tid = threadIdx.x, lane = tid & 63, wid = tid >> 6, wr = wid >> 1, wc = wid & 1, fr = lane & 15, fq = lane >> 4;
    LAS float* lg = (LAS float*)lds;
    const int tm0 = row_lo / 128;
    auto make = [&](int tm, GPtrs& g, int& nk) { plain_ptrs(U, tm * 128, DM, g.a); plain_ptrs(W, 0, DM, g.b); nk = DM / 64; };
    auto epi = [&](int tm, f32x4 (&acc)[4][4]) {
        const int brow = tm * 128;
        if (wc == 0) {
#pragma unroll
            for (int m = 0; m < 4; ++m)
#pragma unroll
                for (int n = 0; n < 4; ++n)
#pragma unroll
                    for (int j = 0; j < 4; ++j) lg[(wr * 64 + m * 16 + fr) * 65 + n * 16 + fq * 4 + j] = acc[m][n][j];
        }
        __syncthreads();
        LAS float* biasl = (LAS float*)(lds + 34816); LAS int* hist = (LAS int*)(lds + 34816 + 256); LAS int* basel = (LAS int*)(lds + 34816 + 512);
        if (tid < 64) { biasl[tid] = p.b_router[l * 64 + tid]; hist[tid] = 0; }
        __syncthreads();
        int esel[8], lrank[8]; float ssel[8]; float wsum = 0.f;
        if (tid < 128) {
            LAS float* L = lg + tid * 65;
            float gs[8];
#pragma unroll
            for (int g = 0; g < 8; ++g) {
                float m1 = -INFINITY, m2 = -INFINITY;
#pragma unroll
                for (int j = 0; j < 8; ++j) {
                    const int e = g * 8 + j;
                    const float sel = 1.f / (1.f + expf(-L[e])) + biasl[e];
                    L[e] = sel;
                    if (sel > m1) { m2 = m1; m1 = sel; } else if (sel > m2) m2 = sel;
                }
                gs[g] = m1 + m2;
            }
            unsigned allowed = 0u;
#pragma unroll
            for (int g = 0; g < 8; ++g) {
                int rk = 0;
#pragma unroll
                for (int h = 0; h < 8; ++h) rk += (gs[h] > gs[g] || (gs[h] == gs[g] && h < g)) ? 1 : 0;
                if (rk < 4) allowed |= 1u << g;
            }
#pragma unroll
            for (int k = 0; k < 8; ++k) {
                float best = -INFINITY; int bi = 0;
#pragma unroll
                for (int g = 0; g < 8; ++g) {
                    if ((allowed >> g) & 1u) {
#pragma unroll
                        for (int j = 0; j < 8; ++j) { const float v = L[g * 8 + j]; if (v > best) { best = v; bi = g * 8 + j; } }
                    }
                }
                esel[k] = bi; ssel[k] = best - biasl[bi]; wsum += ssel[k]; L[bi] = -INFINITY;
            }
#pragma unroll
            for (int k = 0; k < 8; ++k) lrank[k] = __hip_atomic_fetch_add(hist + esel[k], 1, __ATOMIC_RELAXED, __HIP_MEMORY_SCOPE_WORKGROUP);
        }
        __syncthreads();
        if (tid < 64) { const int c = hist[tid]; basel[tid] = c > 0 ? atomicAdd(cntg + tid, c) : 0; }
        __syncthreads();
        if (tid < 128) {
            const int t = brow + tid; const float wn = 2.5f / wsum;
#pragma unroll
            for (int k = 0; k < 8; ++k) {
                const int e = esel[k], pos = basel[e] + lrank[k];
                tokslot[(size_t)t * 8 + k] = (e << 20) | pos;
                W8[(size_t)t * 8 + k] = ssel[k] * wn;
                LIST[(size_t)e * TT + pos] = t * 8 + k;
            }
        }
    };
    gemm_tiles<false>(lds, tm0 + vcu_id(), TT / 128, gridDim.x, make, epi);
}

__device__ __forceinline__ int moe_find_expert(const LAS int* tp, int mtg) {
    int lo = 0, hi = 64;
    while (lo < hi) { const int mid = (lo + hi + 1) >> 1; if (tp[mid] <= mtg) lo = mid; else hi = mid - 1; }
    return lo;
}
__device__ __forceinline__ void ph_moe1(const Params& p, LAS unsigned char* lds, int l, int row_lo) {
    unsigned char* ws = p.ws;
    moe_tables(p, lds, l, row_lo);
    LAS int* cnt = (LAS int*)(lds + MOE_LDS_OFF); LAS int* tp = cnt + 80; LAS int* sp = tp + 80;
    const bf16* U = (const bf16*)(ws + OFF_U); const bf16* WGU = (const bf16*)(ws + OFF_W_GU); bf16* HM = (bf16*)(ws + AM_HM);
    const int* LIST = (const int*)(ws + OFF_LIST);
    const int tid = threadIdx.x, lane = tid & 63, wid = tid >> 6, wr = wid >> 1, wc = wid & 1, fr = lane & 15, fq = lane >> 4;
    const int ntiles = tp[65] * 4;
    auto make = [&](int t, GPtrs& g, int& nk) {
        const int mtg = t >> 2, nt = t & 3, e = moe_find_expert(tp, mtg), mt = mtg - tp[e], ce = cnt[e];
#pragma unroll
        for (int i = 0; i < 4; ++i) {
            const int li = mt * 128 + (tid >> 3) + 32 * i;
            int tk = row_lo;
            if (li < ce) tk = e < 64 ? (LIST[(size_t)e * TT + li] >> 3) : row_lo + li;
            g.a[i] = U + (size_t)tk * DM + stg_col();
        }
        plain_ptrs(WGU + (size_t)e * 512 * DM, nt * 128, DM, g.b); nk = DM / 64;
    };
    auto epi = [&](int t, f32x4 (&acc)[4][4]) {
        const int mtg = t >> 2, nt = t & 3, e = moe_find_expert(tp, mtg), mt = mtg - tp[e], ce = cnt[e];
        const size_t slot0 = e < 64 ? (size_t)(sp[e] + mt * 128) : (size_t)TT * 8 + row_lo + mt * 128;
        const int hc0 = nt * 64 + wc * 32;
#pragma unroll
        for (int m = 0; m < 4; ++m) {
            const int i = wr * 64 + m * 16 + fr;
            if (mt * 128 + i < ce) {
#pragma unroll
                for (int n = 0; n < 2; ++n) {
                    const f32x4 g = acc[m][n], u = acc[m][n + 2];
                    const u32x2 w = {pk2(siluf(g[0]) * u[0], siluf(g[1]) * u[1]), pk2(siluf(g[2]) * u[2], siluf(g[3]) * u[3])};
                    *(u32x2*)(HM + (slot0 + i) * 256 + hc0 + n * 16 + fq * 4) = w;
                }
            }
        }
    };
    gemm_tiles<true>(lds, vcu_id(), ntiles, gridDim.x, make, epi);
}
__device__ __forceinline__ void ph_moe2(const Params& p, LAS unsigned char* lds, int l, int row_lo) {
    unsigned char* ws = p.ws;
    moe_tables(p, lds, l, row_lo);
    LAS int* cnt = (LAS int*)(lds + MOE_LDS_OFF); LAS int* tp = cnt + 80; LAS int* sp = tp + 80;
    const bf16* HM = (const bf16*)(ws + AM_HM); const bf16* WD = (const bf16*)(ws + OFF_W_D); bf16* YR = (bf16*)(ws + AM_YR);
    const int tid = threadIdx.x, lane = tid & 63, wid = tid >> 6, wr = wid >> 1, wc = wid & 1, fr = lane & 15, fq = lane >> 4;
    const int ntiles = tp[65] * 8;
    auto make = [&](int t, GPtrs& g, int& nk) {
        const int mtg = t >> 3, nt = t & 7, e = moe_find_expert(tp, mtg), mt = mtg - tp[e];
        const size_t slot0 = e < 64 ? (size_t)(sp[e] + mt * 128) : (size_t)TT * 8 + row_lo + mt * 128;
        plain_ptrs(HM, 0, 256, g.a);
#pragma unroll
        for (int i = 0; i < 4; ++i) g.a[i] += slot0 * 256;
        plain_ptrs(WD + (size_t)e * DM * 256, nt * 128, 256, g.b); nk = 256 / 64;
    };
    auto epi = [&](int t, f32x4 (&acc)[4][4]) {
        const int mtg = t >> 3, nt = t & 7, e = moe_find_expert(tp, mtg), mt = mtg - tp[e], ce = cnt[e];
        const size_t slot0 = e < 64 ? (size_t)(sp[e] + mt * 128) : (size_t)TT * 8 + row_lo + mt * 128;
        LAS unsigned char* wl = lds + 32768 + wid * 8192;
        const int i0 = wr * 64;
        epi_store_rows(wl, acc, fr, fq, lane, [&](int row) -> bf16* { return (mt * 128 + i0 + row < ce) ? YR + (slot0 + i0 + row) * DM + nt * 128 + wc * 64 : nullptr; });
    };
    gemm_tiles<true>(lds, vcu_id(), ntiles, gridDim.x, make, epi);
}

__device__ __forceinline__ void ph_inproj1(const Params& p, LAS unsigned char* lds) {
    unsigned char* ws = p.ws;
    const bf16* U = (const bf16*)(ws + OFF_U); const bf16* W = (const bf16*)(ws + OFF_W_IN_O);
    bf16* Z1 = (bf16*)(ws + A1_Z1); bf16* KM = (bf16*)(ws + A1_KM);
    const f32x2* rope = (const f32x2*)(ws + OFF_ROPE);
    const int tid = threadIdx.x, lane = tid & 63, wid = tid >> 6, wr = wid >> 1, wc = wid & 1, fr = lane & 15, fq = lane >> 4;
    constexpr int NTN = 7, NTM = TT / 128;
    auto make = [&](int t, GPtrs& g, int& nk) { int tm, tn; tile_mn(t, NTM, NTN, tm, tn); plain_ptrs(U, tm * 128, DM, g.a); plain_ptrs(W, tn * 128, DM, g.b); nk = DM / 64; };
    auto epi = [&](int t, f32x4 (&acc)[4][4]) {
        int tm, tn; tile_mn(t, NTM, NTN, tm, tn); const int brow = tm * 128, bcol = tn * 128;
        const int cb = bcol + wc * 64;
        LAS unsigned char* wl = lds + 32768 + wid * 8192;
        const int r0 = brow + wr * 64;
        const RowInfo ri0 = rowinfo(r0);
        if (cb < 768) {
            float* ssq = (float*)(ws + OFF_SSQ);
#pragma unroll
            for (int m = 0; m < 4; ++m) {
                float q = 0.f;
#pragma unroll
                for (int n = 0; n < 4; ++n) q += (acc[m][n][0] * acc[m][n][0] + acc[m][n][1] * acc[m][n][1]) + (acc[m][n][2] * acc[m][n][2] + acc[m][n][3] * acc[m][n][3]);
                q += __shfl_xor(q, 16); q += __shfl_xor(q, 32);
                if (fq == 0) ssq[(size_t)(r0 + m * 16 + fr) * 12 + (cb >> 6)] = q;
            }
            epi_store_rows(wl, acc, fr, fq, lane, [&](int row) { return Z1 + (size_t)(r0 + row) * Z1P + cb; });
        } else if (cb == 768) {
#pragma unroll
            for (int m = 0; m < 4; ++m) {
                const int pos = ri0.pos + m * 16 + fr;
#pragma unroll
                for (int n = 0; n < 2; ++n)
#pragma unroll
                    for (int j = 0; j < 4; ++j) {
                        const float x1 = acc[m][n][j], x2 = acc[m][n + 2][j];
                        if (ri0.lat) { const f32x2 cs = rope[(size_t)pos * 32 + n * 16 + fq * 4 + j]; acc[m][n][j] = x1 * cs.x - x2 * cs.y; acc[m][n + 2][j] = x2 * cs.x + x1 * cs.y; }
                    }
                asm volatile("" ::: "memory");
            }
            bf16* dst = KM + ((size_t)(ri0.b * 8) * NKEY + ri0.kq) * 192 + 128;
            epi_store_rows(wl, acc, fr, fq, lane, [&](int row) { return dst + (size_t)row * 192; }, 8, (size_t)NKEY * 192);
        }
    };
    gemm_tiles<true>(lds, vcu_id(), NTM * NTN, gridDim.x, make, epi);
}

__device__ __forceinline__ void ph_mla_up(const Params& p, LAS unsigned char* lds) {
    unsigned char* ws = p.ws;
    const bf16* Z1 = (const bf16*)(ws + A1_Z1); const bf16* WQ = (const bf16*)(ws + OFF_W_UQ); const bf16* WKV = (const bf16*)(ws + OFF_W_UKV);
    bf16* QM = (bf16*)(ws + A1_QM); bf16* KM = (bf16*)(ws + A1_KM); bf16* VTM = (bf16*)(ws + A1_VTM);
    const f32x2* rope = (const f32x2*)(ws + OFF_ROPE);
    const int tid = threadIdx.x, lane = tid & 63, wid = tid >> 6, wr = wid >> 1, wc = wid & 1, fr = lane & 15, fq = lane >> 4;
    LAS float* rsb = (LAS float*)(lds + 66560);
    constexpr int NQ = (TL / 128) * 12, NKV = (TT / 128) * 16;
    constexpr float QSCALE = 0.07216878364870322f * LOG2E;
    auto decode = [&](int t, bool& isq, int& tm, int& tn) { isq = t < NQ; if (isq) { tile_mn(t, TL / 128, 12, tm, tn); tm += 4; } else tile_mn(t - NQ, TT / 128, 16, tm, tn); };
    auto make = [&](int t, GPtrs& g, int& nk) {
        bool isq; int tm, tn; decode(t, isq, tm, tn);
        const int brow = tm * 128, bcol = tn * 128, K = isq ? 512 : 256, acol = isq ? 0 : 512;
        const int par = ((t - vcu_id()) / (int)gridDim.x) & 1;
        if (tid < 128) {
            const float* q = (const float*)(ws + OFF_SSQ) + (size_t)(brow + tid) * 12;
            float ss;
            if (isq) { const f32x4 a = *(const f32x4*)q, b2 = *(const f32x4*)(q + 4); ss = ((a.x + a.y) + (a.z + a.w)) + ((b2.x + b2.y) + (b2.z + b2.w)); }
            else { const f32x4 a = *(const f32x4*)(q + 8); ss = (a.x + a.y) + (a.z + a.w); }
            rsb[par * 128 + tid] = rsqrtf(ss / (float)K + RMS_EPS);
        }
        plain_ptrs(Z1 + acol, brow, Z1P, g.a); plain_ptrs(isq ? WQ : WKV, bcol, K, g.b); nk = K / 64;
    };
    auto epi = [&](int t, f32x4 (&acc)[4][4]) {
        bool isq; int tm, tn; decode(t, isq, tm, tn);
        const int brow = tm * 128, bcol = tn * 128;
        const int par = ((t - vcu_id()) / (int)gridDim.x) & 1;
        const int cb = bcol + wc * 64;
        LAS unsigned char* wl = lds + 32768 + wid * 8192;
        const int r0 = brow + wr * 64;
        const RowInfo ri0 = rowinfo(r0);
        if (isq) {
            const int h = cb / 192, part = (cb % 192) >> 6;
#pragma unroll
            for (int m = 0; m < 4; ++m) {
                const float sc = rsb[par * 128 + wr * 64 + m * 16 + fr] * QSCALE;
                const int pos = ri0.pos + m * 16 + fr;
                if (part < 2) {
#pragma unroll
                    for (int n = 0; n < 4; ++n) acc[m][n] = acc[m][n] * sc;
                } else {
#pragma unroll
                    for (int n = 0; n < 2; ++n)
#pragma unroll
                        for (int j = 0; j < 4; ++j) {
                            const float x1 = acc[m][n][j] * sc, x2 = acc[m][n + 2][j] * sc;
                            const f32x2 cs = rope[(size_t)pos * 32 + n * 16 + fq * 4 + j];
                            acc[m][n][j] = x1 * cs.x - x2 * cs.y; acc[m][n + 2][j] = x2 * cs.x + x1 * cs.y;
                        }
                }
                asm volatile("" ::: "memory");
            }
            bf16* dst = QM + ((size_t)(ri0.b * 8 + h) * SEQ + ri0.pos) * 192 + part * 64;
            epi_store_rows(wl, acc, fr, fq, lane, [&](int row) { return dst + (size_t)row * 192; });
        } else {
            const int h = cb >> 8, part = (cb & 255) >> 6;
#pragma unroll
            for (int m = 0; m < 4; ++m) {
                const float rs = rsb[par * 128 + wr * 64 + m * 16 + fr];
#pragma unroll
                for (int n = 0; n < 4; ++n) acc[m][n] = acc[m][n] * rs;
            }
            if (part < 2) {
                bf16* dst = KM + ((size_t)(ri0.b * 8 + h) * NKEY + ri0.kq) * 192 + part * 64;
                epi_store_rows(wl, acc, fr, fq, lane, [&](int row) { return dst + (size_t)row * 192; });
            } else {
                bf16* dst = VTM + ((size_t)(ri0.b * 8 + h) * 128 + (part - 2) * 64) * NKEY + ri0.kq;
                epi_store_cols(wl, acc, fr, fq, lane, [&](int col) { return dst + (size_t)col * NKEY; });
            }
        }
    };
    gemm_tiles<true>(lds, vcu_id(), NQ + NKV, gridDim.x, make, epi);
}

__device__ __forceinline__ void ph_mla_attn(const Params& p, LAS unsigned char* lds) {
    unsigned char* ws = p.ws;
    const bf16* QM = (const bf16*)(ws + A1_QM); const bf16* KM = (const bf16*)(ws + A1_KM); const bf16* VTM = (const bf16*)(ws + A1_VTM); bf16* MIX = (bf16*)(ws + A1_MIX);
    for (int item = vcu_id(); item < 2 * 8 * 64; item += gridDim.x) {
        const int qt = item & 63, h = (item >> 6) & 7, b = item >> 9;
        const bf16* Qg = QM + ((size_t)(b * 8 + h) * SEQ + qt * 128) * 192;
        const bf16* Kg = KM + (size_t)(b * 8 + h) * NKEY * 192;
        const bf16* Vg = VTM + (size_t)(b * 8 + h) * 128 * NKEY;
        attn_item<192, 128>(lds, Qg, Kg, Vg, NKEY / 64, 0, 0, 0, -1e30f, 0.f, MIX + (size_t)(TC + b * SEQ + qt * 128) * DM + h * 128, DM);
    }
}


#define XB_TMO      128
#define XB_XCNT(j)  (256  + 64 * (j))
#define XB_XSUB(j)  (1280 + 64 * (j))
#define XB_XGEN(j)  (2304 + 64 * (j))
#define XB_TOP      3328
#define XB_TOPGEN   3392
#define XCD_BAR_WORDS 3456
#define XB_SPIN_CAP (1u << 18)
__device__ __forceinline__ unsigned xb_ld(unsigned* p)              { return __hip_atomic_load(p, __ATOMIC_RELAXED, __HIP_MEMORY_SCOPE_AGENT); }
__device__ __forceinline__ unsigned xb_add(unsigned* p, unsigned v) { return __hip_atomic_fetch_add(p, v, __ATOMIC_RELAXED, __HIP_MEMORY_SCOPE_AGENT); }
__device__ __forceinline__ unsigned xb_xcc_id() { return (unsigned)__builtin_amdgcn_s_getreg((3 << 11) | 20) & 0xFu; }
#define XB_SPIN(cond, bar) do { unsigned _sp = 0; while (cond) { __builtin_amdgcn_s_sleep(1); \
    if ((++_sp & 255u) == 0u) { if (xb_ld(&(bar)[XB_TMO])) break; if (_sp > XB_SPIN_CAP) { atomicAdd(&(bar)[XB_TMO], 1u); break; } } } } while (0)
struct XcdBarrier { unsigned* bar; unsigned x; volatile LAS unsigned* st; };
__device__ __forceinline__ XcdBarrier xcd_barrier_post(unsigned* bar, volatile LAS unsigned* st) {
    XcdBarrier b; b.bar = bar; b.x = xb_xcc_id(); b.st = st;
    if (threadIdx.x == 0) (void)xb_add(&bar[XB_XCNT(b.x)], 1u);
    return b;
}
__device__ __forceinline__ void xcd_barrier_complete(unsigned* bar, unsigned x, unsigned& nloc, unsigned& nx) {
    const unsigned G = gridDim.x * gridDim.y * gridDim.z;
    unsigned sum, cnt, mine, sp = 0u;
    for (;;) {
        sum = 0u; cnt = 0u; mine = 0u;
#pragma unroll
        for (unsigned j = 0; j < 16; ++j) { const unsigned c = xb_ld(&bar[XB_XCNT(j)]); sum += c; cnt += (c > 0u) ? 1u : 0u; mine = (j == x) ? c : mine; }
        if (sum == G) break;
        __builtin_amdgcn_s_sleep(1);
        if ((++sp & 255u) == 0u) { if (xb_ld(&bar[XB_TMO])) break; if (sp > XB_SPIN_CAP) { atomicAdd(&bar[XB_TMO], 1u); break; } }
    }
    nloc = mine > 0u ? mine : 1u; nx = cnt > 0u ? cnt : 1u;
}
__device__ __forceinline__ void xcd_barrier(const XcdBarrier& b) {
    asm volatile("s_waitcnt vmcnt(0)" ::: "memory");
    __syncthreads();
    if (threadIdx.x == 0) {
        unsigned* bar = b.bar;
        __builtin_amdgcn_s_waitcnt(0);
        unsigned nloc = b.st[0], nx = b.st[1];
        if (nloc == 0u) { xcd_barrier_complete(bar, b.x, nloc, nx); b.st[0] = nloc; b.st[1] = nx; }
        const unsigned old = xb_add(&bar[XB_XSUB(b.x)], 1u);
        const unsigned gen = old / nloc;
        if (old + 1u == (gen + 1u) * nloc) {
            __builtin_amdgcn_fence(__ATOMIC_RELEASE, "agent");
            asm volatile("s_waitcnt vmcnt(0)" ::: "memory");
            const unsigned og = xb_add(&bar[XB_TOP], 1u);
            const unsigned tg = og / nx;
            if (og + 1u == (tg + 1u) * nx) xb_add(&bar[XB_TOPGEN], 1u);
            else XB_SPIN(xb_ld(&bar[XB_TOPGEN]) == tg, bar);
            __builtin_amdgcn_fence(__ATOMIC_ACQUIRE, "agent");
            xb_add(&bar[XB_XGEN(b.x)], 1u);
            asm volatile("s_waitcnt vmcnt(0)" ::: "memory");
        } else {
            XB_SPIN(xb_ld(&bar[XB_XGEN(b.x)]) == gen, bar);
            __builtin_amdgcn_fence(__ATOMIC_ACQUIRE, "agent");
            asm volatile("s_waitcnt vmcnt(0)" ::: "memory");
        }
    }
    __syncthreads();
}
static_assert(XCD_BAR_WORDS * 4 <= BAR_BYTES, "barrier words");

constexpr int NPHASE = 19;
__global__ void __launch_bounds__(256, 2) mega(Params p) {
    extern __shared__ __attribute__((aligned(16))) unsigned char lds_[];
    LAS unsigned char* lds = (LAS unsigned char*)lds_;
    cg::grid_group grid = cg::this_grid();
    unsigned char* ws = p.ws;
    volatile LAS unsigned* bst = (volatile LAS unsigned*)(lds + LDS_BYTES - 16);
    if (threadIdx.x < 4) bst[threadIdx.x] = 0u;
    __syncthreads();
    const XcdBarrier xbar = xcd_barrier_post((unsigned*)(ws + OFF_BAR), bst);
#define GRID_BAR(k) do { if ((k) == 0) grid.sync(); else xcd_barrier(xbar); } while (0)
#ifndef PROBE_REP_MASK
#define PROBE_REP_MASK 0u
#endif
#ifndef PROBE_EXTRA_SYNCS
#define PROBE_EXTRA_SYNCS 0
#endif
#define PHASE(k, body) do { if (p.ph_lo <= (k) && (k) < p.ph_hi) { body; if ((PROBE_REP_MASK >> (k)) & 1u) { xcd_barrier(xbar); body; } if ((k) + 1 < p.ph_hi) GRID_BAR(k); } } while (0)
    for (int i = 0; i < PROBE_EXTRA_SYNCS; ++i) xcd_barrier(xbar);
    PHASE(0, ph_prep(p, lds));
    PHASE(1, ph_modulate0(p));
    PHASE(2, ph_inproj0(p, lds));
    PHASE(3, ph_swa_g1(p, lds));
    PHASE(4, ph_gla_scan(p));
    PHASE(5, ph_gla_g3(p, lds));
    PHASE(6, ph_outproj(p, lds, (const bf16*)(ws + A0_MIX), (const bf16*)(ws + OFF_W_OUT_E), (float*)(ws + A0_Y), 0));
    PHASE(7, ph_rowpassA(p, 0, 0, (const float*)(ws + A0_Y)));
    PHASE(8, { ph_router(p, lds, 0, 0); __syncthreads(); for (int it = blockIdx.x; it < EXP_ITEMS; it += gridDim.x) expert_convert_item(p, lds, 0, it); });
    PHASE(9, ph_moe1(p, lds, 0, 0));
    PHASE(10, ph_moe2(p, lds, 0, 0));
    PHASE(11, ph_rowpassB(p, lds, 0, 0));
    PHASE(12, ph_inproj1(p, lds));
    PHASE(13, ph_mla_up(p, lds));
    PHASE(14, ph_mla_attn(p, lds));
    PHASE(15, ph_outproj(p, lds, (const bf16*)(ws + A1_MIX), (const bf16*)(ws + OFF_W_OUT_O), (float*)(ws + A1_Y), TC));
    PHASE(16, ph_rowpassA(p, 1, TC, (const float*)(ws + A1_Y)));
    PHASE(17, { ph_router(p, lds, 1, TC); __syncthreads(); for (int it = blockIdx.x; it < EXP_ITEMS; it += gridDim.x) expert_convert_item(p, lds, 1, it); });
    PHASE(18, ph_moe1(p, lds, 1, TC));
    PHASE(19, ph_moe2(p, lds, 1, TC));
    PHASE(20, ph_rowpassB(p, lds, 1, TC));
}

extern "C" void kernel_launch(void* const* d_in, const int* in_sizes, int n_in, void* d_out, int out_size, void* d_ws, size_t ws_size, hipStream_t stream) {
    static int grid_blocks = 0;
    if (!grid_blocks) {
        int dev = 0, cus = 0, per_cu = 0;
        (void)hipGetDevice(&dev);
        (void)hipDeviceGetAttribute(&cus, hipDeviceAttributeMultiprocessorCount, dev);
        (void)hipFuncSetAttribute((const void*)mega, hipFuncAttributeMaxDynamicSharedMemorySize, LDS_BYTES);
        (void)hipOccupancyMaxActiveBlocksPerMultiprocessor(&per_cu, (const void*)mega, 256, LDS_BYTES);
        if (per_cu > 2) per_cu = 2;
        if (per_cu < 1) per_cu = 1;
        grid_blocks = cus * per_cu;
        if (ws_size < WS_NEED) fprintf(stderr, "kernel_launch: workspace too small: %zu < %zu\n", ws_size, (size_t)WS_NEED);
    }
    Params p{};
    const float** f = (const float**)&p;
    for (int i = 0; i < 30; ++i) f[i] = (const float*)d_in[i];
    p.out = (float*)d_out; p.ws = (unsigned char*)d_ws; p.ph_lo = 0; p.ph_hi = 21;
    (void)hipMemsetAsync((unsigned char*)d_ws + OFF_BAR, 0, BAR_BYTES, stream);
    void* args[] = {&p};
    hipError_t e = hipLaunchCooperativeKernel((const void*)mega, dim3(grid_blocks), dim3(256), args, LDS_BYTES, stream);
    if (e != hipSuccess) fprintf(stderr, "cooperative launch failed: %s (grid %d)\n", hipGetErrorString(e), grid_blocks);
}
```

```cpp
#include <hip/hip_runtime.h>
#include <hip/hip_cooperative_groups.h>
#include <cstdio>
#include <cstdint>
namespace cg = cooperative_groups;

#define LAS __attribute__((address_space(3)))
typedef unsigned short bf16;
typedef short bf16x8 __attribute__((ext_vector_type(8)));
typedef float f32x2 __attribute__((ext_vector_type(2)));
typedef float f32x4 __attribute__((ext_vector_type(4)));
typedef float f32x8 __attribute__((ext_vector_type(8)));
typedef float f32x16 __attribute__((ext_vector_type(16)));
typedef unsigned u32x2 __attribute__((ext_vector_type(2)));
typedef unsigned u32x4 __attribute__((ext_vector_type(4)));
typedef __bf16 bf16x2_t __attribute__((ext_vector_type(2)));

constexpr int DM = 1024, NB = 2, SEQ = 8192, CTX = 256;
constexpr int TC = NB * CTX, TL = NB * SEQ, TT = TC + TL, NKEY = CTX + SEQ;
constexpr int NEXP = 64;
constexpr float RMS_EPS = 1e-6f;
constexpr int E_IN_PAD = 2432, O_IN_PAD = 896;
constexpr float LOG2E = 1.4426950408889634f;
constexpr int NSTEP = 132;
constexpr int Z0P = 1056;
constexpr int Z1P = 768;
constexpr int LDS_BYTES = 73728;

constexpr size_t al(size_t x) { return (x + 255) & ~(size_t)255; }
constexpr size_t OFF_W_IN_E = 0;
constexpr size_t OFF_W_OUT_E = OFF_W_IN_E + al((size_t)E_IN_PAD * DM * 2);
constexpr size_t OFF_W_IN_O = OFF_W_OUT_E + al((size_t)DM * DM * 2);
constexpr size_t OFF_W_UQ = OFF_W_IN_O + al((size_t)O_IN_PAD * DM * 2);
constexpr size_t OFF_W_UKV = OFF_W_UQ + al((size_t)1536 * 512 * 2);
constexpr size_t OFF_W_OUT_O = OFF_W_UKV + al((size_t)2048 * 256 * 2);
constexpr size_t OFF_W_RT = OFF_W_OUT_O + al((size_t)DM * DM * 2);
constexpr size_t OFF_W_GU = OFF_W_RT + al((size_t)2 * 128 * DM * 2);
constexpr size_t OFF_W_D = OFF_W_GU + al((size_t)65 * 512 * DM * 2);
constexpr size_t OFF_U = OFF_W_D + al((size_t)65 * DM * 256 * 2);
constexpr size_t OFF_HC = OFF_U + al((size_t)TT * DM * 2);
constexpr size_t OFF_MOD = OFF_HC + al((size_t)TC * DM * 4);
constexpr size_t OFF_ROPE = OFF_MOD + al((size_t)2 * 3 * 6144 * 4);
constexpr size_t OFF_CNT = OFF_ROPE + al((size_t)SEQ * 32 * 8);
constexpr size_t OFF_TOKSLOT = OFF_CNT + al(2 * 64 * 4);
constexpr size_t OFF_W8 = OFF_TOKSLOT + al((size_t)TT * 8 * 4);
constexpr size_t OFF_LIST = OFF_W8 + al((size_t)TT * 8 * 4);
constexpr size_t OFF_SSQ = OFF_LIST + al((size_t)64 * TT * 4);
constexpr size_t OFF_DUMP = OFF_SSQ + al((size_t)TT * 12 * 4);
constexpr size_t OFF_BAR = OFF_DUMP + 8192;
constexpr size_t BAR_BYTES = 16384;
constexpr size_t OFF_ARENA = OFF_BAR + BAR_BYTES;
constexpr size_t A0_Z0 = OFF_ARENA;
constexpr size_t A0_VGT = A0_Z0 + al((size_t)TT * Z0P * 2);
constexpr size_t A0_QS = A0_VGT + al((size_t)4 * 128 * TT * 2);
constexpr size_t A0_KS = A0_QS + al((size_t)2 * 8 * NKEY * 64 * 2);
constexpr size_t A0_VST = A0_KS + al((size_t)2 * 2 * NKEY * 64 * 2);
constexpr size_t A0_GS = A0_VST + al((size_t)2 * 2 * 64 * NKEY * 2);
constexpr size_t A0_GD = A0_GS + al((size_t)16 * NSTEP * 8192 * 4);
constexpr size_t A0_MIX = A0_GD + al((size_t)16 * NSTEP * 64 * 4);
constexpr size_t A0_Y = A0_MIX + al((size_t)TT * DM * 2);
constexpr size_t A0_END = A0_Y + al((size_t)TT * DM * 4);
constexpr size_t A1_Z1 = OFF_ARENA;
constexpr size_t A1_QM = A1_Z1 + al((size_t)TT * Z1P * 2);
constexpr size_t A1_KM = A1_QM + al((size_t)2 * 8 * SEQ * 192 * 2);
constexpr size_t A1_VTM = A1_KM + al((size_t)2 * 8 * NKEY * 192 * 2);
constexpr size_t A1_MIX = A1_VTM + al((size_t)2 * 8 * 128 * NKEY * 2);
constexpr size_t A1_Y = A1_MIX + al((size_t)TT * DM * 2);
constexpr size_t A1_END = A1_Y + al((size_t)TT * DM * 4);
constexpr size_t AM_HM = OFF_ARENA;
constexpr size_t AM_YR = AM_HM + al((size_t)TT * 9 * 256 * 2);
constexpr size_t AM_END = AM_YR + al((size_t)TT * 9 * 1024 * 2);
constexpr size_t WS_NEED = AM_END > A0_END ? (AM_END > A1_END ? AM_END : A1_END) : (A0_END > A1_END ? A0_END : A1_END);
static_assert(WS_NEED <= 555747360ull, "workspace map exceeds the guaranteed d_ws size");

struct Params {
    const float *x, *c, *ctx, *c_ctx, *w_mod, *b_mod, *g_mix_pre, *g_mix_post, *g_ffn_pre, *g_ffn_post;
    const float *w_in_e, *gla_wa2, *gla_ba, *gla_norm, *swa_sink, *w_out_e;
    const float *w_in_o, *mla_q_norm, *mla_kv_norm, *w_uq, *w_ukv, *w_out_o;
    const float *w_router, *b_router, *w_exp_gate, *w_exp_up, *w_exp_down, *w_sh_gate, *w_sh_up, *w_sh_down;
    float* out; unsigned char* ws; int ph_lo, ph_hi;
};

__device__ __forceinline__ unsigned pk2(float lo, float hi) { f32x2 v = {lo, hi}; bf16x2_t b = __builtin_convertvector(v, bf16x2_t); return __builtin_bit_cast(unsigned, b); }
__device__ __forceinline__ float bflo(unsigned u) { return __uint_as_float(u << 16); }
__device__ __forceinline__ float bfhi(unsigned u) { return __uint_as_float(u & 0xffff0000u); }
__device__ __forceinline__ float bf2f(bf16 v) { return __uint_as_float((unsigned)v << 16); }
__device__ __forceinline__ bf16 f2bf(float f) { return (bf16)(pk2(f, 0.f) & 0xffffu); }
__device__ __forceinline__ float wave_sum(float v) {
#pragma unroll
    for (int o = 1; o < 64; o <<= 1) v += __shfl_xor(v, o);
    return v;
}
__device__ __forceinline__ void glds16(const void* g, LAS void* l) { __builtin_amdgcn_global_load_lds((const unsigned*)g, (LAS unsigned*)l, 16, 0, 0); }
__device__ __forceinline__ float siluf(float x) { return x / (1.f + __expf(-x)); }
__device__ __forceinline__ float ex2(float x) { return __builtin_amdgcn_exp2f(x); }
__device__ __forceinline__ int crow(int r, int hi) { return (r & 3) + 8 * (r >> 2) + 4 * hi; }
__device__ __forceinline__ bf16x8 mk8(u32x4 v) { return __builtin_bit_cast(bf16x8, v); }

struct RowInfo { int b, kq, pos; bool lat; };
__device__ __forceinline__ RowInfo rowinfo(int r) {
    RowInfo i;
    if (r < TC) { i.b = r >> 8; i.pos = r & 255; i.kq = i.pos; i.lat = false; }
    else { const int rl = r - TC; i.b = rl >> 13; i.pos = rl & (SEQ - 1); i.kq = CTX + i.pos; i.lat = true; }
    return i;
}
__device__ __forceinline__ int modvec(int r) { return r < TC ? 2 : ((r - TC) >> 13); }

struct GPtrs { const bf16* a[4]; const bf16* b[4]; };
constexpr int G_STAGE = 32768;
#define G_FENCE() asm volatile("" ::: "memory")
__device__ __forceinline__ void gemm_issue(LAS unsigned char* lds, const GPtrs& g, int kt) {
    LAS unsigned char* d = lds + (kt & 1) * G_STAGE + threadIdx.x * 16; const int ko = kt * 64;
#pragma unroll
    for (int i = 0; i < 4; ++i) { glds16(g.a[i] + ko, d + i * 4096); glds16(g.b[i] + ko, d + 16384 + i * 4096); }
}
__device__ __forceinline__ void gemm_prologue(LAS unsigned char* lds, const GPtrs& g, int nk) { gemm_issue(lds, g, 0); }
template <int NST>
__device__ __forceinline__ void gemm_main(LAS unsigned char* lds, const GPtrs& g, int nk, f32x4 (&acc)[4][4], bool after_epi) {
    const int tid = threadIdx.x, lane = tid & 63, wid = tid >> 6, wr = wid >> 1, wc = wid & 1, fr = lane & 15, fq = lane >> 4;
#pragma unroll
    for (int m = 0; m < 4; ++m)
#pragma unroll
        for (int n = 0; n < 4; ++n) acc[m][n] = (f32x4){0.f, 0.f, 0.f, 0.f};
    const int c0 = ((fq) ^ (fr & 7)) * 16, c1 = ((4 + fq) ^ (fr & 7)) * 16;
    const int aoff = (wr * 64 + fr) * 128, boff = 16384 + (wc * 64 + fr) * 128;
    for (int kt = 0; kt < nk; ++kt) {
        if (NST == 8 && kt == 0 && after_epi) asm volatile("s_waitcnt vmcnt(8) lgkmcnt(0)" ::: "memory");
        else if (NST == 16 && kt == 0 && after_epi) asm volatile("s_waitcnt vmcnt(16) lgkmcnt(0)" ::: "memory");
        else asm volatile("s_waitcnt vmcnt(0) lgkmcnt(0)" ::: "memory");
        __builtin_amdgcn_s_barrier();
        G_FENCE();
        if (kt + 1 < nk) gemm_issue(lds, g, kt + 1);
        LAS unsigned char* base = lds + (kt & 1) * G_STAGE;
        bf16x8 af0[4], bf0[4], af1[4], bf1[4];
#pragma unroll
        for (int m = 0; m < 4; ++m) af0[m] = *(const LAS bf16x8*)(base + aoff + m * 2048 + c0);
#pragma unroll
        for (int n = 0; n < 4; ++n) bf0[n] = *(const LAS bf16x8*)(base + boff + n * 2048 + c0);
#pragma unroll
        for (int m = 0; m < 4; ++m) af1[m] = *(const LAS bf16x8*)(base + aoff + m * 2048 + c1);
#pragma unroll
        for (int n = 0; n < 4; ++n) bf1[n] = *(const LAS bf16x8*)(base + boff + n * 2048 + c1);
        __builtin_amdgcn_s_setprio(1);
#pragma unroll
        for (int m = 0; m < 4; ++m)
#pragma unroll
            for (int n = 0; n < 4; ++n) acc[m][n] = __builtin_amdgcn_mfma_f32_16x16x32_bf16(bf0[n], af0[m], acc[m][n], 0, 0, 0);
#pragma unroll
        for (int m = 0; m < 4; ++m)
#pragma unroll
            for (int n = 0; n < 4; ++n) acc[m][n] = __builtin_amdgcn_mfma_f32_16x16x32_bf16(bf1[n], af1[m], acc[m][n], 0, 0, 0);
        __builtin_amdgcn_s_setprio(0);
    }
    asm volatile("s_waitcnt lgkmcnt(0)" ::: "memory");
    __builtin_amdgcn_s_barrier();
    G_FENCE();
}
__device__ __forceinline__ int vcu_id() { const int b = blockIdx.x, G = gridDim.x; return (G % 8 == 0) ? (b % 8) * (G / 8) + b / 8 : b; }
__device__ __forceinline__ void tile_mn(int w, int ntm, int ntn, int& tm, int& tn) {
    const int nig = 8 * ntn, gid = w / nig, fm = gid * 8, gsz = (ntm - fm) < 8 ? (ntm - fm) : 8, within = w - gid * nig;
    tm = fm + within % gsz; tn = within / gsz;
}
template <bool PREFETCH_NEXT, int NST = -1, class Make, class Epi>
__device__ __forceinline__ void gemm_tiles(LAS unsigned char* lds, int t0, int nt, int stride, Make make, Epi epi) {
    if (t0 >= nt) return;
    GPtrs g; int nk;
    make(t0, g, nk);
    G_FENCE();
    gemm_prologue(lds, g, nk);
    bool first = true;
    for (int t = t0; t < nt;) {
        const int tn = t + stride;
        f32x4 acc[4][4];
        gemm_main<PREFETCH_NEXT ? NST : -1>(lds, g, nk, acc, !first);
        first = false;
        if (PREFETCH_NEXT) { if (tn < nt) { make(tn, g, nk); G_FENCE(); gemm_prologue(lds, g, nk); } epi(t, acc); }
        else { epi(t, acc); __syncthreads(); if (tn < nt) { make(tn, g, nk); G_FENCE(); gemm_prologue(lds, g, nk); } }
        t = tn;
    }
}

template <class RowPtr>
__device__ __forceinline__ void epi_store_rows(LAS unsigned char* wl, const f32x4 (&v)[4][4], int fr, int fq, int lane, RowPtr rowptr, int nrep = 1, size_t rep_stride = 0) {
#pragma unroll
    for (int m = 0; m < 4; ++m)
#pragma unroll
        for (int n = 0; n < 4; ++n)
            *(LAS u32x2*)(wl + (m * 16 + fr) * 128 + (((n * 2 + (fq >> 1)) ^ (fr & 7)) * 16) + (fq & 1) * 8) = (u32x2){pk2(v[m][n][0], v[m][n][1]), pk2(v[m][n][2], v[m][n][3])};
#pragma unroll
    for (int i = 0; i < 8; ++i) {
        const int row = (lane >> 3) + 8 * i, pos = lane & 7;
        const u32x4 w = *(const LAS u32x4*)(wl + row * 128 + pos * 16);
        bf16* d = rowptr(row);
        if (d) { d += (pos ^ (row & 7)) * 8; for (int r = 0; r < nrep; ++r) *(u32x4*)(d + (size_t)r * rep_stride) = w; }
    }
}
template <class ColPtr>
__device__ __forceinline__ void epi_store_cols(LAS unsigned char* wl, const f32x4 (&v)[4][4], int fr, int fq, int lane, ColPtr colptr) {
    LAS unsigned char* wb = wl + fq * 512 + fr * 2;
#pragma unroll
    for (int m = 0; m < 4; ++m)
#pragma unroll
        for (int n = 0; n < 4; ++n)
#pragma unroll
            for (int j = 0; j < 4; ++j) *(LAS bf16*)(wb + n * 2048 + j * 128 + m * 32) = f2bf(v[m][n][j]);
#pragma unroll
    for (int i = 0; i < 8; ++i) {
        const int col = (lane >> 3) + 8 * i, pos = lane & 7;
        const u32x4 w = *(const LAS u32x4*)(wl + col * 128 + pos * 16);
        bf16* d = colptr(col);
        *(u32x4*)(d + pos * 8) = w;
    }
}

__device__ __forceinline__ int ein_map(int n) {
    if (n < 512) return n;
    if (n < 1024) return n + 512;
    if (n < 1536) return n - 512;
    if (n < 2048) return 1568 + (n - 1536);
    if (n < 2176) return 2080 + (n - 2048);
    if (n < 2304) return 2208 + (n - 2176);
    if (n < 2320) return 1536 + (n - 2304);
    if (n < 2336) return 1552 + (n - 2320);
    return -1;
}
__device__ __forceinline__ void transpose_item(LAS unsigned char* lds, int K, bf16* dst, int k0, int n0, int ld, int mode, const float* srcA, const float* srcB, int nvalid, const float* kscale) {
    LAS float* tile = (LAS float*)lds;
    const int tid = threadIdx.x;
    {
        const int nq = tid & 31, kr = tid >> 5, n = n0 + nq * 4;
        const float* cp = nullptr; float sc = 1.f;
        if (mode == 0) { if (n < nvalid) cp = srcA + n; }
        else if (mode == 1) { const int c = ein_map(n); if (c >= 0) cp = srcA + c; if (n < 256) sc = 0.125f; }
        else { const int grp = n >> 6, w = n & 63; cp = (w < 32 ? srcA : srcB) + grp * 32 + (w & 31); }
        f32x4 v[8];
#pragma unroll
        for (int i = 0; i < 8; ++i) { const int k = kr + 8 * i; v[i] = cp ? *(const f32x4*)(cp + (size_t)(k0 + k) * ld) : (f32x4){0.f, 0.f, 0.f, 0.f}; }
#pragma unroll
        for (int i = 0; i < 8; ++i) { const int k = kr + 8 * i; float m = sc; if (kscale) m *= kscale[k0 + k]; *(LAS f32x4*)(tile + k * 132 + nq * 4) = v[i] * m; }
    }
    __syncthreads();
    {
        const int n = tid >> 1, hf = tid & 1;
#pragma unroll
        for (int c = 0; c < 4; ++c) {
            const int k8 = hf * 32 + c * 8;
            u32x4 o;
            o.x = pk2(tile[(k8 + 0) * 132 + n], tile[(k8 + 1) * 132 + n]);
            o.y = pk2(tile[(k8 + 2) * 132 + n], tile[(k8 + 3) * 132 + n]);
            o.z = pk2(tile[(k8 + 4) * 132 + n], tile[(k8 + 5) * 132 + n]);
            o.w = pk2(tile[(k8 + 6) * 132 + n], tile[(k8 + 7) * 132 + n]);
            *(u32x4*)(dst + (size_t)(n0 + n) * K + k0 + k8) = o;
        }
    }
    __syncthreads();
}

constexpr int EXP_GU_ITEMS = 65 * 16 * 4, EXP_D_ITEMS = 65 * 4 * 8, EXP_ITEMS = EXP_GU_ITEMS + EXP_D_ITEMS;
__device__ __forceinline__ void expert_convert_item(const Params& p, LAS unsigned char* lds, int l, int it) {
    unsigned char* ws = p.ws;
    if (it < EXP_GU_ITEMS) {
        const int e = it / 64, r = it % 64, kb = r / 4, nb = r % 4;
        const float* gate = e < 64 ? p.w_exp_gate + ((size_t)(l * 64 + e)) * DM * 256 : p.w_sh_gate + (size_t)l * DM * 256;
        const float* up = e < 64 ? p.w_exp_up + ((size_t)(l * 64 + e)) * DM * 256 : p.w_sh_up + (size_t)l * DM * 256;
        transpose_item(lds, DM, (bf16*)(ws + OFF_W_GU) + (size_t)e * 512 * DM, kb * 64, nb * 128, 256, 2, gate, up, 512, nullptr);
    } else {
        it -= EXP_GU_ITEMS;
        const int e = it / 32, r = it % 32, kb = r / 8, nb = r % 8;
        const float* dn = e < 64 ? p.w_exp_down + ((size_t)(l * 64 + e)) * 256 * DM : p.w_sh_down + (size_t)l * 256 * DM;
        transpose_item(lds, 256, (bf16*)(ws + OFF_W_D) + (size_t)e * DM * 256, kb * 64, nb * 128, DM, 0, dn, nullptr, DM, nullptr);
    }
}

__device__ __forceinline__ void ph_prep(const Params& p, LAS unsigned char* lds) {
    unsigned char* ws = p.ws;
    const int tid = threadIdx.x;
    if (blockIdx.x == 0 && tid < 128) ((int*)(ws + OFF_CNT))[tid] = 0;
    constexpr int I_MOD = 96, I_ROPE = 1024, I_INE = 16 * 19, I_OUTE = 128, I_INO = 16 * 7, I_UQ = 8 * 12, I_UKV = 4 * 16, I_OUTO = 128, I_RT = 32;
    constexpr int NITEMS = I_MOD + I_ROPE + I_INE + I_OUTE + I_INO + I_UQ + I_UKV + I_OUTO + I_RT;
    for (int item = blockIdx.x; item < NITEMS; item += gridDim.x) {
        int it = item;
        if (it < I_MOD) {
            const int l = it / 48, n0 = (it % 48) * 128, kg = tid >> 5, cl = tid & 31;
            LAS float* s = (LAS float*)lds;
            LAS float* red = (LAS float*)(lds + 12288);
            for (int idx = tid; idx < 3072; idx += 256) { const int v = idx >> 10, k = idx & 1023; const float cv = v < 2 ? p.c[v * DM + k] : p.c_ctx[k]; s[idx] = cv / (1.f + expf(-cv)); }
            __syncthreads();
            f32x4 a0 = {0.f, 0.f, 0.f, 0.f}, a1 = a0, a2 = a0;
            const float* w = p.w_mod + (size_t)l * DM * 6144 + (size_t)(kg * 128) * 6144 + n0 + cl * 4;
#pragma unroll 8
            for (int k = 0; k < 128; ++k) { const f32x4 wv = *(const f32x4*)(w + (size_t)k * 6144); const int kk = kg * 128 + k; a0 += wv * s[kk]; a1 += wv * s[1024 + kk]; a2 += wv * s[2048 + kk]; }
            *(LAS f32x4*)(red + (kg * 3 + 0) * 128 + cl * 4) = a0; *(LAS f32x4*)(red + (kg * 3 + 1) * 128 + cl * 4) = a1; *(LAS f32x4*)(red + (kg * 3 + 2) * 128 + cl * 4) = a2;
            __syncthreads();
            for (int idx = tid; idx < 384; idx += 256) { const int v = idx >> 7, n = idx & 127; float acc = 0.f;
#pragma unroll
                for (int g = 0; g < 8; ++g) acc += red[(g * 3 + v) * 128 + n];
                ((float*)(ws + OFF_MOD))[((size_t)l * 3 + v) * 6144 + n0 + n] = acc + p.b_mod[l * 6144 + n0 + n]; }
            __syncthreads();
            continue;
        }
        it -= I_MOD;
        if (it < I_ROPE) {
            const int idx = it * 256 + tid, pos = idx >> 5, i = idx & 31, row = pos >> 6, col = pos & 63, j = i & 15;
            const float invf = powf(10000.f, -(float)(2 * j) / 32.f);
            const float ang = (float)(i < 16 ? row : col) * invf;
            float sn, cs; sincosf(ang, &sn, &cs);
            ((f32x2*)(ws + OFF_ROPE))[idx] = (f32x2){cs, sn};
            continue;
        }
        it -= I_ROPE;
        if (it < I_INE) { const int kb = it / 19, nb = it % 19;
            transpose_item(lds, DM, (bf16*)(ws + OFF_W_IN_E), kb * 64, nb * 128, 2336, 1, p.w_in_e, nullptr, 2336, nullptr); continue; }
        it -= I_INE;
        if (it < I_OUTE) { const int kb = it / 8, nb = it % 8;
            transpose_item(lds, DM, (bf16*)(ws + OFF_W_OUT_E), kb * 64, nb * 128, DM, 0, p.w_out_e, nullptr, DM, nullptr); continue; }
        it -= I_OUTE;
        if (it < I_INO) { const int kb = it / 7, nb = it % 7;
            transpose_item(lds, DM, (bf16*)(ws + OFF_W_IN_O), kb * 64, nb * 128, 832, 0, p.w_in_o, nullptr, 832, nullptr); continue; }
        it -= I_INO;
        if (it < I_UQ) { const int kb = it / 12, nb = it % 12;
            transpose_item(lds, 512, (bf16*)(ws + OFF_W_UQ), kb * 64, nb * 128, 1536, 0, p.w_uq, nullptr, 1536, p.mla_q_norm); continue; }
        it -= I_UQ;
        if (it < I_UKV) { const int kb = it / 16, nb = it % 16;
            transpose_item(lds, 256, (bf16*)(ws + OFF_W_UKV), kb * 64, nb * 128, 2048, 0, p.w_ukv, nullptr, 2048, p.mla_kv_norm); continue; }
        it -= I_UKV;
        if (it < I_OUTO) { const int kb = it / 8, nb = it % 8;
            transpose_item(lds, DM, (bf16*)(ws + OFF_W_OUT_O), kb * 64, nb * 128, DM, 0, p.w_out_o, nullptr, DM, nullptr); continue; }
        it -= I_OUTO;
        { const int l = it / 16, kb = it % 16;
            transpose_item(lds, DM, (bf16*)(ws + OFF_W_RT) + (size_t)l * 128 * DM, kb * 64, 0, 64, 0, p.w_router + (size_t)l * DM * 64, nullptr, 64, nullptr); }
    }
}

__device__ __forceinline__ void load_row(const float* src, int lane, f32x4 (&v)[4]) {
#pragma unroll
    for (int j = 0; j < 4; ++j) v[j] = *(const f32x4*)(src + lane * 4 + 256 * j);
}
__device__ __forceinline__ float row_sumsq(const f32x4 (&v)[4]) {
    float s = 0.f;
#pragma unroll
    for (int j = 0; j < 4; ++j) s += v[j].x * v[j].x + v[j].y * v[j].y + v[j].z * v[j].z + v[j].w * v[j].w;
    return wave_sum(s);
}
__device__ __forceinline__ void modulate_store(const f32x4 (&v)[4], float rinv, const float* g, const float* sh, const float* sc, bf16* dst, int lane) {
#pragma unroll
    for (int j = 0; j < 4; ++j) {
        const int c = lane * 4 + 256 * j;
        const f32x4 gg = *(const f32x4*)(g + c), s1 = *(const f32x4*)(sc + c), s0 = *(const f32x4*)(sh + c);
        const f32x4 o = v[j] * rinv * gg * (s1 + 1.f) + s0;
        u32x2 w; w.x = pk2(o.x, o.y); w.y = pk2(o.z, o.w);
        *(u32x2*)(dst + c) = w;
    }
}
__device__ __forceinline__ const float* hl_src0(const Params& p, int r) { return r < TC ? p.ctx + (size_t)r * DM : p.x + (size_t)(r - TC) * DM; }
__device__ __forceinline__ float* hl_buf(const Params& p, int r) { return r < TC ? (float*)(p.ws + OFF_HC) + (size_t)r * DM : p.out + (size_t)(r - TC) * DM; }

__device__ __forceinline__ void ph_modulate0(const Params& p) {
    const int lane = threadIdx.x & 63, gw = blockIdx.x * 4 + (threadIdx.x >> 6), ngw = gridDim.x * 4;
    const float* mod = (const float*)(p.ws + OFF_MOD);
    bf16* U = (bf16*)(p.ws + OFF_U);
    for (int r = gw; r < TT; r += ngw) {
        f32x4 v[4]; load_row(hl_src0(p, r), lane, v);
        const float rinv = rsqrtf(row_sumsq(v) * (1.f / DM) + RMS_EPS);
        const float* mv = mod + (size_t)modvec(r) * 6144;
        modulate_store(v, rinv, p.g_mix_pre, mv, mv + 1024, U + (size_t)r * DM, lane);
    }
}

__device__ __forceinline__ void ph_rowpassA(const Params& p, int l, int row_lo, const float* Y) {
    const int lane = threadIdx.x & 63, gw = blockIdx.x * 4 + (threadIdx.x >> 6), ngw = gridDim.x * 4;
    const float* mod = (const float*)(p.ws + OFF_MOD) + (size_t)l * 3 * 6144;
    bf16* U = (bf16*)(p.ws + OFF_U);
    for (int r = row_lo + gw; r < TT; r += ngw) {
        f32x4 y[4], h[4];
        load_row(Y + (size_t)r * DM, lane, y);
        load_row(l == 0 ? hl_src0(p, r) : (const float*)hl_buf(p, r), lane, h);
        const float rinv = rsqrtf(row_sumsq(y) * (1.f / DM) + RMS_EPS);
        const float* mv = mod + (size_t)modvec(r) * 6144;
        float* hb = hl_buf(p, r);
#pragma unroll
        for (int j = 0; j < 4; ++j) {
            const int c = lane * 4 + 256 * j;
            const f32x4 gg = *(const f32x4*)(p.g_mix_post + l * DM + c), gt = *(const f32x4*)(mv + 2048 + c);
            h[j] = h[j] + gt * (y[j] * rinv * gg);
            *(f32x4*)(hb + c) = h[j];
        }
        const float rinv2 = rsqrtf(row_sumsq(h) * (1.f / DM) + RMS_EPS);
        modulate_store(h, rinv2, p.g_ffn_pre + l * DM, mv + 3072, mv + 4096, U + (size_t)r * DM, lane);
    }
}

constexpr int MOE_LDS_OFF = 65536;
__device__ __forceinline__ void moe_tables(const Params& p, LAS unsigned char* lds, int l, int row_lo) {
    LAS int* cnt = (LAS int*)(lds + MOE_LDS_OFF); LAS int* tp = cnt + 80; LAS int* sp = tp + 80;
    const int tid = threadIdx.x;
    if (tid < 64) cnt[tid] = ((const int*)(p.ws + OFF_CNT))[l * 64 + tid];
    if (tid == 64) cnt[64] = TT - row_lo;
    __syncthreads();
    if (tid == 0) {
        int a = 0, s = 0;
        for (int e = 0; e < 65; ++e) { tp[e] = a; sp[e] = s; a += (cnt[e] + 127) >> 7; s += cnt[e]; }
        tp[65] = a;
    }
    __syncthreads();
}

__device__ __forceinline__ void ph_rowpassB(const Params& p, LAS unsigned char* lds, int l, int row_lo) {
    moe_tables(p, lds, l, row_lo);
    LAS int* sp = (LAS int*)(lds + MOE_LDS_OFF) + 160;
    const int lane = threadIdx.x & 63, gw = blockIdx.x * 4 + (threadIdx.x >> 6), ngw = gridDim.x * 4;
    const float* mod = (const float*)(p.ws + OFF_MOD) + (size_t)l * 3 * 6144;
    const bf16* YR = (const bf16*)(p.ws + AM_YR);
    const int* tokslot = (const int*)(p.ws + OFF_TOKSLOT); const float* W8 = (const float*)(p.ws + OFF_W8);
    bf16* U = (bf16*)(p.ws + OFF_U);
    const int c0 = lane * 8;
    for (int r = row_lo + gw; r < TT; r += ngw) {
        int ts = 0; float wv = 0.f;
        if (lane < 8) { ts = tokslot[(size_t)r * 8 + lane]; wv = W8[(size_t)r * 8 + lane]; }
        const int myslot = sp[ts >> 20] + (ts & 0xfffff);
        float f[16];
#pragma unroll
        for (int i = 0; i < 16; ++i) f[i] = 0.f;
#pragma unroll
        for (int k = 0; k < 9; ++k) {
            size_t slot; float wk = 1.f;
            if (k < 8) { slot = (size_t)__shfl(myslot, k); wk = __shfl(wv, k); } else slot = (size_t)TT * 8 + r;
            const bf16* yr = YR + slot * DM + c0;
            const u32x4 a = *(const u32x4*)yr, b2 = *(const u32x4*)(yr + 512);
            f[0] += wk * bflo(a.x); f[1] += wk * bfhi(a.x); f[2] += wk * bflo(a.y); f[3] += wk * bfhi(a.y);
            f[4] += wk * bflo(a.z); f[5] += wk * bfhi(a.z); f[6] += wk * bflo(a.w); f[7] += wk * bfhi(a.w);
            f[8] += wk * bflo(b2.x); f[9] += wk * bfhi(b2.x); f[10] += wk * bflo(b2.y); f[11] += wk * bfhi(b2.y);
            f[12] += wk * bflo(b2.z); f[13] += wk * bfhi(b2.z); f[14] += wk * bflo(b2.w); f[15] += wk * bfhi(b2.w);
        }
        float ss = 0.f;
#pragma unroll
        for (int i = 0; i < 16; ++i) ss += f[i] * f[i];
        const float rinv = rsqrtf(wave_sum(ss) * (1.f / DM) + RMS_EPS);
        const float* mv = mod + (size_t)modvec(r) * 6144;
        float* hb = hl_buf(p, r);
        float h[16];
#pragma unroll
        for (int q = 0; q < 4; ++q) {
            const int c = c0 + (q & 1) * 4 + (q >> 1) * 512;
            const f32x4 hv = *(const f32x4*)(hb + c), gg = *(const f32x4*)(p.g_ffn_post + l * DM + c), gt = *(const f32x4*)(mv + 5120 + c);
            const f32x4 fv = {f[q * 4 + 0], f[q * 4 + 1], f[q * 4 + 2], f[q * 4 + 3]};
            const f32x4 o = hv + gt * (fv * rinv * gg);
            *(f32x4*)(hb + c) = o;
            h[q * 4 + 0] = o.x; h[q * 4 + 1] = o.y; h[q * 4 + 2] = o.z; h[q * 4 + 3] = o.w;
        }
        if (l == 0) {
            float s2 = 0.f;
#pragma unroll
            for (int i = 0; i < 16; ++i) s2 += h[i] * h[i];
            const float rinv2 = rsqrtf(wave_sum(s2) * (1.f / DM) + RMS_EPS);
            const float* mv1 = mv + 3 * 6144;
#pragma unroll
            for (int hf = 0; hf < 2; ++hf) {
                const int c = c0 + hf * 512;
                const f32x4 g0 = *(const f32x4*)(p.g_mix_pre + DM + c), g1 = *(const f32x4*)(p.g_mix_pre + DM + c + 4);
                const f32x4 sh0 = *(const f32x4*)(mv1 + c), sh1 = *(const f32x4*)(mv1 + c + 4), sc0 = *(const f32x4*)(mv1 + 1024 + c), sc1 = *(const f32x4*)(mv1 + 1024 + c + 4);
                const f32x4 h0 = {h[hf * 8 + 0], h[hf * 8 + 1], h[hf * 8 + 2], h[hf * 8 + 3]}, h1 = {h[hf * 8 + 4], h[hf * 8 + 5], h[hf * 8 + 6], h[hf * 8 + 7]};
                const f32x4 o0 = h0 * rinv2 * g0 * (sc0 + 1.f) + sh0, o1 = h1 * rinv2 * g1 * (sc1 + 1.f) + sh1;
                *(u32x4*)(U + (size_t)r * DM + c) = (u32x4){pk2(o0.x, o0.y), pk2(o0.z, o0.w), pk2(o1.x, o1.y), pk2(o1.z, o1.w)};
            }
        }
    }
}

__device__ __forceinline__ int stg_col() { const int tid = threadIdx.x; return ((tid & 7) ^ ((tid >> 3) & 7)) * 8; }
__device__ __forceinline__ void plain_ptrs(const bf16* base, int row0, int ld, const bf16* (&pp)[4]) {
    const int tid = threadIdx.x;
    pp[0] = base + (size_t)(row0 + (tid >> 3)) * ld + stg_col();
#pragma unroll
    for (int i = 1; i < 4; ++i) pp[i] = pp[0] + (size_t)(32 * i) * ld;
}

__device__ __forceinline__ void ph_inproj0(const Params& p, LAS unsigned char* lds) {
    unsigned char* ws = p.ws;
    const bf16* U = (const bf16*)(ws + OFF_U); const bf16* W = (const bf16*)(ws + OFF_W_IN_E);
    bf16* Z0 = (bf16*)(ws + A0_Z0); bf16* VGT = (bf16*)(ws + A0_VGT); bf16* QS = (bf16*)(ws + A0_QS); bf16* KS = (bf16*)(ws + A0_KS); bf16* VST = (bf16*)(ws + A0_VST);
    const f32x2* rope = (const f32x2*)(ws + OFF_ROPE);
    const int tid = threadIdx.x, lane = tid & 63, wid = tid >> 6, wr = wid >> 1, wc = wid & 1, fr = lane & 15, fq = lane >> 4;
    constexpr int NTN = 19, NTM = TT / 128;
    auto make = [&](int t, GPtrs& g, int& nk) { int tm, tn; tile_mn(t, NTM, NTN, tm, tn); plain_ptrs(U, tm * 128, DM, g.a); plain_ptrs(W, tn * 128, DM, g.b); nk = DM / 64; };
    auto epi = [&](int t, f32x4 (&acc)[4][4]) {
        int tm, tn; tile_mn(t, NTM, NTN, tm, tn); const int brow = tm * 128, bcol = tn * 128;
        const int cb = bcol + wc * 64;
        LAS unsigned char* wl = lds + 32768 + wid * 8192;
        const int r0 = brow + wr * 64;
        const RowInfo ri0 = rowinfo(r0);
        if (cb < 1024) {
            epi_store_rows(wl, acc, fr, fq, lane, [&](int row) { return Z0 + (size_t)(r0 + row) * Z0P + cb; });
        } else if (cb < 1536) {
            const int c0 = cb - 1024;
            epi_store_cols(wl, acc, fr, fq, lane, [&](int col) { return VGT + (size_t)(c0 + col) * TT + r0; });
        } else if (cb < 2176) {
            const float sc = cb < 2048 ? 0.125f * LOG2E : 1.f;
#pragma unroll
            for (int m = 0; m < 4; ++m) {
                const int pos = ri0.pos + m * 16 + fr;
#pragma unroll
                for (int n = 0; n < 2; ++n)
#pragma unroll
                    for (int j = 0; j < 4; ++j) {
                        const float x1 = acc[m][n][j] * sc, x2 = acc[m][n + 2][j] * sc;
                        if (ri0.lat) { const f32x2 cs = rope[(size_t)pos * 32 + n * 16 + fq * 4 + j]; acc[m][n][j] = x1 * cs.x - x2 * cs.y; acc[m][n + 2][j] = x2 * cs.x + x1 * cs.y; }
                        else { acc[m][n][j] = x1; acc[m][n + 2][j] = x2; }
                    }
                asm volatile("" ::: "memory");
            }
            bf16* dst;
            if (cb < 2048) { const int h = (cb - 1536) >> 6; dst = QS + ((size_t)(ri0.b * 8 + h) * NKEY + ri0.kq) * 64; }
            else { const int h = (cb - 2048) >> 6; dst = KS + ((size_t)(ri0.b * 2 + h) * NKEY + ri0.kq) * 64; }
            epi_store_rows(wl, acc, fr, fq, lane, [&](int row) { return dst + (size_t)row * 64; });
        } else if (cb < 2304) {
            const int h = (cb - 2176) >> 6;
            bf16* dst = VST + (size_t)(ri0.b * 2 + h) * 64 * NKEY + ri0.kq;
            epi_store_cols(wl, acc, fr, fq, lane, [&](int col) { return dst + (size_t)col * NKEY; });
        } else if (cb == 2304) {
#pragma unroll
            for (int m = 0; m < 4; ++m) {
                const int r = r0 + m * 16 + fr;
#pragma unroll
                for (int n = 0; n < 2; ++n) { u32x2 w; w.x = pk2(acc[m][n][0], acc[m][n][1]); w.y = pk2(acc[m][n][2], acc[m][n][3]); *(u32x2*)(Z0 + (size_t)r * Z0P + 1024 + n * 16 + fq * 4) = w; }
            }
        }
    };
    gemm_tiles<true>(lds, vcu_id(), NTM * NTN, gridDim.x, make, epi);
}

__device__ __forceinline__ void ph_outproj(const Params& p, LAS unsigned char* lds, const bf16* MIX, const bf16* W, float* Y, int row_lo) {
    const int tid = threadIdx.x, lane = tid & 63, wid = tid >> 6, wr = wid >> 1, wc = wid & 1, fr = lane & 15, fq = lane >> 4;
    const int tm0 = row_lo / 128, ntm = TT / 128 - tm0;
    auto make = [&](int t, GPtrs& g, int& nk) { int tm, tn; tile_mn(t, ntm, 8, tm, tn); plain_ptrs(MIX, (tm0 + tm) * 128, DM, g.a); plain_ptrs(W, tn * 128, DM, g.b); nk = DM / 64; };
    auto epi = [&](int t, f32x4 (&acc)[4][4]) {
        int tm, tn; tile_mn(t, ntm, 8, tm, tn); tm += tm0; const int brow = tm * 128, bcol = tn * 128;
#pragma unroll
        for (int m = 0; m < 4; ++m) {
            const int r = brow + wr * 64 + m * 16 + fr;
#pragma unroll
            for (int n = 0; n < 4; ++n) *(f32x4*)(Y + (size_t)r * DM + bcol + wc * 64 + n * 16 + fq * 4) = acc[m][n];
        }
    };
    gemm_tiles<true, 16>(lds, vcu_id(), ntm * 8, gridDim.x, make, epi);
}

template <int DQK, int DV>
__device__ __forceinline__ void attn_item(LAS unsigned char* lds, const bf16* Qg, const bf16* Kg, const bf16* VTg, int a1, int b0, int b1, int qpos0,
                                          float m_init, float l_init, bf16* Og, int o_pitch) {
    constexpr int KPB = DQK * 2, NS = DQK / 16, NDV = DV / 32, KCH = DQK / 8, KBYTES = 64 * KPB, KN = 64 * KCH / 256, VN = DV * 8 / 256;
    static_assert(KN == 6 || KN == 2, "counted waits below are written for KN = 6 or 2");
    const int tid = threadIdx.x, lane = tid & 63, wid = tid >> 6, ql = lane & 31, hi = lane >> 5;
    LAS unsigned char* Kb0 = lds; LAS unsigned char* Vs = lds + 2 * KBYTES;
    asm volatile("s_waitcnt vmcnt(0) lgkmcnt(0)" ::: "memory");
    __builtin_amdgcn_s_barrier();
    asm volatile("" ::: "memory");
    bf16x8 qf[NS];
    {
        const bf16* qrow = Qg + (size_t)(wid * 32 + ql) * DQK + hi * 8;
#pragma unroll
        for (int s = 0; s < NS; ++s) qf[s] = *(const bf16x8*)(qrow + s * 16);
    }
    unsigned koff[KN], voff[VN];
#pragma unroll
    for (int i = 0; i < KN; ++i) { const int pz = tid + 256 * i, key = pz / KCH, ch = pz % KCH; koff[i] = (unsigned)(key * DQK + (((ch & ~7) | ((ch & 7) ^ ((key >> 1) & 7))) * 8)); }
#pragma unroll
    for (int i = 0; i < VN; ++i) { const int pz = tid + 256 * i, dv = pz >> 3, ch = pz & 7; voff[i] = (unsigned)(dv * NKEY + ((ch ^ ((dv >> 1) & 7)) * 8)); }
    const int ntot = a1 + (b1 - b0);
#define ATTN_KT(it_) ((it_) < a1 ? (it_) : b0 + ((it_) - a1))
#define ATTN_DMA_K(kt_, buf_) do { _Pragma("unroll") for (int i_ = 0; i_ < KN; ++i_) glds16(Kg + (size_t)(kt_) * 64 * DQK + koff[i_], Kb0 + (buf_) * KBYTES + (tid + 256 * i_) * 16); } while (0)
#define ATTN_DMA_V(kt_) do { _Pragma("unroll") for (int i_ = 0; i_ < VN; ++i_) glds16(VTg + (size_t)(kt_) * 64 + voff[i_], Vs + (tid + 256 * i_) * 16); } while (0)
    ATTN_DMA_K(ATTN_KT(0), 0);
    f32x16 o[NDV];
#pragma unroll
    for (int d = 0; d < NDV; ++d)
#pragma unroll
        for (int r = 0; r < 16; ++r) o[d][r] = 0.f;
    float mrun = m_init, lrun = l_init;
    const int sw = (ql >> 1) & 7;
    const LAS unsigned char* kfrag = Kb0 + ql * KPB; const LAS unsigned char* vfrag = Vs + ql * 128;
    for (int it = 0; it < ntot; ++it) {
        const int kt = ATTN_KT(it), cur = it & 1;
        const bool masked = it >= a1;
        asm volatile("s_waitcnt vmcnt(0) lgkmcnt(0)" ::: "memory");
        __builtin_amdgcn_s_barrier();
        asm volatile("" ::: "memory");
        ATTN_DMA_V(kt);
        if (it + 1 < ntot) { const int ktn = ATTN_KT(it + 1); ATTN_DMA_K(ktn, cur ^ 1); }
        f32x16 p0, p1;
#pragma unroll
        for (int r = 0; r < 16; ++r) { p0[r] = 0.f; p1[r] = 0.f; }
        const LAS unsigned char* kc = kfrag + cur * KBYTES;
#pragma unroll
        for (int s = 0; s < NS; ++s) {
            const int c = 2 * s + hi, off = ((c & ~7) | ((c & 7) ^ sw)) * 16;
            const bf16x8 k0 = *(const LAS bf16x8*)(kc + off);
            const bf16x8 k1 = *(const LAS bf16x8*)(kc + 32 * KPB + off);
            p0 = __builtin_amdgcn_mfma_f32_32x32x16_bf16(k0, qf[s], p0, 0, 0, 0);
            p1 = __builtin_amdgcn_mfma_f32_32x32x16_bf16(k1, qf[s], p1, 0, 0, 0);
        }
        if (masked) {
            const int kbase = kt * 64 - CTX, qpos = qpos0 + wid * 32 + ql;
#pragma unroll
            for (int r = 0; r < 16; ++r) {
                const int d0 = qpos - (kbase + crow(r, hi)), d1 = d0 - 32;
                if (d0 > 128 || d0 < -128) p0[r] = -1e30f;
                if (d1 > 128 || d1 < -128) p1[r] = -1e30f;
            }
        }
        float mx = p0[0];
#pragma unroll
        for (int r = 1; r < 16; ++r) mx = fmaxf(mx, p0[r]);
#pragma unroll
        for (int r = 0; r < 16; ++r) mx = fmaxf(mx, p1[r]);
        mx = fmaxf(mx, __shfl_xor(mx, 32));
        if (__any(mx > mrun + 8.f)) {
            const float mn = fmaxf(mrun, mx), alpha = ex2(mrun - mn);
            mrun = mn; lrun *= alpha;
#pragma unroll
            for (int d = 0; d < NDV; ++d)
#pragma unroll
                for (int r = 0; r < 16; ++r) o[d][r] *= alpha;
        }
        float rs = 0.f;
#pragma unroll
        for (int r = 0; r < 16; ++r) { p0[r] = ex2(p0[r] - mrun); rs += p0[r]; }
#pragma unroll
        for (int r = 0; r < 16; ++r) { p1[r] = ex2(p1[r] - mrun); rs += p1[r]; }
        rs += __shfl_xor(rs, 32);
        lrun += rs;
        bf16x8 pf[4];
#define ATTN_PK4(P, BASE, OUT) do { const unsigned a0_ = pk2(P[BASE + 0], P[BASE + 1]), a1_ = pk2(P[BASE + 2], P[BASE + 3]), b0_ = pk2(P[BASE + 4], P[BASE + 5]), b1_ = pk2(P[BASE + 6], P[BASE + 7]); \
        const auto r0_ = __builtin_amdgcn_permlane32_swap(a0_, b0_, false, false); const auto r1_ = __builtin_amdgcn_permlane32_swap(a1_, b1_, false, false); \
        OUT = mk8((u32x4){r0_[0], r1_[0], r0_[1], r1_[1]}); } while (0)
        ATTN_PK4(p0, 0, pf[0]); ATTN_PK4(p0, 8, pf[1]); ATTN_PK4(p1, 0, pf[2]); ATTN_PK4(p1, 8, pf[3]);
#undef ATTN_PK4
        if (it + 1 < ntot) { if (KN == 6) asm volatile("s_waitcnt vmcnt(6) lgkmcnt(0)" ::: "memory"); else asm volatile("s_waitcnt vmcnt(2) lgkmcnt(0)" ::: "memory"); }
        else asm volatile("s_waitcnt vmcnt(0) lgkmcnt(0)" ::: "memory");
        __builtin_amdgcn_s_barrier();
        asm volatile("" ::: "memory");
#pragma unroll
        for (int d = 0; d < NDV; ++d) {
#pragma unroll
            for (int kk = 0; kk < 4; ++kk) {
                const bf16x8 vf = *(const LAS bf16x8*)(vfrag + d * 32 * 128 + (((2 * kk + hi) ^ sw) * 16));
                o[d] = __builtin_amdgcn_mfma_f32_32x32x16_bf16(vf, pf[kk], o[d], 0, 0, 0);
            }
        }
    }
#undef ATTN_KT
#undef ATTN_DMA_K
#undef ATTN_DMA_V
    const float inv = 1.f / lrun;
    bf16* orow = Og + (size_t)(wid * 32 + ql) * o_pitch;
#pragma unroll
    for (int d = 0; d < NDV; ++d)
#pragma unroll
        for (int g = 0; g < 4; ++g) {
            u32x2 w; w.x = pk2(o[d][g * 4 + 0] * inv, o[d][g * 4 + 1] * inv); w.y = pk2(o[d][g * 4 + 2] * inv, o[d][g * 4 + 3] * inv);
            *(u32x2*)(orow + d * 32 + 8 * g + 4 * hi) = w;
        }
}

constexpr int GA_CUM = 0, GA_ALOW = 16384, GA_WA = 20480, GA_BA = 24576, GA_QT = 24832, GA_TOT = 25856, GA_END = 26112;
__device__ __forceinline__ void gla_cum(const Params& p, LAS unsigned char* lds, const bf16* Z0, int r0, int h, int dir) {
    const int tid = threadIdx.x;
    LAS float* cum = (LAS float*)(lds + GA_CUM); LAS float* alow = (LAS float*)(lds + GA_ALOW); LAS float* wa = (LAS float*)(lds + GA_WA);
    LAS float* ba = (LAS float*)(lds + GA_BA); LAS float* qt = (LAS float*)(lds + GA_QT); LAS float* tot = (LAS float*)(lds + GA_TOT);
    {
        const int t = tid >> 2, i4 = (tid & 3) * 4;
        const u32x2 w = *(const u32x2*)(Z0 + (size_t)(r0 + t) * Z0P + 1024 + dir * 16 + i4);
        alow[t * 16 + i4 + 0] = bflo(w.x); alow[t * 16 + i4 + 1] = bfhi(w.x); alow[t * 16 + i4 + 2] = bflo(w.y); alow[t * 16 + i4 + 3] = bfhi(w.y);
#pragma unroll
        for (int q = 0; q < 4; ++q) { const int idx = tid * 4 + q, i = idx >> 6, j = idx & 63; wa[idx] = p.gla_wa2[(size_t)(dir * 16 + i) * 256 + h * 64 + j]; }
        if (tid < 64) ba[tid] = p.gla_ba[dir * 256 + h * 64 + tid];
    }
    __syncthreads();
    const int j = tid & 63, tq = tid >> 6;
    float la[16], wj[16];
#pragma unroll
    for (int i = 0; i < 16; ++i) wj[i] = wa[i * 64 + j];
    const float bj = ba[j];
#pragma unroll
    for (int tt = 0; tt < 16; ++tt) {
        const int t = tq * 16 + tt;
        float x = bj;
#pragma unroll
        for (int q = 0; q < 4; ++q) { const f32x4 a = *(const LAS f32x4*)(alow + t * 16 + q * 4);
            x += a.x * wj[q * 4] + a.y * wj[q * 4 + 1] + a.z * wj[q * 4 + 2] + a.w * wj[q * 4 + 3]; }
        la[tt] = (fminf(x, 0.f) - __logf(1.f + __expf(-fabsf(x)))) * (1.f / 16.f);
    }
    float run = 0.f;
    if (dir == 0) {
#pragma unroll
        for (int tt = 0; tt < 16; ++tt) { run += la[tt]; cum[(tq * 16 + tt) * 64 + j] = run; }
    } else {
#pragma unroll
        for (int tt = 15; tt >= 0; --tt) { run += la[tt]; cum[(tq * 16 + tt) * 64 + j] = run; }
    }
    qt[tq * 64 + j] = run;
    __syncthreads();
    float off = 0.f, total = 0.f;
#pragma unroll
    for (int q = 0; q < 4; ++q) { const float v = qt[q * 64 + j]; total += v; if (dir == 0 ? (q < tq) : (q > tq)) off += v; }
#pragma unroll
    for (int tt = 0; tt < 16; ++tt) cum[(tq * 16 + tt) * 64 + j] += off;
    if (tq == 0) tot[j] = total;
    __syncthreads();
}

__device__ __forceinline__ int gla_row0(int b, int cc) { return cc < 4 ? b * CTX + cc * 64 : TC + b * SEQ + (cc - 4) * 64; }
__device__ __forceinline__ int gla_step(int cc, int dir) { return dir == 0 ? cc : (cc < 4 ? 3 - cc : 4 + (131 - cc)); }

__device__ __forceinline__ void gla_g1_item(const Params& p, LAS unsigned char* lds, int item) {
    unsigned char* ws = p.ws;
    const bf16* Z0 = (const bf16*)(ws + A0_Z0); const bf16* VGT = (const bf16*)(ws + A0_VGT);
    bf16* GS = (bf16*)(ws + A0_GS); float* GD = (float*)(ws + A0_GD);
    const int cc = item % NSTEP, rest = item / NSTEP, dir = rest & 1, h = (rest >> 1) & 3, b = rest >> 3;
    const int r0 = gla_row0(b, cc), step = gla_step(cc, dir), chain = (b * 4 + h) * 2 + dir;
    const int tid = threadIdx.x, lane = tid & 63, wid = tid >> 6, fr = lane & 15, fq = lane >> 4;
    __syncthreads();
    gla_cum(p, lds, Z0, r0, h, dir);
    LAS float* cum = (LAS float*)(lds + GA_CUM); LAS float* tot = (LAS float*)(lds + GA_TOT);
    LAS bf16* KT = (LAS bf16*)(lds + GA_END);
    {
        const int t = tid >> 2, d0 = (tid & 3) * 16;
        const u32x4 w0 = *(const u32x4*)(Z0 + (size_t)(r0 + t) * Z0P + 256 + h * 64 + d0), w1 = *(const u32x4*)(Z0 + (size_t)(r0 + t) * Z0P + 256 + h * 64 + d0 + 8);
        const unsigned ww[8] = {w0.x, w0.y, w0.z, w0.w, w1.x, w1.y, w1.z, w1.w};
#pragma unroll
        for (int i = 0; i < 8; ++i) {
            const int d = d0 + 2 * i;
            KT[d * 72 + t] = f2bf(bflo(ww[i]) * __expf(tot[d] - cum[t * 64 + d]));
            KT[(d + 1) * 72 + t] = f2bf(bfhi(ww[i]) * __expf(tot[d + 1] - cum[t * 64 + d + 1]));
        }
    }
    if (tid < 64) GD[((size_t)chain * NSTEP + step) * 64 + tid] = __expf(tot[tid]);
    __syncthreads();
    f32x4 acc[2][4];
#pragma unroll
    for (int m = 0; m < 2; ++m)
#pragma unroll
        for (int n = 0; n < 4; ++n) acc[m][n] = (f32x4){0.f, 0.f, 0.f, 0.f};
#pragma unroll
    for (int ks = 0; ks < 2; ++ks) {
        bf16x8 af[2], bfr[4];
#pragma unroll
        for (int m = 0; m < 2; ++m) af[m] = *(const bf16x8*)(VGT + (size_t)(h * 128 + wid * 32 + m * 16 + fr) * TT + r0 + ks * 32 + fq * 8);
#pragma unroll
        for (int n = 0; n < 4; ++n) bfr[n] = *(const LAS bf16x8*)(KT + (n * 16 + fr) * 72 + ks * 32 + fq * 8);
#pragma unroll
        for (int m = 0; m < 2; ++m)
#pragma unroll
            for (int n = 0; n < 4; ++n) acc[m][n] = __builtin_amdgcn_mfma_f32_16x16x32_bf16(bfr[n], af[m], acc[m][n], 0, 0, 0);
    }
    bf16* dst = GS + ((size_t)chain * NSTEP + step) * 8192;
#pragma unroll
    for (int m = 0; m < 2; ++m)
#pragma unroll
        for (int n = 0; n < 4; ++n) *(u32x2*)(dst + (size_t)(wid * 32 + m * 16 + fr) * 64 + n * 16 + fq * 4) = (u32x2){pk2(acc[m][n][0], acc[m][n][1]), pk2(acc[m][n][2], acc[m][n][3])};
}

__device__ __forceinline__ void ph_gla_scan(const Params& p) {
    unsigned* GS = (unsigned*)(p.ws + A0_GS); const float* GD = (const float*)(p.ws + A0_GD);
    for (int idx = blockIdx.x * 256 + threadIdx.x; idx < 16 * 4096; idx += gridDim.x * 256) {
        const int chain = idx >> 12, e2 = idx & 4095, dk = (e2 & 31) * 2;
        unsigned* g = GS + (size_t)chain * NSTEP * 4096 + e2;
        const f32x2* d = (const f32x2*)(GD + (size_t)chain * NSTEP * 64 + dk);
        float s0 = 0.f, s1 = 0.f;
#pragma unroll 12
        for (int s = 0; s < NSTEP; ++s) {
            const unsigned t = g[(size_t)s * 4096]; const f32x2 dec = d[s * 32];
            g[(size_t)s * 4096] = pk2(s0, s1);
            s0 = dec.x * s0 + bflo(t); s1 = dec.y * s1 + bfhi(t);
        }
    }
}

__device__ __forceinline__ void gla_g3_item(const Params& p, LAS unsigned char* lds, int item) {
    unsigned char* ws = p.ws;
    const bf16* Z0 = (const bf16*)(ws + A0_Z0); const bf16* VGT = (const bf16*)(ws + A0_VGT);
    const bf16* GS = (const bf16*)(ws + A0_GS); bf16* MIX = (bf16*)(ws + A0_MIX);
    const int cc = item % NSTEP, rest = item / NSTEP, h = rest & 3, b = rest >> 2;
    const int r0 = gla_row0(b, cc);
    const int tid = threadIdx.x, lane = tid & 63, wid = tid >> 6, fr = lane & 15, fq = lane >> 4;
    LAS bf16* QT = (LAS bf16*)(lds + GA_END);
    LAS bf16* QI = (LAS bf16*)(lds + GA_END + 9216);
    LAS bf16* KT = (LAS bf16*)(lds + GA_END + 18432);
    LAS bf16* PP = (LAS bf16*)(lds);
    f32x4 o[4][2];
#pragma unroll
    for (int m = 0; m < 4; ++m)
#pragma unroll
        for (int n = 0; n < 2; ++n) o[m][n] = (f32x4){0.f, 0.f, 0.f, 0.f};
    for (int dir = 0; dir < 2; ++dir) {
        const int step = gla_step(cc, dir), chain = (b * 4 + h) * 2 + dir;
        __syncthreads();
        gla_cum(p, lds, Z0, r0, h, dir);
        LAS float* cum = (LAS float*)(lds + GA_CUM); LAS float* tot = (LAS float*)(lds + GA_TOT);
        {
            const int t = tid >> 2, d0 = (tid & 3) * 16;
            const bf16* zr = Z0 + (size_t)(r0 + t) * Z0P + h * 64 + d0;
            const u32x4 q0 = *(const u32x4*)(zr), q1 = *(const u32x4*)(zr + 8), k0 = *(const u32x4*)(zr + 256), k1 = *(const u32x4*)(zr + 264);
            const unsigned qq[8] = {q0.x, q0.y, q0.z, q0.w, q1.x, q1.y, q1.z, q1.w}, kk[8] = {k0.x, k0.y, k0.z, k0.w, k1.x, k1.y, k1.z, k1.w};
            unsigned oqt[8], oqi[8], okt[8];
#pragma unroll
            for (int i = 0; i < 8; ++i) {
                const int d = d0 + 2 * i;
                const float c0 = cum[t * 64 + d], c1 = cum[t * 64 + d + 1], t0 = tot[d], t1 = tot[d + 1];
                const float qa = bflo(qq[i]), qb = bfhi(qq[i]), ka = bflo(kk[i]), kb = bfhi(kk[i]);
                oqt[i] = pk2(qa * __expf(c0 - t0), qb * __expf(c1 - t1));
                oqi[i] = pk2(qa * __expf(c0), qb * __expf(c1));
                okt[i] = pk2(ka * __expf(t0 - c0), kb * __expf(t1 - c1));
            }
            *(LAS u32x4*)(QT + t * 72 + d0) = (u32x4){oqt[0], oqt[1], oqt[2], oqt[3]}; *(LAS u32x4*)(QT + t * 72 + d0 + 8) = (u32x4){oqt[4], oqt[5], oqt[6], oqt[7]};
            *(LAS u32x4*)(QI + t * 72 + d0) = (u32x4){oqi[0], oqi[1], oqi[2], oqi[3]}; *(LAS u32x4*)(QI + t * 72 + d0 + 8) = (u32x4){oqi[4], oqi[5], oqi[6], oqi[7]};
            *(LAS u32x4*)(KT + t * 72 + d0) = (u32x4){okt[0], okt[1], okt[2], okt[3]}; *(LAS u32x4*)(KT + t * 72 + d0 + 8) = (u32x4){okt[4], okt[5], okt[6], okt[7]};
        }
        __syncthreads();
        {
            f32x4 sa[4];
#pragma unroll
            for (int m = 0; m < 4; ++m) sa[m] = (f32x4){0.f, 0.f, 0.f, 0.f};
#pragma unroll
            for (int ks = 0; ks < 2; ++ks) {
                const bf16x8 kf = *(const LAS bf16x8*)(KT + (wid * 16 + fr) * 72 + ks * 32 + fq * 8);
#pragma unroll
                for (int m = 0; m < 4; ++m) {
                    const bf16x8 qfm = *(const LAS bf16x8*)(QT + (m * 16 + fr) * 72 + ks * 32 + fq * 8);
                    sa[m] = __builtin_amdgcn_mfma_f32_16x16x32_bf16(kf, qfm, sa[m], 0, 0, 0);
                }
            }
#pragma unroll
            for (int m = 0; m < 4; ++m) {
                const int t = m * 16 + fr;
                float v[4];
#pragma unroll
                for (int jj = 0; jj < 4; ++jj) { const int j = wid * 16 + fq * 4 + jj; const bool keep = dir == 0 ? (j <= t) : (j >= t); v[jj] = keep ? sa[m][jj] : 0.f; }
                *(LAS u32x2*)(PP + t * 72 + wid * 16 + fq * 4) = (u32x2){pk2(v[0], v[1]), pk2(v[2], v[3])};
            }
        }
        __syncthreads();
        const bf16* Sg = GS + ((size_t)chain * NSTEP + step) * 8192;
#pragma unroll
        for (int ks = 0; ks < 2; ++ks) {
            bf16x8 vfr[2], sfr[2];
#pragma unroll
            for (int n = 0; n < 2; ++n) {
                const int dv = wid * 32 + n * 16 + fr;
                vfr[n] = *(const bf16x8*)(VGT + (size_t)(h * 128 + dv) * TT + r0 + ks * 32 + fq * 8);
                sfr[n] = *(const bf16x8*)(Sg + (size_t)dv * 64 + ks * 32 + fq * 8);
            }
#pragma unroll
            for (int m = 0; m < 4; ++m) {
                const bf16x8 pfm = *(const LAS bf16x8*)(PP + (m * 16 + fr) * 72 + ks * 32 + fq * 8);
                const bf16x8 qim = *(const LAS bf16x8*)(QI + (m * 16 + fr) * 72 + ks * 32 + fq * 8);
#pragma unroll
                for (int n = 0; n < 2; ++n) {
                    o[m][n] = __builtin_amdgcn_mfma_f32_16x16x32_bf16(vfr[n], pfm, o[m][n], 0, 0, 0);
                    o[m][n] = __builtin_amdgcn_mfma_f32_16x16x32_bf16(sfr[n], qim, o[m][n], 0, 0, 0);
                }
            }
        }
    }
    __syncthreads();
    LAS float* red = (LAS float*)(lds + GA_END + 27648);
#pragma unroll
    for (int m = 0; m < 4; ++m) {
        float s = 0.f;
#pragma unroll
        for (int n = 0; n < 2; ++n)
#pragma unroll
            for (int j = 0; j < 4; ++j) s += o[m][n][j] * o[m][n][j];
        s += __shfl_xor(s, 16); s += __shfl_xor(s, 32);
        if (fq == 0) red[wid * 64 + m * 16 + fr] = s;
    }
    __syncthreads();
#pragma unroll
    for (int m = 0; m < 4; ++m) {
        const int t = m * 16 + fr;
        const float ss = red[t] + red[64 + t] + red[128 + t] + red[192 + t];
        const float rinv = rsqrtf(ss * (1.f / 128.f) + RMS_EPS);
        const int r = r0 + t;
#pragma unroll
        for (int n = 0; n < 2; ++n) {
            const int dv = wid * 32 + n * 16 + fq * 4;
            const u32x2 gw = *(const u32x2*)(Z0 + (size_t)r * Z0P + 512 + h * 128 + dv);
            const f32x4 ng = *(const f32x4*)(p.gla_norm + dv);
            const float g0 = bflo(gw.x), g1 = bfhi(gw.x), g2 = bflo(gw.y), g3 = bfhi(gw.y);
            const float y0 = o[m][n][0] * rinv * ng.x * siluf(g0), y1 = o[m][n][1] * rinv * ng.y * siluf(g1);
            const float y2 = o[m][n][2] * rinv * ng.z * siluf(g2), y3 = o[m][n][3] * rinv * ng.w * siluf(g3);
            *(u32x2*)(MIX + (size_t)r * DM + h * 128 + dv) = (u32x2){pk2(y0, y1), pk2(y2, y3)};
        }
    }
}

__device__ __forceinline__ void ph_swa_g1(const Params& p, LAS unsigned char* lds) {
    unsigned char* ws = p.ws;
    const bf16* QS = (const bf16*)(ws + A0_QS); const bf16* KS = (const bf16*)(ws + A0_KS); const bf16* VST = (const bf16*)(ws + A0_VST); bf16* MIX = (bf16*)(ws + A0_MIX);
    constexpr int N_SWA = 2 * 8 * 66, N_G1 = 2 * 4 * 2 * NSTEP;
    for (int item = blockIdx.x; item < N_SWA + N_G1; item += gridDim.x) {
        if (item < N_SWA) {
            const int qt = item % 66, rest = item / 66, h = rest & 7, b = rest >> 3, kvh = h >> 2;
            const bf16* Qg = QS + ((size_t)(b * 8 + h) * NKEY + qt * 128) * 64;
            const bf16* Kg = KS + (size_t)(b * 2 + kvh) * NKEY * 64;
            const bf16* Vg = VST + (size_t)(b * 2 + kvh) * 64 * NKEY;
            int b0 = 0, b1 = 0, qpos0 = 0, row0;
            if (qt >= 2) { qpos0 = (qt - 2) * 128; const int lo = qpos0 - 128 < 0 ? 0 : qpos0 - 128, hi2 = qpos0 + 256 > SEQ ? SEQ : qpos0 + 256; b0 = 4 + lo / 64; b1 = 4 + hi2 / 64; row0 = TC + b * SEQ + qpos0; }
            else row0 = b * CTX + qt * 128;
            const float sink = p.swa_sink[h] * LOG2E;
            attn_item<64, 64>(lds, Qg, Kg, Vg, 4, b0, b1, qpos0, sink, 1.f, MIX + (size_t)row0 * DM + 512 + h * 64, DM);
        } else gla_g1_item(p, lds, item - N_SWA);
    }
}
__device__ __forceinline__ void ph_gla_g3(const Params& p, LAS unsigned char* lds) {
    for (int item = blockIdx.x; item < 2 * 4 * NSTEP; item += gridDim.x) gla_g3_item(p, lds, item);
}

__device__ __forceinline__ void ph_router(const Params& p, LAS unsigned char* lds, int l, int row_lo) {
    unsigned char* ws = p.ws;
    const bf16* U = (const bf16*)(ws + OFF_U); const bf16* W = (const bf16*)(ws + OFF_W_RT) + (size_t)l * 128 * DM;
    int* cntg = (int*)(ws + OFF_CNT) + l * 64; int* tokslot = (int*)(ws + OFF_TOKSLOT); float* W8 = (float*)(ws + OFF_W8); int* LIST = (int*)(ws + OFF_LIST);
    const int tid = threadIdx.x, lane = tid & 63, wid = tid >> 6, wr = wid >> 1, wc = wid & 1, fr = lane & 15, fq = lane >> 4;
    LAS float* lg = (LAS float*)lds;
    const int tm0 = row_lo / 128;
    auto make = [&](int tm, GPtrs& g, int& nk) { plain_ptrs(U, tm * 128, DM, g.a); plain_ptrs(W, 0, DM, g.b); nk = DM / 64; };
    auto epi = [&](int tm, f32x4 (&acc)[4][4]) {
        const int brow = tm * 128;
        if (wc == 0) {
#pragma unroll
            for (int m = 0; m < 4; ++m)
#pragma unroll
                for (int n = 0; n < 4; ++n)
#pragma unroll
                    for (int j = 0; j < 4; ++j) lg[(wr * 64 + m * 16 + fr) * 65 + n * 16 + fq * 4 + j] = acc[m][n][j];
        }
        __syncthreads();
        LAS float* biasl = (LAS float*)(lds + 34816); LAS int* hist = (LAS int*)(lds + 34816 + 256); LAS int* basel = (LAS int*)(lds + 34816 + 512);
        if (tid < 64) { biasl[tid] = p.b_router[l * 64 + tid]; hist[tid] = 0; }
        __syncthreads();
        int esel[8], lrank[8]; float ssel[8]; float wsum = 0.f;
        if (tid < 128) {
            LAS float* L = lg + tid * 65;
            float gs[8];
#pragma unroll
            for (int g = 0; g < 8; ++g) {
                float m1 = -INFINITY, m2 = -INFINITY;
#pragma unroll
                for (int j = 0; j < 8; ++j) {
                    const int e = g * 8 + j;
                    const float sel = 1.f / (1.f + expf(-L[e])) + biasl[e];
                    L[e] = sel;
                    if (sel > m1) { m2 = m1; m1 = sel; } else if (sel > m2) m2 = sel;
                }
                gs[g] = m1 + m2;
            }
            unsigned allowed = 0u;
#pragma unroll
            for (int g = 0; g < 8; ++g) {
                int rk = 0;
#pragma unroll
                for (int h = 0; h < 8; ++h) rk += (gs[h] > gs[g] || (gs[h] == gs[g] && h < g)) ? 1 : 0;
                if (rk < 4) allowed |= 1u << g;
            }
#pragma unroll
            for (int k = 0; k < 8; ++k) {
                float best = -INFINITY; int bi = 0;
#pragma unroll
                for (int g = 0; g < 8; ++g) {
                    if ((allowed >> g) & 1u) {
#pragma unroll
                        for (int j = 0; j < 8; ++j) { const float v = L[g * 8 + j]; if (v > best) { best = v; bi = g * 8 + j; } }
                    }
                }
                esel[k] = bi; ssel[k] = best - biasl[bi]; wsum += ssel[k]; L[bi] = -INFINITY;
            }
#pragma unroll
            for (int k = 0; k < 8; ++k) lrank[k] = __hip_atomic_fetch_add(hist + esel[k], 1, __ATOMIC_RELAXED, __HIP_MEMORY_SCOPE_WORKGROUP);
        }
        __syncthreads();
        if (tid < 64) { const int c = hist[tid]; basel[tid] = c > 0 ? atomicAdd(cntg + tid, c) : 0; }
        __syncthreads();
        if (tid < 128) {
            const int t = brow + tid; const float wn = 2.5f / wsum;
#pragma unroll
            for (int k = 0; k < 8; ++k) {
                const int e = esel[k], pos = basel[e] + lrank[k];
                tokslot[(size_t)t * 8 + k] = (e << 20) | pos;
                W8[(size_t)t * 8 + k] = ssel[k] * wn;
                LIST[(size_t)e * TT + pos] = t * 8 + k;
            }
        }
    };
    gemm_tiles<false>(lds, tm0 + vcu_id(), TT / 128, gridDim.x, make, epi);
}

__device__ __forceinline__ int moe_find_expert(const LAS int* tp, int mtg) {
    int lo = 0, hi = 64;
    while (lo < hi) { const int mid = (lo + hi + 1) >> 1; if (tp[mid] <= mtg) lo = mid; else hi = mid - 1; }
    return lo;
}
__device__ __forceinline__ void ph_moe1(const Params& p, LAS unsigned char* lds, int l, int row_lo) {
    unsigned char* ws = p.ws;
    moe_tables(p, lds, l, row_lo);
    LAS int* cnt = (LAS int*)(lds + MOE_LDS_OFF); LAS int* tp = cnt + 80; LAS int* sp = tp + 80;
    const bf16* U = (const bf16*)(ws + OFF_U); const bf16* WGU = (const bf16*)(ws + OFF_W_GU); bf16* HM = (bf16*)(ws + AM_HM);
    const int* LIST = (const int*)(ws + OFF_LIST);
    const int tid = threadIdx.x, lane = tid & 63, wid = tid >> 6, wr = wid >> 1, wc = wid & 1, fr = lane & 15, fq = lane >> 4;
    const int ntiles = tp[65] * 4;
    auto make = [&](int t, GPtrs& g, int& nk) {
        const int mtg = t >> 2, nt = t & 3, e = moe_find_expert(tp, mtg), mt = mtg - tp[e], ce = cnt[e];
        int lv[4];
#pragma unroll
        for (int i = 0; i < 4; ++i) { const int li = mt * 128 + (tid >> 3) + 32 * i; lv[i] = LIST[(size_t)(e < 64 ? e : 0) * TT + (li < ce ? li : 0)]; }
#pragma unroll
        for (int i = 0; i < 4; ++i) {
            const int li = mt * 128 + (tid >> 3) + 32 * i;
            const int tk = li < ce ? (e < 64 ? (lv[i] >> 3) : row_lo + li) : row_lo;
            g.a[i] = U + (size_t)tk * DM + stg_col();
        }
        plain_ptrs(WGU + (size_t)e * 512 * DM, nt * 128, DM, g.b); nk = DM / 64;
    };
    auto epi = [&](int t, f32x4 (&acc)[4][4]) {
        const int mtg = t >> 2, nt = t & 3, e = moe_find_expert(tp, mtg), mt = mtg - tp[e], ce = cnt[e];
        const size_t slot0 = e < 64 ? (size_t)(sp[e] + mt * 128) : (size_t)TT * 8 + row_lo + mt * 128;
        const int hc0 = nt * 64 + wc * 32;
        bf16* dump = (bf16*)(ws + OFF_DUMP) + lane * 64;
#pragma unroll
        for (int m = 0; m < 4; ++m) {
            const int i = wr * 64 + m * 16 + fr;
            bf16* hrow = (mt * 128 + i < ce) ? HM + (slot0 + i) * 256 + hc0 + fq * 4 : dump;
#pragma unroll
            for (int n = 0; n < 2; ++n) {
                const f32x4 g = acc[m][n], u = acc[m][n + 2];
                const u32x2 w = {pk2(siluf(g[0]) * u[0], siluf(g[1]) * u[1]), pk2(siluf(g[2]) * u[2], siluf(g[3]) * u[3])};
                *(u32x2*)(hrow + n * 16) = w;
            }
        }
    };
    gemm_tiles<true, 8>(lds, vcu_id(), ntiles, gridDim.x, make, epi);
}
__device__ __forceinline__ void ph_moe2(const Params& p, LAS unsigned char* lds, int l, int row_lo) {
    unsigned char* ws = p.ws;
    moe_tables(p, lds, l, row_lo);
    LAS int* cnt = (LAS int*)(lds + MOE_LDS_OFF); LAS int* tp = cnt + 80; LAS int* sp = tp + 80;
    const bf16* HM = (const bf16*)(ws + AM_HM); const bf16* WD = (const bf16*)(ws + OFF_W_D); bf16* YR = (bf16*)(ws + AM_YR);
    const int tid = threadIdx.x, lane = tid & 63, wid = tid >> 6, wr = wid >> 1, wc = wid & 1, fr = lane & 15, fq = lane >> 4;
    const int ntiles = tp[65] * 8;
    auto make = [&](int t, GPtrs& g, int& nk) {
        const int mtg = t >> 3, nt = t & 7, e = moe_find_expert(tp, mtg), mt = mtg - tp[e];
        const size_t slot0 = e < 64 ? (size_t)(sp[e] + mt * 128) : (size_t)TT * 8 + row_lo + mt * 128;
        plain_ptrs(HM, 0, 256, g.a);
#pragma unroll
        for (int i = 0; i < 4; ++i) g.a[i] += slot0 * 256;
        plain_ptrs(WD + (size_t)e * DM * 256, nt * 128, 256, g.b); nk = 256 / 64;
    };
    auto epi = [&](int t, f32x4 (&acc)[4][4]) {
        const int mtg = t >> 3, nt = t & 7, e = moe_find_expert(tp, mtg), mt = mtg - tp[e], ce = cnt[e];
        const size_t slot0 = e < 64 ? (size_t)(sp[e] + mt * 128) : (size_t)TT * 8 + row_lo + mt * 128;
        LAS unsigned char* wl = lds + 32768 + wid * 8192;
        const int i0 = wr * 64;
        bf16* dump = (bf16*)(ws + OFF_DUMP) + wid * 512;
        epi_store_rows(wl, acc, fr, fq, lane, [&](int row) -> bf16* { return (mt * 128 + i0 + row < ce) ? YR + (slot0 + i0 + row) * DM + nt * 128 + wc * 64 : dump + (row & 7) * 64; });
    };
    gemm_tiles<true, 8>(lds, vcu_id(), ntiles, gridDim.x, make, epi);
}

__device__ __forceinline__ void ph_inproj1(const Params& p, LAS unsigned char* lds) {
    unsigned char* ws = p.ws;
    const bf16* U = (const bf16*)(ws + OFF_U); const bf16* W = (const bf16*)(ws + OFF_W_IN_O);
    bf16* Z1 = (bf16*)(ws + A1_Z1); bf16* KM = (bf16*)(ws + A1_KM);
    const f32x2* rope = (const f32x2*)(ws + OFF_ROPE);
    const int tid = threadIdx.x, lane = tid & 63, wid = tid >> 6, wr = wid >> 1, wc = wid & 1, fr = lane & 15, fq = lane >> 4;
    constexpr int NTN = 7, NTM = TT / 128;
    auto make = [&](int t, GPtrs& g, int& nk) { int tm, tn; tile_mn(t, NTM, NTN, tm, tn); plain_ptrs(U, tm * 128, DM, g.a); plain_ptrs(W, tn * 128, DM, g.b); nk = DM / 64; };
    auto epi = [&](int t, f32x4 (&acc)[4][4]) {
        int tm, tn; tile_mn(t, NTM, NTN, tm, tn); const int brow = tm * 128, bcol = tn * 128;
        const int cb = bcol + wc * 64;
        LAS unsigned char* wl = lds + 32768 + wid * 8192;
        const int r0 = brow + wr * 64;
        const RowInfo ri0 = rowinfo(r0);
        if (cb < 768) {
            float* ssq = (float*)(ws + OFF_SSQ);
#pragma unroll
            for (int m = 0; m < 4; ++m) {
                float q = 0.f;
#pragma unroll
                for (int n = 0; n < 4; ++n) q += (acc[m][n][0] * acc[m][n][0] + acc[m][n][1] * acc[m][n][1]) + (acc[m][n][2] * acc[m][n][2] + acc[m][n][3] * acc[m][n][3]);
                q += __shfl_xor(q, 16); q += __shfl_xor(q, 32);
                if (fq == 0) ssq[(size_t)(r0 + m * 16 + fr) * 12 + (cb >> 6)] = q;
            }
            epi_store_rows(wl, acc, fr, fq, lane, [&](int row) { return Z1 + (size_t)(r0 + row) * Z1P + cb; });
        } else if (cb == 768) {
#pragma unroll
            for (int m = 0; m < 4; ++m) {
                const int pos = ri0.pos + m * 16 + fr;
#pragma unroll
                for (int n = 0; n < 2; ++n)
#pragma unroll
                    for (int j = 0; j < 4; ++j) {
                        const float x1 = acc[m][n][j], x2 = acc[m][n + 2][j];
                        if (ri0.lat) { const f32x2 cs = rope[(size_t)pos * 32 + n * 16 + fq * 4 + j]; acc[m][n][j] = x1 * cs.x - x2 * cs.y; acc[m][n + 2][j] = x2 * cs.x + x1 * cs.y; }
                    }
                asm volatile("" ::: "memory");
            }
            bf16* dst = KM + ((size_t)(ri0.b * 8) * NKEY + ri0.kq) * 192 + 128;
            epi_store_rows(wl, acc, fr, fq, lane, [&](int row) { return dst + (size_t)row * 192; }, 8, (size_t)NKEY * 192);
        }
    };
    gemm_tiles<true>(lds, vcu_id(), NTM * NTN, gridDim.x, make, epi);
}

__device__ __forceinline__ void ph_mla_up(const Params& p, LAS unsigned char* lds) {
    unsigned char* ws = p.ws;
    const bf16* Z1 = (const bf16*)(ws + A1_Z1); const bf16* WQ = (const bf16*)(ws + OFF_W_UQ); const bf16* WKV = (const bf16*)(ws + OFF_W_UKV);
    bf16* QM = (bf16*)(ws + A1_QM); bf16* KM = (bf16*)(ws + A1_KM); bf16* VTM = (bf16*)(ws + A1_VTM);
    const f32x2* rope = (const f32x2*)(ws + OFF_ROPE);
    const int tid = threadIdx.x, lane = tid & 63, wid = tid >> 6, wr = wid >> 1, wc = wid & 1, fr = lane & 15, fq = lane >> 4;
    LAS float* rsb = (LAS float*)(lds + 66560);
    constexpr int NQ = (TL / 128) * 12, NKV = (TT / 128) * 16;
    constexpr float QSCALE = 0.07216878364870322f * LOG2E;
    auto decode = [&](int t, bool& isq, int& tm, int& tn) { isq = t < NQ; if (isq) { tile_mn(t, TL / 128, 12, tm, tn); tm += 4; } else tile_mn(t - NQ, TT / 128, 16, tm, tn); };
    auto make = [&](int t, GPtrs& g, int& nk) {
        bool isq; int tm, tn; decode(t, isq, tm, tn);
        const int brow = tm * 128, bcol = tn * 128, K = isq ? 512 : 256, acol = isq ? 0 : 512;
        const int par = ((t - vcu_id()) / (int)gridDim.x) & 1;
        if (tid < 128) {
            const float* q = (const float*)(ws + OFF_SSQ) + (size_t)(brow + tid) * 12;
            float ss;
            if (isq) { const f32x4 a = *(const f32x4*)q, b2 = *(const f32x4*)(q + 4); ss = ((a.x + a.y) + (a.z + a.w)) + ((b2.x + b2.y) + (b2.z + b2.w)); }
            else { const f32x4 a = *(const f32x4*)(q + 8); ss = (a.x + a.y) + (a.z + a.w); }
            rsb[par * 128 + tid] = rsqrtf(ss / (float)K + RMS_EPS);
        }
        plain_ptrs(Z1 + acol, brow, Z1P, g.a); plain_ptrs(isq ? WQ : WKV, bcol, K, g.b); nk = K / 64;
    };
    auto epi = [&](int t, f32x4 (&acc)[4][4]) {
        bool isq; int tm, tn; decode(t, isq, tm, tn);
        const int brow = tm * 128, bcol = tn * 128;
        const int par = ((t - vcu_id()) / (int)gridDim.x) & 1;
        const int cb = bcol + wc * 64;
        LAS unsigned char* wl = lds + 32768 + wid * 8192;
        const int r0 = brow + wr * 64;
        const RowInfo ri0 = rowinfo(r0);
        if (isq) {
            const int h = cb / 192, part = (cb % 192) >> 6;
#pragma unroll
            for (int m = 0; m < 4; ++m) {
                const float sc = rsb[par * 128 + wr * 64 + m * 16 + fr] * QSCALE;
                const int pos = ri0.pos + m * 16 + fr;
                if (part < 2) {
#pragma unroll
                    for (int n = 0; n < 4; ++n) acc[m][n] = acc[m][n] * sc;
                } else {
#pragma unroll
                    for (int n = 0; n < 2; ++n)
#pragma unroll
                        for (int j = 0; j < 4; ++j) {
                            const float x1 = acc[m][n][j] * sc, x2 = acc[m][n + 2][j] * sc;
                            const f32x2 cs = rope[(size_t)pos * 32 + n * 16 + fq * 4 + j];
                            acc[m][n][j] = x1 * cs.x - x2 * cs.y; acc[m][n + 2][j] = x2 * cs.x + x1 * cs.y;
                        }
                }
                asm volatile("" ::: "memory");
            }
            bf16* dst = QM + ((size_t)(ri0.b * 8 + h) * SEQ + ri0.pos) * 192 + part * 64;
            epi_store_rows(wl, acc, fr, fq, lane, [&](int row) { return dst + (size_t)row * 192; });
        } else {
            const int h = cb >> 8, part = (cb & 255) >> 6;
#pragma unroll
            for (int m = 0; m < 4; ++m) {
                const float rs = rsb[par * 128 + wr * 64 + m * 16 + fr];
#pragma unroll
                for (int n = 0; n < 4; ++n) acc[m][n] = acc[m][n] * rs;
            }
            if (part < 2) {
                bf16* dst = KM + ((size_t)(ri0.b * 8 + h) * NKEY + ri0.kq) * 192 + part * 64;
                epi_store_rows(wl, acc, fr, fq, lane, [&](int row) { return dst + (size_t)row * 192; });
            } else {
                bf16* dst = VTM + ((size_t)(ri0.b * 8 + h) * 128 + (part - 2) * 64) * NKEY + ri0.kq;
                epi_store_cols(wl, acc, fr, fq, lane, [&](int col) { return dst + (size_t)col * NKEY; });
            }
        }
    };
    gemm_tiles<true>(lds, vcu_id(), NQ + NKV, gridDim.x, make, epi);
}

__device__ __forceinline__ void ph_mla_attn(const Params& p, LAS unsigned char* lds) {
    unsigned char* ws = p.ws;
    const bf16* QM = (const bf16*)(ws + A1_QM); const bf16* KM = (const bf16*)(ws + A1_KM); const bf16* VTM = (const bf16*)(ws + A1_VTM); bf16* MIX = (bf16*)(ws + A1_MIX);
    for (int item = vcu_id(); item < 2 * 8 * 64; item += gridDim.x) {
        const int qt = item & 63, h = (item >> 6) & 7, b = item >> 9;
        const bf16* Qg = QM + ((size_t)(b * 8 + h) * SEQ + qt * 128) * 192;
        const bf16* Kg = KM + (size_t)(b * 8 + h) * NKEY * 192;
        const bf16* Vg = VTM + (size_t)(b * 8 + h) * 128 * NKEY;
        attn_item<192, 128>(lds, Qg, Kg, Vg, NKEY / 64, 0, 0, 0, -1e30f, 0.f, MIX + (size_t)(TC + b * SEQ + qt * 128) * DM + h * 128, DM);
    }
}


#define XB_TMO      128
#define XB_XCNT(j)  (256  + 64 * (j))
#define XB_XSUB(j)  (1280 + 64 * (j))
#define XB_XGEN(j)  (2304 + 64 * (j))
#define XB_TOP      3328
#define XB_TOPGEN   3392
#define XCD_BAR_WORDS 3456
#define XB_SPIN_CAP (1u << 18)
__device__ __forceinline__ unsigned xb_ld(unsigned* p)              { return __hip_atomic_load(p, __ATOMIC_RELAXED, __HIP_MEMORY_SCOPE_AGENT); }
__device__ __forceinline__ unsigned xb_add(unsigned* p, unsigned v) { return __hip_atomic_fetch_add(p, v, __ATOMIC_RELAXED, __HIP_MEMORY_SCOPE_AGENT); }
__device__ __forceinline__ unsigned xb_xcc_id() { return (unsigned)__builtin_amdgcn_s_getreg((3 << 11) | 20) & 0xFu; }
#define XB_SPIN(cond, bar) do { unsigned _sp = 0; while (cond) { __builtin_amdgcn_s_sleep(1); \
    if ((++_sp & 255u) == 0u) { if (xb_ld(&(bar)[XB_TMO])) break; if (_sp > XB_SPIN_CAP) { atomicAdd(&(bar)[XB_TMO], 1u); break; } } } } while (0)
struct XcdBarrier { unsigned* bar; unsigned x; volatile LAS unsigned* st; };
__device__ __forceinline__ XcdBarrier xcd_barrier_post(unsigned* bar, volatile LAS unsigned* st) {
    XcdBarrier b; b.bar = bar; b.x = xb_xcc_id(); b.st = st;
    if (threadIdx.x == 0) (void)xb_add(&bar[XB_XCNT(b.x)], 1u);
    return b;
}
__device__ __forceinline__ void xcd_barrier_complete(unsigned* bar, unsigned x, unsigned& nloc, unsigned& nx) {
    const unsigned G = gridDim.x * gridDim.y * gridDim.z;
    unsigned sum, cnt, mine, sp = 0u;
    for (;;) {
        sum = 0u; cnt = 0u; mine = 0u;
#pragma unroll
        for (unsigned j = 0; j < 16; ++j) { const unsigned c = xb_ld(&bar[XB_XCNT(j)]); sum += c; cnt += (c > 0u) ? 1u : 0u; mine = (j == x) ? c : mine; }
        if (sum == G) break;
        __builtin_amdgcn_s_sleep(1);
        if ((++sp & 255u) == 0u) { if (xb_ld(&bar[XB_TMO])) break; if (sp > XB_SPIN_CAP) { atomicAdd(&bar[XB_TMO], 1u); break; } }
    }
    nloc = mine > 0u ? mine : 1u; nx = cnt > 0u ? cnt : 1u;
}
__device__ __forceinline__ void xcd_barrier(const XcdBarrier& b) {
    asm volatile("s_waitcnt vmcnt(0)" ::: "memory");
    __syncthreads();
    if (threadIdx.x == 0) {
        unsigned* bar = b.bar;
        __builtin_amdgcn_s_waitcnt(0);
        unsigned nloc = b.st[0], nx = b.st[1];
        if (nloc == 0u) { xcd_barrier_complete(bar, b.x, nloc, nx); b.st[0] = nloc; b.st[1] = nx; }
        const unsigned old = xb_add(&bar[XB_XSUB(b.x)], 1u);
        const unsigned gen = old / nloc;
        if (old + 1u == (gen + 1u) * nloc) {
            __builtin_amdgcn_fence(__ATOMIC_RELEASE, "agent");
            asm volatile("s_waitcnt vmcnt(0)" ::: "memory");
            const unsigned og = xb_add(&bar[XB_TOP], 1u);
            const unsigned tg = og / nx;
            if (og + 1u == (tg + 1u) * nx) xb_add(&bar[XB_TOPGEN], 1u);
            else XB_SPIN(xb_ld(&bar[XB_TOPGEN]) == tg, bar);
            __builtin_amdgcn_fence(__ATOMIC_ACQUIRE, "agent");
            xb_add(&bar[XB_XGEN(b.x)], 1u);
            asm volatile("s_waitcnt vmcnt(0)" ::: "memory");
        } else {
            XB_SPIN(xb_ld(&bar[XB_XGEN(b.x)]) == gen, bar);
            __builtin_amdgcn_fence(__ATOMIC_ACQUIRE, "agent");
            asm volatile("s_waitcnt vmcnt(0)" ::: "memory");
        }
    }
    __syncthreads();
}
static_assert(XCD_BAR_WORDS * 4 <= BAR_BYTES, "barrier words");

__device__ __forceinline__ void convert_shared(const Params& p, LAS unsigned char* lds, int l, int nrt) {
    const int v = vcu_id(), G = gridDim.x, nfree = G - nrt, nslots = 2 * nfree + nrt;
    if (v >= nrt) {
        const int j = v - nrt;
        for (int it = 2 * j; it < EXP_ITEMS; it += nslots) expert_convert_item(p, lds, l, it);
        for (int it = 2 * j + 1; it < EXP_ITEMS; it += nslots) expert_convert_item(p, lds, l, it);
    } else {
        for (int it = 2 * nfree + v; it < EXP_ITEMS; it += nslots) expert_convert_item(p, lds, l, it);
    }
}

constexpr int NPHASE = 19;
__global__ void __launch_bounds__(256, 2) mega(Params p) {
    extern __shared__ __attribute__((aligned(16))) unsigned char lds_[];
    LAS unsigned char* lds = (LAS unsigned char*)lds_;
    cg::grid_group grid = cg::this_grid();
    unsigned char* ws = p.ws;
    volatile LAS unsigned* bst = (volatile LAS unsigned*)(lds + LDS_BYTES - 16);
    if (threadIdx.x < 4) bst[threadIdx.x] = 0u;
    __syncthreads();
    const XcdBarrier xbar = xcd_barrier_post((unsigned*)(ws + OFF_BAR), bst);
#define GRID_BAR(k) do { if ((k) == 0) grid.sync(); else xcd_barrier(xbar); } while (0)
#ifndef PROBE_REP_MASK
#define PROBE_REP_MASK 0u
#endif
#ifndef PROBE_EXTRA_SYNCS
#define PROBE_EXTRA_SYNCS 0
#endif
#define PHASE(k, body) do { if (p.ph_lo <= (k) && (k) < p.ph_hi) { body; if ((PROBE_REP_MASK >> (k)) & 1u) { xcd_barrier(xbar); body; } if ((k) + 1 < p.ph_hi) GRID_BAR(k); } } while (0)
    for (int i = 0; i < PROBE_EXTRA_SYNCS; ++i) xcd_barrier(xbar);
    PHASE(0, ph_prep(p, lds));
    PHASE(1, ph_modulate0(p));
    PHASE(2, ph_inproj0(p, lds));
    PHASE(3, ph_swa_g1(p, lds));
    PHASE(4, ph_gla_scan(p));
    PHASE(5, ph_gla_g3(p, lds));
    PHASE(6, ph_outproj(p, lds, (const bf16*)(ws + A0_MIX), (const bf16*)(ws + OFF_W_OUT_E), (float*)(ws + A0_Y), 0));
    PHASE(7, ph_rowpassA(p, 0, 0, (const float*)(ws + A0_Y)));
    PHASE(8, { ph_router(p, lds, 0, 0); __syncthreads(); convert_shared(p, lds, 0, TT / 128); });
    PHASE(9, ph_moe1(p, lds, 0, 0));
    PHASE(10, ph_moe2(p, lds, 0, 0));
    PHASE(11, ph_rowpassB(p, lds, 0, 0));
    PHASE(12, ph_inproj1(p, lds));
    PHASE(13, ph_mla_up(p, lds));
    PHASE(14, ph_mla_attn(p, lds));
    PHASE(15, ph_outproj(p, lds, (const bf16*)(ws + A1_MIX), (const bf16*)(ws + OFF_W_OUT_O), (float*)(ws + A1_Y), TC));
    PHASE(16, ph_rowpassA(p, 1, TC, (const float*)(ws + A1_Y)));
    PHASE(17, { ph_router(p, lds, 1, TC); __syncthreads(); convert_shared(p, lds, 1, TL / 128); });
    PHASE(18, ph_moe1(p, lds, 1, TC));
    PHASE(19, ph_moe2(p, lds, 1, TC));
    PHASE(20, ph_rowpassB(p, lds, 1, TC));
}

extern "C" void kernel_launch(void* const* d_in, const int* in_sizes, int n_in, void* d_out, int out_size, void* d_ws, size_t ws_size, hipStream_t stream) {
    static int grid_blocks = 0;
    if (!grid_blocks) {
        int dev = 0, cus = 0, per_cu = 0;
        (void)hipGetDevice(&dev);
        (void)hipDeviceGetAttribute(&cus, hipDeviceAttributeMultiprocessorCount, dev);
        (void)hipFuncSetAttribute((const void*)mega, hipFuncAttributeMaxDynamicSharedMemorySize, LDS_BYTES);
        (void)hipOccupancyMaxActiveBlocksPerMultiprocessor(&per_cu, (const void*)mega, 256, LDS_BYTES);
        if (per_cu > 2) per_cu = 2;
        if (per_cu < 1) per_cu = 1;
        grid_blocks = cus * per_cu;
        if (ws_size < WS_NEED) fprintf(stderr, "kernel_launch: workspace too small: %zu < %zu\n", ws_size, (size_t)WS_NEED);
    }
    Params p{};
    const float** f = (const float**)&p;
    for (int i = 0; i < 30; ++i) f[i] = (const float*)d_in[i];
    p.out = (float*)d_out; p.ws = (unsigned char*)d_ws; p.ph_lo = 0; p.ph_hi = 21;
    (void)hipMemsetAsync((unsigned char*)d_ws + OFF_BAR, 0, BAR_BYTES, stream);
    void* args[] = {&p};
    hipError_t e = hipLaunchCooperativeKernel((const void*)mega, dim3(grid_blocks), dim3(256), args, LDS_BYTES, stream);
    if (e != hipSuccess) fprintf(stderr, "cooperative launch failed: %s (grid %d)\n", hipGetErrorString(e), grid_blocks);
}
```

```cpp
#include <hip/hip_runtime.h>
#include <hip/hip_cooperative_groups.h>
#include <cstdio>
#include <cstdint>
namespace cg = cooperative_groups;

#define LAS __attribute__((address_space(3)))
typedef unsigned short bf16;
typedef short bf16x8 __attribute__((ext_vector_type(8)));
typedef float f32x2 __attribute__((ext_vector_type(2)));
typedef float f32x4 __attribute__((ext_vector_type(4)));
typedef float f32x8 __attribute__((ext_vector_type(8)));
typedef float f32x16 __attribute__((ext_vector_type(16)));
typedef unsigned u32x2 __attribute__((ext_vector_type(2)));
typedef unsigned u32x4 __attribute__((ext_vector_type(4)));
typedef __bf16 bf16x2_t __attribute__((ext_vector_type(2)));

constexpr int DM = 1024, NB = 2, SEQ = 8192, CTX = 256;
constexpr int TC = NB * CTX, TL = NB * SEQ, TT = TC + TL, NKEY = CTX + SEQ;
constexpr int NEXP = 64;
constexpr float RMS_EPS = 1e-6f;
constexpr int E_IN_PAD = 2432, O_IN_PAD = 896;
constexpr float LOG2E = 1.4426950408889634f;
constexpr int NSTEP = 132;
constexpr int Z0P = 1056;
constexpr int Z1P = 768;
constexpr int LDS_BYTES = 73728;

constexpr size_t al(size_t x) { return (x + 255) & ~(size_t)255; }
constexpr size_t OFF_W_IN_E = 0;
constexpr size_t OFF_W_OUT_E = OFF_W_IN_E + al((size_t)E_IN_PAD * DM * 2);
constexpr size_t OFF_W_IN_O = OFF_W_OUT_E + al((size_t)DM * DM * 2);
constexpr size_t OFF_W_UQ = OFF_W_IN_O + al((size_t)O_IN_PAD * DM * 2);
constexpr size_t OFF_W_UKV = OFF_W_UQ + al((size_t)1536 * 512 * 2);
constexpr size_t OFF_W_OUT_O = OFF_W_UKV + al((size_t)2048 * 256 * 2);
constexpr size_t OFF_W_RT = OFF_W_OUT_O + al((size_t)DM * DM * 2);
constexpr size_t OFF_W_GU = OFF_W_RT + al((size_t)2 * 128 * DM * 2);
constexpr size_t OFF_W_D = OFF_W_GU + al((size_t)65 * 512 * DM * 2);
constexpr size_t OFF_U = OFF_W_D + al((size_t)65 * DM * 256 * 2);
constexpr size_t OFF_HC = OFF_U + al((size_t)TT * DM * 2);
constexpr size_t OFF_MOD = OFF_HC + al((size_t)TC * DM * 4);
constexpr size_t OFF_ROPE = OFF_MOD + al((size_t)2 * 3 * 6144 * 4);
constexpr size_t OFF_CNT = OFF_ROPE + al((size_t)SEQ * 32 * 8);
constexpr size_t OFF_TOKSLOT = OFF_CNT + al(2 * 64 * 4);
constexpr size_t OFF_W8 = OFF_TOKSLOT + al((size_t)TT * 8 * 4);
constexpr size_t OFF_LIST = OFF_W8 + al((size_t)TT * 8 * 4);
constexpr size_t OFF_SSQ = OFF_LIST + al((size_t)64 * TT * 4);
constexpr size_t OFF_DUMP = OFF_SSQ + al((size_t)TT * 12 * 4);
constexpr size_t OFF_BAR = OFF_DUMP + 8192;
constexpr size_t BAR_BYTES = 16384;
constexpr size_t OFF_ARENA = OFF_BAR + BAR_BYTES;
constexpr size_t A0_Z0 = OFF_ARENA;
constexpr size_t A0_VGT = A0_Z0 + al((size_t)TT * Z0P * 2);
constexpr size_t A0_QS = A0_VGT + al((size_t)4 * 128 * TT * 2);
constexpr size_t A0_KS = A0_QS + al((size_t)2 * 8 * NKEY * 64 * 2);
constexpr size_t A0_VST = A0_KS + al((size_t)2 * 2 * NKEY * 64 * 2);
constexpr size_t A0_GS = A0_VST + al((size_t)2 * 2 * 64 * NKEY * 2);
constexpr size_t A0_GD = A0_GS + al((size_t)16 * NSTEP * 8192 * 4);
constexpr size_t A0_MIX = A0_GD + al((size_t)16 * NSTEP * 64 * 4);
constexpr size_t A0_Y = A0_MIX + al((size_t)TT * DM * 2);
constexpr size_t A0_END = A0_Y + al((size_t)TT * DM * 4);
constexpr size_t A1_Z1 = OFF_ARENA;
constexpr size_t A1_QM = A1_Z1 + al((size_t)TT * Z1P * 2);
constexpr size_t A1_KM = A1_QM + al((size_t)2 * 8 * SEQ * 192 * 2);
constexpr size_t A1_VTM = A1_KM + al((size_t)2 * 8 * NKEY * 192 * 2);
constexpr size_t A1_MIX = A1_VTM + al((size_t)2 * 8 * 128 * NKEY * 2);
constexpr size_t A1_Y = A1_MIX + al((size_t)TT * DM * 2);
constexpr size_t A1_END = A1_Y + al((size_t)TT * DM * 4);
constexpr size_t AM_U8 = OFF_ARENA;
constexpr size_t AM_HM = AM_U8 + al((size_t)TT * 1024);
constexpr size_t AM_YR = AM_HM + al((size_t)TT * 9 * 256);
constexpr size_t AM_END = AM_YR + al((size_t)TT * 9 * 1024 * 2);
constexpr size_t WS_NEED = AM_END > A0_END ? (AM_END > A1_END ? AM_END : A1_END) : (A0_END > A1_END ? A0_END : A1_END);
static_assert(WS_NEED <= 555747360ull, "workspace map exceeds the guaranteed d_ws size");

struct Params {
    const float *x, *c, *ctx, *c_ctx, *w_mod, *b_mod, *g_mix_pre, *g_mix_post, *g_ffn_pre, *g_ffn_post;
    const float *w_in_e, *gla_wa2, *gla_ba, *gla_norm, *swa_sink, *w_out_e;
    const float *w_in_o, *mla_q_norm, *mla_kv_norm, *w_uq, *w_ukv, *w_out_o;
    const float *w_router, *b_router, *w_exp_gate, *w_exp_up, *w_exp_down, *w_sh_gate, *w_sh_up, *w_sh_down;
    float* out; unsigned char* ws; int ph_lo, ph_hi;
};

__device__ __forceinline__ unsigned pk2(float lo, float hi) { f32x2 v = {lo, hi}; bf16x2_t b = __builtin_convertvector(v, bf16x2_t); return __builtin_bit_cast(unsigned, b); }
__device__ __forceinline__ float bflo(unsigned u) { return __uint_as_float(u << 16); }
__device__ __forceinline__ float bfhi(unsigned u) { return __uint_as_float(u & 0xffff0000u); }
__device__ __forceinline__ float bf2f(bf16 v) { return __uint_as_float((unsigned)v << 16); }
__device__ __forceinline__ bf16 f2bf(float f) { return (bf16)(pk2(f, 0.f) & 0xffffu); }
constexpr float W8SC = 64.f, H8SC = 4.f;
__device__ __forceinline__ unsigned pk4_fp8(float a, float b, float c, float d) { int w = 0; w = __builtin_amdgcn_cvt_pk_fp8_f32(a, b, w, false); w = __builtin_amdgcn_cvt_pk_fp8_f32(c, d, w, true); return (unsigned)w; }
__device__ __forceinline__ float wave_sum(float v) {
#pragma unroll
    for (int o = 1; o < 64; o <<= 1) v += __shfl_xor(v, o);
    return v;
}
__device__ __forceinline__ void glds16(const void* g, LAS void* l) { __builtin_amdgcn_global_load_lds((const unsigned*)g, (LAS unsigned*)l, 16, 0, 0); }
__device__ __forceinline__ float siluf(float x) { return x / (1.f + __expf(-x)); }
__device__ __forceinline__ float ex2(float x) { return __builtin_amdgcn_exp2f(x); }
__device__ __forceinline__ int crow(int r, int hi) { return (r & 3) + 8 * (r >> 2) + 4 * hi; }
__device__ __forceinline__ bf16x8 mk8(u32x4 v) { return __builtin_bit_cast(bf16x8, v); }

struct RowInfo { int b, kq, pos; bool lat; };
__device__ __forceinline__ RowInfo rowinfo(int r) {
    RowInfo i;
    if (r < TC) { i.b = r >> 8; i.pos = r & 255; i.kq = i.pos; i.lat = false; }
    else { const int rl = r - TC; i.b = rl >> 13; i.pos = rl & (SEQ - 1); i.kq = CTX + i.pos; i.lat = true; }
    return i;
}
__device__ __forceinline__ int modvec(int r) { return r < TC ? 2 : ((r - TC) >> 13); }

struct GPtrs { const bf16* a[4]; const bf16* b[4]; };
constexpr int G_STAGE = 32768;
#define G_FENCE() asm volatile("" ::: "memory")
__device__ __forceinline__ void gemm_issue(LAS unsigned char* lds, const GPtrs& g, int kt) {
    LAS unsigned char* d = lds + (kt & 1) * G_STAGE + threadIdx.x * 16; const int ko = kt * 64;
#pragma unroll
    for (int i = 0; i < 4; ++i) { glds16(g.a[i] + ko, d + i * 4096); glds16(g.b[i] + ko, d + 16384 + i * 4096); }
}
__device__ __forceinline__ void gemm_prologue(LAS unsigned char* lds, const GPtrs& g, int nk) { gemm_issue(lds, g, 0); }
template <int NST, bool FP8 = false>
__device__ __forceinline__ void gemm_main(LAS unsigned char* lds, const GPtrs& g, int nk, f32x4 (&acc)[4][4], bool after_epi) {
    const int tid = threadIdx.x, lane = tid & 63, wid = tid >> 6, wr = wid >> 1, wc = wid & 1, fr = lane & 15, fq = lane >> 4;
#pragma unroll
    for (int m = 0; m < 4; ++m)
#pragma unroll
        for (int n = 0; n < 4; ++n) acc[m][n] = (f32x4){0.f, 0.f, 0.f, 0.f};
    const int c0 = ((fq) ^ (fr & 7)) * 16, c1 = ((4 + fq) ^ (fr & 7)) * 16;
    const int aoff = (wr * 64 + fr) * 128, boff = 16384 + (wc * 64 + fr) * 128;
    for (int kt = 0; kt < nk; ++kt) {
        if (NST == 8 && kt == 0 && after_epi) asm volatile("s_waitcnt vmcnt(8) lgkmcnt(0)" ::: "memory");
        else if (NST == 16 && kt == 0 && after_epi) asm volatile("s_waitcnt vmcnt(16) lgkmcnt(0)" ::: "memory");
        else asm volatile("s_waitcnt vmcnt(0) lgkmcnt(0)" ::: "memory");
        __builtin_amdgcn_s_barrier();
        G_FENCE();
        if (kt + 1 < nk) gemm_issue(lds, g, kt + 1);
        LAS unsigned char* base = lds + (kt & 1) * G_STAGE;
        if constexpr (FP8) {
            long a8[4][4], b8[4][4];
#pragma unroll
            for (int ks = 0; ks < 4; ++ks) {
                const int co = (((ks * 2 + (fq >> 1)) ^ (fr & 7)) * 16) + (fq & 1) * 8;
#pragma unroll
                for (int m = 0; m < 4; ++m) a8[ks][m] = *(const LAS long*)(base + aoff + m * 2048 + co);
#pragma unroll
                for (int n = 0; n < 4; ++n) b8[ks][n] = *(const LAS long*)(base + boff + n * 2048 + co);
            }
            __builtin_amdgcn_s_setprio(1);
#pragma unroll
            for (int ks = 0; ks < 4; ++ks)
#pragma unroll
                for (int m = 0; m < 4; ++m)
#pragma unroll
                    for (int n = 0; n < 4; ++n) acc[m][n] = __builtin_amdgcn_mfma_f32_16x16x32_fp8_fp8(b8[ks][n], a8[ks][m], acc[m][n], 0, 0, 0);
            __builtin_amdgcn_s_setprio(0);
            continue;
        }
        bf16x8 af0[4], bf0[4], af1[4], bf1[4];
#pragma unroll
        for (int m = 0; m < 4; ++m) af0[m] = *(const LAS bf16x8*)(base + aoff + m * 2048 + c0);
#pragma unroll
        for (int n = 0; n < 4; ++n) bf0[n] = *(const LAS bf16x8*)(base + boff + n * 2048 + c0);
#pragma unroll
        for (int m = 0; m < 4; ++m) af1[m] = *(const LAS bf16x8*)(base + aoff + m * 2048 + c1);
#pragma unroll
        for (int n = 0; n < 4; ++n) bf1[n] = *(const LAS bf16x8*)(base + boff + n * 2048 + c1);
        __builtin_amdgcn_s_setprio(1);
#pragma unroll
        for (int m = 0; m < 4; ++m)
#pragma unroll
            for (int n = 0; n < 4; ++n) acc[m][n] = __builtin_amdgcn_mfma_f32_16x16x32_bf16(bf0[n], af0[m], acc[m][n], 0, 0, 0);
#pragma unroll
        for (int m = 0; m < 4; ++m)
#pragma unroll
            for (int n = 0; n < 4; ++n) acc[m][n] = __builtin_amdgcn_mfma_f32_16x16x32_bf16(bf1[n], af1[m], acc[m][n], 0, 0, 0);
        __builtin_amdgcn_s_setprio(0);
    }
    asm volatile("s_waitcnt lgkmcnt(0)" ::: "memory");
    __builtin_amdgcn_s_barrier();
    G_FENCE();
}
__device__ __forceinline__ int vcu_id() { const int b = blockIdx.x, G = gridDim.x; return (G % 8 == 0) ? (b % 8) * (G / 8) + b / 8 : b; }
__device__ __forceinline__ void tile_mn(int w, int ntm, int ntn, int& tm, int& tn) {
    const int nig = 8 * ntn, gid = w / nig, fm = gid * 8, gsz = (ntm - fm) < 8 ? (ntm - fm) : 8, within = w - gid * nig;
    tm = fm + within % gsz; tn = within / gsz;
}
template <bool PREFETCH_NEXT, int NST = -1, bool FP8 = false, class Make, class Epi>
__device__ __forceinline__ void gemm_tiles(LAS unsigned char* lds, int t0, int nt, int stride, Make make, Epi epi) {
    if (t0 >= nt) return;
    GPtrs g; int nk;
    make(t0, g, nk);
    G_FENCE();
    gemm_prologue(lds, g, nk);
    bool first = true;
    for (int t = t0; t < nt;) {
        const int tn = t + stride;
        f32x4 acc[4][4];
        gemm_main<PREFETCH_NEXT ? NST : -1, FP8>(lds, g, nk, acc, !first);
        first = false;
        if (PREFETCH_NEXT) { if (tn < nt) { make(tn, g, nk); G_FENCE(); gemm_prologue(lds, g, nk); } epi(t, acc); }
        else { epi(t, acc); __syncthreads(); if (tn < nt) { make(tn, g, nk); G_FENCE(); gemm_prologue(lds, g, nk); } }
        t = tn;
    }
}

template <class RowPtr>
__device__ __forceinline__ void epi_store_rows(LAS unsigned char* wl, const f32x4 (&v)[4][4], int fr, int fq, int lane, RowPtr rowptr, int nrep = 1, size_t rep_stride = 0) {
#pragma unroll
    for (int m = 0; m < 4; ++m)
#pragma unroll
        for (int n = 0; n < 4; ++n)
            *(LAS u32x2*)(wl + (m * 16 + fr) * 128 + (((n * 2 + (fq >> 1)) ^ (fr & 7)) * 16) + (fq & 1) * 8) = (u32x2){pk2(v[m][n][0], v[m][n][1]), pk2(v[m][n][2], v[m][n][3])};
#pragma unroll
    for (int i = 0; i < 8; ++i) {
        const int row = (lane >> 3) + 8 * i, pos = lane & 7;
        const u32x4 w = *(const LAS u32x4*)(wl + row * 128 + pos * 16);
        bf16* d = rowptr(row);
        if (d) { d += (pos ^ (row & 7)) * 8; for (int r = 0; r < nrep; ++r) *(u32x4*)(d + (size_t)r * rep_stride) = w; }
    }
}
template <class ColPtr>
__device__ __forceinline__ void epi_store_cols(LAS unsigned char* wl, const f32x4 (&v)[4][4], int fr, int fq, int lane, ColPtr colptr) {
    LAS unsigned char* wb = wl + fq * 512 + fr * 2;
#pragma unroll
    for (int m = 0; m < 4; ++m)
#pragma unroll
        for (int n = 0; n < 4; ++n)
#pragma unroll
            for (int j = 0; j < 4; ++j) *(LAS bf16*)(wb + n * 2048 + j * 128 + m * 32) = f2bf(v[m][n][j]);
#pragma unroll
    for (int i = 0; i < 8; ++i) {
        const int col = (lane >> 3) + 8 * i, pos = lane & 7;
        const u32x4 w = *(const LAS u32x4*)(wl + col * 128 + pos * 16);
        bf16* d = colptr(col);
        *(u32x4*)(d + pos * 8) = w;
    }
}

__device__ __forceinline__ int ein_map(int n) {
    if (n < 512) return n;
    if (n < 1024) return n + 512;
    if (n < 1536) return n - 512;
    if (n < 2048) return 1568 + (n - 1536);
    if (n < 2176) return 2080 + (n - 2048);
    if (n < 2304) return 2208 + (n - 2176);
    if (n < 2320) return 1536 + (n - 2304);
    if (n < 2336) return 1552 + (n - 2320);
    return -1;
}
template <bool FP8 = false>
__device__ __forceinline__ void transpose_item(LAS unsigned char* lds, int K, bf16* dst, int k0, int n0, int ld, int mode, const float* srcA, const float* srcB, int nvalid, const float* kscale) {
    LAS float* tile = (LAS float*)lds;
    const int tid = threadIdx.x;
    {
        const int nq = tid & 31, kr = tid >> 5, n = n0 + nq * 4;
        const float* cp = nullptr; float sc = 1.f;
        if (mode == 0) { if (n < nvalid) cp = srcA + n; }
        else if (mode == 1) { const int c = ein_map(n); if (c >= 0) cp = srcA + c; if (n < 256) sc = 0.125f; }
        else { const int grp = n >> 6, w = n & 63; cp = (w < 32 ? srcA : srcB) + grp * 32 + (w & 31); }
        f32x4 v[8];
#pragma unroll
        for (int i = 0; i < 8; ++i) { const int k = kr + 8 * i; v[i] = cp ? *(const f32x4*)(cp + (size_t)(k0 + k) * ld) : (f32x4){0.f, 0.f, 0.f, 0.f}; }
#pragma unroll
        for (int i = 0; i < 8; ++i) { const int k = kr + 8 * i; float m = sc; if (kscale) m *= kscale[k0 + k]; *(LAS f32x4*)(tile + k * 132 + nq * 4) = v[i] * m; }
    }
    __syncthreads();
    {
        const int n = tid >> 1, hf = tid & 1;
        if constexpr (FP8) {
            unsigned char* d8 = (unsigned char*)dst;
#pragma unroll
            for (int c = 0; c < 2; ++c) {
                const int k16 = hf * 32 + c * 16;
                u32x4 o;
                o.x = pk4_fp8(tile[(k16 + 0) * 132 + n] * W8SC, tile[(k16 + 1) * 132 + n] * W8SC, tile[(k16 + 2) * 132 + n] * W8SC, tile[(k16 + 3) * 132 + n] * W8SC);
                o.y = pk4_fp8(tile[(k16 + 4) * 132 + n] * W8SC, tile[(k16 + 5) * 132 + n] * W8SC, tile[(k16 + 6) * 132 + n] * W8SC, tile[(k16 + 7) * 132 + n] * W8SC);
                o.z = pk4_fp8(tile[(k16 + 8) * 132 + n] * W8SC, tile[(k16 + 9) * 132 + n] * W8SC, tile[(k16 + 10) * 132 + n] * W8SC, tile[(k16 + 11) * 132 + n] * W8SC);
                o.w = pk4_fp8(tile[(k16 + 12) * 132 + n] * W8SC, tile[(k16 + 13) * 132 + n] * W8SC, tile[(k16 + 14) * 132 + n] * W8SC, tile[(k16 + 15) * 132 + n] * W8SC);
                *(u32x4*)(d8 + (size_t)(n0 + n) * K + k0 + k16) = o;
            }
        } else
#pragma unroll
        for (int c = 0; c < 4; ++c) {
            const int k8 = hf * 32 + c * 8;
            u32x4 o;
            o.x = pk2(tile[(k8 + 0) * 132 + n], tile[(k8 + 1) * 132 + n]);
            o.y = pk2(tile[(k8 + 2) * 132 + n], tile[(k8 + 3) * 132 + n]);
            o.z = pk2(tile[(k8 + 4) * 132 + n], tile[(k8 + 5) * 132 + n]);
            o.w = pk2(tile[(k8 + 6) * 132 + n], tile[(k8 + 7) * 132 + n]);
            *(u32x4*)(dst + (size_t)(n0 + n) * K + k0 + k8) = o;
        }
    }
    __syncthreads();
}

constexpr int EXP_GU_ITEMS = 65 * 16 * 4, EXP_D_ITEMS = 65 * 4 * 8, EXP_ITEMS = EXP_GU_ITEMS + EXP_D_ITEMS;
__device__ __forceinline__ void expert_convert_item(const Params& p, LAS unsigned char* lds, int l, int it) {
    unsigned char* ws = p.ws;
    if (it < EXP_GU_ITEMS) {
        const int e = it / 64, r = it % 64, kb = r / 4, nb = r % 4;
        const float* gate = e < 64 ? p.w_exp_gate + ((size_t)(l * 64 + e)) * DM * 256 : p.w_sh_gate + (size_t)l * DM * 256;
        const float* up = e < 64 ? p.w_exp_up + ((size_t)(l * 64 + e)) * DM * 256 : p.w_sh_up + (size_t)l * DM * 256;
        transpose_item<true>(lds, DM, (bf16*)(ws + OFF_W_GU + (size_t)e * 512 * DM), kb * 64, nb * 128, 256, 2, gate, up, 512, nullptr);
    } else {
        it -= EXP_GU_ITEMS;
        const int e = it / 32, r = it % 32, kb = r / 8, nb = r % 8;
        const float* dn = e < 64 ? p.w_exp_down + ((size_t)(l * 64 + e)) * 256 * DM : p.w_sh_down + (size_t)l * 256 * DM;
        transpose_item<true>(lds, 256, (bf16*)(ws + OFF_W_D + (size_t)e * DM * 256), kb * 64, nb * 128, DM, 0, dn, nullptr, DM, nullptr);
    }
}

__device__ __forceinline__ void ph_prep(const Params& p, LAS unsigned char* lds) {
    unsigned char* ws = p.ws;
    const int tid = threadIdx.x;
    if (blockIdx.x == 0 && tid < 128) ((int*)(ws + OFF_CNT))[tid] = 0;
    constexpr int I_MOD = 96, I_ROPE = 1024, I_INE = 16 * 19, I_OUTE = 128, I_INO = 16 * 7, I_UQ = 8 * 12, I_UKV = 4 * 16, I_OUTO = 128, I_RT = 32;
    constexpr int NITEMS = I_MOD + I_ROPE + I_INE + I_OUTE + I_INO + I_UQ + I_UKV + I_OUTO + I_RT;
    for (int item = blockIdx.x; item < NITEMS; item += gridDim.x) {
        int it = item;
        if (it < I_MOD) {
            const int l = it / 48, n0 = (it % 48) * 128, kg = tid >> 5, cl = tid & 31;
            LAS float* s = (LAS float*)lds;
            LAS float* red = (LAS float*)(lds + 12288);
            for (int idx = tid; idx < 3072; idx += 256) { const int v = idx >> 10, k = idx & 1023; const float cv = v < 2 ? p.c[v * DM + k] : p.c_ctx[k]; s[idx] = cv / (1.f + expf(-cv)); }
            __syncthreads();
            f32x4 a0 = {0.f, 0.f, 0.f, 0.f}, a1 = a0, a2 = a0;
            const float* w = p.w_mod + (size_t)l * DM * 6144 + (size_t)(kg * 128) * 6144 + n0 + cl * 4;
#pragma unroll 8
            for (int k = 0; k < 128; ++k) { const f32x4 wv = *(const f32x4*)(w + (size_t)k * 6144); const int kk = kg * 128 + k; a0 += wv * s[kk]; a1 += wv * s[1024 + kk]; a2 += wv * s[2048 + kk]; }
            *(LAS f32x4*)(red + (kg * 3 + 0) * 128 + cl * 4) = a0; *(LAS f32x4*)(red + (kg * 3 + 1) * 128 + cl * 4) = a1; *(LAS f32x4*)(red + (kg * 3 + 2) * 128 + cl * 4) = a2;
            __syncthreads();
            for (int idx = tid; idx < 384; idx += 256) { const int v = idx >> 7, n = idx & 127; float acc = 0.f;
#pragma unroll
                for (int g = 0; g < 8; ++g) acc += red[(g * 3 + v) * 128 + n];
                ((float*)(ws + OFF_MOD))[((size_t)l * 3 + v) * 6144 + n0 + n] = acc + p.b_mod[l * 6144 + n0 + n]; }
            __syncthreads();
            continue;
        }
        it -= I_MOD;
        if (it < I_ROPE) {
            const int idx = it * 256 + tid, pos = idx >> 5, i = idx & 31, row = pos >> 6, col = pos & 63, j = i & 15;
            const float invf = powf(10000.f, -(float)(2 * j) / 32.f);
            const float ang = (float)(i < 16 ? row : col) * invf;
            float sn, cs; sincosf(ang, &sn, &cs);
            ((f32x2*)(ws + OFF_ROPE))[idx] = (f32x2){cs, sn};
            continue;
        }
        it -= I_ROPE;
        if (it < I_INE) { const int kb = it / 19, nb = it % 19;
            transpose_item(lds, DM, (bf16*)(ws + OFF_W_IN_E), kb * 64, nb * 128, 2336, 1, p.w_in_e, nullptr, 2336, nullptr); continue; }
        it -= I_INE;
        if (it < I_OUTE) { const int kb = it / 8, nb = it % 8;
            transpose_item(lds, DM, (bf16*)(ws + OFF_W_OUT_E), kb * 64, nb * 128, DM, 0, p.w_out_e, nullptr, DM, nullptr); continue; }
        it -= I_OUTE;
        if (it < I_INO) { const int kb = it / 7, nb = it % 7;
            transpose_item(lds, DM, (bf16*)(ws + OFF_W_IN_O), kb * 64, nb * 128, 832, 0, p.w_in_o, nullptr, 832, nullptr); continue; }
        it -= I_INO;
        if (it < I_UQ) { const int kb = it / 12, nb = it % 12;
            transpose_item(lds, 512, (bf16*)(ws + OFF_W_UQ), kb * 64, nb * 128, 1536, 0, p.w_uq, nullptr, 1536, p.mla_q_norm); continue; }
        it -= I_UQ;
        if (it < I_UKV) { const int kb = it / 16, nb = it % 16;
            transpose_item(lds, 256, (bf16*)(ws + OFF_W_UKV), kb * 64, nb * 128, 2048, 0, p.w_ukv, nullptr, 2048, p.mla_kv_norm); continue; }
        it -= I_UKV;
        if (it < I_OUTO) { const int kb = it / 8, nb = it % 8;
            transpose_item(lds, DM, (bf16*)(ws + OFF_W_OUT_O), kb * 64, nb * 128, DM, 0, p.w_out_o, nullptr, DM, nullptr); continue; }
        it -= I_OUTO;
        { const int l = it / 16, kb = it % 16;
            transpose_item(lds, DM, (bf16*)(ws + OFF_W_RT) + (size_t)l * 128 * DM, kb * 64, 0, 64, 0, p.w_router + (size_t)l * DM * 64, nullptr, 64, nullptr); }
    }
}

__device__ __forceinline__ void load_row(const float* src, int lane, f32x4 (&v)[4]) {
#pragma unroll
    for (int j = 0; j < 4; ++j) v[j] = *(const f32x4*)(src + lane * 4 + 256 * j);
}
__device__ __forceinline__ float row_sumsq(const f32x4 (&v)[4]) {
    float s = 0.f;
#pragma unroll
    for (int j = 0; j < 4; ++j) s += v[j].x * v[j].x + v[j].y * v[j].y + v[j].z * v[j].z + v[j].w * v[j].w;
    return wave_sum(s);
}
__device__ __forceinline__ void modulate_store(const f32x4 (&v)[4], float rinv, const float* g, const float* sh, const float* sc, bf16* dst, int lane) {
#pragma unroll
    for (int j = 0; j < 4; ++j) {
        const int c = lane * 4 + 256 * j;
        const f32x4 gg = *(const f32x4*)(g + c), s1 = *(const f32x4*)(sc + c), s0 = *(const f32x4*)(sh + c);
        const f32x4 o = v[j] * rinv * gg * (s1 + 1.f) + s0;
        u32x2 w; w.x = pk2(o.x, o.y); w.y = pk2(o.z, o.w);
        *(u32x2*)(dst + c) = w;
    }
}
__device__ __forceinline__ const float* hl_src0(const Params& p, int r) { return r < TC ? p.ctx + (size_t)r * DM : p.x + (size_t)(r - TC) * DM; }
__device__ __forceinline__ float* hl_buf(const Params& p, int r) { return r < TC ? (float*)(p.ws + OFF_HC) + (size_t)r * DM : p.out + (size_t)(r - TC) * DM; }

__device__ __forceinline__ void ph_modulate0(const Params& p) {
    const int lane = threadIdx.x & 63, gw = blockIdx.x * 4 + (threadIdx.x >> 6), ngw = gridDim.x * 4;
    const float* mod = (const float*)(p.ws + OFF_MOD);
    bf16* U = (bf16*)(p.ws + OFF_U);
    for (int r = gw; r < TT; r += ngw) {
        f32x4 v[4]; load_row(hl_src0(p, r), lane, v);
        const float rinv = rsqrtf(row_sumsq(v) * (1.f / DM) + RMS_EPS);
        const float* mv = mod + (size_t)modvec(r) * 6144;
        modulate_store(v, rinv, p.g_mix_pre, mv, mv + 1024, U + (size_t)r * DM, lane);
    }
}

__device__ __forceinline__ void ph_rowpassA(const Params& p, int l, int row_lo, const float* Y) {
    const int lane = threadIdx.x & 63, gw = blockIdx.x * 4 + (threadIdx.x >> 6), ngw = gridDim.x * 4;
    const float* mod = (const float*)(p.ws + OFF_MOD) + (size_t)l * 3 * 6144;
    bf16* U = (bf16*)(p.ws + OFF_U);
    for (int r = row_lo + gw; r < TT; r += ngw) {
        f32x4 y[4], h[4];
        load_row(Y + (size_t)r * DM, lane, y);
        load_row(l == 0 ? hl_src0(p, r) : (const float*)hl_buf(p, r), lane, h);
        const float rinv = rsqrtf(row_sumsq(y) * (1.f / DM) + RMS_EPS);
        const float* mv = mod + (size_t)modvec(r) * 6144;
        float* hb = hl_buf(p, r);
#pragma unroll
        for (int j = 0; j < 4; ++j) {
            const int c = lane * 4 + 256 * j;
            const f32x4 gg = *(const f32x4*)(p.g_mix_post + l * DM + c), gt = *(const f32x4*)(mv + 2048 + c);
            h[j] = h[j] + gt * (y[j] * rinv * gg);
            *(f32x4*)(hb + c) = h[j];
        }
        const float rinv2 = rsqrtf(row_sumsq(h) * (1.f / DM) + RMS_EPS);
        modulate_store(h, rinv2, p.g_ffn_pre + l * DM, mv + 3072, mv + 4096, U + (size_t)r * DM, lane);
        {
            unsigned char* u8 = p.ws + AM_U8 + (size_t)r * DM;
#pragma unroll
            for (int j = 0; j < 4; ++j) {
                const int c = lane * 4 + 256 * j;
                const f32x4 gg = *(const f32x4*)(p.g_ffn_pre + l * DM + c), s1 = *(const f32x4*)(mv + 4096 + c), s0 = *(const f32x4*)(mv + 3072 + c);
                const f32x4 o = h[j] * rinv2 * gg * (s1 + 1.f) + s0;
                *(unsigned*)(u8 + c) = pk4_fp8(o.x, o.y, o.z, o.w);
            }
        }
    }
}

constexpr int MOE_LDS_OFF = 65536;
__device__ __forceinline__ void moe_tables(const Params& p, LAS unsigned char* lds, int l, int row_lo) {
    LAS int* cnt = (LAS int*)(lds + MOE_LDS_OFF); LAS int* tp = cnt + 80; LAS int* sp = tp + 80;
    const int tid = threadIdx.x;
    if (tid < 64) cnt[tid] = ((const int*)(p.ws + OFF_CNT))[l * 64 + tid];
    if (tid == 64) cnt[64] = TT - row_lo;
    __syncthreads();
    if (tid == 0) {
        int a = 0, s = 0;
        for (int e = 0; e < 65; ++e) { tp[e] = a; sp[e] = s; a += (cnt[e] + 127) >> 7; s += cnt[e]; }
        tp[65] = a;
    }
    __syncthreads();
}

__device__ __forceinline__ void ph_rowpassB(const Params& p, LAS unsigned char* lds, int l, int row_lo) {
    moe_tables(p, lds, l, row_lo);
    LAS int* sp = (LAS int*)(lds + MOE_LDS_OFF) + 160;
    const int lane = threadIdx.x & 63, gw = blockIdx.x * 4 + (threadIdx.x >> 6), ngw = gridDim.x * 4;
    const float* mod = (const float*)(p.ws + OFF_MOD) + (size_t)l * 3 * 6144;
    const bf16* YR = (const bf16*)(p.ws + AM_YR);
    const int* tokslot = (const int*)(p.ws + OFF_TOKSLOT); const float* W8 = (const float*)(p.ws + OFF_W8);
    bf16* U = (bf16*)(p.ws + OFF_U);
    const int c0 = lane * 8;
    for (int r = row_lo + gw; r < TT; r += ngw) {
        int ts = 0; float wv = 0.f;
        if (lane < 8) { ts = tokslot[(size_t)r * 8 + lane]; wv = W8[(size_t)r * 8 + lane]; }
        const int myslot = sp[ts >> 20] + (ts & 0xfffff);
        float f[16];
#pragma unroll
        for (int i = 0; i < 16; ++i) f[i] = 0.f;
#pragma unroll
        for (int k = 0; k < 9; ++k) {
            size_t slot; float wk = 1.f;
            if (k < 8) { slot = (size_t)__shfl(myslot, k); wk = __shfl(wv, k); } else slot = (size_t)TT * 8 + r;
            const bf16* yr = YR + slot * DM + c0;
            const u32x4 a = *(const u32x4*)yr, b2 = *(const u32x4*)(yr + 512);
            f[0] += wk * bflo(a.x); f[1] += wk * bfhi(a.x); f[2] += wk * bflo(a.y); f[3] += wk * bfhi(a.y);
            f[4] += wk * bflo(a.z); f[5] += wk * bfhi(a.z); f[6] += wk * bflo(a.w); f[7] += wk * bfhi(a.w);
            f[8] += wk * bflo(b2.x); f[9] += wk * bfhi(b2.x); f[10] += wk * bflo(b2.y); f[11] += wk * bfhi(b2.y);
            f[12] += wk * bflo(b2.z); f[13] += wk * bfhi(b2.z); f[14] += wk * bflo(b2.w); f[15] += wk * bfhi(b2.w);
        }
        float ss = 0.f;
#pragma unroll
        for (int i = 0; i < 16; ++i) ss += f[i] * f[i];
        const float rinv = rsqrtf(wave_sum(ss) * (1.f / DM) + RMS_EPS);
        const float* mv = mod + (size_t)modvec(r) * 6144;
        float* hb = hl_buf(p, r);
        float h[16];
#pragma unroll
        for (int q = 0; q < 4; ++q) {
            const int c = c0 + (q & 1) * 4 + (q >> 1) * 512;
            const f32x4 hv = *(const f32x4*)(hb + c), gg = *(const f32x4*)(p.g_ffn_post + l * DM + c), gt = *(const f32x4*)(mv + 5120 + c);
            const f32x4 fv = {f[q * 4 + 0], f[q * 4 + 1], f[q * 4 + 2], f[q * 4 + 3]};
            const f32x4 o = hv + gt * (fv * rinv * gg);
            *(f32x4*)(hb + c) = o;
            h[q * 4 + 0] = o.x; h[q * 4 + 1] = o.y; h[q * 4 + 2] = o.z; h[q * 4 + 3] = o.w;
        }
        if (l == 0) {
            float s2 = 0.f;
#pragma unroll
            for (int i = 0; i < 16; ++i) s2 += h[i] * h[i];
            const float rinv2 = rsqrtf(wave_sum(s2) * (1.f / DM) + RMS_EPS);
            const float* mv1 = mv + 3 * 6144;
#pragma unroll
            for (int hf = 0; hf < 2; ++hf) {
                const int c = c0 + hf * 512;
                const f32x4 g0 = *(const f32x4*)(p.g_mix_pre + DM + c), g1 = *(const f32x4*)(p.g_mix_pre + DM + c + 4);
                const f32x4 sh0 = *(const f32x4*)(mv1 + c), sh1 = *(const f32x4*)(mv1 + c + 4), sc0 = *(const f32x4*)(mv1 + 1024 + c), sc1 = *(const f32x4*)(mv1 + 1024 + c + 4);
                const f32x4 h0 = {h[hf * 8 + 0], h[hf * 8 + 1], h[hf * 8 + 2], h[hf * 8 + 3]}, h1 = {h[hf * 8 + 4], h[hf * 8 + 5], h[hf * 8 + 6], h[hf * 8 + 7]};
                const f32x4 o0 = h0 * rinv2 * g0 * (sc0 + 1.f) + sh0, o1 = h1 * rinv2 * g1 * (sc1 + 1.f) + sh1;
                *(u32x4*)(U + (size_t)r * DM + c) = (u32x4){pk2(o0.x, o0.y), pk2(o0.z, o0.w), pk2(o1.x, o1.y), pk2(o1.z, o1.w)};
            }
        }
    }
}

__device__ __forceinline__ int stg_col() { const int tid = threadIdx.x; return ((tid & 7) ^ ((tid >> 3) & 7)) * 8; }
__device__ __forceinline__ void plain_ptrs(const bf16* base, int row0, int ld, const bf16* (&pp)[4]) {
    const int tid = threadIdx.x;
    pp[0] = base + (size_t)(row0 + (tid >> 3)) * ld + stg_col();
#pragma unroll
    for (int i = 1; i < 4; ++i) pp[i] = pp[0] + (size_t)(32 * i) * ld;
}

__device__ __forceinline__ void ph_inproj0(const Params& p, LAS unsigned char* lds) {
    unsigned char* ws = p.ws;
    const bf16* U = (const bf16*)(ws + OFF_U); const bf16* W = (const bf16*)(ws + OFF_W_IN_E);
    bf16* Z0 = (bf16*)(ws + A0_Z0); bf16* VGT = (bf16*)(ws + A0_VGT); bf16* QS = (bf16*)(ws + A0_QS); bf16* KS = (bf16*)(ws + A0_KS); bf16* VST = (bf16*)(ws + A0_VST);
    const f32x2* rope = (const f32x2*)(ws + OFF_ROPE);
    const int tid = threadIdx.x, lane = tid & 63, wid = tid >> 6, wr = wid >> 1, wc = wid & 1, fr = lane & 15, fq = lane >> 4;
    constexpr int NTN = 19, NTM = TT / 128;
    auto make = [&](int t, GPtrs& g, int& nk) { int tm, tn; tile_mn(t, NTM, NTN, tm, tn); plain_ptrs(U, tm * 128, DM, g.a); plain_ptrs(W, tn * 128, DM, g.b); nk = DM / 64; };
    auto epi = [&](int t, f32x4 (&acc)[4][4]) {
        int tm, tn; tile_mn(t, NTM, NTN, tm, tn); const int brow = tm * 128, bcol = tn * 128;
        const int cb = bcol + wc * 64;
        LAS unsigned char* wl = lds + 32768 + wid * 8192;
        const int r0 = brow + wr * 64;
        const RowInfo ri0 = rowinfo(r0);
        if (cb < 1024) {
            epi_store_rows(wl, acc, fr, fq, lane, [&](int row) { return Z0 + (size_t)(r0 + row) * Z0P + cb; });
        } else if (cb < 1536) {
            const int c0 = cb - 1024;
            epi_store_cols(wl, acc, fr, fq, lane, [&](int col) { return VGT + (size_t)(c0 + col) * TT + r0; });
        } else if (cb < 2176) {
            const float sc = cb < 2048 ? 0.125f * LOG2E : 1.f;
#pragma unroll
            for (int m = 0; m < 4; ++m) {
                const int pos = ri0.pos + m * 16 + fr;
#pragma unroll
                for (int n = 0; n < 2; ++n)
#pragma unroll
                    for (int j = 0; j < 4; ++j) {
                        const float x1 = acc[m][n][j] * sc, x2 = acc[m][n + 2][j] * sc;
                        if (ri0.lat) { const f32x2 cs = rope[(size_t)pos * 32 + n * 16 + fq * 4 + j]; acc[m][n][j] = x1 * cs.x - x2 * cs.y; acc[m][n + 2][j] = x2 * cs.x + x1 * cs.y; }
                        else { acc[m][n][j] = x1; acc[m][n + 2][j] = x2; }
                    }
                asm volatile("" ::: "memory");
            }
            bf16* dst;
            if (cb < 2048) { const int h = (cb - 1536) >> 6; dst = QS + ((size_t)(ri0.b * 8 + h) * NKEY + ri0.kq) * 64; }
            else { const int h = (cb - 2048) >> 6; dst = KS + ((size_t)(ri0.b * 2 + h) * NKEY + ri0.kq) * 64; }
            epi_store_rows(wl, acc, fr, fq, lane, [&](int row) { return dst + (size_t)row * 64; });
        } else if (cb < 2304) {
            const int h = (cb - 2176) >> 6;
            bf16* dst = VST + (size_t)(ri0.b * 2 + h) * 64 * NKEY + ri0.kq;
            epi_store_cols(wl, acc, fr, fq, lane, [&](int col) { return dst + (size_t)col * NKEY; });
        } else if (cb == 2304) {
#pragma unroll
            for (int m = 0; m < 4; ++m) {
                const int r = r0 + m * 16 + fr;
#pragma unroll
                for (int n = 0; n < 2; ++n) { u32x2 w; w.x = pk2(acc[m][n][0], acc[m][n][1]); w.y = pk2(acc[m][n][2], acc[m][n][3]); *(u32x2*)(Z0 + (size_t)r * Z0P + 1024 + n * 16 + fq * 4) = w; }
            }
        }
    };
    gemm_tiles<true>(lds, vcu_id(), NTM * NTN, gridDim.x, make, epi);
}

__device__ __forceinline__ void ph_outproj(const Params& p, LAS unsigned char* lds, const bf16* MIX, const bf16* W, float* Y, int row_lo) {
    const int tid = threadIdx.x, lane = tid & 63, wid = tid >> 6, wr = wid >> 1, wc = wid & 1, fr = lane & 15, fq = lane >> 4;
    const int tm0 = row_lo / 128, ntm = TT / 128 - tm0;
    auto make = [&](int t, GPtrs& g, int& nk) { int tm, tn; tile_mn(t, ntm, 8, tm, tn); plain_ptrs(MIX, (tm0 + tm) * 128, DM, g.a); plain_ptrs(W, tn * 128, DM, g.b); nk = DM / 64; };
    auto epi = [&](int t, f32x4 (&acc)[4][4]) {
        int tm, tn; tile_mn(t, ntm, 8, tm, tn); tm += tm0; const int brow = tm * 128, bcol = tn * 128;
#pragma unroll
        for (int m = 0; m < 4; ++m) {
            const int r = brow + wr * 64 + m * 16 + fr;
#pragma unroll
            for (int n = 0; n < 4; ++n) *(f32x4*)(Y + (size_t)r * DM + bcol + wc * 64 + n * 16 + fq * 4) = acc[m][n];
        }
    };
    gemm_tiles<true, 16>(lds, vcu_id(), ntm * 8, gridDim.x, make, epi);
}

template <int DQK, int DV>
__device__ __forceinline__ void attn_item(LAS unsigned char* lds, const bf16* Qg, const bf16* Kg, const bf16* VTg, int a1, int b0, int b1, int qpos0,
                                          float m_init, float l_init, bf16* Og, int o_pitch) {
    constexpr int KPB = DQK * 2, NS = DQK / 16, NDV = DV / 32, KCH = DQK / 8, KBYTES = 64 * KPB, KN = 64 * KCH / 256, VN = DV * 8 / 256;
    static_assert(KN == 6 || KN == 2, "counted waits below are written for KN = 6 or 2");
    const int tid = threadIdx.x, lane = tid & 63, wid = tid >> 6, ql = lane & 31, hi = lane >> 5;
    LAS unsigned char* Kb0 = lds; LAS unsigned char* Vs = lds + 2 * KBYTES;
    asm volatile("s_waitcnt vmcnt(0) lgkmcnt(0)" ::: "memory");
    __builtin_amdgcn_s_barrier();
    asm volatile("" ::: "memory");
    bf16x8 qf[NS];
    {
        const bf16* qrow = Qg + (size_t)(wid * 32 + ql) * DQK + hi * 8;
#pragma unroll
        for (int s = 0; s < NS; ++s) qf[s] = *(const bf16x8*)(qrow + s * 16);
    }
    unsigned koff[KN], voff[VN];
#pragma unroll
    for (int i = 0; i < KN; ++i) { const int pz = tid + 256 * i, key = pz / KCH, ch = pz % KCH; koff[i] = (unsigned)(key * DQK + (((ch & ~7) | ((ch & 7) ^ ((key >> 1) & 7))) * 8)); }
#pragma unroll
    for (int i = 0; i < VN; ++i) { const int pz = tid + 256 * i, dv = pz >> 3, ch = pz & 7; voff[i] = (unsigned)(dv * NKEY + ((ch ^ ((dv >> 1) & 7)) * 8)); }
    const int ntot = a1 + (b1 - b0);
#define ATTN_KT(it_) ((it_) < a1 ? (it_) : b0 + ((it_) - a1))
#define ATTN_DMA_K(kt_, buf_) do { _Pragma("unroll") for (int i_ = 0; i_ < KN; ++i_) glds16(Kg + (size_t)(kt_) * 64 * DQK + koff[i_], Kb0 + (buf_) * KBYTES + (tid + 256 * i_) * 16); } while (0)
#define ATTN_DMA_V(kt_) do { _Pragma("unroll") for (int i_ = 0; i_ < VN; ++i_) glds16(VTg + (size_t)(kt_) * 64 + voff[i_], Vs + (tid + 256 * i_) * 16); } while (0)
    ATTN_DMA_K(ATTN_KT(0), 0);
    f32x16 o[NDV];
#pragma unroll
    for (int d = 0; d < NDV; ++d)
#pragma unroll
        for (int r = 0; r < 16; ++r) o[d][r] = 0.f;
    float mrun = m_init, lrun = l_init;
    const int sw = (ql >> 1) & 7;
    const LAS unsigned char* kfrag = Kb0 + ql * KPB; const LAS unsigned char* vfrag = Vs + ql * 128;
    for (int it = 0; it < ntot; ++it) {
        const int kt = ATTN_KT(it), cur = it & 1;
        const bool masked = it >= a1;
        asm volatile("s_waitcnt vmcnt(0) lgkmcnt(0)" ::: "memory");
        __builtin_amdgcn_s_barrier();
        asm volatile("" ::: "memory");
        ATTN_DMA_V(kt);
        if (it + 1 < ntot) { const int ktn = ATTN_KT(it + 1); ATTN_DMA_K(ktn, cur ^ 1); }
        f32x16 p0, p1;
#pragma unroll
        for (int r = 0; r < 16; ++r) { p0[r] = 0.f; p1[r] = 0.f; }
        const LAS unsigned char* kc = kfrag + cur * KBYTES;
#pragma unroll
        for (int s = 0; s < NS; ++s) {
            const int c = 2 * s + hi, off = ((c & ~7) | ((c & 7) ^ sw)) * 16;
            const bf16x8 k0 = *(const LAS bf16x8*)(kc + off);
            const bf16x8 k1 = *(const LAS bf16x8*)(kc + 32 * KPB + off);
            p0 = __builtin_amdgcn_mfma_f32_32x32x16_bf16(k0, qf[s], p0, 0, 0, 0);
            p1 = __builtin_amdgcn_mfma_f32_32x32x16_bf16(k1, qf[s], p1, 0, 0, 0);
        }
        if (masked) {
            const int kbase = kt * 64 - CTX, qpos = qpos0 + wid * 32 + ql;
#pragma unroll
            for (int r = 0; r < 16; ++r) {
                const int d0 = qpos - (kbase + crow(r, hi)), d1 = d0 - 32;
                if (d0 > 128 || d0 < -128) p0[r] = -1e30f;
                if (d1 > 128 || d1 < -128) p1[r] = -1e30f;
            }
        }
        float mx = p0[0];
#pragma unroll
        for (int r = 1; r < 16; ++r) mx = fmaxf(mx, p0[r]);
#pragma unroll
        for (int r = 0; r < 16; ++r) mx = fmaxf(mx, p1[r]);
        mx = fmaxf(mx, __shfl_xor(mx, 32));
        if (__any(mx > mrun + 8.f)) {
            const float mn = fmaxf(mrun, mx), alpha = ex2(mrun - mn);
            mrun = mn; lrun *= alpha;
#pragma unroll
            for (int d = 0; d < NDV; ++d)
#pragma unroll
                for (int r = 0; r < 16; ++r) o[d][r] *= alpha;
        }
        float rs = 0.f;
#pragma unroll
        for (int r = 0; r < 16; ++r) { p0[r] = ex2(p0[r] - mrun); rs += p0[r]; }
#pragma unroll
        for (int r = 0; r < 16; ++r) { p1[r] = ex2(p1[r] - mrun); rs += p1[r]; }
        rs += __shfl_xor(rs, 32);
        lrun += rs;
        bf16x8 pf[4];
#define ATTN_PK4(P, BASE, OUT) do { const unsigned a0_ = pk2(P[BASE + 0], P[BASE + 1]), a1_ = pk2(P[BASE + 2], P[BASE + 3]), b0_ = pk2(P[BASE + 4], P[BASE + 5]), b1_ = pk2(P[BASE + 6], P[BASE + 7]); \
        const auto r0_ = __builtin_amdgcn_permlane32_swap(a0_, b0_, false, false); const auto r1_ = __builtin_amdgcn_permlane32_swap(a1_, b1_, false, false); \
        OUT = mk8((u32x4){r0_[0], r1_[0], r0_[1], r1_[1]}); } while (0)
        ATTN_PK4(p0, 0, pf[0]); ATTN_PK4(p0, 8, pf[1]); ATTN_PK4(p1, 0, pf[2]); ATTN_PK4(p1, 8, pf[3]);
#undef ATTN_PK4
        if (it + 1 < ntot) { if (KN == 6) asm volatile("s_waitcnt vmcnt(6) lgkmcnt(0)" ::: "memory"); else asm volatile("s_waitcnt vmcnt(2) lgkmcnt(0)" ::: "memory"); }
        else asm volatile("s_waitcnt vmcnt(0) lgkmcnt(0)" ::: "memory");
        __builtin_amdgcn_s_barrier();
        asm volatile("" ::: "memory");
#pragma unroll
        for (int d = 0; d < NDV; ++d) {
#pragma unroll
            for (int kk = 0; kk < 4; ++kk) {
                const bf16x8 vf = *(const LAS bf16x8*)(vfrag + d * 32 * 128 + (((2 * kk + hi) ^ sw) * 16));
                o[d] = __builtin_amdgcn_mfma_f32_32x32x16_bf16(vf, pf[kk], o[d], 0, 0, 0);
            }
        }
    }
#undef ATTN_KT
#undef ATTN_DMA_K
#undef ATTN_DMA_V
    const float inv = 1.f / lrun;
    bf16* orow = Og + (size_t)(wid * 32 + ql) * o_pitch;
#pragma unroll
    for (int d = 0; d < NDV; ++d)
#pragma unroll
        for (int g = 0; g < 4; ++g) {
            u32x2 w; w.x = pk2(o[d][g * 4 + 0] * inv, o[d][g * 4 + 1] * inv); w.y = pk2(o[d][g * 4 + 2] * inv, o[d][g * 4 + 3] * inv);
            *(u32x2*)(orow + d * 32 + 8 * g + 4 * hi) = w;
        }
}

constexpr int GA_CUM = 0, GA_ALOW = 16384, GA_WA = 20480, GA_BA = 24576, GA_QT = 24832, GA_TOT = 25856, GA_END = 26112;
__device__ __forceinline__ void gla_cum(const Params& p, LAS unsigned char* lds, const bf16* Z0, int r0, int h, int dir) {
    const int tid = threadIdx.x;
    LAS float* cum = (LAS float*)(lds + GA_CUM); LAS float* alow = (LAS float*)(lds + GA_ALOW); LAS float* wa = (LAS float*)(lds + GA_WA);
    LAS float* ba = (LAS float*)(lds + GA_BA); LAS float* qt = (LAS float*)(lds + GA_QT); LAS float* tot = (LAS float*)(lds + GA_TOT);
    {
        const int t = tid >> 2, i4 = (tid & 3) * 4;
        const u32x2 w = *(const u32x2*)(Z0 + (size_t)(r0 + t) * Z0P + 1024 + dir * 16 + i4);
        alow[t * 16 + i4 + 0] = bflo(w.x); alow[t * 16 + i4 + 1] = bfhi(w.x); alow[t * 16 + i4 + 2] = bflo(w.y); alow[t * 16 + i4 + 3] = bfhi(w.y);
#pragma unroll
        for (int q = 0; q < 4; ++q) { const int idx = tid * 4 + q, i = idx >> 6, j = idx & 63; wa[idx] = p.gla_wa2[(size_t)(dir * 16 + i) * 256 + h * 64 + j]; }
        if (tid < 64) ba[tid] = p.gla_ba[dir * 256 + h * 64 + tid];
    }
    __syncthreads();
    const int j = tid & 63, tq = tid >> 6;
    float la[16], wj[16];
#pragma unroll
    for (int i = 0; i < 16; ++i) wj[i] = wa[i * 64 + j];
    const float bj = ba[j];
#pragma unroll
    for (int tt = 0; tt < 16; ++tt) {
        const int t = tq * 16 + tt;
        float x = bj;
#pragma unroll
        for (int q = 0; q < 4; ++q) { const f32x4 a = *(const LAS f32x4*)(alow + t * 16 + q * 4);
            x += a.x * wj[q * 4] + a.y * wj[q * 4 + 1] + a.z * wj[q * 4 + 2] + a.w * wj[q * 4 + 3]; }
        la[tt] = (fminf(x, 0.f) - __logf(1.f + __expf(-fabsf(x)))) * (1.f / 16.f);
    }
    float run = 0.f;
    if (dir == 0) {
#pragma unroll
        for (int tt = 0; tt < 16; ++tt) { run += la[tt]; cum[(tq * 16 + tt) * 64 + j] = run; }
    } else {
#pragma unroll
        for (int tt = 15; tt >= 0; --tt) { run += la[tt]; cum[(tq * 16 + tt) * 64 + j] = run; }
    }
    qt[tq * 64 + j] = run;
    __syncthreads();
    float off = 0.f, total = 0.f;
#pragma unroll
    for (int q = 0; q < 4; ++q) { const float v = qt[q * 64 + j]; total += v; if (dir == 0 ? (q < tq) : (q > tq)) off += v; }
#pragma unroll
    for (int tt = 0; tt < 16; ++tt) cum[(tq * 16 + tt) * 64 + j] += off;
    if (tq == 0) tot[j] = total;
    __syncthreads();
}

__device__ __forceinline__ int gla_row0(int b, int cc) { return cc < 4 ? b * CTX + cc * 64 : TC + b * SEQ + (cc - 4) * 64; }
__device__ __forceinline__ int gla_step(int cc, int dir) { return dir == 0 ? cc : (cc < 4 ? 3 - cc : 4 + (131 - cc)); }

__device__ __forceinline__ void gla_g1_item(const Params& p, LAS unsigned char* lds, int item) {
    unsigned char* ws = p.ws;
    const bf16* Z0 = (const bf16*)(ws + A0_Z0); const bf16* VGT = (const bf16*)(ws + A0_VGT);
    bf16* GS = (bf16*)(ws + A0_GS); float* GD = (float*)(ws + A0_GD);
    const int cc = item % NSTEP, rest = item / NSTEP, dir = rest & 1, h = (rest >> 1) & 3, b = rest >> 3;
    const int r0 = gla_row0(b, cc), step = gla_step(cc, dir), chain = (b * 4 + h) * 2 + dir;
    const int tid = threadIdx.x, lane = tid & 63, wid = tid >> 6, fr = lane & 15, fq = lane >> 4;
    __syncthreads();
    gla_cum(p, lds, Z0, r0, h, dir);
    LAS float* cum = (LAS float*)(lds + GA_CUM); LAS float* tot = (LAS float*)(lds + GA_TOT);
    LAS bf16* KT = (LAS bf16*)(lds + GA_END);
    {
        const int t = tid >> 2, d0 = (tid & 3) * 16;
        const u32x4 w0 = *(const u32x4*)(Z0 + (size_t)(r0 + t) * Z0P + 256 + h * 64 + d0), w1 = *(const u32x4*)(Z0 + (size_t)(r0 + t) * Z0P + 256 + h * 64 + d0 + 8);
        const unsigned ww[8] = {w0.x, w0.y, w0.z, w0.w, w1.x, w1.y, w1.z, w1.w};
#pragma unroll
        for (int i = 0; i < 8; ++i) {
            const int d = d0 + 2 * i;
            KT[d * 72 + t] = f2bf(bflo(ww[i]) * __expf(tot[d] - cum[t * 64 + d]));
            KT[(d + 1) * 72 + t] = f2bf(bfhi(ww[i]) * __expf(tot[d + 1] - cum[t * 64 + d + 1]));
        }
    }
    if (tid < 64) GD[((size_t)chain * NSTEP + step) * 64 + tid] = __expf(tot[tid]);
    __syncthreads();
    f32x4 acc[2][4];
#pragma unroll
    for (int m = 0; m < 2; ++m)
#pragma unroll
        for (int n = 0; n < 4; ++n) acc[m][n] = (f32x4){0.f, 0.f, 0.f, 0.f};
#pragma unroll
    for (int ks = 0; ks < 2; ++ks) {
        bf16x8 af[2], bfr[4];
#pragma unroll
        for (int m = 0; m < 2; ++m) af[m] = *(const bf16x8*)(VGT + (size_t)(h * 128 + wid * 32 + m * 16 + fr) * TT + r0 + ks * 32 + fq * 8);
#pragma unroll
        for (int n = 0; n < 4; ++n) bfr[n] = *(const LAS bf16x8*)(KT + (n * 16 + fr) * 72 + ks * 32 + fq * 8);
#pragma unroll
        for (int m = 0; m < 2; ++m)
#pragma unroll
            for (int n = 0; n < 4; ++n) acc[m][n] = __builtin_amdgcn_mfma_f32_16x16x32_bf16(bfr[n], af[m], acc[m][n], 0, 0, 0);
    }
    bf16* dst = GS + ((size_t)chain * NSTEP + step) * 8192;
#pragma unroll
    for (int m = 0; m < 2; ++m)
#pragma unroll
        for (int n = 0; n < 4; ++n) *(u32x2*)(dst + (size_t)(wid * 32 + m * 16 + fr) * 64 + n * 16 + fq * 4) = (u32x2){pk2(acc[m][n][0], acc[m][n][1]), pk2(acc[m][n][2], acc[m][n][3])};
}

__device__ __forceinline__ void ph_gla_scan(const Params& p) {
    unsigned* GS = (unsigned*)(p.ws + A0_GS); const float* GD = (const float*)(p.ws + A0_GD);
    for (int idx = blockIdx.x * 256 + threadIdx.x; idx < 16 * 4096; idx += gridDim.x * 256) {
        const int chain = idx >> 12, e2 = idx & 4095, dk = (e2 & 31) * 2;
        unsigned* g = GS + (size_t)chain * NSTEP * 4096 + e2;
        const f32x2* d = (const f32x2*)(GD + (size_t)chain * NSTEP * 64 + dk);
        float s0 = 0.f, s1 = 0.f;
#pragma unroll 12
        for (int s = 0; s < NSTEP; ++s) {
            const unsigned t = g[(size_t)s * 4096]; const f32x2 dec = d[s * 32];
            g[(size_t)s * 4096] = pk2(s0, s1);
            s0 = dec.x * s0 + bflo(t); s1 = dec.y * s1 + bfhi(t);
        }
    }
}

__device__ __forceinline__ void gla_g3_item(const Params& p, LAS unsigned char* lds, int item) {
    unsigned char* ws = p.ws;
    const bf16* Z0 = (const bf16*)(ws + A0_Z0); const bf16* VGT = (const bf16*)(ws + A0_VGT);
    const bf16* GS = (const bf16*)(ws + A0_GS); bf16* MIX = (bf16*)(ws + A0_MIX);
    const int cc = item % NSTEP, rest = item / NSTEP, h = rest & 3, b = rest >> 2;
    const int r0 = gla_row0(b, cc);
    const int tid = threadIdx.x, lane = tid & 63, wid = tid >> 6, fr = lane & 15, fq = lane >> 4;
    LAS bf16* QT = (LAS bf16*)(lds + GA_END);
    LAS bf16* QI = (LAS bf16*)(lds + GA_END + 9216);
    LAS bf16* KT = (LAS bf16*)(lds + GA_END + 18432);
    LAS bf16* PP = (LAS bf16*)(lds);
    f32x4 o[4][2];
#pragma unroll
    for (int m = 0; m < 4; ++m)
#pragma unroll
        for (int n = 0; n < 2; ++n) o[m][n] = (f32x4){0.f, 0.f, 0.f, 0.f};
    for (int dir = 0; dir < 2; ++dir) {
        const int step = gla_step(cc, dir), chain = (b * 4 + h) * 2 + dir;
        __syncthreads();
        gla_cum(p, lds, Z0, r0, h, dir);
        LAS float* cum = (LAS float*)(lds + GA_CUM); LAS float* tot = (LAS float*)(lds + GA_TOT);
        {
            const int t = tid >> 2, d0 = (tid & 3) * 16;
            const bf16* zr = Z0 + (size_t)(r0 + t) * Z0P + h * 64 + d0;
            const u32x4 q0 = *(const u32x4*)(zr), q1 = *(const u32x4*)(zr + 8), k0 = *(const u32x4*)(zr + 256), k1 = *(const u32x4*)(zr + 264);
            const unsigned qq[8] = {q0.x, q0.y, q0.z, q0.w, q1.x, q1.y, q1.z, q1.w}, kk[8] = {k0.x, k0.y, k0.z, k0.w, k1.x, k1.y, k1.z, k1.w};
            unsigned oqt[8], oqi[8], okt[8];
#pragma unroll
            for (int i = 0; i < 8; ++i) {
                const int d = d0 + 2 * i;
                const float c0 = cum[t * 64 + d], c1 = cum[t * 64 + d + 1], t0 = tot[d], t1 = tot[d + 1];
                const float qa = bflo(qq[i]), qb = bfhi(qq[i]), ka = bflo(kk[i]), kb = bfhi(kk[i]);
                oqt[i] = pk2(qa * __expf(c0 - t0), qb * __expf(c1 - t1));
                oqi[i] = pk2(qa * __expf(c0), qb * __expf(c1));
                okt[i] = pk2(ka * __expf(t0 - c0), kb * __expf(t1 - c1));
            }
            *(LAS u32x4*)(QT + t * 72 + d0) = (u32x4){oqt[0], oqt[1], oqt[2], oqt[3]}; *(LAS u32x4*)(QT + t * 72 + d0 + 8) = (u32x4){oqt[4], oqt[5], oqt[6], oqt[7]};
            *(LAS u32x4*)(QI + t * 72 + d0) = (u32x4){oqi[0], oqi[1], oqi[2], oqi[3]}; *(LAS u32x4*)(QI + t * 72 + d0 + 8) = (u32x4){oqi[4], oqi[5], oqi[6], oqi[7]};
            *(LAS u32x4*)(KT + t * 72 + d0) = (u32x4){okt[0], okt[1], okt[2], okt[3]}; *(LAS u32x4*)(KT + t * 72 + d0 + 8) = (u32x4){okt[4], okt[5], okt[6], okt[7]};
        }
        __syncthreads();
        {
            f32x4 sa[4];
#pragma unroll
            for (int m = 0; m < 4; ++m) sa[m] = (f32x4){0.f, 0.f, 0.f, 0.f};
#pragma unroll
            for (int ks = 0; ks < 2; ++ks) {
                const bf16x8 kf = *(const LAS bf16x8*)(KT + (wid * 16 + fr) * 72 + ks * 32 + fq * 8);
#pragma unroll
                for (int m = 0; m < 4; ++m) {
                    const bf16x8 qfm = *(const LAS bf16x8*)(QT + (m * 16 + fr) * 72 + ks * 32 + fq * 8);
                    sa[m] = __builtin_amdgcn_mfma_f32_16x16x32_bf16(kf, qfm, sa[m], 0, 0, 0);
                }
            }
#pragma unroll
            for (int m = 0; m < 4; ++m) {
                const int t = m * 16 + fr;
                float v[4];
#pragma unroll
                for (int jj = 0; jj < 4; ++jj) { const int j = wid * 16 + fq * 4 + jj; const bool keep = dir == 0 ? (j <= t) : (j >= t); v[jj] = keep ? sa[m][jj] : 0.f; }
                *(LAS u32x2*)(PP + t * 72 + wid * 16 + fq * 4) = (u32x2){pk2(v[0], v[1]), pk2(v[2], v[3])};
            }
        }
        __syncthreads();
        const bf16* Sg = GS + ((size_t)chain * NSTEP + step) * 8192;
#pragma unroll
        for (int ks = 0; ks < 2; ++ks) {
            bf16x8 vfr[2], sfr[2];
#pragma unroll
            for (int n = 0; n < 2; ++n) {
                const int dv = wid * 32 + n * 16 + fr;
                vfr[n] = *(const bf16x8*)(VGT + (size_t)(h * 128 + dv) * TT + r0 + ks * 32 + fq * 8);
                sfr[n] = *(const bf16x8*)(Sg + (size_t)dv * 64 + ks * 32 + fq * 8);
            }
#pragma unroll
            for (int m = 0; m < 4; ++m) {
                const bf16x8 pfm = *(const LAS bf16x8*)(PP + (m * 16 + fr) * 72 + ks * 32 + fq * 8);
                const bf16x8 qim = *(const LAS bf16x8*)(QI + (m * 16 + fr) * 72 + ks * 32 + fq * 8);
#pragma unroll
                for (int n = 0; n < 2; ++n) {
                    o[m][n] = __builtin_amdgcn_mfma_f32_16x16x32_bf16(vfr[n], pfm, o[m][n], 0, 0, 0);
                    o[m][n] = __builtin_amdgcn_mfma_f32_16x16x32_bf16(sfr[n], qim, o[m][n], 0, 0, 0);
                }
            }
        }
    }
    __syncthreads();
    LAS float* red = (LAS float*)(lds + GA_END + 27648);
#pragma unroll
    for (int m = 0; m < 4; ++m) {
        float s = 0.f;
#pragma unroll
        for (int n = 0; n < 2; ++n)
#pragma unroll
            for (int j = 0; j < 4; ++j) s += o[m][n][j] * o[m][n][j];
        s += __shfl_xor(s, 16); s += __shfl_xor(s, 32);
        if (fq == 0) red[wid * 64 + m * 16 + fr] = s;
    }
    __syncthreads();
#pragma unroll
    for (int m = 0; m < 4; ++m) {
        const int t = m * 16 + fr;
        const float ss = red[t] + red[64 + t] + red[128 + t] + red[192 + t];
        const float rinv = rsqrtf(ss * (1.f / 128.f) + RMS_EPS);
        const int r = r0 + t;
#pragma unroll
        for (int n = 0; n < 2; ++n) {
            const int dv = wid * 32 + n * 16 + fq * 4;
            const u32x2 gw = *(const u32x2*)(Z0 + (size_t)r * Z0P + 512 + h * 128 + dv);
            const f32x4 ng = *(const f32x4*)(p.gla_norm + dv);
            const float g0 = bflo(gw.x), g1 = bfhi(gw.x), g2 = bflo(gw.y), g3 = bfhi(gw.y);
            const float y0 = o[m][n][0] * rinv * ng.x * siluf(g0), y1 = o[m][n][1] * rinv * ng.y * siluf(g1);
            const float y2 = o[m][n][2] * rinv * ng.z * siluf(g2), y3 = o[m][n][3] * rinv * ng.w * siluf(g3);
            *(u32x2*)(MIX + (size_t)r * DM + h * 128 + dv) = (u32x2){pk2(y0, y1), pk2(y2, y3)};
        }
    }
}

__device__ __forceinline__ void ph_swa_g1(const Params& p, LAS unsigned char* lds) {
    unsigned char* ws = p.ws;
    const bf16* QS = (const bf16*)(ws + A0_QS); const bf16* KS = (const bf16*)(ws + A0_KS); const bf16* VST = (const bf16*)(ws + A0_VST); bf16* MIX = (bf16*)(ws + A0_MIX);
    constexpr int N_SWA = 2 * 8 * 66, N_G1 = 2 * 4 * 2 * NSTEP;
    for (int item = blockIdx.x; item < N_SWA + N_G1; item += gridDim.x) {
        if (item < N_SWA) {
            const int qt = item % 66, rest = item / 66, h = rest & 7, b = rest >> 3, kvh = h >> 2;
            const bf16* Qg = QS + ((size_t)(b * 8 + h) * NKEY + qt * 128) * 64;
            const bf16* Kg = KS + (size_t)(b * 2 + kvh) * NKEY * 64;
            const bf16* Vg = VST + (size_t)(b * 2 + kvh) * 64 * NKEY;
            int b0 = 0, b1 = 0, qpos0 = 0, row0;
            if (qt >= 2) { qpos0 = (qt - 2) * 128; const int lo = qpos0 - 128 < 0 ? 0 : qpos0 - 128, hi2 = qpos0 + 256 > SEQ ? SEQ : qpos0 + 256; b0 = 4 + lo / 64; b1 = 4 + hi2 / 64; row0 = TC + b * SEQ + qpos0; }
            else row0 = b * CTX + qt * 128;
            const float sink = p.swa_sink[h] * LOG2E;
            attn_item<64, 64>(lds, Qg, Kg, Vg, 4, b0, b1, qpos0, sink, 1.f, MIX + (size_t)row0 * DM + 512 + h * 64, DM);
        } else gla_g1_item(p, lds, item - N_SWA);
    }
}
__device__ __forceinline__ void ph_gla_g3(const Params& p, LAS unsigned char* lds) {
    for (int item = blockIdx.x; item < 2 * 4 * NSTEP; item += gridDim.x) gla_g3_item(p, lds, item);
}

__device__ __forceinline__ void ph_router(const Params& p, LAS unsigned char* lds, int l, int row_lo) {
    unsigned char* ws = p.ws;
    const bf16* U = (const bf16*)(ws + OFF_U); const bf16* W = (const bf16*)(ws + OFF_W_RT) + (size_t)l * 128 * DM;
    int* cntg = (int*)(ws + OFF_CNT) + l * 64; int* tokslot = (int*)(ws + OFF_TOKSLOT); float* W8 = (float*)(ws + OFF_W8); int* LIST = (int*)(ws + OFF_LIST);
    const int tid = threadIdx.x, lane = tid & 63, wid = tid >> 6, wr = wid >> 1, wc = wid & 1, fr = lane & 15, fq = lane >> 4;
    LAS float* lg = (LAS float*)lds;
    const int tm0 = row_lo / 128;
    auto make = [&](int tm, GPtrs& g, int& nk) { plain_ptrs(U, tm * 128, DM, g.a); plain_ptrs(W, 0, DM, g.b); nk = DM / 64; };
    auto epi = [&](int tm, f32x4 (&acc)[4][4]) {
        const int brow = tm * 128;
        if (wc == 0) {
#pragma unroll
            for (int m = 0; m < 4; ++m)
#pragma unroll
                for (int n = 0; n < 4; ++n)
#pragma unroll
                    for (int j = 0; j < 4; ++j) lg[(wr * 64 + m * 16 + fr) * 65 + n * 16 + fq * 4 + j] = acc[m][n][j];
        }
        __syncthreads();
        LAS float* biasl = (LAS float*)(lds + 34816); LAS int* hist = (LAS int*)(lds + 34816 + 256); LAS int* basel = (LAS int*)(lds + 34816 + 512);
        if (tid < 64) { biasl[tid] = p.b_router[l * 64 + tid]; hist[tid] = 0; }
        __syncthreads();
        int esel[8], lrank[8]; float ssel[8]; float wsum = 0.f;
        if (tid < 128) {
            LAS float* L = lg + tid * 65;
            float gs[8];
#pragma unroll
            for (int g = 0; g < 8; ++g) {
                float m1 = -INFINITY, m2 = -INFINITY;
#pragma unroll
                for (int j = 0; j < 8; ++j) {
                    const int e = g * 8 + j;
                    const float sel = 1.f / (1.f + expf(-L[e])) + biasl[e];
                    L[e] = sel;
                    if (sel > m1) { m2 = m1; m1 = sel; } else if (sel > m2) m2 = sel;
                }
                gs[g] = m1 + m2;
            }
            unsigned allowed = 0u;
#pragma unroll
            for (int g = 0; g < 8; ++g) {
                int rk = 0;
#pragma unroll
                for (int h = 0; h < 8; ++h) rk += (gs[h] > gs[g] || (gs[h] == gs[g] && h < g)) ? 1 : 0;
                if (rk < 4) allowed |= 1u << g;
            }
#pragma unroll
            for (int k = 0; k < 8; ++k) {
                float best = -INFINITY; int bi = 0;
#pragma unroll
                for (int g = 0; g < 8; ++g) {
                    if ((allowed >> g) & 1u) {
#pragma unroll
                        for (int j = 0; j < 8; ++j) { const float v = L[g * 8 + j]; if (v > best) { best = v; bi = g * 8 + j; } }
                    }
                }
                esel[k] = bi; ssel[k] = best - biasl[bi]; wsum += ssel[k]; L[bi] = -INFINITY;
            }
#pragma unroll
            for (int k = 0; k < 8; ++k) lrank[k] = __hip_atomic_fetch_add(hist + esel[k], 1, __ATOMIC_RELAXED, __HIP_MEMORY_SCOPE_WORKGROUP);
        }
        __syncthreads();
        if (tid < 64) { const int c = hist[tid]; basel[tid] = c > 0 ? atomicAdd(cntg + tid, c) : 0; }
        __syncthreads();
        if (tid < 128) {
            const int t = brow + tid; const float wn = 2.5f / wsum;
#pragma unroll
            for (int k = 0; k < 8; ++k) {
                const int e = esel[k], pos = basel[e] + lrank[k];
                tokslot[(size_t)t * 8 + k] = (e << 20) | pos;
                W8[(size_t)t * 8 + k] = ssel[k] * wn;
                LIST[(size_t)e * TT + pos] = t * 8 + k;
            }
        }
    };
    gemm_tiles<false>(lds, tm0 + vcu_id(), TT / 128, gridDim.x, make, epi);
}

__device__ __forceinline__ int moe_find_expert(const LAS int* tp, int mtg) {
    int lo = 0, hi = 64;
    while (lo < hi) { const int mid = (lo + hi + 1) >> 1; if (tp[mid] <= mtg) lo = mid; else hi = mid - 1; }
    return lo;
}
__device__ __forceinline__ void ph_moe1(const Params& p, LAS unsigned char* lds, int l, int row_lo) {
    unsigned char* ws = p.ws;
    moe_tables(p, lds, l, row_lo);
    LAS int* cnt = (LAS int*)(lds + MOE_LDS_OFF); LAS int* tp = cnt + 80; LAS int* sp = tp + 80;
    const bf16* U = (const bf16*)(ws + AM_U8); const bf16* WGU = (const bf16*)(ws + OFF_W_GU); unsigned char* HM = ws + AM_HM;
    const int* LIST = (const int*)(ws + OFF_LIST);
    const int tid = threadIdx.x, lane = tid & 63, wid = tid >> 6, wr = wid >> 1, wc = wid & 1, fr = lane & 15, fq = lane >> 4;
    const int ntiles = tp[65] * 4;
    auto make = [&](int t, GPtrs& g, int& nk) {
        const int mtg = t >> 2, nt = t & 3, e = moe_find_expert(tp, mtg), mt = mtg - tp[e], ce = cnt[e];
        int lv[4];
#pragma unroll
        for (int i = 0; i < 4; ++i) { const int li = mt * 128 + (tid >> 3) + 32 * i; lv[i] = LIST[(size_t)(e < 64 ? e : 0) * TT + (li < ce ? li : 0)]; }
#pragma unroll
        for (int i = 0; i < 4; ++i) {
            const int li = mt * 128 + (tid >> 3) + 32 * i;
            const int tk = li < ce ? (e < 64 ? (lv[i] >> 3) : row_lo + li) : row_lo;
            g.a[i] = U + (size_t)tk * (DM / 2) + stg_col();
        }
        plain_ptrs(WGU + (size_t)e * 512 * (DM / 2), nt * 128, DM / 2, g.b); nk = DM / 128;
    };
    auto epi = [&](int t, f32x4 (&acc)[4][4]) {
        const int mtg = t >> 2, nt = t & 3, e = moe_find_expert(tp, mtg), mt = mtg - tp[e], ce = cnt[e];
        const size_t slot0 = e < 64 ? (size_t)(sp[e] + mt * 128) : (size_t)TT * 8 + row_lo + mt * 128;
        const int hc0 = nt * 64 + wc * 32;
        unsigned char* dump = ws + OFF_DUMP + lane * 64;
        constexpr float isc = 1.f / W8SC;
#pragma unroll
        for (int m = 0; m < 4; ++m) {
            const int i = wr * 64 + m * 16 + fr;
            unsigned char* hrow = (mt * 128 + i < ce) ? HM + (slot0 + i) * 256 + hc0 + fq * 4 : dump;
#pragma unroll
            for (int n = 0; n < 2; ++n) {
                const f32x4 g = acc[m][n] * isc, u = acc[m][n + 2] * (isc * H8SC);
                *(unsigned*)(hrow + n * 16) = pk4_fp8(siluf(g[0]) * u[0], siluf(g[1]) * u[1], siluf(g[2]) * u[2], siluf(g[3]) * u[3]);
            }
        }
    };
    gemm_tiles<true, 8, true>(lds, vcu_id(), ntiles, gridDim.x, make, epi);
}
__device__ __forceinline__ void ph_moe2(const Params& p, LAS unsigned char* lds, int l, int row_lo) {
    unsigned char* ws = p.ws;
    moe_tables(p, lds, l, row_lo);
    LAS int* cnt = (LAS int*)(lds + MOE_LDS_OFF); LAS int* tp = cnt + 80; LAS int* sp = tp + 80;
    const bf16* HM = (const bf16*)(ws + AM_HM); const bf16* WD = (const bf16*)(ws + OFF_W_D); bf16* YR = (bf16*)(ws + AM_YR);
    const int tid = threadIdx.x, lane = tid & 63, wid = tid >> 6, wr = wid >> 1, wc = wid & 1, fr = lane & 15, fq = lane >> 4;
    const int ntiles = tp[65] * 8;
    auto make = [&](int t, GPtrs& g, int& nk) {
        const int mtg = t >> 3, nt = t & 7, e = moe_find_expert(tp, mtg), mt = mtg - tp[e];
        const size_t slot0 = e < 64 ? (size_t)(sp[e] + mt * 128) : (size_t)TT * 8 + row_lo + mt * 128;
        plain_ptrs(HM, 0, 128, g.a);
#pragma unroll
        for (int i = 0; i < 4; ++i) g.a[i] += slot0 * 128;
        plain_ptrs(WD + (size_t)e * DM * 128, nt * 128, 128, g.b); nk = 256 / 128;
    };
    auto epi = [&](int t, f32x4 (&acc)[4][4]) {
        const int mtg = t >> 3, nt = t & 7, e = moe_find_expert(tp, mtg), mt = mtg - tp[e], ce = cnt[e];
        const size_t slot0 = e < 64 ? (size_t)(sp[e] + mt * 128) : (size_t)TT * 8 + row_lo + mt * 128;
        LAS unsigned char* wl = lds + 32768 + wid * 8192;
        const int i0 = wr * 64;
        constexpr float osc = 1.f / (W8SC * H8SC);
#pragma unroll
        for (int m = 0; m < 4; ++m)
#pragma unroll
            for (int n = 0; n < 4; ++n) acc[m][n] = acc[m][n] * osc;
        bf16* dump = (bf16*)(ws + OFF_DUMP) + wid * 512;
        epi_store_rows(wl, acc, fr, fq, lane, [&](int row) -> bf16* { return (mt * 128 + i0 + row < ce) ? YR + (slot0 + i0 + row) * DM + nt * 128 + wc * 64 : dump + (row & 7) * 64; });
    };
    gemm_tiles<true, 8, true>(lds, vcu_id(), ntiles, gridDim.x, make, epi);
}

__device__ __forceinline__ void ph_inproj1(const Params& p, LAS unsigned char* lds) {
    unsigned char* ws = p.ws;
    const bf16* U = (const bf16*)(ws + OFF_U); const bf16* W = (const bf16*)(ws + OFF_W_IN_O);
    bf16* Z1 = (bf16*)(ws + A1_Z1); bf16* KM = (bf16*)(ws + A1_KM);
    const f32x2* rope = (const f32x2*)(ws + OFF_ROPE);
    const int tid = threadIdx.x, lane = tid & 63, wid = tid >> 6, wr = wid >> 1, wc = wid & 1, fr = lane & 15, fq = lane >> 4;
    constexpr int NTN = 7, NTM = TT / 128;
    auto make = [&](int t, GPtrs& g, int& nk) { int tm, tn; tile_mn(t, NTM, NTN, tm, tn); plain_ptrs(U, tm * 128, DM, g.a); plain_ptrs(W, tn * 128, DM, g.b); nk = DM / 64; };
    auto epi = [&](int t, f32x4 (&acc)[4][4]) {
        int tm, tn; tile_mn(t, NTM, NTN, tm, tn); const int brow = tm * 128, bcol = tn * 128;
        const int cb = bcol + wc * 64;
        LAS unsigned char* wl = lds + 32768 + wid * 8192;
        const int r0 = brow + wr * 64;
        const RowInfo ri0 = rowinfo(r0);
        if (cb < 768) {
            float* ssq = (float*)(ws + OFF_SSQ);
#pragma unroll
            for (int m = 0; m < 4; ++m) {
                float q = 0.f;
#pragma unroll
                for (int n = 0; n < 4; ++n) q += (acc[m][n][0] * acc[m][n][0] + acc[m][n][1] * acc[m][n][1]) + (acc[m][n][2] * acc[m][n][2] + acc[m][n][3] * acc[m][n][3]);
                q += __shfl_xor(q, 16); q += __shfl_xor(q, 32);
                if (fq == 0) ssq[(size_t)(r0 + m * 16 + fr) * 12 + (cb >> 6)] = q;
            }
            epi_store_rows(wl, acc, fr, fq, lane, [&](int row) { return Z1 + (size_t)(r0 + row) * Z1P + cb; });
        } else if (cb == 768) {
#pragma unroll
            for (int m = 0; m < 4; ++m) {
                const int pos = ri0.pos + m * 16 + fr;
#pragma unroll
                for (int n = 0; n < 2; ++n)
#pragma unroll
                    for (int j = 0; j < 4; ++j) {
                        const float x1 = acc[m][n][j], x2 = acc[m][n + 2][j];
                        if (ri0.lat) { const f32x2 cs = rope[(size_t)pos * 32 + n * 16 + fq * 4 + j]; acc[m][n][j] = x1 * cs.x - x2 * cs.y; acc[m][n + 2][j] = x2 * cs.x + x1 * cs.y; }
                    }
                asm volatile("" ::: "memory");
            }
            bf16* dst = KM + ((size_t)(ri0.b * 8) * NKEY + ri0.kq) * 192 + 128;
            epi_store_rows(wl, acc, fr, fq, lane, [&](int row) { return dst + (size_t)row * 192; }, 8, (size_t)NKEY * 192);
        }
    };
    gemm_tiles<true>(lds, vcu_id(), NTM * NTN, gridDim.x, make, epi);
}

__device__ __forceinline__ void ph_mla_up(const Params& p, LAS unsigned char* lds) {
    unsigned char* ws = p.ws;
    const bf16* Z1 = (const bf16*)(ws + A1_Z1); const bf16* WQ = (const bf16*)(ws + OFF_W_UQ); const bf16* WKV = (const bf16*)(ws + OFF_W_UKV);
    bf16* QM = (bf16*)(ws + A1_QM); bf16* KM = (bf16*)(ws + A1_KM); bf16* VTM = (bf16*)(ws + A1_VTM);
    const f32x2* rope = (const f32x2*)(ws + OFF_ROPE);
    const int tid = threadIdx.x, lane = tid & 63, wid = tid >> 6, wr = wid >> 1, wc = wid & 1, fr = lane & 15, fq = lane >> 4;
    LAS float* rsb = (LAS float*)(lds + 66560);
    constexpr int NQ = (TL / 128) * 12, NKV = (TT / 128) * 16;
    constexpr float QSCALE = 0.07216878364870322f * LOG2E;
    auto decode = [&](int t, bool& isq, int& tm, int& tn) { isq = t < NQ; if (isq) { tile_mn(t, TL / 128, 12, tm, tn); tm += 4; } else tile_mn(t - NQ, TT / 128, 16, tm, tn); };
    auto make = [&](int t, GPtrs& g, int& nk) {
        bool isq; int tm, tn; decode(t, isq, tm, tn);
        const int brow = tm * 128, bcol = tn * 128, K = isq ? 512 : 256, acol = isq ? 0 : 512;
        const int par = ((t - vcu_id()) / (int)gridDim.x) & 1;
        if (tid < 128) {
            const float* q = (const float*)(ws + OFF_SSQ) + (size_t)(brow + tid) * 12;
            float ss;
            if (isq) { const f32x4 a = *(const f32x4*)q, b2 = *(const f32x4*)(q + 4); ss = ((a.x + a.y) + (a.z + a.w)) + ((b2.x + b2.y) + (b2.z + b2.w)); }
            else { const f32x4 a = *(const f32x4*)(q + 8); ss = (a.x + a.y) + (a.z + a.w); }
            rsb[par * 128 + tid] = rsqrtf(ss / (float)K + RMS_EPS);
        }
        plain_ptrs(Z1 + acol, brow, Z1P, g.a); plain_ptrs(isq ? WQ : WKV, bcol, K, g.b); nk = K / 64;
    };
    auto epi = [&](int t, f32x4 (&acc)[4][4]) {
        bool isq; int tm, tn; decode(t, isq, tm, tn);
        const int brow = tm * 128, bcol = tn * 128;
        const int par = ((t - vcu_id()) / (int)gridDim.x) & 1;
        const int cb = bcol + wc * 64;
        LAS unsigned char* wl = lds + 32768 + wid * 8192;
        const int r0 = brow + wr * 64;
        const RowInfo ri0 = rowinfo(r0);
        if (isq) {
            const int h = cb / 192, part = (cb % 192) >> 6;
#pragma unroll
            for (int m = 0; m < 4; ++m) {
                const float sc = rsb[par * 128 + wr * 64 + m * 16 + fr] * QSCALE;
                const int pos = ri0.pos + m * 16 + fr;
                if (part < 2) {
#pragma unroll
                    for (int n = 0; n < 4; ++n) acc[m][n] = acc[m][n] * sc;
                } else {
#pragma unroll
                    for (int n = 0; n < 2; ++n)
#pragma unroll
                        for (int j = 0; j < 4; ++j) {
                            const float x1 = acc[m][n][j] * sc, x2 = acc[m][n + 2][j] * sc;
                            const f32x2 cs = rope[(size_t)pos * 32 + n * 16 + fq * 4 + j];
                            acc[m][n][j] = x1 * cs.x - x2 * cs.y; acc[m][n + 2][j] = x2 * cs.x + x1 * cs.y;
                        }
                }
                asm volatile("" ::: "memory");
            }
            bf16* dst = QM + ((size_t)(ri0.b * 8 + h) * SEQ + ri0.pos) * 192 + part * 64;
            epi_store_rows(wl, acc, fr, fq, lane, [&](int row) { return dst + (size_t)row * 192; });
        } else {
            const int h = cb >> 8, part = (cb & 255) >> 6;
#pragma unroll
            for (int m = 0; m < 4; ++m) {
                const float rs = rsb[par * 128 + wr * 64 + m * 16 + fr];
#pragma unroll
                for (int n = 0; n < 4; ++n) acc[m][n] = acc[m][n] * rs;
            }
            if (part < 2) {
                bf16* dst = KM + ((size_t)(ri0.b * 8 + h) * NKEY + ri0.kq) * 192 + part * 64;
                epi_store_rows(wl, acc, fr, fq, lane, [&](int row) { return dst + (size_t)row * 192; });
            } else {
                bf16* dst = VTM + ((size_t)(ri0.b * 8 + h) * 128 + (part - 2) * 64) * NKEY + ri0.kq;
                epi_store_cols(wl, acc, fr, fq, lane, [&](int col) { return dst + (size_t)col * NKEY; });
            }
        }
    };
    gemm_tiles<true>(lds, vcu_id(), NQ + NKV, gridDim.x, make, epi);
}

__device__ __forceinline__ void ph_mla_attn(const Params& p, LAS unsigned char* lds) {
    unsigned char* ws = p.ws;
    const bf16* QM = (const bf16*)(ws + A1_QM); const bf16* KM = (const bf16*)(ws + A1_KM); const bf16* VTM = (const bf16*)(ws + A1_VTM); bf16* MIX = (bf16*)(ws + A1_MIX);
    for (int item = vcu_id(); item < 2 * 8 * 64; item += gridDim.x) {
        const int qt = item & 63, h = (item >> 6) & 7, b = item >> 9;
        const bf16* Qg = QM + ((size_t)(b * 8 + h) * SEQ + qt * 128) * 192;
        const bf16* Kg = KM + (size_t)(b * 8 + h) * NKEY * 192;
        const bf16* Vg = VTM + (size_t)(b * 8 + h) * 128 * NKEY;
        attn_item<192, 128>(lds, Qg, Kg, Vg, NKEY / 64, 0, 0, 0, -1e30f, 0.f, MIX + (size_t)(TC + b * SEQ + qt * 128) * DM + h * 128, DM);
    }
}


#define XB_TMO      128
#define XB_XCNT(j)  (256  + 64 * (j))
#define XB_XSUB(j)  (1280 + 64 * (j))
#define XB_XGEN(j)  (2304 + 64 * (j))
#define XB_TOP      3328
#define XB_TOPGEN   3392
#define XCD_BAR_WORDS 3456
#define XB_SPIN_CAP (1u << 18)
__device__ __forceinline__ unsigned xb_ld(unsigned* p)              { return __hip_atomic_load(p, __ATOMIC_RELAXED, __HIP_MEMORY_SCOPE_AGENT); }
__device__ __forceinline__ unsigned xb_add(unsigned* p, unsigned v) { return __hip_atomic_fetch_add(p, v, __ATOMIC_RELAXED, __HIP_MEMORY_SCOPE_AGENT); }
__device__ __forceinline__ unsigned xb_xcc_id() { return (unsigned)__builtin_amdgcn_s_getreg((3 << 11) | 20) & 0xFu; }
#define XB_SPIN(cond, bar) do { unsigned _sp = 0; while (cond) { __builtin_amdgcn_s_sleep(1); \
    if ((++_sp & 255u) == 0u) { if (xb_ld(&(bar)[XB_TMO])) break; if (_sp > XB_SPIN_CAP) { atomicAdd(&(bar)[XB_TMO], 1u); break; } } } } while (0)
struct XcdBarrier { unsigned* bar; unsigned x; volatile LAS unsigned* st; };
__device__ __forceinline__ XcdBarrier xcd_barrier_post(unsigned* bar, volatile LAS unsigned* st) {
    XcdBarrier b; b.bar = bar; b.x = xb_xcc_id(); b.st = st;
    if (threadIdx.x == 0) (void)xb_add(&bar[XB_XCNT(b.x)], 1u);
    return b;
}
__device__ __forceinline__ void xcd_barrier_complete(unsigned* bar, unsigned x, unsigned& nloc, unsigned& nx) {
    const unsigned G = gridDim.x * gridDim.y * gridDim.z;
    unsigned sum, cnt, mine, sp = 0u;
    for (;;) {
        sum = 0u; cnt = 0u; mine = 0u;
#pragma unroll
        for (unsigned j = 0; j < 16; ++j) { const unsigned c = xb_ld(&bar[XB_XCNT(j)]); sum += c; cnt += (c > 0u) ? 1u : 0u; mine = (j == x) ? c : mine; }
        if (sum == G) break;
        __builtin_amdgcn_s_sleep(1);
        if ((++sp & 255u) == 0u) { if (xb_ld(&bar[XB_TMO])) break; if (sp > XB_SPIN_CAP) { atomicAdd(&bar[XB_TMO], 1u); break; } }
    }
    nloc = mine > 0u ? mine : 1u; nx = cnt > 0u ? cnt : 1u;
}
__device__ __forceinline__ void xcd_barrier(const XcdBarrier& b) {
    asm volatile("s_waitcnt vmcnt(0)" ::: "memory");
    __syncthreads();
    if (threadIdx.x == 0) {
        unsigned* bar = b.bar;
        __builtin_amdgcn_s_waitcnt(0);
        unsigned nloc = b.st[0], nx = b.st[1];
        if (nloc == 0u) { xcd_barrier_complete(bar, b.x, nloc, nx); b.st[0] = nloc; b.st[1] = nx; }
        const unsigned old = xb_add(&bar[XB_XSUB(b.x)], 1u);
        const unsigned gen = old / nloc;
        if (old + 1u == (gen + 1u) * nloc) {
            __builtin_amdgcn_fence(__ATOMIC_RELEASE, "agent");
            asm volatile("s_waitcnt vmcnt(0)" ::: "memory");
            const unsigned og = xb_add(&bar[XB_TOP], 1u);
            const unsigned tg = og / nx;
            if (og + 1u == (tg + 1u) * nx) xb_add(&bar[XB_TOPGEN], 1u);
            else XB_SPIN(xb_ld(&bar[XB_TOPGEN]) == tg, bar);
            __builtin_amdgcn_fence(__ATOMIC_ACQUIRE, "agent");
            xb_add(&bar[XB_XGEN(b.x)], 1u);
            asm volatile("s_waitcnt vmcnt(0)" ::: "memory");
        } else {
            XB_SPIN(xb_ld(&bar[XB_XGEN(b.x)]) == gen, bar);
            __builtin_amdgcn_fence(__ATOMIC_ACQUIRE, "agent");
            asm volatile("s_waitcnt vmcnt(0)" ::: "memory");
        }
    }
    __syncthreads();
}
static_assert(XCD_BAR_WORDS * 4 <= BAR_BYTES, "barrier words");

__device__ __forceinline__ void convert_shared(const Params& p, LAS unsigned char* lds, int l, int nrt) {
    const int v = vcu_id(), G = gridDim.x, nfree = G - nrt, nslots = 2 * nfree + nrt;
    if (v >= nrt) {
        const int j = v - nrt;
        for (int it = 2 * j; it < EXP_ITEMS; it += nslots) expert_convert_item(p, lds, l, it);
        for (int it = 2 * j + 1; it < EXP_ITEMS; it += nslots) expert_convert_item(p, lds, l, it);
    } else {
        for (int it = 2 * nfree + v; it < EXP_ITEMS; it += nslots) expert_convert_item(p, lds, l, it);
    }
}

constexpr int NPHASE = 19;
__global__ void __launch_bounds__(256, 2) mega(Params p) {
    extern __shared__ __attribute__((aligned(16))) unsigned char lds_[];
    LAS unsigned char* lds = (LAS unsigned char*)lds_;
    cg::grid_group grid = cg::this_grid();
    unsigned char* ws = p.ws;
    volatile LAS unsigned* bst = (volatile LAS unsigned*)(lds + LDS_BYTES - 16);
    if (threadIdx.x < 4) bst[threadIdx.x] = 0u;
    __syncthreads();
    const XcdBarrier xbar = xcd_barrier_post((unsigned*)(ws + OFF_BAR), bst);
#define GRID_BAR(k) do { if ((k) == 0) grid.sync(); else xcd_barrier(xbar); } while (0)
#ifndef PROBE_REP_MASK
#define PROBE_REP_MASK 0u
#endif
#ifndef PROBE_EXTRA_SYNCS
#define PROBE_EXTRA_SYNCS 0
#endif
#define PHASE(k, body) do { if (p.ph_lo <= (k) && (k) < p.ph_hi) { body; if ((PROBE_REP_MASK >> (k)) & 1u) { xcd_barrier(xbar); body; } if ((k) + 1 < p.ph_hi) GRID_BAR(k); } } while (0)
    for (int i = 0; i < PROBE_EXTRA_SYNCS; ++i) xcd_barrier(xbar);
    PHASE(0, ph_prep(p, lds));
    PHASE(1, ph_modulate0(p));
    PHASE(2, ph_inproj0(p, lds));
    PHASE(3, ph_swa_g1(p, lds));
    PHASE(4, ph_gla_scan(p));
    PHASE(5, ph_gla_g3(p, lds));
    PHASE(6, ph_outproj(p, lds, (const bf16*)(ws + A0_MIX), (const bf16*)(ws + OFF_W_OUT_E), (float*)(ws + A0_Y), 0));
    PHASE(7, ph_rowpassA(p, 0, 0, (const float*)(ws + A0_Y)));
    PHASE(8, { ph_router(p, lds, 0, 0); __syncthreads(); convert_shared(p, lds, 0, TT / 128); });
    PHASE(9, ph_moe1(p, lds, 0, 0));
    PHASE(10, ph_moe2(p, lds, 0, 0));
    PHASE(11, ph_rowpassB(p, lds, 0, 0));
    PHASE(12, ph_inproj1(p, lds));
    PHASE(13, ph_mla_up(p, lds));
    PHASE(14, ph_mla_attn(p, lds));
    PHASE(15, ph_outproj(p, lds, (const bf16*)(ws + A1_MIX), (const bf16*)(ws + OFF_W_OUT_O), (float*)(ws + A1_Y), TC));
    PHASE(16, ph_rowpassA(p, 1, TC, (const float*)(ws + A1_Y)));
    PHASE(17, { ph_router(p, lds, 1, TC); __syncthreads(); convert_shared(p, lds, 1, TL / 128); });
    PHASE(18, ph_moe1(p, lds, 1, TC));
    PHASE(19, ph_moe2(p, lds, 1, TC));
    PHASE(20, ph_rowpassB(p, lds, 1, TC));
}

extern "C" void kernel_launch(void* const* d_in, const int* in_sizes, int n_in, void* d_out, int out_size, void* d_ws, size_t ws_size, hipStream_t stream) {
    static int grid_blocks = 0;
    if (!grid_blocks) {
        int dev = 0, cus = 0, per_cu = 0;
        (void)hipGetDevice(&dev);
        (void)hipDeviceGetAttribute(&cus, hipDeviceAttributeMultiprocessorCount, dev);
        (void)hipFuncSetAttribute((const void*)mega, hipFuncAttributeMaxDynamicSharedMemorySize, LDS_BYTES);
        (void)hipOccupancyMaxActiveBlocksPerMultiprocessor(&per_cu, (const void*)mega, 256, LDS_BYTES);
        if (per_cu > 2) per_cu = 2;
        if (per_cu < 1) per_cu = 1;
        grid_blocks = cus * per_cu;
        if (ws_size < WS_NEED) fprintf(stderr, "kernel_launch: workspace too small: %zu < %zu\n", ws_size, (size_t)WS_NEED);
    }
    Params p{};
    const float** f = (const float**)&p;
    for (int i = 0; i < 30; ++i) f[i] = (const float*)d_in[i];
    p.out = (float*)d_out; p.ws = (unsigned char*)d_ws; p.ph_lo = 0; p.ph_hi = 21;
    (void)hipMemsetAsync((unsigned char*)d_ws + OFF_BAR, 0, BAR_BYTES, stream);
    void* args[] = {&p};
    hipError_t e = hipLaunchCooperativeKernel((const void*)mega, dim3(grid_blocks), dim3(256), args, LDS_BYTES, stream);
    if (e != hipSuccess) fprintf(stderr, "cooperative launch failed: %s (grid %d)\n", hipGetErrorString(e), grid_blocks);
}
```

```cpp
#include <hip/hip_runtime.h>
#include <hip/hip_cooperative_groups.h>
#include <cstdio>
#include <cstdint>
namespace cg = cooperative_groups;

#define LAS __attribute__((address_space(3)))
typedef unsigned short bf16;
typedef short bf16x8 __attribute__((ext_vector_type(8)));
typedef float f32x2 __attribute__((ext_vector_type(2)));
typedef float f32x4 __attribute__((ext_vector_type(4)));
typedef float f32x8 __attribute__((ext_vector_type(8)));
typedef float f32x16 __attribute__((ext_vector_type(16)));
typedef unsigned u32x2 __attribute__((ext_vector_type(2)));
typedef unsigned u32x4 __attribute__((ext_vector_type(4)));
typedef __bf16 bf16x2_t __attribute__((ext_vector_type(2)));

constexpr int DM = 1024, NB = 2, SEQ = 8192, CTX = 256;
constexpr int TC = NB * CTX, TL = NB * SEQ, TT = TC + TL, NKEY = CTX + SEQ;
constexpr int NEXP = 64;
constexpr float RMS_EPS = 1e-6f;
constexpr int E_IN_PAD = 2432, O_IN_PAD = 896;
constexpr float LOG2E = 1.4426950408889634f;
constexpr int NSTEP = 132;
constexpr int Z0P = 1056;
constexpr int Z1P = 768;
constexpr int LDS_BYTES = 73728;

constexpr size_t al(size_t x) { return (x + 255) & ~(size_t)255; }
constexpr size_t OFF_W_IN_E = 0;
constexpr size_t OFF_W_OUT_E = OFF_W_IN_E + al((size_t)E_IN_PAD * DM * 2);
constexpr size_t OFF_W_IN_O = OFF_W_OUT_E + al((size_t)DM * DM * 2);
constexpr size_t OFF_W_UQ = OFF_W_IN_O + al((size_t)O_IN_PAD * DM * 2);
constexpr size_t OFF_W_UKV = OFF_W_UQ + al((size_t)1536 * 512 * 2);
constexpr size_t OFF_W_OUT_O = OFF_W_UKV + al((size_t)2048 * 256 * 2);
constexpr size_t OFF_W_RT = OFF_W_OUT_O + al((size_t)DM * DM * 2);
constexpr size_t OFF_W_GU = OFF_W_RT + al((size_t)2 * 128 * DM * 2);
constexpr size_t OFF_W_D = OFF_W_GU + al((size_t)65 * 512 * DM * 2);
constexpr size_t OFF_U = OFF_W_D + al((size_t)65 * DM * 256 * 2);
constexpr size_t OFF_HC = OFF_U + al((size_t)TT * DM * 2);
constexpr size_t OFF_MOD = OFF_HC + al((size_t)TC * DM * 4);
constexpr size_t OFF_ROPE = OFF_MOD + al((size_t)2 * 3 * 6144 * 4);
constexpr size_t OFF_CNT = OFF_ROPE + al((size_t)SEQ * 32 * 8);
constexpr size_t OFF_TOKSLOT = OFF_CNT + al(2 * 64 * 4);
constexpr size_t OFF_W8 = OFF_TOKSLOT + al((size_t)TT * 8 * 4);
constexpr size_t OFF_LIST = OFF_W8 + al((size_t)TT * 8 * 4);
constexpr size_t OFF_SSQ = OFF_LIST + al((size_t)64 * TT * 4);
constexpr size_t OFF_DUMP = OFF_SSQ + al((size_t)TT * 12 * 4);
constexpr size_t OFF_BAR = OFF_DUMP + 8192;
constexpr size_t BAR_BYTES = 16384;
constexpr size_t OFF_ARENA = OFF_BAR + BAR_BYTES;
constexpr size_t A0_Z0 = OFF_ARENA;
constexpr size_t A0_VGT = A0_Z0 + al((size_t)TT * Z0P * 2);
constexpr size_t A0_QS = A0_VGT + al((size_t)4 * 128 * TT * 2);
constexpr size_t A0_KS = A0_QS + al((size_t)2 * 8 * NKEY * 64 * 2);
constexpr size_t A0_VST = A0_KS + al((size_t)2 * 2 * NKEY * 64 * 2);
constexpr size_t A0_GS = A0_VST + al((size_t)2 * 2 * 64 * NKEY * 2);
constexpr size_t A0_GD = A0_GS + al((size_t)16 * NSTEP * 8192 * 4);
constexpr size_t A0_MIX = A0_GD + al((size_t)16 * NSTEP * 64 * 4);
constexpr size_t A0_Y = A0_MIX + al((size_t)TT * DM * 2);
constexpr size_t A0_END = A0_Y + al((size_t)TT * DM * 4);
constexpr size_t A1_Z1 = OFF_ARENA;
constexpr size_t A1_QM = A1_Z1 + al((size_t)TT * Z1P * 2);
constexpr size_t A1_KM = A1_QM + al((size_t)2 * 8 * SEQ * 192 * 2);
constexpr size_t A1_VTM = A1_KM + al((size_t)2 * 8 * NKEY * 192 * 2);
constexpr size_t A1_MIX = A1_VTM + al((size_t)2 * 8 * 128 * NKEY * 2);
constexpr size_t A1_Y = A1_MIX + al((size_t)TT * DM * 2);
constexpr size_t A1_END = A1_Y + al((size_t)TT * DM * 4);
constexpr size_t AM_U8 = OFF_ARENA;
constexpr size_t AM_HM = AM_U8 + al((size_t)TT * 1024);
constexpr size_t AM_YR = AM_HM + al((size_t)TT * 9 * 256);
constexpr size_t AM_END = AM_YR + al((size_t)TT * 9 * 1024 * 2);
constexpr size_t WS_NEED = AM_END > A0_END ? (AM_END > A1_END ? AM_END : A1_END) : (A0_END > A1_END ? A0_END : A1_END);
static_assert(WS_NEED <= 555747360ull, "workspace map exceeds the guaranteed d_ws size");

struct Params {
    const float *x, *c, *ctx, *c_ctx, *w_mod, *b_mod, *g_mix_pre, *g_mix_post, *g_ffn_pre, *g_ffn_post;
    const float *w_in_e, *gla_wa2, *gla_ba, *gla_norm, *swa_sink, *w_out_e;
    const float *w_in_o, *mla_q_norm, *mla_kv_norm, *w_uq, *w_ukv, *w_out_o;
    const float *w_router, *b_router, *w_exp_gate, *w_exp_up, *w_exp_down, *w_sh_gate, *w_sh_up, *w_sh_down;
    float* out; unsigned char* ws; int ph_lo, ph_hi;
};

__device__ __forceinline__ unsigned pk2(float lo, float hi) { f32x2 v = {lo, hi}; bf16x2_t b = __builtin_convertvector(v, bf16x2_t); return __builtin_bit_cast(unsigned, b); }
__device__ __forceinline__ float bflo(unsigned u) { return __uint_as_float(u << 16); }
__device__ __forceinline__ float bfhi(unsigned u) { return __uint_as_float(u & 0xffff0000u); }
__device__ __forceinline__ float bf2f(bf16 v) { return __uint_as_float((unsigned)v << 16); }
__device__ __forceinline__ bf16 f2bf(float f) { return (bf16)(pk2(f, 0.f) & 0xffffu); }
constexpr float W8SC = 64.f, H8SC = 4.f, Y8SC = 16.f;
__device__ __forceinline__ unsigned pk4_fp8(float a, float b, float c, float d) { int w = 0; w = __builtin_amdgcn_cvt_pk_fp8_f32(a, b, w, false); w = __builtin_amdgcn_cvt_pk_fp8_f32(c, d, w, true); return (unsigned)w; }
__device__ __forceinline__ float wave_sum(float v) {
#pragma unroll
    for (int o = 1; o < 64; o <<= 1) v += __shfl_xor(v, o);
    return v;
}
__device__ __forceinline__ void glds16(const void* g, LAS void* l) { __builtin_amdgcn_global_load_lds((const unsigned*)g, (LAS unsigned*)l, 16, 0, 0); }
__device__ __forceinline__ float siluf(float x) { return x / (1.f + __expf(-x)); }
__device__ __forceinline__ float ex2(float x) { return __builtin_amdgcn_exp2f(x); }
__device__ __forceinline__ int crow(int r, int hi) { return (r & 3) + 8 * (r >> 2) + 4 * hi; }
__device__ __forceinline__ bf16x8 mk8(u32x4 v) { return __builtin_bit_cast(bf16x8, v); }

struct RowInfo { int b, kq, pos; bool lat; };
__device__ __forceinline__ RowInfo rowinfo(int r) {
    RowInfo i;
    if (r < TC) { i.b = r >> 8; i.pos = r & 255; i.kq = i.pos; i.lat = false; }
    else { const int rl = r - TC; i.b = rl >> 13; i.pos = rl & (SEQ - 1); i.kq = CTX + i.pos; i.lat = true; }
    return i;
}
__device__ __forceinline__ int modvec(int r) { return r < TC ? 2 : ((r - TC) >> 13); }

struct GPtrs { const bf16* a[4]; const bf16* b[4]; };
constexpr int G_STAGE = 32768;
#define G_FENCE() asm volatile("" ::: "memory")
__device__ __forceinline__ void gemm_issue(LAS unsigned char* lds, const GPtrs& g, int kt) {
    LAS unsigned char* d = lds + (kt & 1) * G_STAGE + threadIdx.x * 16; const int ko = kt * 64;
#pragma unroll
    for (int i = 0; i < 4; ++i) { glds16(g.a[i] + ko, d + i * 4096); glds16(g.b[i] + ko, d + 16384 + i * 4096); }
}
__device__ __forceinline__ void gemm_prologue(LAS unsigned char* lds, const GPtrs& g, int nk) { gemm_issue(lds, g, 0); }
__device__ __forceinline__ void gemm_prologue2(LAS unsigned char* lds, const GPtrs& g) { gemm_issue(lds, g, 0); gemm_issue(lds, g, 1); }
template <int NST, bool FP8 = false, bool PRE2 = false>
__device__ __forceinline__ void gemm_main(LAS unsigned char* lds, const GPtrs& g, int nk, f32x4 (&acc)[4][4], bool after_epi) {
    const int tid = threadIdx.x, lane = tid & 63, wid = tid >> 6, wr = wid >> 1, wc = wid & 1, fr = lane & 15, fq = lane >> 4;
#pragma unroll
    for (int m = 0; m < 4; ++m)
#pragma unroll
        for (int n = 0; n < 4; ++n) acc[m][n] = (f32x4){0.f, 0.f, 0.f, 0.f};
    const int c0 = ((fq) ^ (fr & 7)) * 16, c1 = ((4 + fq) ^ (fr & 7)) * 16;
    const int aoff = (wr * 64 + fr) * 128, boff = 16384 + (wc * 64 + fr) * 128;
    for (int kt = 0; kt < nk; ++kt) {
        if (PRE2) {
            static_assert(!PRE2 || NST == 4 || NST < 0, "PRE2 counted waits are written for 4 epilogue stores");
            if (kt == 0) { if (after_epi) asm volatile("s_waitcnt vmcnt(12) lgkmcnt(0)" ::: "memory"); else asm volatile("s_waitcnt vmcnt(8) lgkmcnt(0)" ::: "memory"); }
            else { if (after_epi) asm volatile("s_waitcnt vmcnt(4) lgkmcnt(0)" ::: "memory"); else asm volatile("s_waitcnt vmcnt(0) lgkmcnt(0)" ::: "memory"); }
        } else
        if (NST == 8 && kt == 0 && after_epi) asm volatile("s_waitcnt vmcnt(8) lgkmcnt(0)" ::: "memory");
        else if (NST == 16 && kt == 0 && after_epi) asm volatile("s_waitcnt vmcnt(16) lgkmcnt(0)" ::: "memory");
        else asm volatile("s_waitcnt vmcnt(0) lgkmcnt(0)" ::: "memory");
        __builtin_amdgcn_s_barrier();
        G_FENCE();
        if (!PRE2 && kt + 1 < nk) gemm_issue(lds, g, kt + 1);
        LAS unsigned char* base = lds + (kt & 1) * G_STAGE;
        if constexpr (FP8) {
            long a8[4][4], b8[4][4];
#pragma unroll
            for (int ks = 0; ks < 4; ++ks) {
                const int co = (((ks * 2 + (fq >> 1)) ^ (fr & 7)) * 16) + (fq & 1) * 8;
#pragma unroll
                for (int m = 0; m < 4; ++m) a8[ks][m] = *(const LAS long*)(base + aoff + m * 2048 + co);
#pragma unroll
                for (int n = 0; n < 4; ++n) b8[ks][n] = *(const LAS long*)(base + boff + n * 2048 + co);
            }
            __builtin_amdgcn_s_setprio(1);
#pragma unroll
            for (int ks = 0; ks < 4; ++ks)
#pragma unroll
                for (int m = 0; m < 4; ++m)
#pragma unroll
                    for (int n = 0; n < 4; ++n) acc[m][n] = __builtin_amdgcn_mfma_f32_16x16x32_fp8_fp8(b8[ks][n], a8[ks][m], acc[m][n], 0, 0, 0);
            __builtin_amdgcn_s_setprio(0);
            continue;
        }
        bf16x8 af0[4], bf0[4], af1[4], bf1[4];
#pragma unroll
        for (int m = 0; m < 4; ++m) af0[m] = *(const LAS bf16x8*)(base + aoff + m * 2048 + c0);
#pragma unroll
        for (int n = 0; n < 4; ++n) bf0[n] = *(const LAS bf16x8*)(base + boff + n * 2048 + c0);
#pragma unroll
        for (int m = 0; m < 4; ++m) af1[m] = *(const LAS bf16x8*)(base + aoff + m * 2048 + c1);
#pragma unroll
        for (int n = 0; n < 4; ++n) bf1[n] = *(const LAS bf16x8*)(base + boff + n * 2048 + c1);
        __builtin_amdgcn_s_setprio(1);
#pragma unroll
        for (int m = 0; m < 4; ++m)
#pragma unroll
            for (int n = 0; n < 4; ++n) acc[m][n] = __builtin_amdgcn_mfma_f32_16x16x32_bf16(bf0[n], af0[m], acc[m][n], 0, 0, 0);
#pragma unroll
        for (int m = 0; m < 4; ++m)
#pragma unroll
            for (int n = 0; n < 4; ++n) acc[m][n] = __builtin_amdgcn_mfma_f32_16x16x32_bf16(bf1[n], af1[m], acc[m][n], 0, 0, 0);
        __builtin_amdgcn_s_setprio(0);
    }
    asm volatile("s_waitcnt lgkmcnt(0)" ::: "memory");
    __builtin_amdgcn_s_barrier();
    G_FENCE();
}
__device__ __forceinline__ int vcu_id() { const int b = blockIdx.x, G = gridDim.x; return (G % 8 == 0) ? (b % 8) * (G / 8) + b / 8 : b; }
__device__ __forceinline__ void tile_mn(int w, int ntm, int ntn, int& tm, int& tn) {
    const int nig = 8 * ntn, gid = w / nig, fm = gid * 8, gsz = (ntm - fm) < 8 ? (ntm - fm) : 8, within = w - gid * nig;
    tm = fm + within % gsz; tn = within / gsz;
}
template <bool PREFETCH_NEXT, int NST = -1, bool FP8 = false, bool PRE2 = false, class Make, class Epi>
__device__ __forceinline__ void gemm_tiles(LAS unsigned char* lds, int t0, int nt, int stride, Make make, Epi epi) {
    if (t0 >= nt) return;
    GPtrs g; int nk;
    make(t0, g, nk);
    G_FENCE();
    if (PRE2) gemm_prologue2(lds, g); else gemm_prologue(lds, g, nk);
    bool first = true;
    for (int t = t0; t < nt;) {
        const int tn = t + stride;
        f32x4 acc[4][4];
        gemm_main<PREFETCH_NEXT ? NST : -1, FP8, PRE2>(lds, g, nk, acc, !first);
        first = false;
        if (PREFETCH_NEXT) { if (tn < nt) { make(tn, g, nk); G_FENCE(); if (PRE2) gemm_prologue2(lds, g); else gemm_prologue(lds, g, nk); } epi(t, acc); }
        else { epi(t, acc); __syncthreads(); if (tn < nt) { make(tn, g, nk); G_FENCE(); gemm_prologue(lds, g, nk); } }
        t = tn;
    }
}

template <class RowPtr>
__device__ __forceinline__ void epi_store_rows(LAS unsigned char* wl, const f32x4 (&v)[4][4], int fr, int fq, int lane, RowPtr rowptr, int nrep = 1, size_t rep_stride = 0) {
#pragma unroll
    for (int m = 0; m < 4; ++m)
#pragma unroll
        for (int n = 0; n < 4; ++n)
            *(LAS u32x2*)(wl + (m * 16 + fr) * 128 + (((n * 2 + (fq >> 1)) ^ (fr & 7)) * 16) + (fq & 1) * 8) = (u32x2){pk2(v[m][n][0], v[m][n][1]), pk2(v[m][n][2], v[m][n][3])};
#pragma unroll
    for (int i = 0; i < 8; ++i) {
        const int row = (lane >> 3) + 8 * i, pos = lane & 7;
        const u32x4 w = *(const LAS u32x4*)(wl + row * 128 + pos * 16);
        bf16* d = rowptr(row);
        if (d) { d += (pos ^ (row & 7)) * 8; for (int r = 0; r < nrep; ++r) *(u32x4*)(d + (size_t)r * rep_stride) = w; }
    }
}
template <class ColPtr>
__device__ __forceinline__ void epi_store_cols(LAS unsigned char* wl, const f32x4 (&v)[4][4], int fr, int fq, int lane, ColPtr colptr) {
    LAS unsigned char* wb = wl + fq * 512 + fr * 2;
#pragma unroll
    for (int m = 0; m < 4; ++m)
#pragma unroll
        for (int n = 0; n < 4; ++n)
#pragma unroll
            for (int j = 0; j < 4; ++j) *(LAS bf16*)(wb + n * 2048 + j * 128 + m * 32) = f2bf(v[m][n][j]);
#pragma unroll
    for (int i = 0; i < 8; ++i) {
        const int col = (lane >> 3) + 8 * i, pos = lane & 7;
        const u32x4 w = *(const LAS u32x4*)(wl + col * 128 + pos * 16);
        bf16* d = colptr(col);
        *(u32x4*)(d + pos * 8) = w;
    }
}

__device__ __forceinline__ int ein_map(int n) {
    if (n < 512) return n;
    if (n < 1024) return n + 512;
    if (n < 1536) return n - 512;
    if (n < 2048) return 1568 + (n - 1536);
    if (n < 2176) return 2080 + (n - 2048);
    if (n < 2304) return 2208 + (n - 2176);
    if (n < 2320) return 1536 + (n - 2304);
    if (n < 2336) return 1552 + (n - 2320);
    return -1;
}
template <bool FP8 = false>
__device__ __forceinline__ void transpose_item(LAS unsigned char* lds, int K, bf16* dst, int k0, int n0, int ld, int mode, const float* srcA, const float* srcB, int nvalid, const float* kscale) {
    LAS float* tile = (LAS float*)lds;
    const int tid = threadIdx.x;
    {
        const int nq = tid & 31, kr = tid >> 5, n = n0 + nq * 4;
        const float* cp = nullptr; float sc = 1.f;
        if (mode == 0) { if (n < nvalid) cp = srcA + n; }
        else if (mode == 1) { const int c = ein_map(n); if (c >= 0) cp = srcA + c; if (n < 256) sc = 0.125f; }
        else if (mode == 2) { const int grp = n >> 6, w = n & 63; cp = (w < 32 ? srcA : srcB) + grp * 32 + (w & 31); }
        else { const int b6 = n & 63; cp = srcA + (n & ~63) + ((b6 >> 2) & 3) * 16 + (b6 >> 4) * 4; }
        f32x4 v[8];
#pragma unroll
        for (int i = 0; i < 8; ++i) { const int k = kr + 8 * i; v[i] = cp ? *(const f32x4*)(cp + (size_t)(k0 + k) * ld) : (f32x4){0.f, 0.f, 0.f, 0.f}; }
#pragma unroll
        for (int i = 0; i < 8; ++i) { const int k = kr + 8 * i; float m = sc; if (kscale) m *= kscale[k0 + k]; *(LAS f32x4*)(tile + k * 132 + nq * 4) = v[i] * m; }
    }
    __syncthreads();
    {
        const int n = tid >> 1, hf = tid & 1;
        if constexpr (FP8) {
            unsigned char* d8 = (unsigned char*)dst;
#pragma unroll
            for (int c = 0; c < 2; ++c) {
                const int k16 = hf * 32 + c * 16;
                u32x4 o;
                o.x = pk4_fp8(tile[(k16 + 0) * 132 + n] * W8SC, tile[(k16 + 1) * 132 + n] * W8SC, tile[(k16 + 2) * 132 + n] * W8SC, tile[(k16 + 3) * 132 + n] * W8SC);
                o.y = pk4_fp8(tile[(k16 + 4) * 132 + n] * W8SC, tile[(k16 + 5) * 132 + n] * W8SC, tile[(k16 + 6) * 132 + n] * W8SC, tile[(k16 + 7) * 132 + n] * W8SC);
                o.z = pk4_fp8(tile[(k16 + 8) * 132 + n] * W8SC, tile[(k16 + 9) * 132 + n] * W8SC, tile[(k16 + 10) * 132 + n] * W8SC, tile[(k16 + 11) * 132 + n] * W8SC);
                o.w = pk4_fp8(tile[(k16 + 12) * 132 + n] * W8SC, tile[(k16 + 13) * 132 + n] * W8SC, tile[(k16 + 14) * 132 + n] * W8SC, tile[(k16 + 15) * 132 + n] * W8SC);
                *(u32x4*)(d8 + (size_t)(n0 + n) * K + k0 + k16) = o;
            }
        } else
#pragma unroll
        for (int c = 0; c < 4; ++c) {
            const int k8 = hf * 32 + c * 8;
            u32x4 o;
            o.x = pk2(tile[(k8 + 0) * 132 + n], tile[(k8 + 1) * 132 + n]);
            o.y = pk2(tile[(k8 + 2) * 132 + n], tile[(k8 + 3) * 132 + n]);
            o.z = pk2(tile[(k8 + 4) * 132 + n], tile[(k8 + 5) * 132 + n]);
            o.w = pk2(tile[(k8 + 6) * 132 + n], tile[(k8 + 7) * 132 + n]);
            *(u32x4*)(dst + (size_t)(n0 + n) * K + k0 + k8) = o;
        }
    }
    __syncthreads();
}

constexpr int EXP_GU_ITEMS = 65 * 16 * 4, EXP_D_ITEMS = 65 * 4 * 8, EXP_ITEMS = EXP_GU_ITEMS + EXP_D_ITEMS;
__device__ __forceinline__ void expert_convert_item(const Params& p, LAS unsigned char* lds, int l, int it) {
    unsigned char* ws = p.ws;
    if (it < EXP_GU_ITEMS) {
        const int e = it / 64, r = it % 64, kb = r / 4, nb = r % 4;
        const float* gate = e < 64 ? p.w_exp_gate + ((size_t)(l * 64 + e)) * DM * 256 : p.w_sh_gate + (size_t)l * DM * 256;
        const float* up = e < 64 ? p.w_exp_up + ((size_t)(l * 64 + e)) * DM * 256 : p.w_sh_up + (size_t)l * DM * 256;
        transpose_item<true>(lds, DM, (bf16*)(ws + OFF_W_GU + (size_t)e * 512 * DM), kb * 64, nb * 128, 256, 2, gate, up, 512, nullptr);
    } else {
        it -= EXP_GU_ITEMS;
        const int e = it / 32, r = it % 32, kb = r / 8, nb = r % 8;
        const float* dn = e < 64 ? p.w_exp_down + ((size_t)(l * 64 + e)) * 256 * DM : p.w_sh_down + (size_t)l * 256 * DM;
        transpose_item<true>(lds, 256, (bf16*)(ws + OFF_W_D + (size_t)e * DM * 256), kb * 64, nb * 128, DM, 3, dn, nullptr, DM, nullptr);
    }
}

__device__ __forceinline__ void ph_prep(const Params& p, LAS unsigned char* lds) {
    unsigned char* ws = p.ws;
    const int tid = threadIdx.x;
    if (blockIdx.x == 0 && tid < 128) ((int*)(ws + OFF_CNT))[tid] = 0;
    constexpr int I_MOD = 96, I_ROPE = 1024, I_INE = 16 * 19, I_OUTE = 128, I_INO = 16 * 7, I_UQ = 8 * 12, I_UKV = 4 * 16, I_OUTO = 128, I_RT = 32;
    constexpr int NITEMS = I_MOD + I_ROPE + I_INE + I_OUTE + I_INO + I_UQ + I_UKV + I_OUTO + I_RT;
    for (int item = blockIdx.x; item < NITEMS; item += gridDim.x) {
        int it = item;
        if (it < I_MOD) {
            const int l = it / 48, n0 = (it % 48) * 128, kg = tid >> 5, cl = tid & 31;
            LAS float* s = (LAS float*)lds;
            LAS float* red = (LAS float*)(lds + 12288);
            for (int idx = tid; idx < 3072; idx += 256) { const int v = idx >> 10, k = idx & 1023; const float cv = v < 2 ? p.c[v * DM + k] : p.c_ctx[k]; s[idx] = cv / (1.f + expf(-cv)); }
            __syncthreads();
            f32x4 a0 = {0.f, 0.f, 0.f, 0.f}, a1 = a0, a2 = a0;
            const float* w = p.w_mod + (size_t)l * DM * 6144 + (size_t)(kg * 128) * 6144 + n0 + cl * 4;
#pragma unroll 8
            for (int k = 0; k < 128; ++k) { const f32x4 wv = *(const f32x4*)(w + (size_t)k * 6144); const int kk = kg * 128 + k; a0 += wv * s[kk]; a1 += wv * s[1024 + kk]; a2 += wv * s[2048 + kk]; }
            *(LAS f32x4*)(red + (kg * 3 + 0) * 128 + cl * 4) = a0; *(LAS f32x4*)(red + (kg * 3 + 1) * 128 + cl * 4) = a1; *(LAS f32x4*)(red + (kg * 3 + 2) * 128 + cl * 4) = a2;
            __syncthreads();
            for (int idx = tid; idx < 384; idx += 256) { const int v = idx >> 7, n = idx & 127; float acc = 0.f;
#pragma unroll
                for (int g = 0; g < 8; ++g) acc += red[(g * 3 + v) * 128 + n];
                ((float*)(ws + OFF_MOD))[((size_t)l * 3 + v) * 6144 + n0 + n] = acc + p.b_mod[l * 6144 + n0 + n]; }
            __syncthreads();
            continue;
        }
        it -= I_MOD;
        if (it < I_ROPE) {
            const int idx = it * 256 + tid, pos = idx >> 5, i = idx & 31, row = pos >> 6, col = pos & 63, j = i & 15;
            const float invf = powf(10000.f, -(float)(2 * j) / 32.f);
            const float ang = (float)(i < 16 ? row : col) * invf;
            float sn, cs; sincosf(ang, &sn, &cs);
            ((f32x2*)(ws + OFF_ROPE))[idx] = (f32x2){cs, sn};
            continue;
        }
        it -= I_ROPE;
        if (it < I_INE) { const int kb = it / 19, nb = it % 19;
            transpose_item(lds, DM, (bf16*)(ws + OFF_W_IN_E), kb * 64, nb * 128, 2336, 1, p.w_in_e, nullptr, 2336, nullptr); continue; }
        it -= I_INE;
        if (it < I_OUTE) { const int kb = it / 8, nb = it % 8;
            transpose_item(lds, DM, (bf16*)(ws + OFF_W_OUT_E), kb * 64, nb * 128, DM, 0, p.w_out_e, nullptr, DM, nullptr); continue; }
        it -= I_OUTE;
        if (it < I_INO) { const int kb = it / 7, nb = it % 7;
            transpose_item(lds, DM, (bf16*)(ws + OFF_W_IN_O), kb * 64, nb * 128, 832, 0, p.w_in_o, nullptr, 832, nullptr); continue; }
        it -= I_INO;
        if (it < I_UQ) { const int kb = it / 12, nb = it % 12;
            transpose_item(lds, 512, (bf16*)(ws + OFF_W_UQ), kb * 64, nb * 128, 1536, 0, p.w_uq, nullptr, 1536, p.mla_q_norm); continue; }
        it -= I_UQ;
        if (it < I_UKV) { const int kb = it / 16, nb = it % 16;
            transpose_item(lds, 256, (bf16*)(ws + OFF_W_UKV), kb * 64, nb * 128, 2048, 0, p.w_ukv, nullptr, 2048, p.mla_kv_norm); continue; }
        it -= I_UKV;
        if (it < I_OUTO) { const int kb = it / 8, nb = it % 8;
            transpose_item(lds, DM, (bf16*)(ws + OFF_W_OUT_O), kb * 64, nb * 128, DM, 0, p.w_out_o, nullptr, DM, nullptr); continue; }
        it -= I_OUTO;
        { const int l = it / 16, kb = it % 16;
            transpose_item(lds, DM, (bf16*)(ws + OFF_W_RT) + (size_t)l * 128 * DM, kb * 64, 0, 64, 0, p.w_router + (size_t)l * DM * 64, nullptr, 64, nullptr); }
    }
}

__device__ __forceinline__ void load_row(const float* src, int lane, f32x4 (&v)[4]) {
#pragma unroll
    for (int j = 0; j < 4; ++j) v[j] = *(const f32x4*)(src + lane * 4 + 256 * j);
}
__device__ __forceinline__ float row_sumsq(const f32x4 (&v)[4]) {
    float s = 0.f;
#pragma unroll
    for (int j = 0; j < 4; ++j) s += v[j].x * v[j].x + v[j].y * v[j].y + v[j].z * v[j].z + v[j].w * v[j].w;
    return wave_sum(s);
}
__device__ __forceinline__ void modulate_store(const f32x4 (&v)[4], float rinv, const float* g, const float* sh, const float* sc, bf16* dst, int lane) {
#pragma unroll
    for (int j = 0; j < 4; ++j) {
        const int c = lane * 4 + 256 * j;
        const f32x4 gg = *(const f32x4*)(g + c), s1 = *(const f32x4*)(sc + c), s0 = *(const f32x4*)(sh + c);
        const f32x4 o = v[j] * rinv * gg * (s1 + 1.f) + s0;
        u32x2 w; w.x = pk2(o.x, o.y); w.y = pk2(o.z, o.w);
        *(u32x2*)(dst + c) = w;
    }
}
__device__ __forceinline__ const float* hl_src0(const Params& p, int r) { return r < TC ? p.ctx + (size_t)r * DM : p.x + (size_t)(r - TC) * DM; }
__device__ __forceinline__ float* hl_buf(const Params& p, int r) { return r < TC ? (float*)(p.ws + OFF_HC) + (size_t)r * DM : p.out + (size_t)(r - TC) * DM; }

__device__ __forceinline__ void ph_modulate0(const Params& p) {
    const int lane = threadIdx.x & 63, gw = blockIdx.x * 4 + (threadIdx.x >> 6), ngw = gridDim.x * 4;
    const float* mod = (const float*)(p.ws + OFF_MOD);
    bf16* U = (bf16*)(p.ws + OFF_U);
    for (int r = gw; r < TT; r += ngw) {
        f32x4 v[4]; load_row(hl_src0(p, r), lane, v);
        const float rinv = rsqrtf(row_sumsq(v) * (1.f / DM) + RMS_EPS);
        const float* mv = mod + (size_t)modvec(r) * 6144;
        modulate_store(v, rinv, p.g_mix_pre, mv, mv + 1024, U + (size_t)r * DM, lane);
    }
}

__device__ __forceinline__ void ph_rowpassA(const Params& p, int l, int row_lo, const float* Y) {
    const int lane = threadIdx.x & 63, gw = blockIdx.x * 4 + (threadIdx.x >> 6), ngw = gridDim.x * 4;
    const float* mod = (const float*)(p.ws + OFF_MOD) + (size_t)l * 3 * 6144;
    bf16* U = (bf16*)(p.ws + OFF_U);
    for (int r = row_lo + gw; r < TT; r += ngw) {
        f32x4 y[4], h[4];
        load_row(Y + (size_t)r * DM, lane, y);
        load_row(l == 0 ? hl_src0(p, r) : (const float*)hl_buf(p, r), lane, h);
        const float rinv = rsqrtf(row_sumsq(y) * (1.f / DM) + RMS_EPS);
        const float* mv = mod + (size_t)modvec(r) * 6144;
        float* hb = hl_buf(p, r);
#pragma unroll
        for (int j = 0; j < 4; ++j) {
            const int c = lane * 4 + 256 * j;
            const f32x4 gg = *(const f32x4*)(p.g_mix_post + l * DM + c), gt = *(const f32x4*)(mv + 2048 + c);
            h[j] = h[j] + gt * (y[j] * rinv * gg);
            *(f32x4*)(hb + c) = h[j];
        }
        const float rinv2 = rsqrtf(row_sumsq(h) * (1.f / DM) + RMS_EPS);
        modulate_store(h, rinv2, p.g_ffn_pre + l * DM, mv + 3072, mv + 4096, U + (size_t)r * DM, lane);
        {
            unsigned char* u8 = p.ws + AM_U8 + (size_t)r * DM;
#pragma unroll
            for (int j = 0; j < 4; ++j) {
                const int c = lane * 4 + 256 * j;
                const f32x4 gg = *(const f32x4*)(p.g_ffn_pre + l * DM + c), s1 = *(const f32x4*)(mv + 4096 + c), s0 = *(const f32x4*)(mv + 3072 + c);
                const f32x4 o = h[j] * rinv2 * gg * (s1 + 1.f) + s0;
                *(unsigned*)(u8 + c) = pk4_fp8(o.x, o.y, o.z, o.w);
            }
        }
    }
}

constexpr int MOE_LDS_OFF = 65536;
__device__ __forceinline__ void moe_tables(const Params& p, LAS unsigned char* lds, int l, int row_lo) {
    LAS int* cnt = (LAS int*)(lds + MOE_LDS_OFF); LAS int* tp = cnt + 80; LAS int* sp = tp + 80;
    const int tid = threadIdx.x;
    if (tid < 64) cnt[tid] = ((const int*)(p.ws + OFF_CNT))[l * 64 + tid];
    if (tid == 64) cnt[64] = TT - row_lo;
    __syncthreads();
    if (tid == 0) {
        int a = 0, s = 0;
        for (int e = 0; e < 65; ++e) { tp[e] = a; sp[e] = s; a += (cnt[e] + 127) >> 7; s += cnt[e]; }
        tp[65] = a;
    }
    __syncthreads();
}

__device__ __forceinline__ void ph_rowpassB(const Params& p, LAS unsigned char* lds, int l, int row_lo) {
    moe_tables(p, lds, l, row_lo);
    LAS int* sp = (LAS int*)(lds + MOE_LDS_OFF) + 160;
    const int lane = threadIdx.x & 63, gw = blockIdx.x * 4 + (threadIdx.x >> 6), ngw = gridDim.x * 4;
    const float* mod = (const float*)(p.ws + OFF_MOD) + (size_t)l * 3 * 6144;
    const unsigned char* YR = p.ws + AM_YR;
    const int* tokslot = (const int*)(p.ws + OFF_TOKSLOT); const float* W8 = (const float*)(p.ws + OFF_W8);
    bf16* U = (bf16*)(p.ws + OFF_U);
    const int c0 = lane * 16;
    for (int r = row_lo + gw; r < TT; r += ngw) {
        int ts = 0; float wv = 0.f;
        if (lane < 8) { ts = tokslot[(size_t)r * 8 + lane]; wv = W8[(size_t)r * 8 + lane]; }
        const int myslot = sp[ts >> 20] + (ts & 0xfffff);
        float f[16];
#pragma unroll
        for (int i = 0; i < 16; ++i) f[i] = 0.f;
#pragma unroll
        for (int k = 0; k < 9; ++k) {
            size_t slot; float wk = 1.f / Y8SC;
            if (k < 8) { slot = (size_t)__shfl(myslot, k); wk = __shfl(wv, k) * (1.f / Y8SC); } else slot = (size_t)TT * 8 + r;
            const u32x4 a = *(const u32x4*)(YR + slot * DM + c0);
            const unsigned aw[4] = {a.x, a.y, a.z, a.w};
#pragma unroll
            for (int q = 0; q < 4; ++q) {
                const f32x2 lo = __builtin_amdgcn_cvt_pk_f32_fp8((int)aw[q], false), hi2 = __builtin_amdgcn_cvt_pk_f32_fp8((int)aw[q], true);
                f[q * 4 + 0] += wk * lo.x; f[q * 4 + 1] += wk * lo.y; f[q * 4 + 2] += wk * hi2.x; f[q * 4 + 3] += wk * hi2.y;
            }
        }
        float ss = 0.f;
#pragma unroll
        for (int i = 0; i < 16; ++i) ss += f[i] * f[i];
        const float rinv = rsqrtf(wave_sum(ss) * (1.f / DM) + RMS_EPS);
        const float* mv = mod + (size_t)modvec(r) * 6144;
        float* hb = hl_buf(p, r);
        float h[16];
#pragma unroll
        for (int q = 0; q < 4; ++q) {
            const int c = c0 + q * 4;
            const f32x4 hv = *(const f32x4*)(hb + c), gg = *(const f32x4*)(p.g_ffn_post + l * DM + c), gt = *(const f32x4*)(mv + 5120 + c);
            const f32x4 fv = {f[q * 4 + 0], f[q * 4 + 1], f[q * 4 + 2], f[q * 4 + 3]};
            const f32x4 o = hv + gt * (fv * rinv * gg);
            *(f32x4*)(hb + c) = o;
            h[q * 4 + 0] = o.x; h[q * 4 + 1] = o.y; h[q * 4 + 2] = o.z; h[q * 4 + 3] = o.w;
        }
        if (l == 0) {
            float s2 = 0.f;
#pragma unroll
            for (int i = 0; i < 16; ++i) s2 += h[i] * h[i];
            const float rinv2 = rsqrtf(wave_sum(s2) * (1.f / DM) + RMS_EPS);
            const float* mv1 = mv + 3 * 6144;
#pragma unroll
            for (int hf = 0; hf < 2; ++hf) {
                const int c = c0 + hf * 8;
                const f32x4 g0 = *(const f32x4*)(p.g_mix_pre + DM + c), g1 = *(const f32x4*)(p.g_mix_pre + DM + c + 4);
                const f32x4 sh0 = *(const f32x4*)(mv1 + c), sh1 = *(const f32x4*)(mv1 + c + 4), sc0 = *(const f32x4*)(mv1 + 1024 + c), sc1 = *(const f32x4*)(mv1 + 1024 + c + 4);
                const f32x4 h0 = {h[hf * 8 + 0], h[hf * 8 + 1], h[hf * 8 + 2], h[hf * 8 + 3]}, h1 = {h[hf * 8 + 4], h[hf * 8 + 5], h[hf * 8 + 6], h[hf * 8 + 7]};
                const f32x4 o0 = h0 * rinv2 * g0 * (sc0 + 1.f) + sh0, o1 = h1 * rinv2 * g1 * (sc1 + 1.f) + sh1;
                *(u32x4*)(U + (size_t)r * DM + c) = (u32x4){pk2(o0.x, o0.y), pk2(o0.z, o0.w), pk2(o1.x, o1.y), pk2(o1.z, o1.w)};
            }
        }
    }
}

__device__ __forceinline__ int stg_col() { const int tid = threadIdx.x; return ((tid & 7) ^ ((tid >> 3) & 7)) * 8; }
__device__ __forceinline__ void plain_ptrs(const bf16* base, int row0, int ld, const bf16* (&pp)[4]) {
    const int tid = threadIdx.x;
    pp[0] = base + (size_t)(row0 + (tid >> 3)) * ld + stg_col();
#pragma unroll
    for (int i = 1; i < 4; ++i) pp[i] = pp[0] + (size_t)(32 * i) * ld;
}

__device__ __forceinline__ void ph_inproj0(const Params& p, LAS unsigned char* lds) {
    unsigned char* ws = p.ws;
    const bf16* U = (const bf16*)(ws + OFF_U); const bf16* W = (const bf16*)(ws + OFF_W_IN_E);
    bf16* Z0 = (bf16*)(ws + A0_Z0); bf16* VGT = (bf16*)(ws + A0_VGT); bf16* QS = (bf16*)(ws + A0_QS); bf16* KS = (bf16*)(ws + A0_KS); bf16* VST = (bf16*)(ws + A0_VST);
    const f32x2* rope = (const f32x2*)(ws + OFF_ROPE);
    const int tid = threadIdx.x, lane = tid & 63, wid = tid >> 6, wr = wid >> 1, wc = wid & 1, fr = lane & 15, fq = lane >> 4;
    constexpr int NTN = 19, NTM = TT / 128;
    auto make = [&](int t, GPtrs& g, int& nk) { int tm, tn; tile_mn(t, NTM, NTN, tm, tn); plain_ptrs(U, tm * 128, DM, g.a); plain_ptrs(W, tn * 128, DM, g.b); nk = DM / 64; };
    auto epi = [&](int t, f32x4 (&acc)[4][4]) {
        int tm, tn; tile_mn(t, NTM, NTN, tm, tn); const int brow = tm * 128, bcol = tn * 128;
        const int cb = bcol + wc * 64;
        LAS unsigned char* wl = lds + 32768 + wid * 8192;
        const int r0 = brow + wr * 64;
        const RowInfo ri0 = rowinfo(r0);
        if (cb < 1024) {
            epi_store_rows(wl, acc, fr, fq, lane, [&](int row) { return Z0 + (size_t)(r0 + row) * Z0P + cb; });
        } else if (cb < 1536) {
            const int c0 = cb - 1024;
            epi_store_cols(wl, acc, fr, fq, lane, [&](int col) { return VGT + (size_t)(c0 + col) * TT + r0; });
        } else if (cb < 2176) {
            const float sc = cb < 2048 ? 0.125f * LOG2E : 1.f;
#pragma unroll
            for (int m = 0; m < 4; ++m) {
                const int pos = ri0.pos + m * 16 + fr;
#pragma unroll
                for (int n = 0; n < 2; ++n)
#pragma unroll
                    for (int j = 0; j < 4; ++j) {
                        const float x1 = acc[m][n][j] * sc, x2 = acc[m][n + 2][j] * sc;
                        if (ri0.lat) { const f32x2 cs = rope[(size_t)pos * 32 + n * 16 + fq * 4 + j]; acc[m][n][j] = x1 * cs.x - x2 * cs.y; acc[m][n + 2][j] = x2 * cs.x + x1 * cs.y; }
                        else { acc[m][n][j] = x1; acc[m][n + 2][j] = x2; }
                    }
                asm volatile("" ::: "memory");
            }
            bf16* dst;
            if (cb < 2048) { const int h = (cb - 1536) >> 6; dst = QS + ((size_t)(ri0.b * 8 + h) * NKEY + ri0.kq) * 64; }
            else { const int h = (cb - 2048) >> 6; dst = KS + ((size_t)(ri0.b * 2 + h) * NKEY + ri0.kq) * 64; }
            epi_store_rows(wl, acc, fr, fq, lane, [&](int row) { return dst + (size_t)row * 64; });
        } else if (cb < 2304) {
            const int h = (cb - 2176) >> 6;
            bf16* dst = VST + (size_t)(ri0.b * 2 + h) * 64 * NKEY + ri0.kq;
            epi_store_cols(wl, acc, fr, fq, lane, [&](int col) { return dst + (size_t)col * NKEY; });
        } else if (cb == 2304) {
#pragma unroll
            for (int m = 0; m < 4; ++m) {
                const int r = r0 + m * 16 + fr;
#pragma unroll
                for (int n = 0; n < 2; ++n) { u32x2 w; w.x = pk2(acc[m][n][0], acc[m][n][1]); w.y = pk2(acc[m][n][2], acc[m][n][3]); *(u32x2*)(Z0 + (size_t)r * Z0P + 1024 + n * 16 + fq * 4) = w; }
            }
        }
    };
    gemm_tiles<true>(lds, vcu_id(), NTM * NTN, gridDim.x, make, epi);
}

__device__ __forceinline__ void ph_outproj(const Params& p, LAS unsigned char* lds, const bf16* MIX, const bf16* W, float* Y, int row_lo) {
    const int tid = threadIdx.x, lane = tid & 63, wid = tid >> 6, wr = wid >> 1, wc = wid & 1, fr = lane & 15, fq = lane >> 4;
    const int tm0 = row_lo / 128, ntm = TT / 128 - tm0;
    auto make = [&](int t, GPtrs& g, int& nk) { int tm, tn; tile_mn(t, ntm, 8, tm, tn); plain_ptrs(MIX, (tm0 + tm) * 128, DM, g.a); plain_ptrs(W, tn * 128, DM, g.b); nk = DM / 64; };
    auto epi = [&](int t, f32x4 (&acc)[4][4]) {
        int tm, tn; tile_mn(t, ntm, 8, tm, tn); tm += tm0; const int brow = tm * 128, bcol = tn * 128;
#pragma unroll
        for (int m = 0; m < 4; ++m) {
            const int r = brow + wr * 64 + m * 16 + fr;
#pragma unroll
            for (int n = 0; n < 4; ++n) *(f32x4*)(Y + (size_t)r * DM + bcol + wc * 64 + n * 16 + fq * 4) = acc[m][n];
        }
    };
    gemm_tiles<true, 16>(lds, vcu_id(), ntm * 8, gridDim.x, make, epi);
}

template <int DQK, int DV>
__device__ __forceinline__ void attn_item(LAS unsigned char* lds, const bf16* Qg, const bf16* Kg, const bf16* VTg, int a1, int b0, int b1, int qpos0,
                                          float m_init, float l_init, bf16* Og, int o_pitch) {
    constexpr int KPB = DQK * 2, NS = DQK / 16, NDV = DV / 32, KCH = DQK / 8, KBYTES = 64 * KPB, KN = 64 * KCH / 256, VN = DV * 8 / 256;
    static_assert(KN == 6 || KN == 2, "counted waits below are written for KN = 6 or 2");
    const int tid = threadIdx.x, lane = tid & 63, wid = tid >> 6, ql = lane & 31, hi = lane >> 5;
    LAS unsigned char* Kb0 = lds; LAS unsigned char* Vs = lds + 2 * KBYTES;
    asm volatile("s_waitcnt vmcnt(0) lgkmcnt(0)" ::: "memory");
    __builtin_amdgcn_s_barrier();
    asm volatile("" ::: "memory");
    bf16x8 qf[NS];
    {
        const bf16* qrow = Qg + (size_t)(wid * 32 + ql) * DQK + hi * 8;
#pragma unroll
        for (int s = 0; s < NS; ++s) qf[s] = *(const bf16x8*)(qrow + s * 16);
    }
    unsigned koff[KN], voff[VN];
#pragma unroll
    for (int i = 0; i < KN; ++i) { const int pz = tid + 256 * i, key = pz / KCH, ch = pz % KCH; koff[i] = (unsigned)(key * DQK + (((ch & ~7) | ((ch & 7) ^ ((key >> 1) & 7))) * 8)); }
#pragma unroll
    for (int i = 0; i < VN; ++i) { const int pz = tid + 256 * i, dv = pz >> 3, ch = pz & 7; voff[i] = (unsigned)(dv * NKEY + ((ch ^ ((dv >> 1) & 7)) * 8)); }
    const int ntot = a1 + (b1 - b0);
#define ATTN_KT(it_) ((it_) < a1 ? (it_) : b0 + ((it_) - a1))
#define ATTN_DMA_K(kt_, buf_) do { _Pragma("unroll") for (int i_ = 0; i_ < KN; ++i_) glds16(Kg + (size_t)(kt_) * 64 * DQK + koff[i_], Kb0 + (buf_) * KBYTES + (tid + 256 * i_) * 16); } while (0)
#define ATTN_DMA_V(kt_) do { _Pragma("unroll") for (int i_ = 0; i_ < VN; ++i_) glds16(VTg + (size_t)(kt_) * 64 + voff[i_], Vs + (tid + 256 * i_) * 16); } while (0)
    ATTN_DMA_K(ATTN_KT(0), 0);
    f32x16 o[NDV];
#pragma unroll
    for (int d = 0; d < NDV; ++d)
#pragma unroll
        for (int r = 0; r < 16; ++r) o[d][r] = 0.f;
    float mrun = m_init, lrun = l_init;
    const int sw = (ql >> 1) & 7;
    const LAS unsigned char* kfrag = Kb0 + ql * KPB; const LAS unsigned char* vfrag = Vs + ql * 128;
    for (int it = 0; it < ntot; ++it) {
        const int kt = ATTN_KT(it), cur = it & 1;
        const bool masked = it >= a1;
        asm volatile("s_waitcnt vmcnt(0) lgkmcnt(0)" ::: "memory");
        __builtin_amdgcn_s_barrier();
        asm volatile("" ::: "memory");
        ATTN_DMA_V(kt);
        if (it + 1 < ntot) { const int ktn = ATTN_KT(it + 1); ATTN_DMA_K(ktn, cur ^ 1); }
        f32x16 p0, p1;
#pragma unroll
        for (int r = 0; r < 16; ++r) { p0[r] = 0.f; p1[r] = 0.f; }
        const LAS unsigned char* kc = kfrag + cur * KBYTES;
#pragma unroll
        for (int s = 0; s < NS; ++s) {
            const int c = 2 * s + hi, off = ((c & ~7) | ((c & 7) ^ sw)) * 16;
            const bf16x8 k0 = *(const LAS bf16x8*)(kc + off);
            const bf16x8 k1 = *(const LAS bf16x8*)(kc + 32 * KPB + off);
            p0 = __builtin_amdgcn_mfma_f32_32x32x16_bf16(k0, qf[s], p0, 0, 0, 0);
            p1 = __builtin_amdgcn_mfma_f32_32x32x16_bf16(k1, qf[s], p1, 0, 0, 0);
        }
        if (masked) {
            const int kbase = kt * 64 - CTX, qpos = qpos0 + wid * 32 + ql;
#pragma unroll
            for (int r = 0; r < 16; ++r) {
                const int d0 = qpos - (kbase + crow(r, hi)), d1 = d0 - 32;
                if (d0 > 128 || d0 < -128) p0[r] = -1e30f;
                if (d1 > 128 || d1 < -128) p1[r] = -1e30f;
            }
        }
        float mx = p0[0];
#pragma unroll
        for (int r = 1; r < 16; ++r) mx = fmaxf(mx, p0[r]);
#pragma unroll
        for (int r = 0; r < 16; ++r) mx = fmaxf(mx, p1[r]);
        mx = fmaxf(mx, __shfl_xor(mx, 32));
        if (__any(mx > mrun + 8.f)) {
            const float mn = fmaxf(mrun, mx), alpha = ex2(mrun - mn);
            mrun = mn; lrun *= alpha;
#pragma unroll
            for (int d = 0; d < NDV; ++d)
#pragma unroll
                for (int r = 0; r < 16; ++r) o[d][r] *= alpha;
        }
        float rs = 0.f;
#pragma unroll
        for (int r = 0; r < 16; ++r) { p0[r] = ex2(p0[r] - mrun); rs += p0[r]; }
#pragma unroll
        for (int r = 0; r < 16; ++r) { p1[r] = ex2(p1[r] - mrun); rs += p1[r]; }
        rs += __shfl_xor(rs, 32);
        lrun += rs;
        bf16x8 pf[4];
#define ATTN_PK4(P, BASE, OUT) do { const unsigned a0_ = pk2(P[BASE + 0], P[BASE + 1]), a1_ = pk2(P[BASE + 2], P[BASE + 3]), b0_ = pk2(P[BASE + 4], P[BASE + 5]), b1_ = pk2(P[BASE + 6], P[BASE + 7]); \
        const auto r0_ = __builtin_amdgcn_permlane32_swap(a0_, b0_, false, false); const auto r1_ = __builtin_amdgcn_permlane32_swap(a1_, b1_, false, false); \
        OUT = mk8((u32x4){r0_[0], r1_[0], r0_[1], r1_[1]}); } while (0)
        ATTN_PK4(p0, 0, pf[0]); ATTN_PK4(p0, 8, pf[1]); ATTN_PK4(p1, 0, pf[2]); ATTN_PK4(p1, 8, pf[3]);
#undef ATTN_PK4
        if (it + 1 < ntot) { if (KN == 6) asm volatile("s_waitcnt vmcnt(6) lgkmcnt(0)" ::: "memory"); else asm volatile("s_waitcnt vmcnt(2) lgkmcnt(0)" ::: "memory"); }
        else asm volatile("s_waitcnt vmcnt(0) lgkmcnt(0)" ::: "memory");
        __builtin_amdgcn_s_barrier();
        asm volatile("" ::: "memory");
#pragma unroll
        for (int d = 0; d < NDV; ++d) {
#pragma unroll
            for (int kk = 0; kk < 4; ++kk) {
                const bf16x8 vf = *(const LAS bf16x8*)(vfrag + d * 32 * 128 + (((2 * kk + hi) ^ sw) * 16));
                o[d] = __builtin_amdgcn_mfma_f32_32x32x16_bf16(vf, pf[kk], o[d], 0, 0, 0);
            }
        }
    }
#undef ATTN_KT
#undef ATTN_DMA_K
#undef ATTN_DMA_V
    const float inv = 1.f / lrun;
    bf16* orow = Og + (size_t)(wid * 32 + ql) * o_pitch;
#pragma unroll
    for (int d = 0; d < NDV; ++d)
#pragma unroll
        for (int g = 0; g < 4; ++g) {
            u32x2 w; w.x = pk2(o[d][g * 4 + 0] * inv, o[d][g * 4 + 1] * inv); w.y = pk2(o[d][g * 4 + 2] * inv, o[d][g * 4 + 3] * inv);
            *(u32x2*)(orow + d * 32 + 8 * g + 4 * hi) = w;
        }
}

constexpr int GA_CUM = 0, GA_ALOW = 16384, GA_WA = 20480, GA_BA = 24576, GA_QT = 24832, GA_TOT = 25856, GA_END = 26112;
__device__ __forceinline__ void gla_cum(const Params& p, LAS unsigned char* lds, const bf16* Z0, int r0, int h, int dir) {
    const int tid = threadIdx.x;
    LAS float* cum = (LAS float*)(lds + GA_CUM); LAS float* alow = (LAS float*)(lds + GA_ALOW); LAS float* wa = (LAS float*)(lds + GA_WA);
    LAS float* ba = (LAS float*)(lds + GA_BA); LAS float* qt = (LAS float*)(lds + GA_QT); LAS float* tot = (LAS float*)(lds + GA_TOT);
    {
        const int t = tid >> 2, i4 = (tid & 3) * 4;
        const u32x2 w = *(const u32x2*)(Z0 + (size_t)(r0 + t) * Z0P + 1024 + dir * 16 + i4);
        alow[t * 16 + i4 + 0] = bflo(w.x); alow[t * 16 + i4 + 1] = bfhi(w.x); alow[t * 16 + i4 + 2] = bflo(w.y); alow[t * 16 + i4 + 3] = bfhi(w.y);
#pragma unroll
        for (int q = 0; q < 4; ++q) { const int idx = tid * 4 + q, i = idx >> 6, j = idx & 63; wa[idx] = p.gla_wa2[(size_t)(dir * 16 + i) * 256 + h * 64 + j]; }
        if (tid < 64) ba[tid] = p.gla_ba[dir * 256 + h * 64 + tid];
    }
    __syncthreads();
    const int j = tid & 63, tq = tid >> 6;
    float la[16], wj[16];
#pragma unroll
    for (int i = 0; i < 16; ++i) wj[i] = wa[i * 64 + j];
    const float bj = ba[j];
#pragma unroll
    for (int tt = 0; tt < 16; ++tt) {
        const int t = tq * 16 + tt;
        float x = bj;
#pragma unroll
        for (int q = 0; q < 4; ++q) { const f32x4 a = *(const LAS f32x4*)(alow + t * 16 + q * 4);
            x += a.x * wj[q * 4] + a.y * wj[q * 4 + 1] + a.z * wj[q * 4 + 2] + a.w * wj[q * 4 + 3]; }
        la[tt] = (fminf(x, 0.f) - __logf(1.f + __expf(-fabsf(x)))) * (1.f / 16.f);
    }
    float run = 0.f;
    if (dir == 0) {
#pragma unroll
        for (int tt = 0; tt < 16; ++tt) { run += la[tt]; cum[(tq * 16 + tt) * 64 + j] = run; }
    } else {
#pragma unroll
        for (int tt = 15; tt >= 0; --tt) { run += la[tt]; cum[(tq * 16 + tt) * 64 + j] = run; }
    }
    qt[tq * 64 + j] = run;
    __syncthreads();
    float off = 0.f, total = 0.f;
#pragma unroll
    for (int q = 0; q < 4; ++q) { const float v = qt[q * 64 + j]; total += v; if (dir == 0 ? (q < tq) : (q > tq)) off += v; }
#pragma unroll
    for (int tt = 0; tt < 16; ++tt) cum[(tq * 16 + tt) * 64 + j] += off;
    if (tq == 0) tot[j] = total;
    __syncthreads();
}

__device__ __forceinline__ int gla_row0(int b, int cc) { return cc < 4 ? b * CTX + cc * 64 : TC + b * SEQ + (cc - 4) * 64; }
__device__ __forceinline__ int gla_step(int cc, int dir) { return dir == 0 ? cc : (cc < 4 ? 3 - cc : 4 + (131 - cc)); }

__device__ __forceinline__ void gla_g1_item(const Params& p, LAS unsigned char* lds, int item) {
    unsigned char* ws = p.ws;
    const bf16* Z0 = (const bf16*)(ws + A0_Z0); const bf16* VGT = (const bf16*)(ws + A0_VGT);
    bf16* GS = (bf16*)(ws + A0_GS); float* GD = (float*)(ws + A0_GD);
    const int cc = item % NSTEP, rest = item / NSTEP, dir = rest & 1, h = (rest >> 1) & 3, b = rest >> 3;
    const int r0 = gla_row0(b, cc), step = gla_step(cc, dir), chain = (b * 4 + h) * 2 + dir;
    const int tid = threadIdx.x, lane = tid & 63, wid = tid >> 6, fr = lane & 15, fq = lane >> 4;
    __syncthreads();
    gla_cum(p, lds, Z0, r0, h, dir);
    LAS float* cum = (LAS float*)(lds + GA_CUM); LAS float* tot = (LAS float*)(lds + GA_TOT);
    LAS bf16* KT = (LAS bf16*)(lds + GA_END);
    {
        const int t = tid >> 2, d0 = (tid & 3) * 16;
        const u32x4 w0 = *(const u32x4*)(Z0 + (size_t)(r0 + t) * Z0P + 256 + h * 64 + d0), w1 = *(const u32x4*)(Z0 + (size_t)(r0 + t) * Z0P + 256 + h * 64 + d0 + 8);
        const unsigned ww[8] = {w0.x, w0.y, w0.z, w0.w, w1.x, w1.y, w1.z, w1.w};
#pragma unroll
        for (int i = 0; i < 8; ++i) {
            const int d = d0 + 2 * i;
            KT[d * 72 + t] = f2bf(bflo(ww[i]) * __expf(tot[d] - cum[t * 64 + d]));
            KT[(d + 1) * 72 + t] = f2bf(bfhi(ww[i]) * __expf(tot[d + 1] - cum[t * 64 + d + 1]));
        }
    }
    if (tid < 64) GD[((size_t)chain * NSTEP + step) * 64 + tid] = __expf(tot[tid]);
    __syncthreads();
    f32x4 acc[2][4];
#pragma unroll
    for (int m = 0; m < 2; ++m)
#pragma unroll
        for (int n = 0; n < 4; ++n) acc[m][n] = (f32x4){0.f, 0.f, 0.f, 0.f};
#pragma unroll
    for (int ks = 0; ks < 2; ++ks) {
        bf16x8 af[2], bfr[4];
#pragma unroll
        for (int m = 0; m < 2; ++m) af[m] = *(const bf16x8*)(VGT + (size_t)(h * 128 + wid * 32 + m * 16 + fr) * TT + r0 + ks * 32 + fq * 8);
#pragma unroll
        for (int n = 0; n < 4; ++n) bfr[n] = *(const LAS bf16x8*)(KT + (n * 16 + fr) * 72 + ks * 32 + fq * 8);
#pragma unroll
        for (int m = 0; m < 2; ++m)
#pragma unroll
            for (int n = 0; n < 4; ++n) acc[m][n] = __builtin_amdgcn_mfma_f32_16x16x32_bf16(bfr[n], af[m], acc[m][n], 0, 0, 0);
    }
    bf16* dst = GS + ((size_t)chain * NSTEP + step) * 8192;
#pragma unroll
    for (int m = 0; m < 2; ++m)
#pragma unroll
        for (int n = 0; n < 4; ++n) *(u32x2*)(dst + (size_t)(wid * 32 + m * 16 + fr) * 64 + n * 16 + fq * 4) = (u32x2){pk2(acc[m][n][0], acc[m][n][1]), pk2(acc[m][n][2], acc[m][n][3])};
}

__device__ __forceinline__ void ph_gla_scan(const Params& p) {
    unsigned* GS = (unsigned*)(p.ws + A0_GS); const float* GD = (const float*)(p.ws + A0_GD);
    for (int idx = blockIdx.x * 256 + threadIdx.x; idx < 16 * 4096; idx += gridDim.x * 256) {
        const int chain = idx >> 12, e2 = idx & 4095, dk = (e2 & 31) * 2;
        unsigned* g = GS + (size_t)chain * NSTEP * 4096 + e2;
        const f32x2* d = (const f32x2*)(GD + (size_t)chain * NSTEP * 64 + dk);
        float s0 = 0.f, s1 = 0.f;
#pragma unroll 12
        for (int s = 0; s < NSTEP; ++s) {
            const unsigned t = g[(size_t)s * 4096]; const f32x2 dec = d[s * 32];
            g[(size_t)s * 4096] = pk2(s0, s1);
            s0 = dec.x * s0 + bflo(t); s1 = dec.y * s1 + bfhi(t);
        }
    }
}

__device__ __forceinline__ void gla_g3_item(const Params& p, LAS unsigned char* lds, int item) {
    unsigned char* ws = p.ws;
    const bf16* Z0 = (const bf16*)(ws + A0_Z0); const bf16* VGT = (const bf16*)(ws + A0_VGT);
    const bf16* GS = (const bf16*)(ws + A0_GS); bf16* MIX = (bf16*)(ws + A0_MIX);
    const int cc = item % NSTEP, rest = item / NSTEP, h = rest & 3, b = rest >> 2;
    const int r0 = gla_row0(b, cc);
    const int tid = threadIdx.x, lane = tid & 63, wid = tid >> 6, fr = lane & 15, fq = lane >> 4;
    LAS bf16* QT = (LAS bf16*)(lds + GA_END);
    LAS bf16* QI = (LAS bf16*)(lds + GA_END + 9216);
    LAS bf16* KT = (LAS bf16*)(lds + GA_END + 18432);
    LAS bf16* PP = (LAS bf16*)(lds);
    f32x4 o[4][2];
#pragma unroll
    for (int m = 0; m < 4; ++m)
#pragma unroll
        for (int n = 0; n < 2; ++n) o[m][n] = (f32x4){0.f, 0.f, 0.f, 0.f};
    for (int dir = 0; dir < 2; ++dir) {
        const int step = gla_step(cc, dir), chain = (b * 4 + h) * 2 + dir;
        __syncthreads();
        gla_cum(p, lds, Z0, r0, h, dir);
        LAS float* cum = (LAS float*)(lds + GA_CUM); LAS float* tot = (LAS float*)(lds + GA_TOT);
        {
            const int t = tid >> 2, d0 = (tid & 3) * 16;
            const bf16* zr = Z0 + (size_t)(r0 + t) * Z0P + h * 64 + d0;
            const u32x4 q0 = *(const u32x4*)(zr), q1 = *(const u32x4*)(zr + 8), k0 = *(const u32x4*)(zr + 256), k1 = *(const u32x4*)(zr + 264);
            const unsigned qq[8] = {q0.x, q0.y, q0.z, q0.w, q1.x, q1.y, q1.z, q1.w}, kk[8] = {k0.x, k0.y, k0.z, k0.w, k1.x, k1.y, k1.z, k1.w};
            unsigned oqt[8], oqi[8], okt[8];
#pragma unroll
            for (int i = 0; i < 8; ++i) {
                const int d = d0 + 2 * i;
                const float c0 = cum[t * 64 + d], c1 = cum[t * 64 + d + 1], t0 = tot[d], t1 = tot[d + 1];
                const float qa = bflo(qq[i]), qb = bfhi(qq[i]), ka = bflo(kk[i]), kb = bfhi(kk[i]);
                oqt[i] = pk2(qa * __expf(c0 - t0), qb * __expf(c1 - t1));
                oqi[i] = pk2(qa * __expf(c0), qb * __expf(c1));
                okt[i] = pk2(ka * __expf(t0 - c0), kb * __expf(t1 - c1));
            }
            *(LAS u32x4*)(QT + t * 72 + d0) = (u32x4){oqt[0], oqt[1], oqt[2], oqt[3]}; *(LAS u32x4*)(QT + t * 72 + d0 + 8) = (u32x4){oqt[4], oqt[5], oqt[6], oqt[7]};
            *(LAS u32x4*)(QI + t * 72 + d0) = (u32x4){oqi[0], oqi[1], oqi[2], oqi[3]}; *(LAS u32x4*)(QI + t * 72 + d0 + 8) = (u32x4){oqi[4], oqi[5], oqi[6], oqi[7]};
            *(LAS u32x4*)(KT + t * 72 + d0) = (u32x4){okt[0], okt[1], okt[2], okt[3]}; *(LAS u32x4*)(KT + t * 72 + d0 + 8) = (u32x4){okt[4], okt[5], okt[6], okt[7]};
        }
        __syncthreads();
        {
            f32x4 sa[4];
#pragma unroll
            for (int m = 0; m < 4; ++m) sa[m] = (f32x4){0.f, 0.f, 0.f, 0.f};
#pragma unroll
            for (int ks = 0; ks < 2; ++ks) {
                const bf16x8 kf = *(const LAS bf16x8*)(KT + (wid * 16 + fr) * 72 + ks * 32 + fq * 8);
#pragma unroll
                for (int m = 0; m < 4; ++m) {
                    const bf16x8 qfm = *(const LAS bf16x8*)(QT + (m * 16 + fr) * 72 + ks * 32 + fq * 8);
                    sa[m] = __builtin_amdgcn_mfma_f32_16x16x32_bf16(kf, qfm, sa[m], 0, 0, 0);
                }
            }
#pragma unroll
            for (int m = 0; m < 4; ++m) {
                const int t = m * 16 + fr;
                float v[4];
#pragma unroll
                for (int jj = 0; jj < 4; ++jj) { const int j = wid * 16 + fq * 4 + jj; const bool keep = dir == 0 ? (j <= t) : (j >= t); v[jj] = keep ? sa[m][jj] : 0.f; }
                *(LAS u32x2*)(PP + t * 72 + wid * 16 + fq * 4) = (u32x2){pk2(v[0], v[1]), pk2(v[2], v[3])};
            }
        }
        __syncthreads();
        const bf16* Sg = GS + ((size_t)chain * NSTEP + step) * 8192;
#pragma unroll
        for (int ks = 0; ks < 2; ++ks) {
            bf16x8 vfr[2], sfr[2];
#pragma unroll
            for (int n = 0; n < 2; ++n) {
                const int dv = wid * 32 + n * 16 + fr;
                vfr[n] = *(const bf16x8*)(VGT + (size_t)(h * 128 + dv) * TT + r0 + ks * 32 + fq * 8);
                sfr[n] = *(const bf16x8*)(Sg + (size_t)dv * 64 + ks * 32 + fq * 8);
            }
#pragma unroll
            for (int m = 0; m < 4; ++m) {
                const bf16x8 pfm = *(const LAS bf16x8*)(PP + (m * 16 + fr) * 72 + ks * 32 + fq * 8);
                const bf16x8 qim = *(const LAS bf16x8*)(QI + (m * 16 + fr) * 72 + ks * 32 + fq * 8);
#pragma unroll
                for (int n = 0; n < 2; ++n) {
                    o[m][n] = __builtin_amdgcn_mfma_f32_16x16x32_bf16(vfr[n], pfm, o[m][n], 0, 0, 0);
                    o[m][n] = __builtin_amdgcn_mfma_f32_16x16x32_bf16(sfr[n], qim, o[m][n], 0, 0, 0);
                }
            }
        }
    }
    __syncthreads();
    LAS float* red = (LAS float*)(lds + GA_END + 27648);
#pragma unroll
    for (int m = 0; m < 4; ++m) {
        float s = 0.f;
#pragma unroll
        for (int n = 0; n < 2; ++n)
#pragma unroll
            for (int j = 0; j < 4; ++j) s += o[m][n][j] * o[m][n][j];
        s += __shfl_xor(s, 16); s += __shfl_xor(s, 32);
        if (fq == 0) red[wid * 64 + m * 16 + fr] = s;
    }
    __syncthreads();
#pragma unroll
    for (int m = 0; m < 4; ++m) {
        const int t = m * 16 + fr;
        const float ss = red[t] + red[64 + t] + red[128 + t] + red[192 + t];
        const float rinv = rsqrtf(ss * (1.f / 128.f) + RMS_EPS);
        const int r = r0 + t;
#pragma unroll
        for (int n = 0; n < 2; ++n) {
            const int dv = wid * 32 + n * 16 + fq * 4;
            const u32x2 gw = *(const u32x2*)(Z0 + (size_t)r * Z0P + 512 + h * 128 + dv);
            const f32x4 ng = *(const f32x4*)(p.gla_norm + dv);
            const float g0 = bflo(gw.x), g1 = bfhi(gw.x), g2 = bflo(gw.y), g3 = bfhi(gw.y);
            const float y0 = o[m][n][0] * rinv * ng.x * siluf(g0), y1 = o[m][n][1] * rinv * ng.y * siluf(g1);
            const float y2 = o[m][n][2] * rinv * ng.z * siluf(g2), y3 = o[m][n][3] * rinv * ng.w * siluf(g3);
            *(u32x2*)(MIX + (size_t)r * DM + h * 128 + dv) = (u32x2){pk2(y0, y1), pk2(y2, y3)};
        }
    }
}

__device__ __forceinline__ void ph_swa_g1(const Params& p, LAS unsigned char* lds) {
    unsigned char* ws = p.ws;
    const bf16* QS = (const bf16*)(ws + A0_QS); const bf16* KS = (const bf16*)(ws + A0_KS); const bf16* VST = (const bf16*)(ws + A0_VST); bf16* MIX = (bf16*)(ws + A0_MIX);
    constexpr int N_SWA = 2 * 8 * 66, N_G1 = 2 * 4 * 2 * NSTEP;
    for (int item = blockIdx.x; item < N_SWA + N_G1; item += gridDim.x) {
        if (item < N_SWA) {
            const int qt = item % 66, rest = item / 66, h = rest & 7, b = rest >> 3, kvh = h >> 2;
            const bf16* Qg = QS + ((size_t)(b * 8 + h) * NKEY + qt * 128) * 64;
            const bf16* Kg = KS + (size_t)(b * 2 + kvh) * NKEY * 64;
            const bf16* Vg = VST + (size_t)(b * 2 + kvh) * 64 * NKEY;
            int b0 = 0, b1 = 0, qpos0 = 0, row0;
            if (qt >= 2) { qpos0 = (qt - 2) * 128; const int lo = qpos0 - 128 < 0 ? 0 : qpos0 - 128, hi2 = qpos0 + 256 > SEQ ? SEQ : qpos0 + 256; b0 = 4 + lo / 64; b1 = 4 + hi2 / 64; row0 = TC + b * SEQ + qpos0; }
            else row0 = b * CTX + qt * 128;
            const float sink = p.swa_sink[h] * LOG2E;
            attn_item<64, 64>(lds, Qg, Kg, Vg, 4, b0, b1, qpos0, sink, 1.f, MIX + (size_t)row0 * DM + 512 + h * 64, DM);
        } else gla_g1_item(p, lds, item - N_SWA);
    }
}
__device__ __forceinline__ void ph_gla_g3(const Params& p, LAS unsigned char* lds) {
    for (int item = blockIdx.x; item < 2 * 4 * NSTEP; item += gridDim.x) gla_g3_item(p, lds, item);
}

__device__ __forceinline__ void ph_router(const Params& p, LAS unsigned char* lds, int l, int row_lo) {
    unsigned char* ws = p.ws;
    const bf16* U = (const bf16*)(ws + OFF_U); const bf16* W = (const bf16*)(ws + OFF_W_RT) + (size_t)l * 128 * DM;
    int* cntg = (int*)(ws + OFF_CNT) + l * 64; int* tokslot = (int*)(ws + OFF_TOKSLOT); float* W8 = (float*)(ws + OFF_W8); int* LIST = (int*)(ws + OFF_LIST);
    const int tid = threadIdx.x, lane = tid & 63, wid = tid >> 6, wr = wid >> 1, wc = wid & 1, fr = lane & 15, fq = lane >> 4;
    LAS float* lg = (LAS float*)lds;
    const int tm0 = row_lo / 128;
    auto make = [&](int tm, GPtrs& g, int& nk) { plain_ptrs(U, tm * 128, DM, g.a); plain_ptrs(W, 0, DM, g.b); nk = DM / 64; };
    auto epi = [&](int tm, f32x4 (&acc)[4][4]) {
        const int brow = tm * 128;
        if (wc == 0) {
#pragma unroll
            for (int m = 0; m < 4; ++m)
#pragma unroll
                for (int n = 0; n < 4; ++n)
#pragma unroll
                    for (int j = 0; j < 4; ++j) lg[(wr * 64 + m * 16 + fr) * 65 + n * 16 + fq * 4 + j] = acc[m][n][j];
        }
        __syncthreads();
        LAS float* biasl = (LAS float*)(lds + 34816); LAS int* hist = (LAS int*)(lds + 34816 + 256); LAS int* basel = (LAS int*)(lds + 34816 + 512);
        if (tid < 64) { biasl[tid] = p.b_router[l * 64 + tid]; hist[tid] = 0; }
        __syncthreads();
        int esel[8], lrank[8]; float ssel[8]; float wsum = 0.f;
        if (tid < 128) {
            LAS float* L = lg + tid * 65;
            float gs[8];
#pragma unroll
            for (int g = 0; g < 8; ++g) {
                float m1 = -INFINITY, m2 = -INFINITY;
#pragma unroll
                for (int j = 0; j < 8; ++j) {
                    const int e = g * 8 + j;
                    const float sel = 1.f / (1.f + expf(-L[e])) + biasl[e];
                    L[e] = sel;
                    if (sel > m1) { m2 = m1; m1 = sel; } else if (sel > m2) m2 = sel;
                }
                gs[g] = m1 + m2;
            }
            unsigned allowed = 0u;
#pragma unroll
            for (int g = 0; g < 8; ++g) {
                int rk = 0;
#pragma unroll
                for (int h = 0; h < 8; ++h) rk += (gs[h] > gs[g] || (gs[h] == gs[g] && h < g)) ? 1 : 0;
                if (rk < 4) allowed |= 1u << g;
            }
#pragma unroll
            for (int k = 0; k < 8; ++k) {
                float best = -INFINITY; int bi = 0;
#pragma unroll
                for (int g = 0; g < 8; ++g) {
                    if ((allowed >> g) & 1u) {
#pragma unroll
                        for (int j = 0; j < 8; ++j) { const float v = L[g * 8 + j]; if (v > best) { best = v; bi = g * 8 + j; } }
                    }
                }
                esel[k] = bi; ssel[k] = best - biasl[bi]; wsum += ssel[k]; L[bi] = -INFINITY;
            }
#pragma unroll
            for (int k = 0; k < 8; ++k) lrank[k] = __hip_atomic_fetch_add(hist + esel[k], 1, __ATOMIC_RELAXED, __HIP_MEMORY_SCOPE_WORKGROUP);
        }
        __syncthreads();
        if (tid < 64) { const int c = hist[tid]; basel[tid] = c > 0 ? atomicAdd(cntg + tid, c) : 0; }
        __syncthreads();
        if (tid < 128) {
            const int t = brow + tid; const float wn = 2.5f / wsum;
#pragma unroll
            for (int k = 0; k < 8; ++k) {
                const int e = esel[k], pos = basel[e] + lrank[k];
                tokslot[(size_t)t * 8 + k] = (e << 20) | pos;
                W8[(size_t)t * 8 + k] = ssel[k] * wn;
                LIST[(size_t)e * TT + pos] = t * 8 + k;
            }
        }
    };
    gemm_tiles<false>(lds, tm0 + vcu_id(), TT / 128, gridDim.x, make, epi);
}

__device__ __forceinline__ int moe_find_expert(const LAS int* tp, int mtg) {
    int lo = 0, hi = 64;
    while (lo < hi) { const int mid = (lo + hi + 1) >> 1; if (tp[mid] <= mtg) lo = mid; else hi = mid - 1; }
    return lo;
}
__device__ __forceinline__ void ph_moe1(const Params& p, LAS unsigned char* lds, int l, int row_lo) {
    unsigned char* ws = p.ws;
    moe_tables(p, lds, l, row_lo);
    LAS int* cnt = (LAS int*)(lds + MOE_LDS_OFF); LAS int* tp = cnt + 80; LAS int* sp = tp + 80;
    const bf16* U = (const bf16*)(ws + AM_U8); const bf16* WGU = (const bf16*)(ws + OFF_W_GU); unsigned char* HM = ws + AM_HM;
    const int* LIST = (const int*)(ws + OFF_LIST);
    const int tid = threadIdx.x, lane = tid & 63, wid = tid >> 6, wr = wid >> 1, wc = wid & 1, fr = lane & 15, fq = lane >> 4;
    const int ntiles = tp[65] * 4;
    auto make = [&](int t, GPtrs& g, int& nk) {
        const int mtg = t >> 2, nt = t & 3, e = moe_find_expert(tp, mtg), mt = mtg - tp[e], ce = cnt[e];
        int lv[4];
#pragma unroll
        for (int i = 0; i < 4; ++i) { const int li = mt * 128 + (tid >> 3) + 32 * i; lv[i] = LIST[(size_t)(e < 64 ? e : 0) * TT + (li < ce ? li : 0)]; }
#pragma unroll
        for (int i = 0; i < 4; ++i) {
            const int li = mt * 128 + (tid >> 3) + 32 * i;
            const int tk = li < ce ? (e < 64 ? (lv[i] >> 3) : row_lo + li) : row_lo;
            g.a[i] = U + (size_t)tk * (DM / 2) + stg_col();
        }
        plain_ptrs(WGU + (size_t)e * 512 * (DM / 2), nt * 128, DM / 2, g.b); nk = DM / 128;
    };
    auto epi = [&](int t, f32x4 (&acc)[4][4]) {
        const int mtg = t >> 2, nt = t & 3, e = moe_find_expert(tp, mtg), mt = mtg - tp[e], ce = cnt[e];
        const size_t slot0 = e < 64 ? (size_t)(sp[e] + mt * 128) : (size_t)TT * 8 + row_lo + mt * 128;
        const int hc0 = nt * 64 + wc * 32;
        unsigned char* dump = ws + OFF_DUMP + lane * 64;
        constexpr float isc = 1.f / W8SC;
#pragma unroll
        for (int m = 0; m < 4; ++m) {
            const int i = wr * 64 + m * 16 + fr;
            unsigned char* hrow = (mt * 128 + i < ce) ? HM + (slot0 + i) * 256 + hc0 + fq * 4 : dump;
#pragma unroll
            for (int n = 0; n < 2; ++n) {
                const f32x4 g = acc[m][n] * isc, u = acc[m][n + 2] * (isc * H8SC);
                *(unsigned*)(hrow + n * 16) = pk4_fp8(siluf(g[0]) * u[0], siluf(g[1]) * u[1], siluf(g[2]) * u[2], siluf(g[3]) * u[3]);
            }
        }
    };
    gemm_tiles<true, 8, true>(lds, vcu_id(), ntiles, gridDim.x, make, epi);
}
__device__ __forceinline__ void ph_moe2(const Params& p, LAS unsigned char* lds, int l, int row_lo) {
    unsigned char* ws = p.ws;
    moe_tables(p, lds, l, row_lo);
    LAS int* cnt = (LAS int*)(lds + MOE_LDS_OFF); LAS int* tp = cnt + 80; LAS int* sp = tp + 80;
    const bf16* HM = (const bf16*)(ws + AM_HM); const bf16* WD = (const bf16*)(ws + OFF_W_D);
    const int tid = threadIdx.x, lane = tid & 63, wid = tid >> 6, wr = wid >> 1, wc = wid & 1, fr = lane & 15, fq = lane >> 4;
    const int ntiles = tp[65] * 8;
    auto make = [&](int t, GPtrs& g, int& nk) {
        const int mtg = t >> 3, nt = t & 7, e = moe_find_expert(tp, mtg), mt = mtg - tp[e];
        const size_t slot0 = e < 64 ? (size_t)(sp[e] + mt * 128) : (size_t)TT * 8 + row_lo + mt * 128;
        plain_ptrs(HM, 0, 128, g.a);
#pragma unroll
        for (int i = 0; i < 4; ++i) g.a[i] += slot0 * 128;
        plain_ptrs(WD + (size_t)e * DM * 128, nt * 128, 128, g.b); nk = 256 / 128;
    };
    auto epi = [&](int t, f32x4 (&acc)[4][4]) {
        const int mtg = t >> 3, nt = t & 7, e = moe_find_expert(tp, mtg), mt = mtg - tp[e], ce = cnt[e];
        const size_t slot0 = e < 64 ? (size_t)(sp[e] + mt * 128) : (size_t)TT * 8 + row_lo + mt * 128;
        constexpr float osc = Y8SC / (W8SC * H8SC);
        unsigned char* YR8 = ws + AM_YR; unsigned char* dump = ws + OFF_DUMP + lane * 16;
#pragma unroll
        for (int m = 0; m < 4; ++m) {
            const int i = wr * 64 + m * 16 + fr;
            unsigned char* yrow = (mt * 128 + i < ce) ? YR8 + (slot0 + i) * DM + nt * 128 + wc * 64 + fq * 16 : dump;
            const f32x4 a0 = acc[m][0] * osc, a1 = acc[m][1] * osc, a2 = acc[m][2] * osc, a3 = acc[m][3] * osc;
            *(u32x4*)(yrow) = (u32x4){pk4_fp8(a0[0], a0[1], a0[2], a0[3]), pk4_fp8(a1[0], a1[1], a1[2], a1[3]), pk4_fp8(a2[0], a2[1], a2[2], a2[3]), pk4_fp8(a3[0], a3[1], a3[2], a3[3])};
        }
    };
    gemm_tiles<true, 4, true, true>(lds, vcu_id(), ntiles, gridDim.x, make, epi);
}

__device__ __forceinline__ void ph_inproj1(const Params& p, LAS unsigned char* lds) {
    unsigned char* ws = p.ws;
    const bf16* U = (const bf16*)(ws + OFF_U); const bf16* W = (const bf16*)(ws + OFF_W_IN_O);
    bf16* Z1 = (bf16*)(ws + A1_Z1); bf16* KM = (bf16*)(ws + A1_KM);
    const f32x2* rope = (const f32x2*)(ws + OFF_ROPE);
    const int tid = threadIdx.x, lane = tid & 63, wid = tid >> 6, wr = wid >> 1, wc = wid & 1, fr = lane & 15, fq = lane >> 4;
    constexpr int NTN = 7, NTM = TT / 128;
    auto make = [&](int t, GPtrs& g, int& nk) { int tm, tn; tile_mn(t, NTM, NTN, tm, tn); plain_ptrs(U, tm * 128, DM, g.a); plain_ptrs(W, tn * 128, DM, g.b); nk = DM / 64; };
    auto epi = [&](int t, f32x4 (&acc)[4][4]) {
        int tm, tn; tile_mn(t, NTM, NTN, tm, tn); const int brow = tm * 128, bcol = tn * 128;
        const int cb = bcol + wc * 64;
        LAS unsigned char* wl = lds + 32768 + wid * 8192;
        const int r0 = brow + wr * 64;
        const RowInfo ri0 = rowinfo(r0);
        if (cb < 768) {
            float* ssq = (float*)(ws + OFF_SSQ);
#pragma unroll
            for (int m = 0; m < 4; ++m) {
                float q = 0.f;
#pragma unroll
                for (int n = 0; n < 4; ++n) q += (acc[m][n][0] * acc[m][n][0] + acc[m][n][1] * acc[m][n][1]) + (acc[m][n][2] * acc[m][n][2] + acc[m][n][3] * acc[m][n][3]);
                q += __shfl_xor(q, 16); q += __shfl_xor(q, 32);
                if (fq == 0) ssq[(size_t)(r0 + m * 16 + fr) * 12 + (cb >> 6)] = q;
            }
            epi_store_rows(wl, acc, fr, fq, lane, [&](int row) { return Z1 + (size_t)(r0 + row) * Z1P + cb; });
        } else if (cb == 768) {
#pragma unroll
            for (int m = 0; m < 4; ++m) {
                const int pos = ri0.pos + m * 16 + fr;
#pragma unroll
                for (int n = 0; n < 2; ++n)
#pragma unroll
                    for (int j = 0; j < 4; ++j) {
                        const float x1 = acc[m][n][j], x2 = acc[m][n + 2][j];
                        if (ri0.lat) { const f32x2 cs = rope[(size_t)pos * 32 + n * 16 + fq * 4 + j]; acc[m][n][j] = x1 * cs.x - x2 * cs.y; acc[m][n + 2][j] = x2 * cs.x + x1 * cs.y; }
                    }
                asm volatile("" ::: "memory");
            }
            bf16* dst = KM + ((size_t)(ri0.b * 8) * NKEY + ri0.kq) * 192 + 128;
            epi_store_rows(wl, acc, fr, fq, lane, [&](int row) { return dst + (size_t)row * 192; }, 8, (size_t)NKEY * 192);
        }
    };
    gemm_tiles<true>(lds, vcu_id(), NTM * NTN, gridDim.x, make, epi);
}

__device__ __forceinline__ void ph_mla_up(const Params& p, LAS unsigned char* lds) {
    unsigned char* ws = p.ws;
    const bf16* Z1 = (const bf16*)(ws + A1_Z1); const bf16* WQ = (const bf16*)(ws + OFF_W_UQ); const bf16* WKV = (const bf16*)(ws + OFF_W_UKV);
    bf16* QM = (bf16*)(ws + A1_QM); bf16* KM = (bf16*)(ws + A1_KM); bf16* VTM = (bf16*)(ws + A1_VTM);
    const f32x2* rope = (const f32x2*)(ws + OFF_ROPE);
    const int tid = threadIdx.x, lane = tid & 63, wid = tid >> 6, wr = wid >> 1, wc = wid & 1, fr = lane & 15, fq = lane >> 4;
    LAS float* rsb = (LAS float*)(lds + 66560);
    constexpr int NQ = (TL / 128) * 12, NKV = (TT / 128) * 16;
    constexpr float QSCALE = 0.07216878364870322f * LOG2E;
    auto decode = [&](int t, bool& isq, int& tm, int& tn) { isq = t < NQ; if (isq) { tile_mn(t, TL / 128, 12, tm, tn); tm += 4; } else tile_mn(t - NQ, TT / 128, 16, tm, tn); };
    auto make = [&](int t, GPtrs& g, int& nk) {
        bool isq; int tm, tn; decode(t, isq, tm, tn);
        const int brow = tm * 128, bcol = tn * 128, K = isq ? 512 : 256, acol = isq ? 0 : 512;
        const int par = ((t - vcu_id()) / (int)gridDim.x) & 1;
        if (tid < 128) {
            const float* q = (const float*)(ws + OFF_SSQ) + (size_t)(brow + tid) * 12;
            float ss;
            if (isq) { const f32x4 a = *(const f32x4*)q, b2 = *(const f32x4*)(q + 4); ss = ((a.x + a.y) + (a.z + a.w)) + ((b2.x + b2.y) + (b2.z + b2.w)); }
            else { const f32x4 a = *(const f32x4*)(q + 8); ss = (a.x + a.y) + (a.z + a.w); }
            rsb[par * 128 + tid] = rsqrtf(ss / (float)K + RMS_EPS);
        }
        plain_ptrs(Z1 + acol, brow, Z1P, g.a); plain_ptrs(isq ? WQ : WKV, bcol, K, g.b); nk = K / 64;
    };
    auto epi = [&](int t, f32x4 (&acc)[4][4]) {
        bool isq; int tm, tn; decode(t, isq, tm, tn);
        const int brow = tm * 128, bcol = tn * 128;
        const int par = ((t - vcu_id()) / (int)gridDim.x) & 1;
        const int cb = bcol + wc * 64;
        LAS unsigned char* wl = lds + 32768 + wid * 8192;
        const int r0 = brow + wr * 64;
        const RowInfo ri0 = rowinfo(r0);
        if (isq) {
            const int h = cb / 192, part = (cb % 192) >> 6;
#pragma unroll
            for (int m = 0; m < 4; ++m) {
                const float sc = rsb[par * 128 + wr * 64 + m * 16 + fr] * QSCALE;
                const int pos = ri0.pos + m * 16 + fr;
                if (part < 2) {
#pragma unroll
                    for (int n = 0; n < 4; ++n) acc[m][n] = acc[m][n] * sc;
                } else {
#pragma unroll
                    for (int n = 0; n < 2; ++n)
#pragma unroll
                        for (int j = 0; j < 4; ++j) {
                            const float x1 = acc[m][n][j] * sc, x2 = acc[m][n + 2][j] * sc;
                            const f32x2 cs = rope[(size_t)pos * 32 + n * 16 + fq * 4 + j];
                            acc[m][n][j] = x1 * cs.x - x2 * cs.y; acc[m][n + 2][j] = x2 * cs.x + x1 * cs.y;
                        }
                }
                asm volatile("" ::: "memory");
            }
            bf16* dst = QM + ((size_t)(ri0.b * 8 + h) * SEQ + ri0.pos) * 192 + part * 64;
            epi_store_rows(wl, acc, fr, fq, lane, [&](int row) { return dst + (size_t)row * 192; });
        } else {
            const int h = cb >> 8, part = (cb & 255) >> 6;
#pragma unroll
            for (int m = 0; m < 4; ++m) {
                const float rs = rsb[par * 128 + wr * 64 + m * 16 + fr];
#pragma unroll
                for (int n = 0; n < 4; ++n) acc[m][n] = acc[m][n] * rs;
            }
            if (part < 2) {
                bf16* dst = KM + ((size_t)(ri0.b * 8 + h) * NKEY + ri0.kq) * 192 + part * 64;
                epi_store_rows(wl, acc, fr, fq, lane, [&](int row) { return dst + (size_t)row * 192; });
            } else {
                bf16* dst = VTM + ((size_t)(ri0.b * 8 + h) * 128 + (part - 2) * 64) * NKEY + ri0.kq;
                epi_store_cols(wl, acc, fr, fq, lane, [&](int col) { return dst + (size_t)col * NKEY; });
            }
        }
    };
    gemm_tiles<true>(lds, vcu_id(), NQ + NKV, gridDim.x, make, epi);
}

__device__ __forceinline__ void ph_mla_attn(const Params& p, LAS unsigned char* lds) {
    unsigned char* ws = p.ws;
    const bf16* QM = (const bf16*)(ws + A1_QM); const bf16* KM = (const bf16*)(ws + A1_KM); const bf16* VTM = (const bf16*)(ws + A1_VTM); bf16* MIX = (bf16*)(ws + A1_MIX);
    for (int item = vcu_id(); item < 2 * 8 * 64; item += gridDim.x) {
        const int qt = item & 63, h = (item >> 6) & 7, b = item >> 9;
        const bf16* Qg = QM + ((size_t)(b * 8 + h) * SEQ + qt * 128) * 192;
        const bf16* Kg = KM + (size_t)(b * 8 + h) * NKEY * 192;
        const bf16* Vg = VTM + (size_t)(b * 8 + h) * 128 * NKEY;
        attn_item<192, 128>(lds, Qg, Kg, Vg, NKEY / 64, 0, 0, 0, -1e30f, 0.f, MIX + (size_t)(TC + b * SEQ + qt * 128) * DM + h * 128, DM);
    }
}


#define XB_TMO      128
#define XB_XCNT(j)  (256  + 64 * (j))
#define XB_XSUB(j)  (1280 + 64 * (j))
#define XB_XGEN(j)  (2304 + 64 * (j))
#define XB_TOP      3328
#define XB_TOPGEN   3392
#define XCD_BAR_WORDS 3456
#define XB_SPIN_CAP (1u << 18)
__device__ __forceinline__ unsigned xb_ld(unsigned* p)              { return __hip_atomic_load(p, __ATOMIC_RELAXED, __HIP_MEMORY_SCOPE_AGENT); }
__device__ __forceinline__ unsigned xb_add(unsigned* p, unsigned v) { return __hip_atomic_fetch_add(p, v, __ATOMIC_RELAXED, __HIP_MEMORY_SCOPE_AGENT); }
__device__ __forceinline__ unsigned xb_xcc_id() { return (unsigned)__builtin_amdgcn_s_getreg((3 << 11) | 20) & 0xFu; }
#define XB_SPIN(cond, bar) do { unsigned _sp = 0; while (cond) { __builtin_amdgcn_s_sleep(1); \
    if ((++_sp & 255u) == 0u) { if (xb_ld(&(bar)[XB_TMO])) break; if (_sp > XB_SPIN_CAP) { atomicAdd(&(bar)[XB_TMO], 1u); break; } } } } while (0)
struct XcdBarrier { unsigned* bar; unsigned x; volatile LAS unsigned* st; };
__device__ __forceinline__ XcdBarrier xcd_barrier_post(unsigned* bar, volatile LAS unsigned* st) {
    XcdBarrier b; b.bar = bar; b.x = xb_xcc_id(); b.st = st;
    if (threadIdx.x == 0) (void)xb_add(&bar[XB_XCNT(b.x)], 1u);
    return b;
}
__device__ __forceinline__ void xcd_barrier_complete(unsigned* bar, unsigned x, unsigned& nloc, unsigned& nx) {
    const unsigned G = gridDim.x * gridDim.y * gridDim.z;
    unsigned sum, cnt, mine, sp = 0u;
    for (;;) {
        sum = 0u; cnt = 0u; mine = 0u;
#pragma unroll
        for (unsigned j = 0; j < 16; ++j) { const unsigned c = xb_ld(&bar[XB_XCNT(j)]); sum += c; cnt += (c > 0u) ? 1u : 0u; mine = (j == x) ? c : mine; }
        if (sum == G) break;
        __builtin_amdgcn_s_sleep(1);
        if ((++sp & 255u) == 0u) { if (xb_ld(&bar[XB_TMO])) break; if (sp > XB_SPIN_CAP) { atomicAdd(&bar[XB_TMO], 1u); break; } }
    }
    nloc = mine > 0u ? mine : 1u; nx = cnt > 0u ? cnt : 1u;
}
__device__ __forceinline__ void xcd_barrier(const XcdBarrier& b) {
    asm volatile("s_waitcnt vmcnt(0)" ::: "memory");
    __syncthreads();
    if (threadIdx.x == 0) {
        unsigned* bar = b.bar;
        __builtin_amdgcn_s_waitcnt(0);
        unsigned nloc = b.st[0], nx = b.st[1];
        if (nloc == 0u) { xcd_barrier_complete(bar, b.x, nloc, nx); b.st[0] = nloc; b.st[1] = nx; }
        const unsigned old = xb_add(&bar[XB_XSUB(b.x)], 1u);
        const unsigned gen = old / nloc;
        if (old + 1u == (gen + 1u) * nloc) {
            __builtin_amdgcn_fence(__ATOMIC_RELEASE, "agent");
            asm volatile("s_waitcnt vmcnt(0)" ::: "memory");
            const unsigned og = xb_add(&bar[XB_TOP], 1u);
            const unsigned tg = og / nx;
            if (og + 1u == (tg + 1u) * nx) xb_add(&bar[XB_TOPGEN], 1u);
            else XB_SPIN(xb_ld(&bar[XB_TOPGEN]) == tg, bar);
            __builtin_amdgcn_fence(__ATOMIC_ACQUIRE, "agent");
            xb_add(&bar[XB_XGEN(b.x)], 1u);
            asm volatile("s_waitcnt vmcnt(0)" ::: "memory");
        } else {
            XB_SPIN(xb_ld(&bar[XB_XGEN(b.x)]) == gen, bar);
            __builtin_amdgcn_fence(__ATOMIC_ACQUIRE, "agent");
            asm volatile("s_waitcnt vmcnt(0)" ::: "memory");
        }
    }
    __syncthreads();
}
static_assert(XCD_BAR_WORDS * 4 <= BAR_BYTES, "barrier words");

__device__ __forceinline__ void convert_shared(const Params& p, LAS unsigned char* lds, int l, int nrt) {
    const int v = vcu_id(), G = gridDim.x, nfree = G - nrt, nslots = 2 * nfree + nrt;
    if (v >= nrt) {
        const int j = v - nrt;
        for (int it = 2 * j; it < EXP_ITEMS; it += nslots) expert_convert_item(p, lds, l, it);
        for (int it = 2 * j + 1; it < EXP_ITEMS; it += nslots) expert_convert_item(p, lds, l, it);
    } else {
        for (int it = 2 * nfree + v; it < EXP_ITEMS; it += nslots) expert_convert_item(p, lds, l, it);
    }
}

constexpr int NPHASE = 19;
__global__ void __launch_bounds__(256, 2) mega(Params p) {
    extern __shared__ __attribute__((aligned(16))) unsigned char lds_[];
    LAS unsigned char* lds = (LAS unsigned char*)lds_;
    cg::grid_group grid = cg::this_grid();
    unsigned char* ws = p.ws;
    volatile LAS unsigned* bst = (volatile LAS unsigned*)(lds + LDS_BYTES - 16);
    if (threadIdx.x < 4) bst[threadIdx.x] = 0u;
    __syncthreads();
    const XcdBarrier xbar = xcd_barrier_post((unsigned*)(ws + OFF_BAR), bst);
#define GRID_BAR(k) do { if ((k) == 0) grid.sync(); else xcd_barrier(xbar); } while (0)
#ifndef PROBE_REP_MASK
#define PROBE_REP_MASK 0u
#endif
#ifndef PROBE_EXTRA_SYNCS
#define PROBE_EXTRA_SYNCS 0
#endif
#define PHASE(k, body) do { if (p.ph_lo <= (k) && (k) < p.ph_hi) { body; if ((PROBE_REP_MASK >> (k)) & 1u) { xcd_barrier(xbar); body; } if ((k) + 1 < p.ph_hi) GRID_BAR(k); } } while (0)
    for (int i = 0; i < PROBE_EXTRA_SYNCS; ++i) xcd_barrier(xbar);
    PHASE(0, ph_prep(p, lds));
    PHASE(1, ph_modulate0(p));
    PHASE(2, ph_inproj0(p, lds));
    PHASE(3, ph_swa_g1(p, lds));
    PHASE(4, ph_gla_scan(p));
    PHASE(5, ph_gla_g3(p, lds));
    PHASE(6, ph_outproj(p, lds, (const bf16*)(ws + A0_MIX), (const bf16*)(ws + OFF_W_OUT_E), (float*)(ws + A0_Y), 0));
    PHASE(7, ph_rowpassA(p, 0, 0, (const float*)(ws + A0_Y)));
    PHASE(8, { ph_router(p, lds, 0, 0); __syncthreads(); convert_shared(p, lds, 0, TT / 128); });
    PHASE(9, ph_moe1(p, lds, 0, 0));
    PHASE(10, ph_moe2(p, lds, 0, 0));
    PHASE(11, ph_rowpassB(p, lds, 0, 0));
    PHASE(12, ph_inproj1(p, lds));
    PHASE(13, ph_mla_up(p, lds));
    PHASE(14, ph_mla_attn(p, lds));
    PHASE(15, ph_outproj(p, lds, (const bf16*)(ws + A1_MIX), (const bf16*)(ws + OFF_W_OUT_O), (float*)(ws + A1_Y), TC));
    PHASE(16, ph_rowpassA(p, 1, TC, (const float*)(ws + A1_Y)));
    PHASE(17, { ph_router(p, lds, 1, TC); __syncthreads(); convert_shared(p, lds, 1, TL / 128); });
    PHASE(18, ph_moe1(p, lds, 1, TC));
    PHASE(19, ph_moe2(p, lds, 1, TC));
    PHASE(20, ph_rowpassB(p, lds, 1, TC));
}

extern "C" void kernel_launch(void* const* d_in, const int* in_sizes, int n_in, void* d_out, int out_size, void* d_ws, size_t ws_size, hipStream_t stream) {
    static int grid_blocks = 0;
    if (!grid_blocks) {
        int dev = 0, cus = 0, per_cu = 0;
        (void)hipGetDevice(&dev);
        (void)hipDeviceGetAttribute(&cus, hipDeviceAttributeMultiprocessorCount, dev);
        (void)hipFuncSetAttribute((const void*)mega, hipFuncAttributeMaxDynamicSharedMemorySize, LDS_BYTES);
        (void)hipOccupancyMaxActiveBlocksPerMultiprocessor(&per_cu, (const void*)mega, 256, LDS_BYTES);
        if (per_cu > 2) per_cu = 2;
        if (per_cu < 1) per_cu = 1;
        grid_blocks = cus * per_cu;
        if (ws_size < WS_NEED) fprintf(stderr, "kernel_launch: workspace too small: %zu < %zu\n", ws_size, (size_t)WS_NEED);
    }
    Params p{};
    const float** f = (const float**)&p;
    for (int i = 0; i < 30; ++i) f[i] = (const float*)d_in[i];
    p.out = (float*)d_out; p.ws = (unsigned char*)d_ws; p.ph_lo = 0; p.ph_hi = 21;
    (void)hipMemsetAsync((unsigned char*)d_ws + OFF_BAR, 0, BAR_BYTES, stream);
    void* args[] = {&p};
    hipError_t e = hipLaunchCooperativeKernel((const void*)mega, dim3(grid_blocks), dim3(256), args, LDS_BYTES, stream);
    if (e != hipSuccess) fprintf(stderr, "cooperative launch failed: %s (grid %d)\n", hipGetErrorString(e), grid_blocks);
}
```

```cpp
#include <hip/hip_runtime.h>
#include <hip/hip_cooperative_groups.h>
#include <cstdio>
#include <cstdint>
namespace cg = cooperative_groups;

#define LAS __attribute__((address_space(3)))
typedef unsigned short bf16;
typedef short bf16x8 __attribute__((ext_vector_type(8)));
typedef float f32x2 __attribute__((ext_vector_type(2)));
typedef float f32x4 __attribute__((ext_vector_type(4)));
typedef float f32x8 __attribute__((ext_vector_type(8)));
typedef float f32x16 __attribute__((ext_vector_type(16)));
typedef unsigned u32x2 __attribute__((ext_vector_type(2)));
typedef unsigned u32x4 __attribute__((ext_vector_type(4)));
typedef __bf16 bf16x2_t __attribute__((ext_vector_type(2)));

constexpr int DM = 1024, NB = 2, SEQ = 8192, CTX = 256;
constexpr int TC = NB * CTX, TL = NB * SEQ, TT = TC + TL, NKEY = CTX + SEQ;
constexpr int NEXP = 64;
constexpr float RMS_EPS = 1e-6f;
constexpr int E_IN_PAD = 2432, O_IN_PAD = 896;
constexpr float LOG2E = 1.4426950408889634f;
constexpr int NSTEP = 132;
constexpr int Z0P = 1056;
constexpr int Z1P = 768;
constexpr int LDS_BYTES = 73728;

constexpr size_t al(size_t x) { return (x + 255) & ~(size_t)255; }
constexpr size_t OFF_W_IN_E = 0;
constexpr size_t OFF_W_OUT_E = OFF_W_IN_E + al((size_t)E_IN_PAD * DM * 2);
constexpr size_t OFF_W_IN_O = OFF_W_OUT_E + al((size_t)DM * DM * 2);
constexpr size_t OFF_W_UQ = OFF_W_IN_O + al((size_t)O_IN_PAD * DM * 2);
constexpr size_t OFF_W_UKV = OFF_W_UQ + al((size_t)1536 * 512 * 2);
constexpr size_t OFF_W_OUT_O = OFF_W_UKV + al((size_t)2048 * 256 * 2);
constexpr size_t OFF_W_RT = OFF_W_OUT_O + al((size_t)DM * DM * 2);
constexpr size_t OFF_W_GU = OFF_W_RT + al((size_t)2 * 128 * DM * 2);
constexpr size_t OFF_W_D = OFF_W_GU + al((size_t)65 * 512 * DM * 2);
constexpr size_t OFF_U = OFF_W_D + al((size_t)65 * DM * 256 * 2);
constexpr size_t OFF_HC = OFF_U + al((size_t)TT * DM * 2);
constexpr size_t OFF_MOD = OFF_HC + al((size_t)TC * DM * 4);
constexpr size_t OFF_ROPE = OFF_MOD + al((size_t)2 * 3 * 6144 * 4);
constexpr size_t OFF_CNT = OFF_ROPE + al((size_t)SEQ * 32 * 8);
constexpr size_t OFF_TOKSLOT = OFF_CNT + al(2 * 64 * 4);
constexpr size_t OFF_W8 = OFF_TOKSLOT + al((size_t)TT * 8 * 4);
constexpr size_t OFF_LIST = OFF_W8 + al((size_t)TT * 8 * 4);
constexpr size_t OFF_SSQ = OFF_LIST + al((size_t)64 * TT * 4);
constexpr size_t OFF_DUMP = OFF_SSQ + al((size_t)TT * 12 * 4);
constexpr size_t OFF_BAR = OFF_DUMP + 8192;
constexpr size_t BAR_BYTES = 16384;
constexpr size_t OFF_ARENA = OFF_BAR + BAR_BYTES;
constexpr size_t A0_Z0 = OFF_ARENA;
constexpr size_t A0_VGT = A0_Z0 + al((size_t)TT * Z0P * 2);
constexpr size_t A0_QS = A0_VGT + al((size_t)4 * 128 * TT * 2);
constexpr size_t A0_KS = A0_QS + al((size_t)2 * 8 * NKEY * 64 * 2);
constexpr size_t A0_VST = A0_KS + al((size_t)2 * 2 * NKEY * 64 * 2);
constexpr size_t A0_GS = A0_VST + al((size_t)2 * 2 * 64 * NKEY * 2);
constexpr size_t A0_GD = A0_GS + al((size_t)16 * NSTEP * 8192 * 4);
constexpr size_t A0_MIX = A0_GD + al((size_t)16 * NSTEP * 64 * 4);
constexpr size_t A0_Y = A0_MIX + al((size_t)TT * DM * 2);
constexpr size_t A0_END = A0_Y + al((size_t)TT * DM * 4);
constexpr size_t A1_Z1 = OFF_ARENA;
constexpr size_t A1_QM = A1_Z1 + al((size_t)TT * Z1P * 2);
constexpr size_t A1_KM = A1_QM + al((size_t)2 * 8 * SEQ * 192 * 2);
constexpr size_t A1_VTM = A1_KM + al((size_t)2 * 8 * NKEY * 192 * 2);
constexpr size_t A1_MIX = A1_VTM + al((size_t)2 * 8 * 128 * NKEY * 2);
constexpr size_t A1_Y = A1_MIX + al((size_t)TT * DM * 2);
constexpr size_t A1_END = A1_Y + al((size_t)TT * DM * 4);
constexpr size_t AM_U8 = OFF_ARENA;
constexpr size_t AM_HM = AM_U8 + al((size_t)TT * 1024);
constexpr size_t AM_YR = AM_HM + al((size_t)TT * 9 * 256);
constexpr size_t AM_END = AM_YR + al((size_t)TT * 9 * 1024 * 2);
constexpr size_t WS_NEED = AM_END > A0_END ? (AM_END > A1_END ? AM_END : A1_END) : (A0_END > A1_END ? A0_END : A1_END);
static_assert(WS_NEED <= 555747360ull, "workspace map exceeds the guaranteed d_ws size");

struct Params {
    const float *x, *c, *ctx, *c_ctx, *w_mod, *b_mod, *g_mix_pre, *g_mix_post, *g_ffn_pre, *g_ffn_post;
    const float *w_in_e, *gla_wa2, *gla_ba, *gla_norm, *swa_sink, *w_out_e;
    const float *w_in_o, *mla_q_norm, *mla_kv_norm, *w_uq, *w_ukv, *w_out_o;
    const float *w_router, *b_router, *w_exp_gate, *w_exp_up, *w_exp_down, *w_sh_gate, *w_sh_up, *w_sh_down;
    float* out; unsigned char* ws; int ph_lo, ph_hi;
};

__device__ __forceinline__ unsigned pk2(float lo, float hi) { f32x2 v = {lo, hi}; bf16x2_t b = __builtin_convertvector(v, bf16x2_t); return __builtin_bit_cast(unsigned, b); }
__device__ __forceinline__ float bflo(unsigned u) { return __uint_as_float(u << 16); }
__device__ __forceinline__ float bfhi(unsigned u) { return __uint_as_float(u & 0xffff0000u); }
__device__ __forceinline__ float bf2f(bf16 v) { return __uint_as_float((unsigned)v << 16); }
__device__ __forceinline__ bf16 f2bf(float f) { return (bf16)(pk2(f, 0.f) & 0xffffu); }
constexpr float W8SC = 64.f, H8SC = 4.f, Y8SC = 16.f;
__device__ __forceinline__ unsigned pk4_fp8(float a, float b, float c, float d) { int w = 0; w = __builtin_amdgcn_cvt_pk_fp8_f32(a, b, w, false); w = __builtin_amdgcn_cvt_pk_fp8_f32(c, d, w, true); return (unsigned)w; }
__device__ __forceinline__ float wave_sum(float v) {
#pragma unroll
    for (int o = 1; o < 64; o <<= 1) v += __shfl_xor(v, o);
    return v;
}
__device__ __forceinline__ void glds16(const void* g, LAS void* l) { __builtin_amdgcn_global_load_lds((const unsigned*)g, (LAS unsigned*)l, 16, 0, 0); }
__device__ __forceinline__ float siluf(float x) { return x / (1.f + __expf(-x)); }
__device__ __forceinline__ float ex2(float x) { return __builtin_amdgcn_exp2f(x); }
__device__ __forceinline__ int crow(int r, int hi) { return (r & 3) + 8 * (r >> 2) + 4 * hi; }
__device__ __forceinline__ bf16x8 mk8(u32x4 v) { return __builtin_bit_cast(bf16x8, v); }

struct RowInfo { int b, kq, pos; bool lat; };
__device__ __forceinline__ RowInfo rowinfo(int r) {
    RowInfo i;
    if (r < TC) { i.b = r >> 8; i.pos = r & 255; i.kq = i.pos; i.lat = false; }
    else { const int rl = r - TC; i.b = rl >> 13; i.pos = rl & (SEQ - 1); i.kq = CTX + i.pos; i.lat = true; }
    return i;
}
__device__ __forceinline__ int modvec(int r) { return r < TC ? 2 : ((r - TC) >> 13); }

struct GPtrs { const bf16* a[4]; const bf16* b[4]; };
constexpr int G_STAGE = 32768;
#define G_FENCE() asm volatile("" ::: "memory")
__device__ __forceinline__ void gemm_issue(LAS unsigned char* lds, const GPtrs& g, int kt) {
    LAS unsigned char* d = lds + (kt & 1) * G_STAGE + threadIdx.x * 16; const int ko = kt * 64;
#pragma unroll
    for (int i = 0; i < 4; ++i) { glds16(g.a[i] + ko, d + i * 4096); glds16(g.b[i] + ko, d + 16384 + i * 4096); }
}
__device__ __forceinline__ void gemm_prologue(LAS unsigned char* lds, const GPtrs& g, int nk) { gemm_issue(lds, g, 0); }
__device__ __forceinline__ void gemm_prologue2(LAS unsigned char* lds, const GPtrs& g) { gemm_issue(lds, g, 0); gemm_issue(lds, g, 1); }
template <int NST, bool FP8 = false, bool PRE2 = false>
__device__ __forceinline__ void gemm_main(LAS unsigned char* lds, const GPtrs& g, int nk, f32x4 (&acc)[4][4], bool after_epi) {
    const int tid = threadIdx.x, lane = tid & 63, wid = tid >> 6, wr = wid >> 1, wc = wid & 1, fr = lane & 15, fq = lane >> 4;
#pragma unroll
    for (int m = 0; m < 4; ++m)
#pragma unroll
        for (int n = 0; n < 4; ++n) acc[m][n] = (f32x4){0.f, 0.f, 0.f, 0.f};
    const int c0 = ((fq) ^ (fr & 7)) * 16, c1 = ((4 + fq) ^ (fr & 7)) * 16;
    const int aoff = (wr * 64 + fr) * 128, boff = 16384 + (wc * 64 + fr) * 128;
    for (int kt = 0; kt < nk; ++kt) {
        if (PRE2) {
            static_assert(!PRE2 || NST == 4 || NST < 0, "PRE2 counted waits are written for 4 epilogue stores");
            if (kt == 0) { if (after_epi) asm volatile("s_waitcnt vmcnt(12) lgkmcnt(0)" ::: "memory"); else asm volatile("s_waitcnt vmcnt(8) lgkmcnt(0)" ::: "memory"); }
            else { if (after_epi) asm volatile("s_waitcnt vmcnt(4) lgkmcnt(0)" ::: "memory"); else asm volatile("s_waitcnt vmcnt(0) lgkmcnt(0)" ::: "memory"); }
        } else
        if (NST == 8 && kt == 0 && after_epi) asm volatile("s_waitcnt vmcnt(8) lgkmcnt(0)" ::: "memory");
        else if (NST == 16 && kt == 0 && after_epi) asm volatile("s_waitcnt vmcnt(16) lgkmcnt(0)" ::: "memory");
        else asm volatile("s_waitcnt vmcnt(0) lgkmcnt(0)" ::: "memory");
        __builtin_amdgcn_s_barrier();
        G_FENCE();
        if (!PRE2 && kt + 1 < nk) gemm_issue(lds, g, kt + 1);
        LAS unsigned char* base = lds + (kt & 1) * G_STAGE;
        if constexpr (FP8) {
            long a8[4][4], b8[4][4];
#pragma unroll
            for (int ks = 0; ks < 4; ++ks) {
                const int co = (((ks * 2 + (fq >> 1)) ^ (fr & 7)) * 16) + (fq & 1) * 8;
#pragma unroll
                for (int m = 0; m < 4; ++m) a8[ks][m] = *(const LAS long*)(base + aoff + m * 2048 + co);
#pragma unroll
                for (int n = 0; n < 4; ++n) b8[ks][n] = *(const LAS long*)(base + boff + n * 2048 + co);
            }
            __builtin_amdgcn_s_setprio(1);
#pragma unroll
            for (int ks = 0; ks < 4; ++ks)
#pragma unroll
                for (int m = 0; m < 4; ++m)
#pragma unroll
                    for (int n = 0; n < 4; ++n) acc[m][n] = __builtin_amdgcn_mfma_f32_16x16x32_fp8_fp8(b8[ks][n], a8[ks][m], acc[m][n], 0, 0, 0);
            __builtin_amdgcn_s_setprio(0);
            continue;
        }
        bf16x8 af0[4], bf0[4], af1[4], bf1[4];
#pragma unroll
        for (int m = 0; m < 4; ++m) af0[m] = *(const LAS bf16x8*)(base + aoff + m * 2048 + c0);
#pragma unroll
        for (int n = 0; n < 4; ++n) bf0[n] = *(const LAS bf16x8*)(base + boff + n * 2048 + c0);
#pragma unroll
        for (int m = 0; m < 4; ++m) af1[m] = *(const LAS bf16x8*)(base + aoff + m * 2048 + c1);
#pragma unroll
        for (int n = 0; n < 4; ++n) bf1[n] = *(const LAS bf16x8*)(base + boff + n * 2048 + c1);
        __builtin_amdgcn_s_setprio(1);
#pragma unroll
        for (int m = 0; m < 4; ++m)
#pragma unroll
            for (int n = 0; n < 4; ++n) acc[m][n] = __builtin_amdgcn_mfma_f32_16x16x32_bf16(bf0[n], af0[m], acc[m][n], 0, 0, 0);
#pragma unroll
        for (int m = 0; m < 4; ++m)
#pragma unroll
            for (int n = 0; n < 4; ++n) acc[m][n] = __builtin_amdgcn_mfma_f32_16x16x32_bf16(bf1[n], af1[m], acc[m][n], 0, 0, 0);
        __builtin_amdgcn_s_setprio(0);
    }
    asm volatile("s_waitcnt lgkmcnt(0)" ::: "memory");
    __builtin_amdgcn_s_barrier();
    G_FENCE();
}
__device__ __forceinline__ int vcu_id() { const int b = blockIdx.x, G = gridDim.x; return (G % 8 == 0) ? (b % 8) * (G / 8) + b / 8 : b; }
__device__ __forceinline__ void tile_mn(int w, int ntm, int ntn, int& tm, int& tn) {
    const int nig = 8 * ntn, gid = w / nig, fm = gid * 8, gsz = (ntm - fm) < 8 ? (ntm - fm) : 8, within = w - gid * nig;
    tm = fm + within % gsz; tn = within / gsz;
}
template <bool PREFETCH_NEXT, int NST = -1, bool FP8 = false, bool PRE2 = false, class Make, class Epi>
__device__ __forceinline__ void gemm_tiles(LAS unsigned char* lds, int t0, int nt, int stride, Make make, Epi epi) {
    if (t0 >= nt) return;
    GPtrs g; int nk;
    make(t0, g, nk);
    G_FENCE();
    if (PRE2) gemm_prologue2(lds, g); else gemm_prologue(lds, g, nk);
    bool first = true;
    for (int t = t0; t < nt;) {
        const int tn = t + stride;
        f32x4 acc[4][4];
        gemm_main<PREFETCH_NEXT ? NST : -1, FP8, PRE2>(lds, g, nk, acc, !first);
        first = false;
        if (PREFETCH_NEXT) { if (tn < nt) { make(tn, g, nk); G_FENCE(); if (PRE2) gemm_prologue2(lds, g); else gemm_prologue(lds, g, nk); } epi(t, acc); }
        else { epi(t, acc); __syncthreads(); if (tn < nt) { make(tn, g, nk); G_FENCE(); gemm_prologue(lds, g, nk); } }
        t = tn;
    }
}

template <class RowPtr>
__device__ __forceinline__ void epi_store_rows(LAS unsigned char* wl, const f32x4 (&v)[4][4], int fr, int fq, int lane, RowPtr rowptr, int nrep = 1, size_t rep_stride = 0) {
#pragma unroll
    for (int m = 0; m < 4; ++m)
#pragma unroll
        for (int n = 0; n < 4; ++n)
            *(LAS u32x2*)(wl + (m * 16 + fr) * 128 + (((n * 2 + (fq >> 1)) ^ (fr & 7)) * 16) + (fq & 1) * 8) = (u32x2){pk2(v[m][n][0], v[m][n][1]), pk2(v[m][n][2], v[m][n][3])};
#pragma unroll
    for (int i = 0; i < 8; ++i) {
        const int row = (lane >> 3) + 8 * i, pos = lane & 7;
        const u32x4 w = *(const LAS u32x4*)(wl + row * 128 + pos * 16);
        bf16* d = rowptr(row);
        if (d) { d += (pos ^ (row & 7)) * 8; for (int r = 0; r < nrep; ++r) *(u32x4*)(d + (size_t)r * rep_stride) = w; }
    }
}
template <class ColPtr>
__device__ __forceinline__ void epi_store_cols(LAS unsigned char* wl, const f32x4 (&v)[4][4], int fr, int fq, int lane, ColPtr colptr) {
    LAS unsigned char* wb = wl + fq * 512 + fr * 2;
#pragma unroll
    for (int m = 0; m < 4; ++m)
#pragma unroll
        for (int n = 0; n < 4; ++n)
#pragma unroll
            for (int j = 0; j < 4; ++j) *(LAS bf16*)(wb + n * 2048 + j * 128 + m * 32) = f2bf(v[m][n][j]);
#pragma unroll
    for (int i = 0; i < 8; ++i) {
        const int col = (lane >> 3) + 8 * i, pos = lane & 7;
        const u32x4 w = *(const LAS u32x4*)(wl + col * 128 + pos * 16);
        bf16* d = colptr(col);
        *(u32x4*)(d + pos * 8) = w;
    }
}

__device__ __forceinline__ int ein_map(int n) {
    if (n < 512) return n;
    if (n < 1024) return n + 512;
    if (n < 1536) return n - 512;
    if (n < 2048) return 1568 + (n - 1536);
    if (n < 2176) return 2080 + (n - 2048);
    if (n < 2304) return 2208 + (n - 2176);
    if (n < 2320) return 1536 + (n - 2304);
    if (n < 2336) return 1552 + (n - 2320);
    return -1;
}
template <bool FP8 = false>
__device__ __forceinline__ void transpose_item(LAS unsigned char* lds, int K, bf16* dst, int k0, int n0, int ld, int mode, const float* srcA, const float* srcB, int nvalid, const float* kscale) {
    LAS float* tile = (LAS float*)lds;
    const int tid = threadIdx.x;
    {
        const int nq = tid & 31, kr = tid >> 5, n = n0 + nq * 4;
        const float* cp = nullptr; float sc = 1.f;
        if (mode == 0) { if (n < nvalid) cp = srcA + n; }
        else if (mode == 1) { const int c = ein_map(n); if (c >= 0) cp = srcA + c; if (n < 256) sc = 0.125f; }
        else if (mode == 2) { const int grp = n >> 6, w = n & 63; cp = (w < 32 ? srcA : srcB) + grp * 32 + (w & 31); }
        else { const int b6 = n & 63; cp = srcA + (n & ~63) + ((b6 >> 2) & 3) * 16 + (b6 >> 4) * 4; }
        f32x4 v[8];
#pragma unroll
        for (int i = 0; i < 8; ++i) { const int k = kr + 8 * i; v[i] = cp ? *(const f32x4*)(cp + (size_t)(k0 + k) * ld) : (f32x4){0.f, 0.f, 0.f, 0.f}; }
#pragma unroll
        for (int i = 0; i < 8; ++i) { const int k = kr + 8 * i; float m = sc; if (kscale) m *= kscale[k0 + k]; *(LAS f32x4*)(tile + k * 132 + nq * 4) = v[i] * m; }
    }
    __syncthreads();
    {
        const int n = tid >> 1, hf = tid & 1;
        if constexpr (FP8) {
            unsigned char* d8 = (unsigned char*)dst;
#pragma unroll
            for (int c = 0; c < 2; ++c) {
                const int k16 = hf * 32 + c * 16;
                u32x4 o;
                o.x = pk4_fp8(tile[(k16 + 0) * 132 + n] * W8SC, tile[(k16 + 1) * 132 + n] * W8SC, tile[(k16 + 2) * 132 + n] * W8SC, tile[(k16 + 3) * 132 + n] * W8SC);
                o.y = pk4_fp8(tile[(k16 + 4) * 132 + n] * W8SC, tile[(k16 + 5) * 132 + n] * W8SC, tile[(k16 + 6) * 132 + n] * W8SC, tile[(k16 + 7) * 132 + n] * W8SC);
                o.z = pk4_fp8(tile[(k16 + 8) * 132 + n] * W8SC, tile[(k16 + 9) * 132 + n] * W8SC, tile[(k16 + 10) * 132 + n] * W8SC, tile[(k16 + 11) * 132 + n] * W8SC);
                o.w = pk4_fp8(tile[(k16 + 12) * 132 + n] * W8SC, tile[(k16 + 13) * 132 + n] * W8SC, tile[(k16 + 14) * 132 + n] * W8SC, tile[(k16 + 15) * 132 + n] * W8SC);
                *(u32x4*)(d8 + (size_t)(n0 + n) * K + k0 + k16) = o;
            }
        } else
#pragma unroll
        for (int c = 0; c < 4; ++c) {
            const int k8 = hf * 32 + c * 8;
            u32x4 o;
            o.x = pk2(tile[(k8 + 0) * 132 + n], tile[(k8 + 1) * 132 + n]);
            o.y = pk2(tile[(k8 + 2) * 132 + n], tile[(k8 + 3) * 132 + n]);
            o.z = pk2(tile[(k8 + 4) * 132 + n], tile[(k8 + 5) * 132 + n]);
            o.w = pk2(tile[(k8 + 6) * 132 + n], tile[(k8 + 7) * 132 + n]);
            *(u32x4*)(dst + (size_t)(n0 + n) * K + k0 + k8) = o;
        }
    }
    __syncthreads();
}

constexpr int EXP_GU_ITEMS = 65 * 16 * 4, EXP_D_ITEMS = 65 * 4 * 8, EXP_ITEMS = EXP_GU_ITEMS + EXP_D_ITEMS;
__device__ __forceinline__ void expert_convert_item(const Params& p, LAS unsigned char* lds, int l, int it) {
    unsigned char* ws = p.ws;
    if (it < EXP_GU_ITEMS) {
        const int e = it / 64, r = it % 64, kb = r / 4, nb = r % 4;
        const float* gate = e < 64 ? p.w_exp_gate + ((size_t)(l * 64 + e)) * DM * 256 : p.w_sh_gate + (size_t)l * DM * 256;
        const float* up = e < 64 ? p.w_exp_up + ((size_t)(l * 64 + e)) * DM * 256 : p.w_sh_up + (size_t)l * DM * 256;
        transpose_item<true>(lds, DM, (bf16*)(ws + OFF_W_GU + (size_t)e * 512 * DM), kb * 64, nb * 128, 256, 2, gate, up, 512, nullptr);
    } else {
        it -= EXP_GU_ITEMS;
        const int e = it / 32, r = it % 32, kb = r / 8, nb = r % 8;
        const float* dn = e < 64 ? p.w_exp_down + ((size_t)(l * 64 + e)) * 256 * DM : p.w_sh_down + (size_t)l * 256 * DM;
        transpose_item<true>(lds, 256, (bf16*)(ws + OFF_W_D + (size_t)e * DM * 256), kb * 64, nb * 128, DM, 3, dn, nullptr, DM, nullptr);
    }
}

__device__ __forceinline__ void ph_prep(const Params& p, LAS unsigned char* lds) {
    unsigned char* ws = p.ws;
    const int tid = threadIdx.x;
    if (blockIdx.x == 0 && tid < 128) ((int*)(ws + OFF_CNT))[tid] = 0;
    constexpr int I_MOD = 96, I_ROPE = 1024, I_INE = 16 * 19, I_OUTE = 128, I_INO = 16 * 7, I_UQ = 8 * 12, I_UKV = 4 * 16, I_OUTO = 128, I_RT = 32;
    constexpr int NITEMS = I_MOD + I_ROPE + I_INE + I_OUTE + I_INO + I_UQ + I_UKV + I_OUTO + I_RT;
    for (int item = blockIdx.x; item < NITEMS; item += gridDim.x) {
        int it = item;
        if (it < I_MOD) {
            const int l = it / 48, n0 = (it % 48) * 128, kg = tid >> 5, cl = tid & 31;
            LAS float* s = (LAS float*)lds;
            LAS float* red = (LAS float*)(lds + 12288);
            for (int idx = tid; idx < 3072; idx += 256) { const int v = idx >> 10, k = idx & 1023; const float cv = v < 2 ? p.c[v * DM + k] : p.c_ctx[k]; s[idx] = cv / (1.f + expf(-cv)); }
            __syncthreads();
            f32x4 a0 = {0.f, 0.f, 0.f, 0.f}, a1 = a0, a2 = a0;
            const float* w = p.w_mod + (size_t)l * DM * 6144 + (size_t)(kg * 128) * 6144 + n0 + cl * 4;
#pragma unroll 8
            for (int k = 0; k < 128; ++k) { const f32x4 wv = *(const f32x4*)(w + (size_t)k * 6144); const int kk = kg * 128 + k; a0 += wv * s[kk]; a1 += wv * s[1024 + kk]; a2 += wv * s[2048 + kk]; }
            *(LAS f32x4*)(red + (kg * 3 + 0) * 128 + cl * 4) = a0; *(LAS f32x4*)(red + (kg * 3 + 1) * 128 + cl * 4) = a1; *(LAS f32x4*)(red + (kg * 3 + 2) * 128 + cl * 4) = a2;
            __syncthreads();
            for (int idx = tid; idx < 384; idx += 256) { const int v = idx >> 7, n = idx & 127; float acc = 0.f;
#pragma unroll
                for (int g = 0; g < 8; ++g) acc += red[(g * 3 + v) * 128 + n];
                ((float*)(ws + OFF_MOD))[((size_t)l * 3 + v) * 6144 + n0 + n] = acc + p.b_mod[l * 6144 + n0 + n]; }
            __syncthreads();
            continue;
        }
        it -= I_MOD;
        if (it < I_ROPE) {
            const int idx = it * 256 + tid, pos = idx >> 5, i = idx & 31, row = pos >> 6, col = pos & 63, j = i & 15;
            const float invf = powf(10000.f, -(float)(2 * j) / 32.f);
            const float ang = (float)(i < 16 ? row : col) * invf;
            float sn, cs; sincosf(ang, &sn, &cs);
            ((f32x2*)(ws + OFF_ROPE))[idx] = (f32x2){cs, sn};
            continue;
        }
        it -= I_ROPE;
        if (it < I_INE) { const int kb = it / 19, nb = it % 19;
            transpose_item(lds, DM, (bf16*)(ws + OFF_W_IN_E), kb * 64, nb * 128, 2336, 1, p.w_in_e, nullptr, 2336, nullptr); continue; }
        it -= I_INE;
        if (it < I_OUTE) { const int kb = it / 8, nb = it % 8;
            transpose_item(lds, DM, (bf16*)(ws + OFF_W_OUT_E), kb * 64, nb * 128, DM, 0, p.w_out_e, nullptr, DM, nullptr); continue; }
        it -= I_OUTE;
        if (it < I_INO) { const int kb = it / 7, nb = it % 7;
            transpose_item(lds, DM, (bf16*)(ws + OFF_W_IN_O), kb * 64, nb * 128, 832, 0, p.w_in_o, nullptr, 832, nullptr); continue; }
        it -= I_INO;
        if (it < I_UQ) { const int kb = it / 12, nb = it % 12;
            transpose_item(lds, 512, (bf16*)(ws + OFF_W_UQ), kb * 64, nb * 128, 1536, 0, p.w_uq, nullptr, 1536, p.mla_q_norm); continue; }
        it -= I_UQ;
        if (it < I_UKV) { const int kb = it / 16, nb = it % 16;
            transpose_item(lds, 256, (bf16*)(ws + OFF_W_UKV), kb * 64, nb * 128, 2048, 0, p.w_ukv, nullptr, 2048, p.mla_kv_norm); continue; }
        it -= I_UKV;
        if (it < I_OUTO) { const int kb = it / 8, nb = it % 8;
            transpose_item(lds, DM, (bf16*)(ws + OFF_W_OUT_O), kb * 64, nb * 128, DM, 0, p.w_out_o, nullptr, DM, nullptr); continue; }
        it -= I_OUTO;
        { const int l = it / 16, kb = it % 16;
            transpose_item(lds, DM, (bf16*)(ws + OFF_W_RT) + (size_t)l * 128 * DM, kb * 64, 0, 64, 0, p.w_router + (size_t)l * DM * 64, nullptr, 64, nullptr); }
    }
}

__device__ __forceinline__ void load_row(const float* src, int lane, f32x4 (&v)[4]) {
#pragma unroll
    for (int j = 0; j < 4; ++j) v[j] = *(const f32x4*)(src + lane * 4 + 256 * j);
}
__device__ __forceinline__ float row_sumsq(const f32x4 (&v)[4]) {
    float s = 0.f;
#pragma unroll
    for (int j = 0; j < 4; ++j) s += v[j].x * v[j].x + v[j].y * v[j].y + v[j].z * v[j].z + v[j].w * v[j].w;
    return wave_sum(s);
}
__device__ __forceinline__ void modulate_store(const f32x4 (&v)[4], float rinv, const float* g, const float* sh, const float* sc, bf16* dst, int lane) {
#pragma unroll
    for (int j = 0; j < 4; ++j) {
        const int c = lane * 4 + 256 * j;
        const f32x4 gg = *(const f32x4*)(g + c), s1 = *(const f32x4*)(sc + c), s0 = *(const f32x4*)(sh + c);
        const f32x4 o = v[j] * rinv * gg * (s1 + 1.f) + s0;
        u32x2 w; w.x = pk2(o.x, o.y); w.y = pk2(o.z, o.w);
        *(u32x2*)(dst + c) = w;
    }
}
__device__ __forceinline__ const float* hl_src0(const Params& p, int r) { return r < TC ? p.ctx + (size_t)r * DM : p.x + (size_t)(r - TC) * DM; }
__device__ __forceinline__ bf16* hl_buf(const Params& p, int r) { return r < TC ? (bf16*)(p.ws + OFF_HC) + (size_t)r * DM : (bf16*)(p.out + (size_t)(r - TC) * DM); }

__device__ __forceinline__ void ph_modulate0(const Params& p) {
    const int lane = threadIdx.x & 63, gw = blockIdx.x * 4 + (threadIdx.x >> 6), ngw = gridDim.x * 4;
    const float* mod = (const float*)(p.ws + OFF_MOD);
    bf16* U = (bf16*)(p.ws + OFF_U);
    for (int r = gw; r < TT; r += ngw) {
        f32x4 v[4]; load_row(hl_src0(p, r), lane, v);
        const float rinv = rsqrtf(row_sumsq(v) * (1.f / DM) + RMS_EPS);
        const float* mv = mod + (size_t)modvec(r) * 6144;
        modulate_store(v, rinv, p.g_mix_pre, mv, mv + 1024, U + (size_t)r * DM, lane);
    }
}

__device__ __forceinline__ void ph_rowpassA(const Params& p, int l, int row_lo, const float* Y) {
    const int lane = threadIdx.x & 63, gw = blockIdx.x * 4 + (threadIdx.x >> 6), ngw = gridDim.x * 4;
    const float* mod = (const float*)(p.ws + OFF_MOD) + (size_t)l * 3 * 6144;
    bf16* U = (bf16*)(p.ws + OFF_U);
    for (int r = row_lo + gw; r < TT; r += ngw) {
        f32x4 y[4], h[4];
        load_row(Y + (size_t)r * DM, lane, y);
        bf16* hb = hl_buf(p, r);
        if (l == 0) load_row(hl_src0(p, r), lane, h);
        else {
#pragma unroll
            for (int j = 0; j < 4; ++j) { const u32x2 w = *(const u32x2*)(hb + lane * 4 + 256 * j); h[j] = (f32x4){bflo(w.x), bfhi(w.x), bflo(w.y), bfhi(w.y)}; }
        }
        const float rinv = rsqrtf(row_sumsq(y) * (1.f / DM) + RMS_EPS);
        const float* mv = mod + (size_t)modvec(r) * 6144;
#pragma unroll
        for (int j = 0; j < 4; ++j) {
            const int c = lane * 4 + 256 * j;
            const f32x4 gg = *(const f32x4*)(p.g_mix_post + l * DM + c), gt = *(const f32x4*)(mv + 2048 + c);
            h[j] = h[j] + gt * (y[j] * rinv * gg);
            *(u32x2*)(hb + c) = (u32x2){pk2(h[j].x, h[j].y), pk2(h[j].z, h[j].w)};
        }
        const float rinv2 = rsqrtf(row_sumsq(h) * (1.f / DM) + RMS_EPS);
        modulate_store(h, rinv2, p.g_ffn_pre + l * DM, mv + 3072, mv + 4096, U + (size_t)r * DM, lane);
        {
            unsigned char* u8 = p.ws + AM_U8 + (size_t)r * DM;
#pragma unroll
            for (int j = 0; j < 4; ++j) {
                const int c = lane * 4 + 256 * j;
                const f32x4 gg = *(const f32x4*)(p.g_ffn_pre + l * DM + c), s1 = *(const f32x4*)(mv + 4096 + c), s0 = *(const f32x4*)(mv + 3072 + c);
                const f32x4 o = h[j] * rinv2 * gg * (s1 + 1.f) + s0;
                *(unsigned*)(u8 + c) = pk4_fp8(o.x, o.y, o.z, o.w);
            }
        }
    }
}

constexpr int MOE_LDS_OFF = 65536;
__device__ __forceinline__ void moe_tables(const Params& p, LAS unsigned char* lds, int l, int row_lo) {
    LAS int* cnt = (LAS int*)(lds + MOE_LDS_OFF); LAS int* tp = cnt + 80; LAS int* sp = tp + 80;
    const int tid = threadIdx.x;
    if (tid < 64) cnt[tid] = ((const int*)(p.ws + OFF_CNT))[l * 64 + tid];
    if (tid == 64) cnt[64] = TT - row_lo;
    __syncthreads();
    if (tid == 0) {
        int a = 0, s = 0;
        for (int e = 0; e < 65; ++e) { tp[e] = a; sp[e] = s; a += (cnt[e] + 127) >> 7; s += cnt[e]; }
        tp[65] = a;
    }
    __syncthreads();
}

__device__ __forceinline__ void ph_rowpassB(const Params& p, LAS unsigned char* lds, int l, int row_lo) {
    moe_tables(p, lds, l, row_lo);
    LAS int* sp = (LAS int*)(lds + MOE_LDS_OFF) + 160;
    const int lane = threadIdx.x & 63, gw = blockIdx.x * 4 + (threadIdx.x >> 6), ngw = gridDim.x * 4;
    const float* mod = (const float*)(p.ws + OFF_MOD) + (size_t)l * 3 * 6144;
    const unsigned char* YR = p.ws + AM_YR;
    const int* tokslot = (const int*)(p.ws + OFF_TOKSLOT); const float* W8 = (const float*)(p.ws + OFF_W8);
    bf16* U = (bf16*)(p.ws + OFF_U);
    const int c0 = lane * 16;
    for (int r = row_lo + gw; r < TT; r += ngw) {
        int ts = 0; float wv = 0.f;
        if (lane < 8) { ts = tokslot[(size_t)r * 8 + lane]; wv = W8[(size_t)r * 8 + lane]; }
        const int myslot = sp[ts >> 20] + (ts & 0xfffff);
        float f[16];
#pragma unroll
        for (int i = 0; i < 16; ++i) f[i] = 0.f;
#pragma unroll
        for (int k = 0; k < 9; ++k) {
            size_t slot; float wk = 1.f / Y8SC;
            if (k < 8) { slot = (size_t)__shfl(myslot, k); wk = __shfl(wv, k) * (1.f / Y8SC); } else slot = (size_t)TT * 8 + r;
            const u32x4 a = *(const u32x4*)(YR + slot * DM + c0);
            const unsigned aw[4] = {a.x, a.y, a.z, a.w};
#pragma unroll
            for (int q = 0; q < 4; ++q) {
                const f32x2 lo = __builtin_amdgcn_cvt_pk_f32_fp8((int)aw[q], false), hi2 = __builtin_amdgcn_cvt_pk_f32_fp8((int)aw[q], true);
                f[q * 4 + 0] += wk * lo.x; f[q * 4 + 1] += wk * lo.y; f[q * 4 + 2] += wk * hi2.x; f[q * 4 + 3] += wk * hi2.y;
            }
        }
        float ss = 0.f;
#pragma unroll
        for (int i = 0; i < 16; ++i) ss += f[i] * f[i];
        const float rinv = rsqrtf(wave_sum(ss) * (1.f / DM) + RMS_EPS);
        const float* mv = mod + (size_t)modvec(r) * 6144;
        bf16* hb = hl_buf(p, r);
        float h[16];
        {
            const u32x4 ha = *(const u32x4*)(hb + c0), hb2 = *(const u32x4*)(hb + c0 + 8);
            const unsigned hw[8] = {ha.x, ha.y, ha.z, ha.w, hb2.x, hb2.y, hb2.z, hb2.w};
#pragma unroll
            for (int i = 0; i < 8; ++i) { h[2 * i] = bflo(hw[i]); h[2 * i + 1] = bfhi(hw[i]); }
        }
#pragma unroll
        for (int q = 0; q < 4; ++q) {
            const int c = c0 + q * 4;
            const f32x4 gg = *(const f32x4*)(p.g_ffn_post + l * DM + c), gt = *(const f32x4*)(mv + 5120 + c);
            const f32x4 fv = {f[q * 4 + 0], f[q * 4 + 1], f[q * 4 + 2], f[q * 4 + 3]};
            const f32x4 hv = {h[q * 4 + 0], h[q * 4 + 1], h[q * 4 + 2], h[q * 4 + 3]};
            const f32x4 o = hv + gt * (fv * rinv * gg);
            h[q * 4 + 0] = o.x; h[q * 4 + 1] = o.y; h[q * 4 + 2] = o.z; h[q * 4 + 3] = o.w;
        }
        if (l == 1) {
            float* orow = p.out + (size_t)(r - TC) * DM + c0;
#pragma unroll
            for (int q = 0; q < 4; ++q) *(f32x4*)(orow + q * 4) = (f32x4){h[q * 4 + 0], h[q * 4 + 1], h[q * 4 + 2], h[q * 4 + 3]};
        } else {
            *(u32x4*)(hb + c0) = (u32x4){pk2(h[0], h[1]), pk2(h[2], h[3]), pk2(h[4], h[5]), pk2(h[6], h[7])};
            *(u32x4*)(hb + c0 + 8) = (u32x4){pk2(h[8], h[9]), pk2(h[10], h[11]), pk2(h[12], h[13]), pk2(h[14], h[15])};
        }
        if (l == 0) {
            float s2 = 0.f;
#pragma unroll
            for (int i = 0; i < 16; ++i) s2 += h[i] * h[i];
            const float rinv2 = rsqrtf(wave_sum(s2) * (1.f / DM) + RMS_EPS);
            const float* mv1 = mv + 3 * 6144;
#pragma unroll
            for (int hf = 0; hf < 2; ++hf) {
                const int c = c0 + hf * 8;
                const f32x4 g0 = *(const f32x4*)(p.g_mix_pre + DM + c), g1 = *(const f32x4*)(p.g_mix_pre + DM + c + 4);
                const f32x4 sh0 = *(const f32x4*)(mv1 + c), sh1 = *(const f32x4*)(mv1 + c + 4), sc0 = *(const f32x4*)(mv1 + 1024 + c), sc1 = *(const f32x4*)(mv1 + 1024 + c + 4);
                const f32x4 h0 = {h[hf * 8 + 0], h[hf * 8 + 1], h[hf * 8 + 2], h[hf * 8 + 3]}, h1 = {h[hf * 8 + 4], h[hf * 8 + 5], h[hf * 8 + 6], h[hf * 8 + 7]};
                const f32x4 o0 = h0 * rinv2 * g0 * (sc0 + 1.f) + sh0, o1 = h1 * rinv2 * g1 * (sc1 + 1.f) + sh1;
                *(u32x4*)(U + (size_t)r * DM + c) = (u32x4){pk2(o0.x, o0.y), pk2(o0.z, o0.w), pk2(o1.x, o1.y), pk2(o1.z, o1.w)};
            }
        }
    }
}

__device__ __forceinline__ int stg_col() { const int tid = threadIdx.x; return ((tid & 7) ^ ((tid >> 3) & 7)) * 8; }
__device__ __forceinline__ void plain_ptrs(const bf16* base, int row0, int ld, const bf16* (&pp)[4]) {
    const int tid = threadIdx.x;
    pp[0] = base + (size_t)(row0 + (tid >> 3)) * ld + stg_col();
#pragma unroll
    for (int i = 1; i < 4; ++i) pp[i] = pp[0] + (size_t)(32 * i) * ld;
}

__device__ __forceinline__ void ph_inproj0(const Params& p, LAS unsigned char* lds) {
    unsigned char* ws = p.ws;
    const bf16* U = (const bf16*)(ws + OFF_U); const bf16* W = (const bf16*)(ws + OFF_W_IN_E);
    bf16* Z0 = (bf16*)(ws + A0_Z0); bf16* VGT = (bf16*)(ws + A0_VGT); bf16* QS = (bf16*)(ws + A0_QS); bf16* KS = (bf16*)(ws + A0_KS); bf16* VST = (bf16*)(ws + A0_VST);
    const f32x2* rope = (const f32x2*)(ws + OFF_ROPE);
    const int tid = threadIdx.x, lane = tid & 63, wid = tid >> 6, wr = wid >> 1, wc = wid & 1, fr = lane & 15, fq = lane >> 4;
    constexpr int NTN = 19, NTM = TT / 128;
    auto make = [&](int t, GPtrs& g, int& nk) { int tm, tn; tile_mn(t, NTM, NTN, tm, tn); plain_ptrs(U, tm * 128, DM, g.a); plain_ptrs(W, tn * 128, DM, g.b); nk = DM / 64; };
    auto epi = [&](int t, f32x4 (&acc)[4][4]) {
        int tm, tn; tile_mn(t, NTM, NTN, tm, tn); const int brow = tm * 128, bcol = tn * 128;
        const int cb = bcol + wc * 64;
        LAS unsigned char* wl = lds + 32768 + wid * 8192;
        const int r0 = brow + wr * 64;
        const RowInfo ri0 = rowinfo(r0);
        if (cb < 1024) {
            epi_store_rows(wl, acc, fr, fq, lane, [&](int row) { return Z0 + (size_t)(r0 + row) * Z0P + cb; });
        } else if (cb < 1536) {
            const int c0 = cb - 1024;
            epi_store_cols(wl, acc, fr, fq, lane, [&](int col) { return VGT + (size_t)(c0 + col) * TT + r0; });
        } else if (cb < 2176) {
            const float sc = cb < 2048 ? 0.125f * LOG2E : 1.f;
#pragma unroll
            for (int m = 0; m < 4; ++m) {
                const int pos = ri0.pos + m * 16 + fr;
#pragma unroll
                for (int n = 0; n < 2; ++n)
#pragma unroll
                    for (int j = 0; j < 4; ++j) {
                        const float x1 = acc[m][n][j] * sc, x2 = acc[m][n + 2][j] * sc;
                        if (ri0.lat) { const f32x2 cs = rope[(size_t)pos * 32 + n * 16 + fq * 4 + j]; acc[m][n][j] = x1 * cs.x - x2 * cs.y; acc[m][n + 2][j] = x2 * cs.x + x1 * cs.y; }
                        else { acc[m][n][j] = x1; acc[m][n + 2][j] = x2; }
                    }
                asm volatile("" ::: "memory");
            }
            bf16* dst;
            if (cb < 2048) { const int h = (cb - 1536) >> 6; dst = QS + ((size_t)(ri0.b * 8 + h) * NKEY + ri0.kq) * 64; }
            else { const int h = (cb - 2048) >> 6; dst = KS + ((size_t)(ri0.b * 2 + h) * NKEY + ri0.kq) * 64; }
            epi_store_rows(wl, acc, fr, fq, lane, [&](int row) { return dst + (size_t)row * 64; });
        } else if (cb < 2304) {
            const int h = (cb - 2176) >> 6;
            bf16* dst = VST + (size_t)(ri0.b * 2 + h) * 64 * NKEY + ri0.kq;
            epi_store_cols(wl, acc, fr, fq, lane, [&](int col) { return dst + (size_t)col * NKEY; });
        } else if (cb == 2304) {
#pragma unroll
            for (int m = 0; m < 4; ++m) {
                const int r = r0 + m * 16 + fr;
#pragma unroll
                for (int n = 0; n < 2; ++n) { u32x2 w; w.x = pk2(acc[m][n][0], acc[m][n][1]); w.y = pk2(acc[m][n][2], acc[m][n][3]); *(u32x2*)(Z0 + (size_t)r * Z0P + 1024 + n * 16 + fq * 4) = w; }
            }
        }
    };
    gemm_tiles<true>(lds, vcu_id(), NTM * NTN, gridDim.x, make, epi);
}

__device__ __forceinline__ void ph_outproj(const Params& p, LAS unsigned char* lds, const bf16* MIX, const bf16* W, float* Y, int row_lo) {
    const int tid = threadIdx.x, lane = tid & 63, wid = tid >> 6, wr = wid >> 1, wc = wid & 1, fr = lane & 15, fq = lane >> 4;
    const int tm0 = row_lo / 128, ntm = TT / 128 - tm0;
    auto make = [&](int t, GPtrs& g, int& nk) { int tm, tn; tile_mn(t, ntm, 8, tm, tn); plain_ptrs(MIX, (tm0 + tm) * 128, DM, g.a); plain_ptrs(W, tn * 128, DM, g.b); nk = DM / 64; };
    auto epi = [&](int t, f32x4 (&acc)[4][4]) {
        int tm, tn; tile_mn(t, ntm, 8, tm, tn); tm += tm0; const int brow = tm * 128, bcol = tn * 128;
#pragma unroll
        for (int m = 0; m < 4; ++m) {
            const int r = brow + wr * 64 + m * 16 + fr;
#pragma unroll
            for (int n = 0; n < 4; ++n) *(f32x4*)(Y + (size_t)r * DM + bcol + wc * 64 + n * 16 + fq * 4) = acc[m][n];
        }
    };
    gemm_tiles<true, 16>(lds, vcu_id(), ntm * 8, gridDim.x, make, epi);
}

template <int DQK, int DV>
__device__ __forceinline__ void attn_item(LAS unsigned char* lds, const bf16* Qg, const bf16* Kg, const bf16* VTg, int a1, int b0, int b1, int qpos0,
                                          float m_init, float l_init, bf16* Og, int o_pitch) {
    constexpr int KPB = DQK * 2, NS = DQK / 16, NDV = DV / 32, KCH = DQK / 8, KBYTES = 32 * KPB, VBYTES = DV * 64, KN = 32 * KCH / 256, VN = DV * 4 / 256;
    static_assert((KN == 3 && VN == 2) || (KN == 1 && VN == 1), "piece counts");
    const int tid = threadIdx.x, lane = tid & 63, wid = tid >> 6, ql = lane & 31, hi = lane >> 5;
    LAS unsigned char* Kb0 = lds; LAS unsigned char* Vb0 = lds + 2 * KBYTES;
    asm volatile("s_waitcnt vmcnt(0) lgkmcnt(0)" ::: "memory");
    __builtin_amdgcn_s_barrier();
    asm volatile("" ::: "memory");
    bf16x8 qf[NS];
    {
        const bf16* qrow = Qg + (size_t)(wid * 32 + ql) * DQK + hi * 8;
#pragma unroll
        for (int s = 0; s < NS; ++s) qf[s] = *(const bf16x8*)(qrow + s * 16);
    }
    unsigned koff[KN], voff[VN];
#pragma unroll
    for (int i = 0; i < KN; ++i) { const int pz = tid + 256 * i, key = pz / KCH, ch = pz % KCH; koff[i] = (unsigned)(key * DQK + (((ch & ~7) | ((ch & 7) ^ ((key >> 1) & 7))) * 8)); }
#pragma unroll
    for (int i = 0; i < VN; ++i) { const int pz = tid + 256 * i, dv = pz >> 2, ch = pz & 3; voff[i] = (unsigned)(dv * NKEY + ((ch ^ ((dv >> 2) & 3)) * 8)); }
    const int ntot = a1 + (b1 - b0);
#define ATTN_KT(it_) ((it_) < a1 ? (it_) : b0 + ((it_) - a1))
#define ATTN_DMA_K(IT_) do { const int kt_ = ATTN_KT(IT_); _Pragma("unroll") for (int i_ = 0; i_ < KN; ++i_) glds16(Kg + (size_t)kt_ * 32 * DQK + koff[i_], Kb0 + ((IT_) & 1) * KBYTES + (tid + 256 * i_) * 16); } while (0)
#define ATTN_DMA_V(IT_) do { const int kt_ = ATTN_KT(IT_); _Pragma("unroll") for (int i_ = 0; i_ < VN; ++i_) glds16(VTg + (size_t)kt_ * 32 + voff[i_], Vb0 + ((IT_) & 1) * VBYTES + (tid + 256 * i_) * 16); } while (0)
    f32x16 o[NDV];
#pragma unroll
    for (int d = 0; d < NDV; ++d)
#pragma unroll
        for (int r = 0; r < 16; ++r) o[d][r] = 0.f;
    float mrun = m_init, lrun = l_init;
    const int swk = (ql >> 1) & 7, swv = (ql >> 2) & 3;
    const LAS unsigned char* kfrag = Kb0 + ql * KPB; const LAS unsigned char* vfrag = Vb0 + ql * 64;
#define ATTN_QK(P_, IT_) do { \
        _Pragma("unroll") for (int r_ = 0; r_ < 16; ++r_) P_[r_] = 0.f; \
        const LAS unsigned char* kc_ = kfrag + ((IT_) & 1) * KBYTES; \
        _Pragma("unroll") for (int s_ = 0; s_ < NS; ++s_) { \
            const int c_ = 2 * s_ + hi; \
            const bf16x8 k0_ = *(const LAS bf16x8*)(kc_ + ((c_ & ~7) | ((c_ & 7) ^ swk)) * 16); \
            P_ = __builtin_amdgcn_mfma_f32_32x32x16_bf16(k0_, qf[s_], P_, 0, 0, 0); } \
        if ((IT_) >= a1) { const int kbase_ = ATTN_KT(IT_) * 32 - CTX, qpos_ = qpos0 + wid * 32 + ql; \
            _Pragma("unroll") for (int r_ = 0; r_ < 16; ++r_) { const int d0_ = qpos_ - (kbase_ + crow(r_, hi)); if (d0_ > 128 || d0_ < -128) P_[r_] = -1e30f; } } } while (0)
#define ATTN_PK4(P, BASE, OUT) do { const unsigned a0_ = pk2(P[BASE + 0], P[BASE + 1]), a1_ = pk2(P[BASE + 2], P[BASE + 3]), b0_ = pk2(P[BASE + 4], P[BASE + 5]), b1_ = pk2(P[BASE + 6], P[BASE + 7]); \
        const auto r0_ = __builtin_amdgcn_permlane32_swap(a0_, b0_, false, false); const auto r1_ = __builtin_amdgcn_permlane32_swap(a1_, b1_, false, false); \
        OUT = mk8((u32x4){r0_[0], r1_[0], r0_[1], r1_[1]}); } while (0)
#define ATTN_STEP(C_, N_, IT_) do { \
          \
          \
        asm volatile("s_waitcnt vmcnt(0) lgkmcnt(0)" ::: "memory"); __builtin_amdgcn_s_barrier(); asm volatile("" ::: "memory"); \
        if ((IT_) + 2 < ntot) ATTN_DMA_K((IT_) + 2); \
        if ((IT_) + 1 < ntot) ATTN_DMA_V((IT_) + 1); \
        if ((IT_) + 1 < ntot) ATTN_QK(N_, (IT_) + 1); \
        float mx_ = C_[0]; \
        _Pragma("unroll") for (int r_ = 1; r_ < 16; ++r_) mx_ = fmaxf(mx_, C_[r_]); \
        mx_ = fmaxf(mx_, __shfl_xor(mx_, 32)); \
        if (__any(mx_ > mrun + 8.f)) { const float mn_ = fmaxf(mrun, mx_), alpha_ = ex2(mrun - mn_); mrun = mn_; lrun *= alpha_; \
            _Pragma("unroll") for (int d_ = 0; d_ < NDV; ++d_) _Pragma("unroll") for (int r_ = 0; r_ < 16; ++r_) o[d_][r_] *= alpha_; } \
        float rs_ = 0.f; \
        _Pragma("unroll") for (int r_ = 0; r_ < 16; ++r_) { C_[r_] = ex2(C_[r_] - mrun); rs_ += C_[r_]; } \
        rs_ += __shfl_xor(rs_, 32); lrun += rs_; \
        bf16x8 pf_[2]; \
        ATTN_PK4(C_, 0, pf_[0]); ATTN_PK4(C_, 8, pf_[1]); \
        const LAS unsigned char* vc_ = vfrag + ((IT_) & 1) * VBYTES; \
        _Pragma("unroll") for (int d_ = 0; d_ < NDV; ++d_) { _Pragma("unroll") for (int kk_ = 0; kk_ < 2; ++kk_) { \
            const bf16x8 vf_ = *(const LAS bf16x8*)(vc_ + d_ * 32 * 64 + (((2 * kk_ + hi) ^ swv) * 16)); \
            o[d_] = __builtin_amdgcn_mfma_f32_32x32x16_bf16(vf_, pf_[kk_], o[d_], 0, 0, 0); } } } while (0)
    ATTN_DMA_K(0); ATTN_DMA_V(0);
    asm volatile("s_waitcnt vmcnt(0) lgkmcnt(0)" ::: "memory"); __builtin_amdgcn_s_barrier(); asm volatile("" ::: "memory");
    if (ntot > 1) ATTN_DMA_K(1);
    f32x16 pA, pB;
    ATTN_QK(pA, 0);
    int it = 0;
    for (; it + 1 < ntot; it += 2) {
        ATTN_STEP(pA, pB, it);
        ATTN_STEP(pB, pA, it + 1);
    }
    if (it < ntot) ATTN_STEP(pA, pB, it);
#undef ATTN_STEP
#undef ATTN_PK4
#undef ATTN_QK
#undef ATTN_KT
#undef ATTN_DMA_K
#undef ATTN_DMA_V
    const float inv = 1.f / lrun;
    bf16* orow = Og + (size_t)(wid * 32 + ql) * o_pitch;
#pragma unroll
    for (int d = 0; d < NDV; ++d)
#pragma unroll
        for (int g = 0; g < 4; ++g) {
            u32x2 w; w.x = pk2(o[d][g * 4 + 0] * inv, o[d][g * 4 + 1] * inv); w.y = pk2(o[d][g * 4 + 2] * inv, o[d][g * 4 + 3] * inv);
            *(u32x2*)(orow + d * 32 + 8 * g + 4 * hi) = w;
        }
}

constexpr int GA_CUM = 0, GA_ALOW = 16384, GA_WA = 20480, GA_BA = 24576, GA_QT = 24832, GA_TOT = 25856, GA_END = 26112;
__device__ __forceinline__ void gla_cum(const Params& p, LAS unsigned char* lds, const bf16* Z0, int r0, int h, int dir) {
    const int tid = threadIdx.x;
    LAS float* cum = (LAS float*)(lds + GA_CUM); LAS float* alow = (LAS float*)(lds + GA_ALOW); LAS float* wa = (LAS float*)(lds + GA_WA);
    LAS float* ba = (LAS float*)(lds + GA_BA); LAS float* qt = (LAS float*)(lds + GA_QT); LAS float* tot = (LAS float*)(lds + GA_TOT);
    {
        const int t = tid >> 2, i4 = (tid & 3) * 4;
        const u32x2 w = *(const u32x2*)(Z0 + (size_t)(r0 + t) * Z0P + 1024 + dir * 16 + i4);
        alow[t * 16 + i4 + 0] = bflo(w.x); alow[t * 16 + i4 + 1] = bfhi(w.x); alow[t * 16 + i4 + 2] = bflo(w.y); alow[t * 16 + i4 + 3] = bfhi(w.y);
#pragma unroll
        for (int q = 0; q < 4; ++q) { const int idx = tid * 4 + q, i = idx >> 6, j = idx & 63; wa[idx] = p.gla_wa2[(size_t)(dir * 16 + i) * 256 + h * 64 + j]; }
        if (tid < 64) ba[tid] = p.gla_ba[dir * 256 + h * 64 + tid];
    }
    __syncthreads();
    const int j = tid & 63, tq = tid >> 6;
    float la[16], wj[16];
#pragma unroll
    for (int i = 0; i < 16; ++i) wj[i] = wa[i * 64 + j];
    const float bj = ba[j];
#pragma unroll
    for (int tt = 0; tt < 16; ++tt) {
        const int t = tq * 16 + tt;
        float x = bj;
#pragma unroll
        for (int q = 0; q < 4; ++q) { const f32x4 a = *(const LAS f32x4*)(alow + t * 16 + q * 4);
            x += a.x * wj[q * 4] + a.y * wj[q * 4 + 1] + a.z * wj[q * 4 + 2] + a.w * wj[q * 4 + 3]; }
        la[tt] = (fminf(x, 0.f) - __logf(1.f + __expf(-fabsf(x)))) * (1.f / 16.f);
    }
    float run = 0.f;
    if (dir == 0) {
#pragma unroll
        for (int tt = 0; tt < 16; ++tt) { run += la[tt]; cum[(tq * 16 + tt) * 64 + j] = run; }
    } else {
#pragma unroll
        for (int tt = 15; tt >= 0; --tt) { run += la[tt]; cum[(tq * 16 + tt) * 64 + j] = run; }
    }
    qt[tq * 64 + j] = run;
    __syncthreads();
    float off = 0.f, total = 0.f;
#pragma unroll
    for (int q = 0; q < 4; ++q) { const float v = qt[q * 64 + j]; total += v; if (dir == 0 ? (q < tq) : (q > tq)) off += v; }
#pragma unroll
    for (int tt = 0; tt < 16; ++tt) cum[(tq * 16 + tt) * 64 + j] += off;
    if (tq == 0) tot[j] = total;
    __syncthreads();
}

__device__ __forceinline__ int gla_row0(int b, int cc) { return cc < 4 ? b * CTX + cc * 64 : TC + b * SEQ + (cc - 4) * 64; }
__device__ __forceinline__ int gla_step(int cc, int dir) { return dir == 0 ? cc : (cc < 4 ? 3 - cc : 4 + (131 - cc)); }

__device__ __forceinline__ void gla_g1_item(const Params& p, LAS unsigned char* lds, int item) {
    unsigned char* ws = p.ws;
    const bf16* Z0 = (const bf16*)(ws + A0_Z0); const bf16* VGT = (const bf16*)(ws + A0_VGT);
    bf16* GS = (bf16*)(ws + A0_GS); float* GD = (float*)(ws + A0_GD);
    const int cc = item % NSTEP, rest = item / NSTEP, dir = rest & 1, h = (rest >> 1) & 3, b = rest >> 3;
    const int r0 = gla_row0(b, cc), step = gla_step(cc, dir), chain = (b * 4 + h) * 2 + dir;
    const int tid = threadIdx.x, lane = tid & 63, wid = tid >> 6, fr = lane & 15, fq = lane >> 4;
    __syncthreads();
    gla_cum(p, lds, Z0, r0, h, dir);
    LAS float* cum = (LAS float*)(lds + GA_CUM); LAS float* tot = (LAS float*)(lds + GA_TOT);
    LAS bf16* KT = (LAS bf16*)(lds + GA_END);
    {
        const int t = tid >> 2, d0 = (tid & 3) * 16;
        const u32x4 w0 = *(const u32x4*)(Z0 + (size_t)(r0 + t) * Z0P + 256 + h * 64 + d0), w1 = *(const u32x4*)(Z0 + (size_t)(r0 + t) * Z0P + 256 + h * 64 + d0 + 8);
        const unsigned ww[8] = {w0.x, w0.y, w0.z, w0.w, w1.x, w1.y, w1.z, w1.w};
#pragma unroll
        for (int i = 0; i < 8; ++i) {
            const int d = d0 + 2 * i;
            KT[d * 72 + t] = f2bf(bflo(ww[i]) * __expf(tot[d] - cum[t * 64 + d]));
            KT[(d + 1) * 72 + t] = f2bf(bfhi(ww[i]) * __expf(tot[d + 1] - cum[t * 64 + d + 1]));
        }
    }
    if (tid < 64) GD[((size_t)chain * NSTEP + step) * 64 + tid] = __expf(tot[tid]);
    __syncthreads();
    f32x4 acc[2][4];
#pragma unroll
    for (int m = 0; m < 2; ++m)
#pragma unroll
        for (int n = 0; n < 4; ++n) acc[m][n] = (f32x4){0.f, 0.f, 0.f, 0.f};
#pragma unroll
    for (int ks = 0; ks < 2; ++ks) {
        bf16x8 af[2], bfr[4];
#pragma unroll
        for (int m = 0; m < 2; ++m) af[m] = *(const bf16x8*)(VGT + (size_t)(h * 128 + wid * 32 + m * 16 + fr) * TT + r0 + ks * 32 + fq * 8);
#pragma unroll
        for (int n = 0; n < 4; ++n) bfr[n] = *(const LAS bf16x8*)(KT + (n * 16 + fr) * 72 + ks * 32 + fq * 8);
#pragma unroll
        for (int m = 0; m < 2; ++m)
#pragma unroll
            for (int n = 0; n < 4; ++n) acc[m][n] = __builtin_amdgcn_mfma_f32_16x16x32_bf16(bfr[n], af[m], acc[m][n], 0, 0, 0);
    }
    bf16* dst = GS + ((size_t)chain * NSTEP + step) * 8192;
#pragma unroll
    for (int m = 0; m < 2; ++m)
#pragma unroll
        for (int n = 0; n < 4; ++n) *(u32x2*)(dst + (size_t)(wid * 32 + m * 16 + fr) * 64 + n * 16 + fq * 4) = (u32x2){pk2(acc[m][n][0], acc[m][n][1]), pk2(acc[m][n][2], acc[m][n][3])};
}

__device__ __forceinline__ void ph_gla_scan(const Params& p) {
    unsigned* GS = (unsigned*)(p.ws + A0_GS); const float* GD = (const float*)(p.ws + A0_GD);
    for (int idx = blockIdx.x * 256 + threadIdx.x; idx < 16 * 4096; idx += gridDim.x * 256) {
        const int chain = idx >> 12, e2 = idx & 4095, dk = (e2 & 31) * 2;
        unsigned* g = GS + (size_t)chain * NSTEP * 4096 + e2;
        const f32x2* d = (const f32x2*)(GD + (size_t)chain * NSTEP * 64 + dk);
        float s0 = 0.f, s1 = 0.f;
#pragma unroll 12
        for (int s = 0; s < NSTEP; ++s) {
            const unsigned t = g[(size_t)s * 4096]; const f32x2 dec = d[s * 32];
            g[(size_t)s * 4096] = pk2(s0, s1);
            s0 = dec.x * s0 + bflo(t); s1 = dec.y * s1 + bfhi(t);
        }
    }
}

__device__ __forceinline__ void gla_g3_item(const Params& p, LAS unsigned char* lds, int item) {
    unsigned char* ws = p.ws;
    const bf16* Z0 = (const bf16*)(ws + A0_Z0); const bf16* VGT = (const bf16*)(ws + A0_VGT);
    const bf16* GS = (const bf16*)(ws + A0_GS); bf16* MIX = (bf16*)(ws + A0_MIX);
    const int cc = item % NSTEP, rest = item / NSTEP, h = rest & 3, b = rest >> 2;
    const int r0 = gla_row0(b, cc);
    const int tid = threadIdx.x, lane = tid & 63, wid = tid >> 6, fr = lane & 15, fq = lane >> 4;
    LAS bf16* QT = (LAS bf16*)(lds + GA_END);
    LAS bf16* QI = (LAS bf16*)(lds + GA_END + 9216);
    LAS bf16* KT = (LAS bf16*)(lds + GA_END + 18432);
    LAS bf16* PP = (LAS bf16*)(lds);
    f32x4 o[4][2];
#pragma unroll
    for (int m = 0; m < 4; ++m)
#pragma unroll
        for (int n = 0; n < 2; ++n) o[m][n] = (f32x4){0.f, 0.f, 0.f, 0.f};
    for (int dir = 0; dir < 2; ++dir) {
        const int step = gla_step(cc, dir), chain = (b * 4 + h) * 2 + dir;
        __syncthreads();
        gla_cum(p, lds, Z0, r0, h, dir);
        LAS float* cum = (LAS float*)(lds + GA_CUM); LAS float* tot = (LAS float*)(lds + GA_TOT);
        {
            const int t = tid >> 2, d0 = (tid & 3) * 16;
            const bf16* zr = Z0 + (size_t)(r0 + t) * Z0P + h * 64 + d0;
            const u32x4 q0 = *(const u32x4*)(zr), q1 = *(const u32x4*)(zr + 8), k0 = *(const u32x4*)(zr + 256), k1 = *(const u32x4*)(zr + 264);
            const unsigned qq[8] = {q0.x, q0.y, q0.z, q0.w, q1.x, q1.y, q1.z, q1.w}, kk[8] = {k0.x, k0.y, k0.z, k0.w, k1.x, k1.y, k1.z, k1.w};
            unsigned oqt[8], oqi[8], okt[8];
#pragma unroll
            for (int i = 0; i < 8; ++i) {
                const int d = d0 + 2 * i;
                const float c0 = cum[t * 64 + d], c1 = cum[t * 64 + d + 1], t0 = tot[d], t1 = tot[d + 1];
                const float qa = bflo(qq[i]), qb = bfhi(qq[i]), ka = bflo(kk[i]), kb = bfhi(kk[i]);
                oqt[i] = pk2(qa * __expf(c0 - t0), qb * __expf(c1 - t1));
                oqi[i] = pk2(qa * __expf(c0), qb * __expf(c1));
                okt[i] = pk2(ka * __expf(t0 - c0), kb * __expf(t1 - c1));
            }
            *(LAS u32x4*)(QT + t * 72 + d0) = (u32x4){oqt[0], oqt[1], oqt[2], oqt[3]}; *(LAS u32x4*)(QT + t * 72 + d0 + 8) = (u32x4){oqt[4], oqt[5], oqt[6], oqt[7]};
            *(LAS u32x4*)(QI + t * 72 + d0) = (u32x4){oqi[0], oqi[1], oqi[2], oqi[3]}; *(LAS u32x4*)(QI + t * 72 + d0 + 8) = (u32x4){oqi[4], oqi[5], oqi[6], oqi[7]};
            *(LAS u32x4*)(KT + t * 72 + d0) = (u32x4){okt[0], okt[1], okt[2], okt[3]}; *(LAS u32x4*)(KT + t * 72 + d0 + 8) = (u32x4){okt[4], okt[5], okt[6], okt[7]};
        }
        __syncthreads();
        {
            f32x4 sa[4];
#pragma unroll
            for (int m = 0; m < 4; ++m) sa[m] = (f32x4){0.f, 0.f, 0.f, 0.f};
#pragma unroll
            for (int ks = 0; ks < 2; ++ks) {
                const bf16x8 kf = *(const LAS bf16x8*)(KT + (wid * 16 + fr) * 72 + ks * 32 + fq * 8);
#pragma unroll
                for (int m = 0; m < 4; ++m) {
                    const bf16x8 qfm = *(const LAS bf16x8*)(QT + (m * 16 + fr) * 72 + ks * 32 + fq * 8);
                    sa[m] = __builtin_amdgcn_mfma_f32_16x16x32_bf16(kf, qfm, sa[m], 0, 0, 0);
                }
            }
#pragma unroll
            for (int m = 0; m < 4; ++m) {
                const int t = m * 16 + fr;
                float v[4];
#pragma unroll
                for (int jj = 0; jj < 4; ++jj) { const int j = wid * 16 + fq * 4 + jj; const bool keep = dir == 0 ? (j <= t) : (j >= t); v[jj] = keep ? sa[m][jj] : 0.f; }
                *(LAS u32x2*)(PP + t * 72 + wid * 16 + fq * 4) = (u32x2){pk2(v[0], v[1]), pk2(v[2], v[3])};
            }
        }
        __syncthreads();
        const bf16* Sg = GS + ((size_t)chain * NSTEP + step) * 8192;
#pragma unroll
        for (int ks = 0; ks < 2; ++ks) {
            bf16x8 vfr[2], sfr[2];
#pragma unroll
            for (int n = 0; n < 2; ++n) {
                const int dv = wid * 32 + n * 16 + fr;
                vfr[n] = *(const bf16x8*)(VGT + (size_t)(h * 128 + dv) * TT + r0 + ks * 32 + fq * 8);
                sfr[n] = *(const bf16x8*)(Sg + (size_t)dv * 64 + ks * 32 + fq * 8);
            }
#pragma unroll
            for (int m = 0; m < 4; ++m) {
                const bf16x8 pfm = *(const LAS bf16x8*)(PP + (m * 16 + fr) * 72 + ks * 32 + fq * 8);
                const bf16x8 qim = *(const LAS bf16x8*)(QI + (m * 16 + fr) * 72 + ks * 32 + fq * 8);
#pragma unroll
                for (int n = 0; n < 2; ++n) {
                    o[m][n] = __builtin_amdgcn_mfma_f32_16x16x32_bf16(vfr[n], pfm, o[m][n], 0, 0, 0);
                    o[m][n] = __builtin_amdgcn_mfma_f32_16x16x32_bf16(sfr[n], qim, o[m][n], 0, 0, 0);
                }
            }
        }
    }
    __syncthreads();
    LAS float* red = (LAS float*)(lds + GA_END + 27648);
#pragma unroll
    for (int m = 0; m < 4; ++m) {
        float s = 0.f;
#pragma unroll
        for (int n = 0; n < 2; ++n)
#pragma unroll
            for (int j = 0; j < 4; ++j) s += o[m][n][j] * o[m][n][j];
        s += __shfl_xor(s, 16); s += __shfl_xor(s, 32);
        if (fq == 0) red[wid * 64 + m * 16 + fr] = s;
    }
    __syncthreads();
#pragma unroll
    for (int m = 0; m < 4; ++m) {
        const int t = m * 16 + fr;
        const float ss = red[t] + red[64 + t] + red[128 + t] + red[192 + t];
        const float rinv = rsqrtf(ss * (1.f / 128.f) + RMS_EPS);
        const int r = r0 + t;
#pragma unroll
        for (int n = 0; n < 2; ++n) {
            const int dv = wid * 32 + n * 16 + fq * 4;
            const u32x2 gw = *(const u32x2*)(Z0 + (size_t)r * Z0P + 512 + h * 128 + dv);
            const f32x4 ng = *(const f32x4*)(p.gla_norm + dv);
            const float g0 = bflo(gw.x), g1 = bfhi(gw.x), g2 = bflo(gw.y), g3 = bfhi(gw.y);
            const float y0 = o[m][n][0] * rinv * ng.x * siluf(g0), y1 = o[m][n][1] * rinv * ng.y * siluf(g1);
            const float y2 = o[m][n][2] * rinv * ng.z * siluf(g2), y3 = o[m][n][3] * rinv * ng.w * siluf(g3);
            *(u32x2*)(MIX + (size_t)r * DM + h * 128 + dv) = (u32x2){pk2(y0, y1), pk2(y2, y3)};
        }
    }
}

__device__ __forceinline__ void ph_swa_g1(const Params& p, LAS unsigned char* lds) {
    unsigned char* ws = p.ws;
    const bf16* QS = (const bf16*)(ws + A0_QS); const bf16* KS = (const bf16*)(ws + A0_KS); const bf16* VST = (const bf16*)(ws + A0_VST); bf16* MIX = (bf16*)(ws + A0_MIX);
    constexpr int N_SWA = 2 * 8 * 66, N_G1 = 2 * 4 * 2 * NSTEP;
    for (int item = blockIdx.x; item < N_SWA + N_G1; item += gridDim.x) {
        if (item < N_SWA) {
            const int qt = item % 66, rest = item / 66, h = rest & 7, b = rest >> 3, kvh = h >> 2;
            const bf16* Qg = QS + ((size_t)(b * 8 + h) * NKEY + qt * 128) * 64;
            const bf16* Kg = KS + (size_t)(b * 2 + kvh) * NKEY * 64;
            const bf16* Vg = VST + (size_t)(b * 2 + kvh) * 64 * NKEY;
            int b0 = 0, b1 = 0, qpos0 = 0, row0;
            if (qt >= 2) { qpos0 = (qt - 2) * 128; const int lo = qpos0 - 128 < 0 ? 0 : qpos0 - 128, hi2 = qpos0 + 256 > SEQ ? SEQ : qpos0 + 256; b0 = 8 + lo / 32; b1 = 8 + hi2 / 32; row0 = TC + b * SEQ + qpos0; }
            else row0 = b * CTX + qt * 128;
            const float sink = p.swa_sink[h] * LOG2E;
            attn_item<64, 64>(lds, Qg, Kg, Vg, 8, b0, b1, qpos0, sink, 1.f, MIX + (size_t)row0 * DM + 512 + h * 64, DM);
        } else gla_g1_item(p, lds, item - N_SWA);
    }
}
__device__ __forceinline__ void ph_gla_g3(const Params& p, LAS unsigned char* lds) {
    for (int item = blockIdx.x; item < 2 * 4 * NSTEP; item += gridDim.x) gla_g3_item(p, lds, item);
}

__device__ __forceinline__ void ph_router(const Params& p, LAS unsigned char* lds, int l, int row_lo) {
    unsigned char* ws = p.ws;
    const bf16* U = (const bf16*)(ws + OFF_U); const bf16* W = (const bf16*)(ws + OFF_W_RT) + (size_t)l * 128 * DM;
    int* cntg = (int*)(ws + OFF_CNT) + l * 64; int* tokslot = (int*)(ws + OFF_TOKSLOT); float* W8 = (float*)(ws + OFF_W8); int* LIST = (int*)(ws + OFF_LIST);
    const int tid = threadIdx.x, lane = tid & 63, wid = tid >> 6, wr = wid >> 1, wc = wid & 1, fr = lane & 15, fq = lane >> 4;
    LAS float* lg = (LAS float*)lds;
    const int tm0 = row_lo / 128;
    auto make = [&](int tm, GPtrs& g, int& nk) { plain_ptrs(U, tm * 128, DM, g.a); plain_ptrs(W, 0, DM, g.b); nk = DM / 64; };
    auto epi = [&](int tm, f32x4 (&acc)[4][4]) {
        const int brow = tm * 128;
        if (wc == 0) {
#pragma unroll
            for (int m = 0; m < 4; ++m)
#pragma unroll
                for (int n = 0; n < 4; ++n)
#pragma unroll
                    for (int j = 0; j < 4; ++j) lg[(wr * 64 + m * 16 + fr) * 65 + n * 16 + fq * 4 + j] = acc[m][n][j];
        }
        __syncthreads();
        LAS float* biasl = (LAS float*)(lds + 34816); LAS int* hist = (LAS int*)(lds + 34816 + 256); LAS int* basel = (LAS int*)(lds + 34816 + 512);
        if (tid < 64) { biasl[tid] = p.b_router[l * 64 + tid]; hist[tid] = 0; }
        __syncthreads();
        int esel[8], lrank[8]; float ssel[8]; float wsum = 0.f;
        if (tid < 128) {
            LAS float* L = lg + tid * 65;
            float gs[8];
#pragma unroll
            for (int g = 0; g < 8; ++g) {
                float m1 = -INFINITY, m2 = -INFINITY;
#pragma unroll
                for (int j = 0; j < 8; ++j) {
                    const int e = g * 8 + j;
                    const float sel = 1.f / (1.f + expf(-L[e])) + biasl[e];
                    L[e] = sel;
                    if (sel > m1) { m2 = m1; m1 = sel; } else if (sel > m2) m2 = sel;
                }
                gs[g] = m1 + m2;
            }
            unsigned allowed = 0u;
#pragma unroll
            for (int g = 0; g < 8; ++g) {
                int rk = 0;
#pragma unroll
                for (int h = 0; h < 8; ++h) rk += (gs[h] > gs[g] || (gs[h] == gs[g] && h < g)) ? 1 : 0;
                if (rk < 4) allowed |= 1u << g;
            }
#pragma unroll
            for (int k = 0; k < 8; ++k) {
                float best = -INFINITY; int bi = 0;
#pragma unroll
                for (int g = 0; g < 8; ++g) {
                    if ((allowed >> g) & 1u) {
#pragma unroll
                        for (int j = 0; j < 8; ++j) { const float v = L[g * 8 + j]; if (v > best) { best = v; bi = g * 8 + j; } }
                    }
                }
                esel[k] = bi; ssel[k] = best - biasl[bi]; wsum += ssel[k]; L[bi] = -INFINITY;
            }
#pragma unroll
            for (int k = 0; k < 8; ++k) lrank[k] = __hip_atomic_fetch_add(hist + esel[k], 1, __ATOMIC_RELAXED, __HIP_MEMORY_SCOPE_WORKGROUP);
        }
        __syncthreads();
        if (tid < 64) { const int c = hist[tid]; basel[tid] = c > 0 ? atomicAdd(cntg + tid, c) : 0; }
        __syncthreads();
        if (tid < 128) {
            const int t = brow + tid; const float wn = 2.5f / wsum;
#pragma unroll
            for (int k = 0; k < 8; ++k) {
                const int e = esel[k], pos = basel[e] + lrank[k];
                tokslot[(size_t)t * 8 + k] = (e << 20) | pos;
                W8[(size_t)t * 8 + k] = ssel[k] * wn;
                LIST[(size_t)e * TT + pos] = t * 8 + k;
            }
        }
    };
    gemm_tiles<false>(lds, tm0 + vcu_id(), TT / 128, gridDim.x, make, epi);
}

__device__ __forceinline__ int moe_find_expert(const LAS int* tp, int mtg) {
    int lo = 0, hi = 64;
    while (lo < hi) { const int mid = (lo + hi + 1) >> 1; if (tp[mid] <= mtg) lo = mid; else hi = mid - 1; }
    return lo;
}
__device__ __forceinline__ void ph_moe1(const Params& p, LAS unsigned char* lds, int l, int row_lo) {
    unsigned char* ws = p.ws;
    moe_tables(p, lds, l, row_lo);
    LAS int* cnt = (LAS int*)(lds + MOE_LDS_OFF); LAS int* tp = cnt + 80; LAS int* sp = tp + 80;
    const bf16* U = (const bf16*)(ws + AM_U8); const bf16* WGU = (const bf16*)(ws + OFF_W_GU); unsigned char* HM = ws + AM_HM;
    const int* LIST = (const int*)(ws + OFF_LIST);
    const int tid = threadIdx.x, lane = tid & 63, wid = tid >> 6, wr = wid >> 1, wc = wid & 1, fr = lane & 15, fq = lane >> 4;
    const int ntiles = tp[65] * 4;
    auto make = [&](int t, GPtrs& g, int& nk) {
        const int mtg = t >> 2, nt = t & 3, e = moe_find_expert(tp, mtg), mt = mtg - tp[e], ce = cnt[e];
        int lv[4];
#pragma unroll
        for (int i = 0; i < 4; ++i) { const int li = mt * 128 + (tid >> 3) + 32 * i; lv[i] = LIST[(size_t)(e < 64 ? e : 0) * TT + (li < ce ? li : 0)]; }
#pragma unroll
        for (int i = 0; i < 4; ++i) {
            const int li = mt * 128 + (tid >> 3) + 32 * i;
            const int tk = li < ce ? (e < 64 ? (lv[i] >> 3) : row_lo + li) : row_lo;
            g.a[i] = U + (size_t)tk * (DM / 2) + stg_col();
        }
        plain_ptrs(WGU + (size_t)e * 512 * (DM / 2), nt * 128, DM / 2, g.b); nk = DM / 128;
    };
    auto epi = [&](int t, f32x4 (&acc)[4][4]) {
        const int mtg = t >> 2, nt = t & 3, e = moe_find_expert(tp, mtg), mt = mtg - tp[e], ce = cnt[e];
        const size_t slot0 = e < 64 ? (size_t)(sp[e] + mt * 128) : (size_t)TT * 8 + row_lo + mt * 128;
        const int hc0 = nt * 64 + wc * 32;
        unsigned char* dump = ws + OFF_DUMP + lane * 64;
        constexpr float isc = 1.f / W8SC;
#pragma unroll
        for (int m = 0; m < 4; ++m) {
            const int i = wr * 64 + m * 16 + fr;
            unsigned char* hrow = (mt * 128 + i < ce) ? HM + (slot0 + i) * 256 + hc0 + fq * 4 : dump;
#pragma unroll
            for (int n = 0; n < 2; ++n) {
                const f32x4 g = acc[m][n] * isc, u = acc[m][n + 2] * (isc * H8SC);
                *(unsigned*)(hrow + n * 16) = pk4_fp8(siluf(g[0]) * u[0], siluf(g[1]) * u[1], siluf(g[2]) * u[2], siluf(g[3]) * u[3]);
            }
        }
    };
    gemm_tiles<true, 8, true>(lds, vcu_id(), ntiles, gridDim.x, make, epi);
}
__device__ __forceinline__ void ph_moe2(const Params& p, LAS unsigned char* lds, int l, int row_lo) {
    unsigned char* ws = p.ws;
    moe_tables(p, lds, l, row_lo);
    LAS int* cnt = (LAS int*)(lds + MOE_LDS_OFF); LAS int* tp = cnt + 80; LAS int* sp = tp + 80;
    const bf16* HM = (const bf16*)(ws + AM_HM); const bf16* WD = (const bf16*)(ws + OFF_W_D);
    const int tid = threadIdx.x, lane = tid & 63, wid = tid >> 6, wr = wid >> 1, wc = wid & 1, fr = lane & 15, fq = lane >> 4;
    const int ntiles = tp[65] * 8;
    auto make = [&](int t, GPtrs& g, int& nk) {
        const int mtg = t >> 3, nt = t & 7, e = moe_find_expert(tp, mtg), mt = mtg - tp[e];
        const size_t slot0 = e < 64 ? (size_t)(sp[e] + mt * 128) : (size_t)TT * 8 + row_lo + mt * 128;
        plain_ptrs(HM, 0, 128, g.a);
#pragma unroll
        for (int i = 0; i < 4; ++i) g.a[i] += slot0 * 128;
        plain_ptrs(WD + (size_t)e * DM * 128, nt * 128, 128, g.b); nk = 256 / 128;
    };
    auto epi = [&](int t, f32x4 (&acc)[4][4]) {
        const int mtg = t >> 3, nt = t & 7, e = moe_find_expert(tp, mtg), mt = mtg - tp[e], ce = cnt[e];
        const size_t slot0 = e < 64 ? (size_t)(sp[e] + mt * 128) : (size_t)TT * 8 + row_lo + mt * 128;
        constexpr float osc = Y8SC / (W8SC * H8SC);
        unsigned char* YR8 = ws + AM_YR; unsigned char* dump = ws + OFF_DUMP + lane * 16;
#pragma unroll
        for (int m = 0; m < 4; ++m) {
            const int i = wr * 64 + m * 16 + fr;
            unsigned char* yrow = (mt * 128 + i < ce) ? YR8 + (slot0 + i) * DM + nt * 128 + wc * 64 + fq * 16 : dump;
            const f32x4 a0 = acc[m][0] * osc, a1 = acc[m][1] * osc, a2 = acc[m][2] * osc, a3 = acc[m][3] * osc;
            *(u32x4*)(yrow) = (u32x4){pk4_fp8(a0[0], a0[1], a0[2], a0[3]), pk4_fp8(a1[0], a1[1], a1[2], a1[3]), pk4_fp8(a2[0], a2[1], a2[2], a2[3]), pk4_fp8(a3[0], a3[1], a3[2], a3[3])};
        }
    };
    gemm_tiles<true, 4, true, true>(lds, vcu_id(), ntiles, gridDim.x, make, epi);
}

__device__ __forceinline__ void ph_inproj1(const Params& p, LAS unsigned char* lds) {
    unsigned char* ws = p.ws;
    const bf16* U = (const bf16*)(ws + OFF_U); const bf16* W = (const bf16*)(ws + OFF_W_IN_O);
    bf16* Z1 = (bf16*)(ws + A1_Z1); bf16* KM = (bf16*)(ws + A1_KM);
    const f32x2* rope = (const f32x2*)(ws + OFF_ROPE);
    const int tid = threadIdx.x, lane = tid & 63, wid = tid >> 6, wr = wid >> 1, wc = wid & 1, fr = lane & 15, fq = lane >> 4;
    constexpr int NTN = 7, NTM = TT / 128;
    auto make = [&](int t, GPtrs& g, int& nk) { int tm, tn; tile_mn(t, NTM, NTN, tm, tn); plain_ptrs(U, tm * 128, DM, g.a); plain_ptrs(W, tn * 128, DM, g.b); nk = DM / 64; };
    auto epi = [&](int t, f32x4 (&acc)[4][4]) {
        int tm, tn; tile_mn(t, NTM, NTN, tm, tn); const int brow = tm * 128, bcol = tn * 128;
        const int cb = bcol + wc * 64;
        LAS unsigned char* wl = lds + 32768 + wid * 8192;
        const int r0 = brow + wr * 64;
        const RowInfo ri0 = rowinfo(r0);
        if (cb < 768) {
            float* ssq = (float*)(ws + OFF_SSQ);
#pragma unroll
            for (int m = 0; m < 4; ++m) {
                float q = 0.f;
#pragma unroll
                for (int n = 0; n < 4; ++n) q += (acc[m][n][0] * acc[m][n][0] + acc[m][n][1] * acc[m][n][1]) + (acc[m][n][2] * acc[m][n][2] + acc[m][n][3] * acc[m][n][3]);
                q += __shfl_xor(q, 16); q += __shfl_xor(q, 32);
                if (fq == 0) ssq[(size_t)(r0 + m * 16 + fr) * 12 + (cb >> 6)] = q;
            }
            epi_store_rows(wl, acc, fr, fq, lane, [&](int row) { return Z1 + (size_t)(r0 + row) * Z1P + cb; });
        } else if (cb == 768) {
#pragma unroll
            for (int m = 0; m < 4; ++m) {
                const int pos = ri0.pos + m * 16 + fr;
#pragma unroll
                for (int n = 0; n < 2; ++n)
#pragma unroll
                    for (int j = 0; j < 4; ++j) {
                        const float x1 = acc[m][n][j], x2 = acc[m][n + 2][j];
                        if (ri0.lat) { const f32x2 cs = rope[(size_t)pos * 32 + n * 16 + fq * 4 + j]; acc[m][n][j] = x1 * cs.x - x2 * cs.y; acc[m][n + 2][j] = x2 * cs.x + x1 * cs.y; }
                    }
                asm volatile("" ::: "memory");
            }
            bf16* dst = KM + ((size_t)(ri0.b * 8) * NKEY + ri0.kq) * 192 + 128;
            epi_store_rows(wl, acc, fr, fq, lane, [&](int row) { return dst + (size_t)row * 192; }, 8, (size_t)NKEY * 192);
        }
    };
    gemm_tiles<true>(lds, vcu_id(), NTM * NTN, gridDim.x, make, epi);
}

__device__ __forceinline__ void ph_mla_up(const Params& p, LAS unsigned char* lds) {
    unsigned char* ws = p.ws;
    const bf16* Z1 = (const bf16*)(ws + A1_Z1); const bf16* WQ = (const bf16*)(ws + OFF_W_UQ); const bf16* WKV = (const bf16*)(ws + OFF_W_UKV);
    bf16* QM = (bf16*)(ws + A1_QM); bf16* KM = (bf16*)(ws + A1_KM); bf16* VTM = (bf16*)(ws + A1_VTM);
    const f32x2* rope = (const f32x2*)(ws + OFF_ROPE);
    const int tid = threadIdx.x, lane = tid & 63, wid = tid >> 6, wr = wid >> 1, wc = wid & 1, fr = lane & 15, fq = lane >> 4;
    LAS float* rsb = (LAS float*)(lds + 66560);
    constexpr int NQ = (TL / 128) * 12, NKV = (TT / 128) * 16;
    constexpr float QSCALE = 0.07216878364870322f * LOG2E;
    auto decode = [&](int t, bool& isq, int& tm, int& tn) { isq = t < NQ; if (isq) { tile_mn(t, TL / 128, 12, tm, tn); tm += 4; } else tile_mn(t - NQ, TT / 128, 16, tm, tn); };
    auto make = [&](int t, GPtrs& g, int& nk) {
        bool isq; int tm, tn; decode(t, isq, tm, tn);
        const int brow = tm * 128, bcol = tn * 128, K = isq ? 512 : 256, acol = isq ? 0 : 512;
        const int par = ((t - vcu_id()) / (int)gridDim.x) & 1;
        if (tid < 128) {
            const float* q = (const float*)(ws + OFF_SSQ) + (size_t)(brow + tid) * 12;
            float ss;
            if (isq) { const f32x4 a = *(const f32x4*)q, b2 = *(const f32x4*)(q + 4); ss = ((a.x + a.y) + (a.z + a.w)) + ((b2.x + b2.y) + (b2.z + b2.w)); }
            else { const f32x4 a = *(const f32x4*)(q + 8); ss = (a.x + a.y) + (a.z + a.w); }
            rsb[par * 128 + tid] = rsqrtf(ss / (float)K + RMS_EPS);
        }
        plain_ptrs(Z1 + acol, brow, Z1P, g.a); plain_ptrs(isq ? WQ : WKV, bcol, K, g.b); nk = K / 64;
    };
    auto epi = [&](int t, f32x4 (&acc)[4][4]) {
        bool isq; int tm, tn; decode(t, isq, tm, tn);
        const int brow = tm * 128, bcol = tn * 128;
        const int par = ((t - vcu_id()) / (int)gridDim.x) & 1;
        const int cb = bcol + wc * 64;
        LAS unsigned char* wl = lds + 32768 + wid * 8192;
        const int r0 = brow + wr * 64;
        const RowInfo ri0 = rowinfo(r0);
        if (isq) {
            const int h = cb / 192, part = (cb % 192) >> 6;
#pragma unroll
            for (int m = 0; m < 4; ++m) {
                const float sc = rsb[par * 128 + wr * 64 + m * 16 + fr] * QSCALE;
                const int pos = ri0.pos + m * 16 + fr;
                if (part < 2) {
#pragma unroll
                    for (int n = 0; n < 4; ++n) acc[m][n] = acc[m][n] * sc;
                } else {
#pragma unroll
                    for (int n = 0; n < 2; ++n)
#pragma unroll
                        for (int j = 0; j < 4; ++j) {
                            const float x1 = acc[m][n][j] * sc, x2 = acc[m][n + 2][j] * sc;
                            const f32x2 cs = rope[(size_t)pos * 32 + n * 16 + fq * 4 + j];
                            acc[m][n][j] = x1 * cs.x - x2 * cs.y; acc[m][n + 2][j] = x2 * cs.x + x1 * cs.y;
                        }
                }
                asm volatile("" ::: "memory");
            }
            bf16* dst = QM + ((size_t)(ri0.b * 8 + h) * SEQ + ri0.pos) * 192 + part * 64;
            epi_store_rows(wl, acc, fr, fq, lane, [&](int row) { return dst + (size_t)row * 192; });
        } else {
            const int h = cb >> 8, part = (cb & 255) >> 6;
#pragma unroll
            for (int m = 0; m < 4; ++m) {
                const float rs = rsb[par * 128 + wr * 64 + m * 16 + fr];
#pragma unroll
                for (int n = 0; n < 4; ++n) acc[m][n] = acc[m][n] * rs;
            }
            if (part < 2) {
                bf16* dst = KM + ((size_t)(ri0.b * 8 + h) * NKEY + ri0.kq) * 192 + part * 64;
                epi_store_rows(wl, acc, fr, fq, lane, [&](int row) { return dst + (size_t)row * 192; });
            } else {
                bf16* dst = VTM + ((size_t)(ri0.b * 8 + h) * 128 + (part - 2) * 64) * NKEY + ri0.kq;
                epi_store_cols(wl, acc, fr, fq, lane, [&](int col) { return dst + (size_t)col * NKEY; });
            }
        }
    };
    gemm_tiles<true>(lds, vcu_id(), NQ + NKV, gridDim.x, make, epi);
}

__device__ __forceinline__ void ph_mla_attn(const Params& p, LAS unsigned char* lds) {
    unsigned char* ws = p.ws;
    const bf16* QM = (const bf16*)(ws + A1_QM); const bf16* KM = (const bf16*)(ws + A1_KM); const bf16* VTM = (const bf16*)(ws + A1_VTM); bf16* MIX = (bf16*)(ws + A1_MIX);
    for (int item = vcu_id(); item < 2 * 8 * 64; item += gridDim.x) {
        const int qt = item & 63, h = (item >> 6) & 7, b = item >> 9;
        const bf16* Qg = QM + ((size_t)(b * 8 + h) * SEQ + qt * 128) * 192;
        const bf16* Kg = KM + (size_t)(b * 8 + h) * NKEY * 192;
        const bf16* Vg = VTM + (size_t)(b * 8 + h) * 128 * NKEY;
        attn_item<192, 128>(lds, Qg, Kg, Vg, NKEY / 32, 0, 0, 0, -1e30f, 0.f, MIX + (size_t)(TC + b * SEQ + qt * 128) * DM + h * 128, DM);
    }
}


#define XB_TMO      128
#define XB_XCNT(j)  (256  + 64 * (j))
#define XB_XSUB(j)  (1280 + 64 * (j))
#define XB_XGEN(j)  (2304 + 64 * (j))
#define XB_TOP      3328
#define XB_TOPGEN   3392
#define XCD_BAR_WORDS 3456
#define XB_SPIN_CAP (1u << 18)
__device__ __forceinline__ unsigned xb_ld(unsigned* p)              { return __hip_atomic_load(p, __ATOMIC_RELAXED, __HIP_MEMORY_SCOPE_AGENT); }
__device__ __forceinline__ unsigned xb_add(unsigned* p, unsigned v) { return __hip_atomic_fetch_add(p, v, __ATOMIC_RELAXED, __HIP_MEMORY_SCOPE_AGENT); }
__device__ __forceinline__ unsigned xb_xcc_id() { return (unsigned)__builtin_amdgcn_s_getreg((3 << 11) | 20) & 0xFu; }
#define XB_SPIN(cond, bar) do { unsigned _sp = 0; while (cond) { __builtin_amdgcn_s_sleep(1); \
    if ((++_sp & 255u) == 0u) { if (xb_ld(&(bar)[XB_TMO])) break; if (_sp > XB_SPIN_CAP) { atomicAdd(&(bar)[XB_TMO], 1u); break; } } } } while (0)
struct XcdBarrier { unsigned* bar; unsigned x; volatile LAS unsigned* st; };
__device__ __forceinline__ XcdBarrier xcd_barrier_post(unsigned* bar, volatile LAS unsigned* st) {
    XcdBarrier b; b.bar = bar; b.x = xb_xcc_id(); b.st = st;
    if (threadIdx.x == 0) (void)xb_add(&bar[XB_XCNT(b.x)], 1u);
    return b;
}
__device__ __forceinline__ void xcd_barrier_complete(unsigned* bar, unsigned x, unsigned& nloc, unsigned& nx) {
    const unsigned G = gridDim.x * gridDim.y * gridDim.z;
    unsigned sum, cnt, mine, sp = 0u;
    for (;;) {
        sum = 0u; cnt = 0u; mine = 0u;
#pragma unroll
        for (unsigned j = 0; j < 16; ++j) { const unsigned c = xb_ld(&bar[XB_XCNT(j)]); sum += c; cnt += (c > 0u) ? 1u : 0u; mine = (j == x) ? c : mine; }
        if (sum == G) break;
        __builtin_amdgcn_s_sleep(1);
        if ((++sp & 255u) == 0u) { if (xb_ld(&bar[XB_TMO])) break; if (sp > XB_SPIN_CAP) { atomicAdd(&bar[XB_TMO], 1u); break; } }
    }
    nloc = mine > 0u ? mine : 1u; nx = cnt > 0u ? cnt : 1u;
}
__device__ __forceinline__ void xcd_barrier(const XcdBarrier& b) {
    asm volatile("s_waitcnt vmcnt(0)" ::: "memory");
    __syncthreads();
    if (threadIdx.x == 0) {
        unsigned* bar = b.bar;
        __builtin_amdgcn_s_waitcnt(0);
        unsigned nloc = b.st[0], nx = b.st[1];
        if (nloc == 0u) { xcd_barrier_complete(bar, b.x, nloc, nx); b.st[0] = nloc; b.st[1] = nx; }
        const unsigned old = xb_add(&bar[XB_XSUB(b.x)], 1u);
        const unsigned gen = old / nloc;
        if (old + 1u == (gen + 1u) * nloc) {
            __builtin_amdgcn_fence(__ATOMIC_RELEASE, "agent");
            asm volatile("s_waitcnt vmcnt(0)" ::: "memory");
            const unsigned og = xb_add(&bar[XB_TOP], 1u);
            const unsigned tg = og / nx;
            if (og + 1u == (tg + 1u) * nx) xb_add(&bar[XB_TOPGEN], 1u);
            else XB_SPIN(xb_ld(&bar[XB_TOPGEN]) == tg, bar);
            __builtin_amdgcn_fence(__ATOMIC_ACQUIRE, "agent");
            xb_add(&bar[XB_XGEN(b.x)], 1u);
            asm volatile("s_waitcnt vmcnt(0)" ::: "memory");
        } else {
            XB_SPIN(xb_ld(&bar[XB_XGEN(b.x)]) == gen, bar);
            __builtin_amdgcn_fence(__ATOMIC_ACQUIRE, "agent");
            asm volatile("s_waitcnt vmcnt(0)" ::: "memory");
        }
    }
    __syncthreads();
}
static_assert(XCD_BAR_WORDS * 4 <= BAR_BYTES, "barrier words");

__device__ __forceinline__ void convert_shared(const Params& p, LAS unsigned char* lds, int l, int nrt) {
    const int v = vcu_id(), G = gridDim.x, nfree = G - nrt, nslots = 2 * nfree + nrt;
    if (v >= nrt) {
        const int j = v - nrt;
        for (int it = 2 * j; it < EXP_ITEMS; it += nslots) expert_convert_item(p, lds, l, it);
        for (int it = 2 * j + 1; it < EXP_ITEMS; it += nslots) expert_convert_item(p, lds, l, it);
    } else {
        for (int it = 2 * nfree + v; it < EXP_ITEMS; it += nslots) expert_convert_item(p, lds, l, it);
    }
}

constexpr int NPHASE = 19;
__global__ void __launch_bounds__(256, 2) mega(Params p) {
    extern __shared__ __attribute__((aligned(16))) unsigned char lds_[];
    LAS unsigned char* lds = (LAS unsigned char*)lds_;
    cg::grid_group grid = cg::this_grid();
    unsigned char* ws = p.ws;
    volatile LAS unsigned* bst = (volatile LAS unsigned*)(lds + LDS_BYTES - 16);
    if (threadIdx.x < 4) bst[threadIdx.x] = 0u;
    __syncthreads();
    const XcdBarrier xbar = xcd_barrier_post((unsigned*)(ws + OFF_BAR), bst);
#define GRID_BAR(k) do { if ((k) == 0) grid.sync(); else xcd_barrier(xbar); } while (0)
#ifndef PROBE_REP_MASK
#define PROBE_REP_MASK 0u
#endif
#ifndef PROBE_EXTRA_SYNCS
#define PROBE_EXTRA_SYNCS 0
#endif
#define PHASE(k, body) do { if (p.ph_lo <= (k) && (k) < p.ph_hi) { body; if ((PROBE_REP_MASK >> (k)) & 1u) { xcd_barrier(xbar); body; } if ((k) + 1 < p.ph_hi) GRID_BAR(k); } } while (0)
    for (int i = 0; i < PROBE_EXTRA_SYNCS; ++i) xcd_barrier(xbar);
    PHASE(0, ph_prep(p, lds));
    PHASE(1, ph_modulate0(p));
    PHASE(2, ph_inproj0(p, lds));
    PHASE(3, ph_swa_g1(p, lds));
    PHASE(4, ph_gla_scan(p));
    PHASE(5, ph_gla_g3(p, lds));
    PHASE(6, ph_outproj(p, lds, (const bf16*)(ws + A0_MIX), (const bf16*)(ws + OFF_W_OUT_E), (float*)(ws + A0_Y), 0));
    PHASE(7, ph_rowpassA(p, 0, 0, (const float*)(ws + A0_Y)));
    PHASE(8, { ph_router(p, lds, 0, 0); __syncthreads(); convert_shared(p, lds, 0, TT / 128); });
    PHASE(9, ph_moe1(p, lds, 0, 0));
    PHASE(10, ph_moe2(p, lds, 0, 0));
    PHASE(11, ph_rowpassB(p, lds, 0, 0));
    PHASE(12, ph_inproj1(p, lds));
    PHASE(13, ph_mla_up(p, lds));
    PHASE(14, ph_mla_attn(p, lds));
    PHASE(15, ph_outproj(p, lds, (const bf16*)(ws + A1_MIX), (const bf16*)(ws + OFF_W_OUT_O), (float*)(ws + A1_Y), TC));
    PHASE(16, ph_rowpassA(p, 1, TC, (const float*)(ws + A1_Y)));
    PHASE(17, { ph_router(p, lds, 1, TC); __syncthreads(); convert_shared(p, lds, 1, TL / 128); });
    PHASE(18, ph_moe1(p, lds, 1, TC));
    PHASE(19, ph_moe2(p, lds, 1, TC));
    PHASE(20, ph_rowpassB(p, lds, 1, TC));
}

extern "C" void kernel_launch(void* const* d_in, const int* in_sizes, int n_in, void* d_out, int out_size, void* d_ws, size_t ws_size, hipStream_t stream) {
    static int grid_blocks = 0;
    if (!grid_blocks) {
        int dev = 0, cus = 0, per_cu = 0;
        (void)hipGetDevice(&dev);
        (void)hipDeviceGetAttribute(&cus, hipDeviceAttributeMultiprocessorCount, dev);
        (void)hipFuncSetAttribute((const void*)mega, hipFuncAttributeMaxDynamicSharedMemorySize, LDS_BYTES);
        (void)hipOccupancyMaxActiveBlocksPerMultiprocessor(&per_cu, (const void*)mega, 256, LDS_BYTES);
        if (per_cu > 2) per_cu = 2;
        if (per_cu < 1) per_cu = 1;
        grid_blocks = cus * per_cu;
        if (ws_size < WS_NEED) fprintf(stderr, "kernel_launch: workspace too small: %zu < %zu\n", ws_size, (size_t)WS_NEED);
    }
    Params p{};
    const float** f = (const float**)&p;
    for (int i = 0; i < 30; ++i) f[i] = (const float*)d_in[i];
    p.out = (float*)d_out; p.ws = (unsigned char*)d_ws; p.ph_lo = 0; p.ph_hi = 21;
    (void)hipMemsetAsync((unsigned char*)d_ws + OFF_BAR, 0, BAR_BYTES, stream);
    void* args[] = {&p};
    hipError_t e = hipLaunchCooperativeKernel((const void*)mega, dim3(grid_blocks), dim3(256), args, LDS_BYTES, stream);
    if (e != hipSuccess) fprintf(stderr, "cooperative launch failed: %s (grid %d)\n", hipGetErrorString(e), grid_blocks);
}
```

```cpp
#include <hip/hip_runtime.h>
#include <hip/hip_cooperative_groups.h>
#include <cstdio>
#include <cstdint>
namespace cg = cooperative_groups;

#define LAS __attribute__((address_space(3)))
typedef unsigned short bf16;
typedef short bf16x8 __attribute__((ext_vector_type(8)));
typedef float f32x2 __attribute__((ext_vector_type(2)));
typedef float f32x4 __attribute__((ext_vector_type(4)));
typedef float f32x8 __attribute__((ext_vector_type(8)));
typedef float f32x16 __attribute__((ext_vector_type(16)));
typedef unsigned u32x2 __attribute__((ext_vector_type(2)));
typedef unsigned u32x4 __attribute__((ext_vector_type(4)));
typedef __bf16 bf16x2_t __attribute__((ext_vector_type(2)));

constexpr int DM = 1024, NB = 2, SEQ = 8192, CTX = 256;
constexpr int TC = NB * CTX, TL = NB * SEQ, TT = TC + TL, NKEY = CTX + SEQ;
constexpr int NEXP = 64;
constexpr float RMS_EPS = 1e-6f;
constexpr int E_IN_PAD = 2432, O_IN_PAD = 896;
constexpr float LOG2E = 1.4426950408889634f;
constexpr int NSTEP = 132;
constexpr int Z0P = 1056;
constexpr int Z1P = 768;
constexpr int LDS_BYTES = 73728;

constexpr size_t al(size_t x) { return (x + 255) & ~(size_t)255; }
constexpr size_t OFF_W_IN_E = 0;
constexpr size_t OFF_W_OUT_E = OFF_W_IN_E + al((size_t)E_IN_PAD * DM * 2);
constexpr size_t OFF_W_IN_O = OFF_W_OUT_E + al((size_t)DM * DM * 2);
constexpr size_t OFF_W_UQ = OFF_W_IN_O + al((size_t)O_IN_PAD * DM * 2);
constexpr size_t OFF_W_UKV = OFF_W_UQ + al((size_t)1536 * 512 * 2);
constexpr size_t OFF_W_OUT_O = OFF_W_UKV + al((size_t)2048 * 256 * 2);
constexpr size_t OFF_W_RT = OFF_W_OUT_O + al((size_t)DM * DM * 2);
constexpr size_t OFF_W_GU = OFF_W_RT + al((size_t)2 * 128 * DM * 2);
constexpr size_t OFF_W_D = OFF_W_GU + al((size_t)65 * 512 * DM * 2);
constexpr size_t OFF_U = OFF_W_D + al((size_t)65 * DM * 256 * 2);
constexpr size_t OFF_HC = OFF_U + al((size_t)TT * DM * 2);
constexpr size_t OFF_MOD = OFF_HC + al((size_t)TC * DM * 4);
constexpr size_t OFF_ROPE = OFF_MOD + al((size_t)2 * 3 * 6144 * 4);
constexpr size_t OFF_CNT = OFF_ROPE + al((size_t)SEQ * 32 * 8);
constexpr size_t OFF_TOKSLOT = OFF_CNT + al(2 * 64 * 4);
constexpr size_t OFF_W8 = OFF_TOKSLOT + al((size_t)TT * 8 * 4);
constexpr size_t OFF_LIST = OFF_W8 + al((size_t)TT * 8 * 4);
constexpr size_t OFF_SSQ = OFF_LIST + al((size_t)64 * TT * 4);
constexpr size_t OFF_DUMP = OFF_SSQ + al((size_t)TT * 12 * 4);
constexpr size_t OFF_BAR = OFF_DUMP + 8192;
constexpr size_t BAR_BYTES = 16384;
constexpr size_t OFF_ARENA = OFF_BAR + BAR_BYTES;
constexpr size_t A0_Z0 = OFF_ARENA;
constexpr size_t A0_VGT = A0_Z0 + al((size_t)TT * Z0P * 2);
constexpr size_t A0_QS = A0_VGT + al((size_t)4 * 128 * TT * 2);
constexpr size_t A0_KS = A0_QS + al((size_t)2 * 8 * NKEY * 64 * 2);
constexpr size_t A0_VST = A0_KS + al((size_t)2 * 2 * NKEY * 64 * 2);
constexpr size_t A0_GS = A0_VST + al((size_t)2 * 2 * 64 * NKEY * 2);
constexpr size_t A0_GD = A0_GS + al((size_t)16 * NSTEP * 8192 * 4);
constexpr size_t A0_MIX = A0_GD + al((size_t)16 * NSTEP * 64 * 4);
constexpr size_t A0_Y = A0_MIX + al((size_t)TT * DM * 2);
constexpr size_t A0_END = A0_Y + al((size_t)TT * DM * 4);
constexpr size_t A1_Z1 = OFF_ARENA;
constexpr size_t A1_QM = A1_Z1 + al((size_t)TT * Z1P * 2);
constexpr size_t A1_KM = A1_QM + al((size_t)2 * 8 * SEQ * 192 * 2);
constexpr size_t A1_VTM = A1_KM + al((size_t)2 * 8 * NKEY * 192 * 2);
constexpr size_t A1_MIX = A1_VTM + al((size_t)2 * 8 * 128 * NKEY * 2);
constexpr size_t A1_Y = A1_MIX + al((size_t)TT * DM * 2);
constexpr size_t A1_END = A1_Y + al((size_t)TT * DM * 4);
constexpr size_t AM_U8 = OFF_ARENA;
constexpr size_t AM_HM = AM_U8 + al((size_t)TT * 1024);
constexpr size_t AM_YR = AM_HM + al((size_t)TT * 9 * 256);
constexpr size_t AM_END = AM_YR + al((size_t)TT * 9 * 1024 * 2);
constexpr size_t WS_NEED = AM_END > A0_END ? (AM_END > A1_END ? AM_END : A1_END) : (A0_END > A1_END ? A0_END : A1_END);
static_assert(WS_NEED <= 555747360ull, "workspace map exceeds the guaranteed d_ws size");

struct Params {
    const float *x, *c, *ctx, *c_ctx, *w_mod, *b_mod, *g_mix_pre, *g_mix_post, *g_ffn_pre, *g_ffn_post;
    const float *w_in_e, *gla_wa2, *gla_ba, *gla_norm, *swa_sink, *w_out_e;
    const float *w_in_o, *mla_q_norm, *mla_kv_norm, *w_uq, *w_ukv, *w_out_o;
    const float *w_router, *b_router, *w_exp_gate, *w_exp_up, *w_exp_down, *w_sh_gate, *w_sh_up, *w_sh_down;
    float* out; unsigned char* ws; int ph_lo, ph_hi;
};

__device__ __forceinline__ unsigned pk2(float lo, float hi) { f32x2 v = {lo, hi}; bf16x2_t b = __builtin_convertvector(v, bf16x2_t); return __builtin_bit_cast(unsigned, b); }
__device__ __forceinline__ float bflo(unsigned u) { return __uint_as_float(u << 16); }
__device__ __forceinline__ float bfhi(unsigned u) { return __uint_as_float(u & 0xffff0000u); }
__device__ __forceinline__ float bf2f(bf16 v) { return __uint_as_float((unsigned)v << 16); }
__device__ __forceinline__ bf16 f2bf(float f) { return (bf16)(pk2(f, 0.f) & 0xffffu); }
constexpr float W8SC = 64.f, H8SC = 4.f, Y8SC = 16.f;
__device__ __forceinline__ unsigned pk4_fp8(float a, float b, float c, float d) { int w = 0; w = __builtin_amdgcn_cvt_pk_fp8_f32(a, b, w, false); w = __builtin_amdgcn_cvt_pk_fp8_f32(c, d, w, true); return (unsigned)w; }
__device__ __forceinline__ float wave_sum(float v) {
#pragma unroll
    for (int o = 1; o < 64; o <<= 1) v += __shfl_xor(v, o);
    return v;
}
__device__ __forceinline__ void glds16(const void* g, LAS void* l) { __builtin_amdgcn_global_load_lds((const unsigned*)g, (LAS unsigned*)l, 16, 0, 0); }
__device__ __forceinline__ float siluf(float x) { return x / (1.f + __expf(-x)); }
__device__ __forceinline__ float ex2(float x) { return __builtin_amdgcn_exp2f(x); }
__device__ __forceinline__ int crow(int r, int hi) { return (r & 3) + 8 * (r >> 2) + 4 * hi; }
__device__ __forceinline__ bf16x8 mk8(u32x4 v) { return __builtin_bit_cast(bf16x8, v); }

struct RowInfo { int b, kq, pos; bool lat; };
__device__ __forceinline__ RowInfo rowinfo(int r) {
    RowInfo i;
    if (r < TC) { i.b = r >> 8; i.pos = r & 255; i.kq = i.pos; i.lat = false; }
    else { const int rl = r - TC; i.b = rl >> 13; i.pos = rl & (SEQ - 1); i.kq = CTX + i.pos; i.lat = true; }
    return i;
}
__device__ __forceinline__ int modvec(int r) { return r < TC ? 2 : ((r - TC) >> 13); }

struct GPtrs { const bf16* a[4]; const bf16* b[4]; };
constexpr int G_STAGE = 32768;
#define G_FENCE() asm volatile("" ::: "memory")
__device__ __forceinline__ void gemm_issue(LAS unsigned char* lds, const GPtrs& g, int kt) {
    LAS unsigned char* d = lds + (kt & 1) * G_STAGE + threadIdx.x * 16; const int ko = kt * 64;
#pragma unroll
    for (int i = 0; i < 4; ++i) { glds16(g.a[i] + ko, d + i * 4096); glds16(g.b[i] + ko, d + 16384 + i * 4096); }
}
__device__ __forceinline__ void gemm_prologue(LAS unsigned char* lds, const GPtrs& g, int nk) { gemm_issue(lds, g, 0); }
__device__ __forceinline__ void gemm_prologue2(LAS unsigned char* lds, const GPtrs& g) { gemm_issue(lds, g, 0); gemm_issue(lds, g, 1); }
template <int NST, bool FP8 = false, bool PRE2 = false>
__device__ __forceinline__ void gemm_main(LAS unsigned char* lds, const GPtrs& g, int nk, f32x4 (&acc)[4][4], bool after_epi) {
    const int tid = threadIdx.x, lane = tid & 63, wid = tid >> 6, wr = wid >> 1, wc = wid & 1, fr = lane & 15, fq = lane >> 4;
#pragma unroll
    for (int m = 0; m < 4; ++m)
#pragma unroll
        for (int n = 0; n < 4; ++n) acc[m][n] = (f32x4){0.f, 0.f, 0.f, 0.f};
    const int c0 = ((fq) ^ (fr & 7)) * 16, c1 = ((4 + fq) ^ (fr & 7)) * 16;
    const int aoff = (wr * 64 + fr) * 128, boff = 16384 + (wc * 64 + fr) * 128;
    for (int kt = 0; kt < nk; ++kt) {
        if (PRE2) {
            static_assert(!PRE2 || NST == 4 || NST < 0, "PRE2 counted waits are written for 4 epilogue stores");
            if (kt == 0) { if (after_epi) asm volatile("s_waitcnt vmcnt(12) lgkmcnt(0)" ::: "memory"); else asm volatile("s_waitcnt vmcnt(8) lgkmcnt(0)" ::: "memory"); }
            else { if (after_epi) asm volatile("s_waitcnt vmcnt(4) lgkmcnt(0)" ::: "memory"); else asm volatile("s_waitcnt vmcnt(0) lgkmcnt(0)" ::: "memory"); }
        } else
        if (NST == 8 && kt == 0 && after_epi) asm volatile("s_waitcnt vmcnt(8) lgkmcnt(0)" ::: "memory");
        else if (NST == 16 && kt == 0 && after_epi) asm volatile("s_waitcnt vmcnt(16) lgkmcnt(0)" ::: "memory");
        else asm volatile("s_waitcnt vmcnt(0) lgkmcnt(0)" ::: "memory");
        __builtin_amdgcn_s_barrier();
        G_FENCE();
        if (!PRE2 && kt + 1 < nk) gemm_issue(lds, g, kt + 1);
        LAS unsigned char* base = lds + (kt & 1) * G_STAGE;
        if constexpr (FP8) {
            long a8[4][4], b8[4][4];
#pragma unroll
            for (int ks = 0; ks < 4; ++ks) {
                const int co = (((ks * 2 + (fq >> 1)) ^ (fr & 7)) * 16) + (fq & 1) * 8;
#pragma unroll
                for (int m = 0; m < 4; ++m) a8[ks][m] = *(const LAS long*)(base + aoff + m * 2048 + co);
#pragma unroll
                for (int n = 0; n < 4; ++n) b8[ks][n] = *(const LAS long*)(base + boff + n * 2048 + co);
            }
            __builtin_amdgcn_s_setprio(1);
#pragma unroll
            for (int ks = 0; ks < 4; ++ks)
#pragma unroll
                for (int m = 0; m < 4; ++m)
#pragma unroll
                    for (int n = 0; n < 4; ++n) acc[m][n] = __builtin_amdgcn_mfma_f32_16x16x32_fp8_fp8(b8[ks][n], a8[ks][m], acc[m][n], 0, 0, 0);
            __builtin_amdgcn_s_setprio(0);
            continue;
        }
        bf16x8 af0[4], bf0[4], af1[4], bf1[4];
#pragma unroll
        for (int m = 0; m < 4; ++m) af0[m] = *(const LAS bf16x8*)(base + aoff + m * 2048 + c0);
#pragma unroll
        for (int n = 0; n < 4; ++n) bf0[n] = *(const LAS bf16x8*)(base + boff + n * 2048 + c0);
#pragma unroll
        for (int m = 0; m < 4; ++m) af1[m] = *(const LAS bf16x8*)(base + aoff + m * 2048 + c1);
#pragma unroll
        for (int n = 0; n < 4; ++n) bf1[n] = *(const LAS bf16x8*)(base + boff + n * 2048 + c1);
        __builtin_amdgcn_s_setprio(1);
#pragma unroll
        for (int m = 0; m < 4; ++m)
#pragma unroll
            for (int n = 0; n < 4; ++n) acc[m][n] = __builtin_amdgcn_mfma_f32_16x16x32_bf16(bf0[n], af0[m], acc[m][n], 0, 0, 0);
#pragma unroll
        for (int m = 0; m < 4; ++m)
#pragma unroll
            for (int n = 0; n < 4; ++n) acc[m][n] = __builtin_amdgcn_mfma_f32_16x16x32_bf16(bf1[n], af1[m], acc[m][n], 0, 0, 0);
        __builtin_amdgcn_s_setprio(0);
    }
    asm volatile("s_waitcnt lgkmcnt(0)" ::: "memory");
    __builtin_amdgcn_s_barrier();
    G_FENCE();
}
__device__ __forceinline__ int vcu_id() { const int b = blockIdx.x, G = gridDim.x; return (G % 8 == 0) ? (b % 8) * (G / 8) + b / 8 : b; }
__device__ __forceinline__ void tile_mn(int w, int ntm, int ntn, int& tm, int& tn) {
    const int nig = 8 * ntn, gid = w / nig, fm = gid * 8, gsz = (ntm - fm) < 8 ? (ntm - fm) : 8, within = w - gid * nig;
    tm = fm + within % gsz; tn = within / gsz;
}
template <bool PREFETCH_NEXT, int NST = -1, bool FP8 = false, bool PRE2 = false, class Make, class Epi>
__device__ __forceinline__ void gemm_tiles(LAS unsigned char* lds, int t0, int nt, int stride, Make make, Epi epi) {
    if (t0 >= nt) return;
    GPtrs g; int nk;
    make(t0, g, nk);
    G_FENCE();
    if (PRE2) gemm_prologue2(lds, g); else gemm_prologue(lds, g, nk);
    bool first = true;
    for (int t = t0; t < nt;) {
        const int tn = t + stride;
        f32x4 acc[4][4];
        gemm_main<PREFETCH_NEXT ? NST : -1, FP8, PRE2>(lds, g, nk, acc, !first);
        first = false;
        if (PREFETCH_NEXT) { if (tn < nt) { make(tn, g, nk); G_FENCE(); if (PRE2) gemm_prologue2(lds, g); else gemm_prologue(lds, g, nk); } epi(t, acc); }
        else { epi(t, acc); __syncthreads(); if (tn < nt) { make(tn, g, nk); G_FENCE(); gemm_prologue(lds, g, nk); } }
        t = tn;
    }
}

template <class RowPtr>
__device__ __forceinline__ void epi_store_rows(LAS unsigned char* wl, const f32x4 (&v)[4][4], int fr, int fq, int lane, RowPtr rowptr, int nrep = 1, size_t rep_stride = 0) {
#pragma unroll
    for (int m = 0; m < 4; ++m)
#pragma unroll
        for (int n = 0; n < 4; ++n)
            *(LAS u32x2*)(wl + (m * 16 + fr) * 128 + (((n * 2 + (fq >> 1)) ^ (fr & 7)) * 16) + (fq & 1) * 8) = (u32x2){pk2(v[m][n][0], v[m][n][1]), pk2(v[m][n][2], v[m][n][3])};
#pragma unroll
    for (int i = 0; i < 8; ++i) {
        const int row = (lane >> 3) + 8 * i, pos = lane & 7;
        const u32x4 w = *(const LAS u32x4*)(wl + row * 128 + pos * 16);
        bf16* d = rowptr(row);
        if (d) { d += (pos ^ (row & 7)) * 8; for (int r = 0; r < nrep; ++r) *(u32x4*)(d + (size_t)r * rep_stride) = w; }
    }
}
template <class ColPtr>
__device__ __forceinline__ void epi_store_cols(LAS unsigned char* wl, const f32x4 (&v)[4][4], int fr, int fq, int lane, ColPtr colptr) {
    LAS unsigned char* wb = wl + fq * 512 + fr * 2;
#pragma unroll
    for (int m = 0; m < 4; ++m)
#pragma unroll
        for (int n = 0; n < 4; ++n)
#pragma unroll
            for (int j = 0; j < 4; ++j) *(LAS bf16*)(wb + n * 2048 + j * 128 + m * 32) = f2bf(v[m][n][j]);
#pragma unroll
    for (int i = 0; i < 8; ++i) {
        const int col = (lane >> 3) + 8 * i, pos = lane & 7;
        const u32x4 w = *(const LAS u32x4*)(wl + col * 128 + pos * 16);
        bf16* d = colptr(col);
        *(u32x4*)(d + pos * 8) = w;
    }
}

__device__ __forceinline__ int ein_map(int n) {
    if (n < 512) return n;
    if (n < 1024) return n + 512;
    if (n < 1536) return n - 512;
    if (n < 2048) return 1568 + (n - 1536);
    if (n < 2176) return 2080 + (n - 2048);
    if (n < 2304) return 2208 + (n - 2176);
    if (n < 2320) return 1536 + (n - 2304);
    if (n < 2336) return 1552 + (n - 2320);
    return -1;
}
template <bool FP8 = false>
__device__ __forceinline__ void transpose_item(LAS unsigned char* lds, int K, bf16* dst, int k0, int n0, int ld, int mode, const float* srcA, const float* srcB, int nvalid, const float* kscale) {
    LAS float* tile = (LAS float*)lds;
    const int tid = threadIdx.x;
    {
        const int nq = tid & 31, kr = tid >> 5, n = n0 + nq * 4;
        const float* cp = nullptr; float sc = 1.f;
        if (mode == 0) { if (n < nvalid) cp = srcA + n; }
        else if (mode == 1) { const int c = ein_map(n); if (c >= 0) cp = srcA + c; if (n < 256) sc = 0.125f; }
        else if (mode == 2) { const int grp = n >> 6, w = n & 63; cp = (w < 32 ? srcA : srcB) + grp * 32 + (w & 31); }
        else { const int b6 = n & 63; cp = srcA + (n & ~63) + ((b6 >> 2) & 3) * 16 + (b6 >> 4) * 4; }
        f32x4 v[8];
#pragma unroll
        for (int i = 0; i < 8; ++i) { const int k = kr + 8 * i; v[i] = cp ? *(const f32x4*)(cp + (size_t)(k0 + k) * ld) : (f32x4){0.f, 0.f, 0.f, 0.f}; }
#pragma unroll
        for (int i = 0; i < 8; ++i) { const int k = kr + 8 * i; float m = sc; if (kscale) m *= kscale[k0 + k]; *(LAS f32x4*)(tile + k * 132 + nq * 4) = v[i] * m; }
    }
    __syncthreads();
    {
        const int n = tid >> 1, hf = tid & 1;
        if constexpr (FP8) {
            unsigned char* d8 = (unsigned char*)dst;
#pragma unroll
            for (int c = 0; c < 2; ++c) {
                const int k16 = hf * 32 + c * 16;
                u32x4 o;
                o.x = pk4_fp8(tile[(k16 + 0) * 132 + n] * W8SC, tile[(k16 + 1) * 132 + n] * W8SC, tile[(k16 + 2) * 132 + n] * W8SC, tile[(k16 + 3) * 132 + n] * W8SC);
                o.y = pk4_fp8(tile[(k16 + 4) * 132 + n] * W8SC, tile[(k16 + 5) * 132 + n] * W8SC, tile[(k16 + 6) * 132 + n] * W8SC, tile[(k16 + 7) * 132 + n] * W8SC);
                o.z = pk4_fp8(tile[(k16 + 8) * 132 + n] * W8SC, tile[(k16 + 9) * 132 + n] * W8SC, tile[(k16 + 10) * 132 + n] * W8SC, tile[(k16 + 11) * 132 + n] * W8SC);
                o.w = pk4_fp8(tile[(k16 + 12) * 132 + n] * W8SC, tile[(k16 + 13) * 132 + n] * W8SC, tile[(k16 + 14) * 132 + n] * W8SC, tile[(k16 + 15) * 132 + n] * W8SC);
                *(u32x4*)(d8 + (size_t)(n0 + n) * K + k0 + k16) = o;
            }
        } else
#pragma unroll
        for (int c = 0; c < 4; ++c) {
            const int k8 = hf * 32 + c * 8;
            u32x4 o;
            o.x = pk2(tile[(k8 + 0) * 132 + n], tile[(k8 + 1) * 132 + n]);
            o.y = pk2(tile[(k8 + 2) * 132 + n], tile[(k8 + 3) * 132 + n]);
            o.z = pk2(tile[(k8 + 4) * 132 + n], tile[(k8 + 5) * 132 + n]);
            o.w = pk2(tile[(k8 + 6) * 132 + n], tile[(k8 + 7) * 132 + n]);
            *(u32x4*)(dst + (size_t)(n0 + n) * K + k0 + k8) = o;
        }
    }
    __syncthreads();
}

constexpr int EXP_GU_ITEMS = 65 * 16 * 4, EXP_D_ITEMS = 65 * 4 * 8, EXP_ITEMS = EXP_GU_ITEMS + EXP_D_ITEMS;
__device__ __forceinline__ void expert_convert_item(const Params& p, LAS unsigned char* lds, int l, int it) {
    unsigned char* ws = p.ws;
    if (it < EXP_GU_ITEMS) {
        const int e = it / 64, r = it % 64, kb = r / 4, nb = r % 4;
        const float* gate = e < 64 ? p.w_exp_gate + ((size_t)(l * 64 + e)) * DM * 256 : p.w_sh_gate + (size_t)l * DM * 256;
        const float* up = e < 64 ? p.w_exp_up + ((size_t)(l * 64 + e)) * DM * 256 : p.w_sh_up + (size_t)l * DM * 256;
        transpose_item<true>(lds, DM, (bf16*)(ws + OFF_W_GU + (size_t)e * 512 * DM), kb * 64, nb * 128, 256, 2, gate, up, 512, nullptr);
    } else {
        it -= EXP_GU_ITEMS;
        const int e = it / 32, r = it % 32, kb = r / 8, nb = r % 8;
        const float* dn = e < 64 ? p.w_exp_down + ((size_t)(l * 64 + e)) * 256 * DM : p.w_sh_down + (size_t)l * 256 * DM;
        transpose_item<true>(lds, 256, (bf16*)(ws + OFF_W_D + (size_t)e * DM * 256), kb * 64, nb * 128, DM, 3, dn, nullptr, DM, nullptr);
    }
}

__device__ __forceinline__ void ph_prep(const Params& p, LAS unsigned char* lds) {
    unsigned char* ws = p.ws;
    const int tid = threadIdx.x;
    if (blockIdx.x == 0 && tid < 128) ((int*)(ws + OFF_CNT))[tid] = 0;
    constexpr int I_MOD = 96, I_ROPE = 1024, I_INE = 16 * 19, I_OUTE = 128, I_INO = 16 * 7, I_UQ = 8 * 12, I_UKV = 4 * 16, I_OUTO = 128, I_RT = 32;
    constexpr int NITEMS = I_MOD + I_ROPE + I_INE + I_OUTE + I_INO + I_UQ + I_UKV + I_OUTO + I_RT;
    for (int item = blockIdx.x; item < NITEMS; item += gridDim.x) {
        int it = item;
        if (it < I_MOD) {
            const int l = it / 48, n0 = (it % 48) * 128, kg = tid >> 5, cl = tid & 31;
            LAS float* s = (LAS float*)lds;
            LAS float* red = (LAS float*)(lds + 12288);
            for (int idx = tid; idx < 3072; idx += 256) { const int v = idx >> 10, k = idx & 1023; const float cv = v < 2 ? p.c[v * DM + k] : p.c_ctx[k]; s[idx] = cv / (1.f + expf(-cv)); }
            __syncthreads();
            f32x4 a0 = {0.f, 0.f, 0.f, 0.f}, a1 = a0, a2 = a0;
            const float* w = p.w_mod + (size_t)l * DM * 6144 + (size_t)(kg * 128) * 6144 + n0 + cl * 4;
#pragma unroll 8
            for (int k = 0; k < 128; ++k) { const f32x4 wv = *(const f32x4*)(w + (size_t)k * 6144); const int kk = kg * 128 + k; a0 += wv * s[kk]; a1 += wv * s[1024 + kk]; a2 += wv * s[2048 + kk]; }
            *(LAS f32x4*)(red + (kg * 3 + 0) * 128 + cl * 4) = a0; *(LAS f32x4*)(red + (kg * 3 + 1) * 128 + cl * 4) = a1; *(LAS f32x4*)(red + (kg * 3 + 2) * 128 + cl * 4) = a2;
            __syncthreads();
            for (int idx = tid; idx < 384; idx += 256) { const int v = idx >> 7, n = idx & 127; float acc = 0.f;
#pragma unroll
                for (int g = 0; g < 8; ++g) acc += red[(g * 3 + v) * 128 + n];
                ((float*)(ws + OFF_MOD))[((size_t)l * 3 + v) * 6144 + n0 + n] = acc + p.b_mod[l * 6144 + n0 + n]; }
            __syncthreads();
            continue;
        }
        it -= I_MOD;
        if (it < I_ROPE) {
            const int idx = it * 256 + tid, pos = idx >> 5, i = idx & 31, row = pos >> 6, col = pos & 63, j = i & 15;
            const float invf = powf(10000.f, -(float)(2 * j) / 32.f);
            const float ang = (float)(i < 16 ? row : col) * invf;
            float sn, cs; sincosf(ang, &sn, &cs);
            ((f32x2*)(ws + OFF_ROPE))[idx] = (f32x2){cs, sn};
            continue;
        }
        it -= I_ROPE;
        if (it < I_INE) { const int kb = it / 19, nb = it % 19;
            transpose_item(lds, DM, (bf16*)(ws + OFF_W_IN_E), kb * 64, nb * 128, 2336, 1, p.w_in_e, nullptr, 2336, nullptr); continue; }
        it -= I_INE;
        if (it < I_OUTE) { const int kb = it / 8, nb = it % 8;
            transpose_item(lds, DM, (bf16*)(ws + OFF_W_OUT_E), kb * 64, nb * 128, DM, 0, p.w_out_e, nullptr, DM, nullptr); continue; }
        it -= I_OUTE;
        if (it < I_INO) { const int kb = it / 7, nb = it % 7;
            transpose_item(lds, DM, (bf16*)(ws + OFF_W_IN_O), kb * 64, nb * 128, 832, 0, p.w_in_o, nullptr, 832, nullptr); continue; }
        it -= I_INO;
        if (it < I_UQ) { const int kb = it / 12, nb = it % 12;
            transpose_item(lds, 512, (bf16*)(ws + OFF_W_UQ), kb * 64, nb * 128, 1536, 0, p.w_uq, nullptr, 1536, p.mla_q_norm); continue; }
        it -= I_UQ;
        if (it < I_UKV) { const int kb = it / 16, nb = it % 16;
            transpose_item(lds, 256, (bf16*)(ws + OFF_W_UKV), kb * 64, nb * 128, 2048, 0, p.w_ukv, nullptr, 2048, p.mla_kv_norm); continue; }
        it -= I_UKV;
        if (it < I_OUTO) { const int kb = it / 8, nb = it % 8;
            transpose_item(lds, DM, (bf16*)(ws + OFF_W_OUT_O), kb * 64, nb * 128, DM, 0, p.w_out_o, nullptr, DM, nullptr); continue; }
        it -= I_OUTO;
        { const int l = it / 16, kb = it % 16;
            transpose_item(lds, DM, (bf16*)(ws + OFF_W_RT) + (size_t)l * 128 * DM, kb * 64, 0, 64, 0, p.w_router + (size_t)l * DM * 64, nullptr, 64, nullptr); }
    }
}

__device__ __forceinline__ void load_row(const float* src, int lane, f32x4 (&v)[4]) {
#pragma unroll
    for (int j = 0; j < 4; ++j) v[j] = *(const f32x4*)(src + lane * 4 + 256 * j);
}
__device__ __forceinline__ float row_sumsq(const f32x4 (&v)[4]) {
    float s = 0.f;
#pragma unroll
    for (int j = 0; j < 4; ++j) s += v[j].x * v[j].x + v[j].y * v[j].y + v[j].z * v[j].z + v[j].w * v[j].w;
    return wave_sum(s);
}
__device__ __forceinline__ void modulate_store(const f32x4 (&v)[4], float rinv, const float* g, const float* sh, const float* sc, bf16* dst, int lane) {
#pragma unroll
    for (int j = 0; j < 4; ++j) {
        const int c = lane * 4 + 256 * j;
        const f32x4 gg = *(const f32x4*)(g + c), s1 = *(const f32x4*)(sc + c), s0 = *(const f32x4*)(sh + c);
        const f32x4 o = v[j] * rinv * gg * (s1 + 1.f) + s0;
        u32x2 w; w.x = pk2(o.x, o.y); w.y = pk2(o.z, o.w);
        *(u32x2*)(dst + c) = w;
    }
}
__device__ __forceinline__ const float* hl_src0(const Params& p, int r) { return r < TC ? p.ctx + (size_t)r * DM : p.x + (size_t)(r - TC) * DM; }
__device__ __forceinline__ bf16* hl_buf(const Params& p, int r) { return r < TC ? (bf16*)(p.ws + OFF_HC) + (size_t)r * DM : (bf16*)(p.out + (size_t)(r - TC) * DM); }

__device__ __forceinline__ void ph_modulate0(const Params& p) {
    const int lane = threadIdx.x & 63, gw = blockIdx.x * 4 + (threadIdx.x >> 6), ngw = gridDim.x * 4;
    const float* mod = (const float*)(p.ws + OFF_MOD);
    bf16* U = (bf16*)(p.ws + OFF_U);
    for (int r = gw; r < TT; r += ngw) {
        f32x4 v[4]; load_row(hl_src0(p, r), lane, v);
        const float rinv = rsqrtf(row_sumsq(v) * (1.f / DM) + RMS_EPS);
        const float* mv = mod + (size_t)modvec(r) * 6144;
        modulate_store(v, rinv, p.g_mix_pre, mv, mv + 1024, U + (size_t)r * DM, lane);
    }
}

__device__ __forceinline__ void ph_rowpassA(const Params& p, int l, int row_lo, const float* Y) {
    const int lane = threadIdx.x & 63, gw = blockIdx.x * 4 + (threadIdx.x >> 6), ngw = gridDim.x * 4;
    const float* mod = (const float*)(p.ws + OFF_MOD) + (size_t)l * 3 * 6144;
    bf16* U = (bf16*)(p.ws + OFF_U);
    for (int r = row_lo + gw; r < TT; r += ngw) {
        f32x4 y[4], h[4];
        load_row(Y + (size_t)r * DM, lane, y);
        bf16* hb = hl_buf(p, r);
        if (l == 0) load_row(hl_src0(p, r), lane, h);
        else {
#pragma unroll
            for (int j = 0; j < 4; ++j) { const u32x2 w = *(const u32x2*)(hb + lane * 4 + 256 * j); h[j] = (f32x4){bflo(w.x), bfhi(w.x), bflo(w.y), bfhi(w.y)}; }
        }
        const float rinv = rsqrtf(row_sumsq(y) * (1.f / DM) + RMS_EPS);
        const float* mv = mod + (size_t)modvec(r) * 6144;
#pragma unroll
        for (int j = 0; j < 4; ++j) {
            const int c = lane * 4 + 256 * j;
            const f32x4 gg = *(const f32x4*)(p.g_mix_post + l * DM + c), gt = *(const f32x4*)(mv + 2048 + c);
            h[j] = h[j] + gt * (y[j] * rinv * gg);
            *(u32x2*)(hb + c) = (u32x2){pk2(h[j].x, h[j].y), pk2(h[j].z, h[j].w)};
        }
        const float rinv2 = rsqrtf(row_sumsq(h) * (1.f / DM) + RMS_EPS);
        modulate_store(h, rinv2, p.g_ffn_pre + l * DM, mv + 3072, mv + 4096, U + (size_t)r * DM, lane);
        {
            unsigned char* u8 = p.ws + AM_U8 + (size_t)r * DM;
#pragma unroll
            for (int j = 0; j < 4; ++j) {
                const int c = lane * 4 + 256 * j;
                const f32x4 gg = *(const f32x4*)(p.g_ffn_pre + l * DM + c), s1 = *(const f32x4*)(mv + 4096 + c), s0 = *(const f32x4*)(mv + 3072 + c);
                const f32x4 o = h[j] * rinv2 * gg * (s1 + 1.f) + s0;
                *(unsigned*)(u8 + c) = pk4_fp8(o.x, o.y, o.z, o.w);
            }
        }
    }
}

constexpr int MOE_LDS_OFF = 65536;
__device__ __forceinline__ void moe_tables(const Params& p, LAS unsigned char* lds, int l, int row_lo) {
    LAS int* cnt = (LAS int*)(lds + MOE_LDS_OFF); LAS int* tp = cnt + 80; LAS int* sp = tp + 80;
    const int tid = threadIdx.x;
    if (tid < 64) cnt[tid] = ((const int*)(p.ws + OFF_CNT))[l * 64 + tid];
    if (tid == 64) cnt[64] = TT - row_lo;
    __syncthreads();
    if (tid == 0) {
        int a = 0, s = 0;
        for (int e = 0; e < 65; ++e) { tp[e] = a; sp[e] = s; a += (cnt[e] + 127) >> 7; s += cnt[e]; }
        tp[65] = a;
    }
    __syncthreads();
}

__device__ __forceinline__ void ph_rowpassB(const Params& p, LAS unsigned char* lds, int l, int row_lo) {
    moe_tables(p, lds, l, row_lo);
    LAS int* sp = (LAS int*)(lds + MOE_LDS_OFF) + 160;
    const int lane = threadIdx.x & 63, gw = blockIdx.x * 4 + (threadIdx.x >> 6), ngw = gridDim.x * 4;
    const float* mod = (const float*)(p.ws + OFF_MOD) + (size_t)l * 3 * 6144;
    const unsigned char* YR = p.ws + AM_YR;
    const int* tokslot = (const int*)(p.ws + OFF_TOKSLOT); const float* W8 = (const float*)(p.ws + OFF_W8);
    bf16* U = (bf16*)(p.ws + OFF_U);
    const int c0 = lane * 16;
    for (int r = row_lo + gw; r < TT; r += ngw) {
        int ts = 0; float wv = 0.f;
        if (lane < 8) { ts = tokslot[(size_t)r * 8 + lane]; wv = W8[(size_t)r * 8 + lane]; }
        const int myslot = sp[ts >> 20] + (ts & 0xfffff);
        float f[16];
#pragma unroll
        for (int i = 0; i < 16; ++i) f[i] = 0.f;
#pragma unroll
        for (int k = 0; k < 9; ++k) {
            size_t slot; float wk = 1.f / Y8SC;
            if (k < 8) { slot = (size_t)__shfl(myslot, k); wk = __shfl(wv, k) * (1.f / Y8SC); } else slot = (size_t)TT * 8 + r;
            const u32x4 a = *(const u32x4*)(YR + slot * DM + c0);
            const unsigned aw[4] = {a.x, a.y, a.z, a.w};
#pragma unroll
            for (int q = 0; q < 4; ++q) {
                const f32x2 lo = __builtin_amdgcn_cvt_pk_f32_fp8((int)aw[q], false), hi2 = __builtin_amdgcn_cvt_pk_f32_fp8((int)aw[q], true);
                f[q * 4 + 0] += wk * lo.x; f[q * 4 + 1] += wk * lo.y; f[q * 4 + 2] += wk * hi2.x; f[q * 4 + 3] += wk * hi2.y;
            }
        }
        float ss = 0.f;
#pragma unroll
        for (int i = 0; i < 16; ++i) ss += f[i] * f[i];
        const float rinv = rsqrtf(wave_sum(ss) * (1.f / DM) + RMS_EPS);
        const float* mv = mod + (size_t)modvec(r) * 6144;
        bf16* hb = hl_buf(p, r);
        float h[16];
        {
            const u32x4 ha = *(const u32x4*)(hb + c0), hb2 = *(const u32x4*)(hb + c0 + 8);
            const unsigned hw[8] = {ha.x, ha.y, ha.z, ha.w, hb2.x, hb2.y, hb2.z, hb2.w};
#pragma unroll
            for (int i = 0; i < 8; ++i) { h[2 * i] = bflo(hw[i]); h[2 * i + 1] = bfhi(hw[i]); }
        }
#pragma unroll
        for (int q = 0; q < 4; ++q) {
            const int c = c0 + q * 4;
            const f32x4 gg = *(const f32x4*)(p.g_ffn_post + l * DM + c), gt = *(const f32x4*)(mv + 5120 + c);
            const f32x4 fv = {f[q * 4 + 0], f[q * 4 + 1], f[q * 4 + 2], f[q * 4 + 3]};
            const f32x4 hv = {h[q * 4 + 0], h[q * 4 + 1], h[q * 4 + 2], h[q * 4 + 3]};
            const f32x4 o = hv + gt * (fv * rinv * gg);
            h[q * 4 + 0] = o.x; h[q * 4 + 1] = o.y; h[q * 4 + 2] = o.z; h[q * 4 + 3] = o.w;
        }
        if (l == 1) {
            float* orow = p.out + (size_t)(r - TC) * DM + c0;
#pragma unroll
            for (int q = 0; q < 4; ++q) *(f32x4*)(orow + q * 4) = (f32x4){h[q * 4 + 0], h[q * 4 + 1], h[q * 4 + 2], h[q * 4 + 3]};
        } else {
            *(u32x4*)(hb + c0) = (u32x4){pk2(h[0], h[1]), pk2(h[2], h[3]), pk2(h[4], h[5]), pk2(h[6], h[7])};
            *(u32x4*)(hb + c0 + 8) = (u32x4){pk2(h[8], h[9]), pk2(h[10], h[11]), pk2(h[12], h[13]), pk2(h[14], h[15])};
        }
        if (l == 0) {
            float s2 = 0.f;
#pragma unroll
            for (int i = 0; i < 16; ++i) s2 += h[i] * h[i];
            const float rinv2 = rsqrtf(wave_sum(s2) * (1.f / DM) + RMS_EPS);
            const float* mv1 = mv + 3 * 6144;
#pragma unroll
            for (int hf = 0; hf < 2; ++hf) {
                const int c = c0 + hf * 8;
                const f32x4 g0 = *(const f32x4*)(p.g_mix_pre + DM + c), g1 = *(const f32x4*)(p.g_mix_pre + DM + c + 4);
                const f32x4 sh0 = *(const f32x4*)(mv1 + c), sh1 = *(const f32x4*)(mv1 + c + 4), sc0 = *(const f32x4*)(mv1 + 1024 + c), sc1 = *(const f32x4*)(mv1 + 1024 + c + 4);
                const f32x4 h0 = {h[hf * 8 + 0], h[hf * 8 + 1], h[hf * 8 + 2], h[hf * 8 + 3]}, h1 = {h[hf * 8 + 4], h[hf * 8 + 5], h[hf * 8 + 6], h[hf * 8 + 7]};
                const f32x4 o0 = h0 * rinv2 * g0 * (sc0 + 1.f) + sh0, o1 = h1 * rinv2 * g1 * (sc1 + 1.f) + sh1;
                *(u32x4*)(U + (size_t)r * DM + c) = (u32x4){pk2(o0.x, o0.y), pk2(o0.z, o0.w), pk2(o1.x, o1.y), pk2(o1.z, o1.w)};
            }
        }
    }
}

__device__ __forceinline__ int stg_col() { const int tid = threadIdx.x; return ((tid & 7) ^ ((tid >> 3) & 7)) * 8; }
__device__ __forceinline__ void plain_ptrs(const bf16* base, int row0, int ld, const bf16* (&pp)[4]) {
    const int tid = threadIdx.x;
    pp[0] = base + (size_t)(row0 + (tid >> 3)) * ld + stg_col();
#pragma unroll
    for (int i = 1; i < 4; ++i) pp[i] = pp[0] + (size_t)(32 * i) * ld;
}

__device__ __forceinline__ void ph_inproj0(const Params& p, LAS unsigned char* lds) {
    unsigned char* ws = p.ws;
    const bf16* U = (const bf16*)(ws + OFF_U); const bf16* W = (const bf16*)(ws + OFF_W_IN_E);
    bf16* Z0 = (bf16*)(ws + A0_Z0); bf16* VGT = (bf16*)(ws + A0_VGT); bf16* QS = (bf16*)(ws + A0_QS); bf16* KS = (bf16*)(ws + A0_KS); bf16* VST = (bf16*)(ws + A0_VST);
    const f32x2* rope = (const f32x2*)(ws + OFF_ROPE);
    const int tid = threadIdx.x, lane = tid & 63, wid = tid >> 6, wr = wid >> 1, wc = wid & 1, fr = lane & 15, fq = lane >> 4;
    constexpr int NTN = 19, NTM = TT / 128;
    auto make = [&](int t, GPtrs& g, int& nk) { int tm, tn; tile_mn(t, NTM, NTN, tm, tn); plain_ptrs(U, tm * 128, DM, g.a); plain_ptrs(W, tn * 128, DM, g.b); nk = DM / 64; };
    auto epi = [&](int t, f32x4 (&acc)[4][4]) {
        int tm, tn; tile_mn(t, NTM, NTN, tm, tn); const int brow = tm * 128, bcol = tn * 128;
        const int cb = bcol + wc * 64;
        LAS unsigned char* wl = lds + 32768 + wid * 8192;
        const int r0 = brow + wr * 64;
        const RowInfo ri0 = rowinfo(r0);
        if (cb < 1024) {
            epi_store_rows(wl, acc, fr, fq, lane, [&](int row) { return Z0 + (size_t)(r0 + row) * Z0P + cb; });
        } else if (cb < 1536) {
            const int c0 = cb - 1024;
            epi_store_cols(wl, acc, fr, fq, lane, [&](int col) { return VGT + (size_t)(c0 + col) * TT + r0; });
        } else if (cb < 2176) {
            const float sc = cb < 2048 ? 0.125f * LOG2E : 1.f;
#pragma unroll
            for (int m = 0; m < 4; ++m) {
                const int pos = ri0.pos + m * 16 + fr;
#pragma unroll
                for (int n = 0; n < 2; ++n)
#pragma unroll
                    for (int j = 0; j < 4; ++j) {
                        const float x1 = acc[m][n][j] * sc, x2 = acc[m][n + 2][j] * sc;
                        if (ri0.lat) { const f32x2 cs = rope[(size_t)pos * 32 + n * 16 + fq * 4 + j]; acc[m][n][j] = x1 * cs.x - x2 * cs.y; acc[m][n + 2][j] = x2 * cs.x + x1 * cs.y; }
                        else { acc[m][n][j] = x1; acc[m][n + 2][j] = x2; }
                    }
                asm volatile("" ::: "memory");
            }
            bf16* dst;
            if (cb < 2048) { const int h = (cb - 1536) >> 6; dst = QS + ((size_t)(ri0.b * 8 + h) * NKEY + ri0.kq) * 64; }
            else { const int h = (cb - 2048) >> 6; dst = KS + ((size_t)(ri0.b * 2 + h) * NKEY + ri0.kq) * 64; }
            epi_store_rows(wl, acc, fr, fq, lane, [&](int row) { return dst + (size_t)row * 64; });
        } else if (cb < 2304) {
            const int h = (cb - 2176) >> 6;
            bf16* dst = VST + (size_t)(ri0.b * 2 + h) * 64 * NKEY + ri0.kq;
            epi_store_cols(wl, acc, fr, fq, lane, [&](int col) { return dst + (size_t)col * NKEY; });
        } else if (cb == 2304) {
#pragma unroll
            for (int m = 0; m < 4; ++m) {
                const int r = r0 + m * 16 + fr;
#pragma unroll
                for (int n = 0; n < 2; ++n) { u32x2 w; w.x = pk2(acc[m][n][0], acc[m][n][1]); w.y = pk2(acc[m][n][2], acc[m][n][3]); *(u32x2*)(Z0 + (size_t)r * Z0P + 1024 + n * 16 + fq * 4) = w; }
            }
        }
    };
    gemm_tiles<true>(lds, vcu_id(), NTM * NTN, gridDim.x, make, epi);
}

__device__ __forceinline__ void ph_outproj(const Params& p, LAS unsigned char* lds, const bf16* MIX, const bf16* W, float* Y, int row_lo) {
    const int tid = threadIdx.x, lane = tid & 63, wid = tid >> 6, wr = wid >> 1, wc = wid & 1, fr = lane & 15, fq = lane >> 4;
    const int tm0 = row_lo / 128, ntm = TT / 128 - tm0;
    auto make = [&](int t, GPtrs& g, int& nk) { int tm, tn; tile_mn(t, ntm, 8, tm, tn); plain_ptrs(MIX, (tm0 + tm) * 128, DM, g.a); plain_ptrs(W, tn * 128, DM, g.b); nk = DM / 64; };
    auto epi = [&](int t, f32x4 (&acc)[4][4]) {
        int tm, tn; tile_mn(t, ntm, 8, tm, tn); tm += tm0; const int brow = tm * 128, bcol = tn * 128;
#pragma unroll
        for (int m = 0; m < 4; ++m) {
            const int r = brow + wr * 64 + m * 16 + fr;
#pragma unroll
            for (int n = 0; n < 4; ++n) *(f32x4*)(Y + (size_t)r * DM + bcol + wc * 64 + n * 16 + fq * 4) = acc[m][n];
        }
    };
    gemm_tiles<true, 16>(lds, vcu_id(), ntm * 8, gridDim.x, make, epi);
}

template <int DQK, int DV>
__device__ __forceinline__ void attn_item(LAS unsigned char* lds, const bf16* Qg, const bf16* Kg, const bf16* VTg, int a1, int b0, int b1, int qpos0,
                                          float m_init, float l_init, bf16* Og, int o_pitch) {
    constexpr int KPB = DQK * 2, NS = DQK / 16, NDV = DV / 32, KCH = DQK / 8, KBYTES = 32 * KPB, VBYTES = DV * 64, KN = 32 * KCH / 256, VN = DV * 4 / 256;
    static_assert((KN == 3 && VN == 2) || (KN == 1 && VN == 1), "piece counts");
    const int tid = threadIdx.x, lane = tid & 63, wid = tid >> 6, ql = lane & 31, hi = lane >> 5;
    LAS unsigned char* Kb0 = lds; LAS unsigned char* Vb0 = lds + 2 * KBYTES;
    asm volatile("s_waitcnt vmcnt(0) lgkmcnt(0)" ::: "memory");
    __builtin_amdgcn_s_barrier();
    asm volatile("" ::: "memory");
    bf16x8 qf[NS];
    {
        const bf16* qrow = Qg + (size_t)(wid * 32 + ql) * DQK + hi * 8;
#pragma unroll
        for (int s = 0; s < NS; ++s) qf[s] = *(const bf16x8*)(qrow + s * 16);
    }
    unsigned koff[KN], voff[VN];
#pragma unroll
    for (int i = 0; i < KN; ++i) { const int pz = tid + 256 * i, key = pz / KCH, ch = pz % KCH; koff[i] = (unsigned)(key * DQK + (((ch & ~7) | ((ch & 7) ^ ((key >> 1) & 7))) * 8)); }
#pragma unroll
    for (int i = 0; i < VN; ++i) { const int pz = tid + 256 * i, dv = pz >> 2, ch = pz & 3; voff[i] = (unsigned)(dv * NKEY + ((ch ^ ((dv >> 2) & 3)) * 8)); }
    const int ntot = a1 + (b1 - b0);
#define ATTN_KT(it_) ((it_) < a1 ? (it_) : b0 + ((it_) - a1))
#define ATTN_DMA_K(IT_) do { const int kt_ = ATTN_KT(IT_); _Pragma("unroll") for (int i_ = 0; i_ < KN; ++i_) glds16(Kg + (size_t)kt_ * 32 * DQK + koff[i_], Kb0 + ((IT_) & 1) * KBYTES + (tid + 256 * i_) * 16); } while (0)
#define ATTN_DMA_V(IT_) do { const int kt_ = ATTN_KT(IT_); _Pragma("unroll") for (int i_ = 0; i_ < VN; ++i_) glds16(VTg + (size_t)kt_ * 32 + voff[i_], Vb0 + ((IT_) & 1) * VBYTES + (tid + 256 * i_) * 16); } while (0)
    f32x16 o[NDV];
#pragma unroll
    for (int d = 0; d < NDV; ++d)
#pragma unroll
        for (int r = 0; r < 16; ++r) o[d][r] = 0.f;
    float mrun = m_init, lrun = l_init;
    const int swk = (ql >> 1) & 7, swv = (ql >> 2) & 3;
    const LAS unsigned char* kfrag = Kb0 + ql * KPB; const LAS unsigned char* vfrag = Vb0 + ql * 64;
#define ATTN_QK(P_, IT_) do { \
        _Pragma("unroll") for (int r_ = 0; r_ < 16; ++r_) P_[r_] = 0.f; \
        const LAS unsigned char* kc_ = kfrag + ((IT_) & 1) * KBYTES; \
        _Pragma("unroll") for (int s_ = 0; s_ < NS; ++s_) { \
            const int c_ = 2 * s_ + hi; \
            const bf16x8 k0_ = *(const LAS bf16x8*)(kc_ + ((c_ & ~7) | ((c_ & 7) ^ swk)) * 16); \
            P_ = __builtin_amdgcn_mfma_f32_32x32x16_bf16(k0_, qf[s_], P_, 0, 0, 0); } \
        if ((IT_) >= a1) { const int kbase_ = ATTN_KT(IT_) * 32 - CTX, qpos_ = qpos0 + wid * 32 + ql; \
            _Pragma("unroll") for (int r_ = 0; r_ < 16; ++r_) { const int d0_ = qpos_ - (kbase_ + crow(r_, hi)); if (d0_ > 128 || d0_ < -128) P_[r_] = -1e30f; } } } while (0)
#define ATTN_PK4(P, BASE, OUT) do { const unsigned a0_ = pk2(P[BASE + 0], P[BASE + 1]), a1_ = pk2(P[BASE + 2], P[BASE + 3]), b0_ = pk2(P[BASE + 4], P[BASE + 5]), b1_ = pk2(P[BASE + 6], P[BASE + 7]); \
        const auto r0_ = __builtin_amdgcn_permlane32_swap(a0_, b0_, false, false); const auto r1_ = __builtin_amdgcn_permlane32_swap(a1_, b1_, false, false); \
        OUT = mk8((u32x4){r0_[0], r1_[0], r0_[1], r1_[1]}); } while (0)
#define ATTN_STEP(C_, N_, IT_) do { \
          \
          \
        asm volatile("s_waitcnt vmcnt(0) lgkmcnt(0)" ::: "memory"); __builtin_amdgcn_s_barrier(); asm volatile("" ::: "memory"); \
        if ((IT_) + 2 < ntot) ATTN_DMA_K((IT_) + 2); \
        if ((IT_) + 1 < ntot) ATTN_DMA_V((IT_) + 1); \
        if ((IT_) + 1 < ntot) ATTN_QK(N_, (IT_) + 1); \
        float mx_ = C_[0]; \
        _Pragma("unroll") for (int r_ = 1; r_ < 16; ++r_) mx_ = fmaxf(mx_, C_[r_]); \
        mx_ = fmaxf(mx_, __shfl_xor(mx_, 32)); \
        if (__any(mx_ > mrun + 8.f)) { const float mn_ = fmaxf(mrun, mx_), alpha_ = ex2(mrun - mn_); mrun = mn_; lrun *= alpha_; \
            _Pragma("unroll") for (int d_ = 0; d_ < NDV; ++d_) _Pragma("unroll") for (int r_ = 0; r_ < 16; ++r_) o[d_][r_] *= alpha_; } \
        float rs_ = 0.f; \
        _Pragma("unroll") for (int r_ = 0; r_ < 16; ++r_) { C_[r_] = ex2(C_[r_] - mrun); rs_ += C_[r_]; } \
        rs_ += __shfl_xor(rs_, 32); lrun += rs_; \
        bf16x8 pf_[2]; \
        ATTN_PK4(C_, 0, pf_[0]); ATTN_PK4(C_, 8, pf_[1]); \
        const LAS unsigned char* vc_ = vfrag + ((IT_) & 1) * VBYTES; \
        _Pragma("unroll") for (int d_ = 0; d_ < NDV; ++d_) { _Pragma("unroll") for (int kk_ = 0; kk_ < 2; ++kk_) { \
            const bf16x8 vf_ = *(const LAS bf16x8*)(vc_ + d_ * 32 * 64 + (((2 * kk_ + hi) ^ swv) * 16)); \
            o[d_] = __builtin_amdgcn_mfma_f32_32x32x16_bf16(vf_, pf_[kk_], o[d_], 0, 0, 0); } } } while (0)
    ATTN_DMA_K(0); ATTN_DMA_V(0);
    asm volatile("s_waitcnt vmcnt(0) lgkmcnt(0)" ::: "memory"); __builtin_amdgcn_s_barrier(); asm volatile("" ::: "memory");
    if (ntot > 1) ATTN_DMA_K(1);
    f32x16 pA, pB;
    ATTN_QK(pA, 0);
    int it = 0;
    for (; it + 1 < ntot; it += 2) {
        ATTN_STEP(pA, pB, it);
        ATTN_STEP(pB, pA, it + 1);
    }
    if (it < ntot) ATTN_STEP(pA, pB, it);
#undef ATTN_STEP
#undef ATTN_PK4
#undef ATTN_QK
#undef ATTN_KT
#undef ATTN_DMA_K
#undef ATTN_DMA_V
    const float inv = 1.f / lrun;
    bf16* orow = Og + (size_t)(wid * 32 + ql) * o_pitch;
#pragma unroll
    for (int d = 0; d < NDV; ++d)
#pragma unroll
        for (int g = 0; g < 4; ++g) {
            u32x2 w; w.x = pk2(o[d][g * 4 + 0] * inv, o[d][g * 4 + 1] * inv); w.y = pk2(o[d][g * 4 + 2] * inv, o[d][g * 4 + 3] * inv);
            *(u32x2*)(orow + d * 32 + 8 * g + 4 * hi) = w;
        }
}

constexpr int GA_CUM = 0, GA_ALOW = 16384, GA_WA = 20480, GA_BA = 24576, GA_QT = 24832, GA_TOT = 25856, GA_END = 26112;
__device__ __forceinline__ void gla_cum(const Params& p, LAS unsigned char* lds, const bf16* Z0, int r0, int h, int dir) {
    const int tid = threadIdx.x;
    LAS float* cum = (LAS float*)(lds + GA_CUM); LAS float* alow = (LAS float*)(lds + GA_ALOW); LAS float* wa = (LAS float*)(lds + GA_WA);
    LAS float* ba = (LAS float*)(lds + GA_BA); LAS float* qt = (LAS float*)(lds + GA_QT); LAS float* tot = (LAS float*)(lds + GA_TOT);
    {
        const int t = tid >> 2, i4 = (tid & 3) * 4;
        const u32x2 w = *(const u32x2*)(Z0 + (size_t)(r0 + t) * Z0P + 1024 + dir * 16 + i4);
        alow[t * 16 + i4 + 0] = bflo(w.x); alow[t * 16 + i4 + 1] = bfhi(w.x); alow[t * 16 + i4 + 2] = bflo(w.y); alow[t * 16 + i4 + 3] = bfhi(w.y);
#pragma unroll
        for (int q = 0; q < 4; ++q) { const int idx = tid * 4 + q, i = idx >> 6, j = idx & 63; wa[idx] = p.gla_wa2[(size_t)(dir * 16 + i) * 256 + h * 64 + j]; }
        if (tid < 64) ba[tid] = p.gla_ba[dir * 256 + h * 64 + tid];
    }
    __syncthreads();
    const int j = tid & 63, tq = tid >> 6;
    float la[16], wj[16];
#pragma unroll
    for (int i = 0; i < 16; ++i) wj[i] = wa[i * 64 + j];
    const float bj = ba[j];
#pragma unroll
    for (int tt = 0; tt < 16; ++tt) {
        const int t = tq * 16 + tt;
        float x = bj;
#pragma unroll
        for (int q = 0; q < 4; ++q) { const f32x4 a = *(const LAS f32x4*)(alow + t * 16 + q * 4);
            x += a.x * wj[q * 4] + a.y * wj[q * 4 + 1] + a.z * wj[q * 4 + 2] + a.w * wj[q * 4 + 3]; }
        la[tt] = (fminf(x, 0.f) - __logf(1.f + __expf(-fabsf(x)))) * (1.f / 16.f);
    }
    float run = 0.f;
    if (dir == 0) {
#pragma unroll
        for (int tt = 0; tt < 16; ++tt) { run += la[tt]; cum[(tq * 16 + tt) * 64 + j] = run; }
    } else {
#pragma unroll
        for (int tt = 15; tt >= 0; --tt) { run += la[tt]; cum[(tq * 16 + tt) * 64 + j] = run; }
    }
    qt[tq * 64 + j] = run;
    __syncthreads();
    float off = 0.f, total = 0.f;
#pragma unroll
    for (int q = 0; q < 4; ++q) { const float v = qt[q * 64 + j]; total += v; if (dir == 0 ? (q < tq) : (q > tq)) off += v; }
#pragma unroll
    for (int tt = 0; tt < 16; ++tt) cum[(tq * 16 + tt) * 64 + j] += off;
    if (tq == 0) tot[j] = total;
    __syncthreads();
}

__device__ __forceinline__ int gla_row0(int b, int cc) { return cc < 4 ? b * CTX + cc * 64 : TC + b * SEQ + (cc - 4) * 64; }
__device__ __forceinline__ int gla_step(int cc, int dir) { return dir == 0 ? cc : (cc < 4 ? 3 - cc : 4 + (131 - cc)); }

__device__ __forceinline__ void gla_g1_item(const Params& p, LAS unsigned char* lds, int item) {
    unsigned char* ws = p.ws;
    const bf16* Z0 = (const bf16*)(ws + A0_Z0); const bf16* VGT = (const bf16*)(ws + A0_VGT);
    bf16* GS = (bf16*)(ws + A0_GS); float* GD = (float*)(ws + A0_GD);
    const int cc = item % NSTEP, rest = item / NSTEP, dir = rest & 1, h = (rest >> 1) & 3, b = rest >> 3;
    const int r0 = gla_row0(b, cc), step = gla_step(cc, dir), chain = (b * 4 + h) * 2 + dir;
    const int tid = threadIdx.x, lane = tid & 63, wid = tid >> 6, fr = lane & 15, fq = lane >> 4;
    __syncthreads();
    gla_cum(p, lds, Z0, r0, h, dir);
    LAS float* cum = (LAS float*)(lds + GA_CUM); LAS float* tot = (LAS float*)(lds + GA_TOT);
    LAS bf16* KT = (LAS bf16*)(lds + GA_END);
    {
        const int t = tid >> 2, d0 = (tid & 3) * 16;
        const u32x4 w0 = *(const u32x4*)(Z0 + (size_t)(r0 + t) * Z0P + 256 + h * 64 + d0), w1 = *(const u32x4*)(Z0 + (size_t)(r0 + t) * Z0P + 256 + h * 64 + d0 + 8);
        const unsigned ww[8] = {w0.x, w0.y, w0.z, w0.w, w1.x, w1.y, w1.z, w1.w};
#pragma unroll
        for (int i = 0; i < 8; ++i) {
            const int d = d0 + 2 * i;
            KT[d * 72 + t] = f2bf(bflo(ww[i]) * __expf(tot[d] - cum[t * 64 + d]));
            KT[(d + 1) * 72 + t] = f2bf(bfhi(ww[i]) * __expf(tot[d + 1] - cum[t * 64 + d + 1]));
        }
    }
    if (tid < 64) GD[((size_t)chain * NSTEP + step) * 64 + tid] = __expf(tot[tid]);
    __syncthreads();
    f32x4 acc[2][4];
#pragma unroll
    for (int m = 0; m < 2; ++m)
#pragma unroll
        for (int n = 0; n < 4; ++n) acc[m][n] = (f32x4){0.f, 0.f, 0.f, 0.f};
#pragma unroll
    for (int ks = 0; ks < 2; ++ks) {
        bf16x8 af[2], bfr[4];
#pragma unroll
        for (int m = 0; m < 2; ++m) af[m] = *(const bf16x8*)(VGT + (size_t)(h * 128 + wid * 32 + m * 16 + fr) * TT + r0 + ks * 32 + fq * 8);
#pragma unroll
        for (int n = 0; n < 4; ++n) bfr[n] = *(const LAS bf16x8*)(KT + (n * 16 + fr) * 72 + ks * 32 + fq * 8);
#pragma unroll
        for (int m = 0; m < 2; ++m)
#pragma unroll
            for (int n = 0; n < 4; ++n) acc[m][n] = __builtin_amdgcn_mfma_f32_16x16x32_bf16(bfr[n], af[m], acc[m][n], 0, 0, 0);
    }
    bf16* dst = GS + ((size_t)chain * NSTEP + step) * 8192;
#pragma unroll
    for (int m = 0; m < 2; ++m)
#pragma unroll
        for (int n = 0; n < 4; ++n) *(u32x2*)(dst + (size_t)(wid * 32 + m * 16 + fr) * 64 + n * 16 + fq * 4) = (u32x2){pk2(acc[m][n][0], acc[m][n][1]), pk2(acc[m][n][2], acc[m][n][3])};
}

__device__ __forceinline__ void ph_gla_scan(const Params& p) {
    unsigned* GS = (unsigned*)(p.ws + A0_GS); const float* GD = (const float*)(p.ws + A0_GD);
    for (int idx = blockIdx.x * 256 + threadIdx.x; idx < 16 * 4096; idx += gridDim.x * 256) {
        const int chain = idx >> 12, e2 = idx & 4095, dk = (e2 & 31) * 2;
        unsigned* g = GS + (size_t)chain * NSTEP * 4096 + e2;
        const f32x2* d = (const f32x2*)(GD + (size_t)chain * NSTEP * 64 + dk);
        float s0 = 0.f, s1 = 0.f;
#pragma unroll 12
        for (int s = 0; s < NSTEP; ++s) {
            const unsigned t = g[(size_t)s * 4096]; const f32x2 dec = d[s * 32];
            g[(size_t)s * 4096] = pk2(s0, s1);
            s0 = dec.x * s0 + bflo(t); s1 = dec.y * s1 + bfhi(t);
        }
    }
}

__device__ __forceinline__ void gla_g3_item(const Params& p, LAS unsigned char* lds, int item) {
    unsigned char* ws = p.ws;
    const bf16* Z0 = (const bf16*)(ws + A0_Z0); const bf16* VGT = (const bf16*)(ws + A0_VGT);
    const bf16* GS = (const bf16*)(ws + A0_GS); bf16* MIX = (bf16*)(ws + A0_MIX);
    const int cc = item % NSTEP, rest = item / NSTEP, h = rest & 3, b = rest >> 2;
    const int r0 = gla_row0(b, cc);
    const int tid = threadIdx.x, lane = tid & 63, wid = tid >> 6, fr = lane & 15, fq = lane >> 4;
    LAS bf16* QT = (LAS bf16*)(lds + GA_END);
    LAS bf16* QI = (LAS bf16*)(lds + GA_END + 9216);
    LAS bf16* KT = (LAS bf16*)(lds + GA_END + 18432);
    LAS bf16* PP = (LAS bf16*)(lds);
    f32x4 o[4][2];
#pragma unroll
    for (int m = 0; m < 4; ++m)
#pragma unroll
        for (int n = 0; n < 2; ++n) o[m][n] = (f32x4){0.f, 0.f, 0.f, 0.f};
    for (int dir = 0; dir < 2; ++dir) {
        const int step = gla_step(cc, dir), chain = (b * 4 + h) * 2 + dir;
        __syncthreads();
        gla_cum(p, lds, Z0, r0, h, dir);
        LAS float* cum = (LAS float*)(lds + GA_CUM); LAS float* tot = (LAS float*)(lds + GA_TOT);
        {
            const int t = tid >> 2, d0 = (tid & 3) * 16;
            const bf16* zr = Z0 + (size_t)(r0 + t) * Z0P + h * 64 + d0;
            const u32x4 q0 = *(const u32x4*)(zr), q1 = *(const u32x4*)(zr + 8), k0 = *(const u32x4*)(zr + 256), k1 = *(const u32x4*)(zr + 264);
            const unsigned qq[8] = {q0.x, q0.y, q0.z, q0.w, q1.x, q1.y, q1.z, q1.w}, kk[8] = {k0.x, k0.y, k0.z, k0.w, k1.x, k1.y, k1.z, k1.w};
            unsigned oqt[8], oqi[8], okt[8];
#pragma unroll
            for (int i = 0; i < 8; ++i) {
                const int d = d0 + 2 * i;
                const float c0 = cum[t * 64 + d], c1 = cum[t * 64 + d + 1], t0 = tot[d], t1 = tot[d + 1];
                const float qa = bflo(qq[i]), qb = bfhi(qq[i]), ka = bflo(kk[i]), kb = bfhi(kk[i]);
                oqt[i] = pk2(qa * __expf(c0 - t0), qb * __expf(c1 - t1));
                oqi[i] = pk2(qa * __expf(c0), qb * __expf(c1));
                okt[i] = pk2(ka * __expf(t0 - c0), kb * __expf(t1 - c1));
            }
            *(LAS u32x4*)(QT + t * 72 + d0) = (u32x4){oqt[0], oqt[1], oqt[2], oqt[3]}; *(LAS u32x4*)(QT + t * 72 + d0 + 8) = (u32x4){oqt[4], oqt[5], oqt[6], oqt[7]};
            *(LAS u32x4*)(QI + t * 72 + d0) = (u32x4){oqi[0], oqi[1], oqi[2], oqi[3]}; *(LAS u32x4*)(QI + t * 72 + d0 + 8) = (u32x4){oqi[4], oqi[5], oqi[6], oqi[7]};
            *(LAS u32x4*)(KT + t * 72 + d0) = (u32x4){okt[0], okt[1], okt[2], okt[3]}; *(LAS u32x4*)(KT + t * 72 + d0 + 8) = (u32x4){okt[4], okt[5], okt[6], okt[7]};
        }
        __syncthreads();
        {
            f32x4 sa[4];
#pragma unroll
            for (int m = 0; m < 4; ++m) sa[m] = (f32x4){0.f, 0.f, 0.f, 0.f};
#pragma unroll
            for (int ks = 0; ks < 2; ++ks) {
                const bf16x8 kf = *(const LAS bf16x8*)(KT + (wid * 16 + fr) * 72 + ks * 32 + fq * 8);
#pragma unroll
                for (int m = 0; m < 4; ++m) {
                    const bf16x8 qfm = *(const LAS bf16x8*)(QT + (m * 16 + fr) * 72 + ks * 32 + fq * 8);
                    sa[m] = __builtin_amdgcn_mfma_f32_16x16x32_bf16(kf, qfm, sa[m], 0, 0, 0);
                }
            }
#pragma unroll
            for (int m = 0; m < 4; ++m) {
                const int t = m * 16 + fr;
                float v[4];
#pragma unroll
                for (int jj = 0; jj < 4; ++jj) { const int j = wid * 16 + fq * 4 + jj; const bool keep = dir == 0 ? (j <= t) : (j >= t); v[jj] = keep ? sa[m][jj] : 0.f; }
                *(LAS u32x2*)(PP + t * 72 + wid * 16 + fq * 4) = (u32x2){pk2(v[0], v[1]), pk2(v[2], v[3])};
            }
        }
        __syncthreads();
        const bf16* Sg = GS + ((size_t)chain * NSTEP + step) * 8192;
#pragma unroll
        for (int ks = 0; ks < 2; ++ks) {
            bf16x8 vfr[2], sfr[2];
#pragma unroll
            for (int n = 0; n < 2; ++n) {
                const int dv = wid * 32 + n * 16 + fr;
                vfr[n] = *(const bf16x8*)(VGT + (size_t)(h * 128 + dv) * TT + r0 + ks * 32 + fq * 8);
                sfr[n] = *(const bf16x8*)(Sg + (size_t)dv * 64 + ks * 32 + fq * 8);
            }
#pragma unroll
            for (int m = 0; m < 4; ++m) {
                const bf16x8 pfm = *(const LAS bf16x8*)(PP + (m * 16 + fr) * 72 + ks * 32 + fq * 8);
                const bf16x8 qim = *(const LAS bf16x8*)(QI + (m * 16 + fr) * 72 + ks * 32 + fq * 8);
#pragma unroll
                for (int n = 0; n < 2; ++n) {
                    o[m][n] = __builtin_amdgcn_mfma_f32_16x16x32_bf16(vfr[n], pfm, o[m][n], 0, 0, 0);
                    o[m][n] = __builtin_amdgcn_mfma_f32_16x16x32_bf16(sfr[n], qim, o[m][n], 0, 0, 0);
                }
            }
        }
    }
    __syncthreads();
    LAS float* red = (LAS float*)(lds + GA_END + 27648);
#pragma unroll
    for (int m = 0; m < 4; ++m) {
        float s = 0.f;
#pragma unroll
        for (int n = 0; n < 2; ++n)
#pragma unroll
            for (int j = 0; j < 4; ++j) s += o[m][n][j] * o[m][n][j];
        s += __shfl_xor(s, 16); s += __shfl_xor(s, 32);
        if (fq == 0) red[wid * 64 + m * 16 + fr] = s;
    }
    __syncthreads();
#pragma unroll
    for (int m = 0; m < 4; ++m) {
        const int t = m * 16 + fr;
        const float ss = red[t] + red[64 + t] + red[128 + t] + red[192 + t];
        const float rinv = rsqrtf(ss * (1.f / 128.f) + RMS_EPS);
        const int r = r0 + t;
#pragma unroll
        for (int n = 0; n < 2; ++n) {
            const int dv = wid * 32 + n * 16 + fq * 4;
            const u32x2 gw = *(const u32x2*)(Z0 + (size_t)r * Z0P + 512 + h * 128 + dv);
            const f32x4 ng = *(const f32x4*)(p.gla_norm + dv);
            const float g0 = bflo(gw.x), g1 = bfhi(gw.x), g2 = bflo(gw.y), g3 = bfhi(gw.y);
            const float y0 = o[m][n][0] * rinv * ng.x * siluf(g0), y1 = o[m][n][1] * rinv * ng.y * siluf(g1);
            const float y2 = o[m][n][2] * rinv * ng.z * siluf(g2), y3 = o[m][n][3] * rinv * ng.w * siluf(g3);
            *(u32x2*)(MIX + (size_t)r * DM + h * 128 + dv) = (u32x2){pk2(y0, y1), pk2(y2, y3)};
        }
    }
}

__device__ __forceinline__ void ph_swa_g1(const Params& p, LAS unsigned char* lds) {
    unsigned char* ws = p.ws;
    const bf16* QS = (const bf16*)(ws + A0_QS); const bf16* KS = (const bf16*)(ws + A0_KS); const bf16* VST = (const bf16*)(ws + A0_VST); bf16* MIX = (bf16*)(ws + A0_MIX);
    constexpr int N_SWA = 2 * 8 * 66, N_G1 = 2 * 4 * 2 * NSTEP;
    for (int item = blockIdx.x; item < N_SWA + N_G1; item += gridDim.x) {
        if (item < N_SWA) {
            const int qt = item % 66, rest = item / 66, h = rest & 7, b = rest >> 3, kvh = h >> 2;
            const bf16* Qg = QS + ((size_t)(b * 8 + h) * NKEY + qt * 128) * 64;
            const bf16* Kg = KS + (size_t)(b * 2 + kvh) * NKEY * 64;
            const bf16* Vg = VST + (size_t)(b * 2 + kvh) * 64 * NKEY;
            int b0 = 0, b1 = 0, qpos0 = 0, row0;
            if (qt >= 2) { qpos0 = (qt - 2) * 128; const int lo = qpos0 - 128 < 0 ? 0 : qpos0 - 128, hi2 = qpos0 + 256 > SEQ ? SEQ : qpos0 + 256; b0 = 8 + lo / 32; b1 = 8 + hi2 / 32; row0 = TC + b * SEQ + qpos0; }
            else row0 = b * CTX + qt * 128;
            const float sink = p.swa_sink[h] * LOG2E;
            attn_item<64, 64>(lds, Qg, Kg, Vg, 8, b0, b1, qpos0, sink, 1.f, MIX + (size_t)row0 * DM + 512 + h * 64, DM);
        } else gla_g1_item(p, lds, item - N_SWA);
    }
}
__device__ __forceinline__ void ph_gla_g3(const Params& p, LAS unsigned char* lds) {
    for (int item = blockIdx.x; item < 2 * 4 * NSTEP; item += gridDim.x) gla_g3_item(p, lds, item);
}

__device__ __forceinline__ void ph_router(const Params& p, LAS unsigned char* lds, int l, int row_lo) {
    unsigned char* ws = p.ws;
    const bf16* U = (const bf16*)(ws + OFF_U); const bf16* W = (const bf16*)(ws + OFF_W_RT) + (size_t)l * 128 * DM;
    int* cntg = (int*)(ws + OFF_CNT) + l * 64; int* tokslot = (int*)(ws + OFF_TOKSLOT); float* W8 = (float*)(ws + OFF_W8); int* LIST = (int*)(ws + OFF_LIST);
    const int tid = threadIdx.x, lane = tid & 63, wid = tid >> 6, wr = wid >> 1, wc = wid & 1, fr = lane & 15, fq = lane >> 4;
    LAS float* lg = (LAS float*)lds;
    const int tm0 = row_lo / 128;
    auto make = [&](int tm, GPtrs& g, int& nk) { plain_ptrs(U, tm * 128, DM, g.a); plain_ptrs(W, 0, DM, g.b); nk = DM / 64; };
    auto epi = [&](int tm, f32x4 (&acc)[4][4]) {
        const int brow = tm * 128;
        if (wc == 0) {
#pragma unroll
            for (int m = 0; m < 4; ++m)
#pragma unroll
                for (int n = 0; n < 4; ++n)
#pragma unroll
                    for (int j = 0; j < 4; ++j) lg[(wr * 64 + m * 16 + fr) * 65 + n * 16 + fq * 4 + j] = acc[m][n][j];
        }
        __syncthreads();
        LAS float* biasl = (LAS float*)(lds + 34816); LAS int* hist = (LAS int*)(lds + 34816 + 256); LAS int* basel = (LAS int*)(lds + 34816 + 512);
        if (tid < 64) { biasl[tid] = p.b_router[l * 64 + tid]; hist[tid] = 0; }
        __syncthreads();
        int esel[8], lrank[8]; float ssel[8]; float wsum = 0.f;
        if (tid < 128) {
            LAS float* L = lg + tid * 65;
            float gs[8];
#pragma unroll
            for (int g = 0; g < 8; ++g) {
                float m1 = -INFINITY, m2 = -INFINITY;
#pragma unroll
                for (int j = 0; j < 8; ++j) {
                    const int e = g * 8 + j;
                    const float sel = 1.f / (1.f + expf(-L[e])) + biasl[e];
                    L[e] = sel;
                    if (sel > m1) { m2 = m1; m1 = sel; } else if (sel > m2) m2 = sel;
                }
                gs[g] = m1 + m2;
            }
            unsigned allowed = 0u;
#pragma unroll
            for (int g = 0; g < 8; ++g) {
                int rk = 0;
#pragma unroll
                for (int h = 0; h < 8; ++h) rk += (gs[h] > gs[g] || (gs[h] == gs[g] && h < g)) ? 1 : 0;
                if (rk < 4) allowed |= 1u << g;
            }
#pragma unroll
            for (int k = 0; k < 8; ++k) {
                float best = -INFINITY; int bi = 0;
#pragma unroll
                for (int g = 0; g < 8; ++g) {
                    if ((allowed >> g) & 1u) {
#pragma unroll
                        for (int j = 0; j < 8; ++j) { const float v = L[g * 8 + j]; if (v > best) { best = v; bi = g * 8 + j; } }
                    }
                }
                esel[k] = bi; ssel[k] = best - biasl[bi]; wsum += ssel[k]; L[bi] = -INFINITY;
            }
#pragma unroll
            for (int k = 0; k < 8; ++k) lrank[k] = __hip_atomic_fetch_add(hist + esel[k], 1, __ATOMIC_RELAXED, __HIP_MEMORY_SCOPE_WORKGROUP);
        }
        __syncthreads();
        if (tid < 64) { const int c = hist[tid]; basel[tid] = c > 0 ? atomicAdd(cntg + tid, c) : 0; }
        __syncthreads();
        if (tid < 128) {
            const int t = brow + tid; const float wn = 2.5f / wsum;
#pragma unroll
            for (int k = 0; k < 8; ++k) {
                const int e = esel[k], pos = basel[e] + lrank[k];
                tokslot[(size_t)t * 8 + k] = (e << 20) | pos;
                W8[(size_t)t * 8 + k] = ssel[k] * wn;
                LIST[(size_t)e * TT + pos] = t * 8 + k;
            }
        }
    };
    gemm_tiles<false>(lds, tm0 + vcu_id(), TT / 128, gridDim.x, make, epi);
}

__device__ __forceinline__ int moe_find_expert(const LAS int* tp, int mtg) {
    int lo = 0, hi = 64;
    while (lo < hi) { const int mid = (lo + hi + 1) >> 1; if (tp[mid] <= mtg) lo = mid; else hi = mid - 1; }
    return lo;
}
__device__ __forceinline__ void ph_moe1(const Params& p, LAS unsigned char* lds, int l, int row_lo) {
    unsigned char* ws = p.ws;
    moe_tables(p, lds, l, row_lo);
    LAS int* cnt = (LAS int*)(lds + MOE_LDS_OFF); LAS int* tp = cnt + 80; LAS int* sp = tp + 80;
    const bf16* U = (const bf16*)(ws + AM_U8); const bf16* WGU = (const bf16*)(ws + OFF_W_GU); unsigned char* HM = ws + AM_HM;
    const int* LIST = (const int*)(ws + OFF_LIST);
    const int tid = threadIdx.x, lane = tid & 63, wid = tid >> 6, wr = wid >> 1, wc = wid & 1, fr = lane & 15, fq = lane >> 4;
    const int ntiles = tp[65] * 4;
    auto make = [&](int t, GPtrs& g, int& nk) {
        const int mtg = t >> 2, nt = t & 3, e = moe_find_expert(tp, mtg), mt = mtg - tp[e], ce = cnt[e];
        int lv[4];
#pragma unroll
        for (int i = 0; i < 4; ++i) { const int li = mt * 128 + (tid >> 3) + 32 * i; lv[i] = LIST[(size_t)(e < 64 ? e : 0) * TT + (li < ce ? li : 0)]; }
#pragma unroll
        for (int i = 0; i < 4; ++i) {
            const int li = mt * 128 + (tid >> 3) + 32 * i;
            const int tk = li < ce ? (e < 64 ? (lv[i] >> 3) : row_lo + li) : row_lo;
            g.a[i] = U + (size_t)tk * (DM / 2) + stg_col();
        }
        plain_ptrs(WGU + (size_t)e * 512 * (DM / 2), nt * 128, DM / 2, g.b); nk = DM / 128;
    };
    auto epi = [&](int t, f32x4 (&acc)[4][4]) {
        const int mtg = t >> 2, nt = t & 3, e = moe_find_expert(tp, mtg), mt = mtg - tp[e], ce = cnt[e];
        const size_t slot0 = e < 64 ? (size_t)(sp[e] + mt * 128) : (size_t)TT * 8 + row_lo + mt * 128;
        const int hc0 = nt * 64 + wc * 32;
        unsigned char* dump = ws + OFF_DUMP + lane * 64;
        constexpr float isc = 1.f / W8SC;
#pragma unroll
        for (int m = 0; m < 4; ++m) {
            const int i = wr * 64 + m * 16 + fr;
            unsigned char* hrow = (mt * 128 + i < ce) ? HM + (slot0 + i) * 256 + hc0 + fq * 4 : dump;
#pragma unroll
            for (int n = 0; n < 2; ++n) {
                const f32x4 g = acc[m][n] * isc, u = acc[m][n + 2] * (isc * H8SC);
                *(unsigned*)(hrow + n * 16) = pk4_fp8(siluf(g[0]) * u[0], siluf(g[1]) * u[1], siluf(g[2]) * u[2], siluf(g[3]) * u[3]);
            }
        }
    };
    gemm_tiles<true, 8, true>(lds, vcu_id(), ntiles, gridDim.x, make, epi);
}
__device__ __forceinline__ void ph_moe2(const Params& p, LAS unsigned char* lds, int l, int row_lo) {
    unsigned char* ws = p.ws;
    moe_tables(p, lds, l, row_lo);
    LAS int* cnt = (LAS int*)(lds + MOE_LDS_OFF); LAS int* tp = cnt + 80; LAS int* sp = tp + 80;
    const bf16* HM = (const bf16*)(ws + AM_HM); const bf16* WD = (const bf16*)(ws + OFF_W_D);
    const int tid = threadIdx.x, lane = tid & 63, wid = tid >> 6, wr = wid >> 1, wc = wid & 1, fr = lane & 15, fq = lane >> 4;
    const int ntiles = tp[65] * 8;
    auto make = [&](int t, GPtrs& g, int& nk) {
        const int mtg = t >> 3, nt = t & 7, e = moe_find_expert(tp, mtg), mt = mtg - tp[e];
        const size_t slot0 = e < 64 ? (size_t)(sp[e] + mt * 128) : (size_t)TT * 8 + row_lo + mt * 128;
        plain_ptrs(HM, 0, 128, g.a);
#pragma unroll
        for (int i = 0; i < 4; ++i) g.a[i] += slot0 * 128;
        plain_ptrs(WD + (size_t)e * DM * 128, nt * 128, 128, g.b); nk = 256 / 128;
    };
    auto epi = [&](int t, f32x4 (&acc)[4][4]) {
        const int mtg = t >> 3, nt = t & 7, e = moe_find_expert(tp, mtg), mt = mtg - tp[e], ce = cnt[e];
        const size_t slot0 = e < 64 ? (size_t)(sp[e] + mt * 128) : (size_t)TT * 8 + row_lo + mt * 128;
        constexpr float osc = Y8SC / (W8SC * H8SC);
        unsigned char* YR8 = ws + AM_YR; unsigned char* dump = ws + OFF_DUMP + lane * 16;
#pragma unroll
        for (int m = 0; m < 4; ++m) {
            const int i = wr * 64 + m * 16 + fr;
            unsigned char* yrow = (mt * 128 + i < ce) ? YR8 + (slot0 + i) * DM + nt * 128 + wc * 64 + fq * 16 : dump;
            const f32x4 a0 = acc[m][0] * osc, a1 = acc[m][1] * osc, a2 = acc[m][2] * osc, a3 = acc[m][3] * osc;
            *(u32x4*)(yrow) = (u32x4){pk4_fp8(a0[0], a0[1], a0[2], a0[3]), pk4_fp8(a1[0], a1[1], a1[2], a1[3]), pk4_fp8(a2[0], a2[1], a2[2], a2[3]), pk4_fp8(a3[0], a3[1], a3[2], a3[3])};
        }
    };
    gemm_tiles<true, 4, true, true>(lds, vcu_id(), ntiles, gridDim.x, make, epi);
}

__device__ __forceinline__ void ph_inproj1(const Params& p, LAS unsigned char* lds) {
    unsigned char* ws = p.ws;
    const bf16* U = (const bf16*)(ws + OFF_U); const bf16* W = (const bf16*)(ws + OFF_W_IN_O);
    bf16* Z1 = (bf16*)(ws + A1_Z1); bf16* KM = (bf16*)(ws + A1_KM);
    const f32x2* rope = (const f32x2*)(ws + OFF_ROPE);
    const int tid = threadIdx.x, lane = tid & 63, wid = tid >> 6, wr = wid >> 1, wc = wid & 1, fr = lane & 15, fq = lane >> 4;
    constexpr int NTN = 7, NTM = TT / 128;
    auto make = [&](int t, GPtrs& g, int& nk) { int tm, tn; tile_mn(t, NTM, NTN, tm, tn); plain_ptrs(U, tm * 128, DM, g.a); plain_ptrs(W, tn * 128, DM, g.b); nk = DM / 64; };
    auto epi = [&](int t, f32x4 (&acc)[4][4]) {
        int tm, tn; tile_mn(t, NTM, NTN, tm, tn); const int brow = tm * 128, bcol = tn * 128;
        const int cb = bcol + wc * 64;
        LAS unsigned char* wl = lds + 32768 + wid * 8192;
        const int r0 = brow + wr * 64;
        const RowInfo ri0 = rowinfo(r0);
        if (cb < 768) {
            float* ssq = (float*)(ws + OFF_SSQ);
#pragma unroll
            for (int m = 0; m < 4; ++m) {
                float q = 0.f;
#pragma unroll
                for (int n = 0; n < 4; ++n) q += (acc[m][n][0] * acc[m][n][0] + acc[m][n][1] * acc[m][n][1]) + (acc[m][n][2] * acc[m][n][2] + acc[m][n][3] * acc[m][n][3]);
                q += __shfl_xor(q, 16); q += __shfl_xor(q, 32);
                if (fq == 0) ssq[(size_t)(r0 + m * 16 + fr) * 12 + (cb >> 6)] = q;
            }
            epi_store_rows(wl, acc, fr, fq, lane, [&](int row) { return Z1 + (size_t)(r0 + row) * Z1P + cb; });
        } else if (cb == 768) {
#pragma unroll
            for (int m = 0; m < 4; ++m) {
                const int pos = ri0.pos + m * 16 + fr;
#pragma unroll
                for (int n = 0; n < 2; ++n)
#pragma unroll
                    for (int j = 0; j < 4; ++j) {
                        const float x1 = acc[m][n][j], x2 = acc[m][n + 2][j];
                        if (ri0.lat) { const f32x2 cs = rope[(size_t)pos * 32 + n * 16 + fq * 4 + j]; acc[m][n][j] = x1 * cs.x - x2 * cs.y; acc[m][n + 2][j] = x2 * cs.x + x1 * cs.y; }
                    }
                asm volatile("" ::: "memory");
            }
            bf16* dst = KM + ((size_t)(ri0.b * 8) * NKEY + ri0.kq) * 192 + 128;
            epi_store_rows(wl, acc, fr, fq, lane, [&](int row) { return dst + (size_t)row * 192; }, 8, (size_t)NKEY * 192);
        }
    };
    gemm_tiles<true>(lds, vcu_id(), NTM * NTN, gridDim.x, make, epi);
}

__device__ __forceinline__ void ph_mla_up(const Params& p, LAS unsigned char* lds) {
    unsigned char* ws = p.ws;
    const bf16* Z1 = (const bf16*)(ws + A1_Z1); const bf16* WQ = (const bf16*)(ws + OFF_W_UQ); const bf16* WKV = (const bf16*)(ws + OFF_W_UKV);
    bf16* QM = (bf16*)(ws + A1_QM); bf16* KM = (bf16*)(ws + A1_KM); bf16* VTM = (bf16*)(ws + A1_VTM);
    const f32x2* rope = (const f32x2*)(ws + OFF_ROPE);
    const int tid = threadIdx.x, lane = tid & 63, wid = tid >> 6, wr = wid >> 1, wc = wid & 1, fr = lane & 15, fq = lane >> 4;
    LAS float* rsb = (LAS float*)(lds + 66560);
    constexpr int NQ = (TL / 128) * 12, NKV = (TT / 128) * 16;
    constexpr float QSCALE = 0.07216878364870322f * LOG2E;
    auto decode = [&](int t, bool& isq, int& tm, int& tn) { isq = t < NQ; if (isq) { tile_mn(t, TL / 128, 12, tm, tn); tm += 4; } else tile_mn(t - NQ, TT / 128, 16, tm, tn); };
    auto make = [&](int t, GPtrs& g, int& nk) {
        bool isq; int tm, tn; decode(t, isq, tm, tn);
        const int brow = tm * 128, bcol = tn * 128, K = isq ? 512 : 256, acol = isq ? 0 : 512;
        const int par = ((t - vcu_id()) / (int)gridDim.x) & 1;
        if (tid < 128) {
            const float* q = (const float*)(ws + OFF_SSQ) + (size_t)(brow + tid) * 12;
            float ss;
            if (isq) { const f32x4 a = *(const f32x4*)q, b2 = *(const f32x4*)(q + 4); ss = ((a.x + a.y) + (a.z + a.w)) + ((b2.x + b2.y) + (b2.z + b2.w)); }
            else { const f32x4 a = *(const f32x4*)(q + 8); ss = (a.x + a.y) + (a.z + a.w); }
            rsb[par * 128 + tid] = rsqrtf(ss / (float)K + RMS_EPS);
        }
        plain_ptrs(Z1 + acol, brow, Z1P, g.a); plain_ptrs(isq ? WQ : WKV, bcol, K, g.b); nk = K / 64;
    };
    auto epi = [&](int t, f32x4 (&acc)[4][4]) {
        bool isq; int tm, tn; decode(t, isq, tm, tn);
        const int brow = tm * 128, bcol = tn * 128;
        const int par = ((t - vcu_id()) / (int)gridDim.x) & 1;
        const int cb = bcol + wc * 64;
        LAS unsigned char* wl = lds + 32768 + wid * 8192;
        const int r0 = brow + wr * 64;
        const RowInfo ri0 = rowinfo(r0);
        if (isq) {
            const int h = cb / 192, part = (cb % 192) >> 6;
#pragma unroll
            for (int m = 0; m < 4; ++m) {
                const float sc = rsb[par * 128 + wr * 64 + m * 16 + fr] * QSCALE;
                const int pos = ri0.pos + m * 16 + fr;
                if (part < 2) {
#pragma unroll
                    for (int n = 0; n < 4; ++n) acc[m][n] = acc[m][n] * sc;
                } else {
#pragma unroll
                    for (int n = 0; n < 2; ++n)
#pragma unroll
                        for (int j = 0; j < 4; ++j) {
                            const float x1 = acc[m][n][j] * sc, x2 = acc[m][n + 2][j] * sc;
                            const f32x2 cs = rope[(size_t)pos * 32 + n * 16 + fq * 4 + j];
                            acc[m][n][j] = x1 * cs.x - x2 * cs.y; acc[m][n + 2][j] = x2 * cs.x + x1 * cs.y;
                        }
                }
                asm volatile("" ::: "memory");
            }
            bf16* dst = QM + ((size_t)(ri0.b * 8 + h) * SEQ + ri0.pos) * 192 + part * 64;
            epi_store_rows(wl, acc, fr, fq, lane, [&](int row) { return dst + (size_t)row * 192; });
        } else {
            const int h = cb >> 8, part = (cb & 255) >> 6;
#pragma unroll
            for (int m = 0; m < 4; ++m) {
                const float rs = rsb[par * 128 + wr * 64 + m * 16 + fr];
#pragma unroll
                for (int n = 0; n < 4; ++n) acc[m][n] = acc[m][n] * rs;
            }
            if (part < 2) {
                bf16* dst = KM + ((size_t)(ri0.b * 8 + h) * NKEY + ri0.kq) * 192 + part * 64;
                epi_store_rows(wl, acc, fr, fq, lane, [&](int row) { return dst + (size_t)row * 192; });
            } else {
                bf16* dst = VTM + ((size_t)(ri0.b * 8 + h) * 128 + (part - 2) * 64) * NKEY + ri0.kq;
                epi_store_cols(wl, acc, fr, fq, lane, [&](int col) { return dst + (size_t)col * NKEY; });
            }
        }
    };
    gemm_tiles<true>(lds, vcu_id(), NQ + NKV, gridDim.x, make, epi);
}

__device__ __forceinline__ void ph_mla_attn(const Params& p, LAS unsigned char* lds) {
    unsigned char* ws = p.ws;
    const bf16* QM = (const bf16*)(ws + A1_QM); const bf16* KM = (const bf16*)(ws + A1_KM); const bf16* VTM = (const bf16*)(ws + A1_VTM); bf16* MIX = (bf16*)(ws + A1_MIX);
    for (int item = vcu_id(); item < 2 * 8 * 64; item += gridDim.x) {
        const int qt = item & 63, h = (item >> 6) & 7, b = item >> 9;
        const bf16* Qg = QM + ((size_t)(b * 8 + h) * SEQ + qt * 128) * 192;
        const bf16* Kg = KM + (size_t)(b * 8 + h) * NKEY * 192;
        const bf16* Vg = VTM + (size_t)(b * 8 + h) * 128 * NKEY;
        attn_item<192, 128>(lds, Qg, Kg, Vg, NKEY / 32, 0, 0, 0, -1e30f, 0.f, MIX + (size_t)(TC + b * SEQ + qt * 128) * DM + h * 128, DM);
    }
}


#define XB_TMO      128
#define XB_XCNT(j)  (256  + 64 * (j))
#define XB_XSUB(j)  (1280 + 64 * (j))
#define XB_XGEN(j)  (2304 + 64 * (j))
#define XB_TOP      3328
#define XB_TOPGEN   3392
#define XCD_BAR_WORDS 3456
#define XB_SPIN_CAP (1u << 18)
__device__ __forceinline__ unsigned xb_ld(unsigned* p)              { return __hip_atomic_load(p, __ATOMIC_RELAXED, __HIP_MEMORY_SCOPE_AGENT); }
__device__ __forceinline__ unsigned xb_add(unsigned* p, unsigned v) { return __hip_atomic_fetch_add(p, v, __ATOMIC_RELAXED, __HIP_MEMORY_SCOPE_AGENT); }
__device__ __forceinline__ unsigned xb_xcc_id() { return (unsigned)__builtin_amdgcn_s_getreg((3 << 11) | 20) & 0xFu; }
#define XB_SPIN(cond, bar) do { unsigned _sp = 0; while (cond) { __builtin_amdgcn_s_sleep(1); \
    if ((++_sp & 255u) == 0u) { if (xb_ld(&(bar)[XB_TMO])) break; if (_sp > XB_SPIN_CAP) { atomicAdd(&(bar)[XB_TMO], 1u); break; } } } } while (0)
struct XcdBarrier { unsigned* bar; unsigned x; volatile LAS unsigned* st; };
__device__ __forceinline__ XcdBarrier xcd_barrier_post(unsigned* bar, volatile LAS unsigned* st) {
    XcdBarrier b; b.bar = bar; b.x = xb_xcc_id(); b.st = st;
    if (threadIdx.x == 0) (void)xb_add(&bar[XB_XCNT(b.x)], 1u);
    return b;
}
__device__ __forceinline__ void xcd_barrier_complete(unsigned* bar, unsigned x, unsigned& nloc, unsigned& nx) {
    const unsigned G = gridDim.x * gridDim.y * gridDim.z;
    unsigned sum, cnt, mine, sp = 0u;
    for (;;) {
        sum = 0u; cnt = 0u; mine = 0u;
#pragma unroll
        for (unsigned j = 0; j < 16; ++j) { const unsigned c = xb_ld(&bar[XB_XCNT(j)]); sum += c; cnt += (c > 0u) ? 1u : 0u; mine = (j == x) ? c : mine; }
        if (sum == G) break;
        __builtin_amdgcn_s_sleep(1);
        if ((++sp & 255u) == 0u) { if (xb_ld(&bar[XB_TMO])) break; if (sp > XB_SPIN_CAP) { atomicAdd(&bar[XB_TMO], 1u); break; } }
    }
    nloc = mine > 0u ? mine : 1u; nx = cnt > 0u ? cnt : 1u;
}
__device__ __forceinline__ void xcd_barrier(const XcdBarrier& b) {
    asm volatile("s_waitcnt vmcnt(0)" ::: "memory");
    __syncthreads();
    if (threadIdx.x == 0) {
        unsigned* bar = b.bar;
        __builtin_amdgcn_s_waitcnt(0);
        unsigned nloc = b.st[0], nx = b.st[1];
        if (nloc == 0u) { xcd_barrier_complete(bar, b.x, nloc, nx); b.st[0] = nloc; b.st[1] = nx; }
        const unsigned old = xb_add(&bar[XB_XSUB(b.x)], 1u);
        const unsigned gen = old / nloc;
        if (old + 1u == (gen + 1u) * nloc) {
            __builtin_amdgcn_fence(__ATOMIC_RELEASE, "agent");
            asm volatile("s_waitcnt vmcnt(0)" ::: "memory");
            const unsigned og = xb_add(&bar[XB_TOP], 1u);
            const unsigned tg = og / nx;
            if (og + 1u == (tg + 1u) * nx) xb_add(&bar[XB_TOPGEN], 1u);
            else XB_SPIN(xb_ld(&bar[XB_TOPGEN]) == tg, bar);
            __builtin_amdgcn_fence(__ATOMIC_ACQUIRE, "agent");
            xb_add(&bar[XB_XGEN(b.x)], 1u);
            asm volatile("s_waitcnt vmcnt(0)" ::: "memory");
        } else {
            XB_SPIN(xb_ld(&bar[XB_XGEN(b.x)]) == gen, bar);
            __builtin_amdgcn_fence(__ATOMIC_ACQUIRE, "agent");
            asm volatile("s_waitcnt vmcnt(0)" ::: "memory");
        }
    }
    __syncthreads();
}
static_assert(XCD_BAR_WORDS * 4 <= BAR_BYTES, "barrier words");

__device__ __forceinline__ void convert_shared(const Params& p, LAS unsigned char* lds, int l, int nrt) {
    const int v = vcu_id(), G = gridDim.x, nfree = G - nrt;
    if (v >= nrt) for (int it = v - nrt; it < EXP_ITEMS; it += nfree) expert_convert_item(p, lds, l, it);
}

constexpr int NPHASE = 19;
__global__ void __launch_bounds__(256, 2) mega(Params p) {
    extern __shared__ __attribute__((aligned(16))) unsigned char lds_[];
    LAS unsigned char* lds = (LAS unsigned char*)lds_;
    cg::grid_group grid = cg::this_grid();
    unsigned char* ws = p.ws;
    volatile LAS unsigned* bst = (volatile LAS unsigned*)(lds + LDS_BYTES - 16);
    if (threadIdx.x < 4) bst[threadIdx.x] = 0u;
    __syncthreads();
    const XcdBarrier xbar = xcd_barrier_post((unsigned*)(ws + OFF_BAR), bst);
#define GRID_BAR(k) do { if ((k) == 0) grid.sync(); else xcd_barrier(xbar); } while (0)
#ifndef PROBE_REP_MASK
#define PROBE_REP_MASK 0u
#endif
#ifndef PROBE_EXTRA_SYNCS
#define PROBE_EXTRA_SYNCS 0
#endif
#define PHASE(k, body) do { if (p.ph_lo <= (k) && (k) < p.ph_hi) { body; if ((PROBE_REP_MASK >> (k)) & 1u) { xcd_barrier(xbar); body; } if ((k) + 1 < p.ph_hi) GRID_BAR(k); } } while (0)
    for (int i = 0; i < PROBE_EXTRA_SYNCS; ++i) xcd_barrier(xbar);
    PHASE(0, ph_prep(p, lds));
    PHASE(1, ph_modulate0(p));
    PHASE(2, ph_inproj0(p, lds));
    PHASE(3, ph_swa_g1(p, lds));
    PHASE(4, ph_gla_scan(p));
    PHASE(5, ph_gla_g3(p, lds));
    PHASE(6, ph_outproj(p, lds, (const bf16*)(ws + A0_MIX), (const bf16*)(ws + OFF_W_OUT_E), (float*)(ws + A0_Y), 0));
    PHASE(7, ph_rowpassA(p, 0, 0, (const float*)(ws + A0_Y)));
    PHASE(8, { ph_router(p, lds, 0, 0); __syncthreads(); convert_shared(p, lds, 0, TT / 128); });
    PHASE(9, ph_moe1(p, lds, 0, 0));
    PHASE(10, ph_moe2(p, lds, 0, 0));
    PHASE(11, ph_rowpassB(p, lds, 0, 0));
    PHASE(12, ph_inproj1(p, lds));
    PHASE(13, ph_mla_up(p, lds));
    PHASE(14, ph_mla_attn(p, lds));
    PHASE(15, ph_outproj(p, lds, (const bf16*)(ws + A1_MIX), (const bf16*)(ws + OFF_W_OUT_O), (float*)(ws + A1_Y), TC));
    PHASE(16, ph_rowpassA(p, 1, TC, (const float*)(ws + A1_Y)));
    PHASE(17, { ph_router(p, lds, 1, TC); __syncthreads(); convert_shared(p, lds, 1, TL / 128); });
    PHASE(18, ph_moe1(p, lds, 1, TC));
    PHASE(19, ph_moe2(p, lds, 1, TC));
    PHASE(20, ph_rowpassB(p, lds, 1, TC));
}

extern "C" void kernel_launch(void* const* d_in, const int* in_sizes, int n_in, void* d_out, int out_size, void* d_ws, size_t ws_size, hipStream_t stream) {
    static int grid_blocks = 0;
    if (!grid_blocks) {
        int dev = 0, cus = 0, per_cu = 0;
        (void)hipGetDevice(&dev);
        (void)hipDeviceGetAttribute(&cus, hipDeviceAttributeMultiprocessorCount, dev);
        (void)hipFuncSetAttribute((const void*)mega, hipFuncAttributeMaxDynamicSharedMemorySize, LDS_BYTES);
        (void)hipOccupancyMaxActiveBlocksPerMultiprocessor(&per_cu, (const void*)mega, 256, LDS_BYTES);
        if (per_cu > 2) per_cu = 2;
        if (per_cu < 1) per_cu = 1;
        grid_blocks = cus * per_cu;
        if (ws_size < WS_NEED) fprintf(stderr, "kernel_launch: workspace too small: %zu < %zu\n", ws_size, (size_t)WS_NEED);
    }
    Params p{};
    const float** f = (const float**)&p;
    for (int i = 0; i < 30; ++i) f[i] = (const float*)d_in[i];
    p.out = (float*)d_out; p.ws = (unsigned char*)d_ws; p.ph_lo = 0; p.ph_hi = 21;
    (void)hipMemsetAsync((unsigned char*)d_ws + OFF_BAR, 0, BAR_BYTES, stream);
    void* args[] = {&p};
    hipError_t e = hipLaunchCooperativeKernel((const void*)mega, dim3(grid_blocks), dim3(256), args, LDS_BYTES, stream);
    if (e != hipSuccess) fprintf(stderr, "cooperative launch failed: %s (grid %d)\n", hipGetErrorString(e), grid_blocks);
}
```

```cpp
#include <hip/hip_runtime.h>
#include <hip/hip_cooperative_groups.h>
#include <cstdio>
#include <cstdint>
namespace cg = cooperative_groups;

#define LAS __attribute__((address_space(3)))
typedef unsigned short bf16;
typedef short bf16x8 __attribute__((ext_vector_type(8)));
typedef float f32x2 __attribute__((ext_vector_type(2)));
typedef float f32x4 __attribute__((ext_vector_type(4)));
typedef float f32x8 __attribute__((ext_vector_type(8)));
typedef float f32x16 __attribute__((ext_vector_type(16)));
typedef unsigned u32x2 __attribute__((ext_vector_type(2)));
typedef unsigned u32x4 __attribute__((ext_vector_type(4)));
typedef __bf16 bf16x2_t __attribute__((ext_vector_type(2)));

constexpr int DM = 1024, NB = 2, SEQ = 8192, CTX = 256;
constexpr int TC = NB * CTX, TL = NB * SEQ, TT = TC + TL, NKEY = CTX + SEQ;
constexpr int NEXP = 64;
constexpr float RMS_EPS = 1e-6f;
constexpr int E_IN_PAD = 2432, O_IN_PAD = 896;
constexpr float LOG2E = 1.4426950408889634f;
constexpr int NSTEP = 132;
constexpr int Z0P = 1056;
constexpr int Z1P = 768;
constexpr int LDS_BYTES = 73728;

constexpr size_t al(size_t x) { return (x + 255) & ~(size_t)255; }
constexpr size_t OFF_W_IN_E = 0;
constexpr size_t OFF_W_OUT_E = OFF_W_IN_E + al((size_t)E_IN_PAD * DM * 2);
constexpr size_t OFF_W_IN_O = OFF_W_OUT_E + al((size_t)DM * DM * 2);
constexpr size_t OFF_W_UQ = OFF_W_IN_O + al((size_t)O_IN_PAD * DM * 2);
constexpr size_t OFF_W_UKV = OFF_W_UQ + al((size_t)1536 * 512 * 2);
constexpr size_t OFF_W_OUT_O = OFF_W_UKV + al((size_t)2048 * 256 * 2);
constexpr size_t OFF_W_RT = OFF_W_OUT_O + al((size_t)DM * DM * 2);
constexpr size_t OFF_W_GU = OFF_W_RT + al((size_t)2 * 128 * DM * 2);
constexpr size_t OFF_W_D = OFF_W_GU + al((size_t)65 * 512 * DM * 2);
constexpr size_t OFF_U = OFF_W_D + al((size_t)65 * DM * 256 * 2);
constexpr size_t OFF_HC = OFF_U + al((size_t)TT * DM * 2);
constexpr size_t OFF_MOD = OFF_HC + al((size_t)TC * DM * 4);
constexpr size_t OFF_ROPE = OFF_MOD + al((size_t)2 * 3 * 6144 * 4);
constexpr size_t OFF_CNT = OFF_ROPE + al((size_t)SEQ * 32 * 8);
constexpr size_t OFF_TOKSLOT = OFF_CNT + al(2 * 64 * 4);
constexpr size_t OFF_W8 = OFF_TOKSLOT + al((size_t)TT * 8 * 4);
constexpr size_t OFF_LIST = OFF_W8 + al((size_t)TT * 8 * 4);
constexpr size_t OFF_SSQ = OFF_LIST + al((size_t)64 * TT * 4);
constexpr size_t OFF_DUMP = OFF_SSQ + al((size_t)TT * 12 * 4);
constexpr size_t OFF_BAR = OFF_DUMP + 8192;
constexpr size_t BAR_BYTES = 16384;
constexpr size_t OFF_ARENA = OFF_BAR + BAR_BYTES;
constexpr size_t A0_Z0 = OFF_ARENA;
constexpr size_t A0_VGT = A0_Z0 + al((size_t)TT * Z0P * 2);
constexpr size_t A0_QS = A0_VGT + al((size_t)4 * 128 * TT * 2);
constexpr size_t A0_KS = A0_QS + al((size_t)2 * 8 * NKEY * 64 * 2);
constexpr size_t A0_VST = A0_KS + al((size_t)2 * 2 * NKEY * 64 * 2);
constexpr size_t A0_GS = A0_VST + al((size_t)2 * 2 * 64 * NKEY * 2);
constexpr size_t A0_GD = A0_GS + al((size_t)16 * NSTEP * 8192 * 4);
constexpr size_t A0_MIX = A0_GD + al((size_t)16 * NSTEP * 64 * 4);
constexpr size_t A0_Y = A0_MIX + al((size_t)TT * DM * 2);
constexpr size_t A0_END = A0_Y + al((size_t)TT * DM * 4);
constexpr size_t A1_Z1 = OFF_ARENA;
constexpr size_t A1_QM = A1_Z1 + al((size_t)TT * Z1P * 2);
constexpr size_t A1_KM = A1_QM + al((size_t)2 * 8 * SEQ * 192 * 2);
constexpr size_t A1_VTM = A1_KM + al((size_t)2 * 8 * NKEY * 192 * 2);
constexpr size_t A1_MIX = A1_VTM + al((size_t)2 * 8 * 128 * NKEY * 2);
constexpr size_t A1_Y = A1_MIX + al((size_t)TT * DM * 2);
constexpr size_t A1_END = A1_Y + al((size_t)TT * DM * 4);
constexpr size_t AM_U8 = OFF_ARENA;
constexpr size_t AM_HM = AM_U8 + al((size_t)TT * 1024);
constexpr size_t AM_YR = AM_HM + al((size_t)TT * 9 * 256);
constexpr size_t AM_END = AM_YR + al((size_t)TT * 9 * 1024 * 2);
constexpr size_t WS_NEED = AM_END > A0_END ? (AM_END > A1_END ? AM_END : A1_END) : (A0_END > A1_END ? A0_END : A1_END);
static_assert(WS_NEED <= 555747360ull, "workspace map exceeds the guaranteed d_ws size");

struct Params {
    const float *x, *c, *ctx, *c_ctx, *w_mod, *b_mod, *g_mix_pre, *g_mix_post, *g_ffn_pre, *g_ffn_post;
    const float *w_in_e, *gla_wa2, *gla_ba, *gla_norm, *swa_sink, *w_out_e;
    const float *w_in_o, *mla_q_norm, *mla_kv_norm, *w_uq, *w_ukv, *w_out_o;
    const float *w_router, *b_router, *w_exp_gate, *w_exp_up, *w_exp_down, *w_sh_gate, *w_sh_up, *w_sh_down;
    float* out; unsigned char* ws; int ph_lo, ph_hi;
};

__device__ __forceinline__ unsigned pk2(float lo, float hi) { f32x2 v = {lo, hi}; bf16x2_t b = __builtin_convertvector(v, bf16x2_t); return __builtin_bit_cast(unsigned, b); }
__device__ __forceinline__ float bflo(unsigned u) { return __uint_as_float(u << 16); }
__device__ __forceinline__ float bfhi(unsigned u) { return __uint_as_float(u & 0xffff0000u); }
__device__ __forceinline__ float bf2f(bf16 v) { return __uint_as_float((unsigned)v << 16); }
__device__ __forceinline__ bf16 f2bf(float f) { return (bf16)(pk2(f, 0.f) & 0xffffu); }
constexpr float W8SC = 64.f, H8SC = 4.f, Y8SC = 16.f;
__device__ __forceinline__ unsigned pk4_fp8(float a, float b, float c, float d) { int w = 0; w = __builtin_amdgcn_cvt_pk_fp8_f32(a, b, w, false); w = __builtin_amdgcn_cvt_pk_fp8_f32(c, d, w, true); return (unsigned)w; }
__device__ __forceinline__ float wave_sum(float v) {
#pragma unroll
    for (int o = 1; o < 64; o <<= 1) v += __shfl_xor(v, o);
    return v;
}
__device__ __forceinline__ void glds16(const void* g, LAS void* l) { __builtin_amdgcn_global_load_lds((const unsigned*)g, (LAS unsigned*)l, 16, 0, 0); }
__device__ __forceinline__ float siluf(float x) { return x / (1.f + __expf(-x)); }
__device__ __forceinline__ float ex2(float x) { return __builtin_amdgcn_exp2f(x); }
__device__ __forceinline__ int crow(int r, int hi) { return (r & 3) + 8 * (r >> 2) + 4 * hi; }
__device__ __forceinline__ bf16x8 mk8(u32x4 v) { return __builtin_bit_cast(bf16x8, v); }

struct RowInfo { int b, kq, pos; bool lat; };
__device__ __forceinline__ RowInfo rowinfo(int r) {
    RowInfo i;
    if (r < TC) { i.b = r >> 8; i.pos = r & 255; i.kq = i.pos; i.lat = false; }
    else { const int rl = r - TC; i.b = rl >> 13; i.pos = rl & (SEQ - 1); i.kq = CTX + i.pos; i.lat = true; }
    return i;
}
__device__ __forceinline__ int modvec(int r) { return r < TC ? 2 : ((r - TC) >> 13); }

struct GPtrs { const bf16* a[4]; const bf16* b[4]; };
constexpr int G_STAGE = 32768;
#define G_FENCE() asm volatile("" ::: "memory")
__device__ __forceinline__ void gemm_issue(LAS unsigned char* lds, const GPtrs& g, int kt) {
    LAS unsigned char* d = lds + (kt & 1) * G_STAGE + threadIdx.x * 16; const int ko = kt * 64;
#pragma unroll
    for (int i = 0; i < 4; ++i) { glds16(g.a[i] + ko, d + i * 4096); glds16(g.b[i] + ko, d + 16384 + i * 4096); }
}
__device__ __forceinline__ void gemm_prologue(LAS unsigned char* lds, const GPtrs& g, int nk) { gemm_issue(lds, g, 0); }
__device__ __forceinline__ void gemm_prologue2(LAS unsigned char* lds, const GPtrs& g) { gemm_issue(lds, g, 0); gemm_issue(lds, g, 1); }
template <int NST, bool FP8 = false, bool PRE2 = false>
__device__ __forceinline__ void gemm_main(LAS unsigned char* lds, const GPtrs& g, int nk, f32x4 (&acc)[4][4], bool after_epi) {
    const int tid = threadIdx.x, lane = tid & 63, wid = tid >> 6, wr = wid >> 1, wc = wid & 1, fr = lane & 15, fq = lane >> 4;
#pragma unroll
    for (int m = 0; m < 4; ++m)
#pragma unroll
        for (int n = 0; n < 4; ++n) acc[m][n] = (f32x4){0.f, 0.f, 0.f, 0.f};
    const int c0 = ((fq) ^ (fr & 7)) * 16, c1 = ((4 + fq) ^ (fr & 7)) * 16;
    const int aoff = (wr * 64 + fr) * 128, boff = 16384 + (wc * 64 + fr) * 128;
    for (int kt = 0; kt < nk; ++kt) {
        if (PRE2) {
            static_assert(!PRE2 || NST == 4 || NST < 0, "PRE2 counted waits are written for 4 epilogue stores");
            if (kt == 0) { if (after_epi) asm volatile("s_waitcnt vmcnt(12) lgkmcnt(0)" ::: "memory"); else asm volatile("s_waitcnt vmcnt(8) lgkmcnt(0)" ::: "memory"); }
            else { if (after_epi) asm volatile("s_waitcnt vmcnt(4) lgkmcnt(0)" ::: "memory"); else asm volatile("s_waitcnt vmcnt(0) lgkmcnt(0)" ::: "memory"); }
        } else
        if (NST == 8 && kt == 0 && after_epi) asm volatile("s_waitcnt vmcnt(8) lgkmcnt(0)" ::: "memory");
        else if (NST == 16 && kt == 0 && after_epi) asm volatile("s_waitcnt vmcnt(16) lgkmcnt(0)" ::: "memory");
        else asm volatile("s_waitcnt vmcnt(0) lgkmcnt(0)" ::: "memory");
        __builtin_amdgcn_s_barrier();
        G_FENCE();
        if (!PRE2 && kt + 1 < nk) gemm_issue(lds, g, kt + 1);
        LAS unsigned char* base = lds + (kt & 1) * G_STAGE;
        if constexpr (FP8) {
            long a8[4][4], b8[4][4];
#pragma unroll
            for (int ks = 0; ks < 4; ++ks) {
                const int co = (((ks * 2 + (fq >> 1)) ^ (fr & 7)) * 16) + (fq & 1) * 8;
#pragma unroll
                for (int m = 0; m < 4; ++m) a8[ks][m] = *(const LAS long*)(base + aoff + m * 2048 + co);
#pragma unroll
                for (int n = 0; n < 4; ++n) b8[ks][n] = *(const LAS long*)(base + boff + n * 2048 + co);
            }
            __builtin_amdgcn_s_setprio(1);
#pragma unroll
            for (int ks = 0; ks < 4; ++ks)
#pragma unroll
                for (int m = 0; m < 4; ++m)
#pragma unroll
                    for (int n = 0; n < 4; ++n) acc[m][n] = __builtin_amdgcn_mfma_f32_16x16x32_fp8_fp8(b8[ks][n], a8[ks][m], acc[m][n], 0, 0, 0);
            __builtin_amdgcn_s_setprio(0);
            continue;
        }
        bf16x8 af0[4], bf0[4], af1[4], bf1[4];
#pragma unroll
        for (int m = 0; m < 4; ++m) af0[m] = *(const LAS bf16x8*)(base + aoff + m * 2048 + c0);
#pragma unroll
        for (int n = 0; n < 4; ++n) bf0[n] = *(const LAS bf16x8*)(base + boff + n * 2048 + c0);
#pragma unroll
        for (int m = 0; m < 4; ++m) af1[m] = *(const LAS bf16x8*)(base + aoff + m * 2048 + c1);
#pragma unroll
        for (int n = 0; n < 4; ++n) bf1[n] = *(const LAS bf16x8*)(base + boff + n * 2048 + c1);
        __builtin_amdgcn_s_setprio(1);
#pragma unroll
        for (int m = 0; m < 4; ++m)
#pragma unroll
            for (int n = 0; n < 4; ++n) acc[m][n] = __builtin_amdgcn_mfma_f32_16x16x32_bf16(bf0[n], af0[m], acc[m][n], 0, 0, 0);
#pragma unroll
        for (int m = 0; m < 4; ++m)
#pragma unroll
            for (int n = 0; n < 4; ++n) acc[m][n] = __builtin_amdgcn_mfma_f32_16x16x32_bf16(bf1[n], af1[m], acc[m][n], 0, 0, 0);
        __builtin_amdgcn_s_setprio(0);
    }
    asm volatile("s_waitcnt lgkmcnt(0)" ::: "memory");
    __builtin_amdgcn_s_barrier();
    G_FENCE();
}
__device__ __forceinline__ int vcu_id() { const int b = blockIdx.x, G = gridDim.x; return (G % 8 == 0) ? (b % 8) * (G / 8) + b / 8 : b; }
__device__ __forceinline__ void tile_mn(int w, int ntm, int ntn, int& tm, int& tn) {
    const int nig = 8 * ntn, gid = w / nig, fm = gid * 8, gsz = (ntm - fm) < 8 ? (ntm - fm) : 8, within = w - gid * nig;
    tm = fm + within % gsz; tn = within / gsz;
}
template <bool PREFETCH_NEXT, int NST = -1, bool FP8 = false, bool PRE2 = false, class Make, class Epi>
__device__ __forceinline__ void gemm_tiles(LAS unsigned char* lds, int t0, int nt, int stride, Make make, Epi epi) {
    if (t0 >= nt) return;
    GPtrs g; int nk;
    make(t0, g, nk);
    G_FENCE();
    if (PRE2) gemm_prologue2(lds, g); else gemm_prologue(lds, g, nk);
    bool first = true;
    for (int t = t0; t < nt;) {
        const int tn = t + stride;
        f32x4 acc[4][4];
        gemm_main<PREFETCH_NEXT ? NST : -1, FP8, PRE2>(lds, g, nk, acc, !first);
        first = false;
        if (PREFETCH_NEXT) { if (tn < nt) { make(tn, g, nk); G_FENCE(); if (PRE2) gemm_prologue2(lds, g); else gemm_prologue(lds, g, nk); } epi(t, acc); }
        else { epi(t, acc); __syncthreads(); if (tn < nt) { make(tn, g, nk); G_FENCE(); gemm_prologue(lds, g, nk); } }
        t = tn;
    }
}

template <class RowPtr>
__device__ __forceinline__ void epi_store_rows(LAS unsigned char* wl, const f32x4 (&v)[4][4], int fr, int fq, int lane, RowPtr rowptr, int nrep = 1, size_t rep_stride = 0) {
#pragma unroll
    for (int m = 0; m < 4; ++m)
#pragma unroll
        for (int n = 0; n < 4; ++n)
            *(LAS u32x2*)(wl + (m * 16 + fr) * 128 + (((n * 2 + (fq >> 1)) ^ (fr & 7)) * 16) + (fq & 1) * 8) = (u32x2){pk2(v[m][n][0], v[m][n][1]), pk2(v[m][n][2], v[m][n][3])};
#pragma unroll
    for (int i = 0; i < 8; ++i) {
        const int row = (lane >> 3) + 8 * i, pos = lane & 7;
        const u32x4 w = *(const LAS u32x4*)(wl + row * 128 + pos * 16);
        bf16* d = rowptr(row);
        if (d) { d += (pos ^ (row & 7)) * 8; for (int r = 0; r < nrep; ++r) *(u32x4*)(d + (size_t)r * rep_stride) = w; }
    }
}
template <class ColPtr>
__device__ __forceinline__ void epi_store_cols(LAS unsigned char* wl, const f32x4 (&v)[4][4], int fr, int fq, int lane, ColPtr colptr) {
    LAS unsigned char* wb = wl + fq * 512 + fr * 2;
#pragma unroll
    for (int m = 0; m < 4; ++m)
#pragma unroll
        for (int n = 0; n < 4; ++n)
#pragma unroll
            for (int j = 0; j < 4; ++j) *(LAS bf16*)(wb + n * 2048 + j * 128 + m * 32) = f2bf(v[m][n][j]);
#pragma unroll
    for (int i = 0; i < 8; ++i) {
        const int col = (lane >> 3) + 8 * i, pos = lane & 7;
        const u32x4 w = *(const LAS u32x4*)(wl + col * 128 + pos * 16);
        bf16* d = colptr(col);
        *(u32x4*)(d + pos * 8) = w;
    }
}

__device__ __forceinline__ int ein_map(int n) {
    if (n < 512) return n;
    if (n < 1024) return n + 512;
    if (n < 1536) return n - 512;
    if (n < 2048) return 1568 + (n - 1536);
    if (n < 2176) return 2080 + (n - 2048);
    if (n < 2304) return 2208 + (n - 2176);
    if (n < 2320) return 1536 + (n - 2304);
    if (n < 2336) return 1552 + (n - 2320);
    return -1;
}
template <bool FP8 = false>
__device__ __forceinline__ void transpose_item(LAS unsigned char* lds, int K, bf16* dst, int k0, int n0, int ld, int mode, const float* srcA, const float* srcB, int nvalid, const float* kscale) {
    LAS float* tile = (LAS float*)lds;
    const int tid = threadIdx.x;
    {
        const int nq = tid & 31, kr = tid >> 5, n = n0 + nq * 4;
        const float* cp = nullptr; float sc = 1.f;
        if (mode == 0) { if (n < nvalid) cp = srcA + n; }
        else if (mode == 1) { const int c = ein_map(n); if (c >= 0) cp = srcA + c; if (n < 256) sc = 0.125f; }
        else if (mode == 2) { const int grp = n >> 6, w = n & 63; cp = (w < 32 ? srcA : srcB) + grp * 32 + (w & 31); }
        else { const int b6 = n & 63; cp = srcA + (n & ~63) + ((b6 >> 2) & 3) * 16 + (b6 >> 4) * 4; }
        f32x4 v[8];
#pragma unroll
        for (int i = 0; i < 8; ++i) { const int k = kr + 8 * i; v[i] = cp ? *(const f32x4*)(cp + (size_t)(k0 + k) * ld) : (f32x4){0.f, 0.f, 0.f, 0.f}; }
#pragma unroll
        for (int i = 0; i < 8; ++i) { const int k = kr + 8 * i; float m = sc; if (kscale) m *= kscale[k0 + k]; *(LAS f32x4*)(tile + k * 132 + nq * 4) = v[i] * m; }
    }
    __syncthreads();
    {
        const int n = tid >> 1, hf = tid & 1;
        if constexpr (FP8) {
            unsigned char* d8 = (unsigned char*)dst;
#pragma unroll
            for (int c = 0; c < 2; ++c) {
                const int k16 = hf * 32 + c * 16;
                u32x4 o;
                o.x = pk4_fp8(tile[(k16 + 0) * 132 + n] * W8SC, tile[(k16 + 1) * 132 + n] * W8SC, tile[(k16 + 2) * 132 + n] * W8SC, tile[(k16 + 3) * 132 + n] * W8SC);
                o.y = pk4_fp8(tile[(k16 + 4) * 132 + n] * W8SC, tile[(k16 + 5) * 132 + n] * W8SC, tile[(k16 + 6) * 132 + n] * W8SC, tile[(k16 + 7) * 132 + n] * W8SC);
                o.z = pk4_fp8(tile[(k16 + 8) * 132 + n] * W8SC, tile[(k16 + 9) * 132 + n] * W8SC, tile[(k16 + 10) * 132 + n] * W8SC, tile[(k16 + 11) * 132 + n] * W8SC);
                o.w = pk4_fp8(tile[(k16 + 12) * 132 + n] * W8SC, tile[(k16 + 13) * 132 + n] * W8SC, tile[(k16 + 14) * 132 + n] * W8SC, tile[(k16 + 15) * 132 + n] * W8SC);
                *(u32x4*)(d8 + (size_t)(n0 + n) * K + k0 + k16) = o;
            }
        } else
#pragma unroll
        for (int c = 0; c < 4; ++c) {
            const int k8 = hf * 32 + c * 8;
            u32x4 o;
            o.x = pk2(tile[(k8 + 0) * 132 + n], tile[(k8 + 1) * 132 + n]);
            o.y = pk2(tile[(k8 + 2) * 132 + n], tile[(k8 + 3) * 132 + n]);
            o.z = pk2(tile[(k8 + 4) * 132 + n], tile[(k8 + 5) * 132 + n]);
            o.w = pk2(tile[(k8 + 6) * 132 + n], tile[(k8 + 7) * 132 + n]);
            *(u32x4*)(dst + (size_t)(n0 + n) * K + k0 + k8) = o;
        }
    }
    __syncthreads();
}

constexpr int EXP_GU_ITEMS = 65 * 16 * 4, EXP_D_ITEMS = 65 * 4 * 8, EXP_ITEMS = EXP_GU_ITEMS + EXP_D_ITEMS;
__device__ __forceinline__ void expert_convert_item(const Params& p, LAS unsigned char* lds, int l, int it) {
    unsigned char* ws = p.ws;
    if (it < EXP_GU_ITEMS) {
        const int e = it / 64, r = it % 64, kb = r / 4, nb = r % 4;
        const float* gate = e < 64 ? p.w_exp_gate + ((size_t)(l * 64 + e)) * DM * 256 : p.w_sh_gate + (size_t)l * DM * 256;
        const float* up = e < 64 ? p.w_exp_up + ((size_t)(l * 64 + e)) * DM * 256 : p.w_sh_up + (size_t)l * DM * 256;
        transpose_item<true>(lds, DM, (bf16*)(ws + OFF_W_GU + (size_t)e * 512 * DM), kb * 64, nb * 128, 256, 2, gate, up, 512, nullptr);
    } else {
        it -= EXP_GU_ITEMS;
        const int e = it / 32, r = it % 32, kb = r / 8, nb = r % 8;
        const float* dn = e < 64 ? p.w_exp_down + ((size_t)(l * 64 + e)) * 256 * DM : p.w_sh_down + (size_t)l * 256 * DM;
        transpose_item<true>(lds, 256, (bf16*)(ws + OFF_W_D + (size_t)e * DM * 256), kb * 64, nb * 128, DM, 3, dn, nullptr, DM, nullptr);
    }
}

__device__ __forceinline__ void ph_prep(const Params& p, LAS unsigned char* lds) {
    unsigned char* ws = p.ws;
    const int tid = threadIdx.x;
    if (blockIdx.x == 0 && tid < 128) ((int*)(ws + OFF_CNT))[tid] = 0;
    constexpr int I_MOD = 96, I_ROPE = 1024, I_INE = 16 * 19, I_OUTE = 128, I_INO = 16 * 7, I_UQ = 8 * 12, I_UKV = 4 * 16, I_OUTO = 128, I_RT = 32;
    constexpr int NITEMS = I_MOD + I_ROPE + I_INE + I_OUTE + I_INO + I_UQ + I_UKV + I_OUTO + I_RT;
    for (int item = blockIdx.x; item < NITEMS; item += gridDim.x) {
        int it = item;
        if (it < I_MOD) {
            const int l = it / 48, n0 = (it % 48) * 128, kg = tid >> 5, cl = tid & 31;
            LAS float* s = (LAS float*)lds;
            LAS float* red = (LAS float*)(lds + 12288);
            for (int idx = tid; idx < 3072; idx += 256) { const int v = idx >> 10, k = idx & 1023; const float cv = v < 2 ? p.c[v * DM + k] : p.c_ctx[k]; s[idx] = cv / (1.f + expf(-cv)); }
            __syncthreads();
            f32x4 a0 = {0.f, 0.f, 0.f, 0.f}, a1 = a0, a2 = a0;
            const float* w = p.w_mod + (size_t)l * DM * 6144 + (size_t)(kg * 128) * 6144 + n0 + cl * 4;
#pragma unroll 8
            for (int k = 0; k < 128; ++k) { const f32x4 wv = *(const f32x4*)(w + (size_t)k * 6144); const int kk = kg * 128 + k; a0 += wv * s[kk]; a1 += wv * s[1024 + kk]; a2 += wv * s[2048 + kk]; }
            *(LAS f32x4*)(red + (kg * 3 + 0) * 128 + cl * 4) = a0; *(LAS f32x4*)(red + (kg * 3 + 1) * 128 + cl * 4) = a1; *(LAS f32x4*)(red + (kg * 3 + 2) * 128 + cl * 4) = a2;
            __syncthreads();
            for (int idx = tid; idx < 384; idx += 256) { const int v = idx >> 7, n = idx & 127; float acc = 0.f;
#pragma unroll
                for (int g = 0; g < 8; ++g) acc += red[(g * 3 + v) * 128 + n];
                ((float*)(ws + OFF_MOD))[((size_t)l * 3 + v) * 6144 + n0 + n] = acc + p.b_mod[l * 6144 + n0 + n]; }
            __syncthreads();
            continue;
        }
        it -= I_MOD;
        if (it < I_ROPE) {
            const int idx = it * 256 + tid, pos = idx >> 5, i = idx & 31, row = pos >> 6, col = pos & 63, j = i & 15;
            const float invf = powf(10000.f, -(float)(2 * j) / 32.f);
            const float ang = (float)(i < 16 ? row : col) * invf;
            float sn, cs; sincosf(ang, &sn, &cs);
            ((f32x2*)(ws + OFF_ROPE))[idx] = (f32x2){cs, sn};
            continue;
        }
        it -= I_ROPE;
        if (it < I_INE) { const int kb = it / 19, nb = it % 19;
            transpose_item(lds, DM, (bf16*)(ws + OFF_W_IN_E), kb * 64, nb * 128, 2336, 1, p.w_in_e, nullptr, 2336, nullptr); continue; }
        it -= I_INE;
        if (it < I_OUTE) { const int kb = it / 8, nb = it % 8;
            transpose_item(lds, DM, (bf16*)(ws + OFF_W_OUT_E), kb * 64, nb * 128, DM, 0, p.w_out_e, nullptr, DM, nullptr); continue; }
        it -= I_OUTE;
        if (it < I_INO) { const int kb = it / 7, nb = it % 7;
            transpose_item(lds, DM, (bf16*)(ws + OFF_W_IN_O), kb * 64, nb * 128, 832, 0, p.w_in_o, nullptr, 832, nullptr); continue; }
        it -= I_INO;
        if (it < I_UQ) { const int kb = it / 12, nb = it % 12;
            transpose_item(lds, 512, (bf16*)(ws + OFF_W_UQ), kb * 64, nb * 128, 1536, 0, p.w_uq, nullptr, 1536, p.mla_q_norm); continue; }
        it -= I_UQ;
        if (it < I_UKV) { const int kb = it / 16, nb = it % 16;
            transpose_item(lds, 256, (bf16*)(ws + OFF_W_UKV), kb * 64, nb * 128, 2048, 0, p.w_ukv, nullptr, 2048, p.mla_kv_norm); continue; }
        it -= I_UKV;
        if (it < I_OUTO) { const int kb = it / 8, nb = it % 8;
            transpose_item(lds, DM, (bf16*)(ws + OFF_W_OUT_O), kb * 64, nb * 128, DM, 0, p.w_out_o, nullptr, DM, nullptr); continue; }
        it -= I_OUTO;
        { const int l = it / 16, kb = it % 16;
            transpose_item(lds, DM, (bf16*)(ws + OFF_W_RT) + (size_t)l * 128 * DM, kb * 64, 0, 64, 0, p.w_router + (size_t)l * DM * 64, nullptr, 64, nullptr); }
    }
}

__device__ __forceinline__ void load_row(const float* src, int lane, f32x4 (&v)[4]) {
#pragma unroll
    for (int j = 0; j < 4; ++j) v[j] = *(const f32x4*)(src + lane * 4 + 256 * j);
}
__device__ __forceinline__ float row_sumsq(const f32x4 (&v)[4]) {
    float s = 0.f;
#pragma unroll
    for (int j = 0; j < 4; ++j) s += v[j].x * v[j].x + v[j].y * v[j].y + v[j].z * v[j].z + v[j].w * v[j].w;
    return wave_sum(s);
}
__device__ __forceinline__ void modulate_store(const f32x4 (&v)[4], float rinv, const float* g, const float* sh, const float* sc, bf16* dst, int lane) {
#pragma unroll
    for (int j = 0; j < 4; ++j) {
        const int c = lane * 4 + 256 * j;
        const f32x4 gg = *(const f32x4*)(g + c), s1 = *(const f32x4*)(sc + c), s0 = *(const f32x4*)(sh + c);
        const f32x4 o = v[j] * rinv * gg * (s1 + 1.f) + s0;
        u32x2 w; w.x = pk2(o.x, o.y); w.y = pk2(o.z, o.w);
        *(u32x2*)(dst + c) = w;
    }
}
__device__ __forceinline__ const float* hl_src0(const Params& p, int r) { return r < TC ? p.ctx + (size_t)r * DM : p.x + (size_t)(r - TC) * DM; }
__device__ __forceinline__ bf16* hl_buf(const Params& p, int r) { return r < TC ? (bf16*)(p.ws + OFF_HC) + (size_t)r * DM : (bf16*)(p.out + (size_t)(r - TC) * DM); }

__device__ __forceinline__ void ph_modulate0(const Params& p) {
    const int lane = threadIdx.x & 63, gw = blockIdx.x * 4 + (threadIdx.x >> 6), ngw = gridDim.x * 4;
    const float* mod = (const float*)(p.ws + OFF_MOD);
    bf16* U = (bf16*)(p.ws + OFF_U);
    for (int r = gw; r < TT; r += ngw) {
        f32x4 v[4]; load_row(hl_src0(p, r), lane, v);
        const float rinv = rsqrtf(row_sumsq(v) * (1.f / DM) + RMS_EPS);
        const float* mv = mod + (size_t)modvec(r) * 6144;
        modulate_store(v, rinv, p.g_mix_pre, mv, mv + 1024, U + (size_t)r * DM, lane);
    }
}

__device__ __forceinline__ void ph_rowpassA(const Params& p, int l, int row_lo, const float* Y) {
    const int lane = threadIdx.x & 63, gw = blockIdx.x * 4 + (threadIdx.x >> 6), ngw = gridDim.x * 4;
    const float* mod = (const float*)(p.ws + OFF_MOD) + (size_t)l * 3 * 6144;
    bf16* U = (bf16*)(p.ws + OFF_U);
    for (int r = row_lo + gw; r < TT; r += ngw) {
        f32x4 y[4], h[4];
        load_row(Y + (size_t)r * DM, lane, y);
        bf16* hb = hl_buf(p, r);
        if (l == 0) load_row(hl_src0(p, r), lane, h);
        else {
#pragma unroll
            for (int j = 0; j < 4; ++j) { const u32x2 w = *(const u32x2*)(hb + lane * 4 + 256 * j); h[j] = (f32x4){bflo(w.x), bfhi(w.x), bflo(w.y), bfhi(w.y)}; }
        }
        const float rinv = rsqrtf(row_sumsq(y) * (1.f / DM) + RMS_EPS);
        const float* mv = mod + (size_t)modvec(r) * 6144;
#pragma unroll
        for (int j = 0; j < 4; ++j) {
            const int c = lane * 4 + 256 * j;
            const f32x4 gg = *(const f32x4*)(p.g_mix_post + l * DM + c), gt = *(const f32x4*)(mv + 2048 + c);
            h[j] = h[j] + gt * (y[j] * rinv * gg);
            *(u32x2*)(hb + c) = (u32x2){pk2(h[j].x, h[j].y), pk2(h[j].z, h[j].w)};
        }
        const float rinv2 = rsqrtf(row_sumsq(h) * (1.f / DM) + RMS_EPS);
        modulate_store(h, rinv2, p.g_ffn_pre + l * DM, mv + 3072, mv + 4096, U + (size_t)r * DM, lane);
        {
            unsigned char* u8 = p.ws + AM_U8 + (size_t)r * DM;
#pragma unroll
            for (int j = 0; j < 4; ++j) {
                const int c = lane * 4 + 256 * j;
                const f32x4 gg = *(const f32x4*)(p.g_ffn_pre + l * DM + c), s1 = *(const f32x4*)(mv + 4096 + c), s0 = *(const f32x4*)(mv + 3072 + c);
                const f32x4 o = h[j] * rinv2 * gg * (s1 + 1.f) + s0;
                *(unsigned*)(u8 + c) = pk4_fp8(o.x, o.y, o.z, o.w);
            }
        }
    }
}

constexpr int MOE_LDS_OFF = 65536;
__device__ __forceinline__ void moe_tables(const Params& p, LAS unsigned char* lds, int l, int row_lo) {
    LAS int* cnt = (LAS int*)(lds + MOE_LDS_OFF); LAS int* tp = cnt + 80; LAS int* sp = tp + 80;
    const int tid = threadIdx.x;
    if (tid < 64) cnt[tid] = ((const int*)(p.ws + OFF_CNT))[l * 64 + tid];
    if (tid == 64) cnt[64] = TT - row_lo;
    __syncthreads();
    if (tid == 0) {
        int a = 0, s = 0;
        for (int e = 0; e < 65; ++e) { tp[e] = a; sp[e] = s; a += (cnt[e] + 127) >> 7; s += cnt[e]; }
        tp[65] = a;
    }
    __syncthreads();
}

__device__ __forceinline__ void ph_rowpassB(const Params& p, LAS unsigned char* lds, int l, int row_lo) {
    moe_tables(p, lds, l, row_lo);
    LAS int* sp = (LAS int*)(lds + MOE_LDS_OFF) + 160;
    const int lane = threadIdx.x & 63, gw = blockIdx.x * 4 + (threadIdx.x >> 6), ngw = gridDim.x * 4;
    const float* mod = (const float*)(p.ws + OFF_MOD) + (size_t)l * 3 * 6144;
    const unsigned char* YR = p.ws + AM_YR;
    const int* tokslot = (const int*)(p.ws + OFF_TOKSLOT); const float* W8 = (const float*)(p.ws + OFF_W8);
    bf16* U = (bf16*)(p.ws + OFF_U);
    const int c0 = lane * 16;
    for (int r = row_lo + gw; r < TT; r += ngw) {
        int ts = 0; float wv = 0.f;
        if (lane < 8) { ts = tokslot[(size_t)r * 8 + lane]; wv = W8[(size_t)r * 8 + lane]; }
        const int myslot = sp[ts >> 20] + (ts & 0xfffff);
        float f[16];
#pragma unroll
        for (int i = 0; i < 16; ++i) f[i] = 0.f;
#pragma unroll
        for (int k = 0; k < 9; ++k) {
            size_t slot; float wk = 1.f / Y8SC;
            if (k < 8) { slot = (size_t)__shfl(myslot, k); wk = __shfl(wv, k) * (1.f / Y8SC); } else slot = (size_t)TT * 8 + r;
            const u32x4 a = *(const u32x4*)(YR + slot * DM + c0);
            const unsigned aw[4] = {a.x, a.y, a.z, a.w};
#pragma unroll
            for (int q = 0; q < 4; ++q) {
                const f32x2 lo = __builtin_amdgcn_cvt_pk_f32_fp8((int)aw[q], false), hi2 = __builtin_amdgcn_cvt_pk_f32_fp8((int)aw[q], true);
                f[q * 4 + 0] += wk * lo.x; f[q * 4 + 1] += wk * lo.y; f[q * 4 + 2] += wk * hi2.x; f[q * 4 + 3] += wk * hi2.y;
            }
        }
        float ss = 0.f;
#pragma unroll
        for (int i = 0; i < 16; ++i) ss += f[i] * f[i];
        const float rinv = rsqrtf(wave_sum(ss) * (1.f / DM) + RMS_EPS);
        const float* mv = mod + (size_t)modvec(r) * 6144;
        bf16* hb = hl_buf(p, r);
        float h[16];
        {
            const u32x4 ha = *(const u32x4*)(hb + c0), hb2 = *(const u32x4*)(hb + c0 + 8);
            const unsigned hw[8] = {ha.x, ha.y, ha.z, ha.w, hb2.x, hb2.y, hb2.z, hb2.w};
#pragma unroll
            for (int i = 0; i < 8; ++i) { h[2 * i] = bflo(hw[i]); h[2 * i + 1] = bfhi(hw[i]); }
        }
#pragma unroll
        for (int q = 0; q < 4; ++q) {
            const int c = c0 + q * 4;
            const f32x4 gg = *(const f32x4*)(p.g_ffn_post + l * DM + c), gt = *(const f32x4*)(mv + 5120 + c);
            const f32x4 fv = {f[q * 4 + 0], f[q * 4 + 1], f[q * 4 + 2], f[q * 4 + 3]};
            const f32x4 hv = {h[q * 4 + 0], h[q * 4 + 1], h[q * 4 + 2], h[q * 4 + 3]};
            const f32x4 o = hv + gt * (fv * rinv * gg);
            h[q * 4 + 0] = o.x; h[q * 4 + 1] = o.y; h[q * 4 + 2] = o.z; h[q * 4 + 3] = o.w;
        }
        if (l == 1) {
            float* orow = p.out + (size_t)(r - TC) * DM + c0;
#pragma unroll
            for (int q = 0; q < 4; ++q) *(f32x4*)(orow + q * 4) = (f32x4){h[q * 4 + 0], h[q * 4 + 1], h[q * 4 + 2], h[q * 4 + 3]};
        } else {
            *(u32x4*)(hb + c0) = (u32x4){pk2(h[0], h[1]), pk2(h[2], h[3]), pk2(h[4], h[5]), pk2(h[6], h[7])};
            *(u32x4*)(hb + c0 + 8) = (u32x4){pk2(h[8], h[9]), pk2(h[10], h[11]), pk2(h[12], h[13]), pk2(h[14], h[15])};
        }
        if (l == 0) {
            float s2 = 0.f;
#pragma unroll
            for (int i = 0; i < 16; ++i) s2 += h[i] * h[i];
            const float rinv2 = rsqrtf(wave_sum(s2) * (1.f / DM) + RMS_EPS);
            const float* mv1 = mv + 3 * 6144;
#pragma unroll
            for (int hf = 0; hf < 2; ++hf) {
                const int c = c0 + hf * 8;
                const f32x4 g0 = *(const f32x4*)(p.g_mix_pre + DM + c), g1 = *(const f32x4*)(p.g_mix_pre + DM + c + 4);
                const f32x4 sh0 = *(const f32x4*)(mv1 + c), sh1 = *(const f32x4*)(mv1 + c + 4), sc0 = *(const f32x4*)(mv1 + 1024 + c), sc1 = *(const f32x4*)(mv1 + 1024 + c + 4);
                const f32x4 h0 = {h[hf * 8 + 0], h[hf * 8 + 1], h[hf * 8 + 2], h[hf * 8 + 3]}, h1 = {h[hf * 8 + 4], h[hf * 8 + 5], h[hf * 8 + 6], h[hf * 8 + 7]};
                const f32x4 o0 = h0 * rinv2 * g0 * (sc0 + 1.f) + sh0, o1 = h1 * rinv2 * g1 * (sc1 + 1.f) + sh1;
                *(u32x4*)(U + (size_t)r * DM + c) = (u32x4){pk2(o0.x, o0.y), pk2(o0.z, o0.w), pk2(o1.x, o1.y), pk2(o1.z, o1.w)};
            }
        }
    }
}

__device__ __forceinline__ int stg_col() { const int tid = threadIdx.x; return ((tid & 7) ^ ((tid >> 3) & 7)) * 8; }
__device__ __forceinline__ void plain_ptrs(const bf16* base, int row0, int ld, const bf16* (&pp)[4]) {
    const int tid = threadIdx.x;
    pp[0] = base + (size_t)(row0 + (tid >> 3)) * ld + stg_col();
#pragma unroll
    for (int i = 1; i < 4; ++i) pp[i] = pp[0] + (size_t)(32 * i) * ld;
}

__device__ __forceinline__ void ph_inproj0(const Params& p, LAS unsigned char* lds) {
    unsigned char* ws = p.ws;
    const bf16* U = (const bf16*)(ws + OFF_U); const bf16* W = (const bf16*)(ws + OFF_W_IN_E);
    bf16* Z0 = (bf16*)(ws + A0_Z0); bf16* VGT = (bf16*)(ws + A0_VGT); bf16* QS = (bf16*)(ws + A0_QS); bf16* KS = (bf16*)(ws + A0_KS); bf16* VST = (bf16*)(ws + A0_VST);
    const f32x2* rope = (const f32x2*)(ws + OFF_ROPE);
    const int tid = threadIdx.x, lane = tid & 63, wid = tid >> 6, wr = wid >> 1, wc = wid & 1, fr = lane & 15, fq = lane >> 4;
    constexpr int NTN = 19, NTM = TT / 128;
    auto make = [&](int t, GPtrs& g, int& nk) { int tm, tn; tile_mn(t, NTM, NTN, tm, tn); plain_ptrs(U, tm * 128, DM, g.a); plain_ptrs(W, tn * 128, DM, g.b); nk = DM / 64; };
    auto epi = [&](int t, f32x4 (&acc)[4][4]) {
        int tm, tn; tile_mn(t, NTM, NTN, tm, tn); const int brow = tm * 128, bcol = tn * 128;
        const int cb = bcol + wc * 64;
        LAS unsigned char* wl = lds + 32768 + wid * 8192;
        const int r0 = brow + wr * 64;
        const RowInfo ri0 = rowinfo(r0);
        if (cb < 1024) {
            epi_store_rows(wl, acc, fr, fq, lane, [&](int row) { return Z0 + (size_t)(r0 + row) * Z0P + cb; });
        } else if (cb < 1536) {
            const int c0 = cb - 1024;
            epi_store_cols(wl, acc, fr, fq, lane, [&](int col) { return VGT + (size_t)(c0 + col) * TT + r0; });
        } else if (cb < 2176) {
            const float sc = cb < 2048 ? 0.125f * LOG2E : 1.f;
#pragma unroll
            for (int m = 0; m < 4; ++m) {
                const int pos = ri0.pos + m * 16 + fr;
#pragma unroll
                for (int n = 0; n < 2; ++n)
#pragma unroll
                    for (int j = 0; j < 4; ++j) {
                        const float x1 = acc[m][n][j] * sc, x2 = acc[m][n + 2][j] * sc;
                        if (ri0.lat) { const f32x2 cs = rope[(size_t)pos * 32 + n * 16 + fq * 4 + j]; acc[m][n][j] = x1 * cs.x - x2 * cs.y; acc[m][n + 2][j] = x2 * cs.x + x1 * cs.y; }
                        else { acc[m][n][j] = x1; acc[m][n + 2][j] = x2; }
                    }
                asm volatile("" ::: "memory");
            }
            bf16* dst;
            if (cb < 2048) { const int h = (cb - 1536) >> 6; dst = QS + ((size_t)(ri0.b * 8 + h) * NKEY + ri0.kq) * 64; }
            else { const int h = (cb - 2048) >> 6; dst = KS + ((size_t)(ri0.b * 2 + h) * NKEY + ri0.kq) * 64; }
            epi_store_rows(wl, acc, fr, fq, lane, [&](int row) { return dst + (size_t)row * 64; });
        } else if (cb < 2304) {
            const int h = (cb - 2176) >> 6;
            bf16* dst = VST + (size_t)(ri0.b * 2 + h) * 64 * NKEY + ri0.kq;
            epi_store_cols(wl, acc, fr, fq, lane, [&](int col) { return dst + (size_t)col * NKEY; });
        } else if (cb == 2304) {
#pragma unroll
            for (int m = 0; m < 4; ++m) {
                const int r = r0 + m * 16 + fr;
#pragma unroll
                for (int n = 0; n < 2; ++n) { u32x2 w; w.x = pk2(acc[m][n][0], acc[m][n][1]); w.y = pk2(acc[m][n][2], acc[m][n][3]); *(u32x2*)(Z0 + (size_t)r * Z0P + 1024 + n * 16 + fq * 4) = w; }
            }
        }
    };
    gemm_tiles<true>(lds, vcu_id(), NTM * NTN, gridDim.x, make, epi);
}

__device__ __forceinline__ void ph_outproj(const Params& p, LAS unsigned char* lds, const bf16* MIX, const bf16* W, float* Y, int row_lo) {
    const int tid = threadIdx.x, lane = tid & 63, wid = tid >> 6, wr = wid >> 1, wc = wid & 1, fr = lane & 15, fq = lane >> 4;
    const int tm0 = row_lo / 128, ntm = TT / 128 - tm0;
    auto make = [&](int t, GPtrs& g, int& nk) { int tm, tn; tile_mn(t, ntm, 8, tm, tn); plain_ptrs(MIX, (tm0 + tm) * 128, DM, g.a); plain_ptrs(W, tn * 128, DM, g.b); nk = DM / 64; };
    auto epi = [&](int t, f32x4 (&acc)[4][4]) {
        int tm, tn; tile_mn(t, ntm, 8, tm, tn); tm += tm0; const int brow = tm * 128, bcol = tn * 128;
#pragma unroll
        for (int m = 0; m < 4; ++m) {
            const int r = brow + wr * 64 + m * 16 + fr;
#pragma unroll
            for (int n = 0; n < 4; ++n) *(f32x4*)(Y + (size_t)r * DM + bcol + wc * 64 + n * 16 + fq * 4) = acc[m][n];
        }
    };
    gemm_tiles<true, 16>(lds, vcu_id(), ntm * 8, gridDim.x, make, epi);
}

template <int DQK, int DV>
__device__ __forceinline__ void attn_item(LAS unsigned char* lds, const bf16* Qg, const bf16* Kg, const bf16* VTg, int a1, int b0, int b1, int qpos0,
                                          float m_init, float l_init, bf16* Og, int o_pitch) {
    constexpr int KPB = DQK * 2, NS = DQK / 16, NDV = DV / 32, KCH = DQK / 8, KBYTES = 32 * KPB, VBYTES = DV * 64, KN = 32 * KCH / 256, VN = DV * 4 / 256;
    static_assert((KN == 3 && VN == 2) || (KN == 1 && VN == 1), "piece counts");
    const int tid = threadIdx.x, lane = tid & 63, wid = tid >> 6, ql = lane & 31, hi = lane >> 5;
    LAS unsigned char* Kb0 = lds; LAS unsigned char* Vb0 = lds + 2 * KBYTES;
    asm volatile("s_waitcnt vmcnt(0) lgkmcnt(0)" ::: "memory");
    __builtin_amdgcn_s_barrier();
    asm volatile("" ::: "memory");
    bf16x8 qf[NS];
    {
        const bf16* qrow = Qg + (size_t)(wid * 32 + ql) * DQK + hi * 8;
#pragma unroll
        for (int s = 0; s < NS; ++s) qf[s] = *(const bf16x8*)(qrow + s * 16);
    }
    unsigned koff[KN], voff[VN];
#pragma unroll
    for (int i = 0; i < KN; ++i) { const int pz = tid + 256 * i, key = pz / KCH, ch = pz % KCH; koff[i] = (unsigned)(key * DQK + (((ch & ~7) | ((ch & 7) ^ ((key >> 1) & 7))) * 8)); }
#pragma unroll
    for (int i = 0; i < VN; ++i) { const int pz = tid + 256 * i, dv = pz >> 2, ch = pz & 3; voff[i] = (unsigned)(dv * NKEY + ((ch ^ ((dv >> 2) & 3)) * 8)); }
    const int ntot = a1 + (b1 - b0);
#define ATTN_KT(it_) ((it_) < a1 ? (it_) : b0 + ((it_) - a1))
#define ATTN_DMA_K(IT_) do { const int kt_ = ATTN_KT(IT_); _Pragma("unroll") for (int i_ = 0; i_ < KN; ++i_) glds16(Kg + (size_t)kt_ * 32 * DQK + koff[i_], Kb0 + ((IT_) & 1) * KBYTES + (tid + 256 * i_) * 16); } while (0)
#define ATTN_DMA_V(IT_) do { const int kt_ = ATTN_KT(IT_); _Pragma("unroll") for (int i_ = 0; i_ < VN; ++i_) glds16(VTg + (size_t)kt_ * 32 + voff[i_], Vb0 + ((IT_) & 1) * VBYTES + (tid + 256 * i_) * 16); } while (0)
    f32x16 o[NDV];
#pragma unroll
    for (int d = 0; d < NDV; ++d)
#pragma unroll
        for (int r = 0; r < 16; ++r) o[d][r] = 0.f;
    float mrun = m_init, lrun = l_init;
    const int swk = (ql >> 1) & 7, swv = (ql >> 2) & 3;
    const LAS unsigned char* kfrag = Kb0 + ql * KPB; const LAS unsigned char* vfrag = Vb0 + ql * 64;
#define ATTN_QK(P_, IT_) do { \
        _Pragma("unroll") for (int r_ = 0; r_ < 16; ++r_) P_[r_] = 0.f; \
        const LAS unsigned char* kc_ = kfrag + ((IT_) & 1) * KBYTES; \
        _Pragma("unroll") for (int s_ = 0; s_ < NS; ++s_) { \
            const int c_ = 2 * s_ + hi; \
            const bf16x8 k0_ = *(const LAS bf16x8*)(kc_ + ((c_ & ~7) | ((c_ & 7) ^ swk)) * 16); \
            P_ = __builtin_amdgcn_mfma_f32_32x32x16_bf16(k0_, qf[s_], P_, 0, 0, 0); } \
        if ((IT_) >= a1) { const int kbase_ = ATTN_KT(IT_) * 32 - CTX, qpos_ = qpos0 + wid * 32 + ql; \
            _Pragma("unroll") for (int r_ = 0; r_ < 16; ++r_) { const int d0_ = qpos_ - (kbase_ + crow(r_, hi)); if (d0_ > 128 || d0_ < -128) P_[r_] = -1e30f; } } } while (0)
#define ATTN_PK4(P, BASE, OUT) do { const unsigned a0_ = pk2(P[BASE + 0], P[BASE + 1]), a1_ = pk2(P[BASE + 2], P[BASE + 3]), b0_ = pk2(P[BASE + 4], P[BASE + 5]), b1_ = pk2(P[BASE + 6], P[BASE + 7]); \
        const auto r0_ = __builtin_amdgcn_permlane32_swap(a0_, b0_, false, false); const auto r1_ = __builtin_amdgcn_permlane32_swap(a1_, b1_, false, false); \
        OUT = mk8((u32x4){r0_[0], r1_[0], r0_[1], r1_[1]}); } while (0)
#define ATTN_STEP(C_, N_, IT_) do { \
          \
          \
        asm volatile("s_waitcnt vmcnt(0) lgkmcnt(0)" ::: "memory"); __builtin_amdgcn_s_barrier(); asm volatile("" ::: "memory"); \
        if ((IT_) + 2 < ntot) ATTN_DMA_K((IT_) + 2); \
        if ((IT_) + 1 < ntot) ATTN_DMA_V((IT_) + 1); \
        if ((IT_) + 1 < ntot) ATTN_QK(N_, (IT_) + 1); \
        float mx_ = C_[0]; \
        _Pragma("unroll") for (int r_ = 1; r_ < 16; ++r_) mx_ = fmaxf(mx_, C_[r_]); \
        mx_ = fmaxf(mx_, __shfl_xor(mx_, 32)); \
        if (__any(mx_ > mrun + 8.f)) { const float mn_ = fmaxf(mrun, mx_), alpha_ = ex2(mrun - mn_); mrun = mn_; lrun *= alpha_; \
            _Pragma("unroll") for (int d_ = 0; d_ < NDV; ++d_) _Pragma("unroll") for (int r_ = 0; r_ < 16; ++r_) o[d_][r_] *= alpha_; } \
        float rs_ = 0.f; \
        _Pragma("unroll") for (int r_ = 0; r_ < 16; ++r_) { C_[r_] = ex2(C_[r_] - mrun); rs_ += C_[r_]; } \
        rs_ += __shfl_xor(rs_, 32); lrun += rs_; \
        bf16x8 pf_[2]; \
        ATTN_PK4(C_, 0, pf_[0]); ATTN_PK4(C_, 8, pf_[1]); \
        const LAS unsigned char* vc_ = vfrag + ((IT_) & 1) * VBYTES; \
        _Pragma("unroll") for (int d_ = 0; d_ < NDV; ++d_) { _Pragma("unroll") for (int kk_ = 0; kk_ < 2; ++kk_) { \
            const bf16x8 vf_ = *(const LAS bf16x8*)(vc_ + d_ * 32 * 64 + (((2 * kk_ + hi) ^ swv) * 16)); \
            o[d_] = __builtin_amdgcn_mfma_f32_32x32x16_bf16(vf_, pf_[kk_], o[d_], 0, 0, 0); } } } while (0)
    ATTN_DMA_K(0); ATTN_DMA_V(0);
    asm volatile("s_waitcnt vmcnt(0) lgkmcnt(0)" ::: "memory"); __builtin_amdgcn_s_barrier(); asm volatile("" ::: "memory");
    if (ntot > 1) ATTN_DMA_K(1);
    f32x16 pA, pB;
    ATTN_QK(pA, 0);
    int it = 0;
    for (; it + 1 < ntot; it += 2) {
        ATTN_STEP(pA, pB, it);
        ATTN_STEP(pB, pA, it + 1);
    }
    if (it < ntot) ATTN_STEP(pA, pB, it);
#undef ATTN_STEP
#undef ATTN_PK4
#undef ATTN_QK
#undef ATTN_KT
#undef ATTN_DMA_K
#undef ATTN_DMA_V
    const float inv = 1.f / lrun;
    bf16* orow = Og + (size_t)(wid * 32 + ql) * o_pitch;
#pragma unroll
    for (int d = 0; d < NDV; ++d)
#pragma unroll
        for (int g = 0; g < 4; ++g) {
            u32x2 w; w.x = pk2(o[d][g * 4 + 0] * inv, o[d][g * 4 + 1] * inv); w.y = pk2(o[d][g * 4 + 2] * inv, o[d][g * 4 + 3] * inv);
            *(u32x2*)(orow + d * 32 + 8 * g + 4 * hi) = w;
        }
}

constexpr int GA_CUM = 0, GA_ALOW = 16384, GA_WA = 20480, GA_BA = 24576, GA_QT = 24832, GA_TOT = 25856, GA_END = 26112;
__device__ __forceinline__ void gla_cum(const Params& p, LAS unsigned char* lds, const bf16* Z0, int r0, int h, int dir) {
    const int tid = threadIdx.x;
    LAS float* cum = (LAS float*)(lds + GA_CUM); LAS float* alow = (LAS float*)(lds + GA_ALOW); LAS float* wa = (LAS float*)(lds + GA_WA);
    LAS float* ba = (LAS float*)(lds + GA_BA); LAS float* qt = (LAS float*)(lds + GA_QT); LAS float* tot = (LAS float*)(lds + GA_TOT);
    {
        const int t = tid >> 2, i4 = (tid & 3) * 4;
        const u32x2 w = *(const u32x2*)(Z0 + (size_t)(r0 + t) * Z0P + 1024 + dir * 16 + i4);
        alow[t * 16 + i4 + 0] = bflo(w.x); alow[t * 16 + i4 + 1] = bfhi(w.x); alow[t * 16 + i4 + 2] = bflo(w.y); alow[t * 16 + i4 + 3] = bfhi(w.y);
#pragma unroll
        for (int q = 0; q < 4; ++q) { const int idx = tid * 4 + q, i = idx >> 6, j = idx & 63; wa[idx] = p.gla_wa2[(size_t)(dir * 16 + i) * 256 + h * 64 + j]; }
        if (tid < 64) ba[tid] = p.gla_ba[dir * 256 + h * 64 + tid];
    }
    __syncthreads();
    const int j = tid & 63, tq = tid >> 6;
    float la[16], wj[16];
#pragma unroll
    for (int i = 0; i < 16; ++i) wj[i] = wa[i * 64 + j];
    const float bj = ba[j];
#pragma unroll
    for (int tt = 0; tt < 16; ++tt) {
        const int t = tq * 16 + tt;
        float x = bj;
#pragma unroll
        for (int q = 0; q < 4; ++q) { const f32x4 a = *(const LAS f32x4*)(alow + t * 16 + q * 4);
            x += a.x * wj[q * 4] + a.y * wj[q * 4 + 1] + a.z * wj[q * 4 + 2] + a.w * wj[q * 4 + 3]; }
        la[tt] = (fminf(x, 0.f) - __logf(1.f + __expf(-fabsf(x)))) * (1.f / 16.f);
    }
    float run = 0.f;
    if (dir == 0) {
#pragma unroll
        for (int tt = 0; tt < 16; ++tt) { run += la[tt]; cum[(tq * 16 + tt) * 64 + j] = run; }
    } else {
#pragma unroll
        for (int tt = 15; tt >= 0; --tt) { run += la[tt]; cum[(tq * 16 + tt) * 64 + j] = run; }
    }
    qt[tq * 64 + j] = run;
    __syncthreads();
    float off = 0.f, total = 0.f;
#pragma unroll
    for (int q = 0; q < 4; ++q) { const float v = qt[q * 64 + j]; total += v; if (dir == 0 ? (q < tq) : (q > tq)) off += v; }
#pragma unroll
    for (int tt = 0; tt < 16; ++tt) cum[(tq * 16 + tt) * 64 + j] += off;
    if (tq == 0) tot[j] = total;
    __syncthreads();
}

__device__ __forceinline__ int gla_row0(int b, int cc) { return cc < 4 ? b * CTX + cc * 64 : TC + b * SEQ + (cc - 4) * 64; }
__device__ __forceinline__ int gla_step(int cc, int dir) { return dir == 0 ? cc : (cc < 4 ? 3 - cc : 4 + (131 - cc)); }

__device__ __forceinline__ void gla_g1_item(const Params& p, LAS unsigned char* lds, int item) {
    unsigned char* ws = p.ws;
    const bf16* Z0 = (const bf16*)(ws + A0_Z0); const bf16* VGT = (const bf16*)(ws + A0_VGT);
    bf16* GS = (bf16*)(ws + A0_GS); float* GD = (float*)(ws + A0_GD);
    const int cc = item % NSTEP, rest = item / NSTEP, dir = rest & 1, h = (rest >> 1) & 3, b = rest >> 3;
    const int r0 = gla_row0(b, cc), step = gla_step(cc, dir), chain = (b * 4 + h) * 2 + dir;
    const int tid = threadIdx.x, lane = tid & 63, wid = tid >> 6, fr = lane & 15, fq = lane >> 4;
    __syncthreads();
    gla_cum(p, lds, Z0, r0, h, dir);
    LAS float* cum = (LAS float*)(lds + GA_CUM); LAS float* tot = (LAS float*)(lds + GA_TOT);
    LAS bf16* KT = (LAS bf16*)(lds + GA_END);
    {
        const int t = tid >> 2, d0 = (tid & 3) * 16;
        const u32x4 w0 = *(const u32x4*)(Z0 + (size_t)(r0 + t) * Z0P + 256 + h * 64 + d0), w1 = *(const u32x4*)(Z0 + (size_t)(r0 + t) * Z0P + 256 + h * 64 + d0 + 8);
        const unsigned ww[8] = {w0.x, w0.y, w0.z, w0.w, w1.x, w1.y, w1.z, w1.w};
#pragma unroll
        for (int i = 0; i < 8; ++i) {
            const int d = d0 + 2 * i;
            KT[d * 72 + t] = f2bf(bflo(ww[i]) * __expf(tot[d] - cum[t * 64 + d]));
            KT[(d + 1) * 72 + t] = f2bf(bfhi(ww[i]) * __expf(tot[d + 1] - cum[t * 64 + d + 1]));
        }
    }
    if (tid < 64) GD[((size_t)chain * NSTEP + step) * 64 + tid] = __expf(tot[tid]);
    __syncthreads();
    f32x4 acc[2][4];
#pragma unroll
    for (int m = 0; m < 2; ++m)
#pragma unroll
        for (int n = 0; n < 4; ++n) acc[m][n] = (f32x4){0.f, 0.f, 0.f, 0.f};
#pragma unroll
    for (int ks = 0; ks < 2; ++ks) {
        bf16x8 af[2], bfr[4];
#pragma unroll
        for (int m = 0; m < 2; ++m) af[m] = *(const bf16x8*)(VGT + (size_t)(h * 128 + wid * 32 + m * 16 + fr) * TT + r0 + ks * 32 + fq * 8);
#pragma unroll
        for (int n = 0; n < 4; ++n) bfr[n] = *(const LAS bf16x8*)(KT + (n * 16 + fr) * 72 + ks * 32 + fq * 8);
#pragma unroll
        for (int m = 0; m < 2; ++m)
#pragma unroll
            for (int n = 0; n < 4; ++n) acc[m][n] = __builtin_amdgcn_mfma_f32_16x16x32_bf16(bfr[n], af[m], acc[m][n], 0, 0, 0);
    }
    bf16* dst = GS + ((size_t)chain * NSTEP + step) * 8192;
#pragma unroll
    for (int m = 0; m < 2; ++m)
#pragma unroll
        for (int n = 0; n < 4; ++n) *(u32x2*)(dst + (size_t)(wid * 32 + m * 16 + fr) * 64 + n * 16 + fq * 4) = (u32x2){pk2(acc[m][n][0], acc[m][n][1]), pk2(acc[m][n][2], acc[m][n][3])};
}

__device__ __forceinline__ void ph_gla_scan(const Params& p) {
    unsigned* GS = (unsigned*)(p.ws + A0_GS); const float* GD = (const float*)(p.ws + A0_GD);
    for (int idx = blockIdx.x * 256 + threadIdx.x; idx < 16 * 4096; idx += gridDim.x * 256) {
        const int chain = idx >> 12, e2 = idx & 4095, dk = (e2 & 31) * 2;
        unsigned* g = GS + (size_t)chain * NSTEP * 4096 + e2;
        const f32x2* d = (const f32x2*)(GD + (size_t)chain * NSTEP * 64 + dk);
        float s0 = 0.f, s1 = 0.f;
#pragma unroll 12
        for (int s = 0; s < NSTEP; ++s) {
            const unsigned t = g[(size_t)s * 4096]; const f32x2 dec = d[s * 32];
            g[(size_t)s * 4096] = pk2(s0, s1);
            s0 = dec.x * s0 + bflo(t); s1 = dec.y * s1 + bfhi(t);
        }
    }
}

__device__ __forceinline__ void gla_g3_item(const Params& p, LAS unsigned char* lds, int item) {
    unsigned char* ws = p.ws;
    const bf16* Z0 = (const bf16*)(ws + A0_Z0); const bf16* VGT = (const bf16*)(ws + A0_VGT);
    const bf16* GS = (const bf16*)(ws + A0_GS); bf16* MIX = (bf16*)(ws + A0_MIX);
    const int cc = item % NSTEP, rest = item / NSTEP, h = rest & 3, b = rest >> 2;
    const int r0 = gla_row0(b, cc);
    const int tid = threadIdx.x, lane = tid & 63, wid = tid >> 6, fr = lane & 15, fq = lane >> 4;
    LAS bf16* QT = (LAS bf16*)(lds + GA_END);
    LAS bf16* QI = (LAS bf16*)(lds + GA_END + 9216);
    LAS bf16* KT = (LAS bf16*)(lds + GA_END + 18432);
    LAS bf16* PP = (LAS bf16*)(lds);
    f32x4 o[4][2];
#pragma unroll
    for (int m = 0; m < 4; ++m)
#pragma unroll
        for (int n = 0; n < 2; ++n) o[m][n] = (f32x4){0.f, 0.f, 0.f, 0.f};
    for (int dir = 0; dir < 2; ++dir) {
        const int step = gla_step(cc, dir), chain = (b * 4 + h) * 2 + dir;
        __syncthreads();
        gla_cum(p, lds, Z0, r0, h, dir);
        LAS float* cum = (LAS float*)(lds + GA_CUM); LAS float* tot = (LAS float*)(lds + GA_TOT);
        {
            const int t = tid >> 2, d0 = (tid & 3) * 16;
            const bf16* zr = Z0 + (size_t)(r0 + t) * Z0P + h * 64 + d0;
            const u32x4 q0 = *(const u32x4*)(zr), q1 = *(const u32x4*)(zr + 8), k0 = *(const u32x4*)(zr + 256), k1 = *(const u32x4*)(zr + 264);
            const unsigned qq[8] = {q0.x, q0.y, q0.z, q0.w, q1.x, q1.y, q1.z, q1.w}, kk[8] = {k0.x, k0.y, k0.z, k0.w, k1.x, k1.y, k1.z, k1.w};
            unsigned oqt[8], oqi[8], okt[8];
#pragma unroll
            for (int i = 0; i < 8; ++i) {
                const int d = d0 + 2 * i;
                const float c0 = cum[t * 64 + d], c1 = cum[t * 64 + d + 1], t0 = tot[d], t1 = tot[d + 1];
                const float qa = bflo(qq[i]), qb = bfhi(qq[i]), ka = bflo(kk[i]), kb = bfhi(kk[i]);
                oqt[i] = pk2(qa * __expf(c0 - t0), qb * __expf(c1 - t1));
                oqi[i] = pk2(qa * __expf(c0), qb * __expf(c1));
                okt[i] = pk2(ka * __expf(t0 - c0), kb * __expf(t1 - c1));
            }
            *(LAS u32x4*)(QT + t * 72 + d0) = (u32x4){oqt[0], oqt[1], oqt[2], oqt[3]}; *(LAS u32x4*)(QT + t * 72 + d0 + 8) = (u32x4){oqt[4], oqt[5], oqt[6], oqt[7]};
            *(LAS u32x4*)(QI + t * 72 + d0) = (u32x4){oqi[0], oqi[1], oqi[2], oqi[3]}; *(LAS u32x4*)(QI + t * 72 + d0 + 8) = (u32x4){oqi[4], oqi[5], oqi[6], oqi[7]};
            *(LAS u32x4*)(KT + t * 72 + d0) = (u32x4){okt[0], okt[1], okt[2], okt[3]}; *(LAS u32x4*)(KT + t * 72 + d0 + 8) = (u32x4){okt[4], okt[5], okt[6], okt[7]};
        }
        __syncthreads();
        {
            f32x4 sa[4];
#pragma unroll
            for (int m = 0; m < 4; ++m) sa[m] = (f32x4){0.f, 0.f, 0.f, 0.f};
#pragma unroll
            for (int ks = 0; ks < 2; ++ks) {
                const bf16x8 kf = *(const LAS bf16x8*)(KT + (wid * 16 + fr) * 72 + ks * 32 + fq * 8);
#pragma unroll
                for (int m = 0; m < 4; ++m) {
                    const bf16x8 qfm = *(const LAS bf16x8*)(QT + (m * 16 + fr) * 72 + ks * 32 + fq * 8);
                    sa[m] = __builtin_amdgcn_mfma_f32_16x16x32_bf16(kf, qfm, sa[m], 0, 0, 0);
                }
            }
#pragma unroll
            for (int m = 0; m < 4; ++m) {
                const int t = m * 16 + fr;
                float v[4];
#pragma unroll
                for (int jj = 0; jj < 4; ++jj) { const int j = wid * 16 + fq * 4 + jj; const bool keep = dir == 0 ? (j <= t) : (j >= t); v[jj] = keep ? sa[m][jj] : 0.f; }
                *(LAS u32x2*)(PP + t * 72 + wid * 16 + fq * 4) = (u32x2){pk2(v[0], v[1]), pk2(v[2], v[3])};
            }
        }
        __syncthreads();
        const bf16* Sg = GS + ((size_t)chain * NSTEP + step) * 8192;
#pragma unroll
        for (int ks = 0; ks < 2; ++ks) {
            bf16x8 vfr[2], sfr[2];
#pragma unroll
            for (int n = 0; n < 2; ++n) {
                const int dv = wid * 32 + n * 16 + fr;
                vfr[n] = *(const bf16x8*)(VGT + (size_t)(h * 128 + dv) * TT + r0 + ks * 32 + fq * 8);
                sfr[n] = *(const bf16x8*)(Sg + (size_t)dv * 64 + ks * 32 + fq * 8);
            }
#pragma unroll
            for (int m = 0; m < 4; ++m) {
                const bf16x8 pfm = *(const LAS bf16x8*)(PP + (m * 16 + fr) * 72 + ks * 32 + fq * 8);
                const bf16x8 qim = *(const LAS bf16x8*)(QI + (m * 16 + fr) * 72 + ks * 32 + fq * 8);
#pragma unroll
                for (int n = 0; n < 2; ++n) {
                    o[m][n] = __builtin_amdgcn_mfma_f32_16x16x32_bf16(vfr[n], pfm, o[m][n], 0, 0, 0);
                    o[m][n] = __builtin_amdgcn_mfma_f32_16x16x32_bf16(sfr[n], qim, o[m][n], 0, 0, 0);
                }
            }
        }
    }
    __syncthreads();
    LAS float* red = (LAS float*)(lds + GA_END + 27648);
#pragma unroll
    for (int m = 0; m < 4; ++m) {
        float s = 0.f;
#pragma unroll
        for (int n = 0; n < 2; ++n)
#pragma unroll
            for (int j = 0; j < 4; ++j) s += o[m][n][j] * o[m][n][j];
        s += __shfl_xor(s, 16); s += __shfl_xor(s, 32);
        if (fq == 0) red[wid * 64 + m * 16 + fr] = s;
    }
    __syncthreads();
#pragma unroll
    for (int m = 0; m < 4; ++m) {
        const int t = m * 16 + fr;
        const float ss = red[t] + red[64 + t] + red[128 + t] + red[192 + t];
        const float rinv = rsqrtf(ss * (1.f / 128.f) + RMS_EPS);
        const int r = r0 + t;
#pragma unroll
        for (int n = 0; n < 2; ++n) {
            const int dv = wid * 32 + n * 16 + fq * 4;
            const u32x2 gw = *(const u32x2*)(Z0 + (size_t)r * Z0P + 512 + h * 128 + dv);
            const f32x4 ng = *(const f32x4*)(p.gla_norm + dv);
            const float g0 = bflo(gw.x), g1 = bfhi(gw.x), g2 = bflo(gw.y), g3 = bfhi(gw.y);
            const float y0 = o[m][n][0] * rinv * ng.x * siluf(g0), y1 = o[m][n][1] * rinv * ng.y * siluf(g1);
            const float y2 = o[m][n][2] * rinv * ng.z * siluf(g2), y3 = o[m][n][3] * rinv * ng.w * siluf(g3);
            *(u32x2*)(MIX + (size_t)r * DM + h * 128 + dv) = (u32x2){pk2(y0, y1), pk2(y2, y3)};
        }
    }
}

__device__ __forceinline__ void ph_swa_g1(const Params& p, LAS unsigned char* lds) {
    unsigned char* ws = p.ws;
    const bf16* QS = (const bf16*)(ws + A0_QS); const bf16* KS = (const bf16*)(ws + A0_KS); const bf16* VST = (const bf16*)(ws + A0_VST); bf16* MIX = (bf16*)(ws + A0_MIX);
    constexpr int N_SWA = 2 * 8 * 66, N_G1 = 2 * 4 * 2 * NSTEP;
    for (int item = blockIdx.x; item < N_SWA + N_G1; item += gridDim.x) {
        if (item < N_SWA) {
            const int qt = item % 66, rest = item / 66, h = rest & 7, b = rest >> 3, kvh = h >> 2;
            const bf16* Qg = QS + ((size_t)(b * 8 + h) * NKEY + qt * 128) * 64;
            const bf16* Kg = KS + (size_t)(b * 2 + kvh) * NKEY * 64;
            const bf16* Vg = VST + (size_t)(b * 2 + kvh) * 64 * NKEY;
            int b0 = 0, b1 = 0, qpos0 = 0, row0;
            if (qt >= 2) { qpos0 = (qt - 2) * 128; const int lo = qpos0 - 128 < 0 ? 0 : qpos0 - 128, hi2 = qpos0 + 256 > SEQ ? SEQ : qpos0 + 256; b0 = 8 + lo / 32; b1 = 8 + hi2 / 32; row0 = TC + b * SEQ + qpos0; }
            else row0 = b * CTX + qt * 128;
            const float sink = p.swa_sink[h] * LOG2E;
            attn_item<64, 64>(lds, Qg, Kg, Vg, 8, b0, b1, qpos0, sink, 1.f, MIX + (size_t)row0 * DM + 512 + h * 64, DM);
        } else gla_g1_item(p, lds, item - N_SWA);
    }
}
__device__ __forceinline__ void ph_gla_g3(const Params& p, LAS unsigned char* lds) {
    for (int item = blockIdx.x; item < 2 * 4 * NSTEP; item += gridDim.x) gla_g3_item(p, lds, item);
}

__device__ __forceinline__ void ph_router(const Params& p, LAS unsigned char* lds, int l, int row_lo) {
    unsigned char* ws = p.ws;
    const bf16* U = (const bf16*)(ws + OFF_U); const bf16* W = (const bf16*)(ws + OFF_W_RT) + (size_t)l * 128 * DM;
    int* cntg = (int*)(ws + OFF_CNT) + l * 64; int* tokslot = (int*)(ws + OFF_TOKSLOT); float* W8 = (float*)(ws + OFF_W8); int* LIST = (int*)(ws + OFF_LIST);
    const int tid = threadIdx.x, lane = tid & 63, wid = tid >> 6, wr = wid >> 1, wc = wid & 1, fr = lane & 15, fq = lane >> 4;
    LAS float* lg = (LAS float*)lds;
    const int tm0 = row_lo / 128;
    auto make = [&](int tm, GPtrs& g, int& nk) { plain_ptrs(U, tm * 128, DM, g.a); plain_ptrs(W, 0, DM, g.b); nk = DM / 64; };
    auto epi = [&](int tm, f32x4 (&acc)[4][4]) {
        const int brow = tm * 128;
        if (wc == 0) {
#pragma unroll
            for (int m = 0; m < 4; ++m)
#pragma unroll
                for (int n = 0; n < 4; ++n)
#pragma unroll
                    for (int j = 0; j < 4; ++j) lg[(wr * 64 + m * 16 + fr) * 65 + n * 16 + fq * 4 + j] = acc[m][n][j];
        }
        __syncthreads();
        LAS float* biasl = (LAS float*)(lds + 34816); LAS int* hist = (LAS int*)(lds + 34816 + 256); LAS int* basel = (LAS int*)(lds + 34816 + 512);
        if (tid < 64) { biasl[tid] = p.b_router[l * 64 + tid]; hist[tid] = 0; }
        __syncthreads();
        int esel[8], lrank[8]; float ssel[8]; float wsum = 0.f;
        if (tid < 128) {
            LAS float* L = lg + tid * 65;
            float gs[8];
#pragma unroll
            for (int g = 0; g < 8; ++g) {
                float m1 = -INFINITY, m2 = -INFINITY;
#pragma unroll
                for (int j = 0; j < 8; ++j) {
                    const int e = g * 8 + j;
                    const float sel = 1.f / (1.f + expf(-L[e])) + biasl[e];
                    L[e] = sel;
                    if (sel > m1) { m2 = m1; m1 = sel; } else if (sel > m2) m2 = sel;
                }
                gs[g] = m1 + m2;
            }
            unsigned allowed = 0u;
#pragma unroll
            for (int g = 0; g < 8; ++g) {
                int rk = 0;
#pragma unroll
                for (int h = 0; h < 8; ++h) rk += (gs[h] > gs[g] || (gs[h] == gs[g] && h < g)) ? 1 : 0;
                if (rk < 4) allowed |= 1u << g;
            }
#pragma unroll
            for (int k = 0; k < 8; ++k) {
                float best = -INFINITY; int bi = 0;
#pragma unroll
                for (int g = 0; g < 8; ++g) {
                    if ((allowed >> g) & 1u) {
#pragma unroll
                        for (int j = 0; j < 8; ++j) { const float v = L[g * 8 + j]; if (v > best) { best = v; bi = g * 8 + j; } }
                    }
                }
                esel[k] = bi; ssel[k] = best - biasl[bi]; wsum += ssel[k]; L[bi] = -INFINITY;
            }
#pragma unroll
            for (int k = 0; k < 8; ++k) lrank[k] = __hip_atomic_fetch_add(hist + esel[k], 1, __ATOMIC_RELAXED, __HIP_MEMORY_SCOPE_WORKGROUP);
        }
        __syncthreads();
        if (tid < 64) { const int c = hist[tid]; basel[tid] = c > 0 ? atomicAdd(cntg + tid, c) : 0; }
        __syncthreads();
        if (tid < 128) {
            const int t = brow + tid; const float wn = 2.5f / wsum;
#pragma unroll
            for (int k = 0; k < 8; ++k) {
                const int e = esel[k], pos = basel[e] + lrank[k];
                tokslot[(size_t)t * 8 + k] = (e << 20) | pos;
                W8[(size_t)t * 8 + k] = ssel[k] * wn;
                LIST[(size_t)e * TT + pos] = t * 8 + k;
            }
        }
    };
    gemm_tiles<false>(lds, tm0 + vcu_id(), TT / 128, gridDim.x, make, epi);
}

__device__ __forceinline__ int moe_find_expert(const LAS int* tp, int mtg) {
    int lo = 0, hi = 64;
    while (lo < hi) { const int mid = (lo + hi + 1) >> 1; if (tp[mid] <= mtg) lo = mid; else hi = mid - 1; }
    return lo;
}
__device__ __forceinline__ void ph_moe1(const Params& p, LAS unsigned char* lds, int l, int row_lo) {
    unsigned char* ws = p.ws;
    moe_tables(p, lds, l, row_lo);
    LAS int* cnt = (LAS int*)(lds + MOE_LDS_OFF); LAS int* tp = cnt + 80; LAS int* sp = tp + 80;
    const bf16* U = (const bf16*)(ws + AM_U8); const bf16* WGU = (const bf16*)(ws + OFF_W_GU); unsigned char* HM = ws + AM_HM;
    const int* LIST = (const int*)(ws + OFF_LIST);
    const int tid = threadIdx.x, lane = tid & 63, wid = tid >> 6, wr = wid >> 1, wc = wid & 1, fr = lane & 15, fq = lane >> 4;
    const int ntiles = tp[65] * 4;
    auto make = [&](int t, GPtrs& g, int& nk) {
        const int mtg = t >> 2, nt = t & 3, e = moe_find_expert(tp, mtg), mt = mtg - tp[e], ce = cnt[e];
        int lv[4];
#pragma unroll
        for (int i = 0; i < 4; ++i) { const int li = mt * 128 + (tid >> 3) + 32 * i; lv[i] = LIST[(size_t)(e < 64 ? e : 0) * TT + (li < ce ? li : 0)]; }
#pragma unroll
        for (int i = 0; i < 4; ++i) {
            const int li = mt * 128 + (tid >> 3) + 32 * i;
            const int tk = li < ce ? (e < 64 ? (lv[i] >> 3) : row_lo + li) : row_lo;
            g.a[i] = U + (size_t)tk * (DM / 2) + stg_col();
        }
        plain_ptrs(WGU + (size_t)e * 512 * (DM / 2), nt * 128, DM / 2, g.b); nk = DM / 128;
    };
    auto epi = [&](int t, f32x4 (&acc)[4][4]) {
        const int mtg = t >> 2, nt = t & 3, e = moe_find_expert(tp, mtg), mt = mtg - tp[e], ce = cnt[e];
        const size_t slot0 = e < 64 ? (size_t)(sp[e] + mt * 128) : (size_t)TT * 8 + row_lo + mt * 128;
        const int hc0 = nt * 64 + wc * 32;
        unsigned char* dump = ws + OFF_DUMP + lane * 64;
        constexpr float isc = 1.f / W8SC;
#pragma unroll
        for (int m = 0; m < 4; ++m) {
            const int i = wr * 64 + m * 16 + fr;
            unsigned char* hrow = (mt * 128 + i < ce) ? HM + (slot0 + i) * 256 + hc0 + fq * 4 : dump;
#pragma unroll
            for (int n = 0; n < 2; ++n) {
                const f32x4 g = acc[m][n] * isc, u = acc[m][n + 2] * (isc * H8SC);
                *(unsigned*)(hrow + n * 16) = pk4_fp8(siluf(g[0]) * u[0], siluf(g[1]) * u[1], siluf(g[2]) * u[2], siluf(g[3]) * u[3]);
            }
        }
    };
    gemm_tiles<true, 8, true>(lds, vcu_id(), ntiles, gridDim.x, make, epi);
}
__device__ __forceinline__ void ph_moe2(const Params& p, LAS unsigned char* lds, int l, int row_lo) {
    unsigned char* ws = p.ws;
    moe_tables(p, lds, l, row_lo);
    LAS int* cnt = (LAS int*)(lds + MOE_LDS_OFF); LAS int* tp = cnt + 80; LAS int* sp = tp + 80;
    const bf16* HM = (const bf16*)(ws + AM_HM); const bf16* WD = (const bf16*)(ws + OFF_W_D);
    const int tid = threadIdx.x, lane = tid & 63, wid = tid >> 6, wr = wid >> 1, wc = wid & 1, fr = lane & 15, fq = lane >> 4;
    const int ntiles = tp[65] * 8;
    auto make = [&](int t, GPtrs& g, int& nk) {
        const int mtg = t >> 3, nt = t & 7, e = moe_find_expert(tp, mtg), mt = mtg - tp[e];
        const size_t slot0 = e < 64 ? (size_t)(sp[e] + mt * 128) : (size_t)TT * 8 + row_lo + mt * 128;
        plain_ptrs(HM, 0, 128, g.a);
#pragma unroll
        for (int i = 0; i < 4; ++i) g.a[i] += slot0 * 128;
        plain_ptrs(WD + (size_t)e * DM * 128, nt * 128, 128, g.b); nk = 256 / 128;
    };
    auto epi = [&](int t, f32x4 (&acc)[4][4]) {
        const int mtg = t >> 3, nt = t & 7, e = moe_find_expert(tp, mtg), mt = mtg - tp[e], ce = cnt[e];
        const size_t slot0 = e < 64 ? (size_t)(sp[e] + mt * 128) : (size_t)TT * 8 + row_lo + mt * 128;
        constexpr float osc = Y8SC / (W8SC * H8SC);
        unsigned char* YR8 = ws + AM_YR; unsigned char* dump = ws + OFF_DUMP + lane * 16;
#pragma unroll
        for (int m = 0; m < 4; ++m) {
            const int i = wr * 64 + m * 16 + fr;
            unsigned char* yrow = (mt * 128 + i < ce) ? YR8 + (slot0 + i) * DM + nt * 128 + wc * 64 + fq * 16 : dump;
            const f32x4 a0 = acc[m][0] * osc, a1 = acc[m][1] * osc, a2 = acc[m][2] * osc, a3 = acc[m][3] * osc;
            *(u32x4*)(yrow) = (u32x4){pk4_fp8(a0[0], a0[1], a0[2], a0[3]), pk4_fp8(a1[0], a1[1], a1[2], a1[3]), pk4_fp8(a2[0], a2[1], a2[2], a2[3]), pk4_fp8(a3[0], a3[1], a3[2], a3[3])};
        }
    };
    gemm_tiles<true, 4, true, true>(lds, vcu_id(), ntiles, gridDim.x, make, epi);
}

__device__ __forceinline__ void ph_inproj1(const Params& p, LAS unsigned char* lds) {
    unsigned char* ws = p.ws;
    const bf16* U = (const bf16*)(ws + OFF_U); const bf16* W = (const bf16*)(ws + OFF_W_IN_O);
    bf16* Z1 = (bf16*)(ws + A1_Z1); bf16* KM = (bf16*)(ws + A1_KM);
    const f32x2* rope = (const f32x2*)(ws + OFF_ROPE);
    const int tid = threadIdx.x, lane = tid & 63, wid = tid >> 6, wr = wid >> 1, wc = wid & 1, fr = lane & 15, fq = lane >> 4;
    constexpr int NTN = 7, NTM = TT / 128;
    auto make = [&](int t, GPtrs& g, int& nk) { int tm, tn; tile_mn(t, NTM, NTN, tm, tn); plain_ptrs(U, tm * 128, DM, g.a); plain_ptrs(W, tn * 128, DM, g.b); nk = DM / 64; };
    auto epi = [&](int t, f32x4 (&acc)[4][4]) {
        int tm, tn; tile_mn(t, NTM, NTN, tm, tn); const int brow = tm * 128, bcol = tn * 128;
        const int cb = bcol + wc * 64;
        LAS unsigned char* wl = lds + 32768 + wid * 8192;
        const int r0 = brow + wr * 64;
        const RowInfo ri0 = rowinfo(r0);
        if (cb < 768) {
            float* ssq = (float*)(ws + OFF_SSQ);
#pragma unroll
            for (int m = 0; m < 4; ++m) {
                float q = 0.f;
#pragma unroll
                for (int n = 0; n < 4; ++n) q += (acc[m][n][0] * acc[m][n][0] + acc[m][n][1] * acc[m][n][1]) + (acc[m][n][2] * acc[m][n][2] + acc[m][n][3] * acc[m][n][3]);
                q += __shfl_xor(q, 16); q += __shfl_xor(q, 32);
                if (fq == 0) ssq[(size_t)(r0 + m * 16 + fr) * 12 + (cb >> 6)] = q;
            }
            epi_store_rows(wl, acc, fr, fq, lane, [&](int row) { return Z1 + (size_t)(r0 + row) * Z1P + cb; });
        } else if (cb == 768) {
#pragma unroll
            for (int m = 0; m < 4; ++m) {
                const int pos = ri0.pos + m * 16 + fr;
#pragma unroll
                for (int n = 0; n < 2; ++n)
#pragma unroll
                    for (int j = 0; j < 4; ++j) {
                        const float x1 = acc[m][n][j], x2 = acc[m][n + 2][j];
                        if (ri0.lat) { const f32x2 cs = rope[(size_t)pos * 32 + n * 16 + fq * 4 + j]; acc[m][n][j] = x1 * cs.x - x2 * cs.y; acc[m][n + 2][j] = x2 * cs.x + x1 * cs.y; }
                    }
                asm volatile("" ::: "memory");
            }
            bf16* dst = KM + ((size_t)(ri0.b * 8) * NKEY + ri0.kq) * 192 + 128;
            epi_store_rows(wl, acc, fr, fq, lane, [&](int row) { return dst + (size_t)row * 192; }, 8, (size_t)NKEY * 192);
        }
    };
    gemm_tiles<true>(lds, vcu_id(), NTM * NTN, gridDim.x, make, epi);
}

__device__ __forceinline__ void ph_mla_up(const Params& p, LAS unsigned char* lds) {
    unsigned char* ws = p.ws;
    const bf16* Z1 = (const bf16*)(ws + A1_Z1); const bf16* WQ = (const bf16*)(ws + OFF_W_UQ); const bf16* WKV = (const bf16*)(ws + OFF_W_UKV);
    bf16* QM = (bf16*)(ws + A1_QM); bf16* KM = (bf16*)(ws + A1_KM); bf16* VTM = (bf16*)(ws + A1_VTM);
    const f32x2* rope = (const f32x2*)(ws + OFF_ROPE);
    const int tid = threadIdx.x, lane = tid & 63, wid = tid >> 6, wr = wid >> 1, wc = wid & 1, fr = lane & 15, fq = lane >> 4;
    LAS float* rsb = (LAS float*)(lds + 66560);
    constexpr int NQ = (TL / 128) * 12, NKV = (TT / 128) * 16;
    constexpr float QSCALE = 0.07216878364870322f * LOG2E;
    auto decode = [&](int t, bool& isq, int& tm, int& tn) { isq = t < NQ; if (isq) { tile_mn(t, TL / 128, 12, tm, tn); tm += 4; } else tile_mn(t - NQ, TT / 128, 16, tm, tn); };
    auto make = [&](int t, GPtrs& g, int& nk) {
        bool isq; int tm, tn; decode(t, isq, tm, tn);
        const int brow = tm * 128, bcol = tn * 128, K = isq ? 512 : 256, acol = isq ? 0 : 512;
        const int par = ((t - vcu_id()) / (int)gridDim.x) & 1;
        if (tid < 128) {
            const float* q = (const float*)(ws + OFF_SSQ) + (size_t)(brow + tid) * 12;
            float ss;
            if (isq) { const f32x4 a = *(const f32x4*)q, b2 = *(const f32x4*)(q + 4); ss = ((a.x + a.y) + (a.z + a.w)) + ((b2.x + b2.y) + (b2.z + b2.w)); }
            else { const f32x4 a = *(const f32x4*)(q + 8); ss = (a.x + a.y) + (a.z + a.w); }
            rsb[par * 128 + tid] = rsqrtf(ss / (float)K + RMS_EPS);
        }
        plain_ptrs(Z1 + acol, brow, Z1P, g.a); plain_ptrs(isq ? WQ : WKV, bcol, K, g.b); nk = K / 64;
    };
    auto epi = [&](int t, f32x4 (&acc)[4][4]) {
        bool isq; int tm, tn; decode(t, isq, tm, tn);
        const int brow = tm * 128, bcol = tn * 128;
        const int par = ((t - vcu_id()) / (int)gridDim.x) & 1;
        const int cb = bcol + wc * 64;
        LAS unsigned char* wl = lds + 32768 + wid * 8192;
        const int r0 = brow + wr * 64;
        const RowInfo ri0 = rowinfo(r0);
        if (isq) {
            const int h = cb / 192, part = (cb % 192) >> 6;
#pragma unroll
            for (int m = 0; m < 4; ++m) {
                const float sc = rsb[par * 128 + wr * 64 + m * 16 + fr] * QSCALE;
                const int pos = ri0.pos + m * 16 + fr;
                if (part < 2) {
#pragma unroll
                    for (int n = 0; n < 4; ++n) acc[m][n] = acc[m][n] * sc;
                } else {
#pragma unroll
                    for (int n = 0; n < 2; ++n)
#pragma unroll
                        for (int j = 0; j < 4; ++j) {
                            const float x1 = acc[m][n][j] * sc, x2 = acc[m][n + 2][j] * sc;
                            const f32x2 cs = rope[(size_t)pos * 32 + n * 16 + fq * 4 + j];
                            acc[m][n][j] = x1 * cs.x - x2 * cs.y; acc[m][n + 2][j] = x2 * cs.x + x1 * cs.y;
                        }
                }
                asm volatile("" ::: "memory");
            }
            bf16* dst = QM + ((size_t)(ri0.b * 8 + h) * SEQ + ri0.pos) * 192 + part * 64;
            epi_store_rows(wl, acc, fr, fq, lane, [&](int row) { return dst + (size_t)row * 192; });
        } else {
            const int h = cb >> 8, part = (cb & 255) >> 6;
#pragma unroll
            for (int m = 0; m < 4; ++m) {
                const float rs = rsb[par * 128 + wr * 64 + m * 16 + fr];
#pragma unroll
                for (int n = 0; n < 4; ++n) acc[m][n] = acc[m][n] * rs;
            }
            if (part < 2) {
                bf16* dst = KM + ((size_t)(ri0.b * 8 + h) * NKEY + ri0.kq) * 192 + part * 64;
                epi_store_rows(wl, acc, fr, fq, lane, [&](int row) { return dst + (size_t)row * 192; });
            } else {
                bf16* dst = VTM + ((size_t)(ri0.b * 8 + h) * 128 + (part - 2) * 64) * NKEY + ri0.kq;
                epi_store_cols(wl, acc, fr, fq, lane, [&](int col) { return dst + (size_t)col * NKEY; });
            }
        }
    };
    gemm_tiles<true>(lds, vcu_id(), NQ + NKV, gridDim.x, make, epi);
}

__device__ __forceinline__ void ph_mla_attn(const Params& p, LAS unsigned char* lds) {
    unsigned char* ws = p.ws;
    const bf16* QM = (const bf16*)(ws + A1_QM); const bf16* KM = (const bf16*)(ws + A1_KM); const bf16* VTM = (const bf16*)(ws + A1_VTM); bf16* MIX = (bf16*)(ws + A1_MIX);
    for (int item = vcu_id(); item < 2 * 8 * 64; item += gridDim.x) {
        const int qt = item & 63, h = (item >> 6) & 7, b = item >> 9;
        const bf16* Qg = QM + ((size_t)(b * 8 + h) * SEQ + qt * 128) * 192;
        const bf16* Kg = KM + (size_t)(b * 8 + h) * NKEY * 192;
        const bf16* Vg = VTM + (size_t)(b * 8 + h) * 128 * NKEY;
        attn_item<192, 128>(lds, Qg, Kg, Vg, NKEY / 32, 0, 0, 0, -1e30f, 0.f, MIX + (size_t)(TC + b * SEQ + qt * 128) * DM + h * 128, DM);
    }
}


#define XB_TMO      128
#define XB_XCNT(j)  (256  + 64 * (j))
#define XB_XSUB(j)  (1280 + 64 * (j))
#define XB_XGEN(j)  (2304 + 64 * (j))
#define XB_TOP      3328
#define XB_TOPGEN   3392
#define XCD_BAR_WORDS 3456
#define XB_SPIN_CAP (1u << 18)
__device__ __forceinline__ unsigned xb_ld(unsigned* p)              { return __hip_atomic_load(p, __ATOMIC_RELAXED, __HIP_MEMORY_SCOPE_AGENT); }
__device__ __forceinline__ unsigned xb_add(unsigned* p, unsigned v) { return __hip_atomic_fetch_add(p, v, __ATOMIC_RELAXED, __HIP_MEMORY_SCOPE_AGENT); }
__device__ __forceinline__ unsigned xb_xcc_id() { return (unsigned)__builtin_amdgcn_s_getreg((3 << 11) | 20) & 0xFu; }
#define XB_SPIN(cond, bar) do { unsigned _sp = 0; while (cond) { __builtin_amdgcn_s_sleep(1); \
    if ((++_sp & 255u) == 0u) { if (xb_ld(&(bar)[XB_TMO])) break; if (_sp > XB_SPIN_CAP) { atomicAdd(&(bar)[XB_TMO], 1u); break; } } } } while (0)
struct XcdBarrier { unsigned* bar; unsigned x; volatile LAS unsigned* st; };
__device__ __forceinline__ XcdBarrier xcd_barrier_post(unsigned* bar, volatile LAS unsigned* st) {
    XcdBarrier b; b.bar = bar; b.x = xb_xcc_id(); b.st = st;
    if (threadIdx.x == 0) (void)xb_add(&bar[XB_XCNT(b.x)], 1u);
    return b;
}
__device__ __forceinline__ void xcd_barrier_complete(unsigned* bar, unsigned x, unsigned& nloc, unsigned& nx) {
    const unsigned G = gridDim.x * gridDim.y * gridDim.z;
    unsigned sum, cnt, mine, sp = 0u;
    for (;;) {
        sum = 0u; cnt = 0u; mine = 0u;
#pragma unroll
        for (unsigned j = 0; j < 16; ++j) { const unsigned c = xb_ld(&bar[XB_XCNT(j)]); sum += c; cnt += (c > 0u) ? 1u : 0u; mine = (j == x) ? c : mine; }
        if (sum == G) break;
        __builtin_amdgcn_s_sleep(1);
        if ((++sp & 255u) == 0u) { if (xb_ld(&bar[XB_TMO])) break; if (sp > XB_SPIN_CAP) { atomicAdd(&bar[XB_TMO], 1u); break; } }
    }
    nloc = mine > 0u ? mine : 1u; nx = cnt > 0u ? cnt : 1u;
}
__device__ __forceinline__ void xcd_barrier(const XcdBarrier& b) {
    asm volatile("s_waitcnt vmcnt(0)" ::: "memory");
    __syncthreads();
    if (threadIdx.x == 0) {
        unsigned* bar = b.bar;
        __builtin_amdgcn_s_waitcnt(0);
        unsigned nloc = b.st[0], nx = b.st[1];
        if (nloc == 0u) { xcd_barrier_complete(bar, b.x, nloc, nx); b.st[0] = nloc; b.st[1] = nx; }
        const unsigned old = xb_add(&bar[XB_XSUB(b.x)], 1u);
        const unsigned gen = old / nloc;
        if (old + 1u == (gen + 1u) * nloc) {
            __builtin_amdgcn_fence(__ATOMIC_RELEASE, "agent");
            asm volatile("s_waitcnt vmcnt(0)" ::: "memory");
            const unsigned og = xb_add(&bar[XB_TOP], 1u);
            const unsigned tg = og / nx;
            if (og + 1u == (tg + 1u) * nx) xb_add(&bar[XB_TOPGEN], 1u);
            else XB_SPIN(xb_ld(&bar[XB_TOPGEN]) == tg, bar);
            __builtin_amdgcn_fence(__ATOMIC_ACQUIRE, "agent");
            xb_add(&bar[XB_XGEN(b.x)], 1u);
            asm volatile("s_waitcnt vmcnt(0)" ::: "memory");
        } else {
            XB_SPIN(xb_ld(&bar[XB_XGEN(b.x)]) == gen, bar);
            __builtin_amdgcn_fence(__ATOMIC_ACQUIRE, "agent");
            asm volatile("s_waitcnt vmcnt(0)" ::: "memory");
        }
    }
    __syncthreads();
}
static_assert(XCD_BAR_WORDS * 4 <= BAR_BYTES, "barrier words");

__device__ __forceinline__ void convert_shared(const Params& p, LAS unsigned char* lds, int l, int nrt) {
    const int v = vcu_id(), G = gridDim.x, nfree = G - nrt;
    if (v >= nrt) for (int it = v - nrt; it < EXP_ITEMS; it += nfree) expert_convert_item(p, lds, l, it);
}

constexpr int NPHASE = 19;
__global__ void __launch_bounds__(256, 2) mega(Params p) {
    extern __shared__ __attribute__((aligned(16))) unsigned char lds_[];
    LAS unsigned char* lds = (LAS unsigned char*)lds_;
    cg::grid_group grid = cg::this_grid();
    unsigned char* ws = p.ws;
    volatile LAS unsigned* bst = (volatile LAS unsigned*)(lds + LDS_BYTES - 16);
    if (threadIdx.x < 4) bst[threadIdx.x] = 0u;
    __syncthreads();
    const XcdBarrier xbar = xcd_barrier_post((unsigned*)(ws + OFF_BAR), bst);
#define GRID_BAR(k) do { xcd_barrier(xbar); } while (0)
#ifndef PROBE_REP_MASK
#define PROBE_REP_MASK 0u
#endif
#ifndef PROBE_EXTRA_SYNCS
#define PROBE_EXTRA_SYNCS 0
#endif
#define PHASE(k, body) do { if (p.ph_lo <= (k) && (k) < p.ph_hi) { body; if ((PROBE_REP_MASK >> (k)) & 1u) { xcd_barrier(xbar); body; } if ((k) + 1 < p.ph_hi) GRID_BAR(k); } } while (0)
    for (int i = 0; i < PROBE_EXTRA_SYNCS; ++i) xcd_barrier(xbar);
    PHASE(0, ph_prep(p, lds));
    PHASE(1, ph_modulate0(p));
    PHASE(2, ph_inproj0(p, lds));
    PHASE(3, ph_swa_g1(p, lds));
    PHASE(4, ph_gla_scan(p));
    PHASE(5, ph_gla_g3(p, lds));
    PHASE(6, ph_outproj(p, lds, (const bf16*)(ws + A0_MIX), (const bf16*)(ws + OFF_W_OUT_E), (float*)(ws + A0_Y), 0));
    PHASE(7, ph_rowpassA(p, 0, 0, (const float*)(ws + A0_Y)));
    PHASE(8, { ph_router(p, lds, 0, 0); __syncthreads(); convert_shared(p, lds, 0, TT / 128); });
    PHASE(9, ph_moe1(p, lds, 0, 0));
    PHASE(10, ph_moe2(p, lds, 0, 0));
    PHASE(11, ph_rowpassB(p, lds, 0, 0));
    PHASE(12, ph_inproj1(p, lds));
    PHASE(13, ph_mla_up(p, lds));
    PHASE(14, ph_mla_attn(p, lds));
    PHASE(15, ph_outproj(p, lds, (const bf16*)(ws + A1_MIX), (const bf16*)(ws + OFF_W_OUT_O), (float*)(ws + A1_Y), TC));
    PHASE(16, ph_rowpassA(p, 1, TC, (const float*)(ws + A1_Y)));
    PHASE(17, { ph_router(p, lds, 1, TC); __syncthreads(); convert_shared(p, lds, 1, TL / 128); });
    PHASE(18, ph_moe1(p, lds, 1, TC));
    PHASE(19, ph_moe2(p, lds, 1, TC));
    PHASE(20, ph_rowpassB(p, lds, 1, TC));
}

extern "C" void kernel_launch(void* const* d_in, const int* in_sizes, int n_in, void* d_out, int out_size, void* d_ws, size_t ws_size, hipStream_t stream) {
    static int grid_blocks = 0;
    if (!grid_blocks) {
        int dev = 0, cus = 0, per_cu = 0;
        (void)hipGetDevice(&dev);
        (void)hipDeviceGetAttribute(&cus, hipDeviceAttributeMultiprocessorCount, dev);
        (void)hipFuncSetAttribute((const void*)mega, hipFuncAttributeMaxDynamicSharedMemorySize, LDS_BYTES);
        (void)hipOccupancyMaxActiveBlocksPerMultiprocessor(&per_cu, (const void*)mega, 256, LDS_BYTES);
        if (per_cu > 2) per_cu = 2;
        if (per_cu < 1) per_cu = 1;
        grid_blocks = cus * per_cu;
        if (ws_size < WS_NEED) fprintf(stderr, "kernel_launch: workspace too small: %zu < %zu\n", ws_size, (size_t)WS_NEED);
    }
    Params p{};
    const float** f = (const float**)&p;
    for (int i = 0; i < 30; ++i) f[i] = (const float*)d_in[i];
    p.out = (float*)d_out; p.ws = (unsigned char*)d_ws; p.ph_lo = 0; p.ph_hi = 21;
    (void)hipMemsetAsync((unsigned char*)d_ws + OFF_BAR, 0, BAR_BYTES, stream);
    void* args[] = {&p};
    hipError_t e = hipLaunchCooperativeKernel((const void*)mega, dim3(grid_blocks), dim3(256), args, LDS_BYTES, stream);
    if (e != hipSuccess) fprintf(stderr, "cooperative launch failed: %s (grid %d)\n", hipGetErrorString(e), grid_blocks);
}
```

```cpp
#include <hip/hip_runtime.h>
#include <hip/hip_cooperative_groups.h>
#include <cstdio>
#include <cstdint>
namespace cg = cooperative_groups;

#define LAS __attribute__((address_space(3)))
typedef unsigned short bf16;
typedef short bf16x8 __attribute__((ext_vector_type(8)));
typedef float f32x2 __attribute__((ext_vector_type(2)));
typedef float f32x4 __attribute__((ext_vector_type(4)));
typedef float f32x8 __attribute__((ext_vector_type(8)));
typedef float f32x16 __attribute__((ext_vector_type(16)));
typedef unsigned u32x2 __attribute__((ext_vector_type(2)));
typedef unsigned u32x4 __attribute__((ext_vector_type(4)));
typedef __bf16 bf16x2_t __attribute__((ext_vector_type(2)));
typedef int i32x8 __attribute__((ext_vector_type(8)));

constexpr int DM = 1024, NB = 2, SEQ = 8192, CTX = 256;
constexpr int TC = NB * CTX, TL = NB * SEQ, TT = TC + TL, NKEY = CTX + SEQ;
constexpr int NEXP = 64;
constexpr float RMS_EPS = 1e-6f;
constexpr int E_IN_PAD = 2432, O_IN_PAD = 896;
constexpr float LOG2E = 1.4426950408889634f;
constexpr int NSTEP = 132;
constexpr int Z0P = 1056;
constexpr int Z1P = 768;
constexpr int LDS_BYTES = 73728;

constexpr size_t al(size_t x) { return (x + 255) & ~(size_t)255; }
constexpr size_t OFF_W_IN_E = 0;
constexpr size_t OFF_W_OUT_E = OFF_W_IN_E + al((size_t)E_IN_PAD * DM * 2);
constexpr size_t OFF_W_IN_O = OFF_W_OUT_E + al((size_t)DM * DM * 2);
constexpr size_t OFF_W_UQ = OFF_W_IN_O + al((size_t)O_IN_PAD * DM * 2);
constexpr size_t OFF_W_UKV = OFF_W_UQ + al((size_t)1536 * 512 * 2);
constexpr size_t OFF_W_OUT_O = OFF_W_UKV + al((size_t)2048 * 256 * 2);
constexpr size_t OFF_W_RT = OFF_W_OUT_O + al((size_t)DM * DM * 2);
constexpr size_t OFF_W_GU = OFF_W_RT + al((size_t)2 * 128 * DM * 2);
constexpr size_t OFF_W_D = OFF_W_GU + al((size_t)65 * 512 * DM * 2);
constexpr size_t OFF_U = OFF_W_D + al((size_t)65 * DM * 256 * 2);
constexpr size_t OFF_HC = OFF_U + al((size_t)TT * DM * 2);
constexpr size_t OFF_MOD = OFF_HC + al((size_t)TC * DM * 4);
constexpr size_t OFF_ROPE = OFF_MOD + al((size_t)2 * 3 * 6144 * 4);
constexpr size_t OFF_CNT = OFF_ROPE + al((size_t)SEQ * 32 * 8);
constexpr size_t OFF_TOKSLOT = OFF_CNT + al(2 * 64 * 4);
constexpr size_t OFF_W8 = OFF_TOKSLOT + al((size_t)TT * 8 * 4);
constexpr size_t OFF_LIST = OFF_W8 + al((size_t)TT * 8 * 4);
constexpr size_t OFF_SSQ = OFF_LIST + al((size_t)64 * TT * 4);
constexpr size_t OFF_DUMP = OFF_SSQ + al((size_t)TT * 12 * 4);
constexpr size_t OFF_BAR = OFF_DUMP + 8192;
constexpr size_t BAR_BYTES = 16384;
constexpr size_t OFF_ARENA = OFF_BAR + BAR_BYTES;
constexpr size_t A0_Z0 = OFF_ARENA;
constexpr size_t A0_VGT = A0_Z0 + al((size_t)TT * Z0P * 2);
constexpr size_t A0_QS = A0_VGT + al((size_t)4 * 128 * TT * 2);
constexpr size_t A0_KS = A0_QS + al((size_t)2 * 8 * NKEY * 64 * 2);
constexpr size_t A0_VST = A0_KS + al((size_t)2 * 2 * NKEY * 64 * 2);
constexpr size_t A0_GS = A0_VST + al((size_t)2 * 2 * 64 * NKEY * 2);
constexpr size_t A0_GD = A0_GS + al((size_t)16 * NSTEP * 8192 * 4);
constexpr size_t A0_MIX = A0_GD + al((size_t)16 * NSTEP * 64 * 4);
constexpr size_t A0_Y = A0_MIX + al((size_t)TT * DM * 2);
constexpr size_t A0_END = A0_Y + al((size_t)TT * DM * 4);
constexpr size_t A1_Z1 = OFF_ARENA;
constexpr size_t A1_QM = A1_Z1 + al((size_t)TT * Z1P * 2);
constexpr size_t A1_KM = A1_QM + al((size_t)2 * 8 * SEQ * 192 * 2);
constexpr size_t A1_VTM = A1_KM + al((size_t)2 * 8 * NKEY * 192 * 2);
constexpr size_t A1_MIX = A1_VTM + al((size_t)2 * 8 * 128 * NKEY * 2);
constexpr size_t A1_Y = A1_MIX + al((size_t)TT * DM * 2);
constexpr size_t A1_END = A1_Y + al((size_t)TT * DM * 4);
constexpr size_t AM_U8 = OFF_ARENA;
constexpr size_t AM_HM = AM_U8 + al((size_t)TT * 1024);
constexpr size_t AM_YR = AM_HM + al((size_t)TT * 9 * 256);
constexpr size_t AM_END = AM_YR + al((size_t)TT * 9 * 1024 * 2);
constexpr size_t WS_NEED = AM_END > A0_END ? (AM_END > A1_END ? AM_END : A1_END) : (A0_END > A1_END ? A0_END : A1_END);
static_assert(WS_NEED <= 555747360ull, "workspace map exceeds the guaranteed d_ws size");

struct Params {
    const float *x, *c, *ctx, *c_ctx, *w_mod, *b_mod, *g_mix_pre, *g_mix_post, *g_ffn_pre, *g_ffn_post;
    const float *w_in_e, *gla_wa2, *gla_ba, *gla_norm, *swa_sink, *w_out_e;
    const float *w_in_o, *mla_q_norm, *mla_kv_norm, *w_uq, *w_ukv, *w_out_o;
    const float *w_router, *b_router, *w_exp_gate, *w_exp_up, *w_exp_down, *w_sh_gate, *w_sh_up, *w_sh_down;
    float* out; unsigned char* ws; int ph_lo, ph_hi;
};

__device__ __forceinline__ unsigned pk2(float lo, float hi) { f32x2 v = {lo, hi}; bf16x2_t b = __builtin_convertvector(v, bf16x2_t); return __builtin_bit_cast(unsigned, b); }
__device__ __forceinline__ float bflo(unsigned u) { return __uint_as_float(u << 16); }
__device__ __forceinline__ float bfhi(unsigned u) { return __uint_as_float(u & 0xffff0000u); }
__device__ __forceinline__ float bf2f(bf16 v) { return __uint_as_float((unsigned)v << 16); }
__device__ __forceinline__ bf16 f2bf(float f) { return (bf16)(pk2(f, 0.f) & 0xffffu); }
constexpr float W8SC = 64.f, H8SC = 4.f, Y8SC = 16.f;
__device__ __forceinline__ unsigned pk4_fp8(float a, float b, float c, float d) { int w = 0; w = __builtin_amdgcn_cvt_pk_fp8_f32(a, b, w, false); w = __builtin_amdgcn_cvt_pk_fp8_f32(c, d, w, true); return (unsigned)w; }
__device__ __forceinline__ float wave_sum(float v) {
#pragma unroll
    for (int o = 1; o < 64; o <<= 1) v += __shfl_xor(v, o);
    return v;
}
__device__ __forceinline__ void glds16(const void* g, LAS void* l) { __builtin_amdgcn_global_load_lds((const unsigned*)g, (LAS unsigned*)l, 16, 0, 0); }
__device__ __forceinline__ float siluf(float x) { return x / (1.f + __expf(-x)); }
__device__ __forceinline__ float ex2(float x) { return __builtin_amdgcn_exp2f(x); }
__device__ __forceinline__ int crow(int r, int hi) { return (r & 3) + 8 * (r >> 2) + 4 * hi; }
__device__ __forceinline__ bf16x8 mk8(u32x4 v) { return __builtin_bit_cast(bf16x8, v); }

struct RowInfo { int b, kq, pos; bool lat; };
__device__ __forceinline__ RowInfo rowinfo(int r) {
    RowInfo i;
    if (r < TC) { i.b = r >> 8; i.pos = r & 255; i.kq = i.pos; i.lat = false; }
    else { const int rl = r - TC; i.b = rl >> 13; i.pos = rl & (SEQ - 1); i.kq = CTX + i.pos; i.lat = true; }
    return i;
}
__device__ __forceinline__ int modvec(int r) { return r < TC ? 2 : ((r - TC) >> 13); }

struct GPtrs { const bf16* a[4]; const bf16* b[4]; };
constexpr int G_STAGE = 32768;
#define G_FENCE() asm volatile("" ::: "memory")
__device__ __forceinline__ void gemm_issue(LAS unsigned char* lds, const GPtrs& g, int kt) {
    LAS unsigned char* d = lds + (kt & 1) * G_STAGE + threadIdx.x * 16; const int ko = kt * 64;
#pragma unroll
    for (int i = 0; i < 4; ++i) { glds16(g.a[i] + ko, d + i * 4096); glds16(g.b[i] + ko, d + 16384 + i * 4096); }
}
__device__ __forceinline__ void gemm_prologue(LAS unsigned char* lds, const GPtrs& g, int nk) { gemm_issue(lds, g, 0); }
__device__ __forceinline__ void gemm_prologue2(LAS unsigned char* lds, const GPtrs& g) { gemm_issue(lds, g, 0); gemm_issue(lds, g, 1); }
template <int NST, bool FP8 = false, bool PRE2 = false>
__device__ __forceinline__ void gemm_main(LAS unsigned char* lds, const GPtrs& g, int nk, f32x4 (&acc)[4][4], bool after_epi) {
    const int tid = threadIdx.x, lane = tid & 63, wid = tid >> 6, wr = wid >> 1, wc = wid & 1, fr = lane & 15, fq = lane >> 4;
#pragma unroll
    for (int m = 0; m < 4; ++m)
#pragma unroll
        for (int n = 0; n < 4; ++n) acc[m][n] = (f32x4){0.f, 0.f, 0.f, 0.f};
    const int c0 = ((fq) ^ (fr & 7)) * 16, c1 = ((4 + fq) ^ (fr & 7)) * 16;
    const int aoff = (wr * 64 + fr) * 128, boff = 16384 + (wc * 64 + fr) * 128;
#pragma unroll 1
    for (int kt = 0; kt < nk; ++kt) {
        if (PRE2) {
            static_assert(!PRE2 || NST == 4 || NST < 0, "PRE2 counted waits are written for 4 epilogue stores");
            if (kt == 0) { if (after_epi) asm volatile("s_waitcnt vmcnt(12) lgkmcnt(0)" ::: "memory"); else asm volatile("s_waitcnt vmcnt(8) lgkmcnt(0)" ::: "memory"); }
            else { if (after_epi) asm volatile("s_waitcnt vmcnt(4) lgkmcnt(0)" ::: "memory"); else asm volatile("s_waitcnt vmcnt(0) lgkmcnt(0)" ::: "memory"); }
        } else
        if (NST == 8 && kt == 0 && after_epi) asm volatile("s_waitcnt vmcnt(8) lgkmcnt(0)" ::: "memory");
        else if (NST == 16 && kt == 0 && after_epi) asm volatile("s_waitcnt vmcnt(16) lgkmcnt(0)" ::: "memory");
        else asm volatile("s_waitcnt vmcnt(0) lgkmcnt(0)" ::: "memory");
        __builtin_amdgcn_s_barrier();
        G_FENCE();
        if (!PRE2 && kt + 1 < nk) gemm_issue(lds, g, kt + 1);
        LAS unsigned char* base = lds + (kt & 1) * G_STAGE;
        if constexpr (FP8) {
            i32x8 a8[4], b8[4];
            const int ca = ((2 * fq) ^ (fr & 7)) * 16, cb = ((2 * fq + 1) ^ (fr & 7)) * 16;
#pragma unroll
            for (int m = 0; m < 4; ++m) { const u32x4 x = *(const LAS u32x4*)(base + aoff + m * 2048 + ca), y = *(const LAS u32x4*)(base + aoff + m * 2048 + cb);
                a8[m] = (i32x8){(int)x.x, (int)x.y, (int)x.z, (int)x.w, (int)y.x, (int)y.y, (int)y.z, (int)y.w}; }
#pragma unroll
            for (int n = 0; n < 4; ++n) { const u32x4 x = *(const LAS u32x4*)(base + boff + n * 2048 + ca), y = *(const LAS u32x4*)(base + boff + n * 2048 + cb);
                b8[n] = (i32x8){(int)x.x, (int)x.y, (int)x.z, (int)x.w, (int)y.x, (int)y.y, (int)y.z, (int)y.w}; }
            __builtin_amdgcn_s_setprio(1);
#pragma unroll
            for (int m = 0; m < 4; ++m)
#pragma unroll
                for (int n = 0; n < 4; ++n) acc[m][n] = __builtin_amdgcn_mfma_scale_f32_16x16x128_f8f6f4(b8[n], a8[m], acc[m][n], 0, 0, 0, 0x7F7F7F7F, 0, 0x7F7F7F7F);
            __builtin_amdgcn_s_setprio(0);
            continue;
        }
        bf16x8 af0[4], bf0[4], af1[4], bf1[4];
#pragma unroll
        for (int m = 0; m < 4; ++m) af0[m] = *(const LAS bf16x8*)(base + aoff + m * 2048 + c0);
#pragma unroll
        for (int n = 0; n < 4; ++n) bf0[n] = *(const LAS bf16x8*)(base + boff + n * 2048 + c0);
#pragma unroll
        for (int m = 0; m < 4; ++m) af1[m] = *(const LAS bf16x8*)(base + aoff + m * 2048 + c1);
#pragma unroll
        for (int n = 0; n < 4; ++n) bf1[n] = *(const LAS bf16x8*)(base + boff + n * 2048 + c1);
        __builtin_amdgcn_s_setprio(1);
#pragma unroll
        for (int m = 0; m < 4; ++m)
#pragma unroll
            for (int n = 0; n < 4; ++n) acc[m][n] = __builtin_amdgcn_mfma_f32_16x16x32_bf16(bf0[n], af0[m], acc[m][n], 0, 0, 0);
#pragma unroll
        for (int m = 0; m < 4; ++m)
#pragma unroll
            for (int n = 0; n < 4; ++n) acc[m][n] = __builtin_amdgcn_mfma_f32_16x16x32_bf16(bf1[n], af1[m], acc[m][n], 0, 0, 0);
        __builtin_amdgcn_s_setprio(0);
    }
    asm volatile("s_waitcnt lgkmcnt(0)" ::: "memory");
    __builtin_amdgcn_s_barrier();
    G_FENCE();
}
__device__ __forceinline__ int vcu_id() { const int b = blockIdx.x, G = gridDim.x; return (G % 8 == 0) ? (b % 8) * (G / 8) + b / 8 : b; }
__device__ __forceinline__ void tile_mn(int w, int ntm, int ntn, int& tm, int& tn) {
    const int nig = 8 * ntn, gid = w / nig, fm = gid * 8, gsz = (ntm - fm) < 8 ? (ntm - fm) : 8, within = w - gid * nig;
    tm = fm + within % gsz; tn = within / gsz;
}
template <bool PREFETCH_NEXT, int NST = -1, bool FP8 = false, bool PRE2 = false, class Make, class Epi>
__device__ __forceinline__ void gemm_tiles(LAS unsigned char* lds, int t0, int nt, int stride, Make make, Epi epi) {
    if (t0 >= nt) return;
    GPtrs g; int nk;
    make(t0, g, nk);
    G_FENCE();
    if (PRE2) gemm_prologue2(lds, g); else gemm_prologue(lds, g, nk);
    bool first = true;
    for (int t = t0; t < nt;) {
        const int tn = t + stride;
        f32x4 acc[4][4];
        gemm_main<PREFETCH_NEXT ? NST : -1, FP8, PRE2>(lds, g, nk, acc, !first);
        first = false;
        if (PREFETCH_NEXT) { if (tn < nt) { make(tn, g, nk); G_FENCE(); if (PRE2) gemm_prologue2(lds, g); else gemm_prologue(lds, g, nk); } epi(t, acc); }
        else { epi(t, acc); __syncthreads(); if (tn < nt) { make(tn, g, nk); G_FENCE(); gemm_prologue(lds, g, nk); } }
        t = tn;
    }
}

template <class RowPtr>
__device__ __forceinline__ void epi_store_rows(LAS unsigned char* wl, const f32x4 (&v)[4][4], int fr, int fq, int lane, RowPtr rowptr, int nrep = 1, size_t rep_stride = 0) {
#pragma unroll
    for (int m = 0; m < 4; ++m)
#pragma unroll
        for (int n = 0; n < 4; ++n)
            *(LAS u32x2*)(wl + (m * 16 + fr) * 128 + (((n * 2 + (fq >> 1)) ^ (fr & 7)) * 16) + (fq & 1) * 8) = (u32x2){pk2(v[m][n][0], v[m][n][1]), pk2(v[m][n][2], v[m][n][3])};
#pragma unroll
    for (int i = 0; i < 8; ++i) {
        const int row = (lane >> 3) + 8 * i, pos = lane & 7;
        const u32x4 w = *(const LAS u32x4*)(wl + row * 128 + pos * 16);
        bf16* d = rowptr(row);
        if (d) { d += (pos ^ (row & 7)) * 8; for (int r = 0; r < nrep; ++r) *(u32x4*)(d + (size_t)r * rep_stride) = w; }
    }
}
template <class ColPtr>
__device__ __forceinline__ void epi_store_cols(LAS unsigned char* wl, const f32x4 (&v)[4][4], int fr, int fq, int lane, ColPtr colptr) {
    LAS unsigned char* wb = wl + fq * 512 + fr * 2;
#pragma unroll
    for (int m = 0; m < 4; ++m)
#pragma unroll
        for (int n = 0; n < 4; ++n)
#pragma unroll
            for (int j = 0; j < 4; ++j) *(LAS bf16*)(wb + n * 2048 + j * 128 + m * 32) = f2bf(v[m][n][j]);
#pragma unroll
    for (int i = 0; i < 8; ++i) {
        const int col = (lane >> 3) + 8 * i, pos = lane & 7;
        const u32x4 w = *(const LAS u32x4*)(wl + col * 128 + pos * 16);
        bf16* d = colptr(col);
        *(u32x4*)(d + pos * 8) = w;
    }
}

__device__ __forceinline__ int ein_map(int n) {
    if (n < 512) return n;
    if (n < 1024) return n + 512;
    if (n < 1536) return n - 512;
    if (n < 2048) return 1568 + (n - 1536);
    if (n < 2176) return 2080 + (n - 2048);
    if (n < 2304) return 2208 + (n - 2176);
    if (n < 2320) return 1536 + (n - 2304);
    if (n < 2336) return 1552 + (n - 2320);
    return -1;
}
template <bool FP8 = false>
__device__ __forceinline__ void transpose_item(LAS unsigned char* lds, int K, bf16* dst, int k0, int n0, int ld, int mode, const float* srcA, const float* srcB, int nvalid, const float* kscale) {
    LAS float* tile = (LAS float*)lds;
    const int tid = threadIdx.x;
    {
        const int nq = tid & 31, kr = tid >> 5, n = n0 + nq * 4;
        const float* cp = nullptr; float sc = 1.f;
        if (mode == 0) { if (n < nvalid) cp = srcA + n; }
        else if (mode == 1) { const int c = ein_map(n); if (c >= 0) cp = srcA + c; if (n < 256) sc = 0.125f; }
        else if (mode == 2) { const int grp = n >> 6, w = n & 63; cp = (w < 32 ? srcA : srcB) + grp * 32 + (w & 31); }
        else { const int b6 = n & 63; cp = srcA + (n & ~63) + ((b6 >> 2) & 3) * 16 + (b6 >> 4) * 4; }
        f32x4 v[8];
#pragma unroll
        for (int i = 0; i < 8; ++i) { const int k = kr + 8 * i; v[i] = cp ? *(const f32x4*)(cp + (size_t)(k0 + k) * ld) : (f32x4){0.f, 0.f, 0.f, 0.f}; }
#pragma unroll
        for (int i = 0; i < 8; ++i) { const int k = kr + 8 * i; float m = sc; if (kscale) m *= kscale[k0 + k]; *(LAS f32x4*)(tile + k * 132 + nq * 4) = v[i] * m; }
    }
    __syncthreads();
    {
        const int n = tid >> 1, hf = tid & 1;
        if constexpr (FP8) {
            unsigned char* d8 = (unsigned char*)dst;
#pragma unroll
            for (int c = 0; c < 2; ++c) {
                const int k16 = hf * 32 + c * 16;
                u32x4 o;
                o.x = pk4_fp8(tile[(k16 + 0) * 132 + n] * W8SC, tile[(k16 + 1) * 132 + n] * W8SC, tile[(k16 + 2) * 132 + n] * W8SC, tile[(k16 + 3) * 132 + n] * W8SC);
                o.y = pk4_fp8(tile[(k16 + 4) * 132 + n] * W8SC, tile[(k16 + 5) * 132 + n] * W8SC, tile[(k16 + 6) * 132 + n] * W8SC, tile[(k16 + 7) * 132 + n] * W8SC);
                o.z = pk4_fp8(tile[(k16 + 8) * 132 + n] * W8SC, tile[(k16 + 9) * 132 + n] * W8SC, tile[(k16 + 10) * 132 + n] * W8SC, tile[(k16 + 11) * 132 + n] * W8SC);
                o.w = pk4_fp8(tile[(k16 + 12) * 132 + n] * W8SC, tile[(k16 + 13) * 132 + n] * W8SC, tile[(k16 + 14) * 132 + n] * W8SC, tile[(k16 + 15) * 132 + n] * W8SC);
                *(u32x4*)(d8 + (size_t)(n0 + n) * K + k0 + k16) = o;
            }
        } else
#pragma unroll
        for (int c = 0; c < 4; ++c) {
            const int k8 = hf * 32 + c * 8;
            u32x4 o;
            o.x = pk2(tile[(k8 + 0) * 132 + n], tile[(k8 + 1) * 132 + n]);
            o.y = pk2(tile[(k8 + 2) * 132 + n], tile[(k8 + 3) * 132 + n]);
            o.z = pk2(tile[(k8 + 4) * 132 + n], tile[(k8 + 5) * 132 + n]);
            o.w = pk2(tile[(k8 + 6) * 132 + n], tile[(k8 + 7) * 132 + n]);
            *(u32x4*)(dst + (size_t)(n0 + n) * K + k0 + k8) = o;
        }
    }
    __syncthreads();
}

constexpr int EXP_GU_ITEMS = 65 * 16 * 4, EXP_D_ITEMS = 65 * 4 * 8, EXP_ITEMS = EXP_GU_ITEMS + EXP_D_ITEMS;
__device__ __forceinline__ void expert_convert_item(const Params& p, LAS unsigned char* lds, int l, int it) {
    unsigned char* ws = p.ws;
    if (it < EXP_GU_ITEMS) {
        const int e = it / 64, r = it % 64, kb = r / 4, nb = r % 4;
        const float* gate = e < 64 ? p.w_exp_gate + ((size_t)(l * 64 + e)) * DM * 256 : p.w_sh_gate + (size_t)l * DM * 256;
        const float* up = e < 64 ? p.w_exp_up + ((size_t)(l * 64 + e)) * DM * 256 : p.w_sh_up + (size_t)l * DM * 256;
        transpose_item<true>(lds, DM, (bf16*)(ws + OFF_W_GU + (size_t)e * 512 * DM), kb * 64, nb * 128, 256, 2, gate, up, 512, nullptr);
    } else {
        it -= EXP_GU_ITEMS;
        const int e = it / 32, r = it % 32, kb = r / 8, nb = r % 8;
        const float* dn = e < 64 ? p.w_exp_down + ((size_t)(l * 64 + e)) * 256 * DM : p.w_sh_down + (size_t)l * 256 * DM;
        transpose_item<true>(lds, 256, (bf16*)(ws + OFF_W_D + (size_t)e * DM * 256), kb * 64, nb * 128, DM, 3, dn, nullptr, DM, nullptr);
    }
}

__device__ __forceinline__ void ph_prep(const Params& p, LAS unsigned char* lds) {
    unsigned char* ws = p.ws;
    const int tid = threadIdx.x;
    if (blockIdx.x == 0 && tid < 128) ((int*)(ws + OFF_CNT))[tid] = 0;
    constexpr int I_MOD = 96, I_ROPE = 1024, I_INE = 16 * 19, I_OUTE = 128, I_INO = 16 * 7, I_UQ = 8 * 12, I_UKV = 4 * 16, I_OUTO = 128, I_RT = 32;
    constexpr int NITEMS = I_MOD + I_ROPE + I_INE + I_OUTE + I_INO + I_UQ + I_UKV + I_OUTO + I_RT;
    for (int item = blockIdx.x; item < NITEMS; item += gridDim.x) {
        int it = item;
        if (it < I_MOD) {
            const int l = it / 48, n0 = (it % 48) * 128, kg = tid >> 5, cl = tid & 31;
            LAS float* s = (LAS float*)lds;
            LAS float* red = (LAS float*)(lds + 12288);
            for (int idx = tid; idx < 3072; idx += 256) { const int v = idx >> 10, k = idx & 1023; const float cv = v < 2 ? p.c[v * DM + k] : p.c_ctx[k]; s[idx] = cv / (1.f + expf(-cv)); }
            __syncthreads();
            f32x4 a0 = {0.f, 0.f, 0.f, 0.f}, a1 = a0, a2 = a0;
            const float* w = p.w_mod + (size_t)l * DM * 6144 + (size_t)(kg * 128) * 6144 + n0 + cl * 4;
#pragma unroll 8
            for (int k = 0; k < 128; ++k) { const f32x4 wv = *(const f32x4*)(w + (size_t)k * 6144); const int kk = kg * 128 + k; a0 += wv * s[kk]; a1 += wv * s[1024 + kk]; a2 += wv * s[2048 + kk]; }
            *(LAS f32x4*)(red + (kg * 3 + 0) * 128 + cl * 4) = a0; *(LAS f32x4*)(red + (kg * 3 + 1) * 128 + cl * 4) = a1; *(LAS f32x4*)(red + (kg * 3 + 2) * 128 + cl * 4) = a2;
            __syncthreads();
            for (int idx = tid; idx < 384; idx += 256) { const int v = idx >> 7, n = idx & 127; float acc = 0.f;
#pragma unroll
                for (int g = 0; g < 8; ++g) acc += red[(g * 3 + v) * 128 + n];
                ((float*)(ws + OFF_MOD))[((size_t)l * 3 + v) * 6144 + n0 + n] = acc + p.b_mod[l * 6144 + n0 + n]; }
            __syncthreads();
            continue;
        }
        it -= I_MOD;
        if (it < I_ROPE) {
            const int idx = it * 256 + tid, pos = idx >> 5, i = idx & 31, row = pos >> 6, col = pos & 63, j = i & 15;
            const float invf = powf(10000.f, -(float)(2 * j) / 32.f);
            const float ang = (float)(i < 16 ? row : col) * invf;
            float sn, cs; sincosf(ang, &sn, &cs);
            ((f32x2*)(ws + OFF_ROPE))[idx] = (f32x2){cs, sn};
            continue;
        }
        it -= I_ROPE;
        if (it < I_INE) { const int kb = it / 19, nb = it % 19;
            transpose_item(lds, DM, (bf16*)(ws + OFF_W_IN_E), kb * 64, nb * 128, 2336, 1, p.w_in_e, nullptr, 2336, nullptr); continue; }
        it -= I_INE;
        if (it < I_OUTE) { const int kb = it / 8, nb = it % 8;
            transpose_item(lds, DM, (bf16*)(ws + OFF_W_OUT_E), kb * 64, nb * 128, DM, 0, p.w_out_e, nullptr, DM, nullptr); continue; }
        it -= I_OUTE;
        if (it < I_INO) { const int kb = it / 7, nb = it % 7;
            transpose_item(lds, DM, (bf16*)(ws + OFF_W_IN_O), kb * 64, nb * 128, 832, 0, p.w_in_o, nullptr, 832, nullptr); continue; }
        it -= I_INO;
        if (it < I_UQ) { const int kb = it / 12, nb = it % 12;
            transpose_item(lds, 512, (bf16*)(ws + OFF_W_UQ), kb * 64, nb * 128, 1536, 0, p.w_uq, nullptr, 1536, p.mla_q_norm); continue; }
        it -= I_UQ;
        if (it < I_UKV) { const int kb = it / 16, nb = it % 16;
            transpose_item(lds, 256, (bf16*)(ws + OFF_W_UKV), kb * 64, nb * 128, 2048, 0, p.w_ukv, nullptr, 2048, p.mla_kv_norm); continue; }
        it -= I_UKV;
        if (it < I_OUTO) { const int kb = it / 8, nb = it % 8;
            transpose_item(lds, DM, (bf16*)(ws + OFF_W_OUT_O), kb * 64, nb * 128, DM, 0, p.w_out_o, nullptr, DM, nullptr); continue; }
        it -= I_OUTO;
        { const int l = it / 16, kb = it % 16;
            transpose_item(lds, DM, (bf16*)(ws + OFF_W_RT) + (size_t)l * 128 * DM, kb * 64, 0, 64, 0, p.w_router + (size_t)l * DM * 64, nullptr, 64, nullptr); }
    }
}

__device__ __forceinline__ void load_row(const float* src, int lane, f32x4 (&v)[4]) {
#pragma unroll
    for (int j = 0; j < 4; ++j) v[j] = *(const f32x4*)(src + lane * 4 + 256 * j);
}
__device__ __forceinline__ float row_sumsq(const f32x4 (&v)[4]) {
    float s = 0.f;
#pragma unroll
    for (int j = 0; j < 4; ++j) s += v[j].x * v[j].x + v[j].y * v[j].y + v[j].z * v[j].z + v[j].w * v[j].w;
    return wave_sum(s);
}
__device__ __forceinline__ void modulate_store(const f32x4 (&v)[4], float rinv, const float* g, const float* sh, const float* sc, bf16* dst, int lane) {
#pragma unroll
    for (int j = 0; j < 4; ++j) {
        const int c = lane * 4 + 256 * j;
        const f32x4 gg = *(const f32x4*)(g + c), s1 = *(const f32x4*)(sc + c), s0 = *(const f32x4*)(sh + c);
        const f32x4 o = v[j] * rinv * gg * (s1 + 1.f) + s0;
        u32x2 w; w.x = pk2(o.x, o.y); w.y = pk2(o.z, o.w);
        *(u32x2*)(dst + c) = w;
    }
}
__device__ __forceinline__ const float* hl_src0(const Params& p, int r) { return r < TC ? p.ctx + (size_t)r * DM : p.x + (size_t)(r - TC) * DM; }
__device__ __forceinline__ bf16* hl_buf(const Params& p, int r) { return r < TC ? (bf16*)(p.ws + OFF_HC) + (size_t)r * DM : (bf16*)(p.out + (size_t)(r - TC) * DM); }

__device__ __forceinline__ void ph_modulate0(const Params& p) {
    const int lane = threadIdx.x & 63, gw = blockIdx.x * 4 + (threadIdx.x >> 6), ngw = gridDim.x * 4;
    const float* mod = (const float*)(p.ws + OFF_MOD);
    bf16* U = (bf16*)(p.ws + OFF_U);
    for (int r = gw; r < TT; r += ngw) {
        f32x4 v[4]; load_row(hl_src0(p, r), lane, v);
        const float rinv = rsqrtf(row_sumsq(v) * (1.f / DM) + RMS_EPS);
        const float* mv = mod + (size_t)modvec(r) * 6144;
        modulate_store(v, rinv, p.g_mix_pre, mv, mv + 1024, U + (size_t)r * DM, lane);
    }
}

__device__ __forceinline__ void ph_rowpassA(const Params& p, int l, int row_lo, const float* Y) {
    const int lane = threadIdx.x & 63, gw = blockIdx.x * 4 + (threadIdx.x >> 6), ngw = gridDim.x * 4;
    const float* mod = (const float*)(p.ws + OFF_MOD) + (size_t)l * 3 * 6144;
    bf16* U = (bf16*)(p.ws + OFF_U);
    for (int r = row_lo + gw; r < TT; r += ngw) {
        f32x4 y[4], h[4];
        load_row(Y + (size_t)r * DM, lane, y);
        bf16* hb = hl_buf(p, r);
        if (l == 0) load_row(hl_src0(p, r), lane, h);
        else {
#pragma unroll
            for (int j = 0; j < 4; ++j) { const u32x2 w = *(const u32x2*)(hb + lane * 4 + 256 * j); h[j] = (f32x4){bflo(w.x), bfhi(w.x), bflo(w.y), bfhi(w.y)}; }
        }
        const float rinv = rsqrtf(row_sumsq(y) * (1.f / DM) + RMS_EPS);
        const float* mv = mod + (size_t)modvec(r) * 6144;
#pragma unroll
        for (int j = 0; j < 4; ++j) {
            const int c = lane * 4 + 256 * j;
            const f32x4 gg = *(const f32x4*)(p.g_mix_post + l * DM + c), gt = *(const f32x4*)(mv + 2048 + c);
            h[j] = h[j] + gt * (y[j] * rinv * gg);
            *(u32x2*)(hb + c) = (u32x2){pk2(h[j].x, h[j].y), pk2(h[j].z, h[j].w)};
        }
        const float rinv2 = rsqrtf(row_sumsq(h) * (1.f / DM) + RMS_EPS);
        modulate_store(h, rinv2, p.g_ffn_pre + l * DM, mv + 3072, mv + 4096, U + (size_t)r * DM, lane);
        {
            unsigned char* u8 = p.ws + AM_U8 + (size_t)r * DM;
#pragma unroll
            for (int j = 0; j < 4; ++j) {
                const int c = lane * 4 + 256 * j;
                const f32x4 gg = *(const f32x4*)(p.g_ffn_pre + l * DM + c), s1 = *(const f32x4*)(mv + 4096 + c), s0 = *(const f32x4*)(mv + 3072 + c);
                const f32x4 o = h[j] * rinv2 * gg * (s1 + 1.f) + s0;
                *(unsigned*)(u8 + c) = pk4_fp8(o.x, o.y, o.z, o.w);
            }
        }
    }
}

constexpr int MOE_LDS_OFF = 65536;
__device__ __forceinline__ void moe_tables(const Params& p, LAS unsigned char* lds, int l, int row_lo) {
    LAS int* cnt = (LAS int*)(lds + MOE_LDS_OFF); LAS int* tp = cnt + 80; LAS int* sp = tp + 80;
    const int tid = threadIdx.x;
    if (tid < 64) cnt[tid] = ((const int*)(p.ws + OFF_CNT))[l * 64 + tid];
    if (tid == 64) cnt[64] = TT - row_lo;
    __syncthreads();
    if (tid == 0) {
        int a = 0, s = 0;
        for (int e = 0; e < 65; ++e) { tp[e] = a; sp[e] = s; a += (cnt[e] + 127) >> 7; s += cnt[e]; }
        tp[65] = a;
    }
    __syncthreads();
}

__device__ __forceinline__ void ph_rowpassB(const Params& p, LAS unsigned char* lds, int l, int row_lo) {
    moe_tables(p, lds, l, row_lo);
    LAS int* sp = (LAS int*)(lds + MOE_LDS_OFF) + 160;
    const int lane = threadIdx.x & 63, gw = blockIdx.x * 4 + (threadIdx.x >> 6), ngw = gridDim.x * 4;
    const float* mod = (const float*)(p.ws + OFF_MOD) + (size_t)l * 3 * 6144;
    const unsigned char* YR = p.ws + AM_YR;
    const int* tokslot = (const int*)(p.ws + OFF_TOKSLOT); const float* W8 = (const float*)(p.ws + OFF_W8);
    bf16* U = (bf16*)(p.ws + OFF_U);
    const int c0 = lane * 16;
    for (int r = row_lo + gw; r < TT; r += ngw) {
        int ts = 0; float wv = 0.f;
        if (lane < 8) { ts = tokslot[(size_t)r * 8 + lane]; wv = W8[(size_t)r * 8 + lane]; }
        const int myslot = sp[ts >> 20] + (ts & 0xfffff);
        float f[16];
#pragma unroll
        for (int i = 0; i < 16; ++i) f[i] = 0.f;
#pragma unroll
        for (int k = 0; k < 9; ++k) {
            size_t slot; float wk = 1.f / Y8SC;
            if (k < 8) { slot = (size_t)__shfl(myslot, k); wk = __shfl(wv, k) * (1.f / Y8SC); } else slot = (size_t)TT * 8 + r;
            const u32x4 a = *(const u32x4*)(YR + slot * DM + c0);
            const unsigned aw[4] = {a.x, a.y, a.z, a.w};
#pragma unroll
            for (int q = 0; q < 4; ++q) {
                const f32x2 lo = __builtin_amdgcn_cvt_pk_f32_fp8((int)aw[q], false), hi2 = __builtin_amdgcn_cvt_pk_f32_fp8((int)aw[q], true);
                f[q * 4 + 0] += wk * lo.x; f[q * 4 + 1] += wk * lo.y; f[q * 4 + 2] += wk * hi2.x; f[q * 4 + 3] += wk * hi2.y;
            }
        }
        float ss = 0.f;
#pragma unroll
        for (int i = 0; i < 16; ++i) ss += f[i] * f[i];
        const float rinv = rsqrtf(wave_sum(ss) * (1.f / DM) + RMS_EPS);
        const float* mv = mod + (size_t)modvec(r) * 6144;
        bf16* hb = hl_buf(p, r);
        float h[16];
        {
            const u32x4 ha = *(const u32x4*)(hb + c0), hb2 = *(const u32x4*)(hb + c0 + 8);
            const unsigned hw[8] = {ha.x, ha.y, ha.z, ha.w, hb2.x, hb2.y, hb2.z, hb2.w};
#pragma unroll
            for (int i = 0; i < 8; ++i) { h[2 * i] = bflo(hw[i]); h[2 * i + 1] = bfhi(hw[i]); }
        }
#pragma unroll
        for (int q = 0; q < 4; ++q) {
            const int c = c0 + q * 4;
            const f32x4 gg = *(const f32x4*)(p.g_ffn_post + l * DM + c), gt = *(const f32x4*)(mv + 5120 + c);
            const f32x4 fv = {f[q * 4 + 0], f[q * 4 + 1], f[q * 4 + 2], f[q * 4 + 3]};
            const f32x4 hv = {h[q * 4 + 0], h[q * 4 + 1], h[q * 4 + 2], h[q * 4 + 3]};
            const f32x4 o = hv + gt * (fv * rinv * gg);
            h[q * 4 + 0] = o.x; h[q * 4 + 1] = o.y; h[q * 4 + 2] = o.z; h[q * 4 + 3] = o.w;
        }
        if (l == 1) {
            float* orow = p.out + (size_t)(r - TC) * DM + c0;
#pragma unroll
            for (int q = 0; q < 4; ++q) *(f32x4*)(orow + q * 4) = (f32x4){h[q * 4 + 0], h[q * 4 + 1], h[q * 4 + 2], h[q * 4 + 3]};
        } else {
            *(u32x4*)(hb + c0) = (u32x4){pk2(h[0], h[1]), pk2(h[2], h[3]), pk2(h[4], h[5]), pk2(h[6], h[7])};
            *(u32x4*)(hb + c0 + 8) = (u32x4){pk2(h[8], h[9]), pk2(h[10], h[11]), pk2(h[12], h[13]), pk2(h[14], h[15])};
        }
        if (l == 0) {
            float s2 = 0.f;
#pragma unroll
            for (int i = 0; i < 16; ++i) s2 += h[i] * h[i];
            const float rinv2 = rsqrtf(wave_sum(s2) * (1.f / DM) + RMS_EPS);
            const float* mv1 = mv + 3 * 6144;
#pragma unroll
            for (int hf = 0; hf < 2; ++hf) {
                const int c = c0 + hf * 8;
                const f32x4 g0 = *(const f32x4*)(p.g_mix_pre + DM + c), g1 = *(const f32x4*)(p.g_mix_pre + DM + c + 4);
                const f32x4 sh0 = *(const f32x4*)(mv1 + c), sh1 = *(const f32x4*)(mv1 + c + 4), sc0 = *(const f32x4*)(mv1 + 1024 + c), sc1 = *(const f32x4*)(mv1 + 1024 + c + 4);
                const f32x4 h0 = {h[hf * 8 + 0], h[hf * 8 + 1], h[hf * 8 + 2], h[hf * 8 + 3]}, h1 = {h[hf * 8 + 4], h[hf * 8 + 5], h[hf * 8 + 6], h[hf * 8 + 7]};
                const f32x4 o0 = h0 * rinv2 * g0 * (sc0 + 1.f) + sh0, o1 = h1 * rinv2 * g1 * (sc1 + 1.f) + sh1;
                *(u32x4*)(U + (size_t)r * DM + c) = (u32x4){pk2(o0.x, o0.y), pk2(o0.z, o0.w), pk2(o1.x, o1.y), pk2(o1.z, o1.w)};
            }
        }
    }
}

__device__ __forceinline__ int stg_col() { const int tid = threadIdx.x; return ((tid & 7) ^ ((tid >> 3) & 7)) * 8; }
__device__ __forceinline__ void plain_ptrs(const bf16* base, int row0, int ld, const bf16* (&pp)[4]) {
    const int tid = threadIdx.x;
    pp[0] = base + (size_t)(row0 + (tid >> 3)) * ld + stg_col();
#pragma unroll
    for (int i = 1; i < 4; ++i) pp[i] = pp[0] + (size_t)(32 * i) * ld;
}

__device__ __forceinline__ void ph_inproj0(const Params& p, LAS unsigned char* lds) {
    unsigned char* ws = p.ws;
    const bf16* U = (const bf16*)(ws + OFF_U); const bf16* W = (const bf16*)(ws + OFF_W_IN_E);
    bf16* Z0 = (bf16*)(ws + A0_Z0); bf16* VGT = (bf16*)(ws + A0_VGT); bf16* QS = (bf16*)(ws + A0_QS); bf16* KS = (bf16*)(ws + A0_KS); bf16* VST = (bf16*)(ws + A0_VST);
    const f32x2* rope = (const f32x2*)(ws + OFF_ROPE);
    const int tid = threadIdx.x, lane = tid & 63, wid = tid >> 6, wr = wid >> 1, wc = wid & 1, fr = lane & 15, fq = lane >> 4;
    constexpr int NTN = 19, NTM = TT / 128;
    auto make = [&](int t, GPtrs& g, int& nk) { int tm, tn; tile_mn(t, NTM, NTN, tm, tn); plain_ptrs(U, tm * 128, DM, g.a); plain_ptrs(W, tn * 128, DM, g.b); nk = DM / 64; };
    auto epi = [&](int t, f32x4 (&acc)[4][4]) {
        int tm, tn; tile_mn(t, NTM, NTN, tm, tn); const int brow = tm * 128, bcol = tn * 128;
        const int cb = bcol + wc * 64;
        LAS unsigned char* wl = lds + 32768 + wid * 8192;
        const int r0 = brow + wr * 64;
        const RowInfo ri0 = rowinfo(r0);
        if (cb < 1024) {
            epi_store_rows(wl, acc, fr, fq, lane, [&](int row) { return Z0 + (size_t)(r0 + row) * Z0P + cb; });
        } else if (cb < 1536) {
            const int c0 = cb - 1024;
            epi_store_cols(wl, acc, fr, fq, lane, [&](int col) { return VGT + (size_t)(c0 + col) * TT + r0; });
        } else if (cb < 2176) {
            const float sc = cb < 2048 ? 0.125f * LOG2E : 1.f;
#pragma unroll
            for (int m = 0; m < 4; ++m) {
                const int pos = ri0.pos + m * 16 + fr;
#pragma unroll
                for (int n = 0; n < 2; ++n)
#pragma unroll
                    for (int j = 0; j < 4; ++j) {
                        const float x1 = acc[m][n][j] * sc, x2 = acc[m][n + 2][j] * sc;
                        if (ri0.lat) { const f32x2 cs = rope[(size_t)pos * 32 + n * 16 + fq * 4 + j]; acc[m][n][j] = x1 * cs.x - x2 * cs.y; acc[m][n + 2][j] = x2 * cs.x + x1 * cs.y; }
                        else { acc[m][n][j] = x1; acc[m][n + 2][j] = x2; }
                    }
                asm volatile("" ::: "memory");
            }
            bf16* dst;
            if (cb < 2048) { const int h = (cb - 1536) >> 6; dst = QS + ((size_t)(ri0.b * 8 + h) * NKEY + ri0.kq) * 64; }
            else { const int h = (cb - 2048) >> 6; dst = KS + ((size_t)(ri0.b * 2 + h) * NKEY + ri0.kq) * 64; }
            epi_store_rows(wl, acc, fr, fq, lane, [&](int row) { return dst + (size_t)row * 64; });
        } else if (cb < 2304) {
            const int h = (cb - 2176) >> 6;
            bf16* dst = VST + (size_t)(ri0.b * 2 + h) * 64 * NKEY + ri0.kq;
            epi_store_cols(wl, acc, fr, fq, lane, [&](int col) { return dst + (size_t)col * NKEY; });
        } else if (cb == 2304) {
#pragma unroll
            for (int m = 0; m < 4; ++m) {
                const int r = r0 + m * 16 + fr;
#pragma unroll
                for (int n = 0; n < 2; ++n) { u32x2 w; w.x = pk2(acc[m][n][0], acc[m][n][1]); w.y = pk2(acc[m][n][2], acc[m][n][3]); *(u32x2*)(Z0 + (size_t)r * Z0P + 1024 + n * 16 + fq * 4) = w; }
            }
        }
    };
    gemm_tiles<true>(lds, vcu_id(), NTM * NTN, gridDim.x, make, epi);
}

__device__ __forceinline__ void ph_outproj(const Params& p, LAS unsigned char* lds, const bf16* MIX, const bf16* W, float* Y, int row_lo) {
    const int tid = threadIdx.x, lane = tid & 63, wid = tid >> 6, wr = wid >> 1, wc = wid & 1, fr = lane & 15, fq = lane >> 4;
    const int tm0 = row_lo / 128, ntm = TT / 128 - tm0;
    auto make = [&](int t, GPtrs& g, int& nk) { int tm, tn; tile_mn(t, ntm, 8, tm, tn); plain_ptrs(MIX, (tm0 + tm) * 128, DM, g.a); plain_ptrs(W, tn * 128, DM, g.b); nk = DM / 64; };
    auto epi = [&](int t, f32x4 (&acc)[4][4]) {
        int tm, tn; tile_mn(t, ntm, 8, tm, tn); tm += tm0; const int brow = tm * 128, bcol = tn * 128;
#pragma unroll
        for (int m = 0; m < 4; ++m) {
            const int r = brow + wr * 64 + m * 16 + fr;
#pragma unroll
            for (int n = 0; n < 4; ++n) *(f32x4*)(Y + (size_t)r * DM + bcol + wc * 64 + n * 16 + fq * 4) = acc[m][n];
        }
    };
    gemm_tiles<true, 16>(lds, vcu_id(), ntm * 8, gridDim.x, make, epi);
}

template <int DQK, int DV>
__device__ __forceinline__ void attn_item(LAS unsigned char* lds, const bf16* Qg, const bf16* Kg, const bf16* VTg, int a1, int b0, int b1, int qpos0,
                                          float m_init, float l_init, bf16* Og, int o_pitch) {
    constexpr int KPB = DQK * 2, NS = DQK / 16, NDV = DV / 32, KCH = DQK / 8, KBYTES = 32 * KPB, VBYTES = DV * 64, KN = 32 * KCH / 256, VN = DV * 4 / 256;
    static_assert((KN == 3 && VN == 2) || (KN == 1 && VN == 1), "piece counts");
    const int tid = threadIdx.x, lane = tid & 63, wid = tid >> 6, ql = lane & 31, hi = lane >> 5;
    LAS unsigned char* Kb0 = lds; LAS unsigned char* Vb0 = lds + 2 * KBYTES;
    asm volatile("s_waitcnt vmcnt(0) lgkmcnt(0)" ::: "memory");
    __builtin_amdgcn_s_barrier();
    asm volatile("" ::: "memory");
    bf16x8 qf[NS];
    {
        const bf16* qrow = Qg + (size_t)(wid * 32 + ql) * DQK + hi * 8;
#pragma unroll
        for (int s = 0; s < NS; ++s) qf[s] = *(const bf16x8*)(qrow + s * 16);
    }
    unsigned koff[KN], voff[VN];
#pragma unroll
    for (int i = 0; i < KN; ++i) { const int pz = tid + 256 * i, key = pz / KCH, ch = pz % KCH; koff[i] = (unsigned)(key * DQK + (((ch & ~7) | ((ch & 7) ^ ((key >> 1) & 7))) * 8)); }
#pragma unroll
    for (int i = 0; i < VN; ++i) { const int pz = tid + 256 * i, dv = pz >> 2, ch = pz & 3; voff[i] = (unsigned)(dv * NKEY + ((ch ^ ((dv >> 2) & 3)) * 8)); }
    const int ntot = a1 + (b1 - b0);
#define ATTN_KT(it_) ((it_) < a1 ? (it_) : b0 + ((it_) - a1))
#define ATTN_DMA_K(IT_) do { const int kt_ = ATTN_KT(IT_); _Pragma("unroll") for (int i_ = 0; i_ < KN; ++i_) glds16(Kg + (size_t)kt_ * 32 * DQK + koff[i_], Kb0 + ((IT_) & 1) * KBYTES + (tid + 256 * i_) * 16); } while (0)
#define ATTN_DMA_V(IT_) do { const int kt_ = ATTN_KT(IT_); _Pragma("unroll") for (int i_ = 0; i_ < VN; ++i_) glds16(VTg + (size_t)kt_ * 32 + voff[i_], Vb0 + ((IT_) & 1) * VBYTES + (tid + 256 * i_) * 16); } while (0)
    f32x16 o[NDV];
#pragma unroll
    for (int d = 0; d < NDV; ++d)
#pragma unroll
        for (int r = 0; r < 16; ++r) o[d][r] = 0.f;
    float mrun = m_init, lrun = l_init;
    const int swk = (ql >> 1) & 7, swv = (ql >> 2) & 3;
    const LAS unsigned char* kfrag = Kb0 + ql * KPB; const LAS unsigned char* vfrag = Vb0 + ql * 64;
#define ATTN_QK(P_, IT_) do { \
        _Pragma("unroll") for (int r_ = 0; r_ < 16; ++r_) P_[r_] = 0.f; \
        const LAS unsigned char* kc_ = kfrag + ((IT_) & 1) * KBYTES; \
        _Pragma("unroll") for (int s_ = 0; s_ < NS; ++s_) { \
            const int c_ = 2 * s_ + hi; \
            const bf16x8 k0_ = *(const LAS bf16x8*)(kc_ + ((c_ & ~7) | ((c_ & 7) ^ swk)) * 16); \
            P_ = __builtin_amdgcn_mfma_f32_32x32x16_bf16(k0_, qf[s_], P_, 0, 0, 0); } \
        if ((IT_) >= a1) { const int kbase_ = ATTN_KT(IT_) * 32 - CTX, qpos_ = qpos0 + wid * 32 + ql; \
            _Pragma("unroll") for (int r_ = 0; r_ < 16; ++r_) { const int d0_ = qpos_ - (kbase_ + crow(r_, hi)); if (d0_ > 128 || d0_ < -128) P_[r_] = -1e30f; } } } while (0)
#define ATTN_PK4(P, BASE, OUT) do { const unsigned a0_ = pk2(P[BASE + 0], P[BASE + 1]), a1_ = pk2(P[BASE + 2], P[BASE + 3]), b0_ = pk2(P[BASE + 4], P[BASE + 5]), b1_ = pk2(P[BASE + 6], P[BASE + 7]); \
        const auto r0_ = __builtin_amdgcn_permlane32_swap(a0_, b0_, false, false); const auto r1_ = __builtin_amdgcn_permlane32_swap(a1_, b1_, false, false); \
        OUT = mk8((u32x4){r0_[0], r1_[0], r0_[1], r1_[1]}); } while (0)
#define ATTN_STEP(C_, N_, IT_) do { \
          \
          \
        asm volatile("s_waitcnt vmcnt(0) lgkmcnt(0)" ::: "memory"); __builtin_amdgcn_s_barrier(); asm volatile("" ::: "memory"); \
        if ((IT_) + 2 < ntot) ATTN_DMA_K((IT_) + 2); \
        if ((IT_) + 1 < ntot) ATTN_DMA_V((IT_) + 1); \
        if ((IT_) + 1 < ntot) ATTN_QK(N_, (IT_) + 1); \
        float mx_ = C_[0]; \
        _Pragma("unroll") for (int r_ = 1; r_ < 16; ++r_) mx_ = fmaxf(mx_, C_[r_]); \
        mx_ = fmaxf(mx_, __shfl_xor(mx_, 32)); \
        if (__any(mx_ > mrun + 8.f)) { const float mn_ = fmaxf(mrun, mx_), alpha_ = ex2(mrun - mn_); mrun = mn_; lrun *= alpha_; \
            _Pragma("unroll") for (int d_ = 0; d_ < NDV; ++d_) _Pragma("unroll") for (int r_ = 0; r_ < 16; ++r_) o[d_][r_] *= alpha_; } \
        float rs_ = 0.f; \
        _Pragma("unroll") for (int r_ = 0; r_ < 16; ++r_) { C_[r_] = ex2(C_[r_] - mrun); rs_ += C_[r_]; } \
        rs_ += __shfl_xor(rs_, 32); lrun += rs_; \
        bf16x8 pf_[2]; \
        ATTN_PK4(C_, 0, pf_[0]); ATTN_PK4(C_, 8, pf_[1]); \
        const LAS unsigned char* vc_ = vfrag + ((IT_) & 1) * VBYTES; \
        _Pragma("unroll") for (int d_ = 0; d_ < NDV; ++d_) { _Pragma("unroll") for (int kk_ = 0; kk_ < 2; ++kk_) { \
            const bf16x8 vf_ = *(const LAS bf16x8*)(vc_ + d_ * 32 * 64 + (((2 * kk_ + hi) ^ swv) * 16)); \
            o[d_] = __builtin_amdgcn_mfma_f32_32x32x16_bf16(vf_, pf_[kk_], o[d_], 0, 0, 0); } } } while (0)
    ATTN_DMA_K(0); ATTN_DMA_V(0);
    asm volatile("s_waitcnt vmcnt(0) lgkmcnt(0)" ::: "memory"); __builtin_amdgcn_s_barrier(); asm volatile("" ::: "memory");
    if (ntot > 1) ATTN_DMA_K(1);
    f32x16 pA, pB;
    ATTN_QK(pA, 0);
    int it = 0;
    for (; it + 1 < ntot; it += 2) {
        ATTN_STEP(pA, pB, it);
        ATTN_STEP(pB, pA, it + 1);
    }
    if (it < ntot) ATTN_STEP(pA, pB, it);
#undef ATTN_STEP
#undef ATTN_PK4
#undef ATTN_QK
#undef ATTN_KT
#undef ATTN_DMA_K
#undef ATTN_DMA_V
    const float inv = 1.f / lrun;
    bf16* orow = Og + (size_t)(wid * 32 + ql) * o_pitch;
#pragma unroll
    for (int d = 0; d < NDV; ++d)
#pragma unroll
        for (int g = 0; g < 4; ++g) {
            u32x2 w; w.x = pk2(o[d][g * 4 + 0] * inv, o[d][g * 4 + 1] * inv); w.y = pk2(o[d][g * 4 + 2] * inv, o[d][g * 4 + 3] * inv);
            *(u32x2*)(orow + d * 32 + 8 * g + 4 * hi) = w;
        }
}

constexpr int GA_CUM = 0, GA_ALOW = 16384, GA_WA = 20480, GA_BA = 24576, GA_QT = 24832, GA_TOT = 25856, GA_END = 26112;
__device__ __forceinline__ void gla_cum(const Params& p, LAS unsigned char* lds, const bf16* Z0, int r0, int h, int dir) {
    const int tid = threadIdx.x;
    LAS float* cum = (LAS float*)(lds + GA_CUM); LAS float* alow = (LAS float*)(lds + GA_ALOW); LAS float* wa = (LAS float*)(lds + GA_WA);
    LAS float* ba = (LAS float*)(lds + GA_BA); LAS float* qt = (LAS float*)(lds + GA_QT); LAS float* tot = (LAS float*)(lds + GA_TOT);
    {
        const int t = tid >> 2, i4 = (tid & 3) * 4;
        const u32x2 w = *(const u32x2*)(Z0 + (size_t)(r0 + t) * Z0P + 1024 + dir * 16 + i4);
        alow[t * 16 + i4 + 0] = bflo(w.x); alow[t * 16 + i4 + 1] = bfhi(w.x); alow[t * 16 + i4 + 2] = bflo(w.y); alow[t * 16 + i4 + 3] = bfhi(w.y);
#pragma unroll
        for (int q = 0; q < 4; ++q) { const int idx = tid * 4 + q, i = idx >> 6, j = idx & 63; wa[idx] = p.gla_wa2[(size_t)(dir * 16 + i) * 256 + h * 64 + j]; }
        if (tid < 64) ba[tid] = p.gla_ba[dir * 256 + h * 64 + tid];
    }
    __syncthreads();
    const int j = tid & 63, tq = tid >> 6;
    float la[16], wj[16];
#pragma unroll
    for (int i = 0; i < 16; ++i) wj[i] = wa[i * 64 + j];
    const float bj = ba[j];
#pragma unroll
    for (int tt = 0; tt < 16; ++tt) {
        const int t = tq * 16 + tt;
        float x = bj;
#pragma unroll
        for (int q = 0; q < 4; ++q) { const f32x4 a = *(const LAS f32x4*)(alow + t * 16 + q * 4);
            x += a.x * wj[q * 4] + a.y * wj[q * 4 + 1] + a.z * wj[q * 4 + 2] + a.w * wj[q * 4 + 3]; }
        la[tt] = (fminf(x, 0.f) - __logf(1.f + __expf(-fabsf(x)))) * (1.f / 16.f);
    }
    float run = 0.f;
    if (dir == 0) {
#pragma unroll
        for (int tt = 0; tt < 16; ++tt) { run += la[tt]; cum[(tq * 16 + tt) * 64 + j] = run; }
    } else {
#pragma unroll
        for (int tt = 15; tt >= 0; --tt) { run += la[tt]; cum[(tq * 16 + tt) * 64 + j] = run; }
    }
    qt[tq * 64 + j] = run;
    __syncthreads();
    float off = 0.f, total = 0.f;
#pragma unroll
    for (int q = 0; q < 4; ++q) { const float v = qt[q * 64 + j]; total += v; if (dir == 0 ? (q < tq) : (q > tq)) off += v; }
#pragma unroll
    for (int tt = 0; tt < 16; ++tt) cum[(tq * 16 + tt) * 64 + j] += off;
    if (tq == 0) tot[j] = total;
    __syncthreads();
}

__device__ __forceinline__ int gla_row0(int b, int cc) { return cc < 4 ? b * CTX + cc * 64 : TC + b * SEQ + (cc - 4) * 64; }
__device__ __forceinline__ int gla_step(int cc, int dir) { return dir == 0 ? cc : (cc < 4 ? 3 - cc : 4 + (131 - cc)); }

__device__ __forceinline__ void gla_g1_item(const Params& p, LAS unsigned char* lds, int item) {
    unsigned char* ws = p.ws;
    const bf16* Z0 = (const bf16*)(ws + A0_Z0); const bf16* VGT = (const bf16*)(ws + A0_VGT);
    bf16* GS = (bf16*)(ws + A0_GS); float* GD = (float*)(ws + A0_GD);
    const int cc = item % NSTEP, rest = item / NSTEP, dir = rest & 1, h = (rest >> 1) & 3, b = rest >> 3;
    const int r0 = gla_row0(b, cc), step = gla_step(cc, dir), chain = (b * 4 + h) * 2 + dir;
    const int tid = threadIdx.x, lane = tid & 63, wid = tid >> 6, fr = lane & 15, fq = lane >> 4;
    __syncthreads();
    gla_cum(p, lds, Z0, r0, h, dir);
    LAS float* cum = (LAS float*)(lds + GA_CUM); LAS float* tot = (LAS float*)(lds + GA_TOT);
    LAS bf16* KT = (LAS bf16*)(lds + GA_END);
    {
        const int t = tid >> 2, d0 = (tid & 3) * 16;
        const u32x4 w0 = *(const u32x4*)(Z0 + (size_t)(r0 + t) * Z0P + 256 + h * 64 + d0), w1 = *(const u32x4*)(Z0 + (size_t)(r0 + t) * Z0P + 256 + h * 64 + d0 + 8);
        const unsigned ww[8] = {w0.x, w0.y, w0.z, w0.w, w1.x, w1.y, w1.z, w1.w};
#pragma unroll
        for (int i = 0; i < 8; ++i) {
            const int d = d0 + 2 * i;
            KT[d * 72 + t] = f2bf(bflo(ww[i]) * __expf(tot[d] - cum[t * 64 + d]));
            KT[(d + 1) * 72 + t] = f2bf(bfhi(ww[i]) * __expf(tot[d + 1] - cum[t * 64 + d + 1]));
        }
    }
    if (tid < 64) GD[((size_t)chain * NSTEP + step) * 64 + tid] = __expf(tot[tid]);
    __syncthreads();
    f32x4 acc[2][4];
#pragma unroll
    for (int m = 0; m < 2; ++m)
#pragma unroll
        for (int n = 0; n < 4; ++n) acc[m][n] = (f32x4){0.f, 0.f, 0.f, 0.f};
#pragma unroll
    for (int ks = 0; ks < 2; ++ks) {
        bf16x8 af[2], bfr[4];
#pragma unroll
        for (int m = 0; m < 2; ++m) af[m] = *(const bf16x8*)(VGT + (size_t)(h * 128 + wid * 32 + m * 16 + fr) * TT + r0 + ks * 32 + fq * 8);
#pragma unroll
        for (int n = 0; n < 4; ++n) bfr[n] = *(const LAS bf16x8*)(KT + (n * 16 + fr) * 72 + ks * 32 + fq * 8);
#pragma unroll
        for (int m = 0; m < 2; ++m)
#pragma unroll
            for (int n = 0; n < 4; ++n) acc[m][n] = __builtin_amdgcn_mfma_f32_16x16x32_bf16(bfr[n], af[m], acc[m][n], 0, 0, 0);
    }
    bf16* dst = GS + ((size_t)chain * NSTEP + step) * 8192;
#pragma unroll
    for (int m = 0; m < 2; ++m)
#pragma unroll
        for (int n = 0; n < 4; ++n) *(u32x2*)(dst + (size_t)(wid * 32 + m * 16 + fr) * 64 + n * 16 + fq * 4) = (u32x2){pk2(acc[m][n][0], acc[m][n][1]), pk2(acc[m][n][2], acc[m][n][3])};
}

__device__ __forceinline__ void ph_gla_scan(const Params& p) {
    unsigned* GS = (unsigned*)(p.ws + A0_GS); const float* GD = (const float*)(p.ws + A0_GD);
    for (int idx = blockIdx.x * 256 + threadIdx.x; idx < 16 * 4096; idx += gridDim.x * 256) {
        const int chain = idx >> 12, e2 = idx & 4095, dk = (e2 & 31) * 2;
        unsigned* g = GS + (size_t)chain * NSTEP * 4096 + e2;
        const f32x2* d = (const f32x2*)(GD + (size_t)chain * NSTEP * 64 + dk);
        float s0 = 0.f, s1 = 0.f;
#pragma unroll 12
        for (int s = 0; s < NSTEP; ++s) {
            const unsigned t = g[(size_t)s * 4096]; const f32x2 dec = d[s * 32];
            g[(size_t)s * 4096] = pk2(s0, s1);
            s0 = dec.x * s0 + bflo(t); s1 = dec.y * s1 + bfhi(t);
        }
    }
}

__device__ __forceinline__ void gla_g3_item(const Params& p, LAS unsigned char* lds, int item) {
    unsigned char* ws = p.ws;
    const bf16* Z0 = (const bf16*)(ws + A0_Z0); const bf16* VGT = (const bf16*)(ws + A0_VGT);
    const bf16* GS = (const bf16*)(ws + A0_GS); bf16* MIX = (bf16*)(ws + A0_MIX);
    const int cc = item % NSTEP, rest = item / NSTEP, h = rest & 3, b = rest >> 2;
    const int r0 = gla_row0(b, cc);
    const int tid = threadIdx.x, lane = tid & 63, wid = tid >> 6, fr = lane & 15, fq = lane >> 4;
    LAS bf16* QT = (LAS bf16*)(lds + GA_END);
    LAS bf16* QI = (LAS bf16*)(lds + GA_END + 9216);
    LAS bf16* KT = (LAS bf16*)(lds + GA_END + 18432);
    LAS bf16* PP = (LAS bf16*)(lds);
    f32x4 o[4][2];
#pragma unroll
    for (int m = 0; m < 4; ++m)
#pragma unroll
        for (int n = 0; n < 2; ++n) o[m][n] = (f32x4){0.f, 0.f, 0.f, 0.f};
    for (int dir = 0; dir < 2; ++dir) {
        const int step = gla_step(cc, dir), chain = (b * 4 + h) * 2 + dir;
        __syncthreads();
        gla_cum(p, lds, Z0, r0, h, dir);
        LAS float* cum = (LAS float*)(lds + GA_CUM); LAS float* tot = (LAS float*)(lds + GA_TOT);
        {
            const int t = tid >> 2, d0 = (tid & 3) * 16;
            const bf16* zr = Z0 + (size_t)(r0 + t) * Z0P + h * 64 + d0;
            const u32x4 q0 = *(const u32x4*)(zr), q1 = *(const u32x4*)(zr + 8), k0 = *(const u32x4*)(zr + 256), k1 = *(const u32x4*)(zr + 264);
            const unsigned qq[8] = {q0.x, q0.y, q0.z, q0.w, q1.x, q1.y, q1.z, q1.w}, kk[8] = {k0.x, k0.y, k0.z, k0.w, k1.x, k1.y, k1.z, k1.w};
            unsigned oqt[8], oqi[8], okt[8];
#pragma unroll
            for (int i = 0; i < 8; ++i) {
                const int d = d0 + 2 * i;
                const float c0 = cum[t * 64 + d], c1 = cum[t * 64 + d + 1], t0 = tot[d], t1 = tot[d + 1];
                const float qa = bflo(qq[i]), qb = bfhi(qq[i]), ka = bflo(kk[i]), kb = bfhi(kk[i]);
                oqt[i] = pk2(qa * __expf(c0 - t0), qb * __expf(c1 - t1));
                oqi[i] = pk2(qa * __expf(c0), qb * __expf(c1));
                okt[i] = pk2(ka * __expf(t0 - c0), kb * __expf(t1 - c1));
            }
            *(LAS u32x4*)(QT + t * 72 + d0) = (u32x4){oqt[0], oqt[1], oqt[2], oqt[3]}; *(LAS u32x4*)(QT + t * 72 + d0 + 8) = (u32x4){oqt[4], oqt[5], oqt[6], oqt[7]};
            *(LAS u32x4*)(QI + t * 72 + d0) = (u32x4){oqi[0], oqi[1], oqi[2], oqi[3]}; *(LAS u32x4*)(QI + t * 72 + d0 + 8) = (u32x4){oqi[4], oqi[5], oqi[6], oqi[7]};
            *(LAS u32x4*)(KT + t * 72 + d0) = (u32x4){okt[0], okt[1], okt[2], okt[3]}; *(LAS u32x4*)(KT + t * 72 + d0 + 8) = (u32x4){okt[4], okt[5], okt[6], okt[7]};
        }
        __syncthreads();
        {
            f32x4 sa[4];
#pragma unroll
            for (int m = 0; m < 4; ++m) sa[m] = (f32x4){0.f, 0.f, 0.f, 0.f};
#pragma unroll
            for (int ks = 0; ks < 2; ++ks) {
                const bf16x8 kf = *(const LAS bf16x8*)(KT + (wid * 16 + fr) * 72 + ks * 32 + fq * 8);
#pragma unroll
                for (int m = 0; m < 4; ++m) {
                    const bf16x8 qfm = *(const LAS bf16x8*)(QT + (m * 16 + fr) * 72 + ks * 32 + fq * 8);
                    sa[m] = __builtin_amdgcn_mfma_f32_16x16x32_bf16(kf, qfm, sa[m], 0, 0, 0);
                }
            }
#pragma unroll
            for (int m = 0; m < 4; ++m) {
                const int t = m * 16 + fr;
                float v[4];
#pragma unroll
                for (int jj = 0; jj < 4; ++jj) { const int j = wid * 16 + fq * 4 + jj; const bool keep = dir == 0 ? (j <= t) : (j >= t); v[jj] = keep ? sa[m][jj] : 0.f; }
                *(LAS u32x2*)(PP + t * 72 + wid * 16 + fq * 4) = (u32x2){pk2(v[0], v[1]), pk2(v[2], v[3])};
            }
        }
        __syncthreads();
        const bf16* Sg = GS + ((size_t)chain * NSTEP + step) * 8192;
#pragma unroll
        for (int ks = 0; ks < 2; ++ks) {
            bf16x8 vfr[2], sfr[2];
#pragma unroll
            for (int n = 0; n < 2; ++n) {
                const int dv = wid * 32 + n * 16 + fr;
                vfr[n] = *(const bf16x8*)(VGT + (size_t)(h * 128 + dv) * TT + r0 + ks * 32 + fq * 8);
                sfr[n] = *(const bf16x8*)(Sg + (size_t)dv * 64 + ks * 32 + fq * 8);
            }
#pragma unroll
            for (int m = 0; m < 4; ++m) {
                const bf16x8 pfm = *(const LAS bf16x8*)(PP + (m * 16 + fr) * 72 + ks * 32 + fq * 8);
                const bf16x8 qim = *(const LAS bf16x8*)(QI + (m * 16 + fr) * 72 + ks * 32 + fq * 8);
#pragma unroll
                for (int n = 0; n < 2; ++n) {
                    o[m][n] = __builtin_amdgcn_mfma_f32_16x16x32_bf16(vfr[n], pfm, o[m][n], 0, 0, 0);
                    o[m][n] = __builtin_amdgcn_mfma_f32_16x16x32_bf16(sfr[n], qim, o[m][n], 0, 0, 0);
                }
            }
        }
    }
    __syncthreads();
    LAS float* red = (LAS float*)(lds + GA_END + 27648);
#pragma unroll
    for (int m = 0; m < 4; ++m) {
        float s = 0.f;
#pragma unroll
        for (int n = 0; n < 2; ++n)
#pragma unroll
            for (int j = 0; j < 4; ++j) s += o[m][n][j] * o[m][n][j];
        s += __shfl_xor(s, 16); s += __shfl_xor(s, 32);
        if (fq == 0) red[wid * 64 + m * 16 + fr] = s;
    }
    __syncthreads();
#pragma unroll
    for (int m = 0; m < 4; ++m) {
        const int t = m * 16 + fr;
        const float ss = red[t] + red[64 + t] + red[128 + t] + red[192 + t];
        const float rinv = rsqrtf(ss * (1.f / 128.f) + RMS_EPS);
        const int r = r0 + t;
#pragma unroll
        for (int n = 0; n < 2; ++n) {
            const int dv = wid * 32 + n * 16 + fq * 4;
            const u32x2 gw = *(const u32x2*)(Z0 + (size_t)r * Z0P + 512 + h * 128 + dv);
            const f32x4 ng = *(const f32x4*)(p.gla_norm + dv);
            const float g0 = bflo(gw.x), g1 = bfhi(gw.x), g2 = bflo(gw.y), g3 = bfhi(gw.y);
            const float y0 = o[m][n][0] * rinv * ng.x * siluf(g0), y1 = o[m][n][1] * rinv * ng.y * siluf(g1);
            const float y2 = o[m][n][2] * rinv * ng.z * siluf(g2), y3 = o[m][n][3] * rinv * ng.w * siluf(g3);
            *(u32x2*)(MIX + (size_t)r * DM + h * 128 + dv) = (u32x2){pk2(y0, y1), pk2(y2, y3)};
        }
    }
}

__device__ __forceinline__ void ph_swa_g1(const Params& p, LAS unsigned char* lds) {
    unsigned char* ws = p.ws;
    const bf16* QS = (const bf16*)(ws + A0_QS); const bf16* KS = (const bf16*)(ws + A0_KS); const bf16* VST = (const bf16*)(ws + A0_VST); bf16* MIX = (bf16*)(ws + A0_MIX);
    constexpr int N_SWA = 2 * 8 * 66, N_G1 = 2 * 4 * 2 * NSTEP;
    for (int item = blockIdx.x; item < N_SWA + N_G1; item += gridDim.x) {
        if (item < N_SWA) {
            const int qt = item % 66, rest = item / 66, h = rest & 7, b = rest >> 3, kvh = h >> 2;
            const bf16* Qg = QS + ((size_t)(b * 8 + h) * NKEY + qt * 128) * 64;
            const bf16* Kg = KS + (size_t)(b * 2 + kvh) * NKEY * 64;
            const bf16* Vg = VST + (size_t)(b * 2 + kvh) * 64 * NKEY;
            int b0 = 0, b1 = 0, qpos0 = 0, row0;
            if (qt >= 2) { qpos0 = (qt - 2) * 128; const int lo = qpos0 - 128 < 0 ? 0 : qpos0 - 128, hi2 = qpos0 + 256 > SEQ ? SEQ : qpos0 + 256; b0 = 8 + lo / 32; b1 = 8 + hi2 / 32; row0 = TC + b * SEQ + qpos0; }
            else row0 = b * CTX + qt * 128;
            const float sink = p.swa_sink[h] * LOG2E;
            attn_item<64, 64>(lds, Qg, Kg, Vg, 8, b0, b1, qpos0, sink, 1.f, MIX + (size_t)row0 * DM + 512 + h * 64, DM);
        } else gla_g1_item(p, lds, item - N_SWA);
    }
}
__device__ __forceinline__ void ph_gla_g3(const Params& p, LAS unsigned char* lds) {
    for (int item = blockIdx.x; item < 2 * 4 * NSTEP; item += gridDim.x) gla_g3_item(p, lds, item);
}

__device__ __forceinline__ void ph_router(const Params& p, LAS unsigned char* lds, int l, int row_lo) {
    unsigned char* ws = p.ws;
    const bf16* U = (const bf16*)(ws + OFF_U); const bf16* W = (const bf16*)(ws + OFF_W_RT) + (size_t)l * 128 * DM;
    int* cntg = (int*)(ws + OFF_CNT) + l * 64; int* tokslot = (int*)(ws + OFF_TOKSLOT); float* W8 = (float*)(ws + OFF_W8); int* LIST = (int*)(ws + OFF_LIST);
    const int tid = threadIdx.x, lane = tid & 63, wid = tid >> 6, wr = wid >> 1, wc = wid & 1, fr = lane & 15, fq = lane >> 4;
    LAS float* lg = (LAS float*)lds;
    const int tm0 = row_lo / 128;
    auto make = [&](int tm, GPtrs& g, int& nk) { plain_ptrs(U, tm * 128, DM, g.a); plain_ptrs(W, 0, DM, g.b); nk = DM / 64; };
    auto epi = [&](int tm, f32x4 (&acc)[4][4]) {
        const int brow = tm * 128;
        if (wc == 0) {
#pragma unroll
            for (int m = 0; m < 4; ++m)
#pragma unroll
                for (int n = 0; n < 4; ++n)
#pragma unroll
                    for (int j = 0; j < 4; ++j) lg[(wr * 64 + m * 16 + fr) * 65 + n * 16 + fq * 4 + j] = acc[m][n][j];
        }
        __syncthreads();
        LAS float* biasl = (LAS float*)(lds + 34816); LAS int* hist = (LAS int*)(lds + 34816 + 256); LAS int* basel = (LAS int*)(lds + 34816 + 512);
        if (tid < 64) { biasl[tid] = p.b_router[l * 64 + tid]; hist[tid] = 0; }
        __syncthreads();
        int esel[8], lrank[8]; float ssel[8]; float wsum = 0.f;
        if (tid < 128) {
            LAS float* L = lg + tid * 65;
            float gs[8];
#pragma unroll
            for (int g = 0; g < 8; ++g) {
                float m1 = -INFINITY, m2 = -INFINITY;
#pragma unroll
                for (int j = 0; j < 8; ++j) {
                    const int e = g * 8 + j;
                    const float sel = 1.f / (1.f + expf(-L[e])) + biasl[e];
                    L[e] = sel;
                    if (sel > m1) { m2 = m1; m1 = sel; } else if (sel > m2) m2 = sel;
                }
                gs[g] = m1 + m2;
            }
            unsigned allowed = 0u;
#pragma unroll
            for (int g = 0; g < 8; ++g) {
                int rk = 0;
#pragma unroll
                for (int h = 0; h < 8; ++h) rk += (gs[h] > gs[g] || (gs[h] == gs[g] && h < g)) ? 1 : 0;
                if (rk < 4) allowed |= 1u << g;
            }
#pragma unroll
            for (int k = 0; k < 8; ++k) {
                float best = -INFINITY; int bi = 0;
#pragma unroll
                for (int g = 0; g < 8; ++g) {
                    if ((allowed >> g) & 1u) {
#pragma unroll
                        for (int j = 0; j < 8; ++j) { const float v = L[g * 8 + j]; if (v > best) { best = v; bi = g * 8 + j; } }
                    }
                }
                esel[k] = bi; ssel[k] = best - biasl[bi]; wsum += ssel[k]; L[bi] = -INFINITY;
            }
#pragma unroll
            for (int k = 0; k < 8; ++k) lrank[k] = __hip_atomic_fetch_add(hist + esel[k], 1, __ATOMIC_RELAXED, __HIP_MEMORY_SCOPE_WORKGROUP);
        }
        __syncthreads();
        if (tid < 64) { const int c = hist[tid]; basel[tid] = c > 0 ? atomicAdd(cntg + tid, c) : 0; }
        __syncthreads();
        if (tid < 128) {
            const int t = brow + tid; const float wn = 2.5f / wsum;
#pragma unroll
            for (int k = 0; k < 8; ++k) {
                const int e = esel[k], pos = basel[e] + lrank[k];
                tokslot[(size_t)t * 8 + k] = (e << 20) | pos;
                W8[(size_t)t * 8 + k] = ssel[k] * wn;
                LIST[(size_t)e * TT + pos] = t * 8 + k;
            }
        }
    };
    gemm_tiles<false>(lds, tm0 + vcu_id(), TT / 128, gridDim.x, make, epi);
}

__device__ __forceinline__ int moe_find_expert(const LAS int* tp, int mtg) {
    int lo = 0, hi = 64;
    while (lo < hi) { const int mid = (lo + hi + 1) >> 1; if (tp[mid] <= mtg) lo = mid; else hi = mid - 1; }
    return lo;
}
__device__ __forceinline__ void ph_moe1(const Params& p, LAS unsigned char* lds, int l, int row_lo) {
    unsigned char* ws = p.ws;
    moe_tables(p, lds, l, row_lo);
    LAS int* cnt = (LAS int*)(lds + MOE_LDS_OFF); LAS int* tp = cnt + 80; LAS int* sp = tp + 80;
    const bf16* U = (const bf16*)(ws + AM_U8); const bf16* WGU = (const bf16*)(ws + OFF_W_GU); unsigned char* HM = ws + AM_HM;
    const int* LIST = (const int*)(ws + OFF_LIST);
    const int tid = threadIdx.x, lane = tid & 63, wid = tid >> 6, wr = wid >> 1, wc = wid & 1, fr = lane & 15, fq = lane >> 4;
    const int ntiles = tp[65] * 4;
    auto make = [&](int t, GPtrs& g, int& nk) {
        const int mtg = t >> 2, nt = t & 3, e = moe_find_expert(tp, mtg), mt = mtg - tp[e], ce = cnt[e];
        int lv[4];
#pragma unroll
        for (int i = 0; i < 4; ++i) { const int li = mt * 128 + (tid >> 3) + 32 * i; lv[i] = LIST[(size_t)(e < 64 ? e : 0) * TT + (li < ce ? li : 0)]; }
#pragma unroll
        for (int i = 0; i < 4; ++i) {
            const int li = mt * 128 + (tid >> 3) + 32 * i;
            const int tk = li < ce ? (e < 64 ? (lv[i] >> 3) : row_lo + li) : row_lo;
            g.a[i] = U + (size_t)tk * (DM / 2) + stg_col();
        }
        plain_ptrs(WGU + (size_t)e * 512 * (DM / 2), nt * 128, DM / 2, g.b); nk = DM / 128;
    };
    auto epi = [&](int t, f32x4 (&acc)[4][4]) {
        const int mtg = t >> 2, nt = t & 3, e = moe_find_expert(tp, mtg), mt = mtg - tp[e], ce = cnt[e];
        const size_t slot0 = e < 64 ? (size_t)(sp[e] + mt * 128) : (size_t)TT * 8 + row_lo + mt * 128;
        const int hc0 = nt * 64 + wc * 32;
        unsigned char* dump = ws + OFF_DUMP + lane * 64;
        constexpr float isc = 1.f / W8SC;
#pragma unroll
        for (int m = 0; m < 4; ++m) {
            const int i = wr * 64 + m * 16 + fr;
            unsigned char* hrow = (mt * 128 + i < ce) ? HM + (slot0 + i) * 256 + hc0 + fq * 4 : dump;
#pragma unroll
            for (int n = 0; n < 2; ++n) {
                const f32x4 g = acc[m][n] * isc, u = acc[m][n + 2] * (isc * H8SC);
                *(unsigned*)(hrow + n * 16) = pk4_fp8(siluf(g[0]) * u[0], siluf(g[1]) * u[1], siluf(g[2]) * u[2], siluf(g[3]) * u[3]);
            }
        }
    };
    gemm_tiles<true, 8, true>(lds, vcu_id(), ntiles, gridDim.x, make, epi);
}
__device__ __forceinline__ void ph_moe2(const Params& p, LAS unsigned char* lds, int l, int row_lo) {
    unsigned char* ws = p.ws;
    moe_tables(p, lds, l, row_lo);
    LAS int* cnt = (LAS int*)(lds + MOE_LDS_OFF); LAS int* tp = cnt + 80; LAS int* sp = tp + 80;
    const bf16* HM = (const bf16*)(ws + AM_HM); const bf16* WD = (const bf16*)(ws + OFF_W_D);
    const int tid = threadIdx.x, lane = tid & 63, wid = tid >> 6, wr = wid >> 1, wc = wid & 1, fr = lane & 15, fq = lane >> 4;
    const int ntiles = tp[65] * 8;
    auto make = [&](int t, GPtrs& g, int& nk) {
        const int mtg = t >> 3, nt = t & 7, e = moe_find_expert(tp, mtg), mt = mtg - tp[e];
        const size_t slot0 = e < 64 ? (size_t)(sp[e] + mt * 128) : (size_t)TT * 8 + row_lo + mt * 128;
        plain_ptrs(HM, 0, 128, g.a);
#pragma unroll
        for (int i = 0; i < 4; ++i) g.a[i] += slot0 * 128;
        plain_ptrs(WD + (size_t)e * DM * 128, nt * 128, 128, g.b); nk = 256 / 128;
    };
    auto epi = [&](int t, f32x4 (&acc)[4][4]) {
        const int mtg = t >> 3, nt = t & 7, e = moe_find_expert(tp, mtg), mt = mtg - tp[e], ce = cnt[e];
        const size_t slot0 = e < 64 ? (size_t)(sp[e] + mt * 128) : (size_t)TT * 8 + row_lo + mt * 128;
        constexpr float osc = Y8SC / (W8SC * H8SC);
        unsigned char* YR8 = ws + AM_YR; unsigned char* dump = ws + OFF_DUMP + lane * 16;
#pragma unroll
        for (int m = 0; m < 4; ++m) {
            const int i = wr * 64 + m * 16 + fr;
            unsigned char* yrow = (mt * 128 + i < ce) ? YR8 + (slot0 + i) * DM + nt * 128 + wc * 64 + fq * 16 : dump;
            const f32x4 a0 = acc[m][0] * osc, a1 = acc[m][1] * osc, a2 = acc[m][2] * osc, a3 = acc[m][3] * osc;
            *(u32x4*)(yrow) = (u32x4){pk4_fp8(a0[0], a0[1], a0[2], a0[3]), pk4_fp8(a1[0], a1[1], a1[2], a1[3]), pk4_fp8(a2[0], a2[1], a2[2], a2[3]), pk4_fp8(a3[0], a3[1], a3[2], a3[3])};
        }
    };
    gemm_tiles<true, 4, true, true>(lds, vcu_id(), ntiles, gridDim.x, make, epi);
}

__device__ __forceinline__ void ph_inproj1(const Params& p, LAS unsigned char* lds) {
    unsigned char* ws = p.ws;
    const bf16* U = (const bf16*)(ws + OFF_U); const bf16* W = (const bf16*)(ws + OFF_W_IN_O);
    bf16* Z1 = (bf16*)(ws + A1_Z1); bf16* KM = (bf16*)(ws + A1_KM);
    const f32x2* rope = (const f32x2*)(ws + OFF_ROPE);
    const int tid = threadIdx.x, lane = tid & 63, wid = tid >> 6, wr = wid >> 1, wc = wid & 1, fr = lane & 15, fq = lane >> 4;
    constexpr int NTN = 7, NTM = TT / 128;
    auto make = [&](int t, GPtrs& g, int& nk) { int tm, tn; tile_mn(t, NTM, NTN, tm, tn); plain_ptrs(U, tm * 128, DM, g.a); plain_ptrs(W, tn * 128, DM, g.b); nk = DM / 64; };
    auto epi = [&](int t, f32x4 (&acc)[4][4]) {
        int tm, tn; tile_mn(t, NTM, NTN, tm, tn); const int brow = tm * 128, bcol = tn * 128;
        const int cb = bcol + wc * 64;
        LAS unsigned char* wl = lds + 32768 + wid * 8192;
        const int r0 = brow + wr * 64;
        const RowInfo ri0 = rowinfo(r0);
        if (cb < 768) {
            float* ssq = (float*)(ws + OFF_SSQ);
#pragma unroll
            for (int m = 0; m < 4; ++m) {
                float q = 0.f;
#pragma unroll
                for (int n = 0; n < 4; ++n) q += (acc[m][n][0] * acc[m][n][0] + acc[m][n][1] * acc[m][n][1]) + (acc[m][n][2] * acc[m][n][2] + acc[m][n][3] * acc[m][n][3]);
                q += __shfl_xor(q, 16); q += __shfl_xor(q, 32);
                if (fq == 0) ssq[(size_t)(r0 + m * 16 + fr) * 12 + (cb >> 6)] = q;
            }
            epi_store_rows(wl, acc, fr, fq, lane, [&](int row) { return Z1 + (size_t)(r0 + row) * Z1P + cb; });
        } else if (cb == 768) {
#pragma unroll
            for (int m = 0; m < 4; ++m) {
                const int pos = ri0.pos + m * 16 + fr;
#pragma unroll
                for (int n = 0; n < 2; ++n)
#pragma unroll
                    for (int j = 0; j < 4; ++j) {
                        const float x1 = acc[m][n][j], x2 = acc[m][n + 2][j];
                        if (ri0.lat) { const f32x2 cs = rope[(size_t)pos * 32 + n * 16 + fq * 4 + j]; acc[m][n][j] = x1 * cs.x - x2 * cs.y; acc[m][n + 2][j] = x2 * cs.x + x1 * cs.y; }
                    }
                asm volatile("" ::: "memory");
            }
            bf16* dst = KM + ((size_t)(ri0.b * 8) * NKEY + ri0.kq) * 192 + 128;
            epi_store_rows(wl, acc, fr, fq, lane, [&](int row) { return dst + (size_t)row * 192; }, 8, (size_t)NKEY * 192);
        }
    };
    gemm_tiles<true>(lds, vcu_id(), NTM * NTN, gridDim.x, make, epi);
}

__device__ __forceinline__ void ph_mla_up(const Params& p, LAS unsigned char* lds) {
    unsigned char* ws = p.ws;
    const bf16* Z1 = (const bf16*)(ws + A1_Z1); const bf16* WQ = (const bf16*)(ws + OFF_W_UQ); const bf16* WKV = (const bf16*)(ws + OFF_W_UKV);
    bf16* QM = (bf16*)(ws + A1_QM); bf16* KM = (bf16*)(ws + A1_KM); bf16* VTM = (bf16*)(ws + A1_VTM);
    const f32x2* rope = (const f32x2*)(ws + OFF_ROPE);
    const int tid = threadIdx.x, lane = tid & 63, wid = tid >> 6, wr = wid >> 1, wc = wid & 1, fr = lane & 15, fq = lane >> 4;
    LAS float* rsb = (LAS float*)(lds + 66560);
    constexpr int NQ = (TL / 128) * 12, NKV = (TT / 128) * 16;
    constexpr float QSCALE = 0.07216878364870322f * LOG2E;
    auto decode = [&](int t, bool& isq, int& tm, int& tn) { isq = t < NQ; if (isq) { tile_mn(t, TL / 128, 12, tm, tn); tm += 4; } else tile_mn(t - NQ, TT / 128, 16, tm, tn); };
    auto make = [&](int t, GPtrs& g, int& nk) {
        bool isq; int tm, tn; decode(t, isq, tm, tn);
        const int brow = tm * 128, bcol = tn * 128, K = isq ? 512 : 256, acol = isq ? 0 : 512;
        const int par = ((t - vcu_id()) / (int)gridDim.x) & 1;
        if (tid < 128) {
            const float* q = (const float*)(ws + OFF_SSQ) + (size_t)(brow + tid) * 12;
            float ss;
            if (isq) { const f32x4 a = *(const f32x4*)q, b2 = *(const f32x4*)(q + 4); ss = ((a.x + a.y) + (a.z + a.w)) + ((b2.x + b2.y) + (b2.z + b2.w)); }
            else { const f32x4 a = *(const f32x4*)(q + 8); ss = (a.x + a.y) + (a.z + a.w); }
            rsb[par * 128 + tid] = rsqrtf(ss / (float)K + RMS_EPS);
        }
        plain_ptrs(Z1 + acol, brow, Z1P, g.a); plain_ptrs(isq ? WQ : WKV, bcol, K, g.b); nk = K / 64;
    };
    auto epi = [&](int t, f32x4 (&acc)[4][4]) {
        bool isq; int tm, tn; decode(t, isq, tm, tn);
        const int brow = tm * 128, bcol = tn * 128;
        const int par = ((t - vcu_id()) / (int)gridDim.x) & 1;
        const int cb = bcol + wc * 64;
        LAS unsigned char* wl = lds + 32768 + wid * 8192;
        const int r0 = brow + wr * 64;
        const RowInfo ri0 = rowinfo(r0);
        if (isq) {
            const int h = cb / 192, part = (cb % 192) >> 6;
#pragma unroll
            for (int m = 0; m < 4; ++m) {
                const float sc = rsb[par * 128 + wr * 64 + m * 16 + fr] * QSCALE;
                const int pos = ri0.pos + m * 16 + fr;
                if (part < 2) {
#pragma unroll
                    for (int n = 0; n < 4; ++n) acc[m][n] = acc[m][n] * sc;
                } else {
#pragma unroll
                    for (int n = 0; n < 2; ++n)
#pragma unroll
                        for (int j = 0; j < 4; ++j) {
                            const float x1 = acc[m][n][j] * sc, x2 = acc[m][n + 2][j] * sc;
                            const f32x2 cs = rope[(size_t)pos * 32 + n * 16 + fq * 4 + j];
                            acc[m][n][j] = x1 * cs.x - x2 * cs.y; acc[m][n + 2][j] = x2 * cs.x + x1 * cs.y;
                        }
                }
                asm volatile("" ::: "memory");
            }
            bf16* dst = QM + ((size_t)(ri0.b * 8 + h) * SEQ + ri0.pos) * 192 + part * 64;
            epi_store_rows(wl, acc, fr, fq, lane, [&](int row) { return dst + (size_t)row * 192; });
        } else {
            const int h = cb >> 8, part = (cb & 255) >> 6;
#pragma unroll
            for (int m = 0; m < 4; ++m) {
                const float rs = rsb[par * 128 + wr * 64 + m * 16 + fr];
#pragma unroll
                for (int n = 0; n < 4; ++n) acc[m][n] = acc[m][n] * rs;
            }
            if (part < 2) {
                bf16* dst = KM + ((size_t)(ri0.b * 8 + h) * NKEY + ri0.kq) * 192 + part * 64;
                epi_store_rows(wl, acc, fr, fq, lane, [&](int row) { return dst + (size_t)row * 192; });
            } else {
                bf16* dst = VTM + ((size_t)(ri0.b * 8 + h) * 128 + (part - 2) * 64) * NKEY + ri0.kq;
                epi_store_cols(wl, acc, fr, fq, lane, [&](int col) { return dst + (size_t)col * NKEY; });
            }
        }
    };
    gemm_tiles<true>(lds, vcu_id(), NQ + NKV, gridDim.x, make, epi);
}

__device__ __forceinline__ void ph_mla_attn(const Params& p, LAS unsigned char* lds) {
    unsigned char* ws = p.ws;
    const bf16* QM = (const bf16*)(ws + A1_QM); const bf16* KM = (const bf16*)(ws + A1_KM); const bf16* VTM = (const bf16*)(ws + A1_VTM); bf16* MIX = (bf16*)(ws + A1_MIX);
    for (int item = vcu_id(); item < 2 * 8 * 64; item += gridDim.x) {
        const int qt = item & 63, h = (item >> 6) & 7, b = item >> 9;
        const bf16* Qg = QM + ((size_t)(b * 8 + h) * SEQ + qt * 128) * 192;
        const bf16* Kg = KM + (size_t)(b * 8 + h) * NKEY * 192;
        const bf16* Vg = VTM + (size_t)(b * 8 + h) * 128 * NKEY;
        attn_item<192, 128>(lds, Qg, Kg, Vg, NKEY / 32, 0, 0, 0, -1e30f, 0.f, MIX + (size_t)(TC + b * SEQ + qt * 128) * DM + h * 128, DM);
    }
}


#define XB_TMO      128
#define XB_XCNT(j)  (256  + 64 * (j))
#define XB_XSUB(j)  (1280 + 64 * (j))
#define XB_XGEN(j)  (2304 + 64 * (j))
#define XB_TOP      3328
#define XB_TOPGEN   3392
#define XCD_BAR_WORDS 3456
#define XB_SPIN_CAP (1u << 18)
__device__ __forceinline__ unsigned xb_ld(unsigned* p)              { return __hip_atomic_load(p, __ATOMIC_RELAXED, __HIP_MEMORY_SCOPE_AGENT); }
__device__ __forceinline__ unsigned xb_add(unsigned* p, unsigned v) { return __hip_atomic_fetch_add(p, v, __ATOMIC_RELAXED, __HIP_MEMORY_SCOPE_AGENT); }
__device__ __forceinline__ unsigned xb_xcc_id() { return (unsigned)__builtin_amdgcn_s_getreg((3 << 11) | 20) & 0xFu; }
#define XB_SPIN(cond, bar) do { unsigned _sp = 0; while (cond) { __builtin_amdgcn_s_sleep(1); \
    if ((++_sp & 255u) == 0u) { if (xb_ld(&(bar)[XB_TMO])) break; if (_sp > XB_SPIN_CAP) { atomicAdd(&(bar)[XB_TMO], 1u); break; } } } } while (0)
struct XcdBarrier { unsigned* bar; unsigned x; volatile LAS unsigned* st; };
__device__ __forceinline__ XcdBarrier xcd_barrier_post(unsigned* bar, volatile LAS unsigned* st) {
    XcdBarrier b; b.bar = bar; b.x = xb_xcc_id(); b.st = st;
    if (threadIdx.x == 0) (void)xb_add(&bar[XB_XCNT(b.x)], 1u);
    return b;
}
__device__ __forceinline__ void xcd_barrier_complete(unsigned* bar, unsigned x, unsigned& nloc, unsigned& nx) {
    const unsigned G = gridDim.x * gridDim.y * gridDim.z;
    unsigned sum, cnt, mine, sp = 0u;
    for (;;) {
        sum = 0u; cnt = 0u; mine = 0u;
#pragma unroll
        for (unsigned j = 0; j < 16; ++j) { const unsigned c = xb_ld(&bar[XB_XCNT(j)]); sum += c; cnt += (c > 0u) ? 1u : 0u; mine = (j == x) ? c : mine; }
        if (sum == G) break;
        __builtin_amdgcn_s_sleep(1);
        if ((++sp & 255u) == 0u) { if (xb_ld(&bar[XB_TMO])) break; if (sp > XB_SPIN_CAP) { atomicAdd(&bar[XB_TMO], 1u); break; } }
    }
    nloc = mine > 0u ? mine : 1u; nx = cnt > 0u ? cnt : 1u;
}
__device__ __forceinline__ void xcd_barrier(const XcdBarrier& b) {
    asm volatile("s_waitcnt vmcnt(0)" ::: "memory");
    __syncthreads();
    if (threadIdx.x == 0) {
        unsigned* bar = b.bar;
        __builtin_amdgcn_s_waitcnt(0);
        unsigned nloc = b.st[0], nx = b.st[1];
        if (nloc == 0u) { xcd_barrier_complete(bar, b.x, nloc, nx); b.st[0] = nloc; b.st[1] = nx; }
        const unsigned old = xb_add(&bar[XB_XSUB(b.x)], 1u);
        const unsigned gen = old / nloc;
        if (old + 1u == (gen + 1u) * nloc) {
            __builtin_amdgcn_fence(__ATOMIC_RELEASE, "agent");
            asm volatile("s_waitcnt vmcnt(0)" ::: "memory");
            const unsigned og = xb_add(&bar[XB_TOP], 1u);
            const unsigned tg = og / nx;
            if (og + 1u == (tg + 1u) * nx) xb_add(&bar[XB_TOPGEN], 1u);
            else XB_SPIN(xb_ld(&bar[XB_TOPGEN]) == tg, bar);
            __builtin_amdgcn_fence(__ATOMIC_ACQUIRE, "agent");
            xb_add(&bar[XB_XGEN(b.x)], 1u);
            asm volatile("s_waitcnt vmcnt(0)" ::: "memory");
        } else {
            XB_SPIN(xb_ld(&bar[XB_XGEN(b.x)]) == gen, bar);
            __builtin_amdgcn_fence(__ATOMIC_ACQUIRE, "agent");
            asm volatile("s_waitcnt vmcnt(0)" ::: "memory");
        }
    }
    __syncthreads();
}
static_assert(XCD_BAR_WORDS * 4 <= BAR_BYTES, "barrier words");

__device__ __forceinline__ void convert_shared(const Params& p, LAS unsigned char* lds, int l, int nrt) {
    const int v = vcu_id(), G = gridDim.x, nfree = G - nrt;
    if (v >= nrt) for (int it = v - nrt; it < EXP_ITEMS; it += nfree) expert_convert_item(p, lds, l, it);
}

constexpr int NPHASE = 19;
__global__ void __launch_bounds__(256, 2) mega(Params p) {
    extern __shared__ __attribute__((aligned(16))) unsigned char lds_[];
    LAS unsigned char* lds = (LAS unsigned char*)lds_;
    cg::grid_group grid = cg::this_grid();
    unsigned char* ws = p.ws;
    volatile LAS unsigned* bst = (volatile LAS unsigned*)(lds + LDS_BYTES - 16);
    if (threadIdx.x < 4) bst[threadIdx.x] = 0u;
    __syncthreads();
    const XcdBarrier xbar = xcd_barrier_post((unsigned*)(ws + OFF_BAR), bst);
#define GRID_BAR(k) do { if ((k) == 0) grid.sync(); else xcd_barrier(xbar); } while (0)
#ifndef PROBE_REP_MASK
#define PROBE_REP_MASK 0u
#endif
#ifndef PROBE_EXTRA_SYNCS
#define PROBE_EXTRA_SYNCS 0
#endif
#define PHASE(k, body) do { if (p.ph_lo <= (k) && (k) < p.ph_hi) { body; if ((PROBE_REP_MASK >> (k)) & 1u) { xcd_barrier(xbar); body; } if ((k) + 1 < p.ph_hi) GRID_BAR(k); } } while (0)
    for (int i = 0; i < PROBE_EXTRA_SYNCS; ++i) xcd_barrier(xbar);
    PHASE(0, ph_prep(p, lds));
    PHASE(1, ph_modulate0(p));
    PHASE(2, ph_inproj0(p, lds));
    PHASE(3, ph_swa_g1(p, lds));
    PHASE(4, ph_gla_scan(p));
    PHASE(5, ph_gla_g3(p, lds));
    PHASE(6, ph_outproj(p, lds, (const bf16*)(ws + A0_MIX), (const bf16*)(ws + OFF_W_OUT_E), (float*)(ws + A0_Y), 0));
    PHASE(7, ph_rowpassA(p, 0, 0, (const float*)(ws + A0_Y)));
    PHASE(8, { ph_router(p, lds, 0, 0); __syncthreads(); convert_shared(p, lds, 0, TT / 128); });
    PHASE(9, ph_moe1(p, lds, 0, 0));
    PHASE(10, ph_moe2(p, lds, 0, 0));
    PHASE(11, ph_rowpassB(p, lds, 0, 0));
    PHASE(12, ph_inproj1(p, lds));
    PHASE(13, ph_mla_up(p, lds));
    PHASE(14, ph_mla_attn(p, lds));
    PHASE(15, ph_outproj(p, lds, (const bf16*)(ws + A1_MIX), (const bf16*)(ws + OFF_W_OUT_O), (float*)(ws + A1_Y), TC));
    PHASE(16, ph_rowpassA(p, 1, TC, (const float*)(ws + A1_Y)));
    PHASE(17, { ph_router(p, lds, 1, TC); __syncthreads(); convert_shared(p, lds, 1, TL / 128); });
    PHASE(18, ph_moe1(p, lds, 1, TC));
    PHASE(19, ph_moe2(p, lds, 1, TC));
    PHASE(20, ph_rowpassB(p, lds, 1, TC));
}

extern "C" void kernel_launch(void* const* d_in, const int* in_sizes, int n_in, void* d_out, int out_size, void* d_ws, size_t ws_size, hipStream_t stream) {
    static int grid_blocks = 0;
    if (!grid_blocks) {
        int dev = 0, cus = 0, per_cu = 0;
        (void)hipGetDevice(&dev);
        (void)hipDeviceGetAttribute(&cus, hipDeviceAttributeMultiprocessorCount, dev);
        (void)hipFuncSetAttribute((const void*)mega, hipFuncAttributeMaxDynamicSharedMemorySize, LDS_BYTES);
        (void)hipOccupancyMaxActiveBlocksPerMultiprocessor(&per_cu, (const void*)mega, 256, LDS_BYTES);
        if (per_cu > 2) per_cu = 2;
        if (per_cu < 1) per_cu = 1;
        grid_blocks = cus * per_cu;
        if (ws_size < WS_NEED) fprintf(stderr, "kernel_launch: workspace too small: %zu < %zu\n", ws_size, (size_t)WS_NEED);
    }
    Params p{};
    const float** f = (const float**)&p;
    for (int i = 0; i < 30; ++i) f[i] = (const float*)d_in[i];
    p.out = (float*)d_out; p.ws = (unsigned char*)d_ws; p.ph_lo = 0; p.ph_hi = 21;
    (void)hipMemsetAsync((unsigned char*)d_ws + OFF_BAR, 0, BAR_BYTES, stream);
    void* args[] = {&p};
    hipError_t e = hipLaunchCooperativeKernel((const void*)mega, dim3(grid_blocks), dim3(256), args, LDS_BYTES, stream);
    if (e != hipSuccess) fprintf(stderr, "cooperative launch failed: %s (grid %d)\n", hipGetErrorString(e), grid_blocks);
}
```

```cpp
#include <hip/hip_runtime.h>
#include <hip/hip_cooperative_groups.h>
#include <cstdio>
#include <cstdint>
namespace cg = cooperative_groups;

#define LAS __attribute__((address_space(3)))
typedef unsigned short bf16;
typedef short bf16x8 __attribute__((ext_vector_type(8)));
typedef float f32x2 __attribute__((ext_vector_type(2)));
typedef float f32x4 __attribute__((ext_vector_type(4)));
typedef float f32x8 __attribute__((ext_vector_type(8)));
typedef float f32x16 __attribute__((ext_vector_type(16)));
typedef unsigned u32x2 __attribute__((ext_vector_type(2)));
typedef unsigned u32x4 __attribute__((ext_vector_type(4)));
typedef __bf16 bf16x2_t __attribute__((ext_vector_type(2)));
typedef int i32x8 __attribute__((ext_vector_type(8)));

constexpr int DM = 1024, NB = 2, SEQ = 8192, CTX = 256;
constexpr int TC = NB * CTX, TL = NB * SEQ, TT = TC + TL, NKEY = CTX + SEQ;
constexpr int NEXP = 64;
constexpr float RMS_EPS = 1e-6f;
constexpr int E_IN_PAD = 2432, O_IN_PAD = 896;
constexpr float LOG2E = 1.4426950408889634f;
constexpr int NSTEP = 132;
constexpr int Z0P = 1056;
constexpr int Z1P = 768;
constexpr int LDS_BYTES = 73728;

constexpr size_t al(size_t x) { return (x + 255) & ~(size_t)255; }
constexpr size_t OFF_W_IN_E = 0;
constexpr size_t OFF_W_OUT_E = OFF_W_IN_E + al((size_t)E_IN_PAD * DM * 2);
constexpr size_t OFF_W_IN_O = OFF_W_OUT_E + al((size_t)DM * DM * 2);
constexpr size_t OFF_W_UQ = OFF_W_IN_O + al((size_t)O_IN_PAD * DM * 2);
constexpr size_t OFF_W_UKV = OFF_W_UQ + al((size_t)1536 * 512 * 2);
constexpr size_t OFF_W_OUT_O = OFF_W_UKV + al((size_t)2048 * 256 * 2);
constexpr size_t OFF_W_RT = OFF_W_OUT_O + al((size_t)DM * DM * 2);
constexpr size_t OFF_W_GU = OFF_W_RT + al((size_t)2 * 128 * DM * 2);
constexpr size_t OFF_W_D = OFF_W_GU + al((size_t)65 * 512 * DM * 2);
constexpr size_t OFF_U = OFF_W_D + al((size_t)65 * DM * 256 * 2);
constexpr size_t OFF_HC = OFF_U + al((size_t)TT * DM * 2);
constexpr size_t OFF_MOD = OFF_HC + al((size_t)TC * DM * 4);
constexpr size_t OFF_ROPE = OFF_MOD + al((size_t)2 * 3 * 6144 * 4);
constexpr size_t OFF_CNT = OFF_ROPE + al((size_t)SEQ * 32 * 8);
constexpr size_t OFF_TOKSLOT = OFF_CNT + al(2 * 64 * 4);
constexpr size_t OFF_W8 = OFF_TOKSLOT + al((size_t)TT * 8 * 4);
constexpr size_t OFF_LIST = OFF_W8 + al((size_t)TT * 8 * 4);
constexpr size_t OFF_SSQ = OFF_LIST + al((size_t)64 * TT * 4);
constexpr size_t OFF_DUMP = OFF_SSQ + al((size_t)TT * 12 * 4);
constexpr size_t OFF_BAR = OFF_DUMP + 8192;
constexpr size_t BAR_BYTES = 16384;
constexpr size_t OFF_ARENA = OFF_BAR + BAR_BYTES;
constexpr size_t A0_Z0 = OFF_ARENA;
constexpr size_t A0_VGT = A0_Z0 + al((size_t)TT * Z0P * 2);
constexpr size_t A0_QS = A0_VGT + al((size_t)4 * 128 * TT * 2);
constexpr size_t A0_KS = A0_QS + al((size_t)2 * 8 * NKEY * 64 * 2);
constexpr size_t A0_VST = A0_KS + al((size_t)2 * 2 * NKEY * 64 * 2);
constexpr size_t A0_GS = A0_VST + al((size_t)2 * 2 * 64 * NKEY * 2);
constexpr size_t A0_GD = A0_GS + al((size_t)16 * NSTEP * 8192 * 4);
constexpr size_t A0_MIX = A0_GD + al((size_t)16 * NSTEP * 64 * 4);
constexpr size_t A0_Y = A0_MIX + al((size_t)TT * DM * 2);
constexpr size_t A0_END = A0_Y + al((size_t)TT * DM * 4);
constexpr size_t A1_Z1 = OFF_ARENA;
constexpr size_t A1_QM = A1_Z1 + al((size_t)TT * Z1P * 2);
constexpr size_t A1_KM = A1_QM + al((size_t)2 * 8 * SEQ * 192 * 2);
constexpr size_t A1_VTM = A1_KM + al((size_t)2 * 8 * NKEY * 192 * 2);
constexpr size_t A1_MIX = A1_VTM + al((size_t)2 * 8 * 128 * NKEY * 2);
constexpr size_t A1_Y = A1_MIX + al((size_t)TT * DM * 2);
constexpr size_t A1_END = A1_Y + al((size_t)TT * DM * 4);
constexpr size_t AM_U8 = OFF_ARENA;
constexpr size_t AM_HM = AM_U8 + al((size_t)TT * 1024);
constexpr size_t AM_YR = AM_HM + al((size_t)TT * 9 * 256);
constexpr size_t AM_END = AM_YR + al((size_t)TT * 9 * 1024 * 2);
constexpr size_t WS_NEED = AM_END > A0_END ? (AM_END > A1_END ? AM_END : A1_END) : (A0_END > A1_END ? A0_END : A1_END);
static_assert(WS_NEED <= 555747360ull, "workspace map exceeds the guaranteed d_ws size");

struct Params {
    const float *x, *c, *ctx, *c_ctx, *w_mod, *b_mod, *g_mix_pre, *g_mix_post, *g_ffn_pre, *g_ffn_post;
    const float *w_in_e, *gla_wa2, *gla_ba, *gla_norm, *swa_sink, *w_out_e;
    const float *w_in_o, *mla_q_norm, *mla_kv_norm, *w_uq, *w_ukv, *w_out_o;
    const float *w_router, *b_router, *w_exp_gate, *w_exp_up, *w_exp_down, *w_sh_gate, *w_sh_up, *w_sh_down;
    float* out; unsigned char* ws; int ph_lo, ph_hi;
};

__device__ __forceinline__ unsigned pk2(float lo, float hi) { f32x2 v = {lo, hi}; bf16x2_t b = __builtin_convertvector(v, bf16x2_t); return __builtin_bit_cast(unsigned, b); }
__device__ __forceinline__ float bflo(unsigned u) { return __uint_as_float(u << 16); }
__device__ __forceinline__ float bfhi(unsigned u) { return __uint_as_float(u & 0xffff0000u); }
__device__ __forceinline__ float bf2f(bf16 v) { return __uint_as_float((unsigned)v << 16); }
__device__ __forceinline__ bf16 f2bf(float f) { return (bf16)(pk2(f, 0.f) & 0xffffu); }
constexpr float W8SC = 64.f, H8SC = 4.f, Y8SC = 16.f;
__device__ __forceinline__ unsigned pk4_fp8(float a, float b, float c, float d) { int w = 0; w = __builtin_amdgcn_cvt_pk_fp8_f32(a, b, w, false); w = __builtin_amdgcn_cvt_pk_fp8_f32(c, d, w, true); return (unsigned)w; }
__device__ __forceinline__ float wave_sum(float v) {
#pragma unroll
    for (int o = 1; o < 64; o <<= 1) v += __shfl_xor(v, o);
    return v;
}
__device__ __forceinline__ void glds16(const void* g, LAS void* l) { __builtin_amdgcn_global_load_lds((const unsigned*)g, (LAS unsigned*)l, 16, 0, 0); }
__device__ __forceinline__ float siluf(float x) { return x / (1.f + __expf(-x)); }
__device__ __forceinline__ float ex2(float x) { return __builtin_amdgcn_exp2f(x); }
__device__ __forceinline__ int crow(int r, int hi) { return (r & 3) + 8 * (r >> 2) + 4 * hi; }
__device__ __forceinline__ bf16x8 mk8(u32x4 v) { return __builtin_bit_cast(bf16x8, v); }

struct RowInfo { int b, kq, pos; bool lat; };
__device__ __forceinline__ RowInfo rowinfo(int r) {
    RowInfo i;
    if (r < TC) { i.b = r >> 8; i.pos = r & 255; i.kq = i.pos; i.lat = false; }
    else { const int rl = r - TC; i.b = rl >> 13; i.pos = rl & (SEQ - 1); i.kq = CTX + i.pos; i.lat = true; }
    return i;
}
__device__ __forceinline__ int modvec(int r) { return r < TC ? 2 : ((r - TC) >> 13); }

struct GPtrs { const bf16* a[4]; const bf16* b[4]; };
constexpr int G_STAGE = 32768;
#define G_FENCE() asm volatile("" ::: "memory")
__device__ __forceinline__ void gemm_issue(LAS unsigned char* lds, const GPtrs& g, int kt) {
    LAS unsigned char* d = lds + (kt & 1) * G_STAGE + threadIdx.x * 16; const int ko = kt * 64;
#pragma unroll
    for (int i = 0; i < 4; ++i) { glds16(g.a[i] + ko, d + i * 4096); glds16(g.b[i] + ko, d + 16384 + i * 4096); }
}
__device__ __forceinline__ void gemm_prologue(LAS unsigned char* lds, const GPtrs& g, int nk) { gemm_issue(lds, g, 0); }
__device__ __forceinline__ void gemm_prologue2(LAS unsigned char* lds, const GPtrs& g) { gemm_issue(lds, g, 0); gemm_issue(lds, g, 1); }
template <int NST, bool FP8 = false, bool PRE2 = false>
__device__ __forceinline__ void gemm_main(LAS unsigned char* lds, const GPtrs& g, int nk, f32x4 (&acc)[4][4], bool after_epi) {
    const int tid = threadIdx.x, lane = tid & 63, wid = tid >> 6, wr = wid >> 1, wc = wid & 1, fr = lane & 15, fq = lane >> 4;
#pragma unroll
    for (int m = 0; m < 4; ++m)
#pragma unroll
        for (int n = 0; n < 4; ++n) acc[m][n] = (f32x4){0.f, 0.f, 0.f, 0.f};
    const int c0 = ((fq) ^ (fr & 7)) * 16, c1 = ((4 + fq) ^ (fr & 7)) * 16;
    const int aoff = (wr * 64 + fr) * 128, boff = 16384 + (wc * 64 + fr) * 128;
#pragma unroll 1
    for (int kt = 0; kt < nk; ++kt) {
        if (PRE2) {
            static_assert(!PRE2 || NST == 4 || NST < 0, "PRE2 counted waits are written for 4 epilogue stores");
            if (kt == 0) { if (after_epi) asm volatile("s_waitcnt vmcnt(12) lgkmcnt(0)" ::: "memory"); else asm volatile("s_waitcnt vmcnt(8) lgkmcnt(0)" ::: "memory"); }
            else { if (after_epi) asm volatile("s_waitcnt vmcnt(4) lgkmcnt(0)" ::: "memory"); else asm volatile("s_waitcnt vmcnt(0) lgkmcnt(0)" ::: "memory"); }
        } else
        if (NST == 8 && kt == 0 && after_epi) asm volatile("s_waitcnt vmcnt(8) lgkmcnt(0)" ::: "memory");
        else if (NST == 16 && kt == 0 && after_epi) asm volatile("s_waitcnt vmcnt(16) lgkmcnt(0)" ::: "memory");
        else asm volatile("s_waitcnt vmcnt(0) lgkmcnt(0)" ::: "memory");
        __builtin_amdgcn_s_barrier();
        G_FENCE();
        if (!PRE2 && kt + 1 < nk) gemm_issue(lds, g, kt + 1);
        LAS unsigned char* base = lds + (kt & 1) * G_STAGE;
        if constexpr (FP8) {
            i32x8 a8[4], b8[4];
            const int ca = ((2 * fq) ^ (fr & 7)) * 16, cb = ((2 * fq + 1) ^ (fr & 7)) * 16;
#pragma unroll
            for (int m = 0; m < 4; ++m) { const u32x4 x = *(const LAS u32x4*)(base + aoff + m * 2048 + ca), y = *(const LAS u32x4*)(base + aoff + m * 2048 + cb);
                a8[m] = (i32x8){(int)x.x, (int)x.y, (int)x.z, (int)x.w, (int)y.x, (int)y.y, (int)y.z, (int)y.w}; }
#pragma unroll
            for (int n = 0; n < 4; ++n) { const u32x4 x = *(const LAS u32x4*)(base + boff + n * 2048 + ca), y = *(const LAS u32x4*)(base + boff + n * 2048 + cb);
                b8[n] = (i32x8){(int)x.x, (int)x.y, (int)x.z, (int)x.w, (int)y.x, (int)y.y, (int)y.z, (int)y.w}; }
            __builtin_amdgcn_s_setprio(1);
#pragma unroll
            for (int m = 0; m < 4; ++m)
#pragma unroll
                for (int n = 0; n < 4; ++n) acc[m][n] = __builtin_amdgcn_mfma_scale_f32_16x16x128_f8f6f4(b8[n], a8[m], acc[m][n], 0, 0, 0, 0x7F7F7F7F, 0, 0x7F7F7F7F);
            __builtin_amdgcn_s_setprio(0);
            continue;
        }
        bf16x8 af0[4], bf0[4], af1[4], bf1[4];
#pragma unroll
        for (int m = 0; m < 4; ++m) af0[m] = *(const LAS bf16x8*)(base + aoff + m * 2048 + c0);
#pragma unroll
        for (int n = 0; n < 4; ++n) bf0[n] = *(const LAS bf16x8*)(base + boff + n * 2048 + c0);
#pragma unroll
        for (int m = 0; m < 4; ++m) af1[m] = *(const LAS bf16x8*)(base + aoff + m * 2048 + c1);
#pragma unroll
        for (int n = 0; n < 4; ++n) bf1[n] = *(const LAS bf16x8*)(base + boff + n * 2048 + c1);
        __builtin_amdgcn_s_setprio(1);
#pragma unroll
        for (int m = 0; m < 4; ++m)
#pragma unroll
            for (int n = 0; n < 4; ++n) acc[m][n] = __builtin_amdgcn_mfma_f32_16x16x32_bf16(bf0[n], af0[m], acc[m][n], 0, 0, 0);
#pragma unroll
        for (int m = 0; m < 4; ++m)
#pragma unroll
            for (int n = 0; n < 4; ++n) acc[m][n] = __builtin_amdgcn_mfma_f32_16x16x32_bf16(bf1[n], af1[m], acc[m][n], 0, 0, 0);
        __builtin_amdgcn_s_setprio(0);
    }
    asm volatile("s_waitcnt lgkmcnt(0)" ::: "memory");
    __builtin_amdgcn_s_barrier();
    G_FENCE();
}
__device__ __forceinline__ int vcu_id() { const int b = blockIdx.x, G = gridDim.x; return (G % 8 == 0) ? (b % 8) * (G / 8) + b / 8 : b; }
__device__ __forceinline__ void tile_mn(int w, int ntm, int ntn, int& tm, int& tn) {
    const int nig = 8 * ntn, gid = w / nig, fm = gid * 8, gsz = (ntm - fm) < 8 ? (ntm - fm) : 8, within = w - gid * nig;
    tm = fm + within % gsz; tn = within / gsz;
}
template <bool PREFETCH_NEXT, int NST = -1, bool FP8 = false, bool PRE2 = false, class Make, class Epi>
__device__ __forceinline__ void gemm_tiles(LAS unsigned char* lds, int t0, int nt, int stride, Make make, Epi epi) {
    if (t0 >= nt) return;
    GPtrs g; int nk;
    make(t0, g, nk);
    G_FENCE();
    if (PRE2) gemm_prologue2(lds, g); else gemm_prologue(lds, g, nk);
    bool first = true;
    for (int t = t0; t < nt;) {
        const int tn = t + stride;
        f32x4 acc[4][4];
        gemm_main<PREFETCH_NEXT ? NST : -1, FP8, PRE2>(lds, g, nk, acc, !first);
        first = false;
        if (PREFETCH_NEXT) { if (tn < nt) { make(tn, g, nk); G_FENCE(); if (PRE2) gemm_prologue2(lds, g); else gemm_prologue(lds, g, nk); } epi(t, acc); }
        else { epi(t, acc); __syncthreads(); if (tn < nt) { make(tn, g, nk); G_FENCE(); gemm_prologue(lds, g, nk); } }
        t = tn;
    }
}

template <class RowPtr>
__device__ __forceinline__ void epi_store_rows(LAS unsigned char* wl, const f32x4 (&v)[4][4], int fr, int fq, int lane, RowPtr rowptr, int nrep = 1, size_t rep_stride = 0) {
#pragma unroll
    for (int m = 0; m < 4; ++m)
#pragma unroll
        for (int n = 0; n < 4; ++n)
            *(LAS u32x2*)(wl + (m * 16 + fr) * 128 + (((n * 2 + (fq >> 1)) ^ (fr & 7)) * 16) + (fq & 1) * 8) = (u32x2){pk2(v[m][n][0], v[m][n][1]), pk2(v[m][n][2], v[m][n][3])};
#pragma unroll
    for (int i = 0; i < 8; ++i) {
        const int row = (lane >> 3) + 8 * i, pos = lane & 7;
        const u32x4 w = *(const LAS u32x4*)(wl + row * 128 + pos * 16);
        bf16* d = rowptr(row);
        if (d) { d += (pos ^ (row & 7)) * 8; for (int r = 0; r < nrep; ++r) *(u32x4*)(d + (size_t)r * rep_stride) = w; }
    }
}
template <class ColPtr>
__device__ __forceinline__ void epi_store_cols(LAS unsigned char* wl, const f32x4 (&v)[4][4], int fr, int fq, int lane, ColPtr colptr) {
    LAS unsigned char* wb = wl + fq * 512 + fr * 2;
#pragma unroll
    for (int m = 0; m < 4; ++m)
#pragma unroll
        for (int n = 0; n < 4; ++n)
#pragma unroll
            for (int j = 0; j < 4; ++j) *(LAS bf16*)(wb + n * 2048 + j * 128 + m * 32) = f2bf(v[m][n][j]);
#pragma unroll
    for (int i = 0; i < 8; ++i) {
        const int col = (lane >> 3) + 8 * i, pos = lane & 7;
        const u32x4 w = *(const LAS u32x4*)(wl + col * 128 + pos * 16);
        bf16* d = colptr(col);
        *(u32x4*)(d + pos * 8) = w;
    }
}

template <class RowPtr>
__device__ __forceinline__ void epi_store_rows8(LAS unsigned char* wl, const f32x4 (&v)[4][4], int fr, int fq, int lane, RowPtr rowptr, int nrep = 1, size_t rep_stride = 0) {
#pragma unroll
    for (int m = 0; m < 4; ++m)
#pragma unroll
        for (int n = 0; n < 4; ++n)
            *(LAS unsigned*)(wl + (m * 16 + fr) * 64 + ((n ^ ((fr >> 1) & 3)) * 16) + fq * 4) = pk4_fp8(v[m][n][0], v[m][n][1], v[m][n][2], v[m][n][3]);
#pragma unroll
    for (int i = 0; i < 4; ++i) {
        const int row = (lane >> 2) + 16 * i, pos = lane & 3;
        const u32x4 w = *(const LAS u32x4*)(wl + row * 64 + pos * 16);
        unsigned char* d = rowptr(row) + ((pos ^ ((row >> 1) & 3)) * 16);
        for (int r = 0; r < nrep; ++r) *(u32x4*)(d + (size_t)r * rep_stride) = w;
    }
}
template <class ColPtr>
__device__ __forceinline__ void epi_store_cols8(LAS unsigned char* wl, const f32x4 (&v)[4][4], int fr, int fq, int lane, ColPtr colptr) {
    LAS unsigned char* wb = wl + fq * 256 + 16 * ((fr >> 2) & 1) + 4 * (fr >> 3) + (fr & 3);
#pragma unroll
    for (int m = 0; m < 4; ++m)
#pragma unroll
        for (int n = 0; n < 4; ++n)
#pragma unroll
            for (int j = 0; j < 4; ++j) *(LAS unsigned char*)(wb + n * 1024 + j * 64 + 32 * (m >> 1) + 8 * (m & 1)) = (unsigned char)(pk4_fp8(v[m][n][j], 0.f, 0.f, 0.f) & 0xffu);
#pragma unroll
    for (int i = 0; i < 4; ++i) {
        const int col = (lane >> 2) + 16 * i, pos = lane & 3;
        const u32x4 w = *(const LAS u32x4*)(wl + col * 64 + pos * 16);
        *(u32x4*)(colptr(col) + pos * 16) = w;
    }
}

__device__ __forceinline__ int ein_map(int n) {
    if (n < 512) return n;
    if (n < 1024) return n + 512;
    if (n < 1536) return n - 512;
    if (n < 2048) return 1568 + (n - 1536);
    if (n < 2176) return 2080 + (n - 2048);
    if (n < 2304) return 2208 + (n - 2176);
    if (n < 2320) return 1536 + (n - 2304);
    if (n < 2336) return 1552 + (n - 2320);
    return -1;
}
template <bool FP8 = false>
__device__ __forceinline__ void transpose_item(LAS unsigned char* lds, int K, bf16* dst, int k0, int n0, int ld, int mode, const float* srcA, const float* srcB, int nvalid, const float* kscale) {
    LAS float* tile = (LAS float*)lds;
    const int tid = threadIdx.x;
    {
        const int nq = tid & 31, kr = tid >> 5, n = n0 + nq * 4;
        const float* cp = nullptr; float sc = 1.f;
        if (mode == 0) { if (n < nvalid) cp = srcA + n; }
        else if (mode == 1) { const int c = ein_map(n); if (c >= 0) cp = srcA + c; if (n < 256) sc = 0.125f; }
        else if (mode == 2) { const int grp = n >> 6, w = n & 63; cp = (w < 32 ? srcA : srcB) + grp * 32 + (w & 31); }
        else { const int b6 = n & 63; cp = srcA + (n & ~63) + ((b6 >> 2) & 3) * 16 + (b6 >> 4) * 4; }
        f32x4 v[8];
#pragma unroll
        for (int i = 0; i < 8; ++i) { const int k = kr + 8 * i; v[i] = cp ? *(const f32x4*)(cp + (size_t)(k0 + k) * ld) : (f32x4){0.f, 0.f, 0.f, 0.f}; }
#pragma unroll
        for (int i = 0; i < 8; ++i) { const int k = kr + 8 * i; float m = sc; if (kscale) m *= kscale[k0 + k]; *(LAS f32x4*)(tile + k * 132 + nq * 4) = v[i] * m; }
    }
    __syncthreads();
    {
        const int n = tid >> 1, hf = tid & 1;
        if constexpr (FP8) {
            unsigned char* d8 = (unsigned char*)dst;
#pragma unroll
            for (int c = 0; c < 2; ++c) {
                const int k16 = hf * 32 + c * 16;
                u32x4 o;
                o.x = pk4_fp8(tile[(k16 + 0) * 132 + n] * W8SC, tile[(k16 + 1) * 132 + n] * W8SC, tile[(k16 + 2) * 132 + n] * W8SC, tile[(k16 + 3) * 132 + n] * W8SC);
                o.y = pk4_fp8(tile[(k16 + 4) * 132 + n] * W8SC, tile[(k16 + 5) * 132 + n] * W8SC, tile[(k16 + 6) * 132 + n] * W8SC, tile[(k16 + 7) * 132 + n] * W8SC);
                o.z = pk4_fp8(tile[(k16 + 8) * 132 + n] * W8SC, tile[(k16 + 9) * 132 + n] * W8SC, tile[(k16 + 10) * 132 + n] * W8SC, tile[(k16 + 11) * 132 + n] * W8SC);
                o.w = pk4_fp8(tile[(k16 + 12) * 132 + n] * W8SC, tile[(k16 + 13) * 132 + n] * W8SC, tile[(k16 + 14) * 132 + n] * W8SC, tile[(k16 + 15) * 132 + n] * W8SC);
                *(u32x4*)(d8 + (size_t)(n0 + n) * K + k0 + k16) = o;
            }
        } else
#pragma unroll
        for (int c = 0; c < 4; ++c) {
            const int k8 = hf * 32 + c * 8;
            u32x4 o;
            o.x = pk2(tile[(k8 + 0) * 132 + n], tile[(k8 + 1) * 132 + n]);
            o.y = pk2(tile[(k8 + 2) * 132 + n], tile[(k8 + 3) * 132 + n]);
            o.z = pk2(tile[(k8 + 4) * 132 + n], tile[(k8 + 5) * 132 + n]);
            o.w = pk2(tile[(k8 + 6) * 132 + n], tile[(k8 + 7) * 132 + n]);
            *(u32x4*)(dst + (size_t)(n0 + n) * K + k0 + k8) = o;
        }
    }
    __syncthreads();
}

constexpr int EXP_GU_ITEMS = 65 * 16 * 4, EXP_D_ITEMS = 65 * 4 * 8, EXP_ITEMS = EXP_GU_ITEMS + EXP_D_ITEMS;
__device__ __forceinline__ void expert_convert_item(const Params& p, LAS unsigned char* lds, int l, int it) {
    unsigned char* ws = p.ws;
    if (it < EXP_GU_ITEMS) {
        const int e = it / 64, r = it % 64, kb = r / 4, nb = r % 4;
        const float* gate = e < 64 ? p.w_exp_gate + ((size_t)(l * 64 + e)) * DM * 256 : p.w_sh_gate + (size_t)l * DM * 256;
        const float* up = e < 64 ? p.w_exp_up + ((size_t)(l * 64 + e)) * DM * 256 : p.w_sh_up + (size_t)l * DM * 256;
        transpose_item<true>(lds, DM, (bf16*)(ws + OFF_W_GU + (size_t)e * 512 * DM), kb * 64, nb * 128, 256, 2, gate, up, 512, nullptr);
    } else {
        it -= EXP_GU_ITEMS;
        const int e = it / 32, r = it % 32, kb = r / 8, nb = r % 8;
        const float* dn = e < 64 ? p.w_exp_down + ((size_t)(l * 64 + e)) * 256 * DM : p.w_sh_down + (size_t)l * 256 * DM;
        transpose_item<true>(lds, 256, (bf16*)(ws + OFF_W_D + (size_t)e * DM * 256), kb * 64, nb * 128, DM, 3, dn, nullptr, DM, nullptr);
    }
}

__device__ __forceinline__ void ph_prep(const Params& p, LAS unsigned char* lds) {
    unsigned char* ws = p.ws;
    const int tid = threadIdx.x;
    if (blockIdx.x == 0 && tid < 128) ((int*)(ws + OFF_CNT))[tid] = 0;
    constexpr int I_MOD = 96, I_ROPE = 1024, I_INE = 16 * 19, I_OUTE = 128, I_INO = 16 * 7, I_UQ = 8 * 12, I_UKV = 4 * 16, I_OUTO = 128, I_RT = 32;
    constexpr int NITEMS = I_MOD + I_ROPE + I_INE + I_OUTE + I_INO + I_UQ + I_UKV + I_OUTO + I_RT;
    for (int item = blockIdx.x; item < NITEMS; item += gridDim.x) {
        int it = item;
        if (it < I_MOD) {
            const int l = it / 48, n0 = (it % 48) * 128, kg = tid >> 5, cl = tid & 31;
            LAS float* s = (LAS float*)lds;
            LAS float* red = (LAS float*)(lds + 12288);
            for (int idx = tid; idx < 3072; idx += 256) { const int v = idx >> 10, k = idx & 1023; const float cv = v < 2 ? p.c[v * DM + k] : p.c_ctx[k]; s[idx] = cv / (1.f + expf(-cv)); }
            __syncthreads();
            f32x4 a0 = {0.f, 0.f, 0.f, 0.f}, a1 = a0, a2 = a0;
            const float* w = p.w_mod + (size_t)l * DM * 6144 + (size_t)(kg * 128) * 6144 + n0 + cl * 4;
#pragma unroll 8
            for (int k = 0; k < 128; ++k) { const f32x4 wv = *(const f32x4*)(w + (size_t)k * 6144); const int kk = kg * 128 + k; a0 += wv * s[kk]; a1 += wv * s[1024 + kk]; a2 += wv * s[2048 + kk]; }
            *(LAS f32x4*)(red + (kg * 3 + 0) * 128 + cl * 4) = a0; *(LAS f32x4*)(red + (kg * 3 + 1) * 128 + cl * 4) = a1; *(LAS f32x4*)(red + (kg * 3 + 2) * 128 + cl * 4) = a2;
            __syncthreads();
            for (int idx = tid; idx < 384; idx += 256) { const int v = idx >> 7, n = idx & 127; float acc = 0.f;
#pragma unroll
                for (int g = 0; g < 8; ++g) acc += red[(g * 3 + v) * 128 + n];
                ((float*)(ws + OFF_MOD))[((size_t)l * 3 + v) * 6144 + n0 + n] = acc + p.b_mod[l * 6144 + n0 + n]; }
            __syncthreads();
            continue;
        }
        it -= I_MOD;
        if (it < I_ROPE) {
            const int idx = it * 256 + tid, pos = idx >> 5, i = idx & 31, row = pos >> 6, col = pos & 63, j = i & 15;
            const float invf = powf(10000.f, -(float)(2 * j) / 32.f);
            const float ang = (float)(i < 16 ? row : col) * invf;
            float sn, cs; sincosf(ang, &sn, &cs);
            ((f32x2*)(ws + OFF_ROPE))[idx] = (f32x2){cs, sn};
            continue;
        }
        it -= I_ROPE;
        if (it < I_INE) { const int kb = it / 19, nb = it % 19;
            transpose_item(lds, DM, (bf16*)(ws + OFF_W_IN_E), kb * 64, nb * 128, 2336, 1, p.w_in_e, nullptr, 2336, nullptr); continue; }
        it -= I_INE;
        if (it < I_OUTE) { const int kb = it / 8, nb = it % 8;
            transpose_item(lds, DM, (bf16*)(ws + OFF_W_OUT_E), kb * 64, nb * 128, DM, 0, p.w_out_e, nullptr, DM, nullptr); continue; }
        it -= I_OUTE;
        if (it < I_INO) { const int kb = it / 7, nb = it % 7;
            transpose_item(lds, DM, (bf16*)(ws + OFF_W_IN_O), kb * 64, nb * 128, 832, 0, p.w_in_o, nullptr, 832, nullptr); continue; }
        it -= I_INO;
        if (it < I_UQ) { const int kb = it / 12, nb = it % 12;
            transpose_item(lds, 512, (bf16*)(ws + OFF_W_UQ), kb * 64, nb * 128, 1536, 0, p.w_uq, nullptr, 1536, p.mla_q_norm); continue; }
        it -= I_UQ;
        if (it < I_UKV) { const int kb = it / 16, nb = it % 16;
            transpose_item(lds, 256, (bf16*)(ws + OFF_W_UKV), kb * 64, nb * 128, 2048, 0, p.w_ukv, nullptr, 2048, p.mla_kv_norm); continue; }
        it -= I_UKV;
        if (it < I_OUTO) { const int kb = it / 8, nb = it % 8;
            transpose_item(lds, DM, (bf16*)(ws + OFF_W_OUT_O), kb * 64, nb * 128, DM, 0, p.w_out_o, nullptr, DM, nullptr); continue; }
        it -= I_OUTO;
        { const int l = it / 16, kb = it % 16;
            transpose_item(lds, DM, (bf16*)(ws + OFF_W_RT) + (size_t)l * 128 * DM, kb * 64, 0, 64, 0, p.w_router + (size_t)l * DM * 64, nullptr, 64, nullptr); }
    }
}

__device__ __forceinline__ void load_row(const float* src, int lane, f32x4 (&v)[4]) {
#pragma unroll
    for (int j = 0; j < 4; ++j) v[j] = *(const f32x4*)(src + lane * 4 + 256 * j);
}
__device__ __forceinline__ float row_sumsq(const f32x4 (&v)[4]) {
    float s = 0.f;
#pragma unroll
    for (int j = 0; j < 4; ++j) s += v[j].x * v[j].x + v[j].y * v[j].y + v[j].z * v[j].z + v[j].w * v[j].w;
    return wave_sum(s);
}
__device__ __forceinline__ void modulate_store(const f32x4 (&v)[4], float rinv, const float* g, const float* sh, const float* sc, bf16* dst, int lane) {
#pragma unroll
    for (int j = 0; j < 4; ++j) {
        const int c = lane * 4 + 256 * j;
        const f32x4 gg = *(const f32x4*)(g + c), s1 = *(const f32x4*)(sc + c), s0 = *(const f32x4*)(sh + c);
        const f32x4 o = v[j] * rinv * gg * (s1 + 1.f) + s0;
        u32x2 w; w.x = pk2(o.x, o.y); w.y = pk2(o.z, o.w);
        *(u32x2*)(dst + c) = w;
    }
}
__device__ __forceinline__ const float* hl_src0(const Params& p, int r) { return r < TC ? p.ctx + (size_t)r * DM : p.x + (size_t)(r - TC) * DM; }
__device__ __forceinline__ bf16* hl_buf(const Params& p, int r) { return r < TC ? (bf16*)(p.ws + OFF_HC) + (size_t)r * DM : (bf16*)(p.out + (size_t)(r - TC) * DM); }

__device__ __forceinline__ void ph_modulate0(const Params& p) {
    const int lane = threadIdx.x & 63, gw = blockIdx.x * 4 + (threadIdx.x >> 6), ngw = gridDim.x * 4;
    const float* mod = (const float*)(p.ws + OFF_MOD);
    bf16* U = (bf16*)(p.ws + OFF_U);
    for (int r = gw; r < TT; r += ngw) {
        f32x4 v[4]; load_row(hl_src0(p, r), lane, v);
        const float rinv = rsqrtf(row_sumsq(v) * (1.f / DM) + RMS_EPS);
        const float* mv = mod + (size_t)modvec(r) * 6144;
        modulate_store(v, rinv, p.g_mix_pre, mv, mv + 1024, U + (size_t)r * DM, lane);
    }
}

__device__ __forceinline__ void ph_rowpassA(const Params& p, int l, int row_lo, const float* Y) {
    const int lane = threadIdx.x & 63, gw = blockIdx.x * 4 + (threadIdx.x >> 6), ngw = gridDim.x * 4;
    const float* mod = (const float*)(p.ws + OFF_MOD) + (size_t)l * 3 * 6144;
    bf16* U = (bf16*)(p.ws + OFF_U);
    for (int r = row_lo + gw; r < TT; r += ngw) {
        f32x4 y[4], h[4];
        load_row(Y + (size_t)r * DM, lane, y);
        bf16* hb = hl_buf(p, r);
        if (l == 0) load_row(hl_src0(p, r), lane, h);
        else {
#pragma unroll
            for (int j = 0; j < 4; ++j) { const u32x2 w = *(const u32x2*)(hb + lane * 4 + 256 * j); h[j] = (f32x4){bflo(w.x), bfhi(w.x), bflo(w.y), bfhi(w.y)}; }
        }
        const float rinv = rsqrtf(row_sumsq(y) * (1.f / DM) + RMS_EPS);
        const float* mv = mod + (size_t)modvec(r) * 6144;
#pragma unroll
        for (int j = 0; j < 4; ++j) {
            const int c = lane * 4 + 256 * j;
            const f32x4 gg = *(const f32x4*)(p.g_mix_post + l * DM + c), gt = *(const f32x4*)(mv + 2048 + c);
            h[j] = h[j] + gt * (y[j] * rinv * gg);
            *(u32x2*)(hb + c) = (u32x2){pk2(h[j].x, h[j].y), pk2(h[j].z, h[j].w)};
        }
        const float rinv2 = rsqrtf(row_sumsq(h) * (1.f / DM) + RMS_EPS);
        modulate_store(h, rinv2, p.g_ffn_pre + l * DM, mv + 3072, mv + 4096, U + (size_t)r * DM, lane);
        {
            unsigned char* u8 = p.ws + AM_U8 + (size_t)r * DM;
#pragma unroll
            for (int j = 0; j < 4; ++j) {
                const int c = lane * 4 + 256 * j;
                const f32x4 gg = *(const f32x4*)(p.g_ffn_pre + l * DM + c), s1 = *(const f32x4*)(mv + 4096 + c), s0 = *(const f32x4*)(mv + 3072 + c);
                const f32x4 o = h[j] * rinv2 * gg * (s1 + 1.f) + s0;
                *(unsigned*)(u8 + c) = pk4_fp8(o.x, o.y, o.z, o.w);
            }
        }
    }
}

constexpr int MOE_LDS_OFF = 65536;
__device__ __forceinline__ void moe_tables(const Params& p, LAS unsigned char* lds, int l, int row_lo) {
    LAS int* cnt = (LAS int*)(lds + MOE_LDS_OFF); LAS int* tp = cnt + 80; LAS int* sp = tp + 80;
    const int tid = threadIdx.x;
    if (tid < 64) cnt[tid] = ((const int*)(p.ws + OFF_CNT))[l * 64 + tid];
    if (tid == 64) cnt[64] = TT - row_lo;
    __syncthreads();
    if (tid == 0) {
        int a = 0, s = 0;
        for (int e = 0; e < 65; ++e) { tp[e] = a; sp[e] = s; a += (cnt[e] + 127) >> 7; s += cnt[e]; }
        tp[65] = a;
    }
    __syncthreads();
}

__device__ __forceinline__ void ph_rowpassB(const Params& p, LAS unsigned char* lds, int l, int row_lo) {
    moe_tables(p, lds, l, row_lo);
    LAS int* sp = (LAS int*)(lds + MOE_LDS_OFF) + 160;
    const int lane = threadIdx.x & 63, gw = blockIdx.x * 4 + (threadIdx.x >> 6), ngw = gridDim.x * 4;
    const float* mod = (const float*)(p.ws + OFF_MOD) + (size_t)l * 3 * 6144;
    const unsigned char* YR = p.ws + AM_YR;
    const int* tokslot = (const int*)(p.ws + OFF_TOKSLOT); const float* W8 = (const float*)(p.ws + OFF_W8);
    bf16* U = (bf16*)(p.ws + OFF_U);
    const int c0 = lane * 16;
    for (int r = row_lo + gw; r < TT; r += ngw) {
        int ts = 0; float wv = 0.f;
        if (lane < 8) { ts = tokslot[(size_t)r * 8 + lane]; wv = W8[(size_t)r * 8 + lane]; }
        const int myslot = sp[ts >> 20] + (ts & 0xfffff);
        float f[16];
#pragma unroll
        for (int i = 0; i < 16; ++i) f[i] = 0.f;
#pragma unroll
        for (int k = 0; k < 9; ++k) {
            size_t slot; float wk = 1.f / Y8SC;
            if (k < 8) { slot = (size_t)__shfl(myslot, k); wk = __shfl(wv, k) * (1.f / Y8SC); } else slot = (size_t)TT * 8 + r;
            const u32x4 a = *(const u32x4*)(YR + slot * DM + c0);
            const unsigned aw[4] = {a.x, a.y, a.z, a.w};
#pragma unroll
            for (int q = 0; q < 4; ++q) {
                const f32x2 lo = __builtin_amdgcn_cvt_pk_f32_fp8((int)aw[q], false), hi2 = __builtin_amdgcn_cvt_pk_f32_fp8((int)aw[q], true);
                f[q * 4 + 0] += wk * lo.x; f[q * 4 + 1] += wk * lo.y; f[q * 4 + 2] += wk * hi2.x; f[q * 4 + 3] += wk * hi2.y;
            }
        }
        float ss = 0.f;
#pragma unroll
        for (int i = 0; i < 16; ++i) ss += f[i] * f[i];
        const float rinv = rsqrtf(wave_sum(ss) * (1.f / DM) + RMS_EPS);
        const float* mv = mod + (size_t)modvec(r) * 6144;
        bf16* hb = hl_buf(p, r);
        float h[16];
        {
            const u32x4 ha = *(const u32x4*)(hb + c0), hb2 = *(const u32x4*)(hb + c0 + 8);
            const unsigned hw[8] = {ha.x, ha.y, ha.z, ha.w, hb2.x, hb2.y, hb2.z, hb2.w};
#pragma unroll
            for (int i = 0; i < 8; ++i) { h[2 * i] = bflo(hw[i]); h[2 * i + 1] = bfhi(hw[i]); }
        }
#pragma unroll
        for (int q = 0; q < 4; ++q) {
            const int c = c0 + q * 4;
            const f32x4 gg = *(const f32x4*)(p.g_ffn_post + l * DM + c), gt = *(const f32x4*)(mv + 5120 + c);
            const f32x4 fv = {f[q * 4 + 0], f[q * 4 + 1], f[q * 4 + 2], f[q * 4 + 3]};
            const f32x4 hv = {h[q * 4 + 0], h[q * 4 + 1], h[q * 4 + 2], h[q * 4 + 3]};
            const f32x4 o = hv + gt * (fv * rinv * gg);
            h[q * 4 + 0] = o.x; h[q * 4 + 1] = o.y; h[q * 4 + 2] = o.z; h[q * 4 + 3] = o.w;
        }
        if (l == 1) {
            float* orow = p.out + (size_t)(r - TC) * DM + c0;
#pragma unroll
            for (int q = 0; q < 4; ++q) *(f32x4*)(orow + q * 4) = (f32x4){h[q * 4 + 0], h[q * 4 + 1], h[q * 4 + 2], h[q * 4 + 3]};
        } else {
            *(u32x4*)(hb + c0) = (u32x4){pk2(h[0], h[1]), pk2(h[2], h[3]), pk2(h[4], h[5]), pk2(h[6], h[7])};
            *(u32x4*)(hb + c0 + 8) = (u32x4){pk2(h[8], h[9]), pk2(h[10], h[11]), pk2(h[12], h[13]), pk2(h[14], h[15])};
        }
        if (l == 0) {
            float s2 = 0.f;
#pragma unroll
            for (int i = 0; i < 16; ++i) s2 += h[i] * h[i];
            const float rinv2 = rsqrtf(wave_sum(s2) * (1.f / DM) + RMS_EPS);
            const float* mv1 = mv + 3 * 6144;
#pragma unroll
            for (int hf = 0; hf < 2; ++hf) {
                const int c = c0 + hf * 8;
                const f32x4 g0 = *(const f32x4*)(p.g_mix_pre + DM + c), g1 = *(const f32x4*)(p.g_mix_pre + DM + c + 4);
                const f32x4 sh0 = *(const f32x4*)(mv1 + c), sh1 = *(const f32x4*)(mv1 + c + 4), sc0 = *(const f32x4*)(mv1 + 1024 + c), sc1 = *(const f32x4*)(mv1 + 1024 + c + 4);
                const f32x4 h0 = {h[hf * 8 + 0], h[hf * 8 + 1], h[hf * 8 + 2], h[hf * 8 + 3]}, h1 = {h[hf * 8 + 4], h[hf * 8 + 5], h[hf * 8 + 6], h[hf * 8 + 7]};
                const f32x4 o0 = h0 * rinv2 * g0 * (sc0 + 1.f) + sh0, o1 = h1 * rinv2 * g1 * (sc1 + 1.f) + sh1;
                *(u32x4*)(U + (size_t)r * DM + c) = (u32x4){pk2(o0.x, o0.y), pk2(o0.z, o0.w), pk2(o1.x, o1.y), pk2(o1.z, o1.w)};
            }
        }
    }
}

__device__ __forceinline__ int stg_col() { const int tid = threadIdx.x; return ((tid & 7) ^ ((tid >> 3) & 7)) * 8; }
__device__ __forceinline__ void plain_ptrs(const bf16* base, int row0, int ld, const bf16* (&pp)[4]) {
    const int tid = threadIdx.x;
    pp[0] = base + (size_t)(row0 + (tid >> 3)) * ld + stg_col();
#pragma unroll
    for (int i = 1; i < 4; ++i) pp[i] = pp[0] + (size_t)(32 * i) * ld;
}

__device__ __forceinline__ void ph_inproj0(const Params& p, LAS unsigned char* lds) {
    unsigned char* ws = p.ws;
    const bf16* U = (const bf16*)(ws + OFF_U); const bf16* W = (const bf16*)(ws + OFF_W_IN_E);
    bf16* Z0 = (bf16*)(ws + A0_Z0); bf16* VGT = (bf16*)(ws + A0_VGT); bf16* QS = (bf16*)(ws + A0_QS); bf16* KS = (bf16*)(ws + A0_KS); bf16* VST = (bf16*)(ws + A0_VST);
    const f32x2* rope = (const f32x2*)(ws + OFF_ROPE);
    const int tid = threadIdx.x, lane = tid & 63, wid = tid >> 6, wr = wid >> 1, wc = wid & 1, fr = lane & 15, fq = lane >> 4;
    constexpr int NTN = 19, NTM = TT / 128;
    auto make = [&](int t, GPtrs& g, int& nk) { int tm, tn; tile_mn(t, NTM, NTN, tm, tn); plain_ptrs(U, tm * 128, DM, g.a); plain_ptrs(W, tn * 128, DM, g.b); nk = DM / 64; };
    auto epi = [&](int t, f32x4 (&acc)[4][4]) {
        int tm, tn; tile_mn(t, NTM, NTN, tm, tn); const int brow = tm * 128, bcol = tn * 128;
        const int cb = bcol + wc * 64;
        LAS unsigned char* wl = lds + 32768 + wid * 8192;
        const int r0 = brow + wr * 64;
        const RowInfo ri0 = rowinfo(r0);
        if (cb < 1024) {
            epi_store_rows(wl, acc, fr, fq, lane, [&](int row) { return Z0 + (size_t)(r0 + row) * Z0P + cb; });
        } else if (cb < 1536) {
            const int c0 = cb - 1024;
            epi_store_cols(wl, acc, fr, fq, lane, [&](int col) { return VGT + (size_t)(c0 + col) * TT + r0; });
        } else if (cb < 2176) {
            const float sc = cb < 2048 ? 0.125f * LOG2E : 1.f;
#pragma unroll
            for (int m = 0; m < 4; ++m) {
                const int pos = ri0.pos + m * 16 + fr;
#pragma unroll
                for (int n = 0; n < 2; ++n)
#pragma unroll
                    for (int j = 0; j < 4; ++j) {
                        const float x1 = acc[m][n][j] * sc, x2 = acc[m][n + 2][j] * sc;
                        if (ri0.lat) { const f32x2 cs = rope[(size_t)pos * 32 + n * 16 + fq * 4 + j]; acc[m][n][j] = x1 * cs.x - x2 * cs.y; acc[m][n + 2][j] = x2 * cs.x + x1 * cs.y; }
                        else { acc[m][n][j] = x1; acc[m][n + 2][j] = x2; }
                    }
                asm volatile("" ::: "memory");
            }
            bf16* dst;
            if (cb < 2048) { const int h = (cb - 1536) >> 6; dst = QS + ((size_t)(ri0.b * 8 + h) * NKEY + ri0.kq) * 64; }
            else { const int h = (cb - 2048) >> 6; dst = KS + ((size_t)(ri0.b * 2 + h) * NKEY + ri0.kq) * 64; }
            epi_store_rows(wl, acc, fr, fq, lane, [&](int row) { return dst + (size_t)row * 64; });
        } else if (cb < 2304) {
            const int h = (cb - 2176) >> 6;
            bf16* dst = VST + (size_t)(ri0.b * 2 + h) * 64 * NKEY + ri0.kq;
            epi_store_cols(wl, acc, fr, fq, lane, [&](int col) { return dst + (size_t)col * NKEY; });
        } else if (cb == 2304) {
#pragma unroll
            for (int m = 0; m < 4; ++m) {
                const int r = r0 + m * 16 + fr;
#pragma unroll
                for (int n = 0; n < 2; ++n) { u32x2 w; w.x = pk2(acc[m][n][0], acc[m][n][1]); w.y = pk2(acc[m][n][2], acc[m][n][3]); *(u32x2*)(Z0 + (size_t)r * Z0P + 1024 + n * 16 + fq * 4) = w; }
            }
        }
    };
    gemm_tiles<true>(lds, vcu_id(), NTM * NTN, gridDim.x, make, epi);
}

__device__ __forceinline__ void ph_outproj(const Params& p, LAS unsigned char* lds, const bf16* MIX, const bf16* W, float* Y, int row_lo) {
    const int tid = threadIdx.x, lane = tid & 63, wid = tid >> 6, wr = wid >> 1, wc = wid & 1, fr = lane & 15, fq = lane >> 4;
    const int tm0 = row_lo / 128, ntm = TT / 128 - tm0;
    auto make = [&](int t, GPtrs& g, int& nk) { int tm, tn; tile_mn(t, ntm, 8, tm, tn); plain_ptrs(MIX, (tm0 + tm) * 128, DM, g.a); plain_ptrs(W, tn * 128, DM, g.b); nk = DM / 64; };
    auto epi = [&](int t, f32x4 (&acc)[4][4]) {
        int tm, tn; tile_mn(t, ntm, 8, tm, tn); tm += tm0; const int brow = tm * 128, bcol = tn * 128;
#pragma unroll
        for (int m = 0; m < 4; ++m) {
            const int r = brow + wr * 64 + m * 16 + fr;
#pragma unroll
            for (int n = 0; n < 4; ++n) *(f32x4*)(Y + (size_t)r * DM + bcol + wc * 64 + n * 16 + fq * 4) = acc[m][n];
        }
    };
    gemm_tiles<true, 16>(lds, vcu_id(), ntm * 8, gridDim.x, make, epi);
}

template <int DQK, int DV>
__device__ __forceinline__ void attn_item(LAS unsigned char* lds, const bf16* Qg, const bf16* Kg, const bf16* VTg, int a1, int b0, int b1, int qpos0,
                                          float m_init, float l_init, bf16* Og, int o_pitch) {
    constexpr int KPB = DQK * 2, NS = DQK / 16, NDV = DV / 32, KCH = DQK / 8, KBYTES = 32 * KPB, VBYTES = DV * 64, KN = 32 * KCH / 256, VN = DV * 4 / 256;
    static_assert((KN == 3 && VN == 2) || (KN == 1 && VN == 1), "piece counts");
    const int tid = threadIdx.x, lane = tid & 63, wid = tid >> 6, ql = lane & 31, hi = lane >> 5;
    LAS unsigned char* Kb0 = lds; LAS unsigned char* Vb0 = lds + 2 * KBYTES;
    asm volatile("s_waitcnt vmcnt(0) lgkmcnt(0)" ::: "memory");
    __builtin_amdgcn_s_barrier();
    asm volatile("" ::: "memory");
    bf16x8 qf[NS];
    {
        const bf16* qrow = Qg + (size_t)(wid * 32 + ql) * DQK + hi * 8;
#pragma unroll
        for (int s = 0; s < NS; ++s) qf[s] = *(const bf16x8*)(qrow + s * 16);
    }
    unsigned koff[KN], voff[VN];
#pragma unroll
    for (int i = 0; i < KN; ++i) { const int pz = tid + 256 * i, key = pz / KCH, ch = pz % KCH; koff[i] = (unsigned)(key * DQK + (((ch & ~7) | ((ch & 7) ^ ((key >> 1) & 7))) * 8)); }
#pragma unroll
    for (int i = 0; i < VN; ++i) { const int pz = tid + 256 * i, dv = pz >> 2, ch = pz & 3; voff[i] = (unsigned)(dv * NKEY + ((ch ^ ((dv >> 2) & 3)) * 8)); }
    const int ntot = a1 + (b1 - b0);
#define ATTN_KT(it_) ((it_) < a1 ? (it_) : b0 + ((it_) - a1))
#define ATTN_DMA_K(IT_) do { const int kt_ = ATTN_KT(IT_); _Pragma("unroll") for (int i_ = 0; i_ < KN; ++i_) glds16(Kg + (size_t)kt_ * 32 * DQK + koff[i_], Kb0 + ((IT_) & 1) * KBYTES + (tid + 256 * i_) * 16); } while (0)
#define ATTN_DMA_V(IT_) do { const int kt_ = ATTN_KT(IT_); _Pragma("unroll") for (int i_ = 0; i_ < VN; ++i_) glds16(VTg + (size_t)kt_ * 32 + voff[i_], Vb0 + ((IT_) & 1) * VBYTES + (tid + 256 * i_) * 16); } while (0)
    f32x16 o[NDV];
#pragma unroll
    for (int d = 0; d < NDV; ++d)
#pragma unroll
        for (int r = 0; r < 16; ++r) o[d][r] = 0.f;
    float mrun = m_init, lrun = l_init;
    const int swk = (ql >> 1) & 7, swv = (ql >> 2) & 3;
    const LAS unsigned char* kfrag = Kb0 + ql * KPB; const LAS unsigned char* vfrag = Vb0 + ql * 64;
#define ATTN_QK(P_, IT_) do { \
        _Pragma("unroll") for (int r_ = 0; r_ < 16; ++r_) P_[r_] = 0.f; \
        const LAS unsigned char* kc_ = kfrag + ((IT_) & 1) * KBYTES; \
        _Pragma("unroll") for (int s_ = 0; s_ < NS; ++s_) { \
            const int c_ = 2 * s_ + hi; \
            const bf16x8 k0_ = *(const LAS bf16x8*)(kc_ + ((c_ & ~7) | ((c_ & 7) ^ swk)) * 16); \
            P_ = __builtin_amdgcn_mfma_f32_32x32x16_bf16(k0_, qf[s_], P_, 0, 0, 0); } \
        if ((IT_) >= a1) { const int kbase_ = ATTN_KT(IT_) * 32 - CTX, qpos_ = qpos0 + wid * 32 + ql; \
            _Pragma("unroll") for (int r_ = 0; r_ < 16; ++r_) { const int d0_ = qpos_ - (kbase_ + crow(r_, hi)); if (d0_ > 128 || d0_ < -128) P_[r_] = -1e30f; } } } while (0)
#define ATTN_PK4(P, BASE, OUT) do { const unsigned a0_ = pk2(P[BASE + 0], P[BASE + 1]), a1_ = pk2(P[BASE + 2], P[BASE + 3]), b0_ = pk2(P[BASE + 4], P[BASE + 5]), b1_ = pk2(P[BASE + 6], P[BASE + 7]); \
        const auto r0_ = __builtin_amdgcn_permlane32_swap(a0_, b0_, false, false); const auto r1_ = __builtin_amdgcn_permlane32_swap(a1_, b1_, false, false); \
        OUT = mk8((u32x4){r0_[0], r1_[0], r0_[1], r1_[1]}); } while (0)
#define ATTN_STEP(C_, N_, IT_) do { \
          \
          \
        asm volatile("s_waitcnt vmcnt(0) lgkmcnt(0)" ::: "memory"); __builtin_amdgcn_s_barrier(); asm volatile("" ::: "memory"); \
        if ((IT_) + 2 < ntot) ATTN_DMA_K((IT_) + 2); \
        if ((IT_) + 1 < ntot) ATTN_DMA_V((IT_) + 1); \
        if ((IT_) + 1 < ntot) ATTN_QK(N_, (IT_) + 1); \
        float mx_ = C_[0]; \
        _Pragma("unroll") for (int r_ = 1; r_ < 16; ++r_) mx_ = fmaxf(mx_, C_[r_]); \
        mx_ = fmaxf(mx_, __shfl_xor(mx_, 32)); \
        if (__any(mx_ > mrun + 8.f)) { const float mn_ = fmaxf(mrun, mx_), alpha_ = ex2(mrun - mn_); mrun = mn_; lrun *= alpha_; \
            _Pragma("unroll") for (int d_ = 0; d_ < NDV; ++d_) _Pragma("unroll") for (int r_ = 0; r_ < 16; ++r_) o[d_][r_] *= alpha_; } \
        float rs_ = 0.f; \
        _Pragma("unroll") for (int r_ = 0; r_ < 16; ++r_) { C_[r_] = ex2(C_[r_] - mrun); rs_ += C_[r_]; } \
        rs_ += __shfl_xor(rs_, 32); lrun += rs_; \
        bf16x8 pf_[2]; \
        ATTN_PK4(C_, 0, pf_[0]); ATTN_PK4(C_, 8, pf_[1]); \
        const LAS unsigned char* vc_ = vfrag + ((IT_) & 1) * VBYTES; \
        _Pragma("unroll") for (int d_ = 0; d_ < NDV; ++d_) { _Pragma("unroll") for (int kk_ = 0; kk_ < 2; ++kk_) { \
            const bf16x8 vf_ = *(const LAS bf16x8*)(vc_ + d_ * 32 * 64 + (((2 * kk_ + hi) ^ swv) * 16)); \
            o[d_] = __builtin_amdgcn_mfma_f32_32x32x16_bf16(vf_, pf_[kk_], o[d_], 0, 0, 0); } } } while (0)
    ATTN_DMA_K(0); ATTN_DMA_V(0);
    asm volatile("s_waitcnt vmcnt(0) lgkmcnt(0)" ::: "memory"); __builtin_amdgcn_s_barrier(); asm volatile("" ::: "memory");
    if (ntot > 1) ATTN_DMA_K(1);
    f32x16 pA, pB;
    ATTN_QK(pA, 0);
    int it = 0;
    for (; it + 1 < ntot; it += 2) {
        ATTN_STEP(pA, pB, it);
        ATTN_STEP(pB, pA, it + 1);
    }
    if (it < ntot) ATTN_STEP(pA, pB, it);
#undef ATTN_STEP
#undef ATTN_PK4
#undef ATTN_QK
#undef ATTN_KT
#undef ATTN_DMA_K
#undef ATTN_DMA_V
    const float inv = 1.f / lrun;
    bf16* orow = Og + (size_t)(wid * 32 + ql) * o_pitch;
#pragma unroll
    for (int d = 0; d < NDV; ++d)
#pragma unroll
        for (int g = 0; g < 4; ++g) {
            u32x2 w; w.x = pk2(o[d][g * 4 + 0] * inv, o[d][g * 4 + 1] * inv); w.y = pk2(o[d][g * 4 + 2] * inv, o[d][g * 4 + 3] * inv);
            *(u32x2*)(orow + d * 32 + 8 * g + 4 * hi) = w;
        }
}

constexpr int GA_CUM = 0, GA_ALOW = 16384, GA_WA = 20480, GA_BA = 24576, GA_QT = 24832, GA_TOT = 25856, GA_END = 26112;
__device__ __forceinline__ void gla_cum(const Params& p, LAS unsigned char* lds, const bf16* Z0, int r0, int h, int dir) {
    const int tid = threadIdx.x;
    LAS float* cum = (LAS float*)(lds + GA_CUM); LAS float* alow = (LAS float*)(lds + GA_ALOW); LAS float* wa = (LAS float*)(lds + GA_WA);
    LAS float* ba = (LAS float*)(lds + GA_BA); LAS float* qt = (LAS float*)(lds + GA_QT); LAS float* tot = (LAS float*)(lds + GA_TOT);
    {
        const int t = tid >> 2, i4 = (tid & 3) * 4;
        const u32x2 w = *(const u32x2*)(Z0 + (size_t)(r0 + t) * Z0P + 1024 + dir * 16 + i4);
        alow[t * 16 + i4 + 0] = bflo(w.x); alow[t * 16 + i4 + 1] = bfhi(w.x); alow[t * 16 + i4 + 2] = bflo(w.y); alow[t * 16 + i4 + 3] = bfhi(w.y);
#pragma unroll
        for (int q = 0; q < 4; ++q) { const int idx = tid * 4 + q, i = idx >> 6, j = idx & 63; wa[idx] = p.gla_wa2[(size_t)(dir * 16 + i) * 256 + h * 64 + j]; }
        if (tid < 64) ba[tid] = p.gla_ba[dir * 256 + h * 64 + tid];
    }
    __syncthreads();
    const int j = tid & 63, tq = tid >> 6;
    float la[16], wj[16];
#pragma unroll
    for (int i = 0; i < 16; ++i) wj[i] = wa[i * 64 + j];
    const float bj = ba[j];
#pragma unroll
    for (int tt = 0; tt < 16; ++tt) {
        const int t = tq * 16 + tt;
        float x = bj;
#pragma unroll
        for (int q = 0; q < 4; ++q) { const f32x4 a = *(const LAS f32x4*)(alow + t * 16 + q * 4);
            x += a.x * wj[q * 4] + a.y * wj[q * 4 + 1] + a.z * wj[q * 4 + 2] + a.w * wj[q * 4 + 3]; }
        la[tt] = (fminf(x, 0.f) - __logf(1.f + __expf(-fabsf(x)))) * (1.f / 16.f);
    }
    float run = 0.f;
    if (dir == 0) {
#pragma unroll
        for (int tt = 0; tt < 16; ++tt) { run += la[tt]; cum[(tq * 16 + tt) * 64 + j] = run; }
    } else {
#pragma unroll
        for (int tt = 15; tt >= 0; --tt) { run += la[tt]; cum[(tq * 16 + tt) * 64 + j] = run; }
    }
    qt[tq * 64 + j] = run;
    __syncthreads();
    float off = 0.f, total = 0.f;
#pragma unroll
    for (int q = 0; q < 4; ++q) { const float v = qt[q * 64 + j]; total += v; if (dir == 0 ? (q < tq) : (q > tq)) off += v; }
#pragma unroll
    for (int tt = 0; tt < 16; ++tt) cum[(tq * 16 + tt) * 64 + j] += off;
    if (tq == 0) tot[j] = total;
    __syncthreads();
}

__device__ __forceinline__ int gla_row0(int b, int cc) { return cc < 4 ? b * CTX + cc * 64 : TC + b * SEQ + (cc - 4) * 64; }
__device__ __forceinline__ int gla_step(int cc, int dir) { return dir == 0 ? cc : (cc < 4 ? 3 - cc : 4 + (131 - cc)); }

__device__ __forceinline__ void gla_g1_item(const Params& p, LAS unsigned char* lds, int item) {
    unsigned char* ws = p.ws;
    const bf16* Z0 = (const bf16*)(ws + A0_Z0); const bf16* VGT = (const bf16*)(ws + A0_VGT);
    bf16* GS = (bf16*)(ws + A0_GS); float* GD = (float*)(ws + A0_GD);
    const int cc = item % NSTEP, rest = item / NSTEP, dir = rest & 1, h = (rest >> 1) & 3, b = rest >> 3;
    const int r0 = gla_row0(b, cc), step = gla_step(cc, dir), chain = (b * 4 + h) * 2 + dir;
    const int tid = threadIdx.x, lane = tid & 63, wid = tid >> 6, fr = lane & 15, fq = lane >> 4;
    __syncthreads();
    gla_cum(p, lds, Z0, r0, h, dir);
    LAS float* cum = (LAS float*)(lds + GA_CUM); LAS float* tot = (LAS float*)(lds + GA_TOT);
    LAS bf16* KT = (LAS bf16*)(lds + GA_END);
    {
        const int t = tid >> 2, d0 = (tid & 3) * 16;
        const u32x4 w0 = *(const u32x4*)(Z0 + (size_t)(r0 + t) * Z0P + 256 + h * 64 + d0), w1 = *(const u32x4*)(Z0 + (size_t)(r0 + t) * Z0P + 256 + h * 64 + d0 + 8);
        const unsigned ww[8] = {w0.x, w0.y, w0.z, w0.w, w1.x, w1.y, w1.z, w1.w};
#pragma unroll
        for (int i = 0; i < 8; ++i) {
            const int d = d0 + 2 * i;
            KT[d * 72 + t] = f2bf(bflo(ww[i]) * __expf(tot[d] - cum[t * 64 + d]));
            KT[(d + 1) * 72 + t] = f2bf(bfhi(ww[i]) * __expf(tot[d + 1] - cum[t * 64 + d + 1]));
        }
    }
    if (tid < 64) GD[((size_t)chain * NSTEP + step) * 64 + tid] = __expf(tot[tid]);
    __syncthreads();
    f32x4 acc[2][4];
#pragma unroll
    for (int m = 0; m < 2; ++m)
#pragma unroll
        for (int n = 0; n < 4; ++n) acc[m][n] = (f32x4){0.f, 0.f, 0.f, 0.f};
#pragma unroll
    for (int ks = 0; ks < 2; ++ks) {
        bf16x8 af[2], bfr[4];
#pragma unroll
        for (int m = 0; m < 2; ++m) af[m] = *(const bf16x8*)(VGT + (size_t)(h * 128 + wid * 32 + m * 16 + fr) * TT + r0 + ks * 32 + fq * 8);
#pragma unroll
        for (int n = 0; n < 4; ++n) bfr[n] = *(const LAS bf16x8*)(KT + (n * 16 + fr) * 72 + ks * 32 + fq * 8);
#pragma unroll
        for (int m = 0; m < 2; ++m)
#pragma unroll
            for (int n = 0; n < 4; ++n) acc[m][n] = __builtin_amdgcn_mfma_f32_16x16x32_bf16(bfr[n], af[m], acc[m][n], 0, 0, 0);
    }
    bf16* dst = GS + ((size_t)chain * NSTEP + step) * 8192;
#pragma unroll
    for (int m = 0; m < 2; ++m)
#pragma unroll
        for (int n = 0; n < 4; ++n) *(u32x2*)(dst + (size_t)(wid * 32 + m * 16 + fr) * 64 + n * 16 + fq * 4) = (u32x2){pk2(acc[m][n][0], acc[m][n][1]), pk2(acc[m][n][2], acc[m][n][3])};
}

__device__ __forceinline__ void ph_gla_scan(const Params& p) {
    unsigned* GS = (unsigned*)(p.ws + A0_GS); const float* GD = (const float*)(p.ws + A0_GD);
    for (int idx = blockIdx.x * 256 + threadIdx.x; idx < 16 * 4096; idx += gridDim.x * 256) {
        const int chain = idx >> 12, e2 = idx & 4095, dk = (e2 & 31) * 2;
        unsigned* g = GS + (size_t)chain * NSTEP * 4096 + e2;
        const f32x2* d = (const f32x2*)(GD + (size_t)chain * NSTEP * 64 + dk);
        float s0 = 0.f, s1 = 0.f;
#pragma unroll 12
        for (int s = 0; s < NSTEP; ++s) {
            const unsigned t = g[(size_t)s * 4096]; const f32x2 dec = d[s * 32];
            g[(size_t)s * 4096] = pk2(s0, s1);
            s0 = dec.x * s0 + bflo(t); s1 = dec.y * s1 + bfhi(t);
        }
    }
}

__device__ __forceinline__ void gla_g3_item(const Params& p, LAS unsigned char* lds, int item) {
    unsigned char* ws = p.ws;
    const bf16* Z0 = (const bf16*)(ws + A0_Z0); const bf16* VGT = (const bf16*)(ws + A0_VGT);
    const bf16* GS = (const bf16*)(ws + A0_GS); bf16* MIX = (bf16*)(ws + A0_MIX);
    const int cc = item % NSTEP, rest = item / NSTEP, h = rest & 3, b = rest >> 2;
    const int r0 = gla_row0(b, cc);
    const int tid = threadIdx.x, lane = tid & 63, wid = tid >> 6, fr = lane & 15, fq = lane >> 4;
    LAS bf16* QT = (LAS bf16*)(lds + GA_END);
    LAS bf16* QI = (LAS bf16*)(lds + GA_END + 9216);
    LAS bf16* KT = (LAS bf16*)(lds + GA_END + 18432);
    LAS bf16* PP = (LAS bf16*)(lds);
    f32x4 o[4][2];
#pragma unroll
    for (int m = 0; m < 4; ++m)
#pragma unroll
        for (int n = 0; n < 2; ++n) o[m][n] = (f32x4){0.f, 0.f, 0.f, 0.f};
    for (int dir = 0; dir < 2; ++dir) {
        const int step = gla_step(cc, dir), chain = (b * 4 + h) * 2 + dir;
        __syncthreads();
        gla_cum(p, lds, Z0, r0, h, dir);
        LAS float* cum = (LAS float*)(lds + GA_CUM); LAS float* tot = (LAS float*)(lds + GA_TOT);
        {
            const int t = tid >> 2, d0 = (tid & 3) * 16;
            const bf16* zr = Z0 + (size_t)(r0 + t) * Z0P + h * 64 + d0;
            const u32x4 q0 = *(const u32x4*)(zr), q1 = *(const u32x4*)(zr + 8), k0 = *(const u32x4*)(zr + 256), k1 = *(const u32x4*)(zr + 264);
            const unsigned qq[8] = {q0.x, q0.y, q0.z, q0.w, q1.x, q1.y, q1.z, q1.w}, kk[8] = {k0.x, k0.y, k0.z, k0.w, k1.x, k1.y, k1.z, k1.w};
            unsigned oqt[8], oqi[8], okt[8];
#pragma unroll
            for (int i = 0; i < 8; ++i) {
                const int d = d0 + 2 * i;
                const float c0 = cum[t * 64 + d], c1 = cum[t * 64 + d + 1], t0 = tot[d], t1 = tot[d + 1];
                const float qa = bflo(qq[i]), qb = bfhi(qq[i]), ka = bflo(kk[i]), kb = bfhi(kk[i]);
                oqt[i] = pk2(qa * __expf(c0 - t0), qb * __expf(c1 - t1));
                oqi[i] = pk2(qa * __expf(c0), qb * __expf(c1));
                okt[i] = pk2(ka * __expf(t0 - c0), kb * __expf(t1 - c1));
            }
            *(LAS u32x4*)(QT + t * 72 + d0) = (u32x4){oqt[0], oqt[1], oqt[2], oqt[3]}; *(LAS u32x4*)(QT + t * 72 + d0 + 8) = (u32x4){oqt[4], oqt[5], oqt[6], oqt[7]};
            *(LAS u32x4*)(QI + t * 72 + d0) = (u32x4){oqi[0], oqi[1], oqi[2], oqi[3]}; *(LAS u32x4*)(QI + t * 72 + d0 + 8) = (u32x4){oqi[4], oqi[5], oqi[6], oqi[7]};
            *(LAS u32x4*)(KT + t * 72 + d0) = (u32x4){okt[0], okt[1], okt[2], okt[3]}; *(LAS u32x4*)(KT + t * 72 + d0 + 8) = (u32x4){okt[4], okt[5], okt[6], okt[7]};
        }
        __syncthreads();
        {
            f32x4 sa[4];
#pragma unroll
            for (int m = 0; m < 4; ++m) sa[m] = (f32x4){0.f, 0.f, 0.f, 0.f};
#pragma unroll
            for (int ks = 0; ks < 2; ++ks) {
                const bf16x8 kf = *(const LAS bf16x8*)(KT + (wid * 16 + fr) * 72 + ks * 32 + fq * 8);
#pragma unroll
                for (int m = 0; m < 4; ++m) {
                    const bf16x8 qfm = *(const LAS bf16x8*)(QT + (m * 16 + fr) * 72 + ks * 32 + fq * 8);
                    sa[m] = __builtin_amdgcn_mfma_f32_16x16x32_bf16(kf, qfm, sa[m], 0, 0, 0);
                }
            }
#pragma unroll
            for (int m = 0; m < 4; ++m) {
                const int t = m * 16 + fr;
                float v[4];
#pragma unroll
                for (int jj = 0; jj < 4; ++jj) { const int j = wid * 16 + fq * 4 + jj; const bool keep = dir == 0 ? (j <= t) : (j >= t); v[jj] = keep ? sa[m][jj] : 0.f; }
                *(LAS u32x2*)(PP + t * 72 + wid * 16 + fq * 4) = (u32x2){pk2(v[0], v[1]), pk2(v[2], v[3])};
            }
        }
        __syncthreads();
        const bf16* Sg = GS + ((size_t)chain * NSTEP + step) * 8192;
#pragma unroll
        for (int ks = 0; ks < 2; ++ks) {
            bf16x8 vfr[2], sfr[2];
#pragma unroll
            for (int n = 0; n < 2; ++n) {
                const int dv = wid * 32 + n * 16 + fr;
                vfr[n] = *(const bf16x8*)(VGT + (size_t)(h * 128 + dv) * TT + r0 + ks * 32 + fq * 8);
                sfr[n] = *(const bf16x8*)(Sg + (size_t)dv * 64 + ks * 32 + fq * 8);
            }
#pragma unroll
            for (int m = 0; m < 4; ++m) {
                const bf16x8 pfm = *(const LAS bf16x8*)(PP + (m * 16 + fr) * 72 + ks * 32 + fq * 8);
                const bf16x8 qim = *(const LAS bf16x8*)(QI + (m * 16 + fr) * 72 + ks * 32 + fq * 8);
#pragma unroll
                for (int n = 0; n < 2; ++n) {
                    o[m][n] = __builtin_amdgcn_mfma_f32_16x16x32_bf16(vfr[n], pfm, o[m][n], 0, 0, 0);
                    o[m][n] = __builtin_amdgcn_mfma_f32_16x16x32_bf16(sfr[n], qim, o[m][n], 0, 0, 0);
                }
            }
        }
    }
    __syncthreads();
    LAS float* red = (LAS float*)(lds + GA_END + 27648);
#pragma unroll
    for (int m = 0; m < 4; ++m) {
        float s = 0.f;
#pragma unroll
        for (int n = 0; n < 2; ++n)
#pragma unroll
            for (int j = 0; j < 4; ++j) s += o[m][n][j] * o[m][n][j];
        s += __shfl_xor(s, 16); s += __shfl_xor(s, 32);
        if (fq == 0) red[wid * 64 + m * 16 + fr] = s;
    }
    __syncthreads();
#pragma unroll
    for (int m = 0; m < 4; ++m) {
        const int t = m * 16 + fr;
        const float ss = red[t] + red[64 + t] + red[128 + t] + red[192 + t];
        const float rinv = rsqrtf(ss * (1.f / 128.f) + RMS_EPS);
        const int r = r0 + t;
#pragma unroll
        for (int n = 0; n < 2; ++n) {
            const int dv = wid * 32 + n * 16 + fq * 4;
            const u32x2 gw = *(const u32x2*)(Z0 + (size_t)r * Z0P + 512 + h * 128 + dv);
            const f32x4 ng = *(const f32x4*)(p.gla_norm + dv);
            const float g0 = bflo(gw.x), g1 = bfhi(gw.x), g2 = bflo(gw.y), g3 = bfhi(gw.y);
            const float y0 = o[m][n][0] * rinv * ng.x * siluf(g0), y1 = o[m][n][1] * rinv * ng.y * siluf(g1);
            const float y2 = o[m][n][2] * rinv * ng.z * siluf(g2), y3 = o[m][n][3] * rinv * ng.w * siluf(g3);
            *(u32x2*)(MIX + (size_t)r * DM + h * 128 + dv) = (u32x2){pk2(y0, y1), pk2(y2, y3)};
        }
    }
}

__device__ __forceinline__ void ph_swa_g1(const Params& p, LAS unsigned char* lds) {
    unsigned char* ws = p.ws;
    const bf16* QS = (const bf16*)(ws + A0_QS); const bf16* KS = (const bf16*)(ws + A0_KS); const bf16* VST = (const bf16*)(ws + A0_VST); bf16* MIX = (bf16*)(ws + A0_MIX);
    constexpr int N_SWA = 2 * 8 * 66, N_G1 = 2 * 4 * 2 * NSTEP;
    for (int item = blockIdx.x; item < N_SWA + N_G1; item += gridDim.x) {
        if (item < N_SWA) {
            const int qt = item % 66, rest = item / 66, h = rest & 7, b = rest >> 3, kvh = h >> 2;
            const bf16* Qg = QS + ((size_t)(b * 8 + h) * NKEY + qt * 128) * 64;
            const bf16* Kg = KS + (size_t)(b * 2 + kvh) * NKEY * 64;
            const bf16* Vg = VST + (size_t)(b * 2 + kvh) * 64 * NKEY;
            int b0 = 0, b1 = 0, qpos0 = 0, row0;
            if (qt >= 2) { qpos0 = (qt - 2) * 128; const int lo = qpos0 - 128 < 0 ? 0 : qpos0 - 128, hi2 = qpos0 + 256 > SEQ ? SEQ : qpos0 + 256; b0 = 8 + lo / 32; b1 = 8 + hi2 / 32; row0 = TC + b * SEQ + qpos0; }
            else row0 = b * CTX + qt * 128;
            const float sink = p.swa_sink[h] * LOG2E;
            attn_item<64, 64>(lds, Qg, Kg, Vg, 8, b0, b1, qpos0, sink, 1.f, MIX + (size_t)row0 * DM + 512 + h * 64, DM);
        } else gla_g1_item(p, lds, item - N_SWA);
    }
}
__device__ __forceinline__ void ph_gla_g3(const Params& p, LAS unsigned char* lds) {
    for (int item = blockIdx.x; item < 2 * 4 * NSTEP; item += gridDim.x) gla_g3_item(p, lds, item);
}

__device__ __forceinline__ void ph_router(const Params& p, LAS unsigned char* lds, int l, int row_lo) {
    unsigned char* ws = p.ws;
    const bf16* U = (const bf16*)(ws + OFF_U); const bf16* W = (const bf16*)(ws + OFF_W_RT) + (size_t)l * 128 * DM;
    int* cntg = (int*)(ws + OFF_CNT) + l * 64; int* tokslot = (int*)(ws + OFF_TOKSLOT); float* W8 = (float*)(ws + OFF_W8); int* LIST = (int*)(ws + OFF_LIST);
    const int tid = threadIdx.x, lane = tid & 63, wid = tid >> 6, wr = wid >> 1, wc = wid & 1, fr = lane & 15, fq = lane >> 4;
    LAS float* lg = (LAS float*)lds;
    const int tm0 = row_lo / 128;
    auto make = [&](int tm, GPtrs& g, int& nk) { plain_ptrs(U, tm * 128, DM, g.a); plain_ptrs(W, 0, DM, g.b); nk = DM / 64; };
    auto epi = [&](int tm, f32x4 (&acc)[4][4]) {
        const int brow = tm * 128;
        if (wc == 0) {
#pragma unroll
            for (int m = 0; m < 4; ++m)
#pragma unroll
                for (int n = 0; n < 4; ++n)
#pragma unroll
                    for (int j = 0; j < 4; ++j) lg[(wr * 64 + m * 16 + fr) * 65 + n * 16 + fq * 4 + j] = acc[m][n][j];
        }
        __syncthreads();
        LAS float* biasl = (LAS float*)(lds + 34816); LAS int* hist = (LAS int*)(lds + 34816 + 256); LAS int* basel = (LAS int*)(lds + 34816 + 512);
        if (tid < 64) { biasl[tid] = p.b_router[l * 64 + tid]; hist[tid] = 0; }
        __syncthreads();
        int esel[8], lrank[8]; float ssel[8]; float wsum = 0.f;
        if (tid < 128) {
            LAS float* L = lg + tid * 65;
            float gs[8];
#pragma unroll
            for (int g = 0; g < 8; ++g) {
                float m1 = -INFINITY, m2 = -INFINITY;
#pragma unroll
                for (int j = 0; j < 8; ++j) {
                    const int e = g * 8 + j;
                    const float sel = 1.f / (1.f + expf(-L[e])) + biasl[e];
                    L[e] = sel;
                    if (sel > m1) { m2 = m1; m1 = sel; } else if (sel > m2) m2 = sel;
                }
                gs[g] = m1 + m2;
            }
            unsigned allowed = 0u;
#pragma unroll
            for (int g = 0; g < 8; ++g) {
                int rk = 0;
#pragma unroll
                for (int h = 0; h < 8; ++h) rk += (gs[h] > gs[g] || (gs[h] == gs[g] && h < g)) ? 1 : 0;
                if (rk < 4) allowed |= 1u << g;
            }
#pragma unroll
            for (int k = 0; k < 8; ++k) {
                float best = -INFINITY; int bi = 0;
#pragma unroll
                for (int g = 0; g < 8; ++g) {
                    if ((allowed >> g) & 1u) {
#pragma unroll
                        for (int j = 0; j < 8; ++j) { const float v = L[g * 8 + j]; if (v > best) { best = v; bi = g * 8 + j; } }
                    }
                }
                esel[k] = bi; ssel[k] = best - biasl[bi]; wsum += ssel[k]; L[bi] = -INFINITY;
            }
#pragma unroll
            for (int k = 0; k < 8; ++k) lrank[k] = __hip_atomic_fetch_add(hist + esel[k], 1, __ATOMIC_RELAXED, __HIP_MEMORY_SCOPE_WORKGROUP);
        }
        __syncthreads();
        if (tid < 64) { const int c = hist[tid]; basel[tid] = c > 0 ? atomicAdd(cntg + tid, c) : 0; }
        __syncthreads();
        if (tid < 128) {
            const int t = brow + tid; const float wn = 2.5f / wsum;
#pragma unroll
            for (int k = 0; k < 8; ++k) {
                const int e = esel[k], pos = basel[e] + lrank[k];
                tokslot[(size_t)t * 8 + k] = (e << 20) | pos;
                W8[(size_t)t * 8 + k] = ssel[k] * wn;
                LIST[(size_t)e * TT + pos] = t * 8 + k;
            }
        }
    };
    gemm_tiles<false>(lds, tm0 + vcu_id(), TT / 128, gridDim.x, make, epi);
}

__device__ __forceinline__ int moe_find_expert(const LAS int* tp, int mtg) {
    int lo = 0, hi = 64;
    while (lo < hi) { const int mid = (lo + hi + 1) >> 1; if (tp[mid] <= mtg) lo = mid; else hi = mid - 1; }
    return lo;
}
__device__ __forceinline__ void ph_moe1(const Params& p, LAS unsigned char* lds, int l, int row_lo) {
    unsigned char* ws = p.ws;
    moe_tables(p, lds, l, row_lo);
    LAS int* cnt = (LAS int*)(lds + MOE_LDS_OFF); LAS int* tp = cnt + 80; LAS int* sp = tp + 80;
    const bf16* U = (const bf16*)(ws + AM_U8); const bf16* WGU = (const bf16*)(ws + OFF_W_GU); unsigned char* HM = ws + AM_HM;
    const int* LIST = (const int*)(ws + OFF_LIST);
    const int tid = threadIdx.x, lane = tid & 63, wid = tid >> 6, wr = wid >> 1, wc = wid & 1, fr = lane & 15, fq = lane >> 4;
    const int ntiles = tp[65] * 4;
    auto make = [&](int t, GPtrs& g, int& nk) {
        const int mtg = t >> 2, nt = t & 3, e = moe_find_expert(tp, mtg), mt = mtg - tp[e], ce = cnt[e];
        int lv[4];
#pragma unroll
        for (int i = 0; i < 4; ++i) { const int li = mt * 128 + (tid >> 3) + 32 * i; lv[i] = LIST[(size_t)(e < 64 ? e : 0) * TT + (li < ce ? li : 0)]; }
#pragma unroll
        for (int i = 0; i < 4; ++i) {
            const int li = mt * 128 + (tid >> 3) + 32 * i;
            const int tk = li < ce ? (e < 64 ? (lv[i] >> 3) : row_lo + li) : row_lo;
            g.a[i] = U + (size_t)tk * (DM / 2) + stg_col();
        }
        plain_ptrs(WGU + (size_t)e * 512 * (DM / 2), nt * 128, DM / 2, g.b); nk = DM / 128;
    };
    auto epi = [&](int t, f32x4 (&acc)[4][4]) {
        const int mtg = t >> 2, nt = t & 3, e = moe_find_expert(tp, mtg), mt = mtg - tp[e], ce = cnt[e];
        const size_t slot0 = e < 64 ? (size_t)(sp[e] + mt * 128) : (size_t)TT * 8 + row_lo + mt * 128;
        const int hc0 = nt * 64 + wc * 32;
        unsigned char* dump = ws + OFF_DUMP + lane * 64;
        constexpr float isc = 1.f / W8SC;
#pragma unroll
        for (int m = 0; m < 4; ++m) {
            const int i = wr * 64 + m * 16 + fr;
            unsigned char* hrow = (mt * 128 + i < ce) ? HM + (slot0 + i) * 256 + hc0 + fq * 4 : dump;
#pragma unroll
            for (int n = 0; n < 2; ++n) {
                const f32x4 g = acc[m][n] * isc, u = acc[m][n + 2] * (isc * H8SC);
                *(unsigned*)(hrow + n * 16) = pk4_fp8(siluf(g[0]) * u[0], siluf(g[1]) * u[1], siluf(g[2]) * u[2], siluf(g[3]) * u[3]);
            }
        }
    };
    gemm_tiles<true, 8, true>(lds, vcu_id(), ntiles, gridDim.x, make, epi);
}
__device__ __forceinline__ void ph_moe2(const Params& p, LAS unsigned char* lds, int l, int row_lo) {
    unsigned char* ws = p.ws;
    moe_tables(p, lds, l, row_lo);
    LAS int* cnt = (LAS int*)(lds + MOE_LDS_OFF); LAS int* tp = cnt + 80; LAS int* sp = tp + 80;
    const bf16* HM = (const bf16*)(ws + AM_HM); const bf16* WD = (const bf16*)(ws + OFF_W_D);
    const int tid = threadIdx.x, lane = tid & 63, wid = tid >> 6, wr = wid >> 1, wc = wid & 1, fr = lane & 15, fq = lane >> 4;
    const int ntiles = tp[65] * 8;
    auto make = [&](int t, GPtrs& g, int& nk) {
        const int mtg = t >> 3, nt = t & 7, e = moe_find_expert(tp, mtg), mt = mtg - tp[e];
        const size_t slot0 = e < 64 ? (size_t)(sp[e] + mt * 128) : (size_t)TT * 8 + row_lo + mt * 128;
        plain_ptrs(HM, 0, 128, g.a);
#pragma unroll
        for (int i = 0; i < 4; ++i) g.a[i] += slot0 * 128;
        plain_ptrs(WD + (size_t)e * DM * 128, nt * 128, 128, g.b); nk = 256 / 128;
    };
    auto epi = [&](int t, f32x4 (&acc)[4][4]) {
        const int mtg = t >> 3, nt = t & 7, e = moe_find_expert(tp, mtg), mt = mtg - tp[e], ce = cnt[e];
        const size_t slot0 = e < 64 ? (size_t)(sp[e] + mt * 128) : (size_t)TT * 8 + row_lo + mt * 128;
        constexpr float osc = Y8SC / (W8SC * H8SC);
        unsigned char* YR8 = ws + AM_YR; unsigned char* dump = ws + OFF_DUMP + lane * 16;
#pragma unroll
        for (int m = 0; m < 4; ++m) {
            const int i = wr * 64 + m * 16 + fr;
            unsigned char* yrow = (mt * 128 + i < ce) ? YR8 + (slot0 + i) * DM + nt * 128 + wc * 64 + fq * 16 : dump;
            const f32x4 a0 = acc[m][0] * osc, a1 = acc[m][1] * osc, a2 = acc[m][2] * osc, a3 = acc[m][3] * osc;
            *(u32x4*)(yrow) = (u32x4){pk4_fp8(a0[0], a0[1], a0[2], a0[3]), pk4_fp8(a1[0], a1[1], a1[2], a1[3]), pk4_fp8(a2[0], a2[1], a2[2], a2[3]), pk4_fp8(a3[0], a3[1], a3[2], a3[3])};
        }
    };
    gemm_tiles<true, 4, true, true>(lds, vcu_id(), ntiles, gridDim.x, make, epi);
}

__device__ __forceinline__ void ph_inproj1(const Params& p, LAS unsigned char* lds) {
    unsigned char* ws = p.ws;
    const bf16* U = (const bf16*)(ws + OFF_U); const bf16* W = (const bf16*)(ws + OFF_W_IN_O);
    bf16* Z1 = (bf16*)(ws + A1_Z1); unsigned char* KM = ws + A1_KM;
    const f32x2* rope = (const f32x2*)(ws + OFF_ROPE);
    const int tid = threadIdx.x, lane = tid & 63, wid = tid >> 6, wr = wid >> 1, wc = wid & 1, fr = lane & 15, fq = lane >> 4;
    constexpr int NTN = 7, NTM = TT / 128;
    auto make = [&](int t, GPtrs& g, int& nk) { int tm, tn; tile_mn(t, NTM, NTN, tm, tn); plain_ptrs(U, tm * 128, DM, g.a); plain_ptrs(W, tn * 128, DM, g.b); nk = DM / 64; };
    auto epi = [&](int t, f32x4 (&acc)[4][4]) {
        int tm, tn; tile_mn(t, NTM, NTN, tm, tn); const int brow = tm * 128, bcol = tn * 128;
        const int cb = bcol + wc * 64;
        LAS unsigned char* wl = lds + 32768 + wid * 8192;
        const int r0 = brow + wr * 64;
        const RowInfo ri0 = rowinfo(r0);
        if (cb < 768) {
            float* ssq = (float*)(ws + OFF_SSQ);
#pragma unroll
            for (int m = 0; m < 4; ++m) {
                float q = 0.f;
#pragma unroll
                for (int n = 0; n < 4; ++n) q += (acc[m][n][0] * acc[m][n][0] + acc[m][n][1] * acc[m][n][1]) + (acc[m][n][2] * acc[m][n][2] + acc[m][n][3] * acc[m][n][3]);
                q += __shfl_xor(q, 16); q += __shfl_xor(q, 32);
                if (fq == 0) ssq[(size_t)(r0 + m * 16 + fr) * 12 + (cb >> 6)] = q;
            }
            epi_store_rows(wl, acc, fr, fq, lane, [&](int row) { return Z1 + (size_t)(r0 + row) * Z1P + cb; });
        } else if (cb == 768) {
#pragma unroll
            for (int m = 0; m < 4; ++m) {
                const int pos = ri0.pos + m * 16 + fr;
#pragma unroll
                for (int n = 0; n < 2; ++n)
#pragma unroll
                    for (int j = 0; j < 4; ++j) {
                        const float x1 = acc[m][n][j], x2 = acc[m][n + 2][j];
                        if (ri0.lat) { const f32x2 cs = rope[(size_t)pos * 32 + n * 16 + fq * 4 + j]; acc[m][n][j] = x1 * cs.x - x2 * cs.y; acc[m][n + 2][j] = x2 * cs.x + x1 * cs.y; }
                    }
                asm volatile("" ::: "memory");
            }
            unsigned char* dst = KM + ((size_t)(ri0.b * 8) * NKEY + ri0.kq) * 192 + 128;
            epi_store_rows8(wl, acc, fr, fq, lane, [&](int row) { return dst + (size_t)row * 192; }, 8, (size_t)NKEY * 192);
        }
    };
    gemm_tiles<true>(lds, vcu_id(), NTM * NTN, gridDim.x, make, epi);
}

__device__ __forceinline__ void ph_mla_up(const Params& p, LAS unsigned char* lds) {
    unsigned char* ws = p.ws;
    const bf16* Z1 = (const bf16*)(ws + A1_Z1); const bf16* WQ = (const bf16*)(ws + OFF_W_UQ); const bf16* WKV = (const bf16*)(ws + OFF_W_UKV);
    unsigned char* QM = ws + A1_QM; unsigned char* KM = ws + A1_KM; unsigned char* VTM = ws + A1_VTM;
    const f32x2* rope = (const f32x2*)(ws + OFF_ROPE);
    const int tid = threadIdx.x, lane = tid & 63, wid = tid >> 6, wr = wid >> 1, wc = wid & 1, fr = lane & 15, fq = lane >> 4;
    LAS float* rsb = (LAS float*)(lds + 66560);
    constexpr int NQ = (TL / 128) * 12, NKV = (TT / 128) * 16;
    constexpr float QSCALE = 0.07216878364870322f * LOG2E;
    auto decode = [&](int t, bool& isq, int& tm, int& tn) { isq = t < NQ; if (isq) { tile_mn(t, TL / 128, 12, tm, tn); tm += 4; } else tile_mn(t - NQ, TT / 128, 16, tm, tn); };
    auto make = [&](int t, GPtrs& g, int& nk) {
        bool isq; int tm, tn; decode(t, isq, tm, tn);
        const int brow = tm * 128, bcol = tn * 128, K = isq ? 512 : 256, acol = isq ? 0 : 512;
        const int par = ((t - vcu_id()) / (int)gridDim.x) & 1;
        if (tid < 128) {
            const float* q = (const float*)(ws + OFF_SSQ) + (size_t)(brow + tid) * 12;
            float ss;
            if (isq) { const f32x4 a = *(const f32x4*)q, b2 = *(const f32x4*)(q + 4); ss = ((a.x + a.y) + (a.z + a.w)) + ((b2.x + b2.y) + (b2.z + b2.w)); }
            else { const f32x4 a = *(const f32x4*)(q + 8); ss = (a.x + a.y) + (a.z + a.w); }
            rsb[par * 128 + tid] = rsqrtf(ss / (float)K + RMS_EPS);
        }
        plain_ptrs(Z1 + acol, brow, Z1P, g.a); plain_ptrs(isq ? WQ : WKV, bcol, K, g.b); nk = K / 64;
    };
    auto epi = [&](int t, f32x4 (&acc)[4][4]) {
        bool isq; int tm, tn; decode(t, isq, tm, tn);
        const int brow = tm * 128, bcol = tn * 128;
        const int par = ((t - vcu_id()) / (int)gridDim.x) & 1;
        const int cb = bcol + wc * 64;
        LAS unsigned char* wl = lds + 32768 + wid * 8192;
        const int r0 = brow + wr * 64;
        const RowInfo ri0 = rowinfo(r0);
        if (isq) {
            const int h = cb / 192, part = (cb % 192) >> 6;
#pragma unroll
            for (int m = 0; m < 4; ++m) {
                const float sc = rsb[par * 128 + wr * 64 + m * 16 + fr] * (QSCALE * 16.f);
                const int pos = ri0.pos + m * 16 + fr;
                if (part < 2) {
#pragma unroll
                    for (int n = 0; n < 4; ++n) acc[m][n] = acc[m][n] * sc;
                } else {
#pragma unroll
                    for (int n = 0; n < 2; ++n)
#pragma unroll
                        for (int j = 0; j < 4; ++j) {
                            const float x1 = acc[m][n][j] * sc, x2 = acc[m][n + 2][j] * sc;
                            const f32x2 cs = rope[(size_t)pos * 32 + n * 16 + fq * 4 + j];
                            acc[m][n][j] = x1 * cs.x - x2 * cs.y; acc[m][n + 2][j] = x2 * cs.x + x1 * cs.y;
                        }
                }
                asm volatile("" ::: "memory");
            }
            unsigned char* dst = QM + ((size_t)(ri0.b * 8 + h) * SEQ + ri0.pos) * 192 + part * 64;
            epi_store_rows8(wl, acc, fr, fq, lane, [&](int row) { return dst + (size_t)row * 192; });
        } else {
            const int h = cb >> 8, part = (cb & 255) >> 6;
#pragma unroll
            for (int m = 0; m < 4; ++m) {
                const float rs = rsb[par * 128 + wr * 64 + m * 16 + fr];
#pragma unroll
                for (int n = 0; n < 4; ++n) acc[m][n] = acc[m][n] * rs;
            }
            if (part < 2) {
                unsigned char* dst = KM + ((size_t)(ri0.b * 8 + h) * NKEY + ri0.kq) * 192 + part * 64;
                epi_store_rows8(wl, acc, fr, fq, lane, [&](int row) { return dst + (size_t)row * 192; });
            } else {
                unsigned char* dst = VTM + ((size_t)(ri0.b * 8 + h) * 128 + (part - 2) * 64) * NKEY + ri0.kq;
                epi_store_cols8(wl, acc, fr, fq, lane, [&](int col) { return dst + (size_t)col * NKEY; });
            }
        }
    };
    gemm_tiles<true>(lds, vcu_id(), NQ + NKV, gridDim.x, make, epi);
}

__device__ __forceinline__ void attn_mla8_item(LAS unsigned char* lds, const unsigned char* Qg, const unsigned char* Kg, const unsigned char* VTg, bf16* Og, int o_pitch) {
    constexpr int KBYTES = 64 * 192, VBYTES = 128 * 64, NT = NKEY / 64;
    constexpr float SC = 1.f / 16.f;
    const int tid = threadIdx.x, lane = tid & 63, wid = tid >> 6, ql = lane & 31, hi = lane >> 5;
    LAS unsigned char* Kb0 = lds; LAS unsigned char* Vb0 = lds + 2 * KBYTES;
    asm volatile("s_waitcnt vmcnt(0) lgkmcnt(0)" ::: "memory");
    __builtin_amdgcn_s_barrier();
    asm volatile("" ::: "memory");
    i32x8 qf[3];
    {
        const unsigned char* qrow = Qg + (size_t)(wid * 32 + ql) * 192 + hi * 32;
#pragma unroll
        for (int s = 0; s < 3; ++s) { const u32x4 x = *(const u32x4*)(qrow + s * 64), y = *(const u32x4*)(qrow + s * 64 + 16);
            qf[s] = (i32x8){(int)x.x, (int)x.y, (int)x.z, (int)x.w, (int)y.x, (int)y.y, (int)y.z, (int)y.w}; }
    }
    unsigned koff[3], voff[2];
#pragma unroll
    for (int i = 0; i < 3; ++i) { const int pz = tid + 256 * i, key = pz / 12, ch = pz % 12; koff[i] = (unsigned)(key * 192 + (((ch & ~3) | ((ch & 3) ^ ((key >> 2) & 3))) * 16)); }
#pragma unroll
    for (int i = 0; i < 2; ++i) { const int pz = tid + 256 * i, dv = pz >> 2, ch = pz & 3; voff[i] = (unsigned)(dv * NKEY + ((ch ^ ((dv >> 2) & 3)) * 16)); }
#define A8_DMA_K(IT_) do { _Pragma("unroll") for (int i_ = 0; i_ < 3; ++i_) glds16(Kg + (size_t)(IT_) * 64 * 192 + koff[i_], Kb0 + ((IT_) & 1) * KBYTES + (tid + 256 * i_) * 16); } while (0)
#define A8_DMA_V(IT_) do { _Pragma("unroll") for (int i_ = 0; i_ < 2; ++i_) glds16(VTg + (size_t)(IT_) * 64 + voff[i_], Vb0 + ((IT_) & 1) * VBYTES + (tid + 256 * i_) * 16); } while (0)
    f32x16 o[4];
#pragma unroll
    for (int d = 0; d < 4; ++d)
#pragma unroll
        for (int r = 0; r < 16; ++r) o[d][r] = 0.f;
    float mrun = -1e30f, lrun = 0.f;
    const int swz = (ql >> 2) & 3;
    const LAS unsigned char* kfrag = Kb0 + ql * 192; const LAS unsigned char* vfrag = Vb0 + ql * 64;
#define A8_MFMA(A_, B_, C_) __builtin_amdgcn_mfma_scale_f32_32x32x64_f8f6f4(A_, B_, C_, 0, 0, 0, 0x7F7F7F7F, 0, 0x7F7F7F7F)
#define A8_LD32(DST_, P0_, P1_) do { const u32x4 x_ = *(const LAS u32x4*)(P0_), y_ = *(const LAS u32x4*)(P1_); DST_ = (i32x8){(int)x_.x, (int)x_.y, (int)x_.z, (int)x_.w, (int)y_.x, (int)y_.y, (int)y_.z, (int)y_.w}; } while (0)
#define A8_QK(P0_, P1_, IT_) do { \
        _Pragma("unroll") for (int r_ = 0; r_ < 16; ++r_) { P0_[r_] = 0.f; P1_[r_] = 0.f; } \
        const LAS unsigned char* kc_ = kfrag + ((IT_) & 1) * KBYTES; \
        _Pragma("unroll") for (int s_ = 0; s_ < 3; ++s_) { \
            const int c0_ = 4 * s_ + 2 * hi, o0_ = ((c0_ & ~3) | ((c0_ & 3) ^ swz)) * 16, o1_ = ((c0_ & ~3) | (((c0_ + 1) & 3) ^ swz)) * 16; \
            i32x8 k0_, k1_; A8_LD32(k0_, kc_ + o0_, kc_ + o1_); A8_LD32(k1_, kc_ + 32 * 192 + o0_, kc_ + 32 * 192 + o1_); \
            P0_ = A8_MFMA(k0_, qf[s_], P0_); P1_ = A8_MFMA(k1_, qf[s_], P1_); } } while (0)
#define A8_STEP(C0_, C1_, N0_, N1_, IT_) do { \
          \
        asm volatile("s_waitcnt vmcnt(0) lgkmcnt(0)" ::: "memory"); __builtin_amdgcn_s_barrier(); asm volatile("" ::: "memory"); \
        if ((IT_) + 2 < NT) A8_DMA_K((IT_) + 2); \
        if ((IT_) + 1 < NT) A8_DMA_V((IT_) + 1); \
        if ((IT_) + 1 < NT) A8_QK(N0_, N1_, (IT_) + 1); \
        float mx_ = C0_[0]; \
        _Pragma("unroll") for (int r_ = 1; r_ < 16; ++r_) mx_ = fmaxf(mx_, C0_[r_]); \
        _Pragma("unroll") for (int r_ = 0; r_ < 16; ++r_) mx_ = fmaxf(mx_, C1_[r_]); \
        mx_ = fmaxf(mx_, __shfl_xor(mx_, 32)) * SC; \
        if (__any(mx_ > mrun + 8.f)) { const float mn_ = fmaxf(mrun, mx_), alpha_ = ex2(mrun - mn_); mrun = mn_; lrun *= alpha_; \
            _Pragma("unroll") for (int d_ = 0; d_ < 4; ++d_) _Pragma("unroll") for (int r_ = 0; r_ < 16; ++r_) o[d_][r_] *= alpha_; } \
        float rs_ = 0.f; \
        _Pragma("unroll") for (int r_ = 0; r_ < 16; ++r_) { C0_[r_] = ex2(fmaf(C0_[r_], SC, -mrun)); rs_ += C0_[r_]; } \
        _Pragma("unroll") for (int r_ = 0; r_ < 16; ++r_) { C1_[r_] = ex2(fmaf(C1_[r_], SC, -mrun)); rs_ += C1_[r_]; } \
        rs_ += __shfl_xor(rs_, 32); lrun += rs_; \
          \
        i32x8 pf_; \
        { unsigned x_[4], y_[4]; \
          _Pragma("unroll") for (int v_ = 0; v_ < 4; ++v_) { x_[v_] = pk4_fp8(C0_[4 * v_], C0_[4 * v_ + 1], C0_[4 * v_ + 2], C0_[4 * v_ + 3]); y_[v_] = pk4_fp8(C1_[4 * v_], C1_[4 * v_ + 1], C1_[4 * v_ + 2], C1_[4 * v_ + 3]); } \
          _Pragma("unroll") for (int v_ = 0; v_ < 4; ++v_) { const auto r_ = __builtin_amdgcn_permlane32_swap(x_[v_], y_[v_], false, false); x_[v_] = r_[0]; y_[v_] = r_[1]; } \
          pf_ = (i32x8){(int)x_[0], (int)x_[1], (int)x_[2], (int)x_[3], (int)y_[0], (int)y_[1], (int)y_[2], (int)y_[3]}; } \
        const LAS unsigned char* vc_ = vfrag + ((IT_) & 1) * VBYTES; \
        _Pragma("unroll") for (int d_ = 0; d_ < 4; ++d_) { i32x8 vf_; A8_LD32(vf_, vc_ + d_ * 32 * 64 + (((2 * hi) ^ swz) * 16), vc_ + d_ * 32 * 64 + (((2 * hi + 1) ^ swz) * 16)); \
            o[d_] = A8_MFMA(vf_, pf_, o[d_]); } } while (0)
    A8_DMA_K(0); A8_DMA_V(0);
    asm volatile("s_waitcnt vmcnt(0) lgkmcnt(0)" ::: "memory"); __builtin_amdgcn_s_barrier(); asm volatile("" ::: "memory");
    A8_DMA_K(1);
    f32x16 pA0, pA1, pB0, pB1;
    A8_QK(pA0, pA1, 0);
#pragma unroll 1
    for (int it = 0; it < NT; ++it) {
        A8_STEP(pA0, pA1, pB0, pB1, it);
        pA0 = pB0; pA1 = pB1;
    }
#undef A8_STEP
#undef A8_QK
#undef A8_LD32
#undef A8_MFMA
#undef A8_DMA_K
#undef A8_DMA_V
    const float inv = 1.f / lrun;
    bf16* orow = Og + (size_t)(wid * 32 + ql) * o_pitch;
#pragma unroll
    for (int d = 0; d < 4; ++d)
#pragma unroll
        for (int g = 0; g < 4; ++g) {
            u32x2 w; w.x = pk2(o[d][g * 4 + 0] * inv, o[d][g * 4 + 1] * inv); w.y = pk2(o[d][g * 4 + 2] * inv, o[d][g * 4 + 3] * inv);
            *(u32x2*)(orow + d * 32 + 8 * g + 4 * hi) = w;
        }
}

__device__ __forceinline__ void ph_mla_attn(const Params& p, LAS unsigned char* lds) {
    unsigned char* ws = p.ws;
    const unsigned char* QM = ws + A1_QM; const unsigned char* KM = ws + A1_KM; const unsigned char* VTM = ws + A1_VTM; bf16* MIX = (bf16*)(ws + A1_MIX);
    for (int item = vcu_id(); item < 2 * 8 * 64; item += gridDim.x) {
        const int qt = item & 63, h = (item >> 6) & 7, b = item >> 9;
        const unsigned char* Qg = QM + ((size_t)(b * 8 + h) * SEQ + qt * 128) * 192;
        const unsigned char* Kg = KM + (size_t)(b * 8 + h) * NKEY * 192;
        const unsigned char* Vg = VTM + (size_t)(b * 8 + h) * 128 * NKEY;
        attn_mla8_item(lds, Qg, Kg, Vg, MIX + (size_t)(TC + b * SEQ + qt * 128) * DM + h * 128, DM);
    }
}

#define XB_TMO      128
#define XB_XCNT(j)  (256  + 64 * (j))
#define XB_XSUB(j)  (1280 + 64 * (j))
#define XB_XGEN(j)  (2304 + 64 * (j))
#define XB_TOP      3328
#define XB_TOPGEN   3392
#define XCD_BAR_WORDS 3456
#define XB_SPIN_CAP (1u << 18)
__device__ __forceinline__ unsigned xb_ld(unsigned* p)              { return __hip_atomic_load(p, __ATOMIC_RELAXED, __HIP_MEMORY_SCOPE_AGENT); }
__device__ __forceinline__ unsigned xb_add(unsigned* p, unsigned v) { return __hip_atomic_fetch_add(p, v, __ATOMIC_RELAXED, __HIP_MEMORY_SCOPE_AGENT); }
__device__ __forceinline__ unsigned xb_xcc_id() { return (unsigned)__builtin_amdgcn_s_getreg((3 << 11) | 20) & 0xFu; }
#define XB_SPIN(cond, bar) do { unsigned _sp = 0; while (cond) { __builtin_amdgcn_s_sleep(1); \
    if ((++_sp & 255u) == 0u) { if (xb_ld(&(bar)[XB_TMO])) break; if (_sp > XB_SPIN_CAP) { atomicAdd(&(bar)[XB_TMO], 1u); break; } } } } while (0)
struct XcdBarrier { unsigned* bar; unsigned x; volatile LAS unsigned* st; };
__device__ __forceinline__ XcdBarrier xcd_barrier_post(unsigned* bar, volatile LAS unsigned* st) {
    XcdBarrier b; b.bar = bar; b.x = xb_xcc_id(); b.st = st;
    if (threadIdx.x == 0) (void)xb_add(&bar[XB_XCNT(b.x)], 1u);
    return b;
}
__device__ __forceinline__ void xcd_barrier_complete(unsigned* bar, unsigned x, unsigned& nloc, unsigned& nx) {
    const unsigned G = gridDim.x * gridDim.y * gridDim.z;
    unsigned sum, cnt, mine, sp = 0u;
    for (;;) {
        sum = 0u; cnt = 0u; mine = 0u;
#pragma unroll
        for (unsigned j = 0; j < 16; ++j) { const unsigned c = xb_ld(&bar[XB_XCNT(j)]); sum += c; cnt += (c > 0u) ? 1u : 0u; mine = (j == x) ? c : mine; }
        if (sum == G) break;
        __builtin_amdgcn_s_sleep(1);
        if ((++sp & 255u) == 0u) { if (xb_ld(&bar[XB_TMO])) break; if (sp > XB_SPIN_CAP) { atomicAdd(&bar[XB_TMO], 1u); break; } }
    }
    nloc = mine > 0u ? mine : 1u; nx = cnt > 0u ? cnt : 1u;
}
__device__ __forceinline__ void xcd_barrier(const XcdBarrier& b) {
    asm volatile("s_waitcnt vmcnt(0)" ::: "memory");
    __syncthreads();
    if (threadIdx.x == 0) {
        unsigned* bar = b.bar;
        __builtin_amdgcn_s_waitcnt(0);
        unsigned nloc = b.st[0], nx = b.st[1];
        if (nloc == 0u) { xcd_barrier_complete(bar, b.x, nloc, nx); b.st[0] = nloc; b.st[1] = nx; }
        const unsigned old = xb_add(&bar[XB_XSUB(b.x)], 1u);
        const unsigned gen = old / nloc;
        if (old + 1u == (gen + 1u) * nloc) {
            __builtin_amdgcn_fence(__ATOMIC_RELEASE, "agent");
            asm volatile("s_waitcnt vmcnt(0)" ::: "memory");
            const unsigned og = xb_add(&bar[XB_TOP], 1u);
            const unsigned tg = og / nx;
            if (og + 1u == (tg + 1u) * nx) xb_add(&bar[XB_TOPGEN], 1u);
            else XB_SPIN(xb_ld(&bar[XB_TOPGEN]) == tg, bar);
            __builtin_amdgcn_fence(__ATOMIC_ACQUIRE, "agent");
            xb_add(&bar[XB_XGEN(b.x)], 1u);
            asm volatile("s_waitcnt vmcnt(0)" ::: "memory");
        } else {
            XB_SPIN(xb_ld(&bar[XB_XGEN(b.x)]) == gen, bar);
            __builtin_amdgcn_fence(__ATOMIC_ACQUIRE, "agent");
            asm volatile("s_waitcnt vmcnt(0)" ::: "memory");
        }
    }
    __syncthreads();
}
static_assert(XCD_BAR_WORDS * 4 <= BAR_BYTES, "barrier words");

__device__ __forceinline__ void convert_shared(const Params& p, LAS unsigned char* lds, int l, int nrt) {
    const int v = vcu_id(), G = gridDim.x, nfree = G - nrt;
    if (v >= nrt) for (int it = v - nrt; it < EXP_ITEMS; it += nfree) expert_convert_item(p, lds, l, it);
}

constexpr int NPHASE = 19;
__global__ void __launch_bounds__(256, 2) mega(Params p) {
    extern __shared__ __attribute__((aligned(16))) unsigned char lds_[];
    LAS unsigned char* lds = (LAS unsigned char*)lds_;
    cg::grid_group grid = cg::this_grid();
    unsigned char* ws = p.ws;
    volatile LAS unsigned* bst = (volatile LAS unsigned*)(lds + LDS_BYTES - 16);
    if (threadIdx.x < 4) bst[threadIdx.x] = 0u;
    __syncthreads();
    const XcdBarrier xbar = xcd_barrier_post((unsigned*)(ws + OFF_BAR), bst);
#define GRID_BAR(k) do { if ((k) == 0) grid.sync(); else xcd_barrier(xbar); } while (0)
#ifndef PROBE_REP_MASK
#define PROBE_REP_MASK 0u
#endif
#ifndef PROBE_EXTRA_SYNCS
#define PROBE_EXTRA_SYNCS 0
#endif
#define PHASE(k, body) do { if (p.ph_lo <= (k) && (k) < p.ph_hi) { body; if ((PROBE_REP_MASK >> (k)) & 1u) { xcd_barrier(xbar); body; } if ((k) + 1 < p.ph_hi) GRID_BAR(k); } } while (0)
    for (int i = 0; i < PROBE_EXTRA_SYNCS; ++i) xcd_barrier(xbar);
    PHASE(0, ph_prep(p, lds));
    PHASE(1, ph_modulate0(p));
    PHASE(2, ph_inproj0(p, lds));
    PHASE(3, ph_swa_g1(p, lds));
    PHASE(4, ph_gla_scan(p));
    PHASE(5, ph_gla_g3(p, lds));
    PHASE(6, ph_outproj(p, lds, (const bf16*)(ws + A0_MIX), (const bf16*)(ws + OFF_W_OUT_E), (float*)(ws + A0_Y), 0));
    PHASE(7, ph_rowpassA(p, 0, 0, (const float*)(ws + A0_Y)));
    PHASE(8, { ph_router(p, lds, 0, 0); __syncthreads(); convert_shared(p, lds, 0, TT / 128); });
    PHASE(9, ph_moe1(p, lds, 0, 0));
    PHASE(10, ph_moe2(p, lds, 0, 0));
    PHASE(11, ph_rowpassB(p, lds, 0, 0));
    PHASE(12, ph_inproj1(p, lds));
    PHASE(13, ph_mla_up(p, lds));
    PHASE(14, ph_mla_attn(p, lds));
    PHASE(15, ph_outproj(p, lds, (const bf16*)(ws + A1_MIX), (const bf16*)(ws + OFF_W_OUT_O), (float*)(ws + A1_Y), TC));
    PHASE(16, ph_rowpassA(p, 1, TC, (const float*)(ws + A1_Y)));
    PHASE(17, { ph_router(p, lds, 1, TC); __syncthreads(); convert_shared(p, lds, 1, TL / 128); });
    PHASE(18, ph_moe1(p, lds, 1, TC));
    PHASE(19, ph_moe2(p, lds, 1, TC));
    PHASE(20, ph_rowpassB(p, lds, 1, TC));
}

extern "C" void kernel_launch(void* const* d_in, const int* in_sizes, int n_in, void* d_out, int out_size, void* d_ws, size_t ws_size, hipStream_t stream) {
    static int grid_blocks = 0;
    if (!grid_blocks) {
        int dev = 0, cus = 0, per_cu = 0;
        (void)hipGetDevice(&dev);
        (void)hipDeviceGetAttribute(&cus, hipDeviceAttributeMultiprocessorCount, dev);
        (void)hipFuncSetAttribute((const void*)mega, hipFuncAttributeMaxDynamicSharedMemorySize, LDS_BYTES);
        (void)hipOccupancyMaxActiveBlocksPerMultiprocessor(&per_cu, (const void*)mega, 256, LDS_BYTES);
        if (per_cu > 2) per_cu = 2;
        if (per_cu < 1) per_cu = 1;
        grid_blocks = cus * per_cu;
        if (ws_size < WS_NEED) fprintf(stderr, "kernel_launch: workspace too small: %zu < %zu\n", ws_size, (size_t)WS_NEED);
    }
    Params p{};
    const float** f = (const float**)&p;
    for (int i = 0; i < 30; ++i) f[i] = (const float*)d_in[i];
    p.out = (float*)d_out; p.ws = (unsigned char*)d_ws; p.ph_lo = 0; p.ph_hi = 21;
    (void)hipMemsetAsync((unsigned char*)d_ws + OFF_BAR, 0, BAR_BYTES, stream);
    void* args[] = {&p};
    hipError_t e = hipLaunchCooperativeKernel((const void*)mega, dim3(grid_blocks), dim3(256), args, LDS_BYTES, stream);
    if (e != hipSuccess) fprintf(stderr, "cooperative launch failed: %s (grid %d)\n", hipGetErrorString(e), grid_blocks);
}
```
